# Optimizing an MI355X kernel written in HIP

```python
import math
import jax, jax.numpy as jnp
from jax import lax
import numpy as np

D_MODEL = 1024
BATCH = 32
SEQ = 256
DEPTH = 4
DEC_BATCH = 4
DEC_SEQ = 2048
PAST_LEN = 512

GRID_W = 64
HEAD_DIM = 64
AXIS_DIM = HEAD_DIM // 2
ROPE_THETA = 10000.0
QBLK = 128
GQA_HEADS = 8
GQA_KV_HEADS = 2
DIFF_HEADS = 4
RWKV_HEADS = D_MODEL // HEAD_DIM
DECAY_LORA = 64
AAA_LORA = 64
GATE_LORA = 128
D_FF = 4 * D_MODEL
N_ATTN_LAYERS = (DEPTH + 1) // 2
N_RWKV_LAYERS = DEPTH // 2
GQA_Q = GQA_HEADS * HEAD_DIM
GQA_KV = GQA_KV_HEADS * HEAD_DIM
DIFF_QK = DIFF_HEADS * 2 * HEAD_DIM
DIFF_V = DIFF_HEADS * 2 * HEAD_DIM
ATTN_IN = GQA_Q + 2 * GQA_KV + 2 * DIFF_QK + DIFF_V
ATTN_SPLITS = (GQA_Q, GQA_Q + GQA_KV, GQA_Q + 2 * GQA_KV, GQA_Q + 2 * GQA_KV + DIFF_QK, GQA_Q + 2 * GQA_KV + 2 * DIFF_QK)
MIX_WIDTH = GQA_Q + DIFF_V
NORM_EPS = 1e-6
LNX_EPS = 64e-5

kernel_name = 'hybrid_dit_gqa_diffattn_birwkv7_step'

F32 = jnp.float32


def rms_norm(x, g):
    xf = x.astype(F32)
    y = xf * lax.rsqrt(jnp.mean(xf * xf, axis=-1, keepdims=True) + NORM_EPS)
    return y.astype(x.dtype) * g


def adaln(cond, w, b):
    m = jax.nn.silu(cond) @ w + b
    return jnp.split(m[:, None, :], 6, axis=-1)


def axial_rope(rows):
    row = jnp.repeat(jnp.arange(rows), GRID_W).astype(F32)
    col = jnp.tile(jnp.arange(GRID_W), rows).astype(F32)
    inv = 1.0 / (ROPE_THETA ** (jnp.arange(0, AXIS_DIM, 2, dtype=F32) / AXIS_DIM))
    ar = row[:, None] * inv[None, :]
    ac = col[:, None] * inv[None, :]
    ang = jnp.concatenate([ar, ar, ac, ac], axis=-1)
    return jnp.cos(ang), jnp.sin(ang)


def apply_rope(x, cos, sin):
    bshape = (cos.shape[0],) + (1,) * (x.ndim - 3) + (HEAD_DIM,)
    xh = x.reshape(x.shape[:-1] + (2, 2, AXIS_DIM // 2))
    rot = jnp.stack([-xh[..., 1, :], xh[..., 0, :]], axis=-2).reshape(x.shape)
    return (x.astype(F32) * cos.reshape(bshape) + rot.astype(F32) * sin.reshape(bshape)).astype(x.dtype)


def sweep_query_blocks(fn, q):
    B, T = q.shape[:2]
    nb = T // QBLK
    qb = jnp.moveaxis(q.reshape((B, nb, QBLK) + q.shape[2:]), 1, 0)
    out = lax.map(fn, qb)
    return jnp.moveaxis(out, 0, 1).reshape((B, T) + out.shape[3:])


def gqa_attention(q, k, v):
    B, T = q.shape[:2]
    grp = GQA_HEADS // GQA_KV_HEADS
    qg = q.reshape(B, T, GQA_KV_HEADS, grp, HEAD_DIM)
    scale = HEAD_DIM ** -0.5

    def block(qb):
        s = jnp.einsum('bqhgd,bkhd->bhgqk', qb, k).astype(F32) * scale
        p = jax.nn.softmax(s, axis=-1).astype(v.dtype)
        return jnp.einsum('bhgqk,bkhd->bqhgd', p, v)

    return sweep_query_blocks(block, qg).reshape(B, T, GQA_Q)


def diff_attention(q, k, v, lam):
    scale = HEAD_DIM ** -0.5

    def block(qb):
        s = jnp.einsum('bqhcd,bkhcd->bhcqk', qb, k).astype(F32) * scale
        p = jax.nn.softmax(s, axis=-1)
        pd = (p[:, :, 0] - lam * p[:, :, 1]).astype(v.dtype)
        return jnp.einsum('bhqk,bkhe->bqhe', pd, v)

    return sweep_query_blocks(block, q)


def attn_mixer(h, p, lam_init, rope, ctx):
    w_in, w_out, qk_gain, lam_vec, subln_g = p
    B, T, _ = h.shape
    qa, ka, va, qb, kb, vb = jnp.split(h @ w_in, ATTN_SPLITS, axis=-1)
    qa = rms_norm(qa.reshape(B, T, GQA_HEADS, HEAD_DIM), qk_gain[0])
    ka = rms_norm(ka.reshape(B, T, GQA_KV_HEADS, HEAD_DIM), qk_gain[1])
    va = va.reshape(B, T, GQA_KV_HEADS, HEAD_DIM)
    qb = qb.reshape(B, T, DIFF_HEADS, 2, HEAD_DIM)
    kb = kb.reshape(B, T, DIFF_HEADS, 2, HEAD_DIM)
    vb = vb.reshape(B, T, DIFF_HEADS, 2 * HEAD_DIM)
    side = (ka, va, kb, vb)
    if rope is not None:
        cos, sin = rope
        qa, ka, qb, kb = (apply_rope(t, cos, sin) for t in (qa, ka, qb, kb))
    if ctx is not None:
        ka, va, kb, vb = (jnp.concatenate([cc, t], axis=1) for cc, t in zip(ctx, (ka, va, kb, vb)))
    oa = gqa_attention(qa, ka, va)
    lf = lam_vec.astype(F32)
    lam = jnp.exp(jnp.sum(lf[0] * lf[1])) - jnp.exp(jnp.sum(lf[2] * lf[3])) + lam_init
    ob = rms_norm(diff_attention(qb, kb, vb, lam), subln_g) * (1.0 - lam_init)
    out = jnp.concatenate([oa, ob.reshape(B, T, DIFF_V)], axis=-1) @ w_out
    return out, side


def token_shift_centred(h):
    hp = jnp.pad(h[:, :-1], ((0, 0), (1, 0), (0, 0)))
    hn = jnp.pad(h[:, 1:], ((0, 0), (0, 1), (0, 0)))
    return 0.5 * (hp + hn) - h


def wkv_scan(r, decay, k, v, kk, a, s0, reverse):
    seq = tuple(jnp.moveaxis(t.astype(F32), 1, 0) for t in (r, decay, k, v, kk, kk * a))

    def step(S, inp):
        r_t, w_t, k_t, v_t, kk_t, kka_t = inp
        sk = jnp.einsum('bhvk,bhk->bhv', S, kk_t)
        S = S * w_t[:, :, None, :] - sk[..., None] * kka_t[:, :, None, :] + v_t[..., None] * k_t[:, :, None, :]
        return S, jnp.einsum('bhvk,bhk->bhv', S, r_t)

    sf, ys = lax.scan(step, s0.astype(F32), seq, reverse=reverse)
    return jnp.moveaxis(ys, 0, 1), sf


def rwkv_mixer(h, p, s0):
    mu, w_rkv, w_o, w0, w1, w2, a0, a1, a2, g1, g2, kvec, lnx = p
    B, T, D = h.shape
    hs = (B, T, RWKV_HEADS, HEAD_DIM)
    xx = token_shift_centred(h)
    xr, xw, xk, xv, xa, xg = (h + xx * mu[n] for n in range(6))
    r = (xr @ w_rkv[0]).reshape(hs)
    k = (xk @ w_rkv[1]).reshape(hs)
    v = (xv @ w_rkv[2]).reshape(hs)
    g = jax.nn.sigmoid(xg @ g1) @ g2
    k_k, k_a, r_k = (kvec[n].reshape(RWKV_HEADS, HEAD_DIM) for n in range(3))
    kk = (k * k_k).astype(F32)
    kk = kk * lax.rsqrt(jnp.sum(kk * kk, axis=-1, keepdims=True) + 1e-12)
    ys, bonuses, finals = [], [], []
    for d in range(2):
        wlog = -jax.nn.softplus(-(w0[d] + jnp.tanh(xw @ w1[d]) @ w2[d])) - 0.5
        decay = jnp.exp(-jnp.exp(wlog.astype(F32))).reshape(hs)
        a = jax.nn.sigmoid(a0[d] + (xa @ a1[d]) @ a2[d]).reshape(hs)
        kd = k * (1.0 + (a - 1.0) * k_a)
        y, sf = wkv_scan(r, decay, kd, v, kk, a, s0[:, d], reverse=(d == 1))
        ys.append(y)
        bonuses.append(jnp.sum(r * kd * r_k, axis=-1, keepdims=True) * v)
        finals.append(sf)
    y = ys[0] + ys[1]
    mean = jnp.mean(y, axis=-1, keepdims=True)
    var = jnp.mean(jnp.square(y - mean), axis=-1, keepdims=True)
    y = (y - mean) * lax.rsqrt(var + LNX_EPS)
    y = y.astype(h.dtype) * lnx[0].reshape(RWKV_HEADS, HEAD_DIM) + lnx[1].reshape(RWKV_HEADS, HEAD_DIM)
    y = y + bonuses[0] + bonuses[1]
    out = (y.reshape(B, T, D) * g) @ w_o
    return out, jnp.stack(finals, axis=1).astype(h.dtype)


def trunk_layer(x, cond, w_ada, b_ada, gains, w1, w2, mix_fn):
    sh1, sc1, gt1, sh2, sc2, gt2 = adaln(cond, w_ada, b_ada)
    h = rms_norm(x, gains[0]) * (1.0 + sc1) + sh1
    m, side = mix_fn(h)
    x = x + gt1 * rms_norm(m, gains[1])
    h = rms_norm(x, gains[2]) * (1.0 + sc2) + sh2
    f = jnp.square(jax.nn.relu(h @ w1)) @ w2
    x = x + gt2 * rms_norm(f, gains[3])
    return x, side


def setup_inputs(seed: int = 0) -> dict:
    key = jax.random.key(seed)
    ks = iter(jax.random.split(key, 48))
    D = D_MODEL
    LA, LR = N_ATTN_LAYERS, N_RWKV_LAYERS

    def nrm(shape, scale):
        return scale * jax.random.normal(next(ks), shape, F32)

    def unif(shape, lo, hi):
        return jax.random.uniform(next(ks), shape, F32, lo, hi)

    kv_off = jnp.array([0.85, 1.0, 0.0], F32)[None, :, None]
    kv_sc = jnp.array([0.02, 0.02, 0.1], F32)[None, :, None]
    ln_off = jnp.array([1.0, 0.0], F32)[None, :, None]
    ln_sc = jnp.array([0.02, 0.01], F32)[None, :, None]
    return {
        'x_prompt': nrm((BATCH, SEQ, D), 1.0),
        'x_sample': nrm((DEC_BATCH, DEC_SEQ, D), 1.0),
        'c': nrm((DEC_BATCH, D), 1.0),
        'cache_k_gqa': nrm((DEC_BATCH, LA, PAST_LEN, GQA_KV_HEADS, HEAD_DIM), 1.0),
        'cache_v_gqa': nrm((DEC_BATCH, LA, PAST_LEN, GQA_KV_HEADS, HEAD_DIM), 1.0),
        'cache_k_diff': nrm((DEC_BATCH, LA, PAST_LEN, DIFF_HEADS, 2, HEAD_DIM), 1.0),
        'cache_v_diff': nrm((DEC_BATCH, LA, PAST_LEN, DIFF_HEADS, 2 * HEAD_DIM), 1.0),
        'state_rwkv': nrm((DEC_BATCH, LR, 2, RWKV_HEADS, HEAD_DIM, HEAD_DIM), 0.5),
        'c_ctx': nrm((D,), 1.0),
        'w_ada': nrm((DEPTH, D, 6 * D), 0.5 * D ** -0.5),
        'b_ada': nrm((DEPTH, 6 * D), 0.02),
        'norm_gains': 1.0 + nrm((DEPTH, 4, D), 0.02),
        'attn_w_in': nrm((LA, D, ATTN_IN), D ** -0.5),
        'attn_w_out': nrm((LA, MIX_WIDTH, D), MIX_WIDTH ** -0.5),
        'attn_qk_gain': 1.0 + nrm((LA, 2, HEAD_DIM), 0.02),
        'diff_lambda': nrm((LA, 4, HEAD_DIM), 0.1),
        'diff_subln': 1.0 + nrm((LA, 2 * HEAD_DIM), 0.02),
        'rwkv_mu': unif((LR, 6, D), 0.0, 1.0),
        'rwkv_w_rkv': nrm((LR, 3, D, D), D ** -0.5),
        'rwkv_w_o': nrm((LR, D, D), D ** -0.5),
        'rwkv_w0': unif((LR, 2, D), -5.0, 0.0),
        'rwkv_w1': nrm((LR, 2, D, DECAY_LORA), D ** -0.5),
        'rwkv_w2': nrm((LR, 2, DECAY_LORA, D), 0.1 * DECAY_LORA ** -0.5),
        'rwkv_a0': nrm((LR, 2, D), 0.1),
        'rwkv_a1': nrm((LR, 2, D, AAA_LORA), D ** -0.5),
        'rwkv_a2': nrm((LR, 2, AAA_LORA, D), 0.5 * AAA_LORA ** -0.5),
        'rwkv_g1': nrm((LR, D, GATE_LORA), D ** -0.5),
        'rwkv_g2': nrm((LR, GATE_LORA, D), GATE_LORA ** -0.5),
        'rwkv_kvec': kv_off + kv_sc * jax.random.normal(next(ks), (LR, 3, D), F32),
        'rwkv_lnx': ln_off + ln_sc * jax.random.normal(next(ks), (LR, 2, D), F32),
        'mlp_w1': nrm((DEPTH, D, D_FF), D ** -0.5),
        'mlp_w2': nrm((DEPTH, D_FF, D), D_FF ** -0.5),
    }


def reference(x_prompt, x_sample, c, cache_k_gqa, cache_v_gqa, cache_k_diff, cache_v_diff, state_rwkv,
              c_ctx, w_ada, b_ada, norm_gains, attn_w_in, attn_w_out, attn_qk_gain, diff_lambda, diff_subln,
              rwkv_mu, rwkv_w_rkv, rwkv_w_o, rwkv_w0, rwkv_w1, rwkv_w2, rwkv_a0, rwkv_a1, rwkv_a2,
              rwkv_g1, rwkv_g2, rwkv_kvec, rwkv_lnx, mlp_w1, mlp_w2):
    rows = x_sample.shape[1] // GRID_W
    rope = axial_rope(rows)
    ctx_cond = c_ctx[None, :]
    zero_state = jnp.zeros((x_prompt.shape[0], 2, RWKV_HEADS, HEAD_DIM, HEAD_DIM), x_prompt.dtype)
    xp, xs = x_prompt, x_sample
    kg, vg, kd, vd, st = [], [], [], [], []
    for i in range(DEPTH):
        j = i // 2
        lp = (w_ada[i], b_ada[i], norm_gains[i], mlp_w1[i], mlp_w2[i])
        if i % 2 == 0:
            lam_init = 0.8 - 0.6 * math.exp(-0.3 * i)
            ap = (attn_w_in[j], attn_w_out[j], attn_qk_gain[j], diff_lambda[j], diff_subln[j])
            xp, side = trunk_layer(xp, ctx_cond, *lp, lambda h: attn_mixer(h, ap, lam_init, None, None))
            kg.append(side[0]); vg.append(side[1]); kd.append(side[2]); vd.append(side[3])
            cached = (cache_k_gqa[:, j], cache_v_gqa[:, j], cache_k_diff[:, j], cache_v_diff[:, j])
            xs, _ = trunk_layer(xs, c, *lp, lambda h: attn_mixer(h, ap, lam_init, rope, cached))
        else:
            rp = (rwkv_mu[j], rwkv_w_rkv[j], rwkv_w_o[j], rwkv_w0[j], rwkv_w1[j], rwkv_w2[j],
                  rwkv_a0[j], rwkv_a1[j], rwkv_a2[j], rwkv_g1[j], rwkv_g2[j], rwkv_kvec[j], rwkv_lnx[j])
            xp, sf = trunk_layer(xp, ctx_cond, *lp, lambda h: rwkv_mixer(h, rp, zero_state))
            st.append(sf)
            s0 = state_rwkv[:, j]
            xs, _ = trunk_layer(xs, c, *lp, lambda h: rwkv_mixer(h, rp, s0))
    new_k_gqa = jnp.stack(kg, axis=1)
    new_v_gqa = jnp.stack(vg, axis=1)
    new_k_diff = jnp.stack(kd, axis=1)
    new_v_diff = jnp.stack(vd, axis=1)
    new_state_rwkv = jnp.stack(st, axis=1)
    return (xp, xs, new_k_gqa, new_v_gqa, new_k_diff, new_v_diff, new_state_rwkv)
```

```cpp
#include <hip/hip_runtime.h>
#include <hip/hip_cooperative_groups.h>
#include <cstdio>
#include <cstdint>
namespace cg = cooperative_groups;
namespace pg8 {
#define PG8_LAS __attribute__((address_space(3)))
typedef unsigned short bf16_t;
typedef short bf16x8 __attribute__((ext_vector_type(8)));
typedef float f32x4 __attribute__((ext_vector_type(4)));
typedef unsigned u32x4 __attribute__((ext_vector_type(4)));
constexpr int BM = 256, BK = 64, HALF = 128, HTB = HALF * BK * 2  , STAGE_BYTES = 8 * HTB, NXCD = 8, WGM = 8;

__host__ __device__ __forceinline__ int lds_byte(int r, int c) { const int st = (r >> 4) * 2 + (c >> 5), rr = r & 15, cc = c & 31, ob = rr * 64 + cc * 2; return st * 1024 + (ob ^ (((ob >> 9) & 1) << 5)); }
__host__ __device__ __forceinline__ void stage_rc(int b, int& R, int& C) { const int st = b / 1024, sb = b % 1024, swz = sb ^ (((sb >> 9) & 1) << 5); R = (st >> 1) * 16 + swz / 64; C = (st & 1) * 32 + (swz % 64) / 2; }
__host__ __device__ __forceinline__ int perm32(int rho) { const int n = rho >> 4, i = rho & 15; return 8 * (i >> 2) + 4 * n + (i & 3); }

struct Unit { int pm, pn; };
struct Gemm { const bf16_t* A; const bf16_t* Bt; int M, N, K; };

struct StaticOrder {
    int nM, nN, nwg, G, c;
    __host__ __device__ void init(int M, int N, int G_, int c_) { nM = M / BM; nN = N / BM; nwg = nM * nN; G = G_; c = c_; }
    __host__ __device__ bool next(int i, Unit& u) const {
        const long L = (long)i * G + c; if (L >= nwg) return false;
        int wgid = (int)L; { const int q = nwg / NXCD, r = nwg % NXCD, xcd = wgid % NXCD, off = wgid / NXCD; wgid = (xcd < r ? xcd * (q + 1) : r * (q + 1) + (xcd - r) * q) + off; }
        const int nig = WGM * nN, gid = wgid / nig, fm = gid * WGM, gsz = (nM - fm) < WGM ? (nM - fm) : WGM;
        u.pm = fm + ((wgid % nig) % gsz); u.pn = (wgid % nig) / gsz; return true;
    }
    __device__ __forceinline__ void a_ready(const Unit&) const {}
    __device__ __forceinline__ void done(const Unit&) const {}
};


__device__ __forceinline__ unsigned cvt_pk_bf16(float lo, float hi) { unsigned r; asm volatile("v_cvt_pk_bf16_f32 %0, %1, %2" : "=v"(r) : "v"(lo), "v"(hi)); return r; }

struct EpiF32 {
    static constexpr bool PERM = false, AFTER_DRAIN = false;
    float* C; int ldc;
    __device__ __forceinline__ void operator()(const f32x4 (&acc)[2][2][4][2], const Unit& u, int wr, int wc, int fr, int fq) const {
        const int row0 = u.pm * BM + wr * 64 + fr, col0 = u.pn * BM + wc * 32 + 4 * fq;
#pragma unroll
        for (int ai = 0; ai < 2; ++ai)
#pragma unroll
            for (int m = 0; m < 4; ++m) { float* rowp = C + (size_t)(row0 + ai * HALF + m * 16) * ldc + col0;
#pragma unroll
                for (int bj = 0; bj < 2; ++bj)
#pragma unroll
                    for (int n = 0; n < 2; ++n) *(f32x4*)(rowp + bj * HALF + n * 16) = acc[ai][bj][m][n]; }
    }
    __device__ __forceinline__ void fused(f32x4 (&)[2][2][4][2], const Unit&, int, int, int, int, PG8_LAS unsigned char*, int, int) const {}
};

template <int ACT> struct EpiBf16 {
    static constexpr bool PERM = true, AFTER_DRAIN = false;
    bf16_t* O0; int ld0; int nt0; bf16_t* O1; int ld1;
    __device__ __forceinline__ void operator()(const f32x4 (&acc)[2][2][4][2], const Unit& u, int wr, int wc, int fr, int fq) const {
        const int row0 = u.pm * BM + wr * 64 + fr;
        bf16_t* base; int ldc, colt;
        if (u.pn < nt0) { base = O0; ldc = ld0; colt = u.pn * BM; } else { base = O1; ldc = ld1; colt = (u.pn - nt0) * BM; }
        const int col0 = colt + wc * 32 + 8 * fq;
#pragma unroll
        for (int ai = 0; ai < 2; ++ai)
#pragma unroll
            for (int m = 0; m < 4; ++m) { bf16_t* rowp = base + (size_t)(row0 + ai * HALF + m * 16) * ldc + col0;
#pragma unroll
                for (int bj = 0; bj < 2; ++bj) { f32x4 v0 = acc[ai][bj][m][0], v1 = acc[ai][bj][m][1];
                    if (ACT == 2) {
#pragma unroll
                        for (int e = 0; e < 4; ++e) { float a = v0[e] > 0.f ? v0[e] : 0.f; v0[e] = a * a; float b = v1[e] > 0.f ? v1[e] : 0.f; v1[e] = b * b; } }
                    u32x4 w; w.x = cvt_pk_bf16(v0[0], v0[1]); w.y = cvt_pk_bf16(v0[2], v0[3]); w.z = cvt_pk_bf16(v1[0], v1[1]); w.w = cvt_pk_bf16(v1[2], v1[3]);
                    *(u32x4*)(rowp + bj * HALF) = w; } }
    }
    __device__ __forceinline__ void fused(f32x4 (&)[2][2][4][2], const Unit&, int, int, int, int, PG8_LAS unsigned char*, int, int) const {}
};

template <class Epi, class Sched, bool ALIGN_EPI = false, bool SP2 = false>
__device__ __forceinline__ void gemm_phase(PG8_LAS unsigned char* lds, const Gemm g, const Sched& S, const Epi& E) {
    int tid_o = threadIdx.x; asm volatile("" : "+v"(tid_o));
    const int tid = tid_o, wid = __builtin_amdgcn_readfirstlane(tid >> 6), lane = tid & 63, wr = wid >> 2, wc = wid & 3, fr = lane & 15, fq = lane >> 4;
    const int K = g.K, nt = K / BK;
    unsigned voffA[2], voffB[2];
#pragma unroll
    for (int i = 0; i < 2; ++i) { int R, C; stage_rc(tid * 16 + i * 8192, R, C); const int Rb = Epi::PERM ? ((R & ~31) + perm32(R & 31)) : R;
        voffA[i] = (unsigned)(R * K + C) * 2u; voffB[i] = (unsigned)(Rb * K + C) * 2u; }
    const size_t kstep = (size_t)(BK * 2);
    const size_t hstep = (size_t)HALF * K * 2;
    const size_t tstep = 2 * hstep;
    const unsigned ldsw = (unsigned)wid * 1024u;
    const int aoff = lds_byte(wr * 64 + fr, fq * 8), boff = lds_byte(wc * 32 + fr, fq * 8);
#define PG8_SA(b, h) (((b) * 2 + (h)) * HTB)
#define PG8_SB(b, h) ((4 + (b) * 2 + (h)) * HTB)
#define PG8_STAGE(bufoff, gbase, voff) do { _Pragma("unroll") for (int _i = 0; _i < 2; ++_i) \
        __builtin_amdgcn_global_load_lds((const unsigned*)((const char*)(gbase) + (voff)[_i]), (PG8_LAS unsigned*)(lds + (bufoff) + ldsw + _i * 8192), 16, 0, 0); } while (0)
#define PG8_LDA(dst, b, h) do { _Pragma("unroll") for (int m = 0; m < 4; ++m) _Pragma("unroll") for (int k = 0; k < 2; ++k) dst[m][k] = *(const PG8_LAS bf16x8*)(lds + PG8_SA(b, h) + aoff + m * 2048 + k * 1024); } while (0)
#define PG8_LDB(dst, b, h) do { _Pragma("unroll") for (int n = 0; n < 2; ++n) _Pragma("unroll") for (int k = 0; k < 2; ++k) dst[n][k] = *(const PG8_LAS bf16x8*)(lds + PG8_SB(b, h) + boff + n * 2048 + k * 1024); } while (0)
#define PG8_MMA(ai, bj, At, Bt) do { __builtin_amdgcn_s_setprio(1); _Pragma("unroll") for (int m = 0; m < 4; ++m) _Pragma("unroll") for (int n = 0; n < 2; ++n) _Pragma("unroll") for (int k = 0; k < 2; ++k) \
        acc[ai][bj][m][n] = __builtin_amdgcn_mfma_f32_16x16x32_bf16(Bt[n][k], At[m][k], acc[ai][bj][m][n], 0, 0, 0); __builtin_amdgcn_s_setprio(0); } while (0)
#define PG8_WAIT_V(n) asm volatile("s_waitcnt vmcnt(" #n ")" ::: "memory")
#define PG8_WAIT_L(n) asm volatile("s_waitcnt lgkmcnt(" #n ")" ::: "memory")
#define PG8_BAR __builtin_amdgcn_s_barrier()
#define PG8_SCHED __builtin_amdgcn_sched_barrier(0)
    Unit cur, nxt; int ui = 0;
    if (!S.next(0, cur)) return;
    f32x4 acc[2][2][4][2];
#pragma unroll
    for (int a = 0; a < 2; ++a)
#pragma unroll
        for (int b = 0; b < 2; ++b)
#pragma unroll
            for (int m = 0; m < 4; ++m)
#pragma unroll
                for (int n = 0; n < 2; ++n) acc[a][b][m][n] = (f32x4){0.f, 0.f, 0.f, 0.f};
    bf16x8 At[4][2], B0[2][2], B1[2][2];
    const char* cA = (const char*)g.A + (size_t)cur.pm * tstep; const char* cB = (const char*)g.Bt + (size_t)cur.pn * tstep;
    S.a_ready(cur);
    if constexpr (SP2) {
        PG8_STAGE(PG8_SB(0, 0), cB, voffB); PG8_STAGE(PG8_SB(0, 1), cB + hstep, voffB); PG8_STAGE(PG8_SA(0, 0), cA, voffA); PG8_STAGE(PG8_SA(0, 1), cA + hstep, voffA);
        if (wr == 1) PG8_BAR;
        PG8_WAIT_V(2); PG8_BAR;
        PG8_STAGE(PG8_SB(1, 0), cB + kstep, voffB); PG8_STAGE(PG8_SA(1, 0), cA + kstep, voffA); PG8_STAGE(PG8_SB(1, 1), cB + hstep + kstep, voffB);
        PG8_WAIT_V(6); PG8_BAR;
    } else {
        PG8_STAGE(PG8_SB(0, 0), cB, voffB); PG8_STAGE(PG8_SA(0, 0), cA, voffA); PG8_STAGE(PG8_SB(0, 1), cB + hstep, voffB); PG8_STAGE(PG8_SA(0, 1), cA + hstep, voffA);
        if (wr == 1) PG8_BAR;
        PG8_WAIT_V(4); PG8_BAR;
        PG8_STAGE(PG8_SB(1, 0), cB + kstep, voffB); PG8_STAGE(PG8_SA(1, 0), cA + kstep, voffA); PG8_STAGE(PG8_SB(1, 1), cB + hstep + kstep, voffB);
        PG8_WAIT_V(6); PG8_BAR;
    }
    for (;;) {
        const bool has_next = S.next(ui + 1, nxt);
        const char* nA = has_next ? (const char*)g.A + (size_t)nxt.pm * tstep : cA; const char* nB = has_next ? (const char*)g.Bt + (size_t)nxt.pn * tstep : cB;
        for (int t = 0; t < nt; t += 2) {
            const bool last = (t == nt - 2);
            const char* a1 = cA + (size_t)(t + 1) * kstep;
            const char* a2 = last ? nA : cA + (size_t)(t + 2) * kstep; const char* b2 = last ? nB : cB + (size_t)(t + 2) * kstep;
            const char* a3 = a2 + kstep; const char* b3 = b2 + kstep;
            if (last && has_next) S.a_ready(nxt);
            if constexpr (SP2) {
            PG8_LDB(B0, 0, 0); PG8_LDB(B1, 0, 1); PG8_SCHED; PG8_LDA(At, 0, 0); PG8_STAGE(PG8_SA(1, 1), a1 + hstep, voffA);
            PG8_WAIT_V(8); PG8_WAIT_L(0); PG8_BAR; PG8_MMA(0, 0, At, B0); PG8_MMA(0, 1, At, B1); PG8_BAR; PG8_SCHED;
            PG8_LDA(At, 0, 1); PG8_STAGE(PG8_SB(0, 0), b2, voffB); PG8_STAGE(PG8_SB(0, 1), b2 + hstep, voffB); PG8_STAGE(PG8_SA(0, 0), a2, voffA);
            PG8_WAIT_V(8); PG8_WAIT_L(0); PG8_BAR; PG8_MMA(1, 0, At, B0); PG8_MMA(1, 1, At, B1); PG8_BAR; PG8_SCHED;
            PG8_LDB(B0, 1, 0); PG8_LDB(B1, 1, 1); PG8_SCHED; PG8_LDA(At, 1, 0); PG8_STAGE(PG8_SA(0, 1), a2 + hstep, voffA);
            PG8_WAIT_V(8); PG8_WAIT_L(0); PG8_BAR; PG8_MMA(0, 0, At, B0); PG8_MMA(0, 1, At, B1); PG8_BAR; PG8_SCHED;
            PG8_LDA(At, 1, 1); PG8_STAGE(PG8_SB(1, 0), b3, voffB); PG8_STAGE(PG8_SB(1, 1), b3 + hstep, voffB); PG8_STAGE(PG8_SA(1, 0), a3, voffA);
            PG8_WAIT_V(8); PG8_WAIT_L(0); PG8_BAR; PG8_MMA(1, 0, At, B0); PG8_MMA(1, 1, At, B1); PG8_BAR; PG8_SCHED;
            } else {
            PG8_LDB(B0, 0, 0); PG8_SCHED; PG8_LDA(At, 0, 0); PG8_STAGE(PG8_SA(1, 1), a1 + hstep, voffA);
            PG8_WAIT_L(8); PG8_BAR; PG8_WAIT_L(0); PG8_MMA(0, 0, At, B0); PG8_BAR; PG8_SCHED;
            PG8_LDB(B1, 0, 1); PG8_STAGE(PG8_SB(0, 0), b2, voffB);
            PG8_BAR; PG8_WAIT_L(0); PG8_MMA(0, 1, At, B1); PG8_BAR;
            PG8_LDA(At, 0, 1); PG8_STAGE(PG8_SA(0, 0), a2, voffA);
            PG8_BAR; PG8_WAIT_L(0); PG8_MMA(1, 0, At, B0); PG8_BAR; PG8_SCHED;
            PG8_STAGE(PG8_SB(0, 1), b2 + hstep, voffB);
            PG8_WAIT_V(6); PG8_BAR; PG8_MMA(1, 1, At, B1); PG8_BAR;
            PG8_LDB(B0, 1, 0); PG8_SCHED; PG8_LDA(At, 1, 0); PG8_STAGE(PG8_SA(0, 1), a2 + hstep, voffA);
            PG8_WAIT_L(8); PG8_BAR; PG8_WAIT_L(0); PG8_MMA(0, 0, At, B0); PG8_BAR; PG8_SCHED;
            PG8_LDB(B1, 1, 1); PG8_STAGE(PG8_SB(1, 0), b3, voffB);
            PG8_BAR; PG8_WAIT_L(0); PG8_MMA(0, 1, At, B1); PG8_BAR;
            PG8_LDA(At, 1, 1); PG8_STAGE(PG8_SA(1, 0), a3, voffA);
            PG8_BAR; PG8_WAIT_L(0); PG8_MMA(1, 0, At, B0); PG8_BAR; PG8_SCHED;
            PG8_STAGE(PG8_SB(1, 1), b3 + hstep, voffB);
            PG8_WAIT_V(6); PG8_BAR; PG8_MMA(1, 1, At, B1); PG8_BAR;
            }
        }
        if constexpr (ALIGN_EPI) { if (wr == 0) PG8_BAR; }
        if constexpr (!Epi::AFTER_DRAIN) { E(acc, cur, wr, wc, fr, fq); S.done(cur); }
        if (!has_next) break;
#pragma unroll
        for (int a = 0; a < 2; ++a)
#pragma unroll
            for (int b = 0; b < 2; ++b)
#pragma unroll
                for (int m = 0; m < 4; ++m)
#pragma unroll
                    for (int n = 0; n < 2; ++n) acc[a][b][m][n] = (f32x4){0.f, 0.f, 0.f, 0.f};
        cur = nxt; cA = nA; cB = nB; ++ui;
        if constexpr (ALIGN_EPI) { if (wr == 1) PG8_BAR; }
    }
    PG8_WAIT_V(0);
    if constexpr (!ALIGN_EPI) { if (wr == 0) PG8_BAR; }
    PG8_BAR;
    if constexpr (Epi::AFTER_DRAIN) { E.fused(acc, cur, wr, wc, fr, fq, lds, wid, lane); S.done(cur); }
#undef PG8_SA
#undef PG8_SB
#undef PG8_STAGE
#undef PG8_LDA
#undef PG8_LDB
#undef PG8_MMA
#undef PG8_WAIT_V
#undef PG8_WAIT_L
#undef PG8_BAR
#undef PG8_SCHED
}
}

#define GAS __attribute__((address_space(1)))
#define LAS __attribute__((address_space(3)))
typedef unsigned short bf16;
typedef unsigned v4u __attribute__((ext_vector_type(4)));
typedef unsigned v2u __attribute__((ext_vector_type(2)));
typedef float f32x4 __attribute__((ext_vector_type(4)));
#define LDS_WAIT() asm volatile("s_waitcnt lgkmcnt(0)" ::: "memory")

#ifndef MK_N_LAUNCHES
#define MK_N_LAUNCHES 0
#endif
#ifndef MK_CG_BARRIER
#define MK_CG_BARRIER 1
#endif

constexpr int D = 1024, NTOK = 16384, NPR = 8192, TP = 256, TS = 2048, PAST = 512, SKV = 2560, FF = 4096, DEPTH = 4;
constexpr int NQKV = 2304, NRKV = 3584, KRKV = 2048;
constexpr int NWAVES = 8;
constexpr size_t O_X = 0, O_KG = 16777216, O_VG = 18874368, O_KD = 20971520, O_VD = 29360128, O_ST = 37748736, OUT_TOTAL = 46137344;
constexpr size_t MiB = 1u << 20;
constexpr size_t WS_CTL = 0, CTL_ZERO_BYTES = 1 * MiB;
constexpr size_t WS_MOD = 65536;
constexpr size_t WS_ROPE = 1 * MiB;
constexpr size_t WS_INV = 2 * MiB;
constexpr size_t WS_W = 4 * MiB;
constexpr size_t W_W1T = WS_W, W_W2T = WS_W + 8 * MiB, W_MIX = WS_W + 16 * MiB;
constexpr size_t W_WINT = W_MIX, W_WOUTT = W_MIX + 6 * MiB;
constexpr size_t W_BT1 = W_MIX, W_WOT = W_MIX + 14 * MiB;
constexpr size_t AR = 40 * MiB;
constexpr size_t A_H = AR;
constexpr size_t A_QKVRAW = AR + 32 * MiB;
constexpr size_t A_DT = AR + 32 * MiB;
constexpr size_t A_M = AR + 96 * MiB;
constexpr size_t A_QA = AR + 176 * MiB, A_QB = AR + 192 * MiB, A_KAP = AR + 208 * MiB, A_VAP = AR + 210 * MiB, A_KBP = AR + 212 * MiB, A_VBP = AR + 220 * MiB;
constexpr size_t A_KAS = AR + 228 * MiB, A_VAS = AR + 231 * MiB, A_KBS = AR + 234 * MiB, A_VBS = AR + 244 * MiB;
constexpr size_t A_HID = AR + 32 * MiB;
constexpr size_t A_F = AR + 160 * MiB;
constexpr size_t A_A2 = AR + 32 * MiB;
constexpr size_t A_Y = AR + 32 * MiB;
constexpr size_t A_RKV = AR + 96 * MiB;
constexpr size_t A_L1 = AR + 192 * MiB;
constexpr size_t A_A0 = AR + 208 * MiB, A_A1 = AR + 240 * MiB, A_EW0 = AR + 272 * MiB, A_EW1 = AR + 304 * MiB;
constexpr size_t WS_END = AR + 336 * MiB;
constexpr int CW_BAR = 4096;

constexpr int RING_OFF = 0, RING_BYTES = 131072;
constexpr int LDSCTL_OFF = RING_BYTES, MISC_OFF = LDSCTL_OFF + 320;
constexpr int LDS_BYTES = 147456;

__device__ __forceinline__ unsigned f2bf(float f) { unsigned u = __builtin_bit_cast(unsigned, f); return (u + 0x7fffu + ((u >> 16) & 1u)) >> 16; }
__device__ __forceinline__ unsigned pk2(float lo, float hi) { return f2bf(lo) | (f2bf(hi) << 16); }
__device__ __forceinline__ float bf2f(unsigned short h) { return __builtin_bit_cast(float, (unsigned)h << 16); }
__device__ __forceinline__ float bflo(unsigned w) { return __builtin_bit_cast(float, w << 16); }
__device__ __forceinline__ float bfhi(unsigned w) { return __builtin_bit_cast(float, w & 0xffff0000u); }
__device__ __forceinline__ float wave_sum(float v) {
#pragma unroll
    for (int o = 1; o < 64; o <<= 1) v += __shfl_xor(v, o);
    return v;
}
__device__ __forceinline__ float sigmoidf_(float x) { return 1.0f / (1.0f + __expf(-x)); }
__device__ __forceinline__ float rdl(float x, int l) { return __builtin_bit_cast(float, __builtin_amdgcn_readlane(__builtin_bit_cast(int, x), l)); }

#define XB_TMO      128
#define XB_XCNT(j)  (256  + 64 * (j))
#define XB_XSUB(j)  (1280 + 64 * (j))
#define XB_XGEN(j)  (2304 + 64 * (j))
#define XB_TOP      3328
#define XB_TOPGEN   3392
#define XCD_BAR_WORDS 3456
#define XB_SPIN_CAP (1u << 18)

__device__ __forceinline__ unsigned xb_ld(unsigned* p)              { return __hip_atomic_load(p, __ATOMIC_RELAXED, __HIP_MEMORY_SCOPE_AGENT); }
__device__ __forceinline__ unsigned xb_add(unsigned* p, unsigned v) { return __hip_atomic_fetch_add(p, v, __ATOMIC_RELAXED, __HIP_MEMORY_SCOPE_AGENT); }
__device__ __forceinline__ unsigned xb_xcc_id() { return (unsigned)__builtin_amdgcn_s_getreg((3 << 11) | 20) & 0xFu; }
#define XB_SPIN(cond, bar) do { unsigned _sp = 0; while (cond) { __builtin_amdgcn_s_sleep(1); \
    if ((++_sp & 255u) == 0u) { if (xb_ld(&(bar)[XB_TMO])) break; if (_sp > XB_SPIN_CAP) { atomicAdd(&(bar)[XB_TMO], 1u); break; } } } } while (0)

struct XcdBarrier {
    unsigned* bar; unsigned x;
    volatile LAS unsigned* st;
};

__device__ __forceinline__ XcdBarrier xcd_barrier_post(unsigned* bar, volatile LAS unsigned* st) {
    XcdBarrier b; b.bar = bar; b.x = xb_xcc_id(); b.st = st;
    if (threadIdx.x == 0) (void)xb_add(&bar[XB_XCNT(b.x)], 1u);
    return b;
}
__device__ __forceinline__ void xcd_barrier_complete(unsigned* bar, unsigned x, unsigned& nloc, unsigned& nx) {
    const unsigned G = gridDim.x * gridDim.y * gridDim.z;
    unsigned sum, cnt, mine, sp = 0u;
    for (;;) {
        sum = 0u; cnt = 0u; mine = 0u;
#pragma unroll
        for (unsigned j = 0; j < 16; ++j) { const unsigned c = xb_ld(&bar[XB_XCNT(j)]); sum += c; cnt += (c > 0u) ? 1u : 0u; mine = (j == x) ? c : mine; }
        if (sum == G) break;
        __builtin_amdgcn_s_sleep(1);
        if ((++sp & 255u) == 0u) { if (xb_ld(&bar[XB_TMO])) break; if (sp > XB_SPIN_CAP) { atomicAdd(&bar[XB_TMO], 1u); break; } }
    }
    nloc = mine > 0u ? mine : 1u; nx = cnt > 0u ? cnt : 1u;
}

__device__ __forceinline__ void xcd_barrier(const XcdBarrier& b) {
    asm volatile("s_waitcnt vmcnt(0)" ::: "memory");
    __syncthreads();
    if (threadIdx.x == 0) {
        unsigned* bar = b.bar;
        __builtin_amdgcn_s_waitcnt(0);
        unsigned nloc = b.st[0], nx = b.st[1];
        if (nloc == 0u) { xcd_barrier_complete(bar, b.x, nloc, nx); b.st[0] = nloc; b.st[1] = nx; }
        const unsigned old = xb_add(&bar[XB_XSUB(b.x)], 1u);
        const unsigned gen = old / nloc;
        if (old + 1u == (gen + 1u) * nloc) {
            __builtin_amdgcn_fence(__ATOMIC_RELEASE, "agent");
            asm volatile("s_waitcnt vmcnt(0)" ::: "memory");
            const unsigned og = xb_add(&bar[XB_TOP], 1u);
            const unsigned tg = og / nx;
            if (og + 1u == (tg + 1u) * nx) xb_add(&bar[XB_TOPGEN], 1u);
            else XB_SPIN(xb_ld(&bar[XB_TOPGEN]) == tg, bar);
            __builtin_amdgcn_fence(__ATOMIC_ACQUIRE, "agent");
            xb_add(&bar[XB_XGEN(b.x)], 1u);
            asm volatile("s_waitcnt vmcnt(0)" ::: "memory");
        } else {
            XB_SPIN(xb_ld(&bar[XB_XGEN(b.x)]) == gen, bar);
            __builtin_amdgcn_fence(__ATOMIC_ACQUIRE, "agent");
            asm volatile("s_waitcnt vmcnt(0)" ::: "memory");
        }
    }
    __syncthreads();
}

struct Args { const float* in[32]; float* out; unsigned char* ws; int ph_lo, ph_hi; };
struct Ids { int tid, lane, wave, gw, ngw, z; };

__device__ __forceinline__ int cond_of(int m) { return m < NPR ? 4 : ((m - NPR) >> 11); }
__device__ __forceinline__ const float* mod_ptr_(const Args& a, const Ids& id, int cond, int layer) { return (const float*)(a.ws + id.z + WS_MOD) + (size_t)(cond * 4 + layer) * 6144; }

__device__ __forceinline__ void tr_item(const float* W, int ldw, int col0, const float* scale, bf16* WT, int ldt, int drow0, int dcol0, LAS float* scr, int kb, int nb, int lane) {
    const int k0 = 64 * kb, n0 = 32 * nb;
#pragma unroll 8
    for (int i = 0; i < 32; ++i) { const int kk = 2 * i + (lane >> 5); float v = W[(size_t)(k0 + kk) * ldw + col0 + n0 + (lane & 31)]; if (scale) v *= scale[k0 + kk]; scr[kk * 33 + (lane & 31)] = v; }
    LDS_WAIT(); asm volatile("" ::: "memory");
    const int c = lane & 7;
#pragma unroll
    for (int j = 0; j < 4; ++j) { const int n = (lane >> 3) + 8 * j; const LAS float* s = scr + (8 * c) * 33 + n;
        v4u o; o.x = pk2(s[0 * 33], s[1 * 33]); o.y = pk2(s[2 * 33], s[3 * 33]); o.z = pk2(s[4 * 33], s[5 * 33]); o.w = pk2(s[6 * 33], s[7 * 33]);
        *(v4u*)(WT + (size_t)(drow0 + n0 + n) * ldt + dcol0 + k0 + 8 * c) = o; }
    LDS_WAIT(); asm volatile("" ::: "memory");
}
__device__ __forceinline__ bool tr_matrix(int& r, const float* W, int K, int N, bf16* WT, LAS float* scr, int lane) {
    const int nblk = N / 32, items = (K / 64) * nblk;
    if (r < items) { tr_item(W, N, 0, nullptr, WT, K, 0, 0, scr, r / nblk, r % nblk, lane); return true; }
    r -= items; return false;
}
__device__ __forceinline__ bool tr_rwproj(int& r, const float* W, int ncols, const float* mu, bf16* BT1, int drow0, LAS float* scr, int lane) {
    const int nblk = ncols / 32, items = 16 * nblk * 2;
    if (r < items) { const int half = r / (16 * nblk), q = r % (16 * nblk); tr_item(W, ncols, 0, half ? mu : nullptr, BT1, KRKV, drow0, half * 1024, scr, q / nblk, q % nblk, lane); return true; }
    r -= items; return false;
}
__device__ __forceinline__ void conv_weights(const Args& a, const Ids& id, LAS unsigned char* lds, int layer) {
    LAS float* scr = (LAS float*)(lds + id.wave * 16384);
    const int j = layer >> 1;
    bf16* W1T = (bf16*)(a.ws + id.z + W_W1T); bf16* W2T = (bf16*)(a.ws + id.z + W_W2T);
    const float* mw1 = a.in[30 + id.z] + (size_t)layer * D * FF; const float* mw2 = a.in[31 + id.z] + (size_t)layer * D * FF;
    if ((layer & 1) == 0) {
        bf16* WINT = (bf16*)(a.ws + id.z + W_WINT); bf16* WOUTT = (bf16*)(a.ws + id.z + W_WOUTT);
        const float* win = a.in[12 + id.z] + (size_t)j * D * NQKV; const float* wout = a.in[13 + id.z] + (size_t)j * D * D;
        const int total = 2048 + 2048 + 1152 + 512;
        for (int it = id.gw; it < total; it += id.ngw) {
            int r = it;
            if (tr_matrix(r, mw1, D, FF, W1T, scr, id.lane)) continue;
            if (tr_matrix(r, mw2, FF, D, W2T, scr, id.lane)) continue;
            if (tr_matrix(r, win, D, NQKV, WINT, scr, id.lane)) continue;
            tr_matrix(r, wout, D, D, WOUTT, scr, id.lane);
        }
    } else {
        bf16* BT1 = (bf16*)(a.ws + id.z + W_BT1); bf16* WOT = (bf16*)(a.ws + id.z + W_WOT);
        const float* mu = a.in[17 + id.z] + (size_t)j * 6 * D;
        const float* wrkv = a.in[18 + id.z] + (size_t)j * 3 * D * D;
        const float* w1 = a.in[21 + id.z] + (size_t)j * 2 * D * 64; const float* a1 = a.in[24 + id.z] + (size_t)j * 2 * D * 64; const float* g1 = a.in[26 + id.z] + (size_t)j * D * 128;
        const float* wo = a.in[19 + id.z] + (size_t)j * D * D;
        const int total = 2048 + 2048 + 3072 + 256 + 128 + 512 + 128;
        for (int it = id.gw; it < total; it += id.ngw) {
            int r = it;
            if (tr_matrix(r, mw1, D, FF, W1T, scr, id.lane)) continue;
            if (tr_matrix(r, mw2, FF, D, W2T, scr, id.lane)) continue;
            if (tr_rwproj(r, wrkv, 1024, mu + 0 * D, BT1, 0, scr, id.lane)) continue;
            if (tr_rwproj(r, wrkv + (size_t)D * D, 1024, mu + 2 * D, BT1, 1024, scr, id.lane)) continue;
            if (tr_rwproj(r, wrkv + (size_t)2 * D * D, 1024, mu + 3 * D, BT1, 2048, scr, id.lane)) continue;
            if (tr_rwproj(r, w1, 64, mu + 1 * D, BT1, 3072, scr, id.lane)) continue;
            if (tr_rwproj(r, w1 + (size_t)D * 64, 64, mu + 1 * D, BT1, 3136, scr, id.lane)) continue;
            if (tr_rwproj(r, a1, 64, mu + 4 * D, BT1, 3200, scr, id.lane)) continue;
            if (tr_rwproj(r, a1 + (size_t)D * 64, 64, mu + 4 * D, BT1, 3264, scr, id.lane)) continue;
            if (tr_rwproj(r, g1, 128, mu + 5 * D, BT1, 3328, scr, id.lane)) continue;
            if (tr_matrix(r, wo, D, D, WOT, scr, id.lane)) continue;
            { v4u z = (v4u){0u, 0u, 0u, 0u}; v4u* p = (v4u*)(BT1 + (size_t)(3456 + r) * KRKV);
#pragma unroll
              for (int q = 0; q < 4; ++q) p[id.lane + 64 * q] = z; }
        }
    }
}

struct RowV { f32x4 v[4]; };
__device__ __forceinline__ void ld_row(RowV& r, const float* p, int lane) {
#pragma unroll
    for (int j = 0; j < 4; ++j) r.v[j] = ((const f32x4*)p)[lane + 64 * j];
}
__device__ __forceinline__ void st_row(const RowV& r, float* p, int lane) {
#pragma unroll
    for (int j = 0; j < 4; ++j) ((f32x4*)p)[lane + 64 * j] = r.v[j];
}
__device__ __forceinline__ void st_row_bf16(const RowV& r, bf16* p, int lane) {
#pragma unroll
    for (int j = 0; j < 4; ++j) { v2u w; w.x = pk2(r.v[j][0], r.v[j][1]); w.y = pk2(r.v[j][2], r.v[j][3]); ((v2u*)p)[lane + 64 * j] = w; }
}
__device__ __forceinline__ float row_rinv(const RowV& r) {
    float s = 0.f;
#pragma unroll
    for (int j = 0; j < 4; ++j) s += (r.v[j][0] * r.v[j][0] + r.v[j][1] * r.v[j][1]) + (r.v[j][2] * r.v[j][2] + r.v[j][3] * r.v[j][3]);
    s = wave_sum(s);
    return 1.0f / sqrtf(s * (1.0f / 1024.0f) + 1e-6f);
}
__device__ __forceinline__ void norm_mod(RowV& h, const RowV& x, const float* g, const float* sc, const float* sh, int lane) {
    const float ri = row_rinv(x);
#pragma unroll
    for (int j = 0; j < 4; ++j) { const f32x4 gv = ((const f32x4*)g)[lane + 64 * j], scv = ((const f32x4*)sc)[lane + 64 * j], shv = ((const f32x4*)sh)[lane + 64 * j];
        h.v[j] = (x.v[j] * ri) * gv * (scv + 1.0f) + shv; }
}
__device__ __forceinline__ void resid_add(RowV& x, const RowV& m, const float* g, const float* gt, int lane) {
    const float ri = row_rinv(m);
#pragma unroll
    for (int j = 0; j < 4; ++j) { const f32x4 gv = ((const f32x4*)g)[lane + 64 * j], gtv = ((const f32x4*)gt)[lane + 64 * j];
        x.v[j] = x.v[j] + gtv * ((m.v[j] * ri) * gv); }
}

__device__ __forceinline__ float rope_inv(int jj) {
    const float t[16] = {1.0f, 0.5623413324356079f, 0.3162277638912201f, 0.17782793939113617f, 0.10000000149011612f, 0.05623412877321243f, 0.03162277862429619f, 0.017782794311642647f,
                         0.009999999776482582f, 0.005623413249850273f, 0.003162277862429619f, 0.0017782794311642647f, 0.0010000000474974513f, 0.000562341301701963f, 0.0003162277862429619f, 0.00017782794020604342f};
    float r = t[0];
#pragma unroll
    for (int i = 1; i < 16; ++i) r = (jj == i) ? t[i] : r;
    return r;
}
__device__ __forceinline__ void ph_prologue(const Args& a, const Ids& id, LAS unsigned char* lds) {
    float* MOD = (float*)(a.ws + id.z + WS_MOD);
    for (int it = id.gw; it < 4 * 96; it += id.ngw) {
        const int i = it / 96, n = (it % 96) * 64 + id.lane;
        float acc[5];
#pragma unroll
        for (int c = 0; c < 5; ++c) acc[c] = 0.f;
        const float* W = a.in[9 + id.z] + (size_t)i * 1024 * 6144 + n;
#pragma unroll 1
        for (int k0 = 0; k0 < 1024; k0 += 64) {
            float sv[5];
#pragma unroll
            for (int c = 0; c < 5; ++c) { const float x = (c < 4) ? a.in[2 + id.z][c * 1024 + k0 + id.lane] : a.in[8 + id.z][k0 + id.lane]; sv[c] = x / (1.0f + __expf(-x)); }
#pragma unroll 8
            for (int kk = 0; kk < 64; ++kk) { const float w = W[(size_t)(k0 + kk) * 6144];
#pragma unroll
                for (int c = 0; c < 5; ++c) acc[c] += w * __shfl(sv[c], kk); }
        }
        const float bias = a.in[10 + id.z][i * 6144 + n];
#pragma unroll
        for (int c = 0; c < 5; ++c) MOD[(size_t)(c * 4 + i) * 6144 + n] = acc[c] + bias;
    }
    { float* RC = (float*)(a.ws + id.z + WS_ROPE); float* RS = RC + 2048 * 64;
      for (int e = id.gw * 64 + id.lane; e < 2048 * 64; e += id.ngw * 64) { const int t = e >> 6, d = e & 63; const int pos = (d < 32) ? (t >> 6) : (t & 63);
          const float ang = (float)pos * rope_inv(d & 15); RC[e] = __cosf(ang); RS[e] = __sinf(ang); } }
    { const f32x4* s0 = (const f32x4*)a.in[0 + id.z]; const f32x4* s1 = (const f32x4*)a.in[1 + id.z]; f32x4* dst = (f32x4*)(a.out + id.z + O_X); const int n4 = NPR * D / 4;
      for (int e = id.gw * 64 + id.lane; e < n4; e += id.ngw * 64) { dst[e] = s0[e]; dst[n4 + e] = s1[e]; } }
    conv_weights(a, id, lds, 0);
}

__device__ __forceinline__ void ph_norm0(const Args& a, const Ids& id) {
    bf16* H = (bf16*)(a.ws + id.z + A_H); const float* g0 = a.in[11 + id.z] + (size_t)(0 * 4 + 0) * D;
    for (int m = id.gw; m < NTOK; m += id.ngw) { RowV x, h; ld_row(x, a.out + id.z + O_X + (size_t)m * D, id.lane); const float* md = mod_ptr_(a, id, cond_of(m), 0);
        norm_mod(h, x, g0, md + 1024, md + 0, id.lane); st_row_bf16(h, H + (size_t)m * D, id.lane); }
}
__device__ __forceinline__ void ph_resid_norm(const Args& a, const Ids& id, int layer) {
    bf16* H = (bf16*)(a.ws + id.z + A_H); const float* M = (const float*)(a.ws + id.z + A_M); const float* g1 = a.in[11 + id.z] + (size_t)(layer * 4 + 1) * D; const float* g2 = a.in[11 + id.z] + (size_t)(layer * 4 + 2) * D;
    for (int m = id.gw; m < NTOK; m += id.ngw) { RowV x, mm, h; float* xp = a.out + id.z + O_X + (size_t)m * D; ld_row(x, xp, id.lane); ld_row(mm, M + (size_t)m * D, id.lane);
        const float* md = mod_ptr_(a, id, cond_of(m), layer);
        resid_add(x, mm, g1, md + 2048, id.lane); st_row(x, xp, id.lane);
        norm_mod(h, x, g2, md + 4096, md + 3072, id.lane); st_row_bf16(h, H + (size_t)m * D, id.lane); }
}
__device__ __forceinline__ void ph_resid_end(const Args& a, const Ids& id, LAS unsigned char* lds, int layer) {
    bf16* H = (bf16*)(a.ws + id.z + A_H); const float* F = (const float*)(a.ws + id.z + A_F); const float* g3 = a.in[11 + id.z] + (size_t)(layer * 4 + 3) * D;
    const bool next_attn = (layer + 1 < DEPTH) && (((layer + 1) & 1) == 0);
    const float* g0n = a.in[11 + id.z] + (size_t)((layer + 1) * 4 + 0) * D;
    for (int m = id.gw; m < NTOK; m += id.ngw) { RowV x, ff; float* xp = a.out + id.z + O_X + (size_t)m * D; ld_row(x, xp, id.lane); ld_row(ff, F + (size_t)m * D, id.lane);
        const float* md = mod_ptr_(a, id, cond_of(m), layer);
        resid_add(x, ff, g3, md + 5120, id.lane); st_row(x, xp, id.lane);
        if (next_attn) { RowV h; const float* mdn = mod_ptr_(a, id, cond_of(m), layer + 1); norm_mod(h, x, g0n, mdn + 1024, mdn + 0, id.lane); st_row_bf16(h, H + (size_t)m * D, id.lane); } }
    if (layer + 1 < DEPTH) conv_weights(a, id, lds, layer + 1);
}
__device__ __forceinline__ void ph_rw_mix(const Args& a, const Ids& id, int layer) {
    bf16* A2 = (bf16*)(a.ws + id.z + A_A2); const float* g0 = a.in[11 + id.z] + (size_t)(layer * 4 + 0) * D;
    for (int m = id.gw; m < NTOK; m += id.ngw) {
        const int t = (m < NPR) ? (m & (TP - 1)) : ((m - NPR) & (TS - 1)); const int T = (m < NPR) ? TP : TS;
        const float* md = mod_ptr_(a, id, cond_of(m), layer); const float* xp = a.out + id.z + O_X + (size_t)m * D;
        RowV x, hc, hs, xx; ld_row(x, xp, id.lane); norm_mod(hc, x, g0, md + 1024, md + 0, id.lane);
#pragma unroll
        for (int j = 0; j < 4; ++j) hs.v[j] = (f32x4){0.f, 0.f, 0.f, 0.f};
        if (t > 0) { RowV xn, hn; ld_row(xn, xp - D, id.lane); norm_mod(hn, xn, g0, md + 1024, md + 0, id.lane);
#pragma unroll
            for (int j = 0; j < 4; ++j) hs.v[j] += hn.v[j]; }
        if (t < T - 1) { RowV xn, hn; ld_row(xn, xp + D, id.lane); norm_mod(hn, xn, g0, md + 1024, md + 0, id.lane);
#pragma unroll
            for (int j = 0; j < 4; ++j) hs.v[j] += hn.v[j]; }
#pragma unroll
        for (int j = 0; j < 4; ++j) xx.v[j] = hs.v[j] * 0.5f - hc.v[j];
        st_row_bf16(hc, A2 + (size_t)m * KRKV, id.lane); st_row_bf16(xx, A2 + (size_t)m * KRKV + D, id.lane);
    }
}

__device__ __forceinline__ void ph_att_post(const Args& a, const Ids& id, int layer) {
    const int j = layer >> 1, lane = id.lane;
    const float* RAW = (const float*)(a.ws + id.z + A_QKVRAW);
    bf16 *QA = (bf16*)(a.ws + id.z + A_QA), *QB = (bf16*)(a.ws + id.z + A_QB), *KAP = (bf16*)(a.ws + id.z + A_KAP), *VAP = (bf16*)(a.ws + id.z + A_VAP), *KBP = (bf16*)(a.ws + id.z + A_KBP), *VBP = (bf16*)(a.ws + id.z + A_VBP);
    bf16 *KAS = (bf16*)(a.ws + id.z + A_KAS), *VAS = (bf16*)(a.ws + id.z + A_VAS), *KBS = (bf16*)(a.ws + id.z + A_KBS), *VBS = (bf16*)(a.ws + id.z + A_VBS);
    const float* RC = (const float*)(a.ws + id.z + WS_ROPE); const float* RS = RC + 2048 * 64;
    const float gq = a.in[14 + id.z][j * 128 + lane], gk = a.in[14 + id.z][j * 128 + 64 + lane];
    for (int it = id.gw; it < NTOK + 4 * PAST; it += id.ngw) {
        if (it < NTOK) {
            const int m = it; const bool smp = m >= NPR; const int b = smp ? ((m - NPR) >> 11) : (m >> 8), t = smp ? ((m - NPR) & (TS - 1)) : (m & (TP - 1));
            const float* raw = RAW + (size_t)m * NQKV;
            float cs = 1.f, sn = 0.f; if (smp) { cs = RC[t * 64 + lane]; sn = RS[t * 64 + lane]; }
            const size_t srow = (size_t)(b * SKV + PAST + t);
            const size_t prow = (size_t)((b * 2 + j) * TP + t);
#pragma unroll 1
            for (int ch = 0; ch < 36; ++ch) {
                float v = raw[ch * 64 + lane];
                const bool isq = (ch < 8) || (ch >= 12 && ch < 20), isk = (ch == 8 || ch == 9) || (ch >= 20 && ch < 28);
                if (ch < 10) { const float ss = wave_sum(v * v); v = v * (1.0f / sqrtf(ss * (1.0f / 64.0f) + 1e-6f)) * (ch < 8 ? gq : gk); }
                float vr = v;
                if (smp && (isq || isk)) { const float p = __shfl_xor(v, 16); const float rot = (lane & 16) ? p : -p; vr = v * cs + rot * sn; }
                if (ch < 8) QA[(size_t)m * 512 + ch * 64 + lane] = (bf16)f2bf(vr * 0.125f);
                else if (ch < 10) { const int e = (ch - 8) * 64 + lane; if (!smp) { (a.out + id.z)[O_KG + prow * 128 + e] = v; KAP[(size_t)m * 128 + e] = (bf16)f2bf(v); } else KAS[srow * 128 + e] = (bf16)f2bf(vr); }
                else if (ch < 12) { const int e = (ch - 10) * 64 + lane; if (!smp) { (a.out + id.z)[O_VG + prow * 128 + e] = v; VAP[(size_t)m * 128 + e] = (bf16)f2bf(v); } else VAS[srow * 128 + e] = (bf16)f2bf(v); }
                else if (ch < 20) QB[(size_t)m * 512 + (ch - 12) * 64 + lane] = (bf16)f2bf(vr * 0.125f);
                else if (ch < 28) { const int e = (ch - 20) * 64 + lane; if (!smp) { (a.out + id.z)[O_KD + prow * 512 + e] = v; KBP[(size_t)m * 512 + e] = (bf16)f2bf(v); } else KBS[srow * 512 + e] = (bf16)f2bf(vr); }
                else { const int e = (ch - 28) * 64 + lane; if (!smp) { (a.out + id.z)[O_VD + prow * 512 + e] = v; VBP[(size_t)m * 512 + e] = (bf16)f2bf(v); } else VBS[srow * 512 + e] = (bf16)f2bf(v); }
            }
        } else {
            const int r = it - NTOK, b = r >> 9, pos = r & (PAST - 1);
            const size_t src = (size_t)((b * 2 + j) * PAST + pos), dst = (size_t)(b * SKV + pos);
#pragma unroll
            for (int q = 0; q < 2; ++q) { const int e = lane + 64 * q; KAS[dst * 128 + e] = (bf16)f2bf(a.in[3 + id.z][src * 128 + e]); VAS[dst * 128 + e] = (bf16)f2bf(a.in[4 + id.z][src * 128 + e]); }
#pragma unroll
            for (int q = 0; q < 8; ++q) { const int e = lane + 64 * q; KBS[dst * 512 + e] = (bf16)f2bf(a.in[5 + id.z][src * 512 + e]); VBS[dst * 512 + e] = (bf16)f2bf(a.in[6 + id.z][src * 512 + e]); }
        }
    }
}

__device__ __forceinline__ void ph_attn_simple(const Args& a, const Ids& id) {
    const bf16 *QA = (const bf16*)(a.ws + id.z + A_QA), *QB = (const bf16*)(a.ws + id.z + A_QB), *KAP = (const bf16*)(a.ws + id.z + A_KAP), *VAP = (const bf16*)(a.ws + id.z + A_VAP), *KBP = (const bf16*)(a.ws + id.z + A_KBP), *VBP = (const bf16*)(a.ws + id.z + A_VBP);
    const bf16 *KAS = (const bf16*)(a.ws + id.z + A_KAS), *VAS = (const bf16*)(a.ws + id.z + A_VAS), *KBS = (const bf16*)(a.ws + id.z + A_KBS), *VBS = (const bf16*)(a.ws + id.z + A_VBS);
    bf16* H = (bf16*)(a.ws + id.z + A_H); float* DT = (float*)(a.ws + id.z + A_DT);
    int zoff; asm volatile("v_mov_b32 %0, 0" : "=v"(zoff));
    for (int u = blockIdx.x; u < 64 * 12; u += gridDim.x) {
        const int tb = u / 12, pr = u % 12;
        const int vh = 2 * pr + (id.wave >> 2);
        const int m = tb * 256 + (id.tid & 255);
        const bool smp = tb >= 32; const int b = smp ? ((tb - 32) >> 3) : tb;
        const int S = smp ? SKV : TP;
        const bf16 *qp, *Kb, *Vb; int ldk;
        if (vh < 8) { qp = QA + (size_t)m * 512 + vh * 64; const int kvh = vh >> 2; ldk = 128;
            Kb = (smp ? KAS + (size_t)b * SKV * 128 : KAP + (size_t)b * TP * 128) + kvh * 64; Vb = (smp ? VAS + (size_t)b * SKV * 128 : VAP + (size_t)b * TP * 128) + kvh * 64; }
        else { const int idx = vh - 8, hd = idx >> 2, c = (idx >> 1) & 1, hf = idx & 1; qp = QB + (size_t)m * 512 + (hd * 2 + c) * 64; ldk = 512;
            Kb = (smp ? KBS + (size_t)b * SKV * 512 : KBP + (size_t)b * TP * 512) + (hd * 2 + c) * 64; Vb = (smp ? VBS + (size_t)b * SKV * 512 : VBP + (size_t)b * TP * 512) + hd * 128 + hf * 64; }
        float q[64], o[64];
#pragma unroll
        for (int c8 = 0; c8 < 8; ++c8) { const v4u w = ((const v4u*)qp)[c8];
            q[8 * c8 + 0] = bflo(w.x); q[8 * c8 + 1] = bfhi(w.x); q[8 * c8 + 2] = bflo(w.y); q[8 * c8 + 3] = bfhi(w.y); q[8 * c8 + 4] = bflo(w.z); q[8 * c8 + 5] = bfhi(w.z); q[8 * c8 + 6] = bflo(w.w); q[8 * c8 + 7] = bfhi(w.w); }
#pragma unroll
        for (int d = 0; d < 64; ++d) o[d] = 0.f;
        float mrun = -1e30f, l = 0.f;
#pragma unroll 1
        for (int key = 0; key < S; ++key) {
            const v4u* kp = (const v4u*)(Kb + (size_t)key * ldk + zoff); const v4u* vp = (const v4u*)(Vb + (size_t)key * ldk + zoff);
            float s = 0.f;
#pragma unroll
            for (int c8 = 0; c8 < 8; ++c8) { const v4u w = kp[c8];
                s += q[8 * c8 + 0] * bflo(w.x) + q[8 * c8 + 1] * bfhi(w.x) + q[8 * c8 + 2] * bflo(w.y) + q[8 * c8 + 3] * bfhi(w.y) + q[8 * c8 + 4] * bflo(w.z) + q[8 * c8 + 5] * bfhi(w.z) + q[8 * c8 + 6] * bflo(w.w) + q[8 * c8 + 7] * bfhi(w.w); }
            s *= 1.4426950408889634f;
            const float mn = fmaxf(mrun, s); const float al = exp2f(mrun - mn), p = exp2f(s - mn); mrun = mn; l = l * al + p;
#pragma unroll
            for (int c8 = 0; c8 < 8; ++c8) { const v4u w = vp[c8];
                o[8 * c8 + 0] = o[8 * c8 + 0] * al + p * bflo(w.x); o[8 * c8 + 1] = o[8 * c8 + 1] * al + p * bfhi(w.x); o[8 * c8 + 2] = o[8 * c8 + 2] * al + p * bflo(w.y); o[8 * c8 + 3] = o[8 * c8 + 3] * al + p * bfhi(w.y);
                o[8 * c8 + 4] = o[8 * c8 + 4] * al + p * bflo(w.z); o[8 * c8 + 5] = o[8 * c8 + 5] * al + p * bfhi(w.z); o[8 * c8 + 6] = o[8 * c8 + 6] * al + p * bflo(w.w); o[8 * c8 + 7] = o[8 * c8 + 7] * al + p * bfhi(w.w); }
        }
        const float il = 1.0f / l;
        if (vh < 8) { v4u* dst = (v4u*)(H + (size_t)m * D + vh * 64);
#pragma unroll
            for (int c8 = 0; c8 < 8; ++c8) { v4u w; w.x = pk2(o[8 * c8 + 0] * il, o[8 * c8 + 1] * il); w.y = pk2(o[8 * c8 + 2] * il, o[8 * c8 + 3] * il); w.z = pk2(o[8 * c8 + 4] * il, o[8 * c8 + 5] * il); w.w = pk2(o[8 * c8 + 6] * il, o[8 * c8 + 7] * il); dst[c8] = w; } }
        else { f32x4* dst = (f32x4*)(DT + (size_t)m * D + (vh - 8) * 64);
#pragma unroll
            for (int c4 = 0; c4 < 16; ++c4) dst[c4] = (f32x4){o[4 * c4 + 0] * il, o[4 * c4 + 1] * il, o[4 * c4 + 2] * il, o[4 * c4 + 3] * il}; }
    }
}
__device__ __forceinline__ void ph_att_comb(const Args& a, const Ids& id, int layer) {
    const int j = layer >> 1, lane = id.lane; const float lam_init = (layer == 0) ? 0.2f : 0.4707130183435842f;
    const float* lf = a.in[15 + id.z] + j * 256; const float* sg = a.in[16 + id.z] + j * 128;
    const float s01 = wave_sum(lf[lane] * lf[64 + lane]), s23 = wave_sum(lf[128 + lane] * lf[192 + lane]);
    const float lam = expf(s01) - expf(s23) + lam_init;
    const float* DT = (const float*)(a.ws + id.z + A_DT); bf16* H = (bf16*)(a.ws + id.z + A_H);
    const float g0 = sg[lane] * (1.0f - lam_init), g1 = sg[64 + lane] * (1.0f - lam_init);
    for (int it = id.gw; it < NTOK * 4; it += id.ngw) { const int m = it >> 2, hd = it & 3; const float* p = DT + (size_t)m * D + hd * 256;
        const float v0 = p[lane] - lam * p[128 + lane], v1 = p[64 + lane] - lam * p[192 + lane];
        const float ss = wave_sum(v0 * v0 + v1 * v1); const float ri = 1.0f / sqrtf(ss * (1.0f / 128.0f) + 1e-6f);
        bf16* o = H + (size_t)m * D + 512 + hd * 128; o[lane] = (bf16)f2bf(v0 * ri * g0); o[64 + lane] = (bf16)f2bf(v1 * ri * g1); }
}

__device__ __forceinline__ void ph_rw_prep(const Args& a, const Ids& id, int layer) {
    const int j = layer >> 1, lane = id.lane;
    const bf16* L1 = (const bf16*)(a.ws + id.z + A_L1); const bf16* RKV = (const bf16*)(a.ws + id.z + A_RKV);
    bf16 *A0 = (bf16*)(a.ws + id.z + A_A0), *A1 = (bf16*)(a.ws + id.z + A_A1), *EW0 = (bf16*)(a.ws + id.z + A_EW0), *EW1 = (bf16*)(a.ws + id.z + A_EW1);
    float* INV = (float*)(a.ws + id.z + WS_INV); float* Y = (float*)(a.ws + id.z + A_Y);
    const float* w2 = a.in[22 + id.z] + (size_t)j * 2 * 64 * D; const float* a2 = a.in[25 + id.z] + (size_t)j * 2 * 64 * D;
    const float* w0 = a.in[20 + id.z] + (size_t)j * 2 * D; const float* a0 = a.in[23 + id.z] + (size_t)j * 2 * D; const float* kk_c = a.in[28 + id.z] + (size_t)(j * 3 + 0) * D;
    for (int it = id.gw; it < (NTOK / 4) * 4; it += id.ngw) {
        const int tg = it >> 2, q = it & 3, m0 = tg * 4, c0 = q * 256 + 4 * lane;
        float T0[4], T1[4], R0[4], R1[4];
#pragma unroll
        for (int tt = 0; tt < 4; ++tt) { const bf16* l = L1 + (size_t)(m0 + tt) * 512; T0[tt] = tanhf(bf2f(l[lane])); T1[tt] = tanhf(bf2f(l[64 + lane])); R0[tt] = bf2f(l[128 + lane]); R1[tt] = bf2f(l[192 + lane]); }
        f32x4 d0[4], d1[4], e0[4], e1[4];
#pragma unroll
        for (int tt = 0; tt < 4; ++tt) { d0[tt] = (f32x4){0.f, 0.f, 0.f, 0.f}; d1[tt] = d0[tt]; e0[tt] = d0[tt]; e1[tt] = d0[tt]; }
#pragma unroll 2
        for (int i = 0; i < 64; ++i) {
            const f32x4 wv0 = *(const f32x4*)(w2 + (size_t)i * D + c0), wv1 = *(const f32x4*)(w2 + (size_t)(64 + i) * D + c0), av0 = *(const f32x4*)(a2 + (size_t)i * D + c0), av1 = *(const f32x4*)(a2 + (size_t)(64 + i) * D + c0);
#pragma unroll
            for (int tt = 0; tt < 4; ++tt) { d0[tt] += wv0 * __shfl(T0[tt], i); d1[tt] += wv1 * __shfl(T1[tt], i); e0[tt] += av0 * __shfl(R0[tt], i); e1[tt] += av1 * __shfl(R1[tt], i); }
        }
        const f32x4 w00 = *(const f32x4*)(w0 + c0), w01 = *(const f32x4*)(w0 + D + c0), a00 = *(const f32x4*)(a0 + c0), a01 = *(const f32x4*)(a0 + D + c0);
#pragma unroll
        for (int tt = 0; tt < 4; ++tt) { const size_t off = (size_t)(m0 + tt) * D + c0; float x0[4], x1[4], y0[4], y1[4];
#pragma unroll
            for (int e = 0; e < 4; ++e) { x0[e] = 0.8750387749719753f * sigmoidf_(w00[e] + d0[tt][e]); x1[e] = 0.8750387749719753f * sigmoidf_(w01[e] + d1[tt][e]);
                y0[e] = sigmoidf_(a00[e] + e0[tt][e]); y1[e] = sigmoidf_(a01[e] + e1[tt][e]); }
            *(v2u*)(EW0 + off) = (v2u){pk2(x0[0], x0[1]), pk2(x0[2], x0[3])}; *(v2u*)(EW1 + off) = (v2u){pk2(x1[0], x1[1]), pk2(x1[2], x1[3])};
            *(v2u*)(A0 + off) = (v2u){pk2(y0[0], y0[1]), pk2(y0[2], y0[3])}; *(v2u*)(A1 + off) = (v2u){pk2(y1[0], y1[1]), pk2(y1[2], y1[3])}; }
    }
    for (int m = id.gw; m < NTOK; m += id.ngw) {
#pragma unroll 4
        for (int h = 0; h < 16; ++h) { const float kv = bf2f(RKV[(size_t)m * 3072 + 1024 + h * 64 + lane]) * kk_c[h * 64 + lane]; const float ss = wave_sum(kv * kv); if (lane == 0) INV[m * 16 + h] = 1.0f / sqrtf(ss + 1e-12f); }
        f32x4* yp = (f32x4*)(Y + (size_t)m * D);
#pragma unroll
        for (int q = 0; q < 4; ++q) yp[lane + 64 * q] = (f32x4){0.f, 0.f, 0.f, 0.f};
    }
}

struct ScanIn { float r, k, v, a, ew, inv; };
__device__ __forceinline__ void scan_load(ScanIn& s, const bf16* RKV, const bf16* Ad, const bf16* EWd, const float* INV, int m, int h, int lane) {
    const size_t o = (size_t)m * 3072 + h * 64 + lane;
    s.r = bf2f(RKV[o]); s.k = bf2f(RKV[o + 1024]); s.v = bf2f(RKV[o + 2048]);
    s.a = bf2f(Ad[(size_t)m * D + h * 64 + lane]); s.ew = bf2f(EWd[(size_t)m * D + h * 64 + lane]); s.inv = INV[m * 16 + h];
}
__device__ __forceinline__ void ph_rw_scan_simple(const Args& a, const Ids& id, int layer) {
    const int j = layer >> 1, lane = id.lane;
    const bf16* RKV = (const bf16*)(a.ws + id.z + A_RKV); const float* INV = (const float*)(a.ws + id.z + WS_INV); float* Y = (float*)(a.ws + id.z + A_Y);
    for (int ci = id.gw; ci < 2048; ci += id.ngw) {
        int ch; if ((ci & 15) == 0) ch = ci >> 4; else { const int idx = ci - (ci >> 4) - 1; if (idx >= 1024) continue; ch = 128 + idx; }
        const bool smp = ch < 128; int b, h, dir, T, mbase;
        if (smp) { b = ch >> 5; h = (ch >> 1) & 15; dir = ch & 1; T = TS; mbase = NPR + b * TS; } else { const int c2 = ch - 128; b = c2 >> 5; h = (c2 >> 1) & 15; dir = c2 & 1; T = TP; mbase = b * TP; }
        const bf16* Ad = (const bf16*)(a.ws + id.z + (dir ? A_A1 : A_A0)); const bf16* EWd = (const bf16*)(a.ws + id.z + (dir ? A_EW1 : A_EW0));
        const float kkc = a.in[28 + id.z][(size_t)(j * 3 + 0) * D + h * 64 + lane], kac = a.in[28 + id.z][(size_t)(j * 3 + 1) * D + h * 64 + lane];
        float S[64];
        if (smp) { const f32x4* sp = (const f32x4*)(a.in[7 + id.z] + ((((size_t)(b * 2 + j) * 2 + dir) * 16 + h) * 64 + lane) * 64);
#pragma unroll
            for (int q = 0; q < 16; ++q) { const f32x4 t4 = sp[q]; S[4 * q] = t4[0]; S[4 * q + 1] = t4[1]; S[4 * q + 2] = t4[2]; S[4 * q + 3] = t4[3]; } }
        else {
#pragma unroll
            for (int k = 0; k < 64; ++k) S[k] = 0.f; }
        const int tstep = dir ? -1 : 1; int t = dir ? T - 1 : 0;
        ScanIn cur, nxt; scan_load(cur, RKV, Ad, EWd, INV, mbase + t, h, lane);
#pragma unroll 1
        for (int st = 0; st < T; ++st) {
            const int tn = t + tstep; const int tl = (st + 1 < T) ? tn : t;
            scan_load(nxt, RKV, Ad, EWd, INV, mbase + tl, h, lane);
            const float w = exp2f(-cur.ew), kd = cur.k * (1.0f + (cur.a - 1.0f) * kac), kk = cur.k * kkc * cur.inv, kka = kk * cur.a;
            float sk = 0.f;
#pragma unroll
            for (int k = 0; k < 64; ++k) sk += S[k] * rdl(kk, k);
            float y = 0.f;
#pragma unroll
            for (int k = 0; k < 64; ++k) { S[k] = S[k] * rdl(w, k) - sk * rdl(kka, k) + cur.v * rdl(kd, k); y += S[k] * rdl(cur.r, k); }
            atomicAdd(&Y[(size_t)(mbase + t) * D + h * 64 + lane], y);
            cur = nxt; t = tn;
        }
        if (!smp) { f32x4* dp = (f32x4*)(a.out + id.z + O_ST + ((((size_t)(b * 2 + j) * 2 + dir) * 16 + h) * 64 + lane) * 64);
#pragma unroll
            for (int q = 0; q < 16; ++q) dp[q] = (f32x4){S[4 * q], S[4 * q + 1], S[4 * q + 2], S[4 * q + 3]}; }
    }
}
__device__ __forceinline__ void ph_rw_post(const Args& a, const Ids& id, int layer) {
    const int j = layer >> 1, lane = id.lane;
    const bf16* RKV = (const bf16*)(a.ws + id.z + A_RKV); const bf16* L1 = (const bf16*)(a.ws + id.z + A_L1); const float* Y = (const float*)(a.ws + id.z + A_Y);
    const bf16 *A0 = (const bf16*)(a.ws + id.z + A_A0), *A1 = (const bf16*)(a.ws + id.z + A_A1); bf16* H = (bf16*)(a.ws + id.z + A_H);
    const float* g2 = a.in[27 + id.z] + (size_t)j * 128 * D; const float* kvec = a.in[28 + id.z] + (size_t)j * 3 * D; const float* lnx = a.in[29 + id.z] + (size_t)j * 2 * D;
    for (int m = id.gw; m < NTOK; m += id.ngw) {
        const float sg0 = sigmoidf_(bf2f(L1[(size_t)m * 512 + 256 + lane])), sg1 = sigmoidf_(bf2f(L1[(size_t)m * 512 + 320 + lane]));
#pragma unroll 1
        for (int h = 0; h < 16; ++h) {
            const int c = h * 64 + lane;
            float g = 0.f;
#pragma unroll 8
            for (int i = 0; i < 64; ++i) g += __shfl(sg0, i) * g2[(size_t)i * D + c] + __shfl(sg1, i) * g2[(size_t)(64 + i) * D + c];
            const float y = Y[(size_t)m * D + c]; const float mean = wave_sum(y) * (1.0f / 64.0f); const float dv = y - mean; const float var = wave_sum(dv * dv) * (1.0f / 64.0f);
            float yn = dv * (1.0f / sqrtf(var + 64e-5f)); yn = yn * lnx[c] + lnx[D + c];
            const size_t o = (size_t)m * 3072 + c; const float r = bf2f(RKV[o]), k = bf2f(RKV[o + 1024]), v = bf2f(RKV[o + 2048]);
            const float a0 = bf2f(A0[(size_t)m * D + c]), a1 = bf2f(A1[(size_t)m * D + c]); const float ka = kvec[D + c], rk = kvec[2 * D + c];
            const float kds = k * (1.0f + (a0 - 1.0f) * ka) + k * (1.0f + (a1 - 1.0f) * ka);
            const float bs = wave_sum(r * kds * rk);
            H[(size_t)m * D + c] = (bf16)f2bf((yn + bs * v) * g);
        }
    }
}

enum Kind { K_PRO = 0, K_NORM0 = 1, K_QKV = 2, K_APOST = 3, K_ATTN = 4, K_ACOMB = 5, K_MIXOUT = 6, K_RNORM = 7, K_MLP1 = 8, K_MLP2 = 9, K_REND = 10,
            K_RMIX = 11, K_RKV = 12, K_RPREP = 13, K_RSCAN = 14, K_RPOST = 15 };
constexpr int NPH = 40;
__host__ __device__ __forceinline__ void decode_phase(int ph, int& kind, int& layer) {
    if (ph < 2) { kind = ph; layer = 0; return; }
    const int p = ph - 2, pair = p / 19, q = p % 19;
    if (q < 9) { layer = 2 * pair; kind = K_QKV + q; }
    else { layer = 2 * pair + 1; const int q2 = q - 9; kind = (q2 < 5) ? (K_RMIX + q2) : (K_MIXOUT + (q2 - 5)); }
}

__global__ void __launch_bounds__(NWAVES * 64, 2) mega_fwd(Args a) {
    extern __shared__ __attribute__((aligned(16))) unsigned char lds_raw[];
    LAS unsigned char* lds = (LAS unsigned char*)lds_raw;
    const int G = gridDim.x, bx = blockIdx.x; const int vcu = (G % 8 == 0) ? (bx % 8) * (G / 8) + bx / 8 : bx;
    Ids id0; id0.tid = threadIdx.x; id0.z = 0;
    volatile LAS unsigned* MISC = (volatile LAS unsigned*)(lds + MISC_OFF);
    for (int u = id0.tid; u < (LDS_BYTES - LDSCTL_OFF) / 4; u += NWAVES * 64) ((LAS unsigned*)(lds + LDSCTL_OFF))[u] = 0u;
    __syncthreads();
#if MK_N_LAUNCHES == 1 && !MK_CG_BARRIER
    XcdBarrier bar = xcd_barrier_post((unsigned*)(a.ws + id.z + WS_CTL) + CW_BAR, MISC + 8);
#endif
    (void)MISC;
    int nsync = 0;
    for (int ph = a.ph_lo; ph < a.ph_hi; ++ph) {
        int kind, layer; decode_phase(ph, kind, layer);
        Ids id; { int tv = threadIdx.x; asm volatile("" : "+v"(tv)); int zz; asm volatile("s_mov_b32 %0, 0" : "=s"(zz)); id.tid = tv; id.z = zz; }
        id.lane = id.tid & 63; id.wave = __builtin_amdgcn_readfirstlane(id.tid >> 6); id.gw = vcu * NWAVES + id.wave; id.ngw = G * NWAVES;
        if (kind == K_PRO) ph_prologue(a, id, lds);
        else if (kind == K_NORM0) ph_norm0(a, id);
        else if (kind == K_QKV || kind == K_MIXOUT || kind == K_MLP2) {
            const bf16* A; const bf16* Bt; float* C; int N, K;
            if (kind == K_QKV) { A = (const bf16*)(a.ws + id.z + A_H); Bt = (const bf16*)(a.ws + id.z + W_WINT); C = (float*)(a.ws + id.z + A_QKVRAW); N = NQKV; K = D; }
            else if (kind == K_MIXOUT) { A = (const bf16*)(a.ws + id.z + A_H); Bt = (const bf16*)(a.ws + id.z + ((layer & 1) ? W_WOT : W_WOUTT)); C = (float*)(a.ws + id.z + A_M); N = D; K = D; }
            else { A = (const bf16*)(a.ws + id.z + A_HID); Bt = (const bf16*)(a.ws + id.z + W_W2T); C = (float*)(a.ws + id.z + A_F); N = D; K = FF; }
            pg8::Gemm g{A, Bt, NTOK, N, K}; pg8::StaticOrder S; S.init(NTOK, N, G, bx);
            pg8::EpiF32 E{C, N};
            pg8::gemm_phase<pg8::EpiF32, pg8::StaticOrder, true, true>(lds + RING_OFF, g, S, E);
        }
        else if (kind == K_MLP1) {
            pg8::Gemm g{(const bf16*)(a.ws + id.z + A_H), (const bf16*)(a.ws + id.z + W_W1T), NTOK, FF, D}; pg8::StaticOrder S; S.init(NTOK, FF, G, bx);
            pg8::EpiBf16<2> E{(bf16*)(a.ws + id.z + A_HID), FF, 1 << 20, nullptr, 0};
            pg8::gemm_phase<pg8::EpiBf16<2>, pg8::StaticOrder, true, true>(lds + RING_OFF, g, S, E);
        }
        else if (kind == K_RKV) {
            pg8::Gemm g{(const bf16*)(a.ws + id.z + A_A2), (const bf16*)(a.ws + id.z + W_BT1), NTOK, NRKV, KRKV}; pg8::StaticOrder S; S.init(NTOK, NRKV, G, bx);
            pg8::EpiBf16<0> E{(bf16*)(a.ws + id.z + A_RKV), 3072, 12, (bf16*)(a.ws + id.z + A_L1), 512};
            pg8::gemm_phase<pg8::EpiBf16<0>, pg8::StaticOrder, true, true>(lds + RING_OFF, g, S, E);
        }
        else if (kind == K_APOST) ph_att_post(a, id, layer);
        else if (kind == K_ATTN) ph_attn_simple(a, id);
        else if (kind == K_ACOMB) ph_att_comb(a, id, layer);
        else if (kind == K_RNORM) ph_resid_norm(a, id, layer);
        else if (kind == K_REND) ph_resid_end(a, id, lds, layer);
        else if (kind == K_RMIX) ph_rw_mix(a, id, layer);
        else if (kind == K_RPREP) ph_rw_prep(a, id, layer);
        else if (kind == K_RSCAN) ph_rw_scan_simple(a, id, layer);
        else if (kind == K_RPOST) ph_rw_post(a, id, layer);
        if (ph + 1 < a.ph_hi) {
#if MK_N_LAUNCHES == 1
#if MK_CG_BARRIER
            cg::this_grid().sync();
#else
            if (nsync == 0) cg::this_grid().sync(); else xcd_barrier(bar);
#endif
#endif
            ++nsync;
        }
    }
}

extern "C" void kernel_launch(void* const* d_in, const int* in_sizes, int n_in, void* d_out, int out_size, void* d_ws, size_t ws_size, hipStream_t stream) {
    static int grid = 0;
    if (grid == 0) {
        if (n_in != 32 || (size_t)out_size != OUT_TOTAL || ws_size < WS_END) { fprintf(stderr, "kernel_launch: unexpected problem (n_in %d, out %d, ws %zu; need ws >= %zu); nothing launched\n", n_in, out_size, ws_size, (size_t)WS_END); grid = -1; return; }
        int dev = 0, cus = 0, per_cu = 0;
        if (hipGetDevice(&dev) != hipSuccess || hipDeviceGetAttribute(&cus, hipDeviceAttributeMultiprocessorCount, dev) != hipSuccess) { grid = -1; return; }
        if (hipFuncSetAttribute((const void*)mega_fwd, hipFuncAttributeMaxDynamicSharedMemorySize, LDS_BYTES) != hipSuccess) { fprintf(stderr, "kernel_launch: hipFuncSetAttribute failed\n"); grid = -1; return; }
        if (hipOccupancyMaxActiveBlocksPerMultiprocessor(&per_cu, (const void*)mega_fwd, NWAVES * 64, LDS_BYTES) != hipSuccess || per_cu < 1) { fprintf(stderr, "kernel_launch: occupancy query failed (%d)\n", per_cu); (void)hipGetLastError(); per_cu = 1; }
        grid = cus * (per_cu < 1 ? 1 : 1);
        fprintf(stderr, "kernel_launch: %d CUs, occupancy %d/CU, grid %d\n", cus, per_cu, grid);
    }
    if (grid < 0) return;
    (void)in_sizes;
    if (hipMemsetAsync((char*)d_ws + WS_CTL, 0, CTL_ZERO_BYTES, stream) != hipSuccess) { fprintf(stderr, "kernel_launch: memset failed\n"); return; }
    Args a{};
    for (int i = 0; i < 32; ++i) a.in[i] = (const float*)d_in[i];
    a.out = (float*)d_out; a.ws = (unsigned char*)d_ws;
#if MK_N_LAUNCHES == 1
    a.ph_lo = 0; a.ph_hi = NPH;
    void* args[] = {&a};
    hipError_t e = hipLaunchCooperativeKernel((const void*)mega_fwd, dim3(grid), dim3(NWAVES * 64), args, LDS_BYTES, stream);
    if (e != hipSuccess) fprintf(stderr, "kernel_launch: cooperative launch failed: %s (grid %d)\n", hipGetErrorString(e), grid);
#else
    for (int ph = 0; ph < NPH; ++ph) {
        a.ph_lo = ph; a.ph_hi = ph + 1;
        hipLaunchKernelGGL(mega_fwd, dim3(grid), dim3(NWAVES * 64), LDS_BYTES, stream, a);
    }
#endif
}
```

```cpp
#include <hip/hip_runtime.h>
#include <hip/hip_cooperative_groups.h>
#include <cstdio>
#include <cstdint>
namespace cg = cooperative_groups;
namespace pg8 {
#define PG8_LAS __attribute__((address_space(3)))
typedef unsigned short bf16_t;
typedef short bf16x8 __attribute__((ext_vector_type(8)));
typedef float f32x4 __attribute__((ext_vector_type(4)));
typedef unsigned u32x4 __attribute__((ext_vector_type(4)));
constexpr int BM = 256, BK = 64, HALF = 128, HTB = HALF * BK * 2  , STAGE_BYTES = 8 * HTB, NXCD = 8, WGM = 8;

__host__ __device__ __forceinline__ int lds_byte(int r, int c) { const int st = (r >> 4) * 2 + (c >> 5), rr = r & 15, cc = c & 31, ob = rr * 64 + cc * 2; return st * 1024 + (ob ^ (((ob >> 9) & 1) << 5)); }
__host__ __device__ __forceinline__ void stage_rc(int b, int& R, int& C) { const int st = b / 1024, sb = b % 1024, swz = sb ^ (((sb >> 9) & 1) << 5); R = (st >> 1) * 16 + swz / 64; C = (st & 1) * 32 + (swz % 64) / 2; }
__host__ __device__ __forceinline__ int perm32(int rho) { const int n = rho >> 4, i = rho & 15; return 8 * (i >> 2) + 4 * n + (i & 3); }

struct Unit { int pm, pn; };
struct Gemm { const bf16_t* A; const bf16_t* Bt; int M, N, K; };

struct StaticOrder {
    int nM, nN, nwg, G, c;
    __host__ __device__ void init(int M, int N, int G_, int c_) { nM = M / BM; nN = N / BM; nwg = nM * nN; G = G_; c = c_; }
    __host__ __device__ bool next(int i, Unit& u) const {
        const long L = (long)i * G + c; if (L >= nwg) return false;
        int wgid = (int)L; { const int q = nwg / NXCD, r = nwg % NXCD, xcd = wgid % NXCD, off = wgid / NXCD; wgid = (xcd < r ? xcd * (q + 1) : r * (q + 1) + (xcd - r) * q) + off; }
        const int nig = WGM * nN, gid = wgid / nig, fm = gid * WGM, gsz = (nM - fm) < WGM ? (nM - fm) : WGM;
        u.pm = fm + ((wgid % nig) % gsz); u.pn = (wgid % nig) / gsz; return true;
    }
    __device__ __forceinline__ void a_ready(const Unit&) const {}
    __device__ __forceinline__ void done(const Unit&) const {}
};


__device__ __forceinline__ unsigned cvt_pk_bf16(float lo, float hi) { unsigned r; asm volatile("v_cvt_pk_bf16_f32 %0, %1, %2" : "=v"(r) : "v"(lo), "v"(hi)); return r; }

struct EpiF32 {
    static constexpr bool PERM = false, AFTER_DRAIN = false;
    float* C; int ldc;
    __device__ __forceinline__ void operator()(const f32x4 (&acc)[2][2][4][2], const Unit& u, int wr, int wc, int fr, int fq) const {
        const int row0 = u.pm * BM + wr * 64 + fr, col0 = u.pn * BM + wc * 32 + 4 * fq;
#pragma unroll
        for (int ai = 0; ai < 2; ++ai)
#pragma unroll
            for (int m = 0; m < 4; ++m) { float* rowp = C + (size_t)(row0 + ai * HALF + m * 16) * ldc + col0;
#pragma unroll
                for (int bj = 0; bj < 2; ++bj)
#pragma unroll
                    for (int n = 0; n < 2; ++n) *(f32x4*)(rowp + bj * HALF + n * 16) = acc[ai][bj][m][n]; }
    }
    __device__ __forceinline__ void fused(f32x4 (&)[2][2][4][2], const Unit&, int, int, int, int, PG8_LAS unsigned char*, int, int) const {}
};

template <int ACT> struct EpiBf16 {
    static constexpr bool PERM = true, AFTER_DRAIN = false;
    bf16_t* O0; int ld0; int nt0; bf16_t* O1; int ld1;
    __device__ __forceinline__ void operator()(const f32x4 (&acc)[2][2][4][2], const Unit& u, int wr, int wc, int fr, int fq) const {
        const int row0 = u.pm * BM + wr * 64 + fr;
        bf16_t* base; int ldc, colt;
        if (u.pn < nt0) { base = O0; ldc = ld0; colt = u.pn * BM; } else { base = O1; ldc = ld1; colt = (u.pn - nt0) * BM; }
        const int col0 = colt + wc * 32 + 8 * fq;
#pragma unroll
        for (int ai = 0; ai < 2; ++ai)
#pragma unroll
            for (int m = 0; m < 4; ++m) { bf16_t* rowp = base + (size_t)(row0 + ai * HALF + m * 16) * ldc + col0;
#pragma unroll
                for (int bj = 0; bj < 2; ++bj) { f32x4 v0 = acc[ai][bj][m][0], v1 = acc[ai][bj][m][1];
                    if (ACT == 2) {
#pragma unroll
                        for (int e = 0; e < 4; ++e) { float a = v0[e] > 0.f ? v0[e] : 0.f; v0[e] = a * a; float b = v1[e] > 0.f ? v1[e] : 0.f; v1[e] = b * b; } }
                    u32x4 w; w.x = cvt_pk_bf16(v0[0], v0[1]); w.y = cvt_pk_bf16(v0[2], v0[3]); w.z = cvt_pk_bf16(v1[0], v1[1]); w.w = cvt_pk_bf16(v1[2], v1[3]);
                    *(u32x4*)(rowp + bj * HALF) = w; } }
    }
    __device__ __forceinline__ void fused(f32x4 (&)[2][2][4][2], const Unit&, int, int, int, int, PG8_LAS unsigned char*, int, int) const {}
};

template <class Epi, class Sched, bool ALIGN_EPI = false, bool SP2 = false>
__device__ __forceinline__ void gemm_phase(PG8_LAS unsigned char* lds, const Gemm g, const Sched& S, const Epi& E) {
    int tid_o = threadIdx.x; asm volatile("" : "+v"(tid_o));
    const int tid = tid_o, wid = __builtin_amdgcn_readfirstlane(tid >> 6), lane = tid & 63, wr = wid >> 2, wc = wid & 3, fr = lane & 15, fq = lane >> 4;
    const int K = g.K, nt = K / BK;
    unsigned voffA[2], voffB[2];
#pragma unroll
    for (int i = 0; i < 2; ++i) { int R, C; stage_rc(tid * 16 + i * 8192, R, C); const int Rb = Epi::PERM ? ((R & ~31) + perm32(R & 31)) : R;
        voffA[i] = (unsigned)(R * K + C) * 2u; voffB[i] = (unsigned)(Rb * K + C) * 2u; }
    const size_t kstep = (size_t)(BK * 2);
    const size_t hstep = (size_t)HALF * K * 2;
    const size_t tstep = 2 * hstep;
    const unsigned ldsw = (unsigned)wid * 1024u;
    const int aoff = lds_byte(wr * 64 + fr, fq * 8), boff = lds_byte(wc * 32 + fr, fq * 8);
#define PG8_SA(b, h) (((b) * 2 + (h)) * HTB)
#define PG8_SB(b, h) ((4 + (b) * 2 + (h)) * HTB)
#define PG8_STAGE(bufoff, gbase, voff) do { _Pragma("unroll") for (int _i = 0; _i < 2; ++_i) \
        __builtin_amdgcn_global_load_lds((const unsigned*)((const char*)(gbase) + (voff)[_i]), (PG8_LAS unsigned*)(lds + (bufoff) + ldsw + _i * 8192), 16, 0, 0); } while (0)
#define PG8_LDA(dst, b, h) do { _Pragma("unroll") for (int m = 0; m < 4; ++m) _Pragma("unroll") for (int k = 0; k < 2; ++k) dst[m][k] = *(const PG8_LAS bf16x8*)(lds + PG8_SA(b, h) + aoff + m * 2048 + k * 1024); } while (0)
#define PG8_LDB(dst, b, h) do { _Pragma("unroll") for (int n = 0; n < 2; ++n) _Pragma("unroll") for (int k = 0; k < 2; ++k) dst[n][k] = *(const PG8_LAS bf16x8*)(lds + PG8_SB(b, h) + boff + n * 2048 + k * 1024); } while (0)
#define PG8_MMA(ai, bj, At, Bt) do { __builtin_amdgcn_s_setprio(1); _Pragma("unroll") for (int m = 0; m < 4; ++m) _Pragma("unroll") for (int n = 0; n < 2; ++n) _Pragma("unroll") for (int k = 0; k < 2; ++k) \
        acc[ai][bj][m][n] = __builtin_amdgcn_mfma_f32_16x16x32_bf16(Bt[n][k], At[m][k], acc[ai][bj][m][n], 0, 0, 0); __builtin_amdgcn_s_setprio(0); } while (0)
#define PG8_WAIT_V(n) asm volatile("s_waitcnt vmcnt(" #n ")" ::: "memory")
#define PG8_WAIT_L(n) asm volatile("s_waitcnt lgkmcnt(" #n ")" ::: "memory")
#define PG8_BAR __builtin_amdgcn_s_barrier()
#define PG8_SCHED __builtin_amdgcn_sched_barrier(0)
    Unit cur, nxt; int ui = 0;
    if (!S.next(0, cur)) return;
    f32x4 acc[2][2][4][2];
#pragma unroll
    for (int a = 0; a < 2; ++a)
#pragma unroll
        for (int b = 0; b < 2; ++b)
#pragma unroll
            for (int m = 0; m < 4; ++m)
#pragma unroll
                for (int n = 0; n < 2; ++n) acc[a][b][m][n] = (f32x4){0.f, 0.f, 0.f, 0.f};
    bf16x8 At[4][2], B0[2][2], B1[2][2];
    const char* cA = (const char*)g.A + (size_t)cur.pm * tstep; const char* cB = (const char*)g.Bt + (size_t)cur.pn * tstep;
    S.a_ready(cur);
    if constexpr (SP2) {
        PG8_STAGE(PG8_SB(0, 0), cB, voffB); PG8_STAGE(PG8_SB(0, 1), cB + hstep, voffB); PG8_STAGE(PG8_SA(0, 0), cA, voffA); PG8_STAGE(PG8_SA(0, 1), cA + hstep, voffA);
        if (wr == 1) PG8_BAR;
        PG8_WAIT_V(2); PG8_BAR;
        PG8_STAGE(PG8_SB(1, 0), cB + kstep, voffB); PG8_STAGE(PG8_SA(1, 0), cA + kstep, voffA); PG8_STAGE(PG8_SB(1, 1), cB + hstep + kstep, voffB);
        PG8_WAIT_V(6); PG8_BAR;
    } else {
        PG8_STAGE(PG8_SB(0, 0), cB, voffB); PG8_STAGE(PG8_SA(0, 0), cA, voffA); PG8_STAGE(PG8_SB(0, 1), cB + hstep, voffB); PG8_STAGE(PG8_SA(0, 1), cA + hstep, voffA);
        if (wr == 1) PG8_BAR;
        PG8_WAIT_V(4); PG8_BAR;
        PG8_STAGE(PG8_SB(1, 0), cB + kstep, voffB); PG8_STAGE(PG8_SA(1, 0), cA + kstep, voffA); PG8_STAGE(PG8_SB(1, 1), cB + hstep + kstep, voffB);
        PG8_WAIT_V(6); PG8_BAR;
    }
    for (;;) {
        const bool has_next = S.next(ui + 1, nxt);
        const char* nA = has_next ? (const char*)g.A + (size_t)nxt.pm * tstep : cA; const char* nB = has_next ? (const char*)g.Bt + (size_t)nxt.pn * tstep : cB;
        for (int t = 0; t < nt; t += 2) {
            const bool last = (t == nt - 2);
            const char* a1 = cA + (size_t)(t + 1) * kstep;
            const char* a2 = last ? nA : cA + (size_t)(t + 2) * kstep; const char* b2 = last ? nB : cB + (size_t)(t + 2) * kstep;
            const char* a3 = a2 + kstep; const char* b3 = b2 + kstep;
            if (last && has_next) S.a_ready(nxt);
            if constexpr (SP2) {
            PG8_LDB(B0, 0, 0); PG8_LDB(B1, 0, 1); PG8_SCHED; PG8_LDA(At, 0, 0); PG8_STAGE(PG8_SA(1, 1), a1 + hstep, voffA);
            PG8_WAIT_V(8); PG8_WAIT_L(0); PG8_BAR; PG8_MMA(0, 0, At, B0); PG8_MMA(0, 1, At, B1); PG8_BAR; PG8_SCHED;
            PG8_LDA(At, 0, 1); PG8_STAGE(PG8_SB(0, 0), b2, voffB); PG8_STAGE(PG8_SB(0, 1), b2 + hstep, voffB); PG8_STAGE(PG8_SA(0, 0), a2, voffA);
            PG8_WAIT_V(8); PG8_WAIT_L(0); PG8_BAR; PG8_MMA(1, 0, At, B0); PG8_MMA(1, 1, At, B1); PG8_BAR; PG8_SCHED;
            PG8_LDB(B0, 1, 0); PG8_LDB(B1, 1, 1); PG8_SCHED; PG8_LDA(At, 1, 0); PG8_STAGE(PG8_SA(0, 1), a2 + hstep, voffA);
            PG8_WAIT_V(8); PG8_WAIT_L(0); PG8_BAR; PG8_MMA(0, 0, At, B0); PG8_MMA(0, 1, At, B1); PG8_BAR; PG8_SCHED;
            PG8_LDA(At, 1, 1); PG8_STAGE(PG8_SB(1, 0), b3, voffB); PG8_STAGE(PG8_SB(1, 1), b3 + hstep, voffB); PG8_STAGE(PG8_SA(1, 0), a3, voffA);
            PG8_WAIT_V(8); PG8_WAIT_L(0); PG8_BAR; PG8_MMA(1, 0, At, B0); PG8_MMA(1, 1, At, B1); PG8_BAR; PG8_SCHED;
            } else {
            PG8_LDB(B0, 0, 0); PG8_SCHED; PG8_LDA(At, 0, 0); PG8_STAGE(PG8_SA(1, 1), a1 + hstep, voffA);
            PG8_WAIT_L(8); PG8_BAR; PG8_WAIT_L(0); PG8_MMA(0, 0, At, B0); PG8_BAR; PG8_SCHED;
            PG8_LDB(B1, 0, 1); PG8_STAGE(PG8_SB(0, 0), b2, voffB);
            PG8_BAR; PG8_WAIT_L(0); PG8_MMA(0, 1, At, B1); PG8_BAR;
            PG8_LDA(At, 0, 1); PG8_STAGE(PG8_SA(0, 0), a2, voffA);
            PG8_BAR; PG8_WAIT_L(0); PG8_MMA(1, 0, At, B0); PG8_BAR; PG8_SCHED;
            PG8_STAGE(PG8_SB(0, 1), b2 + hstep, voffB);
            PG8_WAIT_V(6); PG8_BAR; PG8_MMA(1, 1, At, B1); PG8_BAR;
            PG8_LDB(B0, 1, 0); PG8_SCHED; PG8_LDA(At, 1, 0); PG8_STAGE(PG8_SA(0, 1), a2 + hstep, voffA);
            PG8_WAIT_L(8); PG8_BAR; PG8_WAIT_L(0); PG8_MMA(0, 0, At, B0); PG8_BAR; PG8_SCHED;
            PG8_LDB(B1, 1, 1); PG8_STAGE(PG8_SB(1, 0), b3, voffB);
            PG8_BAR; PG8_WAIT_L(0); PG8_MMA(0, 1, At, B1); PG8_BAR;
            PG8_LDA(At, 1, 1); PG8_STAGE(PG8_SA(1, 0), a3, voffA);
            PG8_BAR; PG8_WAIT_L(0); PG8_MMA(1, 0, At, B0); PG8_BAR; PG8_SCHED;
            PG8_STAGE(PG8_SB(1, 1), b3 + hstep, voffB);
            PG8_WAIT_V(6); PG8_BAR; PG8_MMA(1, 1, At, B1); PG8_BAR;
            }
        }
        if constexpr (ALIGN_EPI) { if (wr == 0) PG8_BAR; }
        if constexpr (!Epi::AFTER_DRAIN) { E(acc, cur, wr, wc, fr, fq); S.done(cur); }
        if (!has_next) break;
#pragma unroll
        for (int a = 0; a < 2; ++a)
#pragma unroll
            for (int b = 0; b < 2; ++b)
#pragma unroll
                for (int m = 0; m < 4; ++m)
#pragma unroll
                    for (int n = 0; n < 2; ++n) acc[a][b][m][n] = (f32x4){0.f, 0.f, 0.f, 0.f};
        cur = nxt; cA = nA; cB = nB; ++ui;
        if constexpr (ALIGN_EPI) { if (wr == 1) PG8_BAR; }
    }
    PG8_WAIT_V(0);
    if constexpr (!ALIGN_EPI) { if (wr == 0) PG8_BAR; }
    PG8_BAR;
    if constexpr (Epi::AFTER_DRAIN) { E.fused(acc, cur, wr, wc, fr, fq, lds, wid, lane); S.done(cur); }
#undef PG8_SA
#undef PG8_SB
#undef PG8_STAGE
#undef PG8_LDA
#undef PG8_LDB
#undef PG8_MMA
#undef PG8_WAIT_V
#undef PG8_WAIT_L
#undef PG8_BAR
#undef PG8_SCHED
}
}

#define GAS __attribute__((address_space(1)))
#define LAS __attribute__((address_space(3)))
typedef unsigned short bf16;
typedef unsigned v4u __attribute__((ext_vector_type(4)));
typedef unsigned v2u __attribute__((ext_vector_type(2)));
typedef float f32x4 __attribute__((ext_vector_type(4)));
#define LDS_WAIT() asm volatile("s_waitcnt lgkmcnt(0)" ::: "memory")

#ifndef MK_N_LAUNCHES
#define MK_N_LAUNCHES 1
#endif
#ifndef MK_CG_BARRIER
#define MK_CG_BARRIER 1
#endif

constexpr int D = 1024, NTOK = 16384, NPR = 8192, TP = 256, TS = 2048, PAST = 512, SKV = 2560, FF = 4096, DEPTH = 4;
constexpr int NQKV = 2304, NRKV = 3584, KRKV = 2048;
constexpr int NWAVES = 8;
constexpr size_t O_X = 0, O_KG = 16777216, O_VG = 18874368, O_KD = 20971520, O_VD = 29360128, O_ST = 37748736, OUT_TOTAL = 46137344;
constexpr size_t MiB = 1u << 20;
constexpr size_t WS_CTL = 0, CTL_ZERO_BYTES = 1 * MiB;
constexpr size_t WS_MOD = 65536;
constexpr size_t WS_ROPE = 1 * MiB;
constexpr size_t WS_INV = 2 * MiB;
constexpr size_t WS_W = 4 * MiB;
constexpr size_t W_W1T = WS_W, W_W2T = WS_W + 8 * MiB, W_MIX = WS_W + 16 * MiB;
constexpr size_t W_WINT = W_MIX, W_WOUTT = W_MIX + 6 * MiB;
constexpr size_t W_BT1 = W_MIX, W_WOT = W_MIX + 14 * MiB;
constexpr size_t AR = 40 * MiB;
constexpr size_t A_H = AR;
constexpr size_t A_QKVRAW = AR + 32 * MiB;
constexpr size_t A_DT = AR + 32 * MiB;
constexpr size_t A_M = AR + 96 * MiB;
constexpr size_t A_QA = AR + 176 * MiB, A_QB = AR + 192 * MiB, A_KAP = AR + 208 * MiB, A_VAP = AR + 210 * MiB, A_KBP = AR + 212 * MiB, A_VBP = AR + 220 * MiB;
constexpr size_t A_KAS = AR + 228 * MiB, A_VAS = AR + 231 * MiB, A_KBS = AR + 234 * MiB, A_VBS = AR + 244 * MiB;
constexpr size_t A_HID = AR + 32 * MiB;
constexpr size_t A_F = AR + 160 * MiB;
constexpr size_t A_A2 = AR + 32 * MiB;
constexpr size_t A_Y = AR + 32 * MiB;
constexpr size_t A_RKV = AR + 96 * MiB;
constexpr size_t A_L1 = AR + 192 * MiB;
constexpr size_t A_A0 = AR + 208 * MiB, A_A1 = AR + 240 * MiB, A_EW0 = AR + 272 * MiB, A_EW1 = AR + 304 * MiB;
constexpr size_t WS_END = AR + 336 * MiB;
constexpr int CW_BAR = 4096;

constexpr int RING_OFF = 0, RING_BYTES = 131072;
constexpr int LDSCTL_OFF = RING_BYTES, MISC_OFF = LDSCTL_OFF + 320;
constexpr int LDS_BYTES = 147456;

__device__ __forceinline__ unsigned f2bf(float f) { unsigned u = __builtin_bit_cast(unsigned, f); return (u + 0x7fffu + ((u >> 16) & 1u)) >> 16; }
__device__ __forceinline__ unsigned pk2(float lo, float hi) { return f2bf(lo) | (f2bf(hi) << 16); }
__device__ __forceinline__ float bf2f(unsigned short h) { return __builtin_bit_cast(float, (unsigned)h << 16); }
__device__ __forceinline__ float bflo(unsigned w) { return __builtin_bit_cast(float, w << 16); }
__device__ __forceinline__ float bfhi(unsigned w) { return __builtin_bit_cast(float, w & 0xffff0000u); }
__device__ __forceinline__ float wave_sum(float v) {
#pragma unroll
    for (int o = 1; o < 64; o <<= 1) v += __shfl_xor(v, o);
    return v;
}
__device__ __forceinline__ float sigmoidf_(float x) { return 1.0f / (1.0f + __expf(-x)); }
__device__ __forceinline__ float rdl(float x, int l) { return __builtin_bit_cast(float, __builtin_amdgcn_readlane(__builtin_bit_cast(int, x), l)); }

#define XB_TMO      128
#define XB_XCNT(j)  (256  + 64 * (j))
#define XB_XSUB(j)  (1280 + 64 * (j))
#define XB_XGEN(j)  (2304 + 64 * (j))
#define XB_TOP      3328
#define XB_TOPGEN   3392
#define XCD_BAR_WORDS 3456
#define XB_SPIN_CAP (1u << 18)

__device__ __forceinline__ unsigned xb_ld(unsigned* p)              { return __hip_atomic_load(p, __ATOMIC_RELAXED, __HIP_MEMORY_SCOPE_AGENT); }
__device__ __forceinline__ unsigned xb_add(unsigned* p, unsigned v) { return __hip_atomic_fetch_add(p, v, __ATOMIC_RELAXED, __HIP_MEMORY_SCOPE_AGENT); }
__device__ __forceinline__ unsigned xb_xcc_id() { return (unsigned)__builtin_amdgcn_s_getreg((3 << 11) | 20) & 0xFu; }
#define XB_SPIN(cond, bar) do { unsigned _sp = 0; while (cond) { __builtin_amdgcn_s_sleep(1); \
    if ((++_sp & 255u) == 0u) { if (xb_ld(&(bar)[XB_TMO])) break; if (_sp > XB_SPIN_CAP) { atomicAdd(&(bar)[XB_TMO], 1u); break; } } } } while (0)

struct XcdBarrier {
    unsigned* bar; unsigned x;
    volatile LAS unsigned* st;
};

__device__ __forceinline__ XcdBarrier xcd_barrier_post(unsigned* bar, volatile LAS unsigned* st) {
    XcdBarrier b; b.bar = bar; b.x = xb_xcc_id(); b.st = st;
    if (threadIdx.x == 0) (void)xb_add(&bar[XB_XCNT(b.x)], 1u);
    return b;
}
__device__ __forceinline__ void xcd_barrier_complete(unsigned* bar, unsigned x, unsigned& nloc, unsigned& nx) {
    const unsigned G = gridDim.x * gridDim.y * gridDim.z;
    unsigned sum, cnt, mine, sp = 0u;
    for (;;) {
        sum = 0u; cnt = 0u; mine = 0u;
#pragma unroll
        for (unsigned j = 0; j < 16; ++j) { const unsigned c = xb_ld(&bar[XB_XCNT(j)]); sum += c; cnt += (c > 0u) ? 1u : 0u; mine = (j == x) ? c : mine; }
        if (sum == G) break;
        __builtin_amdgcn_s_sleep(1);
        if ((++sp & 255u) == 0u) { if (xb_ld(&bar[XB_TMO])) break; if (sp > XB_SPIN_CAP) { atomicAdd(&bar[XB_TMO], 1u); break; } }
    }
    nloc = mine > 0u ? mine : 1u; nx = cnt > 0u ? cnt : 1u;
}

__device__ __forceinline__ void xcd_barrier(const XcdBarrier& b) {
    asm volatile("s_waitcnt vmcnt(0)" ::: "memory");
    __syncthreads();
    if (threadIdx.x == 0) {
        unsigned* bar = b.bar;
        __builtin_amdgcn_s_waitcnt(0);
        unsigned nloc = b.st[0], nx = b.st[1];
        if (nloc == 0u) { xcd_barrier_complete(bar, b.x, nloc, nx); b.st[0] = nloc; b.st[1] = nx; }
        const unsigned old = xb_add(&bar[XB_XSUB(b.x)], 1u);
        const unsigned gen = old / nloc;
        if (old + 1u == (gen + 1u) * nloc) {
            __builtin_amdgcn_fence(__ATOMIC_RELEASE, "agent");
            asm volatile("s_waitcnt vmcnt(0)" ::: "memory");
            const unsigned og = xb_add(&bar[XB_TOP], 1u);
            const unsigned tg = og / nx;
            if (og + 1u == (tg + 1u) * nx) xb_add(&bar[XB_TOPGEN], 1u);
            else XB_SPIN(xb_ld(&bar[XB_TOPGEN]) == tg, bar);
            __builtin_amdgcn_fence(__ATOMIC_ACQUIRE, "agent");
            xb_add(&bar[XB_XGEN(b.x)], 1u);
            asm volatile("s_waitcnt vmcnt(0)" ::: "memory");
        } else {
            XB_SPIN(xb_ld(&bar[XB_XGEN(b.x)]) == gen, bar);
            __builtin_amdgcn_fence(__ATOMIC_ACQUIRE, "agent");
            asm volatile("s_waitcnt vmcnt(0)" ::: "memory");
        }
    }
    __syncthreads();
}

struct Args { const float* in[32]; float* out; unsigned char* ws; int ph_lo, ph_hi; };
struct Ids { int tid, lane, wave, gw, ngw, z; };

__device__ __forceinline__ int cond_of(int m) { return m < NPR ? 4 : ((m - NPR) >> 11); }
__device__ __forceinline__ const float* mod_ptr_(const Args& a, const Ids& id, int cond, int layer) { return (const float*)(a.ws + id.z + WS_MOD) + (size_t)(cond * 4 + layer) * 6144; }

__device__ __forceinline__ void tr_item(const float* W, int ldw, int col0, const float* scale, bf16* WT, int ldt, int drow0, int dcol0, LAS float* scr, int kb, int nb, int lane) {
    const int k0 = 64 * kb, n0 = 32 * nb;
#pragma unroll 8
    for (int i = 0; i < 32; ++i) { const int kk = 2 * i + (lane >> 5); float v = W[(size_t)(k0 + kk) * ldw + col0 + n0 + (lane & 31)]; if (scale) v *= scale[k0 + kk]; scr[kk * 33 + (lane & 31)] = v; }
    LDS_WAIT(); asm volatile("" ::: "memory");
    const int c = lane & 7;
#pragma unroll
    for (int j = 0; j < 4; ++j) { const int n = (lane >> 3) + 8 * j; const LAS float* s = scr + (8 * c) * 33 + n;
        v4u o; o.x = pk2(s[0 * 33], s[1 * 33]); o.y = pk2(s[2 * 33], s[3 * 33]); o.z = pk2(s[4 * 33], s[5 * 33]); o.w = pk2(s[6 * 33], s[7 * 33]);
        *(v4u*)(WT + (size_t)(drow0 + n0 + n) * ldt + dcol0 + k0 + 8 * c) = o; }
    LDS_WAIT(); asm volatile("" ::: "memory");
}
__device__ __forceinline__ bool tr_matrix(int& r, const float* W, int K, int N, bf16* WT, LAS float* scr, int lane) {
    const int nblk = N / 32, items = (K / 64) * nblk;
    if (r < items) { tr_item(W, N, 0, nullptr, WT, K, 0, 0, scr, r / nblk, r % nblk, lane); return true; }
    r -= items; return false;
}
__device__ __forceinline__ bool tr_rwproj(int& r, const float* W, int ncols, const float* mu, bf16* BT1, int drow0, LAS float* scr, int lane) {
    const int nblk = ncols / 32, items = 16 * nblk * 2;
    if (r < items) { const int half = r / (16 * nblk), q = r % (16 * nblk); tr_item(W, ncols, 0, half ? mu : nullptr, BT1, KRKV, drow0, half * 1024, scr, q / nblk, q % nblk, lane); return true; }
    r -= items; return false;
}
__device__ __forceinline__ void conv_weights(const Args& a, const Ids& id, LAS unsigned char* lds, int layer) {
    LAS float* scr = (LAS float*)(lds + id.wave * 16384);
    const int j = layer >> 1;
    bf16* W1T = (bf16*)(a.ws + id.z + W_W1T); bf16* W2T = (bf16*)(a.ws + id.z + W_W2T);
    const float* mw1 = a.in[30 + id.z] + (size_t)layer * D * FF; const float* mw2 = a.in[31 + id.z] + (size_t)layer * D * FF;
    if ((layer & 1) == 0) {
        bf16* WINT = (bf16*)(a.ws + id.z + W_WINT); bf16* WOUTT = (bf16*)(a.ws + id.z + W_WOUTT);
        const float* win = a.in[12 + id.z] + (size_t)j * D * NQKV; const float* wout = a.in[13 + id.z] + (size_t)j * D * D;
        const int total = 2048 + 2048 + 1152 + 512;
        for (int it = id.gw; it < total; it += id.ngw) {
            int r = it;
            if (tr_matrix(r, mw1, D, FF, W1T, scr, id.lane)) continue;
            if (tr_matrix(r, mw2, FF, D, W2T, scr, id.lane)) continue;
            if (tr_matrix(r, win, D, NQKV, WINT, scr, id.lane)) continue;
            tr_matrix(r, wout, D, D, WOUTT, scr, id.lane);
        }
    } else {
        bf16* BT1 = (bf16*)(a.ws + id.z + W_BT1); bf16* WOT = (bf16*)(a.ws + id.z + W_WOT);
        const float* mu = a.in[17 + id.z] + (size_t)j * 6 * D;
        const float* wrkv = a.in[18 + id.z] + (size_t)j * 3 * D * D;
        const float* w1 = a.in[21 + id.z] + (size_t)j * 2 * D * 64; const float* a1 = a.in[24 + id.z] + (size_t)j * 2 * D * 64; const float* g1 = a.in[26 + id.z] + (size_t)j * D * 128;
        const float* wo = a.in[19 + id.z] + (size_t)j * D * D;
        const int total = 2048 + 2048 + 3072 + 256 + 128 + 512 + 128;
        for (int it = id.gw; it < total; it += id.ngw) {
            int r = it;
            if (tr_matrix(r, mw1, D, FF, W1T, scr, id.lane)) continue;
            if (tr_matrix(r, mw2, FF, D, W2T, scr, id.lane)) continue;
            if (tr_rwproj(r, wrkv, 1024, mu + 0 * D, BT1, 0, scr, id.lane)) continue;
            if (tr_rwproj(r, wrkv + (size_t)D * D, 1024, mu + 2 * D, BT1, 1024, scr, id.lane)) continue;
            if (tr_rwproj(r, wrkv + (size_t)2 * D * D, 1024, mu + 3 * D, BT1, 2048, scr, id.lane)) continue;
            if (tr_rwproj(r, w1, 64, mu + 1 * D, BT1, 3072, scr, id.lane)) continue;
            if (tr_rwproj(r, w1 + (size_t)D * 64, 64, mu + 1 * D, BT1, 3136, scr, id.lane)) continue;
            if (tr_rwproj(r, a1, 64, mu + 4 * D, BT1, 3200, scr, id.lane)) continue;
            if (tr_rwproj(r, a1 + (size_t)D * 64, 64, mu + 4 * D, BT1, 3264, scr, id.lane)) continue;
            if (tr_rwproj(r, g1, 128, mu + 5 * D, BT1, 3328, scr, id.lane)) continue;
            if (tr_matrix(r, wo, D, D, WOT, scr, id.lane)) continue;
            { v4u z = (v4u){0u, 0u, 0u, 0u}; v4u* p = (v4u*)(BT1 + (size_t)(3456 + r) * KRKV);
#pragma unroll
              for (int q = 0; q < 4; ++q) p[id.lane + 64 * q] = z; }
        }
    }
}

struct RowV { f32x4 v[4]; };
__device__ __forceinline__ void ld_row(RowV& r, const float* p, int lane) {
#pragma unroll
    for (int j = 0; j < 4; ++j) r.v[j] = ((const f32x4*)p)[lane + 64 * j];
}
__device__ __forceinline__ void st_row(const RowV& r, float* p, int lane) {
#pragma unroll
    for (int j = 0; j < 4; ++j) ((f32x4*)p)[lane + 64 * j] = r.v[j];
}
__device__ __forceinline__ void st_row_bf16(const RowV& r, bf16* p, int lane) {
#pragma unroll
    for (int j = 0; j < 4; ++j) { v2u w; w.x = pk2(r.v[j][0], r.v[j][1]); w.y = pk2(r.v[j][2], r.v[j][3]); ((v2u*)p)[lane + 64 * j] = w; }
}
__device__ __forceinline__ float row_rinv(const RowV& r) {
    float s = 0.f;
#pragma unroll
    for (int j = 0; j < 4; ++j) s += (r.v[j][0] * r.v[j][0] + r.v[j][1] * r.v[j][1]) + (r.v[j][2] * r.v[j][2] + r.v[j][3] * r.v[j][3]);
    s = wave_sum(s);
    return 1.0f / sqrtf(s * (1.0f / 1024.0f) + 1e-6f);
}
__device__ __forceinline__ void norm_mod(RowV& h, const RowV& x, const float* g, const float* sc, const float* sh, int lane) {
    const float ri = row_rinv(x);
#pragma unroll
    for (int j = 0; j < 4; ++j) { const f32x4 gv = ((const f32x4*)g)[lane + 64 * j], scv = ((const f32x4*)sc)[lane + 64 * j], shv = ((const f32x4*)sh)[lane + 64 * j];
        h.v[j] = (x.v[j] * ri) * gv * (scv + 1.0f) + shv; }
}
__device__ __forceinline__ void resid_add(RowV& x, const RowV& m, const float* g, const float* gt, int lane) {
    const float ri = row_rinv(m);
#pragma unroll
    for (int j = 0; j < 4; ++j) { const f32x4 gv = ((const f32x4*)g)[lane + 64 * j], gtv = ((const f32x4*)gt)[lane + 64 * j];
        x.v[j] = x.v[j] + gtv * ((m.v[j] * ri) * gv); }
}

__device__ __forceinline__ float rope_inv(int jj) {
    const float t[16] = {1.0f, 0.5623413324356079f, 0.3162277638912201f, 0.17782793939113617f, 0.10000000149011612f, 0.05623412877321243f, 0.03162277862429619f, 0.017782794311642647f,
                         0.009999999776482582f, 0.005623413249850273f, 0.003162277862429619f, 0.0017782794311642647f, 0.0010000000474974513f, 0.000562341301701963f, 0.0003162277862429619f, 0.00017782794020604342f};
    float r = t[0];
#pragma unroll
    for (int i = 1; i < 16; ++i) r = (jj == i) ? t[i] : r;
    return r;
}
__device__ __forceinline__ void ph_prologue(const Args& a, const Ids& id, LAS unsigned char* lds) {
    float* MOD = (float*)(a.ws + id.z + WS_MOD);
    for (int it = id.gw; it < 4 * 96; it += id.ngw) {
        const int i = it / 96, n = (it % 96) * 64 + id.lane;
        float acc[5];
#pragma unroll
        for (int c = 0; c < 5; ++c) acc[c] = 0.f;
        const float* W = a.in[9 + id.z] + (size_t)i * 1024 * 6144 + n;
#pragma unroll 1
        for (int k0 = 0; k0 < 1024; k0 += 64) {
            float sv[5];
#pragma unroll
            for (int c = 0; c < 5; ++c) { const float x = (c < 4) ? a.in[2 + id.z][c * 1024 + k0 + id.lane] : a.in[8 + id.z][k0 + id.lane]; sv[c] = x / (1.0f + __expf(-x)); }
#pragma unroll 8
            for (int kk = 0; kk < 64; ++kk) { const float w = W[(size_t)(k0 + kk) * 6144];
#pragma unroll
                for (int c = 0; c < 5; ++c) acc[c] += w * __shfl(sv[c], kk); }
        }
        const float bias = a.in[10 + id.z][i * 6144 + n];
#pragma unroll
        for (int c = 0; c < 5; ++c) MOD[(size_t)(c * 4 + i) * 6144 + n] = acc[c] + bias;
    }
    { float* RC = (float*)(a.ws + id.z + WS_ROPE); float* RS = RC + 2048 * 64;
      for (int e = id.gw * 64 + id.lane; e < 2048 * 64; e += id.ngw * 64) { const int t = e >> 6, d = e & 63; const int pos = (d < 32) ? (t >> 6) : (t & 63);
          const float ang = (float)pos * rope_inv(d & 15); RC[e] = __cosf(ang); RS[e] = __sinf(ang); } }
    { const f32x4* s0 = (const f32x4*)a.in[0 + id.z]; const f32x4* s1 = (const f32x4*)a.in[1 + id.z]; f32x4* dst = (f32x4*)(a.out + id.z + O_X); const int n4 = NPR * D / 4;
      for (int e = id.gw * 64 + id.lane; e < n4; e += id.ngw * 64) { dst[e] = s0[e]; dst[n4 + e] = s1[e]; } }
    conv_weights(a, id, lds, 0);
}

__device__ __forceinline__ void ph_norm0(const Args& a, const Ids& id) {
    bf16* H = (bf16*)(a.ws + id.z + A_H); const float* g0 = a.in[11 + id.z] + (size_t)(0 * 4 + 0) * D;
    for (int m = id.gw; m < NTOK; m += id.ngw) { RowV x, h; ld_row(x, a.out + id.z + O_X + (size_t)m * D, id.lane); const float* md = mod_ptr_(a, id, cond_of(m), 0);
        norm_mod(h, x, g0, md + 1024, md + 0, id.lane); st_row_bf16(h, H + (size_t)m * D, id.lane); }
}
__device__ __forceinline__ void ph_resid_norm(const Args& a, const Ids& id, int layer) {
    bf16* H = (bf16*)(a.ws + id.z + A_H); const float* M = (const float*)(a.ws + id.z + A_M); const float* g1 = a.in[11 + id.z] + (size_t)(layer * 4 + 1) * D; const float* g2 = a.in[11 + id.z] + (size_t)(layer * 4 + 2) * D;
    for (int m = id.gw; m < NTOK; m += id.ngw) { RowV x, mm, h; float* xp = a.out + id.z + O_X + (size_t)m * D; ld_row(x, xp, id.lane); ld_row(mm, M + (size_t)m * D, id.lane);
        const float* md = mod_ptr_(a, id, cond_of(m), layer);
        resid_add(x, mm, g1, md + 2048, id.lane); st_row(x, xp, id.lane);
        norm_mod(h, x, g2, md + 4096, md + 3072, id.lane); st_row_bf16(h, H + (size_t)m * D, id.lane); }
}
__device__ __forceinline__ void ph_resid_end(const Args& a, const Ids& id, LAS unsigned char* lds, int layer) {
    bf16* H = (bf16*)(a.ws + id.z + A_H); const float* F = (const float*)(a.ws + id.z + A_F); const float* g3 = a.in[11 + id.z] + (size_t)(layer * 4 + 3) * D;
    const bool next_attn = (layer + 1 < DEPTH) && (((layer + 1) & 1) == 0);
    const float* g0n = a.in[11 + id.z] + (size_t)((layer + 1) * 4 + 0) * D;
    for (int m = id.gw; m < NTOK; m += id.ngw) { RowV x, ff; float* xp = a.out + id.z + O_X + (size_t)m * D; ld_row(x, xp, id.lane); ld_row(ff, F + (size_t)m * D, id.lane);
        const float* md = mod_ptr_(a, id, cond_of(m), layer);
        resid_add(x, ff, g3, md + 5120, id.lane); st_row(x, xp, id.lane);
        if (next_attn) { RowV h; const float* mdn = mod_ptr_(a, id, cond_of(m), layer + 1); norm_mod(h, x, g0n, mdn + 1024, mdn + 0, id.lane); st_row_bf16(h, H + (size_t)m * D, id.lane); } }
    if (layer + 1 < DEPTH) conv_weights(a, id, lds, layer + 1);
}
__device__ __forceinline__ void ph_rw_mix(const Args& a, const Ids& id, int layer) {
    bf16* A2 = (bf16*)(a.ws + id.z + A_A2); const float* g0 = a.in[11 + id.z] + (size_t)(layer * 4 + 0) * D;
    for (int m = id.gw; m < NTOK; m += id.ngw) {
        const int t = (m < NPR) ? (m & (TP - 1)) : ((m - NPR) & (TS - 1)); const int T = (m < NPR) ? TP : TS;
        const float* md = mod_ptr_(a, id, cond_of(m), layer); const float* xp = a.out + id.z + O_X + (size_t)m * D;
        RowV x, hc, hs, xx; ld_row(x, xp, id.lane); norm_mod(hc, x, g0, md + 1024, md + 0, id.lane);
#pragma unroll
        for (int j = 0; j < 4; ++j) hs.v[j] = (f32x4){0.f, 0.f, 0.f, 0.f};
        if (t > 0) { RowV xn, hn; ld_row(xn, xp - D, id.lane); norm_mod(hn, xn, g0, md + 1024, md + 0, id.lane);
#pragma unroll
            for (int j = 0; j < 4; ++j) hs.v[j] += hn.v[j]; }
        if (t < T - 1) { RowV xn, hn; ld_row(xn, xp + D, id.lane); norm_mod(hn, xn, g0, md + 1024, md + 0, id.lane);
#pragma unroll
            for (int j = 0; j < 4; ++j) hs.v[j] += hn.v[j]; }
#pragma unroll
        for (int j = 0; j < 4; ++j) xx.v[j] = hs.v[j] * 0.5f - hc.v[j];
        st_row_bf16(hc, A2 + (size_t)m * KRKV, id.lane); st_row_bf16(xx, A2 + (size_t)m * KRKV + D, id.lane);
    }
}

__device__ __forceinline__ void ph_att_post(const Args& a, const Ids& id, int layer) {
    const int j = layer >> 1, lane = id.lane;
    const float* RAW = (const float*)(a.ws + id.z + A_QKVRAW);
    bf16 *QA = (bf16*)(a.ws + id.z + A_QA), *QB = (bf16*)(a.ws + id.z + A_QB), *KAP = (bf16*)(a.ws + id.z + A_KAP), *VAP = (bf16*)(a.ws + id.z + A_VAP), *KBP = (bf16*)(a.ws + id.z + A_KBP), *VBP = (bf16*)(a.ws + id.z + A_VBP);
    bf16 *KAS = (bf16*)(a.ws + id.z + A_KAS), *VAS = (bf16*)(a.ws + id.z + A_VAS), *KBS = (bf16*)(a.ws + id.z + A_KBS), *VBS = (bf16*)(a.ws + id.z + A_VBS);
    const float* RC = (const float*)(a.ws + id.z + WS_ROPE); const float* RS = RC + 2048 * 64;
    const float gq = a.in[14 + id.z][j * 128 + lane], gk = a.in[14 + id.z][j * 128 + 64 + lane];
    for (int it = id.gw; it < NTOK + 4 * PAST; it += id.ngw) {
        if (it < NTOK) {
            const int m = it; const bool smp = m >= NPR; const int b = smp ? ((m - NPR) >> 11) : (m >> 8), t = smp ? ((m - NPR) & (TS - 1)) : (m & (TP - 1));
            const float* raw = RAW + (size_t)m * NQKV;
            float cs = 1.f, sn = 0.f; if (smp) { cs = RC[t * 64 + lane]; sn = RS[t * 64 + lane]; }
            const size_t srow = (size_t)(b * SKV + PAST + t);
            const size_t prow = (size_t)((b * 2 + j) * TP + t);
#pragma unroll 1
            for (int ch = 0; ch < 36; ++ch) {
                float v = raw[ch * 64 + lane];
                const bool isq = (ch < 8) || (ch >= 12 && ch < 20), isk = (ch == 8 || ch == 9) || (ch >= 20 && ch < 28);
                if (ch < 10) { const float ss = wave_sum(v * v); v = v * (1.0f / sqrtf(ss * (1.0f / 64.0f) + 1e-6f)) * (ch < 8 ? gq : gk); }
                float vr = v;
                if (smp && (isq || isk)) { const float p = __shfl_xor(v, 16); const float rot = (lane & 16) ? p : -p; vr = v * cs + rot * sn; }
                if (ch < 8) QA[(size_t)m * 512 + ch * 64 + lane] = (bf16)f2bf(vr * 0.125f);
                else if (ch < 10) { const int e = (ch - 8) * 64 + lane; if (!smp) { (a.out + id.z)[O_KG + prow * 128 + e] = v; KAP[(size_t)m * 128 + e] = (bf16)f2bf(v); } else KAS[srow * 128 + e] = (bf16)f2bf(vr); }
                else if (ch < 12) { const int e = (ch - 10) * 64 + lane; if (!smp) { (a.out + id.z)[O_VG + prow * 128 + e] = v; VAP[(size_t)m * 128 + e] = (bf16)f2bf(v); } else VAS[srow * 128 + e] = (bf16)f2bf(v); }
                else if (ch < 20) QB[(size_t)m * 512 + (ch - 12) * 64 + lane] = (bf16)f2bf(vr * 0.125f);
                else if (ch < 28) { const int e = (ch - 20) * 64 + lane; if (!smp) { (a.out + id.z)[O_KD + prow * 512 + e] = v; KBP[(size_t)m * 512 + e] = (bf16)f2bf(v); } else KBS[srow * 512 + e] = (bf16)f2bf(vr); }
                else { const int e = (ch - 28) * 64 + lane; if (!smp) { (a.out + id.z)[O_VD + prow * 512 + e] = v; VBP[(size_t)m * 512 + e] = (bf16)f2bf(v); } else VBS[srow * 512 + e] = (bf16)f2bf(v); }
            }
        } else {
            const int r = it - NTOK, b = r >> 9, pos = r & (PAST - 1);
            const size_t src = (size_t)((b * 2 + j) * PAST + pos), dst = (size_t)(b * SKV + pos);
#pragma unroll
            for (int q = 0; q < 2; ++q) { const int e = lane + 64 * q; KAS[dst * 128 + e] = (bf16)f2bf(a.in[3 + id.z][src * 128 + e]); VAS[dst * 128 + e] = (bf16)f2bf(a.in[4 + id.z][src * 128 + e]); }
#pragma unroll
            for (int q = 0; q < 8; ++q) { const int e = lane + 64 * q; KBS[dst * 512 + e] = (bf16)f2bf(a.in[5 + id.z][src * 512 + e]); VBS[dst * 512 + e] = (bf16)f2bf(a.in[6 + id.z][src * 512 + e]); }
        }
    }
}

__device__ __forceinline__ void ph_attn_simple(const Args& a, const Ids& id) {
    const bf16 *QA = (const bf16*)(a.ws + id.z + A_QA), *QB = (const bf16*)(a.ws + id.z + A_QB), *KAP = (const bf16*)(a.ws + id.z + A_KAP), *VAP = (const bf16*)(a.ws + id.z + A_VAP), *KBP = (const bf16*)(a.ws + id.z + A_KBP), *VBP = (const bf16*)(a.ws + id.z + A_VBP);
    const bf16 *KAS = (const bf16*)(a.ws + id.z + A_KAS), *VAS = (const bf16*)(a.ws + id.z + A_VAS), *KBS = (const bf16*)(a.ws + id.z + A_KBS), *VBS = (const bf16*)(a.ws + id.z + A_VBS);
    bf16* H = (bf16*)(a.ws + id.z + A_H); float* DT = (float*)(a.ws + id.z + A_DT);
    int zoff; asm volatile("v_mov_b32 %0, 0" : "=v"(zoff));
    for (int u = blockIdx.x; u < 64 * 12; u += gridDim.x) {
        const int tb = u / 12, pr = u % 12;
        const int vh = 2 * pr + (id.wave >> 2);
        const int m = tb * 256 + (id.tid & 255);
        const bool smp = tb >= 32; const int b = smp ? ((tb - 32) >> 3) : tb;
        const int S = smp ? SKV : TP;
        const bf16 *qp, *Kb, *Vb; int ldk;
        if (vh < 8) { qp = QA + (size_t)m * 512 + vh * 64; const int kvh = vh >> 2; ldk = 128;
            Kb = (smp ? KAS + (size_t)b * SKV * 128 : KAP + (size_t)b * TP * 128) + kvh * 64; Vb = (smp ? VAS + (size_t)b * SKV * 128 : VAP + (size_t)b * TP * 128) + kvh * 64; }
        else { const int idx = vh - 8, hd = idx >> 2, c = (idx >> 1) & 1, hf = idx & 1; qp = QB + (size_t)m * 512 + (hd * 2 + c) * 64; ldk = 512;
            Kb = (smp ? KBS + (size_t)b * SKV * 512 : KBP + (size_t)b * TP * 512) + (hd * 2 + c) * 64; Vb = (smp ? VBS + (size_t)b * SKV * 512 : VBP + (size_t)b * TP * 512) + hd * 128 + hf * 64; }
        float q[64], o[64];
#pragma unroll
        for (int c8 = 0; c8 < 8; ++c8) { const v4u w = ((const v4u*)qp)[c8];
            q[8 * c8 + 0] = bflo(w.x); q[8 * c8 + 1] = bfhi(w.x); q[8 * c8 + 2] = bflo(w.y); q[8 * c8 + 3] = bfhi(w.y); q[8 * c8 + 4] = bflo(w.z); q[8 * c8 + 5] = bfhi(w.z); q[8 * c8 + 6] = bflo(w.w); q[8 * c8 + 7] = bfhi(w.w); }
#pragma unroll
        for (int d = 0; d < 64; ++d) o[d] = 0.f;
        float mrun = -1e30f, l = 0.f;
#pragma unroll 1
        for (int key = 0; key < S; ++key) {
            const v4u* kp = (const v4u*)(Kb + (size_t)key * ldk + zoff); const v4u* vp = (const v4u*)(Vb + (size_t)key * ldk + zoff);
            float s = 0.f;
#pragma unroll
            for (int c8 = 0; c8 < 8; ++c8) { const v4u w = kp[c8];
                s += q[8 * c8 + 0] * bflo(w.x) + q[8 * c8 + 1] * bfhi(w.x) + q[8 * c8 + 2] * bflo(w.y) + q[8 * c8 + 3] * bfhi(w.y) + q[8 * c8 + 4] * bflo(w.z) + q[8 * c8 + 5] * bfhi(w.z) + q[8 * c8 + 6] * bflo(w.w) + q[8 * c8 + 7] * bfhi(w.w); }
            s *= 1.4426950408889634f;
            const float mn = fmaxf(mrun, s); const float al = exp2f(mrun - mn), p = exp2f(s - mn); mrun = mn; l = l * al + p;
#pragma unroll
            for (int c8 = 0; c8 < 8; ++c8) { const v4u w = vp[c8];
                o[8 * c8 + 0] = o[8 * c8 + 0] * al + p * bflo(w.x); o[8 * c8 + 1] = o[8 * c8 + 1] * al + p * bfhi(w.x); o[8 * c8 + 2] = o[8 * c8 + 2] * al + p * bflo(w.y); o[8 * c8 + 3] = o[8 * c8 + 3] * al + p * bfhi(w.y);
                o[8 * c8 + 4] = o[8 * c8 + 4] * al + p * bflo(w.z); o[8 * c8 + 5] = o[8 * c8 + 5] * al + p * bfhi(w.z); o[8 * c8 + 6] = o[8 * c8 + 6] * al + p * bflo(w.w); o[8 * c8 + 7] = o[8 * c8 + 7] * al + p * bfhi(w.w); }
        }
        const float il = 1.0f / l;
        if (vh < 8) { v4u* dst = (v4u*)(H + (size_t)m * D + vh * 64);
#pragma unroll
            for (int c8 = 0; c8 < 8; ++c8) { v4u w; w.x = pk2(o[8 * c8 + 0] * il, o[8 * c8 + 1] * il); w.y = pk2(o[8 * c8 + 2] * il, o[8 * c8 + 3] * il); w.z = pk2(o[8 * c8 + 4] * il, o[8 * c8 + 5] * il); w.w = pk2(o[8 * c8 + 6] * il, o[8 * c8 + 7] * il); dst[c8] = w; } }
        else { f32x4* dst = (f32x4*)(DT + (size_t)m * D + (vh - 8) * 64);
#pragma unroll
            for (int c4 = 0; c4 < 16; ++c4) dst[c4] = (f32x4){o[4 * c4 + 0] * il, o[4 * c4 + 1] * il, o[4 * c4 + 2] * il, o[4 * c4 + 3] * il}; }
    }
}
__device__ __forceinline__ void ph_att_comb(const Args& a, const Ids& id, int layer) {
    const int j = layer >> 1, lane = id.lane; const float lam_init = (layer == 0) ? 0.2f : 0.4707130183435842f;
    const float* lf = a.in[15 + id.z] + j * 256; const float* sg = a.in[16 + id.z] + j * 128;
    const float s01 = wave_sum(lf[lane] * lf[64 + lane]), s23 = wave_sum(lf[128 + lane] * lf[192 + lane]);
    const float lam = expf(s01) - expf(s23) + lam_init;
    const float* DT = (const float*)(a.ws + id.z + A_DT); bf16* H = (bf16*)(a.ws + id.z + A_H);
    const float g0 = sg[lane] * (1.0f - lam_init), g1 = sg[64 + lane] * (1.0f - lam_init);
    for (int it = id.gw; it < NTOK * 4; it += id.ngw) { const int m = it >> 2, hd = it & 3; const float* p = DT + (size_t)m * D + hd * 256;
        const float v0 = p[lane] - lam * p[128 + lane], v1 = p[64 + lane] - lam * p[192 + lane];
        const float ss = wave_sum(v0 * v0 + v1 * v1); const float ri = 1.0f / sqrtf(ss * (1.0f / 128.0f) + 1e-6f);
        bf16* o = H + (size_t)m * D + 512 + hd * 128; o[lane] = (bf16)f2bf(v0 * ri * g0); o[64 + lane] = (bf16)f2bf(v1 * ri * g1); }
}

__device__ __forceinline__ void ph_rw_prep(const Args& a, const Ids& id, int layer) {
    const int j = layer >> 1, lane = id.lane;
    const bf16* L1 = (const bf16*)(a.ws + id.z + A_L1); const bf16* RKV = (const bf16*)(a.ws + id.z + A_RKV);
    bf16 *A0 = (bf16*)(a.ws + id.z + A_A0), *A1 = (bf16*)(a.ws + id.z + A_A1), *EW0 = (bf16*)(a.ws + id.z + A_EW0), *EW1 = (bf16*)(a.ws + id.z + A_EW1);
    float* INV = (float*)(a.ws + id.z + WS_INV); float* Y = (float*)(a.ws + id.z + A_Y);
    const float* w2 = a.in[22 + id.z] + (size_t)j * 2 * 64 * D; const float* a2 = a.in[25 + id.z] + (size_t)j * 2 * 64 * D;
    const float* w0 = a.in[20 + id.z] + (size_t)j * 2 * D; const float* a0 = a.in[23 + id.z] + (size_t)j * 2 * D; const float* kk_c = a.in[28 + id.z] + (size_t)(j * 3 + 0) * D;
    for (int it = id.gw; it < (NTOK / 4) * 4; it += id.ngw) {
        const int tg = it >> 2, q = it & 3, m0 = tg * 4, c0 = q * 256 + 4 * lane;
        float T0[4], T1[4], R0[4], R1[4];
#pragma unroll
        for (int tt = 0; tt < 4; ++tt) { const bf16* l = L1 + (size_t)(m0 + tt) * 512; T0[tt] = tanhf(bf2f(l[lane])); T1[tt] = tanhf(bf2f(l[64 + lane])); R0[tt] = bf2f(l[128 + lane]); R1[tt] = bf2f(l[192 + lane]); }
        f32x4 d0[4], d1[4], e0[4], e1[4];
#pragma unroll
        for (int tt = 0; tt < 4; ++tt) { d0[tt] = (f32x4){0.f, 0.f, 0.f, 0.f}; d1[tt] = d0[tt]; e0[tt] = d0[tt]; e1[tt] = d0[tt]; }
#pragma unroll 2
        for (int i = 0; i < 64; ++i) {
            const f32x4 wv0 = *(const f32x4*)(w2 + (size_t)i * D + c0), wv1 = *(const f32x4*)(w2 + (size_t)(64 + i) * D + c0), av0 = *(const f32x4*)(a2 + (size_t)i * D + c0), av1 = *(const f32x4*)(a2 + (size_t)(64 + i) * D + c0);
#pragma unroll
            for (int tt = 0; tt < 4; ++tt) { d0[tt] += wv0 * __shfl(T0[tt], i); d1[tt] += wv1 * __shfl(T1[tt], i); e0[tt] += av0 * __shfl(R0[tt], i); e1[tt] += av1 * __shfl(R1[tt], i); }
        }
        const f32x4 w00 = *(const f32x4*)(w0 + c0), w01 = *(const f32x4*)(w0 + D + c0), a00 = *(const f32x4*)(a0 + c0), a01 = *(const f32x4*)(a0 + D + c0);
#pragma unroll
        for (int tt = 0; tt < 4; ++tt) { const size_t off = (size_t)(m0 + tt) * D + c0; float x0[4], x1[4], y0[4], y1[4];
#pragma unroll
            for (int e = 0; e < 4; ++e) { x0[e] = 0.8750387749719753f * sigmoidf_(w00[e] + d0[tt][e]); x1[e] = 0.8750387749719753f * sigmoidf_(w01[e] + d1[tt][e]);
                y0[e] = sigmoidf_(a00[e] + e0[tt][e]); y1[e] = sigmoidf_(a01[e] + e1[tt][e]); }
            *(v2u*)(EW0 + off) = (v2u){pk2(x0[0], x0[1]), pk2(x0[2], x0[3])}; *(v2u*)(EW1 + off) = (v2u){pk2(x1[0], x1[1]), pk2(x1[2], x1[3])};
            *(v2u*)(A0 + off) = (v2u){pk2(y0[0], y0[1]), pk2(y0[2], y0[3])}; *(v2u*)(A1 + off) = (v2u){pk2(y1[0], y1[1]), pk2(y1[2], y1[3])}; }
    }
    for (int m = id.gw; m < NTOK; m += id.ngw) {
#pragma unroll 4
        for (int h = 0; h < 16; ++h) { const float kv = bf2f(RKV[(size_t)m * 3072 + 1024 + h * 64 + lane]) * kk_c[h * 64 + lane]; const float ss = wave_sum(kv * kv); if (lane == 0) INV[m * 16 + h] = 1.0f / sqrtf(ss + 1e-12f); }
        f32x4* yp = (f32x4*)(Y + (size_t)m * D);
#pragma unroll
        for (int q = 0; q < 4; ++q) yp[lane + 64 * q] = (f32x4){0.f, 0.f, 0.f, 0.f};
    }
}

struct ScanIn { float r, k, v, a, ew, inv; };
__device__ __forceinline__ void scan_load(ScanIn& s, const bf16* RKV, const bf16* Ad, const bf16* EWd, const float* INV, int m, int h, int lane) {
    const size_t o = (size_t)m * 3072 + h * 64 + lane;
    s.r = bf2f(RKV[o]); s.k = bf2f(RKV[o + 1024]); s.v = bf2f(RKV[o + 2048]);
    s.a = bf2f(Ad[(size_t)m * D + h * 64 + lane]); s.ew = bf2f(EWd[(size_t)m * D + h * 64 + lane]); s.inv = INV[m * 16 + h];
}
__device__ __forceinline__ void ph_rw_scan_simple(const Args& a, const Ids& id, int layer) {
    const int j = layer >> 1, lane = id.lane;
    const bf16* RKV = (const bf16*)(a.ws + id.z + A_RKV); const float* INV = (const float*)(a.ws + id.z + WS_INV); float* Y = (float*)(a.ws + id.z + A_Y);
    for (int ci = id.gw; ci < 2048; ci += id.ngw) {
        int ch; if ((ci & 15) == 0) ch = ci >> 4; else { const int idx = ci - (ci >> 4) - 1; if (idx >= 1024) continue; ch = 128 + idx; }
        const bool smp = ch < 128; int b, h, dir, T, mbase;
        if (smp) { b = ch >> 5; h = (ch >> 1) & 15; dir = ch & 1; T = TS; mbase = NPR + b * TS; } else { const int c2 = ch - 128; b = c2 >> 5; h = (c2 >> 1) & 15; dir = c2 & 1; T = TP; mbase = b * TP; }
        const bf16* Ad = (const bf16*)(a.ws + id.z + (dir ? A_A1 : A_A0)); const bf16* EWd = (const bf16*)(a.ws + id.z + (dir ? A_EW1 : A_EW0));
        const float kkc = a.in[28 + id.z][(size_t)(j * 3 + 0) * D + h * 64 + lane], kac = a.in[28 + id.z][(size_t)(j * 3 + 1) * D + h * 64 + lane];
        float S[64];
        if (smp) { const f32x4* sp = (const f32x4*)(a.in[7 + id.z] + ((((size_t)(b * 2 + j) * 2 + dir) * 16 + h) * 64 + lane) * 64);
#pragma unroll
            for (int q = 0; q < 16; ++q) { const f32x4 t4 = sp[q]; S[4 * q] = t4[0]; S[4 * q + 1] = t4[1]; S[4 * q + 2] = t4[2]; S[4 * q + 3] = t4[3]; } }
        else {
#pragma unroll
            for (int k = 0; k < 64; ++k) S[k] = 0.f; }
        const int tstep = dir ? -1 : 1; int t = dir ? T - 1 : 0;
        ScanIn cur, nxt; scan_load(cur, RKV, Ad, EWd, INV, mbase + t, h, lane);
#pragma unroll 1
        for (int st = 0; st < T; ++st) {
            const int tn = t + tstep; const int tl = (st + 1 < T) ? tn : t;
            scan_load(nxt, RKV, Ad, EWd, INV, mbase + tl, h, lane);
            const float w = exp2f(-cur.ew), kd = cur.k * (1.0f + (cur.a - 1.0f) * kac), kk = cur.k * kkc * cur.inv, kka = kk * cur.a;
            float sk = 0.f;
#pragma unroll
            for (int k = 0; k < 64; ++k) sk += S[k] * rdl(kk, k);
            float y = 0.f;
#pragma unroll
            for (int k = 0; k < 64; ++k) { S[k] = S[k] * rdl(w, k) - sk * rdl(kka, k) + cur.v * rdl(kd, k); y += S[k] * rdl(cur.r, k); }
            atomicAdd(&Y[(size_t)(mbase + t) * D + h * 64 + lane], y);
            cur = nxt; t = tn;
        }
        if (!smp) { f32x4* dp = (f32x4*)(a.out + id.z + O_ST + ((((size_t)(b * 2 + j) * 2 + dir) * 16 + h) * 64 + lane) * 64);
#pragma unroll
            for (int q = 0; q < 16; ++q) dp[q] = (f32x4){S[4 * q], S[4 * q + 1], S[4 * q + 2], S[4 * q + 3]}; }
    }
}
__device__ __forceinline__ void ph_rw_post(const Args& a, const Ids& id, int layer) {
    const int j = layer >> 1, lane = id.lane;
    const bf16* RKV = (const bf16*)(a.ws + id.z + A_RKV); const bf16* L1 = (const bf16*)(a.ws + id.z + A_L1); const float* Y = (const float*)(a.ws + id.z + A_Y);
    const bf16 *A0 = (const bf16*)(a.ws + id.z + A_A0), *A1 = (const bf16*)(a.ws + id.z + A_A1); bf16* H = (bf16*)(a.ws + id.z + A_H);
    const float* g2 = a.in[27 + id.z] + (size_t)j * 128 * D; const float* kvec = a.in[28 + id.z] + (size_t)j * 3 * D; const float* lnx = a.in[29 + id.z] + (size_t)j * 2 * D;
    for (int m = id.gw; m < NTOK; m += id.ngw) {
        const float sg0 = sigmoidf_(bf2f(L1[(size_t)m * 512 + 256 + lane])), sg1 = sigmoidf_(bf2f(L1[(size_t)m * 512 + 320 + lane]));
#pragma unroll 1
        for (int h = 0; h < 16; ++h) {
            const int c = h * 64 + lane;
            float g = 0.f;
#pragma unroll 8
            for (int i = 0; i < 64; ++i) g += __shfl(sg0, i) * g2[(size_t)i * D + c] + __shfl(sg1, i) * g2[(size_t)(64 + i) * D + c];
            const float y = Y[(size_t)m * D + c]; const float mean = wave_sum(y) * (1.0f / 64.0f); const float dv = y - mean; const float var = wave_sum(dv * dv) * (1.0f / 64.0f);
            float yn = dv * (1.0f / sqrtf(var + 64e-5f)); yn = yn * lnx[c] + lnx[D + c];
            const size_t o = (size_t)m * 3072 + c; const float r = bf2f(RKV[o]), k = bf2f(RKV[o + 1024]), v = bf2f(RKV[o + 2048]);
            const float a0 = bf2f(A0[(size_t)m * D + c]), a1 = bf2f(A1[(size_t)m * D + c]); const float ka = kvec[D + c], rk = kvec[2 * D + c];
            const float kds = k * (1.0f + (a0 - 1.0f) * ka) + k * (1.0f + (a1 - 1.0f) * ka);
            const float bs = wave_sum(r * kds * rk);
            H[(size_t)m * D + c] = (bf16)f2bf((yn + bs * v) * g);
        }
    }
}

enum Kind { K_PRO = 0, K_NORM0 = 1, K_QKV = 2, K_APOST = 3, K_ATTN = 4, K_ACOMB = 5, K_MIXOUT = 6, K_RNORM = 7, K_MLP1 = 8, K_MLP2 = 9, K_REND = 10,
            K_RMIX = 11, K_RKV = 12, K_RPREP = 13, K_RSCAN = 14, K_RPOST = 15 };
constexpr int NPH = 40;
__host__ __device__ __forceinline__ void decode_phase(int ph, int& kind, int& layer) {
    if (ph < 2) { kind = ph; layer = 0; return; }
    const int p = ph - 2, pair = p / 19, q = p % 19;
    if (q < 9) { layer = 2 * pair; kind = K_QKV + q; }
    else { layer = 2 * pair + 1; const int q2 = q - 9; kind = (q2 < 5) ? (K_RMIX + q2) : (K_MIXOUT + (q2 - 5)); }
}

__global__ void __launch_bounds__(NWAVES * 64, 2) mega_fwd(Args a) {
    extern __shared__ __attribute__((aligned(16))) unsigned char lds_raw[];
    LAS unsigned char* lds = (LAS unsigned char*)lds_raw;
    const int G = gridDim.x, bx = blockIdx.x; const int vcu = (G % 8 == 0) ? (bx % 8) * (G / 8) + bx / 8 : bx;
    Ids id0; id0.tid = threadIdx.x; id0.z = 0;
    volatile LAS unsigned* MISC = (volatile LAS unsigned*)(lds + MISC_OFF);
    for (int u = id0.tid; u < (LDS_BYTES - LDSCTL_OFF) / 4; u += NWAVES * 64) ((LAS unsigned*)(lds + LDSCTL_OFF))[u] = 0u;
    __syncthreads();
#if MK_N_LAUNCHES == 1 && !MK_CG_BARRIER
    XcdBarrier bar = xcd_barrier_post((unsigned*)(a.ws + id.z + WS_CTL) + CW_BAR, MISC + 8);
#endif
    (void)MISC;
    int nsync = 0;
    for (int ph = a.ph_lo; ph < a.ph_hi; ++ph) {
        int kind, layer; decode_phase(ph, kind, layer);
        Ids id; { int tv = threadIdx.x; asm volatile("" : "+v"(tv)); int zz; asm volatile("s_mov_b32 %0, 0" : "=s"(zz)); id.tid = tv; id.z = zz; }
        id.lane = id.tid & 63; id.wave = __builtin_amdgcn_readfirstlane(id.tid >> 6); id.gw = vcu * NWAVES + id.wave; id.ngw = G * NWAVES;
        if (kind == K_PRO) ph_prologue(a, id, lds);
        else if (kind == K_NORM0) ph_norm0(a, id);
        else if (kind == K_QKV || kind == K_MIXOUT || kind == K_MLP2) {
            const bf16* A; const bf16* Bt; float* C; int N, K;
            if (kind == K_QKV) { A = (const bf16*)(a.ws + id.z + A_H); Bt = (const bf16*)(a.ws + id.z + W_WINT); C = (float*)(a.ws + id.z + A_QKVRAW); N = NQKV; K = D; }
            else if (kind == K_MIXOUT) { A = (const bf16*)(a.ws + id.z + A_H); Bt = (const bf16*)(a.ws + id.z + ((layer & 1) ? W_WOT : W_WOUTT)); C = (float*)(a.ws + id.z + A_M); N = D; K = D; }
            else { A = (const bf16*)(a.ws + id.z + A_HID); Bt = (const bf16*)(a.ws + id.z + W_W2T); C = (float*)(a.ws + id.z + A_F); N = D; K = FF; }
            pg8::Gemm g{A, Bt, NTOK, N, K}; pg8::StaticOrder S; S.init(NTOK, N, G, bx);
            pg8::EpiF32 E{C, N};
            pg8::gemm_phase<pg8::EpiF32, pg8::StaticOrder, true, true>(lds + RING_OFF, g, S, E);
        }
        else if (kind == K_MLP1) {
            pg8::Gemm g{(const bf16*)(a.ws + id.z + A_H), (const bf16*)(a.ws + id.z + W_W1T), NTOK, FF, D}; pg8::StaticOrder S; S.init(NTOK, FF, G, bx);
            pg8::EpiBf16<2> E{(bf16*)(a.ws + id.z + A_HID), FF, 1 << 20, nullptr, 0};
            pg8::gemm_phase<pg8::EpiBf16<2>, pg8::StaticOrder, true, true>(lds + RING_OFF, g, S, E);
        }
        else if (kind == K_RKV) {
            pg8::Gemm g{(const bf16*)(a.ws + id.z + A_A2), (const bf16*)(a.ws + id.z + W_BT1), NTOK, NRKV, KRKV}; pg8::StaticOrder S; S.init(NTOK, NRKV, G, bx);
            pg8::EpiBf16<0> E{(bf16*)(a.ws + id.z + A_RKV), 3072, 12, (bf16*)(a.ws + id.z + A_L1), 512};
            pg8::gemm_phase<pg8::EpiBf16<0>, pg8::StaticOrder, true, true>(lds + RING_OFF, g, S, E);
        }
        else if (kind == K_APOST) ph_att_post(a, id, layer);
        else if (kind == K_ATTN) ph_attn_simple(a, id);
        else if (kind == K_ACOMB) ph_att_comb(a, id, layer);
        else if (kind == K_RNORM) ph_resid_norm(a, id, layer);
        else if (kind == K_REND) ph_resid_end(a, id, lds, layer);
        else if (kind == K_RMIX) ph_rw_mix(a, id, layer);
        else if (kind == K_RPREP) ph_rw_prep(a, id, layer);
        else if (kind == K_RSCAN) ph_rw_scan_simple(a, id, layer);
        else if (kind == K_RPOST) ph_rw_post(a, id, layer);
        if (ph + 1 < a.ph_hi) {
#if MK_N_LAUNCHES == 1
#if MK_CG_BARRIER
            cg::this_grid().sync();
#else
            if (nsync == 0) cg::this_grid().sync(); else xcd_barrier(bar);
#endif
#endif
            ++nsync;
        }
    }
}

extern "C" void kernel_launch(void* const* d_in, const int* in_sizes, int n_in, void* d_out, int out_size, void* d_ws, size_t ws_size, hipStream_t stream) {
    static int grid = 0;
    if (grid == 0) {
        if (n_in != 32 || (size_t)out_size != OUT_TOTAL || ws_size < WS_END) { fprintf(stderr, "kernel_launch: unexpected problem (n_in %d, out %d, ws %zu; need ws >= %zu); nothing launched\n", n_in, out_size, ws_size, (size_t)WS_END); grid = -1; return; }
        int dev = 0, cus = 0, per_cu = 0;
        if (hipGetDevice(&dev) != hipSuccess || hipDeviceGetAttribute(&cus, hipDeviceAttributeMultiprocessorCount, dev) != hipSuccess) { grid = -1; return; }
        if (hipFuncSetAttribute((const void*)mega_fwd, hipFuncAttributeMaxDynamicSharedMemorySize, LDS_BYTES) != hipSuccess) { fprintf(stderr, "kernel_launch: hipFuncSetAttribute failed\n"); grid = -1; return; }
        if (hipOccupancyMaxActiveBlocksPerMultiprocessor(&per_cu, (const void*)mega_fwd, NWAVES * 64, LDS_BYTES) != hipSuccess || per_cu < 1) { fprintf(stderr, "kernel_launch: occupancy query failed (%d)\n", per_cu); (void)hipGetLastError(); per_cu = 1; }
        grid = cus * (per_cu < 1 ? 1 : 1);
        fprintf(stderr, "kernel_launch: %d CUs, occupancy %d/CU, grid %d\n", cus, per_cu, grid);
    }
    if (grid < 0) return;
    (void)in_sizes;
    if (hipMemsetAsync((char*)d_ws + WS_CTL, 0, CTL_ZERO_BYTES, stream) != hipSuccess) { fprintf(stderr, "kernel_launch: memset failed\n"); return; }
    Args a{};
    for (int i = 0; i < 32; ++i) a.in[i] = (const float*)d_in[i];
    a.out = (float*)d_out; a.ws = (unsigned char*)d_ws;
#if MK_N_LAUNCHES == 1
    a.ph_lo = 0; a.ph_hi = NPH;
    void* args[] = {&a};
    hipError_t e = hipLaunchCooperativeKernel((const void*)mega_fwd, dim3(grid), dim3(NWAVES * 64), args, LDS_BYTES, stream);
    if (e != hipSuccess) fprintf(stderr, "kernel_launch: cooperative launch failed: %s (grid %d)\n", hipGetErrorString(e), grid);
#else
    for (int ph = 0; ph < NPH; ++ph) {
        a.ph_lo = ph; a.ph_hi = ph + 1;
        hipLaunchKernelGGL(mega_fwd, dim3(grid), dim3(NWAVES * 64), LDS_BYTES, stream, a);
    }
#endif
}
```

```cpp
#include <hip/hip_runtime.h>
#include <hip/hip_cooperative_groups.h>
#include <cstdio>
#include <cstdint>
namespace cg = cooperative_groups;
namespace pg8 {
#define PG8_LAS __attribute__((address_space(3)))
typedef unsigned short bf16_t;
typedef short bf16x8 __attribute__((ext_vector_type(8)));
typedef float f32x4 __attribute__((ext_vector_type(4)));
typedef unsigned u32x4 __attribute__((ext_vector_type(4)));
constexpr int BM = 256, BK = 64, HALF = 128, HTB = HALF * BK * 2  , STAGE_BYTES = 8 * HTB, NXCD = 8, WGM = 8;

__host__ __device__ __forceinline__ int lds_byte(int r, int c) { const int st = (r >> 4) * 2 + (c >> 5), rr = r & 15, cc = c & 31, ob = rr * 64 + cc * 2; return st * 1024 + (ob ^ (((ob >> 9) & 1) << 5)); }
__host__ __device__ __forceinline__ void stage_rc(int b, int& R, int& C) { const int st = b / 1024, sb = b % 1024, swz = sb ^ (((sb >> 9) & 1) << 5); R = (st >> 1) * 16 + swz / 64; C = (st & 1) * 32 + (swz % 64) / 2; }
__host__ __device__ __forceinline__ int perm32(int rho) { const int n = rho >> 4, i = rho & 15; return 8 * (i >> 2) + 4 * n + (i & 3); }

struct Unit { int pm, pn; };
struct Gemm { const bf16_t* A; const bf16_t* Bt; int M, N, K; };

struct StaticOrder {
    int nM, nN, nwg, G, c;
    __host__ __device__ void init(int M, int N, int G_, int c_) { nM = M / BM; nN = N / BM; nwg = nM * nN; G = G_; c = c_; }
    __host__ __device__ bool next(int i, Unit& u) const {
        const long L = (long)i * G + c; if (L >= nwg) return false;
        int wgid = (int)L; { const int q = nwg / NXCD, r = nwg % NXCD, xcd = wgid % NXCD, off = wgid / NXCD; wgid = (xcd < r ? xcd * (q + 1) : r * (q + 1) + (xcd - r) * q) + off; }
        const int nig = WGM * nN, gid = wgid / nig, fm = gid * WGM, gsz = (nM - fm) < WGM ? (nM - fm) : WGM;
        u.pm = fm + ((wgid % nig) % gsz); u.pn = (wgid % nig) / gsz; return true;
    }
    __device__ __forceinline__ void a_ready(const Unit&) const {}
    __device__ __forceinline__ void done(const Unit&) const {}
};


__device__ __forceinline__ unsigned cvt_pk_bf16(float lo, float hi) { unsigned r; asm volatile("v_cvt_pk_bf16_f32 %0, %1, %2" : "=v"(r) : "v"(lo), "v"(hi)); return r; }

struct EpiF32 {
    static constexpr bool PERM = false, AFTER_DRAIN = false;
    float* C; int ldc;
    __device__ __forceinline__ void operator()(const f32x4 (&acc)[2][2][4][2], const Unit& u, int wr, int wc, int fr, int fq) const {
        const int row0 = u.pm * BM + wr * 64 + fr, col0 = u.pn * BM + wc * 32 + 4 * fq;
#pragma unroll
        for (int ai = 0; ai < 2; ++ai)
#pragma unroll
            for (int m = 0; m < 4; ++m) { float* rowp = C + (size_t)(row0 + ai * HALF + m * 16) * ldc + col0;
#pragma unroll
                for (int bj = 0; bj < 2; ++bj)
#pragma unroll
                    for (int n = 0; n < 2; ++n) *(f32x4*)(rowp + bj * HALF + n * 16) = acc[ai][bj][m][n]; }
    }
    __device__ __forceinline__ void fused(f32x4 (&)[2][2][4][2], const Unit&, int, int, int, int, PG8_LAS unsigned char*, int, int) const {}
};

template <int ACT> struct EpiBf16 {
    static constexpr bool PERM = true, AFTER_DRAIN = false;
    bf16_t* O0; int ld0; int nt0; bf16_t* O1; int ld1;
    __device__ __forceinline__ void operator()(const f32x4 (&acc)[2][2][4][2], const Unit& u, int wr, int wc, int fr, int fq) const {
        const int row0 = u.pm * BM + wr * 64 + fr;
        bf16_t* base; int ldc, colt;
        if (u.pn < nt0) { base = O0; ldc = ld0; colt = u.pn * BM; } else { base = O1; ldc = ld1; colt = (u.pn - nt0) * BM; }
        const int col0 = colt + wc * 32 + 8 * fq;
#pragma unroll
        for (int ai = 0; ai < 2; ++ai)
#pragma unroll
            for (int m = 0; m < 4; ++m) { bf16_t* rowp = base + (size_t)(row0 + ai * HALF + m * 16) * ldc + col0;
#pragma unroll
                for (int bj = 0; bj < 2; ++bj) { f32x4 v0 = acc[ai][bj][m][0], v1 = acc[ai][bj][m][1];
                    if (ACT == 2) {
#pragma unroll
                        for (int e = 0; e < 4; ++e) { float a = v0[e] > 0.f ? v0[e] : 0.f; v0[e] = a * a; float b = v1[e] > 0.f ? v1[e] : 0.f; v1[e] = b * b; } }
                    u32x4 w; w.x = cvt_pk_bf16(v0[0], v0[1]); w.y = cvt_pk_bf16(v0[2], v0[3]); w.z = cvt_pk_bf16(v1[0], v1[1]); w.w = cvt_pk_bf16(v1[2], v1[3]);
                    *(u32x4*)(rowp + bj * HALF) = w; } }
    }
    __device__ __forceinline__ void fused(f32x4 (&)[2][2][4][2], const Unit&, int, int, int, int, PG8_LAS unsigned char*, int, int) const {}
};


__device__ __forceinline__ float sig_f(float x) { return 1.0f / (1.0f + __expf(-x)); }
struct EpiRkv {
    static constexpr bool PERM = true, AFTER_DRAIN = false;
    bf16_t* RKV; bf16_t* L1;
    __device__ __forceinline__ void operator()(const f32x4 (&acc)[2][2][4][2], const Unit& u, int wr, int wc, int fr, int fq) const {
        const int row0 = u.pm * BM + wr * 64 + fr;
        const bool lora = u.pn >= 12; bf16_t* base = lora ? L1 : RKV; const int ldc = lora ? 384 : 3072, colt = lora ? (u.pn - 12) * BM : u.pn * BM;
        const int col0 = colt + wc * 32 + 8 * fq;
#pragma unroll
        for (int ai = 0; ai < 2; ++ai)
#pragma unroll
            for (int m = 0; m < 4; ++m) { bf16_t* rowp = base + (size_t)(row0 + ai * HALF + m * 16) * ldc + col0;
#pragma unroll
                for (int bj = 0; bj < 2; ++bj) { f32x4 v0 = acc[ai][bj][m][0], v1 = acc[ai][bj][m][1];
                    if (lora) { const int cb = colt + bj * HALF;
                        if (cb >= 384) continue;
                        if (cb == 0) {
#pragma unroll
                            for (int e = 0; e < 4; ++e) { v0[e] = 1.0f - 2.0f / (1.0f + __expf(2.0f * v0[e])); v1[e] = 1.0f - 2.0f / (1.0f + __expf(2.0f * v1[e])); } }
                        else if (cb == 256) {
#pragma unroll
                            for (int e = 0; e < 4; ++e) { v0[e] = sig_f(v0[e]); v1[e] = sig_f(v1[e]); } } }
                    u32x4 w; w.x = cvt_pk_bf16(v0[0], v0[1]); w.y = cvt_pk_bf16(v0[2], v0[3]); w.z = cvt_pk_bf16(v1[0], v1[1]); w.w = cvt_pk_bf16(v1[2], v1[3]);
                    *(u32x4*)(rowp + bj * HALF) = w; } }
    }
};
struct EpiLora2 {
    static constexpr bool PERM = true, AFTER_DRAIN = false;
    bf16_t* o4; size_t ostride; bf16_t* og; const float* a0; const float* w0;
    __device__ __forceinline__ void operator()(const f32x4 (&acc)[2][2][4][2], const Unit& u, int wr, int wc, int fr, int fq) const {
        const int row0 = u.pm * BM + wr * 64 + fr; const int blk = u.pn >> 2, colt = (u.pn & 3) * BM;
        bf16_t* base = (blk < 4) ? o4 + (size_t)blk * ostride : og;
        const float* bs = ((blk < 2) ? a0 : w0) + (blk & 1) * 1024;
        const int col0 = colt + wc * 32 + 8 * fq;
        const float sc = (blk >= 2) ? 0.8750387749719753f : 1.0f;
#pragma unroll
        for (int bj = 0; bj < 2; ++bj) {
            f32x4 b0 = (f32x4){0.f, 0.f, 0.f, 0.f}, b1 = b0;
            if (blk < 4) { b0 = *(const f32x4*)(bs + col0 + bj * HALF); b1 = *(const f32x4*)(bs + col0 + bj * HALF + 4); }
#pragma unroll
            for (int ai = 0; ai < 2; ++ai)
#pragma unroll
                for (int m = 0; m < 4; ++m) { bf16_t* rowp = base + (size_t)(row0 + ai * HALF + m * 16) * 1024 + col0;
                    f32x4 v0 = acc[ai][bj][m][0] + b0, v1 = acc[ai][bj][m][1] + b1;
                    if (blk < 4) {
#pragma unroll
                        for (int e = 0; e < 4; ++e) { v0[e] = sc * sig_f(v0[e]); v1[e] = sc * sig_f(v1[e]); } }
                    u32x4 w; w.x = cvt_pk_bf16(v0[0], v0[1]); w.y = cvt_pk_bf16(v0[2], v0[3]); w.z = cvt_pk_bf16(v1[0], v1[1]); w.w = cvt_pk_bf16(v1[2], v1[3]);
                    *(u32x4*)(rowp + bj * HALF) = w; } }
    }
};

template <class Epi, class Sched, bool ALIGN_EPI = false, bool SP2 = false>
__device__ __forceinline__ void gemm_phase(PG8_LAS unsigned char* lds, const Gemm g, const Sched& S, const Epi& E, const int wave_index) {
    int lane_o; asm volatile("v_mbcnt_lo_u32_b32 %0, -1, 0\n\tv_mbcnt_hi_u32_b32 %0, -1, %0" : "=v"(lane_o));
    const int wid = wave_index, lane = lane_o, tid = wid * 64 + lane, wr = wid >> 2, wc = wid & 3, fr = lane & 15, fq = lane >> 4;
    const int K = g.K, nt = K / BK;
    unsigned voffA[2], voffB[2];
#pragma unroll
    for (int i = 0; i < 2; ++i) { int R, C; stage_rc(tid * 16 + i * 8192, R, C); const int Rb = Epi::PERM ? ((R & ~31) + perm32(R & 31)) : R;
        voffA[i] = (unsigned)(R * K + C) * 2u; voffB[i] = (unsigned)(Rb * K + C) * 2u; }
    const size_t kstep = (size_t)(BK * 2);
    const size_t hstep = (size_t)HALF * K * 2;
    const size_t tstep = 2 * hstep;
    const unsigned ldsw = (unsigned)wid * 1024u;
    const int aoff = lds_byte(wr * 64 + fr, fq * 8), boff = lds_byte(wc * 32 + fr, fq * 8);
#define PG8_SA(b, h) (((b) * 2 + (h)) * HTB)
#define PG8_SB(b, h) ((4 + (b) * 2 + (h)) * HTB)
#define PG8_STAGE(bufoff, gbase, voff) do { _Pragma("unroll") for (int _i = 0; _i < 2; ++_i) \
        __builtin_amdgcn_global_load_lds((const unsigned*)((const char*)(gbase) + (voff)[_i]), (PG8_LAS unsigned*)(lds + (bufoff) + ldsw + _i * 8192), 16, 0, 0); } while (0)
#define PG8_LDA(dst, b, h) do { _Pragma("unroll") for (int m = 0; m < 4; ++m) _Pragma("unroll") for (int k = 0; k < 2; ++k) dst[m][k] = *(const PG8_LAS bf16x8*)(lds + PG8_SA(b, h) + aoff + m * 2048 + k * 1024); } while (0)
#define PG8_LDB(dst, b, h) do { _Pragma("unroll") for (int n = 0; n < 2; ++n) _Pragma("unroll") for (int k = 0; k < 2; ++k) dst[n][k] = *(const PG8_LAS bf16x8*)(lds + PG8_SB(b, h) + boff + n * 2048 + k * 1024); } while (0)
#define PG8_MMA(ai, bj, At, Bt) do { __builtin_amdgcn_s_setprio(1); _Pragma("unroll") for (int m = 0; m < 4; ++m) _Pragma("unroll") for (int n = 0; n < 2; ++n) _Pragma("unroll") for (int k = 0; k < 2; ++k) \
        acc[ai][bj][m][n] = __builtin_amdgcn_mfma_f32_16x16x32_bf16(Bt[n][k], At[m][k], acc[ai][bj][m][n], 0, 0, 0); __builtin_amdgcn_s_setprio(0); } while (0)
#define PG8_WAIT_V(n) asm volatile("s_waitcnt vmcnt(" #n ")" ::: "memory")
#define PG8_WAIT_L(n) asm volatile("s_waitcnt lgkmcnt(" #n ")" ::: "memory")
#define PG8_BAR __builtin_amdgcn_s_barrier()
#define PG8_SCHED __builtin_amdgcn_sched_barrier(0)
    Unit cur, nxt; int ui = 0;
    if (!S.next(0, cur)) return;
    f32x4 acc[2][2][4][2];
#pragma unroll
    for (int a = 0; a < 2; ++a)
#pragma unroll
        for (int b = 0; b < 2; ++b)
#pragma unroll
            for (int m = 0; m < 4; ++m)
#pragma unroll
                for (int n = 0; n < 2; ++n) acc[a][b][m][n] = (f32x4){0.f, 0.f, 0.f, 0.f};
    bf16x8 At[4][2], B0[2][2], B1[2][2];
    const char* cA = (const char*)g.A + (size_t)cur.pm * tstep; const char* cB = (const char*)g.Bt + (size_t)cur.pn * tstep;
    S.a_ready(cur);
    if constexpr (SP2) {
        PG8_STAGE(PG8_SB(0, 0), cB, voffB); PG8_STAGE(PG8_SB(0, 1), cB + hstep, voffB); PG8_STAGE(PG8_SA(0, 0), cA, voffA); PG8_STAGE(PG8_SA(0, 1), cA + hstep, voffA);
        if (wr == 1) PG8_BAR;
        PG8_WAIT_V(2); PG8_BAR;
        PG8_STAGE(PG8_SB(1, 0), cB + kstep, voffB); PG8_STAGE(PG8_SA(1, 0), cA + kstep, voffA); PG8_STAGE(PG8_SB(1, 1), cB + hstep + kstep, voffB);
        PG8_WAIT_V(6); PG8_BAR;
    } else {
        PG8_STAGE(PG8_SB(0, 0), cB, voffB); PG8_STAGE(PG8_SA(0, 0), cA, voffA); PG8_STAGE(PG8_SB(0, 1), cB + hstep, voffB); PG8_STAGE(PG8_SA(0, 1), cA + hstep, voffA);
        if (wr == 1) PG8_BAR;
        PG8_WAIT_V(4); PG8_BAR;
        PG8_STAGE(PG8_SB(1, 0), cB + kstep, voffB); PG8_STAGE(PG8_SA(1, 0), cA + kstep, voffA); PG8_STAGE(PG8_SB(1, 1), cB + hstep + kstep, voffB);
        PG8_WAIT_V(6); PG8_BAR;
    }
    for (;;) {
        const bool has_next = S.next(ui + 1, nxt);
        const char* nA = has_next ? (const char*)g.A + (size_t)nxt.pm * tstep : cA; const char* nB = has_next ? (const char*)g.Bt + (size_t)nxt.pn * tstep : cB;
#pragma unroll 1
        for (int t = 0; t < nt; t += 2) {
            const bool last = (t == nt - 2);
            const char* a1 = cA + (size_t)(t + 1) * kstep;
            const char* a2 = last ? nA : cA + (size_t)(t + 2) * kstep; const char* b2 = last ? nB : cB + (size_t)(t + 2) * kstep;
            const char* a3 = a2 + kstep; const char* b3 = b2 + kstep;
            if (last && has_next) S.a_ready(nxt);
            if constexpr (SP2) {
            PG8_LDB(B0, 0, 0); PG8_LDB(B1, 0, 1); PG8_SCHED; PG8_LDA(At, 0, 0); PG8_STAGE(PG8_SA(1, 1), a1 + hstep, voffA);
            PG8_WAIT_V(8); PG8_WAIT_L(0); PG8_BAR; PG8_MMA(0, 0, At, B0); PG8_MMA(0, 1, At, B1); PG8_BAR; PG8_SCHED;
            PG8_LDA(At, 0, 1); PG8_STAGE(PG8_SB(0, 0), b2, voffB); PG8_STAGE(PG8_SB(0, 1), b2 + hstep, voffB); PG8_STAGE(PG8_SA(0, 0), a2, voffA);
            PG8_WAIT_V(8); PG8_WAIT_L(0); PG8_BAR; PG8_MMA(1, 0, At, B0); PG8_MMA(1, 1, At, B1); PG8_BAR; PG8_SCHED;
            PG8_LDB(B0, 1, 0); PG8_LDB(B1, 1, 1); PG8_SCHED; PG8_LDA(At, 1, 0); PG8_STAGE(PG8_SA(0, 1), a2 + hstep, voffA);
            PG8_WAIT_V(8); PG8_WAIT_L(0); PG8_BAR; PG8_MMA(0, 0, At, B0); PG8_MMA(0, 1, At, B1); PG8_BAR; PG8_SCHED;
            PG8_LDA(At, 1, 1); PG8_STAGE(PG8_SB(1, 0), b3, voffB); PG8_STAGE(PG8_SB(1, 1), b3 + hstep, voffB); PG8_STAGE(PG8_SA(1, 0), a3, voffA);
            PG8_WAIT_V(8); PG8_WAIT_L(0); PG8_BAR; PG8_MMA(1, 0, At, B0); PG8_MMA(1, 1, At, B1); PG8_BAR; PG8_SCHED;
            } else {
            PG8_LDB(B0, 0, 0); PG8_SCHED; PG8_LDA(At, 0, 0); PG8_STAGE(PG8_SA(1, 1), a1 + hstep, voffA);
            PG8_WAIT_L(8); PG8_BAR; PG8_WAIT_L(0); PG8_MMA(0, 0, At, B0); PG8_BAR; PG8_SCHED;
            PG8_LDB(B1, 0, 1); PG8_STAGE(PG8_SB(0, 0), b2, voffB);
            PG8_BAR; PG8_WAIT_L(0); PG8_MMA(0, 1, At, B1); PG8_BAR;
            PG8_LDA(At, 0, 1); PG8_STAGE(PG8_SA(0, 0), a2, voffA);
            PG8_BAR; PG8_WAIT_L(0); PG8_MMA(1, 0, At, B0); PG8_BAR; PG8_SCHED;
            PG8_STAGE(PG8_SB(0, 1), b2 + hstep, voffB);
            PG8_WAIT_V(6); PG8_BAR; PG8_MMA(1, 1, At, B1); PG8_BAR;
            PG8_LDB(B0, 1, 0); PG8_SCHED; PG8_LDA(At, 1, 0); PG8_STAGE(PG8_SA(0, 1), a2 + hstep, voffA);
            PG8_WAIT_L(8); PG8_BAR; PG8_WAIT_L(0); PG8_MMA(0, 0, At, B0); PG8_BAR; PG8_SCHED;
            PG8_LDB(B1, 1, 1); PG8_STAGE(PG8_SB(1, 0), b3, voffB);
            PG8_BAR; PG8_WAIT_L(0); PG8_MMA(0, 1, At, B1); PG8_BAR;
            PG8_LDA(At, 1, 1); PG8_STAGE(PG8_SA(1, 0), a3, voffA);
            PG8_BAR; PG8_WAIT_L(0); PG8_MMA(1, 0, At, B0); PG8_BAR; PG8_SCHED;
            PG8_STAGE(PG8_SB(1, 1), b3 + hstep, voffB);
            PG8_WAIT_V(6); PG8_BAR; PG8_MMA(1, 1, At, B1); PG8_BAR;
            }
        }
        if constexpr (ALIGN_EPI) { if (wr == 0) PG8_BAR; }
        if constexpr (!Epi::AFTER_DRAIN) { E(acc, cur, wr, wc, fr, fq); S.done(cur); }
        if (!has_next) break;
#pragma unroll
        for (int a = 0; a < 2; ++a)
#pragma unroll
            for (int b = 0; b < 2; ++b)
#pragma unroll
                for (int m = 0; m < 4; ++m)
#pragma unroll
                    for (int n = 0; n < 2; ++n) acc[a][b][m][n] = (f32x4){0.f, 0.f, 0.f, 0.f};
        cur = nxt; cA = nA; cB = nB; ++ui;
        if constexpr (ALIGN_EPI) { if (wr == 1) PG8_BAR; }
    }
    PG8_WAIT_V(0);
    if constexpr (!ALIGN_EPI) { if (wr == 0) PG8_BAR; }
    PG8_BAR;
    if constexpr (Epi::AFTER_DRAIN) { E.fused(acc, cur, wr, wc, fr, fq, lds, wid, lane); S.done(cur); }
#undef PG8_SA
#undef PG8_SB
#undef PG8_STAGE
#undef PG8_LDA
#undef PG8_LDB
#undef PG8_MMA
#undef PG8_WAIT_V
#undef PG8_WAIT_L
#undef PG8_BAR
#undef PG8_SCHED
}
}

#define GAS __attribute__((address_space(1)))
#define LAS __attribute__((address_space(3)))
typedef unsigned short bf16;
typedef unsigned v4u __attribute__((ext_vector_type(4)));
typedef unsigned v2u __attribute__((ext_vector_type(2)));
typedef float f32x4 __attribute__((ext_vector_type(4)));
#define LDS_WAIT() asm volatile("s_waitcnt lgkmcnt(0)" ::: "memory")

#ifndef MK_N_LAUNCHES
#define MK_N_LAUNCHES 1
#endif
#ifndef MK_CG_BARRIER
#define MK_CG_BARRIER 0
#endif

constexpr int D = 1024, NTOK = 16384, NPR = 8192, TP = 256, TS = 2048, PAST = 512, SKV = 2560, FF = 4096, DEPTH = 4;
constexpr int NQKV = 2304, NRKV = 3584, KRKV = 2048;
constexpr int NWAVES = 8;
constexpr size_t O_X = 0, O_KG = 16777216, O_VG = 18874368, O_KD = 20971520, O_VD = 29360128, O_ST = 37748736, OUT_TOTAL = 46137344;
constexpr size_t MiB = 1u << 20;
constexpr size_t WS_CTL = 0, CTL_ZERO_BYTES = 1 * MiB;
constexpr size_t WS_MOD = 65536;
constexpr size_t WS_ROPE = 1 * MiB;
constexpr size_t WS_INV = 2 * MiB;
constexpr size_t WS_W = 4 * MiB;
constexpr size_t W_W1T = WS_W, W_W2T = WS_W + 8 * MiB, W_MIX = WS_W + 16 * MiB;
constexpr size_t W_WINT = W_MIX, W_WOUTT = W_MIX + 6 * MiB;
constexpr size_t W_BT1 = W_MIX, W_WOT = W_MIX + 14 * MiB, W_BT2 = W_MIX + 16 * MiB;
constexpr size_t AR = 40 * MiB;
constexpr size_t A_H = AR;
constexpr size_t A_QKVRAW = AR + 32 * MiB;
constexpr size_t A_DT = AR + 32 * MiB;
constexpr size_t A_M = AR + 96 * MiB;
constexpr size_t A_QA = AR + 176 * MiB, A_QB = AR + 192 * MiB, A_KAP = AR + 208 * MiB, A_VAP = AR + 210 * MiB, A_KBP = AR + 212 * MiB, A_VBP = AR + 220 * MiB;
constexpr size_t A_KAS = AR + 228 * MiB, A_VAS = AR + 231 * MiB, A_KBS = AR + 234 * MiB, A_VBS = AR + 244 * MiB;
constexpr size_t A_HID = AR + 32 * MiB;
constexpr size_t A_F = AR + 160 * MiB;
constexpr size_t A_A2 = AR + 32 * MiB;
constexpr size_t A_Y = AR + 32 * MiB;
constexpr size_t A_RKV = AR + 96 * MiB;
constexpr size_t A_L1 = AR + 192 * MiB;
constexpr size_t A_G = A_H;
constexpr size_t A_A0 = AR + 208 * MiB, A_A1 = AR + 240 * MiB, A_EW0 = AR + 272 * MiB, A_EW1 = AR + 304 * MiB;
constexpr size_t WS_END = AR + 336 * MiB;
constexpr int CW_BAR = 4096;

constexpr int RING_OFF = 0, RING_BYTES = 131072;
constexpr int LDSCTL_OFF = RING_BYTES, MISC_OFF = LDSCTL_OFF + 320;
constexpr int LDS_BYTES = 147456;

__device__ __forceinline__ unsigned f2bf(float f) { unsigned u = __builtin_bit_cast(unsigned, f); return (u + 0x7fffu + ((u >> 16) & 1u)) >> 16; }
__device__ __forceinline__ unsigned pk2(float lo, float hi) { return f2bf(lo) | (f2bf(hi) << 16); }
__device__ __forceinline__ float bf2f(unsigned short h) { return __builtin_bit_cast(float, (unsigned)h << 16); }
__device__ __forceinline__ float bflo(unsigned w) { return __builtin_bit_cast(float, w << 16); }
__device__ __forceinline__ float bfhi(unsigned w) { return __builtin_bit_cast(float, w & 0xffff0000u); }
__device__ __forceinline__ float wave_sum(float v) {
#pragma unroll
    for (int o = 1; o < 64; o <<= 1) v += __shfl_xor(v, o);
    return v;
}
__device__ __forceinline__ float sigmoidf_(float x) { return 1.0f / (1.0f + __expf(-x)); }
__device__ __forceinline__ float rdl(float x, int l) { return __builtin_bit_cast(float, __builtin_amdgcn_readlane(__builtin_bit_cast(int, x), l)); }

#define XB_TMO      128
#define XB_XCNT(j)  (256  + 64 * (j))
#define XB_XSUB(j)  (1280 + 64 * (j))
#define XB_XGEN(j)  (2304 + 64 * (j))
#define XB_TOP      3328
#define XB_TOPGEN   3392
#define XCD_BAR_WORDS 3456
#define XB_SPIN_CAP (1u << 18)

__device__ __forceinline__ unsigned xb_ld(unsigned* p)              { return __hip_atomic_load(p, __ATOMIC_RELAXED, __HIP_MEMORY_SCOPE_AGENT); }
__device__ __forceinline__ unsigned xb_add(unsigned* p, unsigned v) { return __hip_atomic_fetch_add(p, v, __ATOMIC_RELAXED, __HIP_MEMORY_SCOPE_AGENT); }
__device__ __forceinline__ unsigned xb_xcc_id() { return (unsigned)__builtin_amdgcn_s_getreg((3 << 11) | 20) & 0xFu; }
#define XB_SPIN(cond, bar) do { unsigned _sp = 0; while (cond) { __builtin_amdgcn_s_sleep(1); \
    if ((++_sp & 255u) == 0u) { if (xb_ld(&(bar)[XB_TMO])) break; if (_sp > XB_SPIN_CAP) { atomicAdd(&(bar)[XB_TMO], 1u); break; } } } } while (0)

struct XcdBarrier {
    unsigned* bar; unsigned x;
    volatile LAS unsigned* st;
};

__device__ __forceinline__ XcdBarrier xcd_barrier_post(unsigned* bar, volatile LAS unsigned* st, bool leader) {
    XcdBarrier b; b.bar = bar; b.x = xb_xcc_id(); b.st = st;
    if (leader) (void)xb_add(&bar[XB_XCNT(b.x)], 1u);
    return b;
}
__device__ __forceinline__ void xcd_barrier_complete(unsigned* bar, unsigned x, unsigned& nloc, unsigned& nx) {
    const unsigned G = gridDim.x * gridDim.y * gridDim.z;
    unsigned sum, cnt, mine, sp = 0u;
    for (;;) {
        sum = 0u; cnt = 0u; mine = 0u;
#pragma unroll
        for (unsigned j = 0; j < 16; ++j) { const unsigned c = xb_ld(&bar[XB_XCNT(j)]); sum += c; cnt += (c > 0u) ? 1u : 0u; mine = (j == x) ? c : mine; }
        if (sum == G) break;
        __builtin_amdgcn_s_sleep(1);
        if ((++sp & 255u) == 0u) { if (xb_ld(&bar[XB_TMO])) break; if (sp > XB_SPIN_CAP) { atomicAdd(&bar[XB_TMO], 1u); break; } }
    }
    nloc = mine > 0u ? mine : 1u; nx = cnt > 0u ? cnt : 1u;
}

__device__ __forceinline__ void xcd_barrier(const XcdBarrier& b, bool leader) {
    asm volatile("s_waitcnt vmcnt(0)" ::: "memory");
    __syncthreads();
    if (leader) {
        unsigned* bar = b.bar;
        __builtin_amdgcn_s_waitcnt(0);
        unsigned nloc = b.st[0], nx = b.st[1];
        if (nloc == 0u) { xcd_barrier_complete(bar, b.x, nloc, nx); b.st[0] = nloc; b.st[1] = nx; }
        const unsigned old = xb_add(&bar[XB_XSUB(b.x)], 1u);
        const unsigned gen = old / nloc;
        if (old + 1u == (gen + 1u) * nloc) {
            __builtin_amdgcn_fence(__ATOMIC_RELEASE, "agent");
            asm volatile("s_waitcnt vmcnt(0)" ::: "memory");
            const unsigned og = xb_add(&bar[XB_TOP], 1u);
            const unsigned tg = og / nx;
            if (og + 1u == (tg + 1u) * nx) xb_add(&bar[XB_TOPGEN], 1u);
            else XB_SPIN(xb_ld(&bar[XB_TOPGEN]) == tg, bar);
            __builtin_amdgcn_fence(__ATOMIC_ACQUIRE, "agent");
            xb_add(&bar[XB_XGEN(b.x)], 1u);
            asm volatile("s_waitcnt vmcnt(0)" ::: "memory");
        } else {
            XB_SPIN(xb_ld(&bar[XB_XGEN(b.x)]) == gen, bar);
            __builtin_amdgcn_fence(__ATOMIC_ACQUIRE, "agent");
            asm volatile("s_waitcnt vmcnt(0)" ::: "memory");
        }
    }
    __syncthreads();
}

struct Args { const float* in[32]; float* out; unsigned char* ws; int ph_lo, ph_hi; };
struct Ids { int tid, lane, wave, gw, ngw, z; };

__device__ __forceinline__ int cond_of(int m) { return m < NPR ? 4 : ((m - NPR) >> 11); }
__device__ __forceinline__ const float* mod_ptr_(const Args& a, const Ids& id, int cond, int layer) { return (const float*)(a.ws + id.z + WS_MOD) + (size_t)(cond * 4 + layer) * 6144; }

__device__ __forceinline__ void tr_item(const float* W, int ldw, int col0, const float* scale, bf16* WT, int ldt, int drow0, int dcol0, LAS float* scr, int kb, int nb, int lane) {
    const int k0 = 64 * kb, n0 = 32 * nb;
#pragma unroll 8
    for (int i = 0; i < 32; ++i) { const int kk = 2 * i + (lane >> 5); float v = W[(size_t)(k0 + kk) * ldw + col0 + n0 + (lane & 31)]; if (scale) v *= scale[k0 + kk]; scr[kk * 33 + (lane & 31)] = v; }
    LDS_WAIT(); asm volatile("" ::: "memory");
    const int c = lane & 7;
#pragma unroll
    for (int j = 0; j < 4; ++j) { const int n = (lane >> 3) + 8 * j; const LAS float* s = scr + (8 * c) * 33 + n;
        v4u o; o.x = pk2(s[0 * 33], s[1 * 33]); o.y = pk2(s[2 * 33], s[3 * 33]); o.z = pk2(s[4 * 33], s[5 * 33]); o.w = pk2(s[6 * 33], s[7 * 33]);
        *(v4u*)(WT + (size_t)(drow0 + n0 + n) * ldt + dcol0 + k0 + 8 * c) = o; }
    LDS_WAIT(); asm volatile("" ::: "memory");
}
__device__ __forceinline__ bool tr_matrix(int& r, const float* W, int K, int N, bf16* WT, LAS float* scr, int lane) {
    const int nblk = N / 32, items = (K / 64) * nblk;
    if (r < items) { tr_item(W, N, 0, nullptr, WT, K, 0, 0, scr, r / nblk, r % nblk, lane); return true; }
    r -= items; return false;
}
__device__ __forceinline__ bool tr_rwproj(int& r, const float* W, int ncols, const float* mu, bf16* BT1, int drow0, LAS float* scr, int lane) {
    const int nblk = ncols / 32, items = 16 * nblk * 2;
    if (r < items) { const int half = r / (16 * nblk), q = r % (16 * nblk); tr_item(W, ncols, 0, half ? mu : nullptr, BT1, KRKV, drow0, half * 1024, scr, q / nblk, q % nblk, lane); return true; }
    r -= items; return false;
}
__device__ __forceinline__ void conv_weights(const Args& a, const Ids& id, LAS unsigned char* lds, int layer) {
    LAS float* scr = (LAS float*)(lds + id.wave * 16384);
    const int j = layer >> 1;
    bf16* W1T = (bf16*)(a.ws + id.z + W_W1T); bf16* W2T = (bf16*)(a.ws + id.z + W_W2T);
    const float* mw1 = a.in[30 + id.z] + (size_t)layer * D * FF; const float* mw2 = a.in[31 + id.z] + (size_t)layer * D * FF;
    if ((layer & 1) == 0) {
        bf16* WINT = (bf16*)(a.ws + id.z + W_WINT); bf16* WOUTT = (bf16*)(a.ws + id.z + W_WOUTT);
        const float* win = a.in[12 + id.z] + (size_t)j * D * NQKV; const float* wout = a.in[13 + id.z] + (size_t)j * D * D;
        const int total = 2048 + 2048 + 1152 + 512;
        for (int it = id.gw; it < total; it += id.ngw) {
            int r = it;
            if (tr_matrix(r, mw1, D, FF, W1T, scr, id.lane)) continue;
            if (tr_matrix(r, mw2, FF, D, W2T, scr, id.lane)) continue;
            if (tr_matrix(r, win, D, NQKV, WINT, scr, id.lane)) continue;
            tr_matrix(r, wout, D, D, WOUTT, scr, id.lane);
        }
    } else {
        bf16* BT1 = (bf16*)(a.ws + id.z + W_BT1); bf16* WOT = (bf16*)(a.ws + id.z + W_WOT);
        const float* mu = a.in[17 + id.z] + (size_t)j * 6 * D;
        const float* wrkv = a.in[18 + id.z] + (size_t)j * 3 * D * D;
        const float* w1 = a.in[21 + id.z] + (size_t)j * 2 * D * 64; const float* a1 = a.in[24 + id.z] + (size_t)j * 2 * D * 64; const float* g1 = a.in[26 + id.z] + (size_t)j * D * 128;
        const float* wo = a.in[19 + id.z] + (size_t)j * D * D;
        bf16* BT2 = (bf16*)(a.ws + id.z + W_BT2); const float* w2 = a.in[22 + id.z] + (size_t)j * 2 * 64 * D; const float* a2 = a.in[25 + id.z] + (size_t)j * 2 * 64 * D; const float* g2 = a.in[27 + id.z] + (size_t)j * 128 * D;
        const int total = 2048 + 2048 + 3072 + 256 + 128 + 512 + 128 + 4 * 32 + 64 + 5120;
        for (int it = id.gw; it < total; it += id.ngw) {
            int r = it;
            if (tr_matrix(r, mw1, D, FF, W1T, scr, id.lane)) continue;
            if (tr_matrix(r, mw2, FF, D, W2T, scr, id.lane)) continue;
            if (tr_rwproj(r, wrkv, 1024, mu + 0 * D, BT1, 0, scr, id.lane)) continue;
            if (tr_rwproj(r, wrkv + (size_t)D * D, 1024, mu + 2 * D, BT1, 1024, scr, id.lane)) continue;
            if (tr_rwproj(r, wrkv + (size_t)2 * D * D, 1024, mu + 3 * D, BT1, 2048, scr, id.lane)) continue;
            if (tr_rwproj(r, w1, 64, mu + 1 * D, BT1, 3072, scr, id.lane)) continue;
            if (tr_rwproj(r, w1 + (size_t)D * 64, 64, mu + 1 * D, BT1, 3136, scr, id.lane)) continue;
            if (tr_rwproj(r, a1, 64, mu + 4 * D, BT1, 3200, scr, id.lane)) continue;
            if (tr_rwproj(r, a1 + (size_t)D * 64, 64, mu + 4 * D, BT1, 3264, scr, id.lane)) continue;
            if (tr_rwproj(r, g1, 128, mu + 5 * D, BT1, 3328, scr, id.lane)) continue;
            if (tr_matrix(r, wo, D, D, WOT, scr, id.lane)) continue;
            if (r < 128) {
                v4u z = (v4u){0u, 0u, 0u, 0u}; v4u* p = (v4u*)(BT1 + (size_t)(3456 + r) * KRKV);
#pragma unroll
                for (int q = 0; q < 4; ++q) p[id.lane + 64 * q] = z;
                continue; }
            r -= 128;
            if (r < 128) { const int i = r >> 5, q = r & 31; const float* W = (i < 2 ? a2 : w2) + (size_t)(i & 1) * 64 * D; tr_item(W, D, 0, nullptr, BT2, 384, 1024 * i, 64 * (i ^ 2), scr, 0, q, id.lane); continue; }
            r -= 128;
            if (r < 64) { tr_item(g2, D, 0, nullptr, BT2, 384, 4096, 256, scr, r >> 5, r & 31, id.lane); continue; }
            r -= 64;
            { const int blk = r >> 10; const int c0 = (blk < 4) ? 8 * (blk ^ 2) : 32, c1 = (blk < 4) ? 8 * (blk ^ 2) + 8 : 48;
              if (id.lane < 48 && (id.lane < c0 || id.lane >= c1)) *(v4u*)(BT2 + (size_t)r * 384 + 8 * id.lane) = (v4u){0u, 0u, 0u, 0u}; }
        }
    }
}

struct RowV { f32x4 v[4]; };
__device__ __forceinline__ void ld_row(RowV& r, const float* p, int lane) {
#pragma unroll
    for (int j = 0; j < 4; ++j) r.v[j] = ((const f32x4*)p)[lane + 64 * j];
}
__device__ __forceinline__ void st_row(const RowV& r, float* p, int lane) {
#pragma unroll
    for (int j = 0; j < 4; ++j) ((f32x4*)p)[lane + 64 * j] = r.v[j];
}
__device__ __forceinline__ void st_row_bf16(const RowV& r, bf16* p, int lane) {
#pragma unroll
    for (int j = 0; j < 4; ++j) { v2u w; w.x = pk2(r.v[j][0], r.v[j][1]); w.y = pk2(r.v[j][2], r.v[j][3]); ((v2u*)p)[lane + 64 * j] = w; }
}
__device__ __forceinline__ float row_rinv(const RowV& r) {
    float s = 0.f;
#pragma unroll
    for (int j = 0; j < 4; ++j) s += (r.v[j][0] * r.v[j][0] + r.v[j][1] * r.v[j][1]) + (r.v[j][2] * r.v[j][2] + r.v[j][3] * r.v[j][3]);
    s = wave_sum(s);
    return 1.0f / sqrtf(s * (1.0f / 1024.0f) + 1e-6f);
}
__device__ __forceinline__ void norm_mod(RowV& h, const RowV& x, const float* g, const float* sc, const float* sh, int lane) {
    const float ri = row_rinv(x);
#pragma unroll
    for (int j = 0; j < 4; ++j) { const f32x4 gv = ((const f32x4*)g)[lane + 64 * j], scv = ((const f32x4*)sc)[lane + 64 * j], shv = ((const f32x4*)sh)[lane + 64 * j];
        h.v[j] = (x.v[j] * ri) * gv * (scv + 1.0f) + shv; }
}
__device__ __forceinline__ void resid_add(RowV& x, const RowV& m, const float* g, const float* gt, int lane) {
    const float ri = row_rinv(m);
#pragma unroll
    for (int j = 0; j < 4; ++j) { const f32x4 gv = ((const f32x4*)g)[lane + 64 * j], gtv = ((const f32x4*)gt)[lane + 64 * j];
        x.v[j] = x.v[j] + gtv * ((m.v[j] * ri) * gv); }
}

__device__ __forceinline__ float rope_inv(int jj) {
    const float t[16] = {1.0f, 0.5623413324356079f, 0.3162277638912201f, 0.17782793939113617f, 0.10000000149011612f, 0.05623412877321243f, 0.03162277862429619f, 0.017782794311642647f,
                         0.009999999776482582f, 0.005623413249850273f, 0.003162277862429619f, 0.0017782794311642647f, 0.0010000000474974513f, 0.000562341301701963f, 0.0003162277862429619f, 0.00017782794020604342f};
    float r = t[0];
#pragma unroll
    for (int i = 1; i < 16; ++i) r = (jj == i) ? t[i] : r;
    return r;
}
__device__ __forceinline__ void ph_prologue(const Args& a, const Ids& id, LAS unsigned char* lds) {
    float* MOD = (float*)(a.ws + id.z + WS_MOD);
    for (int it = id.gw; it < 4 * 96; it += id.ngw) {
        const int i = it / 96, n = (it % 96) * 64 + id.lane;
        float acc[5];
#pragma unroll
        for (int c = 0; c < 5; ++c) acc[c] = 0.f;
        const float* W = a.in[9 + id.z] + (size_t)i * 1024 * 6144 + n;
#pragma unroll 1
        for (int k0 = 0; k0 < 1024; k0 += 64) {
            float sv[5];
#pragma unroll
            for (int c = 0; c < 5; ++c) { const float x = (c < 4) ? a.in[2 + id.z][c * 1024 + k0 + id.lane] : a.in[8 + id.z][k0 + id.lane]; sv[c] = x / (1.0f + __expf(-x)); }
#pragma unroll 8
            for (int kk = 0; kk < 64; ++kk) { const float w = W[(size_t)(k0 + kk) * 6144];
#pragma unroll
                for (int c = 0; c < 5; ++c) acc[c] += w * __shfl(sv[c], kk); }
        }
        const float bias = a.in[10 + id.z][i * 6144 + n];
#pragma unroll
        for (int c = 0; c < 5; ++c) MOD[(size_t)(c * 4 + i) * 6144 + n] = acc[c] + bias;
    }
    { float* RC = (float*)(a.ws + id.z + WS_ROPE); float* RS = RC + 2048 * 64;
      for (int e = id.gw * 64 + id.lane; e < 2048 * 64; e += id.ngw * 64) { const int t = e >> 6, d = e & 63; const int pos = (d < 32) ? (t >> 6) : (t & 63);
          const float ang = (float)pos * rope_inv(d & 15); RC[e] = __cosf(ang); RS[e] = __sinf(ang); } }
    { const f32x4* s0 = (const f32x4*)a.in[0 + id.z]; const f32x4* s1 = (const f32x4*)a.in[1 + id.z]; f32x4* dst = (f32x4*)(a.out + id.z + O_X); const int n4 = NPR * D / 4;
      for (int e = id.gw * 64 + id.lane; e < n4; e += id.ngw * 64) { dst[e] = s0[e]; dst[n4 + e] = s1[e]; } }
    conv_weights(a, id, lds, 0);
}

__device__ __forceinline__ void ph_norm0(const Args& a, const Ids& id) {
    bf16* H = (bf16*)(a.ws + id.z + A_H); const float* g0 = a.in[11 + id.z] + (size_t)(0 * 4 + 0) * D;
    for (int m = id.gw; m < NTOK; m += id.ngw) { RowV x, h; ld_row(x, a.out + id.z + O_X + (size_t)m * D, id.lane); const float* md = mod_ptr_(a, id, cond_of(m), 0);
        norm_mod(h, x, g0, md + 1024, md + 0, id.lane); st_row_bf16(h, H + (size_t)m * D, id.lane); }
}
__device__ __forceinline__ void ph_resid_norm(const Args& a, const Ids& id, int layer) {
    bf16* H = (bf16*)(a.ws + id.z + A_H); const float* M = (const float*)(a.ws + id.z + A_M); const float* g1 = a.in[11 + id.z] + (size_t)(layer * 4 + 1) * D; const float* g2 = a.in[11 + id.z] + (size_t)(layer * 4 + 2) * D;
    for (int m = id.gw; m < NTOK; m += id.ngw) { RowV x, mm, h; float* xp = a.out + id.z + O_X + (size_t)m * D; ld_row(x, xp, id.lane); ld_row(mm, M + (size_t)m * D, id.lane);
        const float* md = mod_ptr_(a, id, cond_of(m), layer);
        resid_add(x, mm, g1, md + 2048, id.lane); st_row(x, xp, id.lane);
        norm_mod(h, x, g2, md + 4096, md + 3072, id.lane); st_row_bf16(h, H + (size_t)m * D, id.lane); }
}
__device__ __forceinline__ void ph_resid_end(const Args& a, const Ids& id, LAS unsigned char* lds, int layer) {
    bf16* H = (bf16*)(a.ws + id.z + A_H); const float* F = (const float*)(a.ws + id.z + A_F); const float* g3 = a.in[11 + id.z] + (size_t)(layer * 4 + 3) * D;
    const bool next_attn = (layer + 1 < DEPTH) && (((layer + 1) & 1) == 0);
    const float* g0n = a.in[11 + id.z] + (size_t)((layer + 1) * 4 + 0) * D;
    for (int m = id.gw; m < NTOK; m += id.ngw) { RowV x, ff; float* xp = a.out + id.z + O_X + (size_t)m * D; ld_row(x, xp, id.lane); ld_row(ff, F + (size_t)m * D, id.lane);
        const float* md = mod_ptr_(a, id, cond_of(m), layer);
        resid_add(x, ff, g3, md + 5120, id.lane); st_row(x, xp, id.lane);
        if (next_attn) { RowV h; const float* mdn = mod_ptr_(a, id, cond_of(m), layer + 1); norm_mod(h, x, g0n, mdn + 1024, mdn + 0, id.lane); st_row_bf16(h, H + (size_t)m * D, id.lane); } }
    if (layer + 1 < DEPTH) conv_weights(a, id, lds, layer + 1);
}
__device__ __forceinline__ void ph_rw_mix(const Args& a, const Ids& id, int layer) {
    bf16* A2 = (bf16*)(a.ws + id.z + A_A2); const float* g0 = a.in[11 + id.z] + (size_t)(layer * 4 + 0) * D;
    for (int m = id.gw; m < NTOK; m += id.ngw) {
        const int t = (m < NPR) ? (m & (TP - 1)) : ((m - NPR) & (TS - 1)); const int T = (m < NPR) ? TP : TS;
        const float* md = mod_ptr_(a, id, cond_of(m), layer); const float* xp = a.out + id.z + O_X + (size_t)m * D;
        RowV x, hc, hs, xx; ld_row(x, xp, id.lane); norm_mod(hc, x, g0, md + 1024, md + 0, id.lane);
#pragma unroll
        for (int j = 0; j < 4; ++j) hs.v[j] = (f32x4){0.f, 0.f, 0.f, 0.f};
        if (t > 0) { RowV xn, hn; ld_row(xn, xp - D, id.lane); norm_mod(hn, xn, g0, md + 1024, md + 0, id.lane);
#pragma unroll
            for (int j = 0; j < 4; ++j) hs.v[j] += hn.v[j]; }
        if (t < T - 1) { RowV xn, hn; ld_row(xn, xp + D, id.lane); norm_mod(hn, xn, g0, md + 1024, md + 0, id.lane);
#pragma unroll
            for (int j = 0; j < 4; ++j) hs.v[j] += hn.v[j]; }
#pragma unroll
        for (int j = 0; j < 4; ++j) xx.v[j] = hs.v[j] * 0.5f - hc.v[j];
        st_row_bf16(hc, A2 + (size_t)m * KRKV, id.lane); st_row_bf16(xx, A2 + (size_t)m * KRKV + D, id.lane);
    }
}

__device__ __forceinline__ void ph_att_post(const Args& a, const Ids& id, int layer) {
    const int j = layer >> 1, lane = id.lane;
    const float* RAW = (const float*)(a.ws + id.z + A_QKVRAW);
    bf16 *QA = (bf16*)(a.ws + id.z + A_QA), *QB = (bf16*)(a.ws + id.z + A_QB), *KAP = (bf16*)(a.ws + id.z + A_KAP), *VAP = (bf16*)(a.ws + id.z + A_VAP), *KBP = (bf16*)(a.ws + id.z + A_KBP), *VBP = (bf16*)(a.ws + id.z + A_VBP);
    bf16 *KAS = (bf16*)(a.ws + id.z + A_KAS), *VAS = (bf16*)(a.ws + id.z + A_VAS), *KBS = (bf16*)(a.ws + id.z + A_KBS), *VBS = (bf16*)(a.ws + id.z + A_VBS);
    const float* RC = (const float*)(a.ws + id.z + WS_ROPE); const float* RS = RC + 2048 * 64;
    const float gq = a.in[14 + id.z][j * 128 + lane], gk = a.in[14 + id.z][j * 128 + 64 + lane];
    for (int it = id.gw; it < NTOK + 4 * PAST; it += id.ngw) {
        if (it < NTOK) {
            const int m = it; const bool smp = m >= NPR; const int b = smp ? ((m - NPR) >> 11) : (m >> 8), t = smp ? ((m - NPR) & (TS - 1)) : (m & (TP - 1));
            const float* raw = RAW + (size_t)m * NQKV;
            float cs = 1.f, sn = 0.f; if (smp) { cs = RC[t * 64 + lane]; sn = RS[t * 64 + lane]; }
            const size_t srow = (size_t)(b * SKV + PAST + t);
            const size_t prow = (size_t)((b * 2 + j) * TP + t);
#pragma unroll 1
            for (int ch = 0; ch < 36; ++ch) {
                float v = raw[ch * 64 + lane];
                const bool isq = (ch < 8) || (ch >= 12 && ch < 20), isk = (ch == 8 || ch == 9) || (ch >= 20 && ch < 28);
                if (ch < 10) { const float ss = wave_sum(v * v); v = v * (1.0f / sqrtf(ss * (1.0f / 64.0f) + 1e-6f)) * (ch < 8 ? gq : gk); }
                float vr = v;
                if (smp && (isq || isk)) { const float p = __shfl_xor(v, 16); const float rot = (lane & 16) ? p : -p; vr = v * cs + rot * sn; }
                if (ch < 8) QA[(size_t)m * 512 + ch * 64 + lane] = (bf16)f2bf(vr * 0.18033688011112042f);
                else if (ch < 10) { const int e = (ch - 8) * 64 + lane; if (!smp) { (a.out + id.z)[O_KG + prow * 128 + e] = v; KAP[(size_t)m * 128 + e] = (bf16)f2bf(v); } else KAS[srow * 128 + e] = (bf16)f2bf(vr); }
                else if (ch < 12) { const int e = (ch - 10) * 64 + lane; if (!smp) { (a.out + id.z)[O_VG + prow * 128 + e] = v; VAP[(size_t)m * 128 + e] = (bf16)f2bf(v); } else VAS[srow * 128 + e] = (bf16)f2bf(v); }
                else if (ch < 20) QB[(size_t)m * 512 + (ch - 12) * 64 + lane] = (bf16)f2bf(vr * 0.18033688011112042f);
                else if (ch < 28) { const int e = (ch - 20) * 64 + lane; if (!smp) { (a.out + id.z)[O_KD + prow * 512 + e] = v; KBP[(size_t)m * 512 + e] = (bf16)f2bf(v); } else KBS[srow * 512 + e] = (bf16)f2bf(vr); }
                else { const int e = (ch - 28) * 64 + lane; if (!smp) { (a.out + id.z)[O_VD + prow * 512 + e] = v; VBP[(size_t)m * 512 + e] = (bf16)f2bf(v); } else VBS[srow * 512 + e] = (bf16)f2bf(v); }
            }
        } else {
            const int r = it - NTOK, b = r >> 9, pos = r & (PAST - 1);
            const size_t src = (size_t)((b * 2 + j) * PAST + pos), dst = (size_t)(b * SKV + pos);
#pragma unroll
            for (int q = 0; q < 2; ++q) { const int e = lane + 64 * q; KAS[dst * 128 + e] = (bf16)f2bf(a.in[3 + id.z][src * 128 + e]); VAS[dst * 128 + e] = (bf16)f2bf(a.in[4 + id.z][src * 128 + e]); }
#pragma unroll
            for (int q = 0; q < 8; ++q) { const int e = lane + 64 * q; KBS[dst * 512 + e] = (bf16)f2bf(a.in[5 + id.z][src * 512 + e]); VBS[dst * 512 + e] = (bf16)f2bf(a.in[6 + id.z][src * 512 + e]); }
        }
    }
}

typedef short bf16x8_t __attribute__((ext_vector_type(8)));
typedef float f32x16 __attribute__((ext_vector_type(16)));
typedef short v4i16_t __attribute__((ext_vector_type(4)));
constexpr int AT_KP = 144, AT_KBUF = 64 * AT_KP, AT_VOFF = 2 * AT_KBUF, AT_VBUFMAX = 64 * 288, AT_WSF = AT_VOFF + 2 * AT_VBUFMAX;
static_assert(AT_WSF + 8 * 128 <= RING_BYTES, "attention LDS");
template <int NDT>
__device__ __forceinline__ void attn_unit(const bf16* Qrow0, int ldq, const bf16* Kb, int ldk, const bf16* Vb, int ldv, int S, bf16* Obf, float* Of32, int ldo, LAS unsigned char* lds, const Ids& id) {
    constexpr int VP = (NDT == 2) ? 144 : 288, NVL = NDT / 2;
    const int lane = id.lane, w = id.wave, r32 = lane & 31, hi = lane >> 5, tid = id.tid;
    bf16x8_t qf[4];
    { const bf16* qrow = Qrow0 + (size_t)(32 * w + r32) * ldq;
#pragma unroll
      for (int s = 0; s < 4; ++s) qf[s] = *(const bf16x8_t*)(qrow + 16 * s + 8 * hi); }
    f32x16 o[NDT];
#pragma unroll
    for (int dt = 0; dt < NDT; ++dt)
#pragma unroll
        for (int r = 0; r < 16; ++r) o[dt][r] = 0.f;
    float m_run = -1e30f, l_run = 0.f;
    const int NT = S >> 6;
    LAS float* wsf = (LAS float*)(lds + AT_WSF + w * 128);
    const int krow = tid >> 3, kch = tid & 7;
    v4u kreg, vreg[NVL];
#define AT_GLOAD(t) do { kreg = *(const v4u*)(Kb + (size_t)((t) * 64 + krow) * ldk + 8 * kch); \
        if (NDT == 2) vreg[0] = *(const v4u*)(Vb + (size_t)((t) * 64 + krow) * ldv + 8 * kch); \
        else { _Pragma("unroll") for (int i_ = 0; i_ < NVL; ++i_) { const int ix_ = tid + 512 * i_; vreg[i_] = *(const v4u*)(Vb + (size_t)((t) * 64 + (ix_ >> 4)) * ldv + 8 * (ix_ & 15)); } } } while (0)
#define AT_LSTORE(b) do { *(LAS v4u*)(lds + (b) * AT_KBUF + krow * AT_KP + 16 * kch) = kreg; \
        if (NDT == 2) *(LAS v4u*)(lds + AT_VOFF + (b) * AT_VBUFMAX + krow * VP + 16 * kch) = vreg[0]; \
        else { _Pragma("unroll") for (int i_ = 0; i_ < NVL; ++i_) { const int ix_ = tid + 512 * i_; *(LAS v4u*)(lds + AT_VOFF + (b) * AT_VBUFMAX + (ix_ >> 4) * VP + 16 * (ix_ & 15)) = vreg[i_]; } } } while (0)
    AT_GLOAD(0); AT_LSTORE(0);
    __syncthreads();
    const int vbase = (4 * hi + ((lane & 15) >> 2)) * VP + 32 * ((lane >> 4) & 1) + 8 * (lane & 3);
#pragma unroll 1
    for (int t = 0; t < NT; ++t) {
        const int b = t & 1;
        if (t + 1 < NT) AT_GLOAD(t + 1);
        const LAS unsigned char* Kt = lds + b * AT_KBUF + r32 * AT_KP + 16 * hi;
        const LAS unsigned char* Vt = lds + AT_VOFF + b * AT_VBUFMAX + vbase;
        f32x16 p0, p1;
#pragma unroll
        for (int r = 0; r < 16; ++r) { p0[r] = 0.f; p1[r] = 0.f; }
#pragma unroll
        for (int s = 0; s < 4; ++s) { const bf16x8_t k0 = *(const LAS bf16x8_t*)(Kt + 32 * s), k1 = *(const LAS bf16x8_t*)(Kt + 32 * AT_KP + 32 * s);
            p0 = __builtin_amdgcn_mfma_f32_32x32x16_bf16(k0, qf[s], p0, 0, 0, 0); p1 = __builtin_amdgcn_mfma_f32_32x32x16_bf16(k1, qf[s], p1, 0, 0, 0); }
        float mx = fmaxf(p0[0], p1[0]);
#pragma unroll
        for (int r = 1; r < 16; ++r) mx = fmaxf(mx, fmaxf(p0[r], p1[r]));
        mx = fmaxf(mx, __shfl_xor(mx, 32));
        const float mn = fmaxf(m_run, mx), al = exp2f(m_run - mn); m_run = mn;
        float rs = 0.f;
#pragma unroll
        for (int r = 0; r < 16; ++r) { p0[r] = exp2f(p0[r] - mn); p1[r] = exp2f(p1[r] - mn); rs += p0[r] + p1[r]; }
        l_run = l_run * al + rs;
        if (hi == 0) wsf[r32] = al;
        LDS_WAIT(); asm volatile("" ::: "memory");
        { f32x4 a4[4];
#pragma unroll
          for (int g4 = 0; g4 < 4; ++g4) a4[g4] = *(const LAS f32x4*)(wsf + 8 * g4 + 4 * hi);
#pragma unroll
          for (int dt = 0; dt < NDT; ++dt)
#pragma unroll
              for (int r = 0; r < 16; ++r) o[dt][r] *= a4[r >> 2][r & 3]; }
        LDS_WAIT(); asm volatile("" ::: "memory");
        bf16x8_t pf[4];
#pragma unroll
        for (int ks = 0; ks < 4; ++ks) { v4u pw;
#pragma unroll
            for (int dd = 0; dd < 4; ++dd) { const int r = 8 * (ks & 1) + 2 * dd; pw[dd] = (ks < 2) ? pk2(p0[r], p0[r + 1]) : pk2(p1[r], p1[r + 1]); }
            pf[ks] = __builtin_bit_cast(bf16x8_t, pw); }
#pragma unroll
        for (int ks = 0; ks < 4; ++ks)
#pragma unroll
            for (int dt = 0; dt < NDT; ++dt) {
                const v4i16_t lo = __builtin_amdgcn_ds_read_tr16_b64_v4i16((LAS v4i16_t*)(Vt + (16 * ks) * VP + 64 * dt));
                const v4i16_t hh = __builtin_amdgcn_ds_read_tr16_b64_v4i16((LAS v4i16_t*)(Vt + (16 * ks + 8) * VP + 64 * dt));
                const bf16x8_t vf = (bf16x8_t){lo[0], lo[1], lo[2], lo[3], hh[0], hh[1], hh[2], hh[3]};
                o[dt] = __builtin_amdgcn_mfma_f32_32x32x16_bf16(pf[ks], vf, o[dt], 0, 0, 0); }
        if (t + 1 < NT) AT_LSTORE(b ^ 1);
        __syncthreads();
    }
#undef AT_GLOAD
#undef AT_LSTORE
    const float lt = l_run + __shfl_xor(l_run, 32);
    int lane_e = lane; asm volatile("" : "+v"(lane_e));
    const int r32e = lane_e & 31, hie = lane_e >> 5;
    if (hi == 0) wsf[r32] = 1.0f / lt;
    LDS_WAIT(); asm volatile("" ::: "memory");
    f32x4 a4[4];
#pragma unroll
    for (int g4 = 0; g4 < 4; ++g4) a4[g4] = *(const LAS f32x4*)(wsf + 8 * g4 + 4 * hi);
    LDS_WAIT(); asm volatile("" ::: "memory");
#pragma unroll
    for (int dt = 0; dt < NDT; ++dt)
#pragma unroll
        for (int r = 0; r < 16; ++r) { const float val = o[dt][r] * a4[r >> 2][r & 3]; const int off = (32 * w + (r & 3) + 8 * (r >> 2) + 4 * hie) * ldo + 32 * dt + r32e;
            if (NDT == 2) Obf[off] = (bf16)f2bf(val); else Of32[off] = val; }
}
__device__ __forceinline__ void ph_attn(const Args& a, const Ids& id, LAS unsigned char* lds, int G, int vcu) {
    const bf16 *QA = (const bf16*)(a.ws + id.z + A_QA), *QB = (const bf16*)(a.ws + id.z + A_QB), *KAP = (const bf16*)(a.ws + id.z + A_KAP), *VAP = (const bf16*)(a.ws + id.z + A_VAP), *KBP = (const bf16*)(a.ws + id.z + A_KBP), *VBP = (const bf16*)(a.ws + id.z + A_VBP);
    const bf16 *KAS = (const bf16*)(a.ws + id.z + A_KAS), *VAS = (const bf16*)(a.ws + id.z + A_VAS), *KBS = (const bf16*)(a.ws + id.z + A_KBS), *VBS = (const bf16*)(a.ws + id.z + A_VBS);
    bf16* H = (bf16*)(a.ws + id.z + A_H); float* DT = (float*)(a.ws + id.z + A_DT);
    for (int s = vcu; s < 256; s += G) {
        const int h8 = s & 7;
#pragma unroll 1
        for (int pass = 0; pass < 2; ++pass) {
            size_t m0, kvrow; int S;
            if (pass == 0) { const int b = s >> 6, qb = (s >> 3) & 7; m0 = (size_t)NPR + b * TS + qb * 256; kvrow = (size_t)b * SKV; S = SKV; }
            else { const int b = s >> 3; m0 = (size_t)b * TP; kvrow = m0; S = TP; }
            const bf16* Ka = (pass == 0 ? KAS : KAP) + kvrow * 128 + (h8 >> 2) * 64; const bf16* Va = (pass == 0 ? VAS : VAP) + kvrow * 128 + (h8 >> 2) * 64;
            const bf16* Kd = (pass == 0 ? KBS : KBP) + kvrow * 512 + h8 * 64; const bf16* Vd = (pass == 0 ? VBS : VBP) + kvrow * 512 + (h8 >> 1) * 128;
            attn_unit<2>(QA + m0 * 512 + h8 * 64, 512, Ka, 128, Va, 128, S, H + m0 * D + h8 * 64, nullptr, D, lds, id);
            attn_unit<4>(QB + m0 * 512 + h8 * 64, 512, Kd, 512, Vd, 512, S, nullptr, DT + m0 * D + h8 * 128, D, lds, id);
        }
    }
}
__device__ __forceinline__ void ph_att_comb(const Args& a, const Ids& id, int layer) {
    const int j = layer >> 1, lane = id.lane; const float lam_init = (layer == 0) ? 0.2f : 0.4707130183435842f;
    const float* lf = a.in[15 + id.z] + j * 256; const float* sg = a.in[16 + id.z] + j * 128;
    const float s01 = wave_sum(lf[lane] * lf[64 + lane]), s23 = wave_sum(lf[128 + lane] * lf[192 + lane]);
    const float lam = expf(s01) - expf(s23) + lam_init;
    const float* DT = (const float*)(a.ws + id.z + A_DT); bf16* H = (bf16*)(a.ws + id.z + A_H);
    const float g0 = sg[lane] * (1.0f - lam_init), g1 = sg[64 + lane] * (1.0f - lam_init);
    for (int it = id.gw; it < NTOK * 4; it += id.ngw) { const int m = it >> 2, hd = it & 3; const float* p = DT + (size_t)m * D + hd * 256;
        const float v0 = p[lane] - lam * p[128 + lane], v1 = p[64 + lane] - lam * p[192 + lane];
        const float ss = wave_sum(v0 * v0 + v1 * v1); const float ri = 1.0f / sqrtf(ss * (1.0f / 128.0f) + 1e-6f);
        bf16* o = H + (size_t)m * D + 512 + hd * 128; o[lane] = (bf16)f2bf(v0 * ri * g0); o[64 + lane] = (bf16)f2bf(v1 * ri * g1); }
}

__device__ __forceinline__ void ph_rw_prep(const Args& a, const Ids& id, int layer) {
    const int j = layer >> 1, lane = id.lane;
    const bf16* RKV = (const bf16*)(a.ws + id.z + A_RKV); float* INV = (float*)(a.ws + id.z + WS_INV); float* Y = (float*)(a.ws + id.z + A_Y);
    const float* kk_c = a.in[28 + id.z] + (size_t)(j * 3 + 0) * D;
    for (int m = id.gw; m < NTOK; m += id.ngw) {
#pragma unroll 4
        for (int h = 0; h < 16; ++h) { const float kv = bf2f(RKV[(size_t)m * 3072 + 1024 + h * 64 + lane]) * kk_c[h * 64 + lane]; const float ss = wave_sum(kv * kv); if (lane == 0) INV[m * 16 + h] = 1.0f / sqrtf(ss + 1e-12f); }
        f32x4* yp = (f32x4*)(Y + (size_t)m * D);
#pragma unroll
        for (int q = 0; q < 4; ++q) yp[lane + 64 * q] = (f32x4){0.f, 0.f, 0.f, 0.f};
    }
}

constexpr int SC_TC = 16, SC_ROWF = 352;
constexpr int SC_OPF = SC_TC * SC_ROWF;
constexpr int SC_YOFF = 4 * SC_OPF;
static_assert((SC_YOFF + 4 * SC_TC * 32) * 4 <= RING_BYTES, "scan LDS");
struct ScDesc { int mbase, T, h, dir, half, b; };
__device__ __forceinline__ void sc_desc(ScDesc& d, int slot, int grp, int c) {
    if (grp == 0) { const int cs = slot >> 1; d.b = cs >> 5; d.h = (cs >> 1) & 15; d.dir = cs & 1; d.half = slot & 1; d.T = TS; d.mbase = NPR + d.b * TS; }
    else { const int pu = slot * 8 + (c >> 4), cp = pu >> 1; d.b = cp >> 5; d.h = (cp >> 1) & 15; d.dir = cp & 1; d.half = pu & 1; d.T = TP; d.mbase = d.b * TP; }
}
__device__ __forceinline__ int sc_tok(const ScDesc& d, int grp, int c, int i) { const int s = (grp == 0 ? c : (c & 15)) * SC_TC + i; return d.mbase + (d.dir ? d.T - 1 - s : s); }
template <int N> __device__ __forceinline__ float dpp_ror(float x) { return __builtin_bit_cast(float, __builtin_amdgcn_update_dpp(0, __builtin_bit_cast(int, x), 0x120 + N, 0xf, 0xf, false)); }
__device__ __forceinline__ float row16_sum(float x) { x += dpp_ror<8>(x); x += dpp_ror<4>(x); x += dpp_ror<2>(x); x += dpp_ror<1>(x); return x; }
__device__ __forceinline__ float fma_s(float a, float b, float c) { float r; asm("v_fma_f32 %0, %1, %2, %3" : "=v"(r) : "v"(a), "v"(b), "v"(c)); return r; }
__device__ __forceinline__ float fnma_s(float a, float b, float c) { float r; asm("v_fma_f32 %0, -%1, %2, %3" : "=v"(r) : "v"(a), "v"(b), "v"(c)); return r; }
__device__ __forceinline__ float mul_s(float a, float b) { float r; asm("v_mul_f32_e32 %0, %1, %2" : "=v"(r) : "v"(a), "v"(b)); return r; }
__device__ __forceinline__ float add_s(float a, float b) { float r; asm("v_add_f32_e32 %0, %1, %2" : "=v"(r) : "v"(a), "v"(b)); return r; }
__device__ __forceinline__ void row16_sum4(float& a, float& b, float& c, float& d) {
    asm("s_nop 1\n\t"
        "v_add_f32_dpp %0, %0, %0 row_ror:8 row_mask:0xf bank_mask:0xf\n\tv_add_f32_dpp %1, %1, %1 row_ror:8 row_mask:0xf bank_mask:0xf\n\tv_add_f32_dpp %2, %2, %2 row_ror:8 row_mask:0xf bank_mask:0xf\n\tv_add_f32_dpp %3, %3, %3 row_ror:8 row_mask:0xf bank_mask:0xf\n\t"
        "v_add_f32_dpp %0, %0, %0 row_ror:4 row_mask:0xf bank_mask:0xf\n\tv_add_f32_dpp %1, %1, %1 row_ror:4 row_mask:0xf bank_mask:0xf\n\tv_add_f32_dpp %2, %2, %2 row_ror:4 row_mask:0xf bank_mask:0xf\n\tv_add_f32_dpp %3, %3, %3 row_ror:4 row_mask:0xf bank_mask:0xf\n\t"
        "v_add_f32_dpp %0, %0, %0 row_ror:2 row_mask:0xf bank_mask:0xf\n\tv_add_f32_dpp %1, %1, %1 row_ror:2 row_mask:0xf bank_mask:0xf\n\tv_add_f32_dpp %2, %2, %2 row_ror:2 row_mask:0xf bank_mask:0xf\n\tv_add_f32_dpp %3, %3, %3 row_ror:2 row_mask:0xf bank_mask:0xf\n\t"
        "v_add_f32_dpp %0, %0, %0 row_ror:1 row_mask:0xf bank_mask:0xf\n\tv_add_f32_dpp %1, %1, %1 row_ror:1 row_mask:0xf bank_mask:0xf\n\tv_add_f32_dpp %2, %2, %2 row_ror:1 row_mask:0xf bank_mask:0xf\n\tv_add_f32_dpp %3, %3, %3 row_ror:1 row_mask:0xf bank_mask:0xf\n\ts_nop 1"
        : "+v"(a), "+v"(b), "+v"(c), "+v"(d));
}
struct ScOps { f32x4 w, kd, kk, ka, r; float va, vb; };
__device__ __forceinline__ void sc_ldops(ScOps& o, const LAS float* p, int g, int rg) {
    o.w = *(const LAS f32x4*)(p + 4 * g); o.kd = *(const LAS f32x4*)(p + 64 + 4 * g); o.kk = *(const LAS f32x4*)(p + 128 + 4 * g); o.ka = *(const LAS f32x4*)(p + 192 + 4 * g); o.r = *(const LAS f32x4*)(p + 256 + 4 * g);
    o.va = p[320 + 2 * rg]; o.vb = p[321 + 2 * rg];
}
struct ScRaw { float r[4], k[4], a[4], e[4], v[4], iv[4]; };
__device__ __forceinline__ void sc_load(ScRaw& R, const Args& a, const Ids& id, int slot, int c) {
    const int w = id.wave, grp = w >> 2, lane = id.lane; ScDesc d; sc_desc(d, slot, grp, c);
    const bf16* RKV = (const bf16*)(a.ws + id.z + A_RKV); const float* INV = (const float*)(a.ws + id.z + WS_INV);
    const bf16* Ad = (const bf16*)(a.ws + id.z + (d.dir ? A_A1 : A_A0)); const bf16* EWd = (const bf16*)(a.ws + id.z + (d.dir ? A_EW1 : A_EW0));
#pragma unroll
    for (int q = 0; q < 4; ++q) { const int m = sc_tok(d, grp, c, (w & 3) * 4 + q); const size_t o = (size_t)m * 3072 + d.h * 64 + lane, o2 = (size_t)m * D + d.h * 64 + lane;
        R.r[q] = bf2f(RKV[o]); R.k[q] = bf2f(RKV[o + 1024]); R.a[q] = bf2f(Ad[o2]); R.e[q] = bf2f(EWd[o2]); R.iv[q] = INV[m * 16 + d.h];
        R.v[q] = bf2f(RKV[(size_t)m * 3072 + 2048 + d.h * 64 + d.half * 32 + (lane & 31)]); }
}
__device__ __forceinline__ void sc_derive(const ScRaw& R, const Args& a, const Ids& id, LAS float* L, int layer, int slot, int c, int buf) {
    const int w = id.wave, grp = w >> 2, lane = id.lane, j = layer >> 1; ScDesc d; sc_desc(d, slot, grp, c);
    const float kkc = a.in[28 + id.z][(size_t)(j * 3 + 0) * D + d.h * 64 + lane], kac = a.in[28 + id.z][(size_t)(j * 3 + 1) * D + d.h * 64 + lane];
#pragma unroll
    for (int q = 0; q < 4; ++q) { LAS float* p = L + (buf * 2 + grp) * SC_OPF + ((w & 3) * 4 + q) * SC_ROWF;
        const float kk = R.k[q] * kkc * R.iv[q];
        p[lane] = exp2f(-R.e[q]); p[64 + lane] = R.k[q] * (1.0f + (R.a[q] - 1.0f) * kac); p[128 + lane] = kk; p[192 + lane] = kk * R.a[q]; p[256 + lane] = R.r[q];
        if (lane < 32) p[320 + lane] = R.v[q]; }
}
__device__ __forceinline__ void ph_rw_scan(const Args& a, const Ids& id, LAS unsigned char* lds, int layer, int G, int vcu) {
    const int j = layer >> 1, lane = id.lane, w = id.wave, grp = w >> 2, g = lane & 15, rg = (w & 3) * 4 + (lane >> 4);
    LAS float* L = (LAS float*)lds; float* Y = (float*)(a.ws + id.z + A_Y);
    constexpr int NC = TS / SC_TC;
    for (int slot = vcu; slot < 256; slot += G) {
        f32x4 Sa, Sb;
        { ScDesc d; sc_desc(d, slot, 0, 0);
          if (grp == 0) { const float* sp = a.in[7 + id.z] + ((((size_t)(d.b * 2 + j) * 2 + d.dir) * 16 + d.h) * 64 + d.half * 32 + 2 * rg) * 64 + 4 * g; Sa = *(const f32x4*)sp; Sb = *(const f32x4*)(sp + 64); }
          else { Sa = (f32x4){0.f, 0.f, 0.f, 0.f}; Sb = Sa; } }
        ScRaw R; sc_load(R, a, id, slot, 0); sc_derive(R, a, id, L, layer, slot, 0, 0);
        __syncthreads();
#pragma unroll 1
        for (int c = 0; c < NC; ++c) {
            const int buf = c & 1;
            if (c + 1 < NC) sc_load(R, a, id, slot, c + 1);
            if (c > 0) {
#pragma unroll
                for (int q = 0; q < 2; ++q) { const int idx = id.tid + 512 * q, fg = idx >> 9, s = (idx >> 5) & 15, row = idx & 31; ScDesc d; sc_desc(d, slot, fg, c - 1);
                    const float yv = L[SC_YOFF + ((buf ^ 1) * 2 + fg) * SC_TC * 32 + s * 32 + row];
                    atomicAdd(&Y[(size_t)sc_tok(d, fg, c - 1, s) * D + d.h * 64 + d.half * 32 + row], yv); } }
            if (grp == 1 && (c & 15) == 0) { Sa = (f32x4){0.f, 0.f, 0.f, 0.f}; Sb = Sa; }
            const LAS float* ob = L + (buf * 2 + grp) * SC_OPF; LAS float* yb = L + SC_YOFF + (buf * 2 + grp) * SC_TC * 32 + 2 * rg;
            {
                ScOps cur, nxt; sc_ldops(cur, ob, g, rg);
                float ypa = 0.f, ypb = 0.f;
#pragma unroll
                for (int i = 0; i < SC_TC; ++i) {
                    if (i + 1 < SC_TC) sc_ldops(nxt, ob + (i + 1) * SC_ROWF, g, rg);
                    float ua[4], ub[4];
#pragma unroll
                    for (int e2 = 0; e2 < 4; ++e2) { ua[e2] = fma_s(Sa[e2], cur.w[e2], mul_s(cur.va, cur.kd[e2])); ub[e2] = fma_s(Sb[e2], cur.w[e2], mul_s(cur.vb, cur.kd[e2])); }
                    float ska = add_s(fma_s(Sa[1], cur.kk[1], mul_s(Sa[0], cur.kk[0])), fma_s(Sa[3], cur.kk[3], mul_s(Sa[2], cur.kk[2])));
                    float skb = add_s(fma_s(Sb[1], cur.kk[1], mul_s(Sb[0], cur.kk[0])), fma_s(Sb[3], cur.kk[3], mul_s(Sb[2], cur.kk[2])));
                    row16_sum4(ska, skb, ypa, ypb);
                    if (i > 0 && g == 0) { yb[(i - 1) * 32] = ypa; yb[(i - 1) * 32 + 1] = ypb; }
#pragma unroll
                    for (int e2 = 0; e2 < 4; ++e2) { Sa[e2] = fnma_s(ska, cur.ka[e2], ua[e2]); Sb[e2] = fnma_s(skb, cur.ka[e2], ub[e2]); }
                    ypa = add_s(fma_s(Sa[1], cur.r[1], mul_s(Sa[0], cur.r[0])), fma_s(Sa[3], cur.r[3], mul_s(Sa[2], cur.r[2])));
                    ypb = add_s(fma_s(Sb[1], cur.r[1], mul_s(Sb[0], cur.r[0])), fma_s(Sb[3], cur.r[3], mul_s(Sb[2], cur.r[2])));
                    if (i + 1 < SC_TC) cur = nxt;
                }
                float z0 = 0.f, z1 = 0.f; row16_sum4(ypa, ypb, z0, z1);
                if (g == 0) { yb[(SC_TC - 1) * 32] = ypa; yb[(SC_TC - 1) * 32 + 1] = ypb; }
            }
            if (grp == 1 && (c & 15) == 15) { ScDesc d; sc_desc(d, slot, 1, c);
                float* dp = a.out + id.z + O_ST + ((((size_t)(d.b * 2 + j) * 2 + d.dir) * 16 + d.h) * 64 + d.half * 32 + 2 * rg) * 64 + 4 * g; *(f32x4*)dp = Sa; *(f32x4*)(dp + 64) = Sb; }
            if (c + 1 < NC) sc_derive(R, a, id, L, layer, slot, c + 1, buf ^ 1);
            __syncthreads();
        }
        {
#pragma unroll
            for (int q = 0; q < 2; ++q) { const int idx = id.tid + 512 * q, fg = idx >> 9, s = (idx >> 5) & 15, row = idx & 31; ScDesc d; sc_desc(d, slot, fg, NC - 1);
                const float yv = L[SC_YOFF + (((NC - 1) & 1) * 2 + fg) * SC_TC * 32 + s * 32 + row];
                atomicAdd(&Y[(size_t)sc_tok(d, fg, NC - 1, s) * D + d.h * 64 + d.half * 32 + row], yv); }
        }
        __syncthreads();
    }
}
__device__ __forceinline__ void ph_rw_post(const Args& a, const Ids& id, int layer) {
    const int j = layer >> 1, lane = id.lane;
    const bf16* RKV = (const bf16*)(a.ws + id.z + A_RKV); const float* Y = (const float*)(a.ws + id.z + A_Y);
    const bf16 *A0 = (const bf16*)(a.ws + id.z + A_A0), *A1 = (const bf16*)(a.ws + id.z + A_A1); bf16* H = (bf16*)(a.ws + id.z + A_H);
    const float* kvec = a.in[28 + id.z] + (size_t)j * 3 * D; const float* lnx = a.in[29 + id.z] + (size_t)j * 2 * D;
    for (int m = id.gw; m < NTOK; m += id.ngw) {
#pragma unroll 4
        for (int h = 0; h < 16; ++h) {
            const int c = h * 64 + lane;
            const float g = bf2f(H[(size_t)m * D + c]);
            const float y = Y[(size_t)m * D + c]; const float mean = wave_sum(y) * (1.0f / 64.0f); const float dv = y - mean; const float var = wave_sum(dv * dv) * (1.0f / 64.0f);
            float yn = dv * (1.0f / sqrtf(var + 64e-5f)); yn = yn * lnx[c] + lnx[D + c];
            const size_t o = (size_t)m * 3072 + c; const float r = bf2f(RKV[o]), k = bf2f(RKV[o + 1024]), v = bf2f(RKV[o + 2048]);
            const float a0 = bf2f(A0[(size_t)m * D + c]), a1 = bf2f(A1[(size_t)m * D + c]); const float ka = kvec[D + c], rk = kvec[2 * D + c];
            const float kds = k * (1.0f + (a0 - 1.0f) * ka) + k * (1.0f + (a1 - 1.0f) * ka);
            const float bs = wave_sum(r * kds * rk);
            H[(size_t)m * D + c] = (bf16)f2bf((yn + bs * v) * g);
        }
    }
}

enum Kind { K_PRO = 0, K_NORM0 = 1, K_QKV = 2, K_APOST = 3, K_ATTN = 4, K_ACOMB = 5, K_MIXOUT = 6, K_RNORM = 7, K_MLP1 = 8, K_MLP2 = 9, K_REND = 10,
            K_RMIX = 11, K_RKV = 12, K_RPREP = 13, K_RSCAN = 14, K_RPOST = 15 };
constexpr int NPH = 40;
__host__ __device__ __forceinline__ void decode_phase(int ph, int& kind, int& layer) {
    if (ph < 2) { kind = ph; layer = 0; return; }
    const int p = ph - 2, pair = p / 19, q = p % 19;
    if (q < 9) { layer = 2 * pair; kind = K_QKV + q; }
    else { layer = 2 * pair + 1; const int q2 = q - 9; kind = (q2 < 5) ? (K_RMIX + q2) : (K_MIXOUT + (q2 - 5)); }
}

#ifndef PROBE_KIND
#define PROBE_KIND -1
#endif
#ifndef PROBE_REPS
#define PROBE_REPS 1
#endif
template <int KIND, int LAYER>
__device__ __forceinline__ void run_phase(const Args& a, LAS unsigned char* lds, int G, int bx, int vcu, int wave_s, int rep) {
    Ids id; { int lv; asm volatile("v_mbcnt_lo_u32_b32 %0, -1, 0\n\tv_mbcnt_hi_u32_b32 %0, -1, %0" : "=v"(lv)); int zz; asm volatile("s_mov_b32 %0, 0" : "=s"(zz)); id.lane = lv; id.z = zz; }
    id.wave = wave_s; id.tid = wave_s * 64 + id.lane; id.gw = vcu * NWAVES + id.wave; id.ngw = G * NWAVES;
    constexpr int layer = LAYER;
    if constexpr (KIND == K_PRO) ph_prologue(a, id, lds);
    else if constexpr (KIND == K_NORM0) ph_norm0(a, id);
    else if constexpr (KIND == K_QKV) {
        pg8::Gemm g{(const bf16*)(a.ws + id.z + A_H), (const bf16*)(a.ws + id.z + W_WINT), NTOK, NQKV, D}; pg8::StaticOrder S; S.init(NTOK, NQKV, G, bx);
        pg8::EpiF32 E{(float*)(a.ws + id.z + A_QKVRAW), NQKV};
        pg8::gemm_phase<pg8::EpiF32, pg8::StaticOrder, true, true>(lds + RING_OFF, g, S, E, id.wave);
    }
    else if constexpr (KIND == K_MIXOUT) {
        pg8::Gemm g{(const bf16*)(a.ws + id.z + A_H), (const bf16*)(a.ws + id.z + ((layer & 1) ? W_WOT : W_WOUTT)), NTOK, D, D}; pg8::StaticOrder S; S.init(NTOK, D, G, bx);
        pg8::EpiF32 E{(float*)(a.ws + id.z + A_M), D};
        pg8::gemm_phase<pg8::EpiF32, pg8::StaticOrder, true, true>(lds + RING_OFF, g, S, E, id.wave);
    }
    else if constexpr (KIND == K_MLP2) {
        pg8::Gemm g{(const bf16*)(a.ws + id.z + A_HID), (const bf16*)(a.ws + id.z + W_W2T), NTOK, D, FF}; pg8::StaticOrder S; S.init(NTOK, D, G, bx);
        pg8::EpiF32 E{(float*)(a.ws + id.z + A_F), D};
        pg8::gemm_phase<pg8::EpiF32, pg8::StaticOrder, true, true>(lds + RING_OFF, g, S, E, id.wave);
    }
    else if constexpr (KIND == K_MLP1) {
        pg8::Gemm g{(const bf16*)(a.ws + id.z + A_H), (const bf16*)(a.ws + id.z + W_W1T), NTOK, FF, D}; pg8::StaticOrder S; S.init(NTOK, FF, G, bx);
        pg8::EpiBf16<2> E{(bf16*)(a.ws + id.z + A_HID), FF, 1 << 20, nullptr, 0};
        pg8::gemm_phase<pg8::EpiBf16<2>, pg8::StaticOrder, true, true>(lds + RING_OFF, g, S, E, id.wave);
    }
    else if constexpr (KIND == K_RKV) {
        pg8::Gemm g{(const bf16*)(a.ws + id.z + A_A2), (const bf16*)(a.ws + id.z + W_BT1), NTOK, NRKV, KRKV}; pg8::StaticOrder S; S.init(NTOK, NRKV, G, bx);
        pg8::EpiRkv E{(bf16*)(a.ws + id.z + A_RKV), (bf16*)(a.ws + id.z + A_L1)};
        pg8::gemm_phase<pg8::EpiRkv, pg8::StaticOrder, true, true>(lds + RING_OFF, g, S, E, id.wave);
    }
    else if constexpr (KIND == K_RPREP) {
        constexpr int j = layer >> 1;
        pg8::Gemm g{(const bf16*)(a.ws + id.z + A_L1), (const bf16*)(a.ws + id.z + W_BT2), NTOK, 5120, 384}; pg8::StaticOrder S; S.init(NTOK, 5120, G, bx);
        static_assert(A_A1 - A_A0 == 32 * MiB && A_EW0 - A_A0 == 64 * MiB && A_EW1 - A_A0 == 96 * MiB, "EpiLora2 output stride");
        pg8::EpiLora2 E{(bf16*)(a.ws + id.z + A_A0), (size_t)16 * MiB, (bf16*)(a.ws + id.z + A_G), a.in[23 + id.z] + (size_t)j * 2 * D, a.in[20 + id.z] + (size_t)j * 2 * D};
        pg8::gemm_phase<pg8::EpiLora2, pg8::StaticOrder, true, true>(lds + RING_OFF, g, S, E, id.wave);
        { Ids id2 = id; int lv; asm volatile("v_mbcnt_lo_u32_b32 %0, -1, 0\n\tv_mbcnt_hi_u32_b32 %0, -1, %0" : "=v"(lv)); int zz; asm volatile("s_mov_b32 %0, 0" : "=s"(zz));
          id2.lane = lv; id2.z = zz; id2.tid = id.wave * 64 + lv; ph_rw_prep(a, id2, layer); }
    }
    else if constexpr (KIND == K_APOST) ph_att_post(a, id, layer);
    else if constexpr (KIND == K_ATTN) ph_attn(a, id, lds, G, vcu);
    else if constexpr (KIND == K_ACOMB) ph_att_comb(a, id, layer);
    else if constexpr (KIND == K_RNORM) ph_resid_norm(a, id, layer);
    else if constexpr (KIND == K_REND) ph_resid_end(a, id, lds, layer);
    else if constexpr (KIND == K_RMIX) ph_rw_mix(a, id, layer);
    else if constexpr (KIND == K_RSCAN) { if (rep > 0) { ph_rw_prep(a, id, layer); __syncthreads(); cg::this_grid().sync(); } ph_rw_scan(a, id, lds, layer, G, vcu); }
    else if constexpr (KIND == K_RPOST) ph_rw_post(a, id, layer);
}

__global__ void __launch_bounds__(NWAVES * 64, 2) mega_fwd(Args a) {
    extern __shared__ __attribute__((aligned(16))) unsigned char lds_raw[];
    LAS unsigned char* lds = (LAS unsigned char*)lds_raw;
    const int G = gridDim.x, bx = blockIdx.x; const int vcu = (G % 8 == 0) ? (bx % 8) * (G / 8) + bx / 8 : bx;
    volatile LAS unsigned* MISC = (volatile LAS unsigned*)(lds + MISC_OFF);
    for (int u = threadIdx.x; u < (LDS_BYTES - LDSCTL_OFF) / 4; u += NWAVES * 64) ((LAS unsigned*)(lds + LDSCTL_OFF))[u] = 0u;
    __syncthreads();
#if MK_N_LAUNCHES == 1 && !MK_CG_BARRIER
    XcdBarrier bar = xcd_barrier_post((unsigned*)(a.ws + WS_CTL) + CW_BAR, MISC + 8, threadIdx.x == 0);
#endif
    (void)MISC;
    const int lo = a.ph_lo, hi = a.ph_hi;
    const int wave_s = __builtin_amdgcn_readfirstlane(threadIdx.x >> 6);
#if MK_N_LAUNCHES == 1
#if MK_CG_BARRIER
#define GRID_BAR(ph) cg::this_grid().sync()
#else
#define GRID_BAR(ph) do { if ((ph) == 0) cg::this_grid().sync(); else { int l_; asm volatile("v_mbcnt_lo_u32_b32 %0, -1, 0\n\tv_mbcnt_hi_u32_b32 %0, -1, %0" : "=v"(l_)); xcd_barrier(bar, wave_s == 0 && l_ == 0); } } while (0)
#endif
#else
#define GRID_BAR(ph) do { } while (0)
#endif
#define PHASE(ph, KIND, LAYER) do { if (lo <= (ph) && (ph) < hi) { constexpr int nrep_ = ((KIND) == PROBE_KIND) ? PROBE_REPS : 1; \
        _Pragma("unroll 1") for (int rep_ = 0; rep_ < nrep_; ++rep_) { run_phase<KIND, LAYER>(a, lds, G, bx, vcu, wave_s, rep_); if (rep_ + 1 < nrep_) { __syncthreads(); cg::this_grid().sync(); } } \
        if ((ph) + 1 < hi) GRID_BAR(ph); } } while (0)
#define ATTN_LAYER(p0, L) PHASE((p0) + 0, K_QKV, L); PHASE((p0) + 1, K_APOST, L); PHASE((p0) + 2, K_ATTN, L); PHASE((p0) + 3, K_ACOMB, L); PHASE((p0) + 4, K_MIXOUT, L); \
        PHASE((p0) + 5, K_RNORM, L); PHASE((p0) + 6, K_MLP1, L); PHASE((p0) + 7, K_MLP2, L); PHASE((p0) + 8, K_REND, L)
#define RWKV_LAYER(p0, L) PHASE((p0) + 0, K_RMIX, L); PHASE((p0) + 1, K_RKV, L); PHASE((p0) + 2, K_RPREP, L); PHASE((p0) + 3, K_RSCAN, L); PHASE((p0) + 4, K_RPOST, L); PHASE((p0) + 5, K_MIXOUT, L); \
        PHASE((p0) + 6, K_RNORM, L); PHASE((p0) + 7, K_MLP1, L); PHASE((p0) + 8, K_MLP2, L); PHASE((p0) + 9, K_REND, L)
    PHASE(0, K_PRO, 0); PHASE(1, K_NORM0, 0);
    ATTN_LAYER(2, 0); RWKV_LAYER(11, 1); ATTN_LAYER(21, 2); RWKV_LAYER(30, 3);
#undef PHASE
#undef ATTN_LAYER
#undef RWKV_LAYER
#undef GRID_BAR
}

extern "C" void kernel_launch(void* const* d_in, const int* in_sizes, int n_in, void* d_out, int out_size, void* d_ws, size_t ws_size, hipStream_t stream) {
    static int grid = 0;
    if (grid == 0) {
        if (n_in != 32 || (size_t)out_size != OUT_TOTAL || ws_size < WS_END) { fprintf(stderr, "kernel_launch: unexpected problem (n_in %d, out %d, ws %zu; need ws >= %zu); nothing launched\n", n_in, out_size, ws_size, (size_t)WS_END); grid = -1; return; }
        int dev = 0, cus = 0, per_cu = 0;
        if (hipGetDevice(&dev) != hipSuccess || hipDeviceGetAttribute(&cus, hipDeviceAttributeMultiprocessorCount, dev) != hipSuccess) { grid = -1; return; }
        if (hipFuncSetAttribute((const void*)mega_fwd, hipFuncAttributeMaxDynamicSharedMemorySize, LDS_BYTES) != hipSuccess) { fprintf(stderr, "kernel_launch: hipFuncSetAttribute failed\n"); grid = -1; return; }
        if (hipOccupancyMaxActiveBlocksPerMultiprocessor(&per_cu, (const void*)mega_fwd, NWAVES * 64, LDS_BYTES) != hipSuccess || per_cu < 1) { fprintf(stderr, "kernel_launch: occupancy query failed (%d)\n", per_cu); (void)hipGetLastError(); per_cu = 1; }
        grid = cus * (per_cu < 1 ? 1 : 1);
        fprintf(stderr, "kernel_launch: %d CUs, occupancy %d/CU, grid %d\n", cus, per_cu, grid);
    }
    if (grid < 0) return;
    (void)in_sizes;
    if (hipMemsetAsync((char*)d_ws + WS_CTL, 0, CTL_ZERO_BYTES, stream) != hipSuccess) { fprintf(stderr, "kernel_launch: memset failed\n"); return; }
    Args a{};
    for (int i = 0; i < 32; ++i) a.in[i] = (const float*)d_in[i];
    a.out = (float*)d_out; a.ws = (unsigned char*)d_ws;
#if MK_N_LAUNCHES == 1
    a.ph_lo = 0; a.ph_hi = NPH;
    void* args[] = {&a};
    hipError_t e = hipLaunchCooperativeKernel((const void*)mega_fwd, dim3(grid), dim3(NWAVES * 64), args, LDS_BYTES, stream);
    if (e != hipSuccess) fprintf(stderr, "kernel_launch: cooperative launch failed: %s (grid %d)\n", hipGetErrorString(e), grid);
#else
    for (int ph = 0; ph < NPH; ++ph) {
        a.ph_lo = ph; a.ph_hi = ph + 1;
        hipLaunchKernelGGL(mega_fwd, dim3(grid), dim3(NWAVES * 64), LDS_BYTES, stream, a);
    }
#endif
}
```

```cpp
#include <hip/hip_runtime.h>
#include <hip/hip_cooperative_groups.h>
#include <cstdio>
#include <cstdint>
namespace cg = cooperative_groups;
namespace pg8 {
#define PG8_LAS __attribute__((address_space(3)))
typedef unsigned short bf16_t;
typedef short bf16x8 __attribute__((ext_vector_type(8)));
typedef float f32x4 __attribute__((ext_vector_type(4)));
typedef unsigned u32x4 __attribute__((ext_vector_type(4)));
constexpr int BM = 256, BK = 64, HALF = 128, HTB = HALF * BK * 2  , STAGE_BYTES = 8 * HTB, NXCD = 8, WGM = 8;

__host__ __device__ __forceinline__ int lds_byte(int r, int c) { const int st = (r >> 4) * 2 + (c >> 5), rr = r & 15, cc = c & 31, ob = rr * 64 + cc * 2; return st * 1024 + (ob ^ (((ob >> 9) & 1) << 5)); }
__host__ __device__ __forceinline__ void stage_rc(int b, int& R, int& C) { const int st = b / 1024, sb = b % 1024, swz = sb ^ (((sb >> 9) & 1) << 5); R = (st >> 1) * 16 + swz / 64; C = (st & 1) * 32 + (swz % 64) / 2; }
__host__ __device__ __forceinline__ int perm32(int rho) { const int n = rho >> 4, i = rho & 15; return 8 * (i >> 2) + 4 * n + (i & 3); }

struct Unit { int pm, pn; };
struct Gemm { const bf16_t* A; const bf16_t* Bt; int M, N, K; };

struct StaticOrder {
    int nM, nN, nwg, G, c;
    __host__ __device__ void init(int M, int N, int G_, int c_) { nM = M / BM; nN = N / BM; nwg = nM * nN; G = G_; c = c_; }
    __host__ __device__ bool next(int i, Unit& u) const {
        const long L = (long)i * G + c; if (L >= nwg) return false;
        int wgid = (int)L; { const int q = nwg / NXCD, r = nwg % NXCD, xcd = wgid % NXCD, off = wgid / NXCD; wgid = (xcd < r ? xcd * (q + 1) : r * (q + 1) + (xcd - r) * q) + off; }
        const int nig = WGM * nN, gid = wgid / nig, fm = gid * WGM, gsz = (nM - fm) < WGM ? (nM - fm) : WGM;
        u.pm = fm + ((wgid % nig) % gsz); u.pn = (wgid % nig) / gsz; return true;
    }
    __device__ __forceinline__ void a_ready(const Unit&) const {}
    __device__ __forceinline__ void done(const Unit&) const {}
};


__device__ __forceinline__ unsigned cvt_pk_bf16(float lo, float hi) { unsigned r; asm volatile("v_cvt_pk_bf16_f32 %0, %1, %2" : "=v"(r) : "v"(lo), "v"(hi)); return r; }

struct EpiF32 {
    static constexpr bool PERM = false, AFTER_DRAIN = false;
    float* C; int ldc;
    __device__ __forceinline__ void operator()(const f32x4 (&acc)[2][2][4][2], const Unit& u, int wr, int wc, int fr, int fq) const {
        const int row0 = u.pm * BM + wr * 64 + fr, col0 = u.pn * BM + wc * 32 + 4 * fq;
#pragma unroll
        for (int ai = 0; ai < 2; ++ai)
#pragma unroll
            for (int m = 0; m < 4; ++m) { float* rowp = C + (size_t)(row0 + ai * HALF + m * 16) * ldc + col0;
#pragma unroll
                for (int bj = 0; bj < 2; ++bj)
#pragma unroll
                    for (int n = 0; n < 2; ++n) *(f32x4*)(rowp + bj * HALF + n * 16) = acc[ai][bj][m][n]; }
    }
    __device__ __forceinline__ void fused(f32x4 (&)[2][2][4][2], const Unit&, int, int, int, int, PG8_LAS unsigned char*, int, int) const {}
};

template <int ACT> struct EpiBf16 {
    static constexpr bool PERM = true, AFTER_DRAIN = false;
    bf16_t* O0; int ld0; int nt0; bf16_t* O1; int ld1;
    __device__ __forceinline__ void operator()(const f32x4 (&acc)[2][2][4][2], const Unit& u, int wr, int wc, int fr, int fq) const {
        const int row0 = u.pm * BM + wr * 64 + fr;
        bf16_t* base; int ldc, colt;
        if (u.pn < nt0) { base = O0; ldc = ld0; colt = u.pn * BM; } else { base = O1; ldc = ld1; colt = (u.pn - nt0) * BM; }
        const int col0 = colt + wc * 32 + 8 * fq;
#pragma unroll
        for (int ai = 0; ai < 2; ++ai)
#pragma unroll
            for (int m = 0; m < 4; ++m) { bf16_t* rowp = base + (size_t)(row0 + ai * HALF + m * 16) * ldc + col0;
#pragma unroll
                for (int bj = 0; bj < 2; ++bj) { f32x4 v0 = acc[ai][bj][m][0], v1 = acc[ai][bj][m][1];
                    if (ACT == 2) {
#pragma unroll
                        for (int e = 0; e < 4; ++e) { float a = v0[e] > 0.f ? v0[e] : 0.f; v0[e] = a * a; float b = v1[e] > 0.f ? v1[e] : 0.f; v1[e] = b * b; } }
                    u32x4 w; w.x = cvt_pk_bf16(v0[0], v0[1]); w.y = cvt_pk_bf16(v0[2], v0[3]); w.z = cvt_pk_bf16(v1[0], v1[1]); w.w = cvt_pk_bf16(v1[2], v1[3]);
                    *(u32x4*)(rowp + bj * HALF) = w; } }
    }
    __device__ __forceinline__ void fused(f32x4 (&)[2][2][4][2], const Unit&, int, int, int, int, PG8_LAS unsigned char*, int, int) const {}
};


__device__ __forceinline__ float sig_f(float x) { return 1.0f / (1.0f + __expf(-x)); }
struct EpiRkv {
    static constexpr bool PERM = true, AFTER_DRAIN = false;
    bf16_t* RKV; bf16_t* L1;
    __device__ __forceinline__ void operator()(const f32x4 (&acc)[2][2][4][2], const Unit& u, int wr, int wc, int fr, int fq) const {
        const int row0 = u.pm * BM + wr * 64 + fr;
        const bool lora = u.pn >= 12; bf16_t* base = lora ? L1 : RKV; const int ldc = lora ? 384 : 3072, colt = lora ? (u.pn - 12) * BM : u.pn * BM;
        const int col0 = colt + wc * 32 + 8 * fq;
#pragma unroll
        for (int ai = 0; ai < 2; ++ai)
#pragma unroll
            for (int m = 0; m < 4; ++m) { bf16_t* rowp = base + (size_t)(row0 + ai * HALF + m * 16) * ldc + col0;
#pragma unroll
                for (int bj = 0; bj < 2; ++bj) { f32x4 v0 = acc[ai][bj][m][0], v1 = acc[ai][bj][m][1];
                    if (lora) { const int cb = colt + bj * HALF;
                        if (cb >= 384) continue;
                        if (cb == 0) {
#pragma unroll
                            for (int e = 0; e < 4; ++e) { v0[e] = 1.0f - 2.0f / (1.0f + __expf(2.0f * v0[e])); v1[e] = 1.0f - 2.0f / (1.0f + __expf(2.0f * v1[e])); } }
                        else if (cb == 256) {
#pragma unroll
                            for (int e = 0; e < 4; ++e) { v0[e] = sig_f(v0[e]); v1[e] = sig_f(v1[e]); } } }
                    u32x4 w; w.x = cvt_pk_bf16(v0[0], v0[1]); w.y = cvt_pk_bf16(v0[2], v0[3]); w.z = cvt_pk_bf16(v1[0], v1[1]); w.w = cvt_pk_bf16(v1[2], v1[3]);
                    *(u32x4*)(rowp + bj * HALF) = w; } }
    }
};
struct EpiLora2 {
    static constexpr bool PERM = true, AFTER_DRAIN = false;
    bf16_t* o4; size_t ostride; bf16_t* og; const float* a0; const float* w0;
    __device__ __forceinline__ void operator()(const f32x4 (&acc)[2][2][4][2], const Unit& u, int wr, int wc, int fr, int fq) const {
        const int row0 = u.pm * BM + wr * 64 + fr; const int blk = u.pn >> 2, colt = (u.pn & 3) * BM;
        bf16_t* base = (blk < 4) ? o4 + (size_t)blk * ostride : og;
        const float* bs = ((blk < 2) ? a0 : w0) + (blk & 1) * 1024;
        const int col0 = colt + wc * 32 + 8 * fq;
        const float sc = (blk >= 2) ? 0.8750387749719753f : 1.0f;
#pragma unroll
        for (int bj = 0; bj < 2; ++bj) {
            f32x4 b0 = (f32x4){0.f, 0.f, 0.f, 0.f}, b1 = b0;
            if (blk < 4) { b0 = *(const f32x4*)(bs + col0 + bj * HALF); b1 = *(const f32x4*)(bs + col0 + bj * HALF + 4); }
#pragma unroll
            for (int ai = 0; ai < 2; ++ai)
#pragma unroll
                for (int m = 0; m < 4; ++m) { bf16_t* rowp = base + (size_t)(row0 + ai * HALF + m * 16) * 1024 + col0;
                    f32x4 v0 = acc[ai][bj][m][0] + b0, v1 = acc[ai][bj][m][1] + b1;
                    if (blk < 4) {
#pragma unroll
                        for (int e = 0; e < 4; ++e) { v0[e] = sc * sig_f(v0[e]); v1[e] = sc * sig_f(v1[e]); } }
                    u32x4 w; w.x = cvt_pk_bf16(v0[0], v0[1]); w.y = cvt_pk_bf16(v0[2], v0[3]); w.z = cvt_pk_bf16(v1[0], v1[1]); w.w = cvt_pk_bf16(v1[2], v1[3]);
                    *(u32x4*)(rowp + bj * HALF) = w; } }
    }
};

template <class Epi, class Sched, bool ALIGN_EPI = false, bool SP2 = false>
__device__ __forceinline__ void gemm_phase(PG8_LAS unsigned char* lds, const Gemm g, const Sched& S, const Epi& E, const int wave_index) {
    int lane_o; asm volatile("v_mbcnt_lo_u32_b32 %0, -1, 0\n\tv_mbcnt_hi_u32_b32 %0, -1, %0" : "=v"(lane_o));
    const int wid = wave_index, lane = lane_o, tid = wid * 64 + lane, wr = wid >> 2, wc = wid & 3, fr = lane & 15, fq = lane >> 4;
    const int K = g.K, nt = K / BK;
    unsigned voffA[2], voffB[2];
#pragma unroll
    for (int i = 0; i < 2; ++i) { int R, C; stage_rc(tid * 16 + i * 8192, R, C); const int Rb = Epi::PERM ? ((R & ~31) + perm32(R & 31)) : R;
        voffA[i] = (unsigned)(R * K + C) * 2u; voffB[i] = (unsigned)(Rb * K + C) * 2u; }
    const size_t kstep = (size_t)(BK * 2);
    const size_t hstep = (size_t)HALF * K * 2;
    const size_t tstep = 2 * hstep;
    const unsigned ldsw = (unsigned)wid * 1024u;
    const int aoff = lds_byte(wr * 64 + fr, fq * 8), boff = lds_byte(wc * 32 + fr, fq * 8);
#define PG8_SA(b, h) (((b) * 2 + (h)) * HTB)
#define PG8_SB(b, h) ((4 + (b) * 2 + (h)) * HTB)
#define PG8_STAGE(bufoff, gbase, voff) do { _Pragma("unroll") for (int _i = 0; _i < 2; ++_i) \
        __builtin_amdgcn_global_load_lds((const unsigned*)((const char*)(gbase) + (voff)[_i]), (PG8_LAS unsigned*)(lds + (bufoff) + ldsw + _i * 8192), 16, 0, 0); } while (0)
#define PG8_LDA(dst, b, h) do { _Pragma("unroll") for (int m = 0; m < 4; ++m) _Pragma("unroll") for (int k = 0; k < 2; ++k) dst[m][k] = *(const PG8_LAS bf16x8*)(lds + PG8_SA(b, h) + aoff + m * 2048 + k * 1024); } while (0)
#define PG8_LDB(dst, b, h) do { _Pragma("unroll") for (int n = 0; n < 2; ++n) _Pragma("unroll") for (int k = 0; k < 2; ++k) dst[n][k] = *(const PG8_LAS bf16x8*)(lds + PG8_SB(b, h) + boff + n * 2048 + k * 1024); } while (0)
#define PG8_MMA(ai, bj, At, Bt) do { __builtin_amdgcn_s_setprio(1); _Pragma("unroll") for (int m = 0; m < 4; ++m) _Pragma("unroll") for (int n = 0; n < 2; ++n) _Pragma("unroll") for (int k = 0; k < 2; ++k) \
        acc[ai][bj][m][n] = __builtin_amdgcn_mfma_f32_16x16x32_bf16(Bt[n][k], At[m][k], acc[ai][bj][m][n], 0, 0, 0); __builtin_amdgcn_s_setprio(0); } while (0)
#define PG8_WAIT_V(n) asm volatile("s_waitcnt vmcnt(" #n ")" ::: "memory")
#define PG8_WAIT_L(n) asm volatile("s_waitcnt lgkmcnt(" #n ")" ::: "memory")
#define PG8_BAR __builtin_amdgcn_s_barrier()
#define PG8_SCHED __builtin_amdgcn_sched_barrier(0)
    Unit cur, nxt; int ui = 0;
    if (!S.next(0, cur)) return;
    f32x4 acc[2][2][4][2];
#pragma unroll
    for (int a = 0; a < 2; ++a)
#pragma unroll
        for (int b = 0; b < 2; ++b)
#pragma unroll
            for (int m = 0; m < 4; ++m)
#pragma unroll
                for (int n = 0; n < 2; ++n) acc[a][b][m][n] = (f32x4){0.f, 0.f, 0.f, 0.f};
    bf16x8 At[4][2], B0[2][2], B1[2][2];
    const char* cA = (const char*)g.A + (size_t)cur.pm * tstep; const char* cB = (const char*)g.Bt + (size_t)cur.pn * tstep;
    S.a_ready(cur);
    if constexpr (SP2) {
        PG8_STAGE(PG8_SB(0, 0), cB, voffB); PG8_STAGE(PG8_SB(0, 1), cB + hstep, voffB); PG8_STAGE(PG8_SA(0, 0), cA, voffA); PG8_STAGE(PG8_SA(0, 1), cA + hstep, voffA);
        if (wr == 1) PG8_BAR;
        PG8_WAIT_V(2); PG8_BAR;
        PG8_STAGE(PG8_SB(1, 0), cB + kstep, voffB); PG8_STAGE(PG8_SA(1, 0), cA + kstep, voffA); PG8_STAGE(PG8_SB(1, 1), cB + hstep + kstep, voffB);
        PG8_WAIT_V(6); PG8_BAR;
    } else {
        PG8_STAGE(PG8_SB(0, 0), cB, voffB); PG8_STAGE(PG8_SA(0, 0), cA, voffA); PG8_STAGE(PG8_SB(0, 1), cB + hstep, voffB); PG8_STAGE(PG8_SA(0, 1), cA + hstep, voffA);
        if (wr == 1) PG8_BAR;
        PG8_WAIT_V(4); PG8_BAR;
        PG8_STAGE(PG8_SB(1, 0), cB + kstep, voffB); PG8_STAGE(PG8_SA(1, 0), cA + kstep, voffA); PG8_STAGE(PG8_SB(1, 1), cB + hstep + kstep, voffB);
        PG8_WAIT_V(6); PG8_BAR;
    }
    for (;;) {
        const bool has_next = S.next(ui + 1, nxt);
        const char* nA = has_next ? (const char*)g.A + (size_t)nxt.pm * tstep : cA; const char* nB = has_next ? (const char*)g.Bt + (size_t)nxt.pn * tstep : cB;
#pragma unroll 1
        for (int t = 0; t < nt; t += 2) {
            const bool last = (t == nt - 2);
            const char* a1 = cA + (size_t)(t + 1) * kstep;
            const char* a2 = last ? nA : cA + (size_t)(t + 2) * kstep; const char* b2 = last ? nB : cB + (size_t)(t + 2) * kstep;
            const char* a3 = a2 + kstep; const char* b3 = b2 + kstep;
            if (last && has_next) S.a_ready(nxt);
            if constexpr (SP2) {
            PG8_LDB(B0, 0, 0); PG8_LDB(B1, 0, 1); PG8_SCHED; PG8_LDA(At, 0, 0); PG8_STAGE(PG8_SA(1, 1), a1 + hstep, voffA);
            PG8_WAIT_V(8); PG8_WAIT_L(0); PG8_BAR; PG8_MMA(0, 0, At, B0); PG8_MMA(0, 1, At, B1); PG8_BAR; PG8_SCHED;
            PG8_LDA(At, 0, 1); PG8_STAGE(PG8_SB(0, 0), b2, voffB); PG8_STAGE(PG8_SB(0, 1), b2 + hstep, voffB); PG8_STAGE(PG8_SA(0, 0), a2, voffA);
            PG8_WAIT_V(8); PG8_WAIT_L(0); PG8_BAR; PG8_MMA(1, 0, At, B0); PG8_MMA(1, 1, At, B1); PG8_BAR; PG8_SCHED;
            PG8_LDB(B0, 1, 0); PG8_LDB(B1, 1, 1); PG8_SCHED; PG8_LDA(At, 1, 0); PG8_STAGE(PG8_SA(0, 1), a2 + hstep, voffA);
            PG8_WAIT_V(8); PG8_WAIT_L(0); PG8_BAR; PG8_MMA(0, 0, At, B0); PG8_MMA(0, 1, At, B1); PG8_BAR; PG8_SCHED;
            PG8_LDA(At, 1, 1); PG8_STAGE(PG8_SB(1, 0), b3, voffB); PG8_STAGE(PG8_SB(1, 1), b3 + hstep, voffB); PG8_STAGE(PG8_SA(1, 0), a3, voffA);
            PG8_WAIT_V(8); PG8_WAIT_L(0); PG8_BAR; PG8_MMA(1, 0, At, B0); PG8_MMA(1, 1, At, B1); PG8_BAR; PG8_SCHED;
            } else {
            PG8_LDB(B0, 0, 0); PG8_SCHED; PG8_LDA(At, 0, 0); PG8_STAGE(PG8_SA(1, 1), a1 + hstep, voffA);
            PG8_WAIT_L(8); PG8_BAR; PG8_WAIT_L(0); PG8_MMA(0, 0, At, B0); PG8_BAR; PG8_SCHED;
            PG8_LDB(B1, 0, 1); PG8_STAGE(PG8_SB(0, 0), b2, voffB);
            PG8_BAR; PG8_WAIT_L(0); PG8_MMA(0, 1, At, B1); PG8_BAR;
            PG8_LDA(At, 0, 1); PG8_STAGE(PG8_SA(0, 0), a2, voffA);
            PG8_BAR; PG8_WAIT_L(0); PG8_MMA(1, 0, At, B0); PG8_BAR; PG8_SCHED;
            PG8_STAGE(PG8_SB(0, 1), b2 + hstep, voffB);
            PG8_WAIT_V(6); PG8_BAR; PG8_MMA(1, 1, At, B1); PG8_BAR;
            PG8_LDB(B0, 1, 0); PG8_SCHED; PG8_LDA(At, 1, 0); PG8_STAGE(PG8_SA(0, 1), a2 + hstep, voffA);
            PG8_WAIT_L(8); PG8_BAR; PG8_WAIT_L(0); PG8_MMA(0, 0, At, B0); PG8_BAR; PG8_SCHED;
            PG8_LDB(B1, 1, 1); PG8_STAGE(PG8_SB(1, 0), b3, voffB);
            PG8_BAR; PG8_WAIT_L(0); PG8_MMA(0, 1, At, B1); PG8_BAR;
            PG8_LDA(At, 1, 1); PG8_STAGE(PG8_SA(1, 0), a3, voffA);
            PG8_BAR; PG8_WAIT_L(0); PG8_MMA(1, 0, At, B0); PG8_BAR; PG8_SCHED;
            PG8_STAGE(PG8_SB(1, 1), b3 + hstep, voffB);
            PG8_WAIT_V(6); PG8_BAR; PG8_MMA(1, 1, At, B1); PG8_BAR;
            }
        }
        if constexpr (ALIGN_EPI) { if (wr == 0) PG8_BAR; }
        if constexpr (!Epi::AFTER_DRAIN) { E(acc, cur, wr, wc, fr, fq); S.done(cur); }
        if (!has_next) break;
#pragma unroll
        for (int a = 0; a < 2; ++a)
#pragma unroll
            for (int b = 0; b < 2; ++b)
#pragma unroll
                for (int m = 0; m < 4; ++m)
#pragma unroll
                    for (int n = 0; n < 2; ++n) acc[a][b][m][n] = (f32x4){0.f, 0.f, 0.f, 0.f};
        cur = nxt; cA = nA; cB = nB; ++ui;
        if constexpr (ALIGN_EPI) { if (wr == 1) PG8_BAR; }
    }
    PG8_WAIT_V(0);
    if constexpr (!ALIGN_EPI) { if (wr == 0) PG8_BAR; }
    PG8_BAR;
    if constexpr (Epi::AFTER_DRAIN) { E.fused(acc, cur, wr, wc, fr, fq, lds, wid, lane); S.done(cur); }
#undef PG8_SA
#undef PG8_SB
#undef PG8_STAGE
#undef PG8_LDA
#undef PG8_LDB
#undef PG8_MMA
#undef PG8_WAIT_V
#undef PG8_WAIT_L
#undef PG8_BAR
#undef PG8_SCHED
}
}

#define GAS __attribute__((address_space(1)))
#define LAS __attribute__((address_space(3)))
typedef unsigned short bf16;
typedef unsigned v4u __attribute__((ext_vector_type(4)));
typedef unsigned v2u __attribute__((ext_vector_type(2)));
typedef float f32x4 __attribute__((ext_vector_type(4)));
#define LDS_WAIT() asm volatile("s_waitcnt lgkmcnt(0)" ::: "memory")

#ifndef MK_N_LAUNCHES
#define MK_N_LAUNCHES 1
#endif
#ifndef MK_CG_BARRIER
#define MK_CG_BARRIER 0
#endif

constexpr int D = 1024, NTOK = 16384, NPR = 8192, TP = 256, TS = 2048, PAST = 512, SKV = 2560, FF = 4096, DEPTH = 4;
constexpr int NQKV = 2304, NRKV = 3584, KRKV = 2048;
constexpr int NWAVES = 8;
constexpr size_t O_X = 0, O_KG = 16777216, O_VG = 18874368, O_KD = 20971520, O_VD = 29360128, O_ST = 37748736, OUT_TOTAL = 46137344;
constexpr size_t MiB = 1u << 20;
constexpr size_t WS_CTL = 0, CTL_ZERO_BYTES = 1 * MiB;
constexpr size_t WS_MOD = 65536;
constexpr size_t WS_ROPE = 1 * MiB;
constexpr size_t WS_INV = 2 * MiB;
constexpr size_t WS_W = 4 * MiB;
constexpr size_t W_W1T = WS_W, W_W2T = WS_W + 8 * MiB, W_MIX = WS_W + 16 * MiB;
constexpr size_t W_WINT = W_MIX, W_WOUTT = W_MIX + 6 * MiB;
constexpr size_t W_BT1 = W_MIX, W_WOT = W_MIX + 14 * MiB, W_BT2 = W_MIX + 16 * MiB;
constexpr size_t AR = 40 * MiB;
constexpr size_t A_H = AR;
constexpr size_t A_QKVRAW = AR + 32 * MiB;
constexpr size_t A_DT = AR + 32 * MiB;
constexpr size_t A_M = AR + 96 * MiB;
constexpr size_t A_QA = AR + 176 * MiB, A_QB = AR + 192 * MiB, A_KAP = AR + 208 * MiB, A_VAP = AR + 210 * MiB, A_KBP = AR + 212 * MiB, A_VBP = AR + 220 * MiB;
constexpr size_t A_KAS = AR + 228 * MiB, A_VAS = AR + 231 * MiB, A_KBS = AR + 234 * MiB, A_VBS = AR + 244 * MiB;
constexpr size_t A_HID = AR + 32 * MiB;
constexpr size_t A_F = AR + 160 * MiB;
constexpr size_t A_A2 = AR + 32 * MiB;
constexpr size_t A_Y = AR + 32 * MiB;
constexpr size_t A_RKV = AR + 96 * MiB;
constexpr size_t A_L1 = AR + 192 * MiB;
constexpr size_t A_G = A_H;
constexpr size_t A_A0 = AR + 208 * MiB, A_A1 = AR + 240 * MiB, A_EW0 = AR + 272 * MiB, A_EW1 = AR + 304 * MiB;
constexpr size_t WS_END = AR + 336 * MiB;
constexpr int CW_BAR = 4096;

constexpr int RING_OFF = 0, RING_BYTES = 131072;
constexpr int LDSCTL_OFF = RING_BYTES, MISC_OFF = LDSCTL_OFF + 320;
constexpr int LDS_BYTES = 147456;

__device__ __forceinline__ unsigned f2bf(float f) { unsigned u = __builtin_bit_cast(unsigned, f); return (u + 0x7fffu + ((u >> 16) & 1u)) >> 16; }
__device__ __forceinline__ unsigned pk2(float lo, float hi) { return f2bf(lo) | (f2bf(hi) << 16); }
__device__ __forceinline__ float bf2f(unsigned short h) { return __builtin_bit_cast(float, (unsigned)h << 16); }
__device__ __forceinline__ float bflo(unsigned w) { return __builtin_bit_cast(float, w << 16); }
__device__ __forceinline__ float bfhi(unsigned w) { return __builtin_bit_cast(float, w & 0xffff0000u); }
__device__ __forceinline__ float wave_sum(float v) {
#pragma unroll
    for (int o = 1; o < 64; o <<= 1) v += __shfl_xor(v, o);
    return v;
}
__device__ __forceinline__ float sigmoidf_(float x) { return 1.0f / (1.0f + __expf(-x)); }
__device__ __forceinline__ float rdl(float x, int l) { return __builtin_bit_cast(float, __builtin_amdgcn_readlane(__builtin_bit_cast(int, x), l)); }

#define XB_TMO      128
#define XB_XCNT(j)  (256  + 64 * (j))
#define XB_XSUB(j)  (1280 + 64 * (j))
#define XB_XGEN(j)  (2304 + 64 * (j))
#define XB_TOP      3328
#define XB_TOPGEN   3392
#define XCD_BAR_WORDS 3456
#define XB_SPIN_CAP (1u << 18)

__device__ __forceinline__ unsigned xb_ld(unsigned* p)              { return __hip_atomic_load(p, __ATOMIC_RELAXED, __HIP_MEMORY_SCOPE_AGENT); }
__device__ __forceinline__ unsigned xb_add(unsigned* p, unsigned v) { return __hip_atomic_fetch_add(p, v, __ATOMIC_RELAXED, __HIP_MEMORY_SCOPE_AGENT); }
__device__ __forceinline__ unsigned xb_xcc_id() { return (unsigned)__builtin_amdgcn_s_getreg((3 << 11) | 20) & 0xFu; }
#define XB_SPIN(cond, bar) do { unsigned _sp = 0; while (cond) { __builtin_amdgcn_s_sleep(1); \
    if ((++_sp & 255u) == 0u) { if (xb_ld(&(bar)[XB_TMO])) break; if (_sp > XB_SPIN_CAP) { atomicAdd(&(bar)[XB_TMO], 1u); break; } } } } while (0)

struct XcdBarrier {
    unsigned* bar; unsigned x;
    volatile LAS unsigned* st;
};

__device__ __forceinline__ XcdBarrier xcd_barrier_post(unsigned* bar, volatile LAS unsigned* st, bool leader) {
    XcdBarrier b; b.bar = bar; b.x = xb_xcc_id(); b.st = st;
    if (leader) (void)xb_add(&bar[XB_XCNT(b.x)], 1u);
    return b;
}
__device__ __forceinline__ void xcd_barrier_complete(unsigned* bar, unsigned x, unsigned& nloc, unsigned& nx) {
    const unsigned G = gridDim.x * gridDim.y * gridDim.z;
    unsigned sum, cnt, mine, sp = 0u;
    for (;;) {
        sum = 0u; cnt = 0u; mine = 0u;
#pragma unroll
        for (unsigned j = 0; j < 16; ++j) { const unsigned c = xb_ld(&bar[XB_XCNT(j)]); sum += c; cnt += (c > 0u) ? 1u : 0u; mine = (j == x) ? c : mine; }
        if (sum == G) break;
        __builtin_amdgcn_s_sleep(1);
        if ((++sp & 255u) == 0u) { if (xb_ld(&bar[XB_TMO])) break; if (sp > XB_SPIN_CAP) { atomicAdd(&bar[XB_TMO], 1u); break; } }
    }
    nloc = mine > 0u ? mine : 1u; nx = cnt > 0u ? cnt : 1u;
}

__device__ __forceinline__ void xcd_barrier(const XcdBarrier& b, bool leader) {
    asm volatile("s_waitcnt vmcnt(0)" ::: "memory");
    __syncthreads();
    if (leader) {
        unsigned* bar = b.bar;
        __builtin_amdgcn_s_waitcnt(0);
        unsigned nloc = b.st[0], nx = b.st[1];
        if (nloc == 0u) { xcd_barrier_complete(bar, b.x, nloc, nx); b.st[0] = nloc; b.st[1] = nx; }
        const unsigned old = xb_add(&bar[XB_XSUB(b.x)], 1u);
        const unsigned gen = old / nloc;
        if (old + 1u == (gen + 1u) * nloc) {
            __builtin_amdgcn_fence(__ATOMIC_RELEASE, "agent");
            asm volatile("s_waitcnt vmcnt(0)" ::: "memory");
            const unsigned og = xb_add(&bar[XB_TOP], 1u);
            const unsigned tg = og / nx;
            if (og + 1u == (tg + 1u) * nx) xb_add(&bar[XB_TOPGEN], 1u);
            else XB_SPIN(xb_ld(&bar[XB_TOPGEN]) == tg, bar);
            __builtin_amdgcn_fence(__ATOMIC_ACQUIRE, "agent");
            xb_add(&bar[XB_XGEN(b.x)], 1u);
            asm volatile("s_waitcnt vmcnt(0)" ::: "memory");
        } else {
            XB_SPIN(xb_ld(&bar[XB_XGEN(b.x)]) == gen, bar);
            __builtin_amdgcn_fence(__ATOMIC_ACQUIRE, "agent");
            asm volatile("s_waitcnt vmcnt(0)" ::: "memory");
        }
    }
    __syncthreads();
}

struct Args { const float* in[32]; float* out; unsigned char* ws; int ph_lo, ph_hi; };
struct Ids { int tid, lane, wave, gw, ngw, z; };

__device__ __forceinline__ int cond_of(int m) { return m < NPR ? 4 : ((m - NPR) >> 11); }
__device__ __forceinline__ const float* mod_ptr_(const Args& a, const Ids& id, int cond, int layer) { return (const float*)(a.ws + id.z + WS_MOD) + (size_t)(cond * 4 + layer) * 6144; }

__device__ __forceinline__ void tr_item(const float* W, int ldw, int col0, const float* scale, bf16* WT, int ldt, int drow0, int dcol0, LAS float* scr, int kb, int nb, int lane) {
    const int k0 = 64 * kb, n0 = 32 * nb;
#pragma unroll 8
    for (int i = 0; i < 32; ++i) { const int kk = 2 * i + (lane >> 5); float v = W[(size_t)(k0 + kk) * ldw + col0 + n0 + (lane & 31)]; if (scale) v *= scale[k0 + kk]; scr[kk * 33 + (lane & 31)] = v; }
    LDS_WAIT(); asm volatile("" ::: "memory");
    const int c = lane & 7;
#pragma unroll
    for (int j = 0; j < 4; ++j) { const int n = (lane >> 3) + 8 * j; const LAS float* s = scr + (8 * c) * 33 + n;
        v4u o; o.x = pk2(s[0 * 33], s[1 * 33]); o.y = pk2(s[2 * 33], s[3 * 33]); o.z = pk2(s[4 * 33], s[5 * 33]); o.w = pk2(s[6 * 33], s[7 * 33]);
        *(v4u*)(WT + (size_t)(drow0 + n0 + n) * ldt + dcol0 + k0 + 8 * c) = o; }
    LDS_WAIT(); asm volatile("" ::: "memory");
}
__device__ __forceinline__ bool tr_matrix(int& r, const float* W, int K, int N, bf16* WT, LAS float* scr, int lane) {
    const int nblk = N / 32, items = (K / 64) * nblk;
    if (r < items) { tr_item(W, N, 0, nullptr, WT, K, 0, 0, scr, r / nblk, r % nblk, lane); return true; }
    r -= items; return false;
}
__device__ __forceinline__ bool tr_rwproj(int& r, const float* W, int ncols, const float* mu, bf16* BT1, int drow0, LAS float* scr, int lane) {
    const int nblk = ncols / 32, items = 16 * nblk * 2;
    if (r < items) { const int half = r / (16 * nblk), q = r % (16 * nblk); tr_item(W, ncols, 0, half ? mu : nullptr, BT1, KRKV, drow0, half * 1024, scr, q / nblk, q % nblk, lane); return true; }
    r -= items; return false;
}
__device__ __forceinline__ void conv_weights(const Args& a, const Ids& id, LAS unsigned char* lds, int layer) {
    LAS float* scr = (LAS float*)(lds + id.wave * 16384);
    const int j = layer >> 1;
    bf16* W1T = (bf16*)(a.ws + id.z + W_W1T); bf16* W2T = (bf16*)(a.ws + id.z + W_W2T);
    const float* mw1 = a.in[30 + id.z] + (size_t)layer * D * FF; const float* mw2 = a.in[31 + id.z] + (size_t)layer * D * FF;
    if ((layer & 1) == 0) {
        bf16* WINT = (bf16*)(a.ws + id.z + W_WINT); bf16* WOUTT = (bf16*)(a.ws + id.z + W_WOUTT);
        const float* win = a.in[12 + id.z] + (size_t)j * D * NQKV; const float* wout = a.in[13 + id.z] + (size_t)j * D * D;
        const int total = 2048 + 2048 + 1152 + 512;
        for (int it = id.gw; it < total; it += id.ngw) {
            int r = it;
            if (tr_matrix(r, mw1, D, FF, W1T, scr, id.lane)) continue;
            if (tr_matrix(r, mw2, FF, D, W2T, scr, id.lane)) continue;
            if (tr_matrix(r, win, D, NQKV, WINT, scr, id.lane)) continue;
            tr_matrix(r, wout, D, D, WOUTT, scr, id.lane);
        }
    } else {
        bf16* BT1 = (bf16*)(a.ws + id.z + W_BT1); bf16* WOT = (bf16*)(a.ws + id.z + W_WOT);
        const float* mu = a.in[17 + id.z] + (size_t)j * 6 * D;
        const float* wrkv = a.in[18 + id.z] + (size_t)j * 3 * D * D;
        const float* w1 = a.in[21 + id.z] + (size_t)j * 2 * D * 64; const float* a1 = a.in[24 + id.z] + (size_t)j * 2 * D * 64; const float* g1 = a.in[26 + id.z] + (size_t)j * D * 128;
        const float* wo = a.in[19 + id.z] + (size_t)j * D * D;
        bf16* BT2 = (bf16*)(a.ws + id.z + W_BT2); const float* w2 = a.in[22 + id.z] + (size_t)j * 2 * 64 * D; const float* a2 = a.in[25 + id.z] + (size_t)j * 2 * 64 * D; const float* g2 = a.in[27 + id.z] + (size_t)j * 128 * D;
        const int total = 2048 + 2048 + 3072 + 256 + 128 + 512 + 128 + 4 * 32 + 64 + 5120;
        for (int it = id.gw; it < total; it += id.ngw) {
            int r = it;
            if (tr_matrix(r, mw1, D, FF, W1T, scr, id.lane)) continue;
            if (tr_matrix(r, mw2, FF, D, W2T, scr, id.lane)) continue;
            if (tr_rwproj(r, wrkv, 1024, mu + 0 * D, BT1, 0, scr, id.lane)) continue;
            if (tr_rwproj(r, wrkv + (size_t)D * D, 1024, mu + 2 * D, BT1, 1024, scr, id.lane)) continue;
            if (tr_rwproj(r, wrkv + (size_t)2 * D * D, 1024, mu + 3 * D, BT1, 2048, scr, id.lane)) continue;
            if (tr_rwproj(r, w1, 64, mu + 1 * D, BT1, 3072, scr, id.lane)) continue;
            if (tr_rwproj(r, w1 + (size_t)D * 64, 64, mu + 1 * D, BT1, 3136, scr, id.lane)) continue;
            if (tr_rwproj(r, a1, 64, mu + 4 * D, BT1, 3200, scr, id.lane)) continue;
            if (tr_rwproj(r, a1 + (size_t)D * 64, 64, mu + 4 * D, BT1, 3264, scr, id.lane)) continue;
            if (tr_rwproj(r, g1, 128, mu + 5 * D, BT1, 3328, scr, id.lane)) continue;
            if (tr_matrix(r, wo, D, D, WOT, scr, id.lane)) continue;
            if (r < 128) {
                v4u z = (v4u){0u, 0u, 0u, 0u}; v4u* p = (v4u*)(BT1 + (size_t)(3456 + r) * KRKV);
#pragma unroll
                for (int q = 0; q < 4; ++q) p[id.lane + 64 * q] = z;
                continue; }
            r -= 128;
            if (r < 128) { const int i = r >> 5, q = r & 31; const float* W = (i < 2 ? a2 : w2) + (size_t)(i & 1) * 64 * D; tr_item(W, D, 0, nullptr, BT2, 384, 1024 * i, 64 * (i ^ 2), scr, 0, q, id.lane); continue; }
            r -= 128;
            if (r < 64) { tr_item(g2, D, 0, nullptr, BT2, 384, 4096, 256, scr, r >> 5, r & 31, id.lane); continue; }
            r -= 64;
            { const int blk = r >> 10; const int c0 = (blk < 4) ? 8 * (blk ^ 2) : 32, c1 = (blk < 4) ? 8 * (blk ^ 2) + 8 : 48;
              if (id.lane < 48 && (id.lane < c0 || id.lane >= c1)) *(v4u*)(BT2 + (size_t)r * 384 + 8 * id.lane) = (v4u){0u, 0u, 0u, 0u}; }
        }
    }
}

struct RowV { f32x4 v[4]; };
__device__ __forceinline__ void ld_row(RowV& r, const float* p, int lane) {
#pragma unroll
    for (int j = 0; j < 4; ++j) r.v[j] = ((const f32x4*)p)[lane + 64 * j];
}
__device__ __forceinline__ void st_row(const RowV& r, float* p, int lane) {
#pragma unroll
    for (int j = 0; j < 4; ++j) ((f32x4*)p)[lane + 64 * j] = r.v[j];
}
__device__ __forceinline__ void st_row_bf16(const RowV& r, bf16* p, int lane) {
#pragma unroll
    for (int j = 0; j < 4; ++j) { v2u w; w.x = pk2(r.v[j][0], r.v[j][1]); w.y = pk2(r.v[j][2], r.v[j][3]); ((v2u*)p)[lane + 64 * j] = w; }
}
__device__ __forceinline__ float row_rinv(const RowV& r) {
    float s = 0.f;
#pragma unroll
    for (int j = 0; j < 4; ++j) s += (r.v[j][0] * r.v[j][0] + r.v[j][1] * r.v[j][1]) + (r.v[j][2] * r.v[j][2] + r.v[j][3] * r.v[j][3]);
    s = wave_sum(s);
    return 1.0f / sqrtf(s * (1.0f / 1024.0f) + 1e-6f);
}
__device__ __forceinline__ void norm_mod(RowV& h, const RowV& x, const float* g, const float* sc, const float* sh, int lane) {
    const float ri = row_rinv(x);
#pragma unroll
    for (int j = 0; j < 4; ++j) { const f32x4 gv = ((const f32x4*)g)[lane + 64 * j], scv = ((const f32x4*)sc)[lane + 64 * j], shv = ((const f32x4*)sh)[lane + 64 * j];
        h.v[j] = (x.v[j] * ri) * gv * (scv + 1.0f) + shv; }
}
__device__ __forceinline__ void resid_add(RowV& x, const RowV& m, const float* g, const float* gt, int lane) {
    const float ri = row_rinv(m);
#pragma unroll
    for (int j = 0; j < 4; ++j) { const f32x4 gv = ((const f32x4*)g)[lane + 64 * j], gtv = ((const f32x4*)gt)[lane + 64 * j];
        x.v[j] = x.v[j] + gtv * ((m.v[j] * ri) * gv); }
}

__device__ __forceinline__ float rope_inv(int jj) {
    const float t[16] = {1.0f, 0.5623413324356079f, 0.3162277638912201f, 0.17782793939113617f, 0.10000000149011612f, 0.05623412877321243f, 0.03162277862429619f, 0.017782794311642647f,
                         0.009999999776482582f, 0.005623413249850273f, 0.003162277862429619f, 0.0017782794311642647f, 0.0010000000474974513f, 0.000562341301701963f, 0.0003162277862429619f, 0.00017782794020604342f};
    float r = t[0];
#pragma unroll
    for (int i = 1; i < 16; ++i) r = (jj == i) ? t[i] : r;
    return r;
}
__device__ __forceinline__ void ph_prologue(const Args& a, const Ids& id, LAS unsigned char* lds) {
    float* MOD = (float*)(a.ws + id.z + WS_MOD);
    { LAS float* red = (LAS float*)lds;
      for (int it = blockIdx.x; it < 4 * 96; it += gridDim.x) {
        const int i = it / 96, n = (it % 96) * 64 + id.lane;
        float acc[5];
#pragma unroll
        for (int c = 0; c < 5; ++c) acc[c] = 0.f;
        const float* W = a.in[9 + id.z] + (size_t)i * 1024 * 6144 + n;
#pragma unroll 1
        for (int k0 = 128 * id.wave; k0 < 128 * id.wave + 128; k0 += 64) {
            float sv[5];
#pragma unroll
            for (int c = 0; c < 5; ++c) { const float x = (c < 4) ? a.in[2 + id.z][c * 1024 + k0 + id.lane] : a.in[8 + id.z][k0 + id.lane]; sv[c] = x / (1.0f + __expf(-x)); }
#pragma unroll 16
            for (int kk = 0; kk < 64; ++kk) { const float w = W[(size_t)(k0 + kk) * 6144];
#pragma unroll
                for (int c = 0; c < 5; ++c) acc[c] += w * __shfl(sv[c], kk); }
        }
#pragma unroll
        for (int c = 0; c < 5; ++c) red[(id.wave * 5 + c) * 64 + id.lane] = acc[c];
        __syncthreads();
        if (id.wave < 5) { float s = a.in[10 + id.z][i * 6144 + n];
#pragma unroll
            for (int w8 = 0; w8 < 8; ++w8) s += red[(w8 * 5 + id.wave) * 64 + id.lane];
            MOD[(size_t)(id.wave * 4 + i) * 6144 + n] = s; }
        __syncthreads();
      } }
    { float* RC = (float*)(a.ws + id.z + WS_ROPE); float* RS = RC + 2048 * 64;
      for (int e = id.gw * 64 + id.lane; e < 2048 * 64; e += id.ngw * 64) { const int t = e >> 6, d = e & 63; const int pos = (d < 32) ? (t >> 6) : (t & 63);
          const float ang = (float)pos * rope_inv(d & 15); RC[e] = __cosf(ang); RS[e] = __sinf(ang); } }
    { const f32x4* s0 = (const f32x4*)a.in[0 + id.z]; const f32x4* s1 = (const f32x4*)a.in[1 + id.z]; f32x4* dst = (f32x4*)(a.out + id.z + O_X); const int n4 = NPR * D / 4;
      for (int e = id.gw * 64 + id.lane; e < n4; e += id.ngw * 64) { dst[e] = s0[e]; dst[n4 + e] = s1[e]; } }
    conv_weights(a, id, lds, 0);
}

__device__ __forceinline__ void ph_norm0(const Args& a, const Ids& id) {
    bf16* H = (bf16*)(a.ws + id.z + A_H); const float* g0 = a.in[11 + id.z] + (size_t)(0 * 4 + 0) * D;
    for (int m = id.gw; m < NTOK; m += id.ngw) { RowV x, h; ld_row(x, a.out + id.z + O_X + (size_t)m * D, id.lane); const float* md = mod_ptr_(a, id, cond_of(m), 0);
        norm_mod(h, x, g0, md + 1024, md + 0, id.lane); st_row_bf16(h, H + (size_t)m * D, id.lane); }
}
__device__ __forceinline__ void ph_resid_norm(const Args& a, const Ids& id, int layer, bool dummy = false) {
    bf16* H = (bf16*)(a.ws + id.z + (dummy ? AR + 224 * MiB : A_H)); float* xout = dummy ? (float*)(a.ws + id.z + A_F) : a.out + id.z + O_X; const float* M = (const float*)(a.ws + id.z + A_M); const float* g1 = a.in[11 + id.z] + (size_t)(layer * 4 + 1) * D; const float* g2 = a.in[11 + id.z] + (size_t)(layer * 4 + 2) * D;
    for (int m = id.gw; m < NTOK; m += id.ngw) { RowV x, mm, h; float* xp = a.out + id.z + O_X + (size_t)m * D; ld_row(x, xp, id.lane); ld_row(mm, M + (size_t)m * D, id.lane);
        const float* md = mod_ptr_(a, id, cond_of(m), layer);
        resid_add(x, mm, g1, md + 2048, id.lane); st_row(x, xout + (size_t)m * D, id.lane);
        norm_mod(h, x, g2, md + 4096, md + 3072, id.lane); st_row_bf16(h, H + (size_t)m * D, id.lane); }
}
__device__ __forceinline__ void ph_resid_end(const Args& a, const Ids& id, LAS unsigned char* lds, int layer, bool dummy = false) {
    bf16* H = (bf16*)(a.ws + id.z + (dummy ? AR + 96 * MiB : A_H)); float* xout = dummy ? (float*)(a.ws + id.z + AR + 32 * MiB) : a.out + id.z + O_X; const float* F = (const float*)(a.ws + id.z + A_F); const float* g3 = a.in[11 + id.z] + (size_t)(layer * 4 + 3) * D;
    const bool next_attn = (layer + 1 < DEPTH) && (((layer + 1) & 1) == 0);
    const float* g0n = a.in[11 + id.z] + (size_t)((layer + 1) * 4 + 0) * D;
    for (int m = id.gw; m < NTOK; m += id.ngw) { RowV x, ff; float* xp = a.out + id.z + O_X + (size_t)m * D; ld_row(x, xp, id.lane); ld_row(ff, F + (size_t)m * D, id.lane);
        const float* md = mod_ptr_(a, id, cond_of(m), layer);
        resid_add(x, ff, g3, md + 5120, id.lane); st_row(x, xout + (size_t)m * D, id.lane);
        if (next_attn) { RowV h; const float* mdn = mod_ptr_(a, id, cond_of(m), layer + 1); norm_mod(h, x, g0n, mdn + 1024, mdn + 0, id.lane); st_row_bf16(h, H + (size_t)m * D, id.lane); } }
    if (layer + 1 < DEPTH) conv_weights(a, id, lds, layer + 1);
}
__device__ __forceinline__ void ph_rw_mix(const Args& a, const Ids& id, int layer) {
    bf16* A2 = (bf16*)(a.ws + id.z + A_A2); const float* g0 = a.in[11 + id.z] + (size_t)(layer * 4 + 0) * D;
    for (int g8 = id.gw; g8 < NTOK / 8; g8 += id.ngw) {
        const int m0 = g8 * 8; const int t0 = (m0 < NPR) ? (m0 & (TP - 1)) : ((m0 - NPR) & (TS - 1)); const int T = (m0 < NPR) ? TP : TS;
        const float* md = mod_ptr_(a, id, cond_of(m0), layer); const float* xp = a.out + id.z + O_X + (size_t)m0 * D;
        RowV hp, hc, hn, xr;
#pragma unroll
        for (int q = 0; q < 4; ++q) hp.v[q] = (f32x4){0.f, 0.f, 0.f, 0.f};
        if (t0 > 0) { ld_row(xr, xp - D, id.lane); norm_mod(hp, xr, g0, md + 1024, md + 0, id.lane); }
        ld_row(xr, xp, id.lane); norm_mod(hc, xr, g0, md + 1024, md + 0, id.lane);
#pragma unroll 1
        for (int i = 0; i < 8; ++i) {
#pragma unroll
            for (int q = 0; q < 4; ++q) hn.v[q] = (f32x4){0.f, 0.f, 0.f, 0.f};
            if (t0 + i + 1 < T) { ld_row(xr, xp + (size_t)(i + 1) * D, id.lane); norm_mod(hn, xr, g0, md + 1024, md + 0, id.lane); }
            RowV xx;
#pragma unroll
            for (int q = 0; q < 4; ++q) xx.v[q] = (hp.v[q] + hn.v[q]) * 0.5f - hc.v[q];
            st_row_bf16(hc, A2 + (size_t)(m0 + i) * KRKV, id.lane); st_row_bf16(xx, A2 + (size_t)(m0 + i) * KRKV + D, id.lane);
            hp = hc; hc = hn;
        }
    }
}

__device__ __forceinline__ void row16_sum4(float& a, float& b, float& c, float& d) {
    asm("s_nop 1\n\t"
        "v_add_f32_dpp %0, %0, %0 row_ror:8 row_mask:0xf bank_mask:0xf\n\tv_add_f32_dpp %1, %1, %1 row_ror:8 row_mask:0xf bank_mask:0xf\n\tv_add_f32_dpp %2, %2, %2 row_ror:8 row_mask:0xf bank_mask:0xf\n\tv_add_f32_dpp %3, %3, %3 row_ror:8 row_mask:0xf bank_mask:0xf\n\t"
        "v_add_f32_dpp %0, %0, %0 row_ror:4 row_mask:0xf bank_mask:0xf\n\tv_add_f32_dpp %1, %1, %1 row_ror:4 row_mask:0xf bank_mask:0xf\n\tv_add_f32_dpp %2, %2, %2 row_ror:4 row_mask:0xf bank_mask:0xf\n\tv_add_f32_dpp %3, %3, %3 row_ror:4 row_mask:0xf bank_mask:0xf\n\t"
        "v_add_f32_dpp %0, %0, %0 row_ror:2 row_mask:0xf bank_mask:0xf\n\tv_add_f32_dpp %1, %1, %1 row_ror:2 row_mask:0xf bank_mask:0xf\n\tv_add_f32_dpp %2, %2, %2 row_ror:2 row_mask:0xf bank_mask:0xf\n\tv_add_f32_dpp %3, %3, %3 row_ror:2 row_mask:0xf bank_mask:0xf\n\t"
        "v_add_f32_dpp %0, %0, %0 row_ror:1 row_mask:0xf bank_mask:0xf\n\tv_add_f32_dpp %1, %1, %1 row_ror:1 row_mask:0xf bank_mask:0xf\n\tv_add_f32_dpp %2, %2, %2 row_ror:1 row_mask:0xf bank_mask:0xf\n\tv_add_f32_dpp %3, %3, %3 row_ror:1 row_mask:0xf bank_mask:0xf"
        : "+v"(a), "+v"(b), "+v"(c), "+v"(d));
}
__device__ __forceinline__ f32x4 ld_bf4(const bf16* p) { const v2u w = *(const v2u*)p; return (f32x4){bflo(w.x), bfhi(w.x), bflo(w.y), bfhi(w.y)}; }
__device__ __forceinline__ void ph_att_post(const Args& a, const Ids& id, int layer) {
    const int j = layer >> 1, lane = id.lane, e4 = 4 * (lane & 15), rowq = lane >> 4;
    const float* RAW = (const float*)(a.ws + id.z + A_QKVRAW);
    bf16 *KAS = (bf16*)(a.ws + id.z + A_KAS), *VAS = (bf16*)(a.ws + id.z + A_VAS), *KBS = (bf16*)(a.ws + id.z + A_KBS), *VBS = (bf16*)(a.ws + id.z + A_VBS);
    const float* RC = (const float*)(a.ws + id.z + WS_ROPE); const float* RS = RC + 2048 * 64;
    const f32x4 gq = *(const f32x4*)(a.in[14 + id.z] + j * 128 + e4), gk = *(const f32x4*)(a.in[14 + id.z] + j * 128 + 64 + e4);
    constexpr float QS = 0.18033688011112042f;
    for (int it = id.gw; it < NTOK + 4 * PAST; it += id.ngw) {
        if (it < NTOK) {
            const int m = it; const bool smp = m >= NPR; const int b = smp ? ((m - NPR) >> 11) : (m >> 8), t = smp ? ((m - NPR) & (TS - 1)) : (m & (TP - 1));
            const float* raw = RAW + (size_t)m * NQKV + 4 * lane;
            f32x4 v[9];
#pragma unroll
            for (int q = 0; q < 9; ++q) v[q] = *(const f32x4*)(raw + 256 * q);
            f32x4 cs = (f32x4){1.f, 1.f, 1.f, 1.f}, sn = (f32x4){0.f, 0.f, 0.f, 0.f};
            if (smp) { cs = *(const f32x4*)(RC + t * 64 + e4); sn = *(const f32x4*)(RS + t * 64 + e4); }
            { float s0 = (v[0][0] * v[0][0] + v[0][1] * v[0][1]) + (v[0][2] * v[0][2] + v[0][3] * v[0][3]), s1 = (v[1][0] * v[1][0] + v[1][1] * v[1][1]) + (v[1][2] * v[1][2] + v[1][3] * v[1][3]),
                    s2 = (v[2][0] * v[2][0] + v[2][1] * v[2][1]) + (v[2][2] * v[2][2] + v[2][3] * v[2][3]), s3 = 0.f;
              row16_sum4(s0, s1, s2, s3);
              v[0] = v[0] * (1.0f / sqrtf(s0 * (1.0f / 64.0f) + 1e-6f)) * gq; v[1] = v[1] * (1.0f / sqrtf(s1 * (1.0f / 64.0f) + 1e-6f)) * gq;
              if (rowq < 2) v[2] = v[2] * (1.0f / sqrtf(s2 * (1.0f / 64.0f) + 1e-6f)) * gk; }
            const size_t srow = (size_t)(b * SKV + PAST + t);
            const size_t prow = (size_t)((b * 2 + j) * TP + t);
            unsigned char* wsb = a.ws + id.z; float* ob = a.out + id.z;
#define AP_ROPE(q) f32x4 vr = v[q]; if (smp) { f32x4 p; p[0] = __shfl_xor(v[q][0], 4); p[1] = __shfl_xor(v[q][1], 4); p[2] = __shfl_xor(v[q][2], 4); p[3] = __shfl_xor(v[q][3], 4); \
                const f32x4 rot = (lane & 4) ? p : -p; vr = v[q] * cs + rot * sn; }
#define AP_PK(x) ((v2u){pk2((x)[0], (x)[1]), pk2((x)[2], (x)[3])})
#pragma unroll
            for (int q = 0; q < 2; ++q) { AP_ROPE(q); const f32x4 sq = vr * QS; *(v2u*)(wsb + A_QA + ((size_t)m * 512 + (rowq + 4 * q) * 64 + e4) * 2) = AP_PK(sq); }
            { AP_ROPE(2); const int e = (rowq & 1) * 64 + e4; const bool isk = rowq < 2;
              if (!smp) { *(f32x4*)(ob + (isk ? O_KG : O_VG) + prow * 128 + e) = v[2]; *(v2u*)(wsb + (isk ? A_KAP : A_VAP) + ((size_t)m * 128 + e) * 2) = AP_PK(v[2]); }
              else { const f32x4 x = isk ? vr : v[2]; *(v2u*)(wsb + (isk ? A_KAS : A_VAS) + (srow * 128 + e) * 2) = AP_PK(x); } }
#pragma unroll
            for (int q = 3; q < 5; ++q) { AP_ROPE(q); const f32x4 sq = vr * QS; *(v2u*)(wsb + A_QB + ((size_t)m * 512 + (rowq + 4 * (q - 3)) * 64 + e4) * 2) = AP_PK(sq); }
#pragma unroll
            for (int q = 5; q < 7; ++q) { AP_ROPE(q); const int e = (rowq + 4 * (q - 5)) * 64 + e4;
              if (!smp) { *(f32x4*)(ob + O_KD + prow * 512 + e) = v[q]; *(v2u*)(wsb + A_KBP + ((size_t)m * 512 + e) * 2) = AP_PK(v[q]); } else *(v2u*)(wsb + A_KBS + (srow * 512 + e) * 2) = AP_PK(vr); }
#pragma unroll
            for (int q = 7; q < 9; ++q) { const int e = (rowq + 4 * (q - 7)) * 64 + e4;
              if (!smp) { *(f32x4*)(ob + O_VD + prow * 512 + e) = v[q]; *(v2u*)(wsb + A_VBP + ((size_t)m * 512 + e) * 2) = AP_PK(v[q]); } else *(v2u*)(wsb + A_VBS + (srow * 512 + e) * 2) = AP_PK(v[q]); }
#undef AP_ROPE
#undef AP_PK
        } else {
            const int r = it - NTOK, b = r >> 9, pos = r & (PAST - 1);
            const size_t src = (size_t)((b * 2 + j) * PAST + pos), dst = (size_t)(b * SKV + pos);
#pragma unroll
            for (int q = 0; q < 2; ++q) { const int e = lane + 64 * q; KAS[dst * 128 + e] = (bf16)f2bf(a.in[3 + id.z][src * 128 + e]); VAS[dst * 128 + e] = (bf16)f2bf(a.in[4 + id.z][src * 128 + e]); }
#pragma unroll
            for (int q = 0; q < 8; ++q) { const int e = lane + 64 * q; KBS[dst * 512 + e] = (bf16)f2bf(a.in[5 + id.z][src * 512 + e]); VBS[dst * 512 + e] = (bf16)f2bf(a.in[6 + id.z][src * 512 + e]); }
        }
    }
}

typedef short bf16x8_t __attribute__((ext_vector_type(8)));
typedef float f32x16 __attribute__((ext_vector_type(16)));
typedef short v4i16_t __attribute__((ext_vector_type(4)));
constexpr int AT_KP = 144, AT_KBUF = 64 * AT_KP, AT_VOFF = 2 * AT_KBUF, AT_VBUFMAX = 64 * 288, AT_WSF = AT_VOFF + 2 * AT_VBUFMAX;
static_assert(AT_WSF + 8 * 128 <= RING_BYTES, "attention LDS");
template <int NDT>
__device__ __forceinline__ void attn_unit(const bf16* Qrow0, int ldq, const bf16* Kb, int ldk, const bf16* Vb, int ldv, int S, bf16* Obf, float* Of32, int ldo, LAS unsigned char* lds, const Ids& id) {
    constexpr int VP = (NDT == 2) ? 144 : 288, NVL = NDT / 2;
    const int lane = id.lane, w = id.wave, r32 = lane & 31, hi = lane >> 5, tid = id.tid;
    bf16x8_t qf[4];
    { const bf16* qrow = Qrow0 + (size_t)(32 * w + r32) * ldq;
#pragma unroll
      for (int s = 0; s < 4; ++s) qf[s] = *(const bf16x8_t*)(qrow + 16 * s + 8 * hi); }
    f32x16 o[NDT];
#pragma unroll
    for (int dt = 0; dt < NDT; ++dt)
#pragma unroll
        for (int r = 0; r < 16; ++r) o[dt][r] = 0.f;
    float m_run = -1e30f, l_run = 0.f;
    const int NT = S >> 6;
    LAS float* wsf = (LAS float*)(lds + AT_WSF + w * 128);
    const int krow = tid >> 3, kch = tid & 7;
    v4u kreg, vreg[NVL];
#define AT_GLOAD(t) do { kreg = *(const v4u*)(Kb + (size_t)((t) * 64 + krow) * ldk + 8 * kch); \
        if (NDT == 2) vreg[0] = *(const v4u*)(Vb + (size_t)((t) * 64 + krow) * ldv + 8 * kch); \
        else { _Pragma("unroll") for (int i_ = 0; i_ < NVL; ++i_) { const int ix_ = tid + 512 * i_; vreg[i_] = *(const v4u*)(Vb + (size_t)((t) * 64 + (ix_ >> 4)) * ldv + 8 * (ix_ & 15)); } } } while (0)
#define AT_LSTORE(b) do { *(LAS v4u*)(lds + (b) * AT_KBUF + krow * AT_KP + 16 * kch) = kreg; \
        if (NDT == 2) *(LAS v4u*)(lds + AT_VOFF + (b) * AT_VBUFMAX + krow * VP + 16 * kch) = vreg[0]; \
        else { _Pragma("unroll") for (int i_ = 0; i_ < NVL; ++i_) { const int ix_ = tid + 512 * i_; *(LAS v4u*)(lds + AT_VOFF + (b) * AT_VBUFMAX + (ix_ >> 4) * VP + 16 * (ix_ & 15)) = vreg[i_]; } } } while (0)
    AT_GLOAD(0); AT_LSTORE(0);
    __syncthreads();
    const int vbase = (4 * hi + ((lane & 15) >> 2)) * VP + 32 * ((lane >> 4) & 1) + 8 * (lane & 3);
#pragma unroll 1
    for (int t = 0; t < NT; ++t) {
        const int b = t & 1;
        if (t + 1 < NT) AT_GLOAD(t + 1);
        const LAS unsigned char* Kt = lds + b * AT_KBUF + r32 * AT_KP + 16 * hi;
        const LAS unsigned char* Vt = lds + AT_VOFF + b * AT_VBUFMAX + vbase;
        f32x16 p0, p1;
#pragma unroll
        for (int r = 0; r < 16; ++r) { p0[r] = 0.f; p1[r] = 0.f; }
#pragma unroll
        for (int s = 0; s < 4; ++s) { const bf16x8_t k0 = *(const LAS bf16x8_t*)(Kt + 32 * s), k1 = *(const LAS bf16x8_t*)(Kt + 32 * AT_KP + 32 * s);
            p0 = __builtin_amdgcn_mfma_f32_32x32x16_bf16(k0, qf[s], p0, 0, 0, 0); p1 = __builtin_amdgcn_mfma_f32_32x32x16_bf16(k1, qf[s], p1, 0, 0, 0); }
        float mx = fmaxf(p0[0], p1[0]);
#pragma unroll
        for (int r = 1; r < 16; ++r) mx = fmaxf(mx, fmaxf(p0[r], p1[r]));
        mx = fmaxf(mx, __shfl_xor(mx, 32));
        const float mn = fmaxf(m_run, mx), al = exp2f(m_run - mn); m_run = mn;
        float rs = 0.f;
#pragma unroll
        for (int r = 0; r < 16; ++r) { p0[r] = exp2f(p0[r] - mn); p1[r] = exp2f(p1[r] - mn); rs += p0[r] + p1[r]; }
        l_run = l_run * al + rs;
        if (hi == 0) wsf[r32] = al;
        LDS_WAIT(); asm volatile("" ::: "memory");
        { f32x4 a4[4];
#pragma unroll
          for (int g4 = 0; g4 < 4; ++g4) a4[g4] = *(const LAS f32x4*)(wsf + 8 * g4 + 4 * hi);
#pragma unroll
          for (int dt = 0; dt < NDT; ++dt)
#pragma unroll
              for (int r = 0; r < 16; ++r) o[dt][r] *= a4[r >> 2][r & 3]; }
        LDS_WAIT(); asm volatile("" ::: "memory");
        bf16x8_t pf[4];
#pragma unroll
        for (int ks = 0; ks < 4; ++ks) { v4u pw;
#pragma unroll
            for (int dd = 0; dd < 4; ++dd) { const int r = 8 * (ks & 1) + 2 * dd; pw[dd] = (ks < 2) ? pk2(p0[r], p0[r + 1]) : pk2(p1[r], p1[r + 1]); }
            pf[ks] = __builtin_bit_cast(bf16x8_t, pw); }
#pragma unroll
        for (int ks = 0; ks < 4; ++ks)
#pragma unroll
            for (int dt = 0; dt < NDT; ++dt) {
                const v4i16_t lo = __builtin_amdgcn_ds_read_tr16_b64_v4i16((LAS v4i16_t*)(Vt + (16 * ks) * VP + 64 * dt));
                const v4i16_t hh = __builtin_amdgcn_ds_read_tr16_b64_v4i16((LAS v4i16_t*)(Vt + (16 * ks + 8) * VP + 64 * dt));
                const bf16x8_t vf = (bf16x8_t){lo[0], lo[1], lo[2], lo[3], hh[0], hh[1], hh[2], hh[3]};
                o[dt] = __builtin_amdgcn_mfma_f32_32x32x16_bf16(pf[ks], vf, o[dt], 0, 0, 0); }
        if (t + 1 < NT) AT_LSTORE(b ^ 1);
        __syncthreads();
    }
#undef AT_GLOAD
#undef AT_LSTORE
    const float lt = l_run + __shfl_xor(l_run, 32);
    int lane_e = lane; asm volatile("" : "+v"(lane_e));
    const int r32e = lane_e & 31, hie = lane_e >> 5;
    if (hi == 0) wsf[r32] = 1.0f / lt;
    LDS_WAIT(); asm volatile("" ::: "memory");
    f32x4 a4[4];
#pragma unroll
    for (int g4 = 0; g4 < 4; ++g4) a4[g4] = *(const LAS f32x4*)(wsf + 8 * g4 + 4 * hi);
    LDS_WAIT(); asm volatile("" ::: "memory");
#pragma unroll
    for (int dt = 0; dt < NDT; ++dt)
#pragma unroll
        for (int r = 0; r < 16; ++r) { const float val = o[dt][r] * a4[r >> 2][r & 3]; const int off = (32 * w + (r & 3) + 8 * (r >> 2) + 4 * hie) * ldo + 32 * dt + r32e;
            if (NDT == 2) Obf[off] = (bf16)f2bf(val); else Of32[off] = val; }
}
__device__ __forceinline__ void ph_attn(const Args& a, const Ids& id, LAS unsigned char* lds, int G, int vcu) {
    const bf16 *QA = (const bf16*)(a.ws + id.z + A_QA), *QB = (const bf16*)(a.ws + id.z + A_QB), *KAP = (const bf16*)(a.ws + id.z + A_KAP), *VAP = (const bf16*)(a.ws + id.z + A_VAP), *KBP = (const bf16*)(a.ws + id.z + A_KBP), *VBP = (const bf16*)(a.ws + id.z + A_VBP);
    const bf16 *KAS = (const bf16*)(a.ws + id.z + A_KAS), *VAS = (const bf16*)(a.ws + id.z + A_VAS), *KBS = (const bf16*)(a.ws + id.z + A_KBS), *VBS = (const bf16*)(a.ws + id.z + A_VBS);
    bf16* H = (bf16*)(a.ws + id.z + A_H); float* DT = (float*)(a.ws + id.z + A_DT);
    for (int s = vcu; s < 256; s += G) {
        const int h8 = s & 7;
#pragma unroll 1
        for (int pass = 0; pass < 2; ++pass) {
            size_t m0, kvrow; int S;
            if (pass == 0) { const int b = s >> 6, qb = (s >> 3) & 7; m0 = (size_t)NPR + b * TS + qb * 256; kvrow = (size_t)b * SKV; S = SKV; }
            else { const int b = s >> 3; m0 = (size_t)b * TP; kvrow = m0; S = TP; }
            const bf16* Ka = (pass == 0 ? KAS : KAP) + kvrow * 128 + (h8 >> 2) * 64; const bf16* Va = (pass == 0 ? VAS : VAP) + kvrow * 128 + (h8 >> 2) * 64;
            const bf16* Kd = (pass == 0 ? KBS : KBP) + kvrow * 512 + h8 * 64; const bf16* Vd = (pass == 0 ? VBS : VBP) + kvrow * 512 + (h8 >> 1) * 128;
            attn_unit<2>(QA + m0 * 512 + h8 * 64, 512, Ka, 128, Va, 128, S, H + m0 * D + h8 * 64, nullptr, D, lds, id);
            attn_unit<4>(QB + m0 * 512 + h8 * 64, 512, Kd, 512, Vd, 512, S, nullptr, DT + m0 * D + h8 * 128, D, lds, id);
        }
    }
}
__device__ __forceinline__ void ph_att_comb(const Args& a, const Ids& id, int layer) {
    const int j = layer >> 1, lane = id.lane; const float lam_init = (layer == 0) ? 0.2f : 0.4707130183435842f;
    const float* lf = a.in[15 + id.z] + j * 256; const float* sg = a.in[16 + id.z] + j * 128;
    const float s01 = wave_sum(lf[lane] * lf[64 + lane]), s23 = wave_sum(lf[128 + lane] * lf[192 + lane]);
    const float lam = expf(s01) - expf(s23) + lam_init;
    const float* DT = (const float*)(a.ws + id.z + A_DT); bf16* H = (bf16*)(a.ws + id.z + A_H);
    const f32x4 gg = *(const f32x4*)(sg + 4 * (lane & 31)) * (1.0f - lam_init);
    for (int m = id.gw; m < NTOK; m += id.ngw) {
        f32x4 v[4];
#pragma unroll
        for (int hd = 0; hd < 4; ++hd) v[hd] = *(const f32x4*)(DT + (size_t)m * D + 256 * hd + 4 * lane);
        float ss[4];
#pragma unroll
        for (int hd = 0; hd < 4; ++hd) { f32x4 o; o[0] = __shfl_xor(v[hd][0], 32); o[1] = __shfl_xor(v[hd][1], 32); o[2] = __shfl_xor(v[hd][2], 32); o[3] = __shfl_xor(v[hd][3], 32);
            v[hd] = v[hd] - o * lam;
            ss[hd] = (lane < 32) ? (v[hd][0] * v[hd][0] + v[hd][1] * v[hd][1]) + (v[hd][2] * v[hd][2] + v[hd][3] * v[hd][3]) : 0.f; }
        row16_sum4(ss[0], ss[1], ss[2], ss[3]);
#pragma unroll
        for (int hd = 0; hd < 4; ++hd) { const float tot = ss[hd] + __shfl_xor(ss[hd], 16); const float ri = 1.0f / sqrtf(tot * (1.0f / 128.0f) + 1e-6f); const f32x4 o = v[hd] * ri * gg;
            if (lane < 32) *(v2u*)(H + (size_t)m * D + 512 + hd * 128 + 4 * lane) = (v2u){pk2(o[0], o[1]), pk2(o[2], o[3])}; }
    }
}

__device__ __forceinline__ void ph_rw_prep(const Args& a, const Ids& id, int layer) {
    const int j = layer >> 1, lane = id.lane;
    const bf16* RKV = (const bf16*)(a.ws + id.z + A_RKV); float* INV = (float*)(a.ws + id.z + WS_INV); float* Y = (float*)(a.ws + id.z + A_Y);
    const float* kk_c = a.in[28 + id.z] + (size_t)(j * 3 + 0) * D;
    for (int m = id.gw; m < NTOK; m += id.ngw) {
#pragma unroll 4
        for (int h = 0; h < 16; ++h) { const float kv = bf2f(RKV[(size_t)m * 3072 + 1024 + h * 64 + lane]) * kk_c[h * 64 + lane]; const float ss = wave_sum(kv * kv); if (lane == 0) INV[m * 16 + h] = 1.0f / sqrtf(ss + 1e-12f); }
        f32x4* yp = (f32x4*)(Y + (size_t)m * D);
#pragma unroll
        for (int q = 0; q < 4; ++q) yp[lane + 64 * q] = (f32x4){0.f, 0.f, 0.f, 0.f};
    }
}

constexpr int SC_TC = 16, SC_ROWF = 352;
constexpr int SC_OPF = SC_TC * SC_ROWF;
constexpr int SC_YOFF = 4 * SC_OPF;
static_assert((SC_YOFF + 4 * SC_TC * 32) * 4 <= RING_BYTES, "scan LDS");
struct ScDesc { int mbase, T, h, dir, half, b; };
__device__ __forceinline__ void sc_desc(ScDesc& d, int slot, int grp, int c) {
    if (grp == 0) { const int cs = slot >> 1; d.b = cs >> 5; d.h = (cs >> 1) & 15; d.dir = cs & 1; d.half = slot & 1; d.T = TS; d.mbase = NPR + d.b * TS; }
    else { const int pu = slot * 8 + (c >> 4), cp = pu >> 1; d.b = cp >> 5; d.h = (cp >> 1) & 15; d.dir = cp & 1; d.half = pu & 1; d.T = TP; d.mbase = d.b * TP; }
}
__device__ __forceinline__ int sc_tok(const ScDesc& d, int grp, int c, int i) { const int s = (grp == 0 ? c : (c & 15)) * SC_TC + i; return d.mbase + (d.dir ? d.T - 1 - s : s); }
__device__ __forceinline__ float fma_s(float a, float b, float c) { float r; asm("v_fma_f32 %0, %1, %2, %3" : "=v"(r) : "v"(a), "v"(b), "v"(c)); return r; }
__device__ __forceinline__ float fnma_s(float a, float b, float c) { float r; asm("v_fma_f32 %0, -%1, %2, %3" : "=v"(r) : "v"(a), "v"(b), "v"(c)); return r; }
__device__ __forceinline__ float mul_s(float a, float b) { float r; asm("v_mul_f32_e32 %0, %1, %2" : "=v"(r) : "v"(a), "v"(b)); return r; }
__device__ __forceinline__ float add_s(float a, float b) { float r; asm("v_add_f32_e32 %0, %1, %2" : "=v"(r) : "v"(a), "v"(b)); return r; }
__device__ __forceinline__ void oct_sum4(float& a, float& b, float& c, float& d) {
    asm("s_nop 1\n\t"
        "v_add_f32_dpp %0, %0, %0 quad_perm:[1,0,3,2] row_mask:0xf bank_mask:0xf\n\tv_add_f32_dpp %1, %1, %1 quad_perm:[1,0,3,2] row_mask:0xf bank_mask:0xf\n\tv_add_f32_dpp %2, %2, %2 quad_perm:[1,0,3,2] row_mask:0xf bank_mask:0xf\n\tv_add_f32_dpp %3, %3, %3 quad_perm:[1,0,3,2] row_mask:0xf bank_mask:0xf\n\t"
        "v_add_f32_dpp %0, %0, %0 quad_perm:[2,3,0,1] row_mask:0xf bank_mask:0xf\n\tv_add_f32_dpp %1, %1, %1 quad_perm:[2,3,0,1] row_mask:0xf bank_mask:0xf\n\tv_add_f32_dpp %2, %2, %2 quad_perm:[2,3,0,1] row_mask:0xf bank_mask:0xf\n\tv_add_f32_dpp %3, %3, %3 quad_perm:[2,3,0,1] row_mask:0xf bank_mask:0xf\n\t"
        "v_add_f32_dpp %0, %0, %0 row_half_mirror row_mask:0xf bank_mask:0xf\n\tv_add_f32_dpp %1, %1, %1 row_half_mirror row_mask:0xf bank_mask:0xf\n\tv_add_f32_dpp %2, %2, %2 row_half_mirror row_mask:0xf bank_mask:0xf\n\tv_add_f32_dpp %3, %3, %3 row_half_mirror row_mask:0xf bank_mask:0xf"
        : "+v"(a), "+v"(b), "+v"(c), "+v"(d));
}
struct ScOps { f32x4 w[2], kd[2], kk[2], ka[2], r[2]; float va, vb; };
__device__ __forceinline__ void sc_ldops(ScOps& o, const LAS float* p, int kg, int ra) {
#pragma unroll
    for (int hq = 0; hq < 2; ++hq) { o.w[hq] = *(const LAS f32x4*)(p + 8 * kg + 4 * hq); o.kd[hq] = *(const LAS f32x4*)(p + 64 + 8 * kg + 4 * hq); o.kk[hq] = *(const LAS f32x4*)(p + 128 + 8 * kg + 4 * hq);
        o.ka[hq] = *(const LAS f32x4*)(p + 192 + 8 * kg + 4 * hq); o.r[hq] = *(const LAS f32x4*)(p + 256 + 8 * kg + 4 * hq); }
    o.va = p[320 + ra]; o.vb = p[321 + ra];
}
__device__ __forceinline__ float dot8_s(const float (&S)[8], const f32x4 (&x)[2]) {
    const float p0 = fma_s(S[3], x[0][3], fma_s(S[2], x[0][2], fma_s(S[1], x[0][1], mul_s(S[0], x[0][0]))));
    const float p1 = fma_s(S[7], x[1][3], fma_s(S[6], x[1][2], fma_s(S[5], x[1][1], mul_s(S[4], x[1][0]))));
    return add_s(p0, p1);
}
struct ScRaw { float r[8], k[8], a[8], e[8], v[8], iv[8]; };
__device__ __forceinline__ void sc_load(ScRaw& R, const Args& a, const Ids& id, int hw, int slot, int c) {
    const int grp = hw >> 1, lane = id.lane; ScDesc d; sc_desc(d, slot, grp, c);
    const bf16* RKV = (const bf16*)(a.ws + id.z + A_RKV); const float* INV = (const float*)(a.ws + id.z + WS_INV);
    const bf16* Ad = (const bf16*)(a.ws + id.z + (d.dir ? A_A1 : A_A0)); const bf16* EWd = (const bf16*)(a.ws + id.z + (d.dir ? A_EW1 : A_EW0));
#pragma unroll
    for (int q = 0; q < 8; ++q) { const int m = sc_tok(d, grp, c, (hw & 1) * 8 + q); const size_t o = (size_t)m * 3072 + d.h * 64 + lane, o2 = (size_t)m * D + d.h * 64 + lane;
        R.r[q] = bf2f(RKV[o]); R.k[q] = bf2f(RKV[o + 1024]); R.a[q] = bf2f(Ad[o2]); R.e[q] = bf2f(EWd[o2]); R.iv[q] = INV[m * 16 + d.h];
        R.v[q] = bf2f(RKV[(size_t)m * 3072 + 2048 + d.h * 64 + d.half * 32 + (lane & 31)]); }
}
__device__ __forceinline__ void sc_derive(const ScRaw& R, const Args& a, const Ids& id, LAS float* L, int layer, int hw, int slot, int c, int buf) {
    const int grp = hw >> 1, lane = id.lane, j = layer >> 1; ScDesc d; sc_desc(d, slot, grp, c);
    const float kkc = a.in[28 + id.z][(size_t)(j * 3 + 0) * D + d.h * 64 + lane], kac = a.in[28 + id.z][(size_t)(j * 3 + 1) * D + d.h * 64 + lane];
#pragma unroll
    for (int q = 0; q < 8; ++q) { LAS float* p = L + (buf * 2 + grp) * SC_OPF + ((hw & 1) * 8 + q) * SC_ROWF;
        const float kk = R.k[q] * kkc * R.iv[q];
        p[lane] = exp2f(-R.e[q]); p[64 + lane] = R.k[q] * (1.0f + (R.a[q] - 1.0f) * kac); p[128 + lane] = kk; p[192 + lane] = kk * R.a[q]; p[256 + lane] = R.r[q];
        if (lane < 32) p[320 + lane] = R.v[q]; }
}
__device__ __forceinline__ void sc_flush(const Args& a, const Ids& id, const LAS float* L, int hw, int slot, int c) {
    float* Y = (float*)(a.ws + id.z + A_Y);
#pragma unroll
    for (int q = 0; q < 4; ++q) { const int idx = hw * 64 + id.lane + 256 * q, fg = idx >> 9, s = (idx >> 5) & 15, row = idx & 31; ScDesc d; sc_desc(d, slot, fg, c);
        const float yv = L[SC_YOFF + ((c & 1) * 2 + fg) * SC_TC * 32 + s * 32 + row];
        atomicAdd(&Y[(size_t)sc_tok(d, fg, c, s) * D + d.h * 64 + d.half * 32 + row], yv); }
}
__device__ __forceinline__ void ph_rw_scan(const Args& a, const Ids& id, LAS unsigned char* lds, int layer, int G, int vcu) {
    const int j = layer >> 1, lane = id.lane, w = id.wave;
    LAS float* L = (LAS float*)lds;
    constexpr int NC = TS / SC_TC;
    for (int slot = vcu; slot < 256; slot += G) {
        if (w >= 4) {
            const int hw = w - 4; ScRaw R;
            sc_load(R, a, id, hw, slot, 0); sc_derive(R, a, id, L, layer, hw, slot, 0, 0);
            __syncthreads();
#pragma unroll 1
            for (int c = 0; c < NC; ++c) {
                if (c + 1 < NC) sc_load(R, a, id, hw, slot, c + 1);
                if (c > 0) sc_flush(a, id, L, hw, slot, c - 1);
                if (c + 1 < NC) sc_derive(R, a, id, L, layer, hw, slot, c + 1, (c & 1) ^ 1);
                __syncthreads();
            }
            sc_flush(a, id, L, hw, slot, NC - 1);
        } else {
            const int grp = w >> 1, kg = lane & 7, ra = 16 * (w & 1) + 2 * (lane >> 3);
            float Sa[8], Sb[8];
            { ScDesc d; sc_desc(d, slot, 0, 0);
              if (grp == 0) { const float* sp = a.in[7 + id.z] + ((((size_t)(d.b * 2 + j) * 2 + d.dir) * 16 + d.h) * 64 + d.half * 32 + ra) * 64 + 8 * kg;
                  const f32x4 t0 = *(const f32x4*)sp, t1 = *(const f32x4*)(sp + 4), t2 = *(const f32x4*)(sp + 64), t3 = *(const f32x4*)(sp + 68);
#pragma unroll
                  for (int e2 = 0; e2 < 4; ++e2) { Sa[e2] = t0[e2]; Sa[4 + e2] = t1[e2]; Sb[e2] = t2[e2]; Sb[4 + e2] = t3[e2]; } }
              else {
#pragma unroll
                  for (int e2 = 0; e2 < 8; ++e2) { Sa[e2] = 0.f; Sb[e2] = 0.f; } } }
            __syncthreads();
#pragma unroll 1
            for (int c = 0; c < NC; ++c) {
                const int buf = c & 1;
                if (grp == 1 && (c & 15) == 0) {
#pragma unroll
                    for (int e2 = 0; e2 < 8; ++e2) { Sa[e2] = 0.f; Sb[e2] = 0.f; } }
                const LAS float* ob = L + (buf * 2 + grp) * SC_OPF; LAS float* yb = L + SC_YOFF + (buf * 2 + grp) * SC_TC * 32 + ra;
                {
                    ScOps cur, nxt; sc_ldops(cur, ob, kg, ra);
                    float ypa = 0.f, ypb = 0.f;
#pragma unroll
                    for (int i = 0; i < SC_TC; ++i) {
                        if (i + 1 < SC_TC) sc_ldops(nxt, ob + (i + 1) * SC_ROWF, kg, ra);
                        float ua[8], ub[8];
#pragma unroll
                        for (int e2 = 0; e2 < 8; ++e2) { ua[e2] = fma_s(Sa[e2], cur.w[e2 >> 2][e2 & 3], mul_s(cur.va, cur.kd[e2 >> 2][e2 & 3])); ub[e2] = fma_s(Sb[e2], cur.w[e2 >> 2][e2 & 3], mul_s(cur.vb, cur.kd[e2 >> 2][e2 & 3])); }
                        float ska = dot8_s(Sa, cur.kk), skb = dot8_s(Sb, cur.kk);
                        oct_sum4(ska, skb, ypa, ypb);
                        if (i > 0 && kg == 0) { yb[(i - 1) * 32] = ypa; yb[(i - 1) * 32 + 1] = ypb; }
#pragma unroll
                        for (int e2 = 0; e2 < 8; ++e2) { Sa[e2] = fnma_s(ska, cur.ka[e2 >> 2][e2 & 3], ua[e2]); Sb[e2] = fnma_s(skb, cur.ka[e2 >> 2][e2 & 3], ub[e2]); }
                        ypa = dot8_s(Sa, cur.r); ypb = dot8_s(Sb, cur.r);
                        if (i + 1 < SC_TC) cur = nxt;
                    }
                    float z0 = 0.f, z1 = 0.f; oct_sum4(ypa, ypb, z0, z1);
                    if (kg == 0) { yb[(SC_TC - 1) * 32] = ypa; yb[(SC_TC - 1) * 32 + 1] = ypb; }
                }
                if (grp == 1 && (c & 15) == 15) { ScDesc d; sc_desc(d, slot, 1, c);
                    float* dp = a.out + id.z + O_ST + ((((size_t)(d.b * 2 + j) * 2 + d.dir) * 16 + d.h) * 64 + d.half * 32 + ra) * 64 + 8 * kg;
                    *(f32x4*)dp = (f32x4){Sa[0], Sa[1], Sa[2], Sa[3]}; *(f32x4*)(dp + 4) = (f32x4){Sa[4], Sa[5], Sa[6], Sa[7]};
                    *(f32x4*)(dp + 64) = (f32x4){Sb[0], Sb[1], Sb[2], Sb[3]}; *(f32x4*)(dp + 68) = (f32x4){Sb[4], Sb[5], Sb[6], Sb[7]}; }
                __syncthreads();
            }
        }
        __syncthreads();
    }
}
__device__ __forceinline__ void ph_rw_post(const Args& a, const Ids& id, int layer) {
    const int j = layer >> 1, lane = id.lane;
    const bf16* RKV = (const bf16*)(a.ws + id.z + A_RKV); const float* Y = (const float*)(a.ws + id.z + A_Y);
    const bf16 *A0 = (const bf16*)(a.ws + id.z + A_A0), *A1 = (const bf16*)(a.ws + id.z + A_A1); bf16* H = (bf16*)(a.ws + id.z + A_H);
    const float* kvec = a.in[28 + id.z] + (size_t)j * 3 * D; const float* lnx = a.in[29 + id.z] + (size_t)j * 2 * D;
    f32x4 ka[4], rk[4], l0[4], l1[4];
#pragma unroll
    for (int q = 0; q < 4; ++q) { const int c = 4 * lane + 256 * q; ka[q] = *(const f32x4*)(kvec + D + c); rk[q] = *(const f32x4*)(kvec + 2 * D + c); l0[q] = *(const f32x4*)(lnx + c); l1[q] = *(const f32x4*)(lnx + D + c); }
    for (int m = id.gw; m < NTOK; m += id.ngw) {
        f32x4 y[4], r[4], k[4], v[4], a0[4], a1[4], g[4];
#pragma unroll
        for (int q = 0; q < 4; ++q) { const int c = 4 * lane + 256 * q; y[q] = *(const f32x4*)(Y + (size_t)m * D + c);
            r[q] = ld_bf4(RKV + (size_t)m * 3072 + c); k[q] = ld_bf4(RKV + (size_t)m * 3072 + 1024 + c); v[q] = ld_bf4(RKV + (size_t)m * 3072 + 2048 + c);
            a0[q] = ld_bf4(A0 + (size_t)m * D + c); a1[q] = ld_bf4(A1 + (size_t)m * D + c); g[q] = ld_bf4(H + (size_t)m * D + c); }
        float s[4], qv[4], bs[4];
#pragma unroll
        for (int q = 0; q < 4; ++q) s[q] = (y[q][0] + y[q][1]) + (y[q][2] + y[q][3]);
        row16_sum4(s[0], s[1], s[2], s[3]);
#pragma unroll
        for (int q = 0; q < 4; ++q) { const float mean = s[q] * (1.0f / 64.0f); y[q] = y[q] - mean; qv[q] = (y[q][0] * y[q][0] + y[q][1] * y[q][1]) + (y[q][2] * y[q][2] + y[q][3] * y[q][3]);
            const f32x4 kds = k[q] * ((a0[q] - 1.0f) * ka[q] + 1.0f) + k[q] * ((a1[q] - 1.0f) * ka[q] + 1.0f); const f32x4 t = r[q] * kds * rk[q]; bs[q] = (t[0] + t[1]) + (t[2] + t[3]); }
        row16_sum4(qv[0], qv[1], qv[2], qv[3]);
        row16_sum4(bs[0], bs[1], bs[2], bs[3]);
#pragma unroll
        for (int q = 0; q < 4; ++q) { const float ri = 1.0f / sqrtf(qv[q] * (1.0f / 64.0f) + 64e-5f); const f32x4 o = ((y[q] * ri) * l0[q] + l1[q] + v[q] * bs[q]) * g[q];
            *(v2u*)(H + (size_t)m * D + 4 * lane + 256 * q) = (v2u){pk2(o[0], o[1]), pk2(o[2], o[3])}; }
    }
}

enum Kind { K_PRO = 0, K_NORM0 = 1, K_QKV = 2, K_APOST = 3, K_ATTN = 4, K_ACOMB = 5, K_MIXOUT = 6, K_RNORM = 7, K_MLP1 = 8, K_MLP2 = 9, K_REND = 10,
            K_RMIX = 11, K_RKV = 12, K_RPREP = 13, K_RSCAN = 14, K_RPOST = 15 };
constexpr int NPH = 40;
__host__ __device__ __forceinline__ void decode_phase(int ph, int& kind, int& layer) {
    if (ph < 2) { kind = ph; layer = 0; return; }
    const int p = ph - 2, pair = p / 19, q = p % 19;
    if (q < 9) { layer = 2 * pair; kind = K_QKV + q; }
    else { layer = 2 * pair + 1; const int q2 = q - 9; kind = (q2 < 5) ? (K_RMIX + q2) : (K_MIXOUT + (q2 - 5)); }
}

#ifndef PROBE_MASK
#define PROBE_MASK 0
#endif
#ifndef PROBE_REPS
#define PROBE_REPS 1
#endif
template <int KIND, int LAYER>
__device__ __forceinline__ void run_phase(const Args& a, LAS unsigned char* lds, int G, int bx, int vcu, int wave_s, int rep) {
    Ids id; { int lv; asm volatile("v_mbcnt_lo_u32_b32 %0, -1, 0\n\tv_mbcnt_hi_u32_b32 %0, -1, %0" : "=v"(lv)); int zz; asm volatile("s_mov_b32 %0, 0" : "=s"(zz)); id.lane = lv; id.z = zz; }
    id.wave = wave_s; id.tid = wave_s * 64 + id.lane; id.gw = vcu * NWAVES + id.wave; id.ngw = G * NWAVES;
    constexpr int layer = LAYER;
    if constexpr (KIND == K_PRO) ph_prologue(a, id, lds);
    else if constexpr (KIND == K_NORM0) ph_norm0(a, id);
    else if constexpr (KIND == K_QKV) {
        pg8::Gemm g{(const bf16*)(a.ws + id.z + A_H), (const bf16*)(a.ws + id.z + W_WINT), NTOK, NQKV, D}; pg8::StaticOrder S; S.init(NTOK, NQKV, G, bx);
        pg8::EpiF32 E{(float*)(a.ws + id.z + A_QKVRAW), NQKV};
        pg8::gemm_phase<pg8::EpiF32, pg8::StaticOrder, true, true>(lds + RING_OFF, g, S, E, id.wave);
    }
    else if constexpr (KIND == K_MIXOUT) {
        pg8::Gemm g{(const bf16*)(a.ws + id.z + A_H), (const bf16*)(a.ws + id.z + ((layer & 1) ? W_WOT : W_WOUTT)), NTOK, D, D}; pg8::StaticOrder S; S.init(NTOK, D, G, bx);
        pg8::EpiF32 E{(float*)(a.ws + id.z + A_M), D};
        pg8::gemm_phase<pg8::EpiF32, pg8::StaticOrder, true, true>(lds + RING_OFF, g, S, E, id.wave);
    }
    else if constexpr (KIND == K_MLP2) {
        pg8::Gemm g{(const bf16*)(a.ws + id.z + A_HID), (const bf16*)(a.ws + id.z + W_W2T), NTOK, D, FF}; pg8::StaticOrder S; S.init(NTOK, D, G, bx);
        pg8::EpiF32 E{(float*)(a.ws + id.z + A_F), D};
        pg8::gemm_phase<pg8::EpiF32, pg8::StaticOrder, true, true>(lds + RING_OFF, g, S, E, id.wave);
    }
    else if constexpr (KIND == K_MLP1) {
        pg8::Gemm g{(const bf16*)(a.ws + id.z + A_H), (const bf16*)(a.ws + id.z + W_W1T), NTOK, FF, D}; pg8::StaticOrder S; S.init(NTOK, FF, G, bx);
        pg8::EpiBf16<2> E{(bf16*)(a.ws + id.z + A_HID), FF, 1 << 20, nullptr, 0};
        pg8::gemm_phase<pg8::EpiBf16<2>, pg8::StaticOrder, true, true>(lds + RING_OFF, g, S, E, id.wave);
    }
    else if constexpr (KIND == K_RKV) {
        pg8::Gemm g{(const bf16*)(a.ws + id.z + A_A2), (const bf16*)(a.ws + id.z + W_BT1), NTOK, NRKV, KRKV}; pg8::StaticOrder S; S.init(NTOK, NRKV, G, bx);
        pg8::EpiRkv E{(bf16*)(a.ws + id.z + A_RKV), (bf16*)(a.ws + id.z + A_L1)};
        pg8::gemm_phase<pg8::EpiRkv, pg8::StaticOrder, true, true>(lds + RING_OFF, g, S, E, id.wave);
    }
    else if constexpr (KIND == K_RPREP) {
        constexpr int j = layer >> 1;
        pg8::Gemm g{(const bf16*)(a.ws + id.z + A_L1), (const bf16*)(a.ws + id.z + W_BT2), NTOK, 5120, 384}; pg8::StaticOrder S; S.init(NTOK, 5120, G, bx);
        static_assert(A_A1 - A_A0 == 32 * MiB && A_EW0 - A_A0 == 64 * MiB && A_EW1 - A_A0 == 96 * MiB, "EpiLora2 output stride");
        pg8::EpiLora2 E{(bf16*)(a.ws + id.z + A_A0), (size_t)16 * MiB, (bf16*)(a.ws + id.z + A_G), a.in[23 + id.z] + (size_t)j * 2 * D, a.in[20 + id.z] + (size_t)j * 2 * D};
        pg8::gemm_phase<pg8::EpiLora2, pg8::StaticOrder, true, true>(lds + RING_OFF, g, S, E, id.wave);
        { Ids id2 = id; int lv; asm volatile("v_mbcnt_lo_u32_b32 %0, -1, 0\n\tv_mbcnt_hi_u32_b32 %0, -1, %0" : "=v"(lv)); int zz; asm volatile("s_mov_b32 %0, 0" : "=s"(zz));
          id2.lane = lv; id2.z = zz; id2.tid = id.wave * 64 + lv; ph_rw_prep(a, id2, layer); }
    }
    else if constexpr (KIND == K_APOST) ph_att_post(a, id, layer);
    else if constexpr (KIND == K_ATTN) ph_attn(a, id, lds, G, vcu);
    else if constexpr (KIND == K_ACOMB) ph_att_comb(a, id, layer);
    else if constexpr (KIND == K_RNORM) ph_resid_norm(a, id, layer, rep + 1 < (((PROBE_MASK >> K_RNORM) & 1) ? PROBE_REPS : 1));
    else if constexpr (KIND == K_REND) ph_resid_end(a, id, lds, layer, rep + 1 < (((PROBE_MASK >> K_REND) & 1) ? PROBE_REPS : 1));
    else if constexpr (KIND == K_RMIX) ph_rw_mix(a, id, layer);
    else if constexpr (KIND == K_RSCAN) { if (rep > 0) { ph_rw_prep(a, id, layer); __syncthreads(); cg::this_grid().sync(); } ph_rw_scan(a, id, lds, layer, G, vcu); }
    else if constexpr (KIND == K_RPOST) ph_rw_post(a, id, layer);
}

__global__ void __launch_bounds__(NWAVES * 64, 2) mega_fwd(Args a) {
    extern __shared__ __attribute__((aligned(16))) unsigned char lds_raw[];
    LAS unsigned char* lds = (LAS unsigned char*)lds_raw;
    const int G = gridDim.x, bx = blockIdx.x; const int vcu = (G % 8 == 0) ? (bx % 8) * (G / 8) + bx / 8 : bx;
    volatile LAS unsigned* MISC = (volatile LAS unsigned*)(lds + MISC_OFF);
    for (int u = threadIdx.x; u < (LDS_BYTES - LDSCTL_OFF) / 4; u += NWAVES * 64) ((LAS unsigned*)(lds + LDSCTL_OFF))[u] = 0u;
    __syncthreads();
#if MK_N_LAUNCHES == 1 && !MK_CG_BARRIER
    XcdBarrier bar = xcd_barrier_post((unsigned*)(a.ws + WS_CTL) + CW_BAR, MISC + 8, threadIdx.x == 0);
#endif
    (void)MISC;
    const int lo = a.ph_lo, hi = a.ph_hi;
    const int wave_s = __builtin_amdgcn_readfirstlane(threadIdx.x >> 6);
#if MK_N_LAUNCHES == 1
#if MK_CG_BARRIER
#define GRID_BAR(ph) cg::this_grid().sync()
#else
#define GRID_BAR(ph) do { if ((ph) == 0) cg::this_grid().sync(); else { int l_; asm volatile("v_mbcnt_lo_u32_b32 %0, -1, 0\n\tv_mbcnt_hi_u32_b32 %0, -1, %0" : "=v"(l_)); xcd_barrier(bar, wave_s == 0 && l_ == 0); } } while (0)
#endif
#else
#define GRID_BAR(ph) do { } while (0)
#endif
#define PHASE(ph, KIND, LAYER) do { if (lo <= (ph) && (ph) < hi) { constexpr int nrep_ = ((PROBE_MASK >> (KIND)) & 1) ? PROBE_REPS : 1; \
        _Pragma("unroll 1") for (int rep_ = 0; rep_ < nrep_; ++rep_) { run_phase<KIND, LAYER>(a, lds, G, bx, vcu, wave_s, rep_); if (rep_ + 1 < nrep_) { __syncthreads(); cg::this_grid().sync(); } } \
        if ((ph) + 1 < hi) GRID_BAR(ph); } } while (0)
#define ATTN_LAYER(p0, L) PHASE((p0) + 0, K_QKV, L); PHASE((p0) + 1, K_APOST, L); PHASE((p0) + 2, K_ATTN, L); PHASE((p0) + 3, K_ACOMB, L); PHASE((p0) + 4, K_MIXOUT, L); \
        PHASE((p0) + 5, K_RNORM, L); PHASE((p0) + 6, K_MLP1, L); PHASE((p0) + 7, K_MLP2, L); PHASE((p0) + 8, K_REND, L)
#define RWKV_LAYER(p0, L) PHASE((p0) + 0, K_RMIX, L); PHASE((p0) + 1, K_RKV, L); PHASE((p0) + 2, K_RPREP, L); PHASE((p0) + 3, K_RSCAN, L); PHASE((p0) + 4, K_RPOST, L); PHASE((p0) + 5, K_MIXOUT, L); \
        PHASE((p0) + 6, K_RNORM, L); PHASE((p0) + 7, K_MLP1, L); PHASE((p0) + 8, K_MLP2, L); PHASE((p0) + 9, K_REND, L)
    PHASE(0, K_PRO, 0); PHASE(1, K_NORM0, 0);
    ATTN_LAYER(2, 0); RWKV_LAYER(11, 1); ATTN_LAYER(21, 2); RWKV_LAYER(30, 3);
#undef PHASE
#undef ATTN_LAYER
#undef RWKV_LAYER
#undef GRID_BAR
}

extern "C" void kernel_launch(void* const* d_in, const int* in_sizes, int n_in, void* d_out, int out_size, void* d_ws, size_t ws_size, hipStream_t stream) {
    static int grid = 0;
    if (grid == 0) {
        if (n_in != 32 || (size_t)out_size != OUT_TOTAL || ws_size < WS_END) { fprintf(stderr, "kernel_launch: unexpected problem (n_in %d, out %d, ws %zu; need ws >= %zu); nothing launched\n", n_in, out_size, ws_size, (size_t)WS_END); grid = -1; return; }
        int dev = 0, cus = 0, per_cu = 0;
        if (hipGetDevice(&dev) != hipSuccess || hipDeviceGetAttribute(&cus, hipDeviceAttributeMultiprocessorCount, dev) != hipSuccess) { grid = -1; return; }
        if (hipFuncSetAttribute((const void*)mega_fwd, hipFuncAttributeMaxDynamicSharedMemorySize, LDS_BYTES) != hipSuccess) { fprintf(stderr, "kernel_launch: hipFuncSetAttribute failed\n"); grid = -1; return; }
        if (hipOccupancyMaxActiveBlocksPerMultiprocessor(&per_cu, (const void*)mega_fwd, NWAVES * 64, LDS_BYTES) != hipSuccess || per_cu < 1) { fprintf(stderr, "kernel_launch: occupancy query failed (%d)\n", per_cu); (void)hipGetLastError(); per_cu = 1; }
        grid = cus * (per_cu < 1 ? 1 : 1);
        fprintf(stderr, "kernel_launch: %d CUs, occupancy %d/CU, grid %d\n", cus, per_cu, grid);
    }
    if (grid < 0) return;
    (void)in_sizes;
    if (hipMemsetAsync((char*)d_ws + WS_CTL, 0, CTL_ZERO_BYTES, stream) != hipSuccess) { fprintf(stderr, "kernel_launch: memset failed\n"); return; }
    Args a{};
    for (int i = 0; i < 32; ++i) a.in[i] = (const float*)d_in[i];
    a.out = (float*)d_out; a.ws = (unsigned char*)d_ws;
#if MK_N_LAUNCHES == 1
    a.ph_lo = 0; a.ph_hi = NPH;
    void* args[] = {&a};
    hipError_t e = hipLaunchCooperativeKernel((const void*)mega_fwd, dim3(grid), dim3(NWAVES * 64), args, LDS_BYTES, stream);
    if (e != hipSuccess) fprintf(stderr, "kernel_launch: cooperative launch failed: %s (grid %d)\n", hipGetErrorString(e), grid);
#else
    for (int ph = 0; ph < NPH; ++ph) {
        a.ph_lo = ph; a.ph_hi = ph + 1;
        hipLaunchKernelGGL(mega_fwd, dim3(grid), dim3(NWAVES * 64), LDS_BYTES, stream, a);
    }
#endif
}
```

```cpp
#include <hip/hip_runtime.h>
#include <hip/hip_cooperative_groups.h>
#include <cstdio>
#include <cstdint>
namespace cg = cooperative_groups;
namespace pg8 {
#define PG8_LAS __attribute__((address_space(3)))
typedef unsigned short bf16_t;
typedef short bf16x8 __attribute__((ext_vector_type(8)));
typedef float f32x4 __attribute__((ext_vector_type(4)));
typedef unsigned u32x4 __attribute__((ext_vector_type(4)));
constexpr int BM = 256, BK = 64, HALF = 128, HTB = HALF * BK * 2  , STAGE_BYTES = 8 * HTB, NXCD = 8, WGM = 8;

__host__ __device__ __forceinline__ int lds_byte(int r, int c) { const int st = (r >> 4) * 2 + (c >> 5), rr = r & 15, cc = c & 31, ob = rr * 64 + cc * 2; return st * 1024 + (ob ^ (((ob >> 9) & 1) << 5)); }
__host__ __device__ __forceinline__ void stage_rc(int b, int& R, int& C) { const int st = b / 1024, sb = b % 1024, swz = sb ^ (((sb >> 9) & 1) << 5); R = (st >> 1) * 16 + swz / 64; C = (st & 1) * 32 + (swz % 64) / 2; }
__host__ __device__ __forceinline__ int perm32(int rho) { const int n = rho >> 4, i = rho & 15; return 8 * (i >> 2) + 4 * n + (i & 3); }

struct Unit { int pm, pn; };
struct Gemm { const bf16_t* A; const bf16_t* Bt; int M, N, K; };

struct StaticOrder {
    int nM, nN, nwg, G, c;
    __host__ __device__ void init(int M, int N, int G_, int c_) { nM = M / BM; nN = N / BM; nwg = nM * nN; G = G_; c = c_; }
    __host__ __device__ bool next(int i, Unit& u) const {
        const long L = (long)i * G + c; if (L >= nwg) return false;
        int wgid = (int)L; { const int q = nwg / NXCD, r = nwg % NXCD, xcd = wgid % NXCD, off = wgid / NXCD; wgid = (xcd < r ? xcd * (q + 1) : r * (q + 1) + (xcd - r) * q) + off; }
        const int nig = WGM * nN, gid = wgid / nig, fm = gid * WGM, gsz = (nM - fm) < WGM ? (nM - fm) : WGM;
        u.pm = fm + ((wgid % nig) % gsz); u.pn = (wgid % nig) / gsz; return true;
    }
    __device__ __forceinline__ void a_ready(const Unit&) const {}
    __device__ __forceinline__ void done(const Unit&) const {}
};


__device__ __forceinline__ unsigned cvt_pk_bf16(float lo, float hi) { unsigned r; asm volatile("v_cvt_pk_bf16_f32 %0, %1, %2" : "=v"(r) : "v"(lo), "v"(hi)); return r; }

struct EpiF32 {
    static constexpr bool PERM = false, AFTER_DRAIN = false;
    float* C; int ldc;
    __device__ __forceinline__ void operator()(const f32x4 (&acc)[2][2][4][2], const Unit& u, int wr, int wc, int fr, int fq) const {
        const int row0 = u.pm * BM + wr * 64 + fr, col0 = u.pn * BM + wc * 32 + 4 * fq;
#pragma unroll
        for (int ai = 0; ai < 2; ++ai)
#pragma unroll
            for (int m = 0; m < 4; ++m) { float* rowp = C + (size_t)(row0 + ai * HALF + m * 16) * ldc + col0;
#pragma unroll
                for (int bj = 0; bj < 2; ++bj)
#pragma unroll
                    for (int n = 0; n < 2; ++n) *(f32x4*)(rowp + bj * HALF + n * 16) = acc[ai][bj][m][n]; }
    }
    __device__ __forceinline__ void fused(f32x4 (&)[2][2][4][2], const Unit&, int, int, int, int, PG8_LAS unsigned char*, int, int) const {}
};

template <int ACT> struct EpiBf16 {
    static constexpr bool PERM = true, AFTER_DRAIN = false;
    bf16_t* O0; int ld0; int nt0; bf16_t* O1; int ld1;
    __device__ __forceinline__ void operator()(const f32x4 (&acc)[2][2][4][2], const Unit& u, int wr, int wc, int fr, int fq) const {
        const int row0 = u.pm * BM + wr * 64 + fr;
        bf16_t* base; int ldc, colt;
        if (u.pn < nt0) { base = O0; ldc = ld0; colt = u.pn * BM; } else { base = O1; ldc = ld1; colt = (u.pn - nt0) * BM; }
        const int col0 = colt + wc * 32 + 8 * fq;
#pragma unroll
        for (int ai = 0; ai < 2; ++ai)
#pragma unroll
            for (int m = 0; m < 4; ++m) { bf16_t* rowp = base + (size_t)(row0 + ai * HALF + m * 16) * ldc + col0;
#pragma unroll
                for (int bj = 0; bj < 2; ++bj) { f32x4 v0 = acc[ai][bj][m][0], v1 = acc[ai][bj][m][1];
                    if (ACT == 2) {
#pragma unroll
                        for (int e = 0; e < 4; ++e) { float a = v0[e] > 0.f ? v0[e] : 0.f; v0[e] = a * a; float b = v1[e] > 0.f ? v1[e] : 0.f; v1[e] = b * b; } }
                    u32x4 w; w.x = cvt_pk_bf16(v0[0], v0[1]); w.y = cvt_pk_bf16(v0[2], v0[3]); w.z = cvt_pk_bf16(v1[0], v1[1]); w.w = cvt_pk_bf16(v1[2], v1[3]);
                    *(u32x4*)(rowp + bj * HALF) = w; } }
    }
    __device__ __forceinline__ void fused(f32x4 (&)[2][2][4][2], const Unit&, int, int, int, int, PG8_LAS unsigned char*, int, int) const {}
};


__device__ __forceinline__ float sig_f(float x) { return 1.0f / (1.0f + __expf(-x)); }
struct RkvOrder {
    int c;
    __device__ __forceinline__ bool next(int i, Unit& u) const {
        int L; if (c < 128) { if (i >= 2) return false; L = c * 2 + i; } else { if (i >= 4) return false; L = 256 + (c - 128) * 4 + i; }
        const int which = L >> 8, r = L & 255; u.pm = which * 64 + (r >> 2); u.pn = which * 4 + (r & 3); return true; }
    __device__ __forceinline__ void a_ready(const Unit&) const {}
    __device__ __forceinline__ void done(const Unit&) const {}
};
struct EpiRkv3 {
    static constexpr bool PERM = true, AFTER_DRAIN = false;
    bf16_t* RKV;
    __device__ __forceinline__ void operator()(const f32x4 (&acc)[2][2][4][2], const Unit& u, int wr, int wc, int fr, int fq) const {
        const int row0 = (u.pm & 63) * BM + wr * 64 + fr, col0 = u.pn * BM + wc * 32 + 8 * fq;
#pragma unroll
        for (int ai = 0; ai < 2; ++ai)
#pragma unroll
            for (int m = 0; m < 4; ++m) { bf16_t* rowp = RKV + (size_t)(row0 + ai * HALF + m * 16) * 3072 + col0;
#pragma unroll
                for (int bj = 0; bj < 2; ++bj) { const f32x4 v0 = acc[ai][bj][m][0], v1 = acc[ai][bj][m][1];
                    u32x4 w; w.x = cvt_pk_bf16(v0[0], v0[1]); w.y = cvt_pk_bf16(v0[2], v0[3]); w.z = cvt_pk_bf16(v1[0], v1[1]); w.w = cvt_pk_bf16(v1[2], v1[3]);
                    *(u32x4*)(rowp + bj * HALF) = w; } }
    }
};
struct EpiL1 {
    static constexpr bool PERM = true, AFTER_DRAIN = false;
    bf16_t* L1;
    __device__ __forceinline__ void operator()(const f32x4 (&acc)[2][2][4][2], const Unit& u, int wr, int wc, int fr, int fq) const {
        const int row0 = u.pm * BM + wr * 64 + fr, colt = u.pn * BM, col0 = colt + wc * 32 + 8 * fq;
#pragma unroll
        for (int ai = 0; ai < 2; ++ai)
#pragma unroll
            for (int m = 0; m < 4; ++m) { bf16_t* rowp = L1 + (size_t)(row0 + ai * HALF + m * 16) * 384 + col0;
#pragma unroll
                for (int bj = 0; bj < 2; ++bj) { f32x4 v0 = acc[ai][bj][m][0], v1 = acc[ai][bj][m][1];
                    const int cb = colt + bj * HALF;
                    if (cb >= 384) continue;
                    if (cb == 0) {
#pragma unroll
                        for (int e = 0; e < 4; ++e) { v0[e] = 1.0f - 2.0f / (1.0f + __expf(2.0f * v0[e])); v1[e] = 1.0f - 2.0f / (1.0f + __expf(2.0f * v1[e])); } }
                    else if (cb == 256) {
#pragma unroll
                        for (int e = 0; e < 4; ++e) { v0[e] = sig_f(v0[e]); v1[e] = sig_f(v1[e]); } }
                    u32x4 w; w.x = cvt_pk_bf16(v0[0], v0[1]); w.y = cvt_pk_bf16(v0[2], v0[3]); w.z = cvt_pk_bf16(v1[0], v1[1]); w.w = cvt_pk_bf16(v1[2], v1[3]);
                    *(u32x4*)(rowp + bj * HALF) = w; } }
    }
};
struct EpiLora2 {
    static constexpr bool PERM = true, AFTER_DRAIN = false;
    bf16_t* o4; size_t ostride; bf16_t* og; const float* a0; const float* w0;
    __device__ __forceinline__ void operator()(const f32x4 (&acc)[2][2][4][2], const Unit& u, int wr, int wc, int fr, int fq) const {
        const int row0 = u.pm * BM + wr * 64 + fr; const int blk = u.pn >> 2, colt = (u.pn & 3) * BM;
        bf16_t* base = (blk < 4) ? o4 + (size_t)blk * ostride : og;
        const float* bs = ((blk < 2) ? a0 : w0) + (blk & 1) * 1024;
        const int col0 = colt + wc * 32 + 8 * fq;
        const float sc = (blk >= 2) ? 0.8750387749719753f : 1.0f;
#pragma unroll
        for (int bj = 0; bj < 2; ++bj) {
            f32x4 b0 = (f32x4){0.f, 0.f, 0.f, 0.f}, b1 = b0;
            if (blk < 4) { b0 = *(const f32x4*)(bs + col0 + bj * HALF); b1 = *(const f32x4*)(bs + col0 + bj * HALF + 4); }
#pragma unroll
            for (int ai = 0; ai < 2; ++ai)
#pragma unroll
                for (int m = 0; m < 4; ++m) { bf16_t* rowp = base + (size_t)(row0 + ai * HALF + m * 16) * 1024 + col0;
                    f32x4 v0 = acc[ai][bj][m][0] + b0, v1 = acc[ai][bj][m][1] + b1;
                    if (blk < 4) {
#pragma unroll
                        for (int e = 0; e < 4; ++e) { v0[e] = sc * sig_f(v0[e]); v1[e] = sc * sig_f(v1[e]); } }
                    u32x4 w; w.x = cvt_pk_bf16(v0[0], v0[1]); w.y = cvt_pk_bf16(v0[2], v0[3]); w.z = cvt_pk_bf16(v1[0], v1[1]); w.w = cvt_pk_bf16(v1[2], v1[3]);
                    *(u32x4*)(rowp + bj * HALF) = w; } }
    }
};


template <class MP> struct EpiQkv {
    static constexpr bool PERM = true, AFTER_DRAIN = false;
    unsigned char* ws; float* out; const float* gain; const float* RC; const float* RS; int j;
    static constexpr size_t oQA = MP::oQA, oQB = MP::oQB, oKAP = MP::oKAP, oVAP = MP::oVAP, oKBP = MP::oKBP, oVBP = MP::oVBP, oKAS = MP::oKAS, oVAS = MP::oVAS, oKBS = MP::oKBS, oVBS = MP::oVBS;
    static constexpr size_t oKG = MP::oKG, oVG = MP::oVG, oKD = MP::oKD, oVD = MP::oVD;
    __device__ __forceinline__ void operator()(const f32x4 (&acc)[2][2][4][2], const Unit& u, int wr, int wc, int fr, int fq) const {
        const int ch = 4 * u.pn + wc; const bool smp = u.pm >= 32;
        const bool isq = (ch < 8) || (ch >= 12 && ch < 20), isk = (ch == 8 || ch == 9) || (ch >= 20 && ch < 28);
        const int dl = 8 * fq;
        const bool hi2 = (fq & 2) != 0;
        f32x4 g[2][2];
#pragma unroll
        for (int bj = 0; bj < 2; ++bj)
#pragma unroll
            for (int n = 0; n < 2; ++n) g[bj][n] = (ch < 10) ? *(const f32x4*)(gain + (ch < 8 ? 0 : 64) + bj * 32 + dl + 4 * n) : (f32x4){1.f, 1.f, 1.f, 1.f};
        constexpr float QS = 0.18033688011112042f;
#pragma unroll
        for (int ai = 0; ai < 2; ++ai)
#pragma unroll
            for (int m = 0; m < 4; ++m) {
                const int mrow = u.pm * BM + ai * HALF + wr * 64 + m * 16 + fr;
                const int b = smp ? ((mrow - 8192) >> 11) : (mrow >> 8), t = smp ? ((mrow - 8192) & 2047) : (mrow & 255);
                f32x4 v[2][2];
#pragma unroll
                for (int bj = 0; bj < 2; ++bj)
#pragma unroll
                    for (int n = 0; n < 2; ++n) v[bj][n] = acc[ai][bj][m][n];
                if (ch < 10) { float ss = 0.f;
#pragma unroll
                    for (int bj = 0; bj < 2; ++bj)
#pragma unroll
                        for (int n = 0; n < 2; ++n) ss += (v[bj][n][0] * v[bj][n][0] + v[bj][n][1] * v[bj][n][1]) + (v[bj][n][2] * v[bj][n][2] + v[bj][n][3] * v[bj][n][3]);
                    ss += __shfl_xor(ss, 16); ss += __shfl_xor(ss, 32);
                    const float ri = 1.0f / sqrtf(ss * (1.0f / 64.0f) + 1e-6f);
#pragma unroll
                    for (int bj = 0; bj < 2; ++bj)
#pragma unroll
                        for (int n = 0; n < 2; ++n) v[bj][n] = v[bj][n] * ri * g[bj][n]; }
                f32x4 vr[2][2];
#pragma unroll
                for (int bj = 0; bj < 2; ++bj)
#pragma unroll
                    for (int n = 0; n < 2; ++n) { vr[bj][n] = v[bj][n];
                        if (smp && (isq || isk)) { f32x4 p; p[0] = __shfl_xor(v[bj][n][0], 32); p[1] = __shfl_xor(v[bj][n][1], 32); p[2] = __shfl_xor(v[bj][n][2], 32); p[3] = __shfl_xor(v[bj][n][3], 32);
                            const f32x4 cs = *(const f32x4*)(RC + t * 64 + bj * 32 + dl + 4 * n), sn = *(const f32x4*)(RS + t * 64 + bj * 32 + dl + 4 * n);
                            const f32x4 rot = hi2 ? p : -p; vr[bj][n] = v[bj][n] * cs + rot * sn; } }
#define EQ_PK8(x0, x1) ((u32x4){cvt_pk_bf16((x0)[0], (x0)[1]), cvt_pk_bf16((x0)[2], (x0)[3]), cvt_pk_bf16((x1)[0], (x1)[1]), cvt_pk_bf16((x1)[2], (x1)[3])})
                const size_t srow = (size_t)(b * 2560 + 512 + t), prow = (size_t)((b * 2 + j) * 256 + t);
#pragma unroll
                for (int bj = 0; bj < 2; ++bj) {
                    const int f0 = bj * 32 + dl;
                    if (isq) { const f32x4 s0 = vr[bj][0] * QS, s1 = vr[bj][1] * QS; const size_t o = (ch < 8) ? oQA + ((size_t)mrow * 512 + ch * 64 + f0) * 2 : oQB + ((size_t)mrow * 512 + (ch - 12) * 64 + f0) * 2;
                        *(u32x4*)(ws + o) = EQ_PK8(s0, s1); }
                    else {
                        const bool gq = ch < 12, kk = isk;
                        const int e = gq ? ((ch & 1) * 64 + f0) : ((ch - (kk ? 20 : 28)) * 64 + f0); const int wdt = gq ? 128 : 512;
                        if (!smp) { const size_t of = (gq ? (kk ? oKG : oVG) : (kk ? oKD : oVD)) + prow * wdt + e; *(f32x4*)(out + of) = v[bj][0]; *(f32x4*)(out + of + 4) = v[bj][1];
                            const size_t o = (gq ? (kk ? oKAP : oVAP) : (kk ? oKBP : oVBP)) + ((size_t)mrow * wdt + e) * 2; *(u32x4*)(ws + o) = EQ_PK8(v[bj][0], v[bj][1]); }
                        else { const size_t o = (gq ? (kk ? oKAS : oVAS) : (kk ? oKBS : oVBS)) + (srow * wdt + e) * 2; *(u32x4*)(ws + o) = EQ_PK8(vr[bj][0], vr[bj][1]); } }
                }
#undef EQ_PK8
            }
    }
};

template <class Epi, class Sched, bool ALIGN_EPI = false, bool SP2 = false>
__device__ __forceinline__ void gemm_phase(PG8_LAS unsigned char* lds, const Gemm g, const Sched& S, const Epi& E, const int wave_index) {
    int lane_o; asm volatile("v_mbcnt_lo_u32_b32 %0, -1, 0\n\tv_mbcnt_hi_u32_b32 %0, -1, %0" : "=v"(lane_o));
    const int wid = wave_index, lane = lane_o, tid = wid * 64 + lane, wr = wid >> 2, wc = wid & 3, fr = lane & 15, fq = lane >> 4;
    const int K = g.K, nt = K / BK;
    unsigned voffA[2], voffB[2];
#pragma unroll
    for (int i = 0; i < 2; ++i) { int R, C; stage_rc(tid * 16 + i * 8192, R, C); const int Rb = Epi::PERM ? ((R & ~31) + perm32(R & 31)) : R;
        voffA[i] = (unsigned)(R * K + C) * 2u; voffB[i] = (unsigned)(Rb * K + C) * 2u; }
    const size_t kstep = (size_t)(BK * 2);
    const size_t hstep = (size_t)HALF * K * 2;
    const size_t tstep = 2 * hstep;
    const unsigned ldsw = (unsigned)wid * 1024u;
    const int aoff = lds_byte(wr * 64 + fr, fq * 8), boff = lds_byte(wc * 32 + fr, fq * 8);
#define PG8_SA(b, h) (((b) * 2 + (h)) * HTB)
#define PG8_SB(b, h) ((4 + (b) * 2 + (h)) * HTB)
#define PG8_STAGE(bufoff, gbase, voff) do { _Pragma("unroll") for (int _i = 0; _i < 2; ++_i) \
        __builtin_amdgcn_global_load_lds((const unsigned*)((const char*)(gbase) + (voff)[_i]), (PG8_LAS unsigned*)(lds + (bufoff) + ldsw + _i * 8192), 16, 0, 0); } while (0)
#define PG8_LDA(dst, b, h) do { _Pragma("unroll") for (int m = 0; m < 4; ++m) _Pragma("unroll") for (int k = 0; k < 2; ++k) dst[m][k] = *(const PG8_LAS bf16x8*)(lds + PG8_SA(b, h) + aoff + m * 2048 + k * 1024); } while (0)
#define PG8_LDB(dst, b, h) do { _Pragma("unroll") for (int n = 0; n < 2; ++n) _Pragma("unroll") for (int k = 0; k < 2; ++k) dst[n][k] = *(const PG8_LAS bf16x8*)(lds + PG8_SB(b, h) + boff + n * 2048 + k * 1024); } while (0)
#define PG8_MMA(ai, bj, At, Bt) do { __builtin_amdgcn_s_setprio(1); _Pragma("unroll") for (int m = 0; m < 4; ++m) _Pragma("unroll") for (int n = 0; n < 2; ++n) _Pragma("unroll") for (int k = 0; k < 2; ++k) \
        acc[ai][bj][m][n] = __builtin_amdgcn_mfma_f32_16x16x32_bf16(Bt[n][k], At[m][k], acc[ai][bj][m][n], 0, 0, 0); __builtin_amdgcn_s_setprio(0); } while (0)
#define PG8_WAIT_V(n) asm volatile("s_waitcnt vmcnt(" #n ")" ::: "memory")
#define PG8_WAIT_L(n) asm volatile("s_waitcnt lgkmcnt(" #n ")" ::: "memory")
#define PG8_BAR __builtin_amdgcn_s_barrier()
#define PG8_SCHED __builtin_amdgcn_sched_barrier(0)
    Unit cur, nxt; int ui = 0;
    if (!S.next(0, cur)) return;
    f32x4 acc[2][2][4][2];
#pragma unroll
    for (int a = 0; a < 2; ++a)
#pragma unroll
        for (int b = 0; b < 2; ++b)
#pragma unroll
            for (int m = 0; m < 4; ++m)
#pragma unroll
                for (int n = 0; n < 2; ++n) acc[a][b][m][n] = (f32x4){0.f, 0.f, 0.f, 0.f};
    bf16x8 At[4][2], B0[2][2], B1[2][2];
    const char* cA = (const char*)g.A + (size_t)cur.pm * tstep; const char* cB = (const char*)g.Bt + (size_t)cur.pn * tstep;
    S.a_ready(cur);
    if constexpr (SP2) {
        PG8_STAGE(PG8_SB(0, 0), cB, voffB); PG8_STAGE(PG8_SB(0, 1), cB + hstep, voffB); PG8_STAGE(PG8_SA(0, 0), cA, voffA); PG8_STAGE(PG8_SA(0, 1), cA + hstep, voffA);
        if (wr == 1) PG8_BAR;
        PG8_WAIT_V(2); PG8_BAR;
        PG8_STAGE(PG8_SB(1, 0), cB + kstep, voffB); PG8_STAGE(PG8_SA(1, 0), cA + kstep, voffA); PG8_STAGE(PG8_SB(1, 1), cB + hstep + kstep, voffB);
        PG8_WAIT_V(6); PG8_BAR;
    } else {
        PG8_STAGE(PG8_SB(0, 0), cB, voffB); PG8_STAGE(PG8_SA(0, 0), cA, voffA); PG8_STAGE(PG8_SB(0, 1), cB + hstep, voffB); PG8_STAGE(PG8_SA(0, 1), cA + hstep, voffA);
        if (wr == 1) PG8_BAR;
        PG8_WAIT_V(4); PG8_BAR;
        PG8_STAGE(PG8_SB(1, 0), cB + kstep, voffB); PG8_STAGE(PG8_SA(1, 0), cA + kstep, voffA); PG8_STAGE(PG8_SB(1, 1), cB + hstep + kstep, voffB);
        PG8_WAIT_V(6); PG8_BAR;
    }
    for (;;) {
        const bool has_next = S.next(ui + 1, nxt);
        const char* nA = has_next ? (const char*)g.A + (size_t)nxt.pm * tstep : cA; const char* nB = has_next ? (const char*)g.Bt + (size_t)nxt.pn * tstep : cB;
#pragma unroll 1
        for (int t = 0; t < nt; t += 2) {
            const bool last = (t == nt - 2);
            const char* a1 = cA + (size_t)(t + 1) * kstep;
            const char* a2 = last ? nA : cA + (size_t)(t + 2) * kstep; const char* b2 = last ? nB : cB + (size_t)(t + 2) * kstep;
            const char* a3 = a2 + kstep; const char* b3 = b2 + kstep;
            if (last && has_next) S.a_ready(nxt);
            if constexpr (SP2) {
            PG8_LDB(B0, 0, 0); PG8_LDB(B1, 0, 1); PG8_SCHED; PG8_LDA(At, 0, 0); PG8_STAGE(PG8_SA(1, 1), a1 + hstep, voffA);
            PG8_WAIT_V(8); PG8_WAIT_L(0); PG8_BAR; PG8_MMA(0, 0, At, B0); PG8_MMA(0, 1, At, B1); PG8_BAR; PG8_SCHED;
            PG8_LDA(At, 0, 1); PG8_STAGE(PG8_SB(0, 0), b2, voffB); PG8_STAGE(PG8_SB(0, 1), b2 + hstep, voffB); PG8_STAGE(PG8_SA(0, 0), a2, voffA);
            PG8_WAIT_V(8); PG8_WAIT_L(0); PG8_BAR; PG8_MMA(1, 0, At, B0); PG8_MMA(1, 1, At, B1); PG8_BAR; PG8_SCHED;
            PG8_LDB(B0, 1, 0); PG8_LDB(B1, 1, 1); PG8_SCHED; PG8_LDA(At, 1, 0); PG8_STAGE(PG8_SA(0, 1), a2 + hstep, voffA);
            PG8_WAIT_V(8); PG8_WAIT_L(0); PG8_BAR; PG8_MMA(0, 0, At, B0); PG8_MMA(0, 1, At, B1); PG8_BAR; PG8_SCHED;
            PG8_LDA(At, 1, 1); PG8_STAGE(PG8_SB(1, 0), b3, voffB); PG8_STAGE(PG8_SB(1, 1), b3 + hstep, voffB); PG8_STAGE(PG8_SA(1, 0), a3, voffA);
            PG8_WAIT_V(8); PG8_WAIT_L(0); PG8_BAR; PG8_MMA(1, 0, At, B0); PG8_MMA(1, 1, At, B1); PG8_BAR; PG8_SCHED;
            } else {
            PG8_LDB(B0, 0, 0); PG8_SCHED; PG8_LDA(At, 0, 0); PG8_STAGE(PG8_SA(1, 1), a1 + hstep, voffA);
            PG8_WAIT_L(8); PG8_BAR; PG8_WAIT_L(0); PG8_MMA(0, 0, At, B0); PG8_BAR; PG8_SCHED;
            PG8_LDB(B1, 0, 1); PG8_STAGE(PG8_SB(0, 0), b2, voffB);
            PG8_BAR; PG8_WAIT_L(0); PG8_MMA(0, 1, At, B1); PG8_BAR;
            PG8_LDA(At, 0, 1); PG8_STAGE(PG8_SA(0, 0), a2, voffA);
            PG8_BAR; PG8_WAIT_L(0); PG8_MMA(1, 0, At, B0); PG8_BAR; PG8_SCHED;
            PG8_STAGE(PG8_SB(0, 1), b2 + hstep, voffB);
            PG8_WAIT_V(6); PG8_BAR; PG8_MMA(1, 1, At, B1); PG8_BAR;
            PG8_LDB(B0, 1, 0); PG8_SCHED; PG8_LDA(At, 1, 0); PG8_STAGE(PG8_SA(0, 1), a2 + hstep, voffA);
            PG8_WAIT_L(8); PG8_BAR; PG8_WAIT_L(0); PG8_MMA(0, 0, At, B0); PG8_BAR; PG8_SCHED;
            PG8_LDB(B1, 1, 1); PG8_STAGE(PG8_SB(1, 0), b3, voffB);
            PG8_BAR; PG8_WAIT_L(0); PG8_MMA(0, 1, At, B1); PG8_BAR;
            PG8_LDA(At, 1, 1); PG8_STAGE(PG8_SA(1, 0), a3, voffA);
            PG8_BAR; PG8_WAIT_L(0); PG8_MMA(1, 0, At, B0); PG8_BAR; PG8_SCHED;
            PG8_STAGE(PG8_SB(1, 1), b3 + hstep, voffB);
            PG8_WAIT_V(6); PG8_BAR; PG8_MMA(1, 1, At, B1); PG8_BAR;
            }
        }
        if constexpr (ALIGN_EPI) { if (wr == 0) PG8_BAR; }
        if constexpr (!Epi::AFTER_DRAIN) { E(acc, cur, wr, wc, fr, fq); S.done(cur); }
        if (!has_next) break;
#pragma unroll
        for (int a = 0; a < 2; ++a)
#pragma unroll
            for (int b = 0; b < 2; ++b)
#pragma unroll
                for (int m = 0; m < 4; ++m)
#pragma unroll
                    for (int n = 0; n < 2; ++n) acc[a][b][m][n] = (f32x4){0.f, 0.f, 0.f, 0.f};
        cur = nxt; cA = nA; cB = nB; ++ui;
        if constexpr (ALIGN_EPI) { if (wr == 1) PG8_BAR; }
    }
    PG8_WAIT_V(0);
    if constexpr (!ALIGN_EPI) { if (wr == 0) PG8_BAR; }
    PG8_BAR;
    if constexpr (Epi::AFTER_DRAIN) { E.fused(acc, cur, wr, wc, fr, fq, lds, wid, lane); S.done(cur); }
#undef PG8_SA
#undef PG8_SB
#undef PG8_STAGE
#undef PG8_LDA
#undef PG8_LDB
#undef PG8_MMA
#undef PG8_WAIT_V
#undef PG8_WAIT_L
#undef PG8_BAR
#undef PG8_SCHED
}
}

#define GAS __attribute__((address_space(1)))
#define LAS __attribute__((address_space(3)))
typedef unsigned short bf16;
typedef unsigned v4u __attribute__((ext_vector_type(4)));
typedef unsigned v2u __attribute__((ext_vector_type(2)));
typedef float f32x4 __attribute__((ext_vector_type(4)));
#define LDS_WAIT() asm volatile("s_waitcnt lgkmcnt(0)" ::: "memory")

#ifndef MK_N_LAUNCHES
#define MK_N_LAUNCHES 1
#endif
#ifndef MK_CG_BARRIER
#define MK_CG_BARRIER 0
#endif

constexpr int D = 1024, NTOK = 16384, NPR = 8192, TP = 256, TS = 2048, PAST = 512, SKV = 2560, FF = 4096, DEPTH = 4;
constexpr int NQKV = 2304, NRKV = 3584, KRKV = 2048;
constexpr int NWAVES = 8;
constexpr size_t O_X = 0, O_KG = 16777216, O_VG = 18874368, O_KD = 20971520, O_VD = 29360128, O_ST = 37748736, OUT_TOTAL = 46137344;
constexpr size_t MiB = 1u << 20;
constexpr size_t WS_CTL = 0, CTL_ZERO_BYTES = 1 * MiB;
constexpr size_t WS_MOD = 65536;
constexpr size_t WS_ROPE = 1 * MiB;
constexpr size_t WS_INV = 2 * MiB;
constexpr size_t WS_W = 4 * MiB;
constexpr size_t W_W1T = WS_W, W_W2T = WS_W + 8 * MiB, W_MIX = WS_W + 16 * MiB;
constexpr size_t W_WINT = W_MIX, W_WOUTT = W_MIX + 6 * MiB;
constexpr size_t W_BTR = W_MIX, W_BTL = W_MIX + 6 * MiB, W_WOT = W_MIX + 14 * MiB, W_BT2 = W_MIX + 16 * MiB;
constexpr size_t AR = 40 * MiB;
constexpr size_t A_H = AR;
constexpr size_t A_QKVRAW = AR + 32 * MiB;
constexpr size_t A_DT = AR + 32 * MiB;
constexpr size_t A_M = AR + 96 * MiB;
constexpr size_t A_QA = AR + 176 * MiB, A_QB = AR + 192 * MiB, A_KAP = AR + 208 * MiB, A_VAP = AR + 210 * MiB, A_KBP = AR + 212 * MiB, A_VBP = AR + 220 * MiB;
constexpr size_t A_KAS = AR + 228 * MiB, A_VAS = AR + 231 * MiB, A_KBS = AR + 234 * MiB, A_VBS = AR + 244 * MiB;
constexpr size_t A_HID = AR + 32 * MiB;
constexpr size_t A_F = AR + 160 * MiB;
constexpr size_t A_A2 = AR + 32 * MiB;
constexpr size_t A_XS = AR + 208 * MiB;
constexpr size_t A_Y = AR + 32 * MiB;
constexpr size_t A_RKV = AR + 96 * MiB;
constexpr size_t A_L1 = AR + 192 * MiB;
constexpr size_t A_G = A_H;
constexpr size_t A_A0 = AR + 208 * MiB, A_A1 = AR + 240 * MiB, A_EW0 = AR + 272 * MiB, A_EW1 = AR + 304 * MiB;
constexpr size_t WS_END = AR + 336 * MiB;
struct QkvMap { static constexpr size_t oQA = A_QA, oQB = A_QB, oKAP = A_KAP, oVAP = A_VAP, oKBP = A_KBP, oVBP = A_VBP, oKAS = A_KAS, oVAS = A_VAS, oKBS = A_KBS, oVBS = A_VBS, oKG = O_KG, oVG = O_VG, oKD = O_KD, oVD = O_VD; };
constexpr int CW_BAR = 4096;

constexpr int RING_OFF = 0, RING_BYTES = 131072;
constexpr int LDSCTL_OFF = RING_BYTES, MISC_OFF = LDSCTL_OFF + 320;
constexpr int LDS_BYTES = 147456;

typedef float f32x2_t __attribute__((ext_vector_type(2))); typedef __bf16 bf16x2_t __attribute__((ext_vector_type(2)));
__device__ __forceinline__ unsigned pk2(float lo, float hi) { const f32x2_t v = {lo, hi}; return __builtin_bit_cast(unsigned, __builtin_convertvector(v, bf16x2_t)); }
__device__ __forceinline__ unsigned f2bf(float f) { return pk2(f, 0.f) & 0xffffu; }
__device__ __forceinline__ float bf2f(unsigned short h) { return __builtin_bit_cast(float, (unsigned)h << 16); }
__device__ __forceinline__ float bflo(unsigned w) { return __builtin_bit_cast(float, w << 16); }
__device__ __forceinline__ float bfhi(unsigned w) { return __builtin_bit_cast(float, w & 0xffff0000u); }
__device__ __forceinline__ float wave_sum(float v) {
#pragma unroll
    for (int o = 1; o < 64; o <<= 1) v += __shfl_xor(v, o);
    return v;
}
__device__ __forceinline__ float sigmoidf_(float x) { return 1.0f / (1.0f + __expf(-x)); }
__device__ __forceinline__ float rdl(float x, int l) { return __builtin_bit_cast(float, __builtin_amdgcn_readlane(__builtin_bit_cast(int, x), l)); }

#define XB_TMO      128
#define XB_XCNT(j)  (256  + 64 * (j))
#define XB_XSUB(j)  (1280 + 64 * (j))
#define XB_XGEN(j)  (2304 + 64 * (j))
#define XB_TOP      3328
#define XB_TOPGEN   3392
#define XCD_BAR_WORDS 3456
#define XB_SPIN_CAP (1u << 18)

__device__ __forceinline__ unsigned xb_ld(unsigned* p)              { return __hip_atomic_load(p, __ATOMIC_RELAXED, __HIP_MEMORY_SCOPE_AGENT); }
__device__ __forceinline__ unsigned xb_add(unsigned* p, unsigned v) { return __hip_atomic_fetch_add(p, v, __ATOMIC_RELAXED, __HIP_MEMORY_SCOPE_AGENT); }
__device__ __forceinline__ unsigned xb_xcc_id() { return (unsigned)__builtin_amdgcn_s_getreg((3 << 11) | 20) & 0xFu; }
#define XB_SPIN(cond, bar) do { unsigned _sp = 0; while (cond) { __builtin_amdgcn_s_sleep(1); \
    if ((++_sp & 255u) == 0u) { if (xb_ld(&(bar)[XB_TMO])) break; if (_sp > XB_SPIN_CAP) { atomicAdd(&(bar)[XB_TMO], 1u); break; } } } } while (0)

struct XcdBarrier {
    unsigned* bar; unsigned x;
    volatile LAS unsigned* st;
};

__device__ __forceinline__ XcdBarrier xcd_barrier_post(unsigned* bar, volatile LAS unsigned* st, bool leader) {
    XcdBarrier b; b.bar = bar; b.x = xb_xcc_id(); b.st = st;
    if (leader) (void)xb_add(&bar[XB_XCNT(b.x)], 1u);
    return b;
}
__device__ __forceinline__ void xcd_barrier_complete(unsigned* bar, unsigned x, unsigned& nloc, unsigned& nx) {
    const unsigned G = gridDim.x * gridDim.y * gridDim.z;
    unsigned sum, cnt, mine, sp = 0u;
    for (;;) {
        sum = 0u; cnt = 0u; mine = 0u;
#pragma unroll
        for (unsigned j = 0; j < 16; ++j) { const unsigned c = xb_ld(&bar[XB_XCNT(j)]); sum += c; cnt += (c > 0u) ? 1u : 0u; mine = (j == x) ? c : mine; }
        if (sum == G) break;
        __builtin_amdgcn_s_sleep(1);
        if ((++sp & 255u) == 0u) { if (xb_ld(&bar[XB_TMO])) break; if (sp > XB_SPIN_CAP) { atomicAdd(&bar[XB_TMO], 1u); break; } }
    }
    nloc = mine > 0u ? mine : 1u; nx = cnt > 0u ? cnt : 1u;
}

__device__ __forceinline__ void xcd_barrier(const XcdBarrier& b, bool leader) {
    asm volatile("s_waitcnt vmcnt(0)" ::: "memory");
    __syncthreads();
    if (leader) {
        unsigned* bar = b.bar;
        __builtin_amdgcn_s_waitcnt(0);
        unsigned nloc = b.st[0], nx = b.st[1];
        if (nloc == 0u) { xcd_barrier_complete(bar, b.x, nloc, nx); b.st[0] = nloc; b.st[1] = nx; }
        const unsigned old = xb_add(&bar[XB_XSUB(b.x)], 1u);
        const unsigned gen = old / nloc;
        if (old + 1u == (gen + 1u) * nloc) {
            __builtin_amdgcn_fence(__ATOMIC_RELEASE, "agent");
            asm volatile("s_waitcnt vmcnt(0)" ::: "memory");
            const unsigned og = xb_add(&bar[XB_TOP], 1u);
            const unsigned tg = og / nx;
            if (og + 1u == (tg + 1u) * nx) xb_add(&bar[XB_TOPGEN], 1u);
            else XB_SPIN(xb_ld(&bar[XB_TOPGEN]) == tg, bar);
            __builtin_amdgcn_fence(__ATOMIC_ACQUIRE, "agent");
            xb_add(&bar[XB_XGEN(b.x)], 1u);
            asm volatile("s_waitcnt vmcnt(0)" ::: "memory");
        } else {
            XB_SPIN(xb_ld(&bar[XB_XGEN(b.x)]) == gen, bar);
            __builtin_amdgcn_fence(__ATOMIC_ACQUIRE, "agent");
            asm volatile("s_waitcnt vmcnt(0)" ::: "memory");
        }
    }
    __syncthreads();
}

struct Args { const float* in[32]; float* out; unsigned char* ws; int ph_lo, ph_hi; };
struct Ids { int tid, lane, wave, gw, ngw, z; };

__device__ __forceinline__ int cond_of(int m) { return m < NPR ? 4 : ((m - NPR) >> 11); }
__device__ __forceinline__ const float* mod_ptr_(const Args& a, const Ids& id, int cond, int layer) { return (const float*)(a.ws + id.z + WS_MOD) + (size_t)(cond * 4 + layer) * 6144; }

__device__ __forceinline__ void tr_item(const float* W, int ldw, int col0, const float* scale, bf16* WT, int ldt, int drow0, int dcol0, LAS float* scr, int kb, int nb, int lane, int dnb = -1) {
    const int k0 = 64 * kb, n0 = 32 * nb, dn0 = 32 * (dnb < 0 ? nb : dnb);
#pragma unroll 8
    for (int i = 0; i < 32; ++i) { const int kk = 2 * i + (lane >> 5); float v = W[(size_t)(k0 + kk) * ldw + col0 + n0 + (lane & 31)]; if (scale) v *= scale[k0 + kk]; scr[kk * 33 + (lane & 31)] = v; }
    LDS_WAIT(); asm volatile("" ::: "memory");
    const int c = lane & 7;
#pragma unroll
    for (int j = 0; j < 4; ++j) { const int n = (lane >> 3) + 8 * j; const LAS float* s = scr + (8 * c) * 33 + n;
        v4u o; o.x = pk2(s[0 * 33], s[1 * 33]); o.y = pk2(s[2 * 33], s[3 * 33]); o.z = pk2(s[4 * 33], s[5 * 33]); o.w = pk2(s[6 * 33], s[7 * 33]);
        *(v4u*)(WT + (size_t)(drow0 + dn0 + n) * ldt + dcol0 + k0 + 8 * c) = o; }
    LDS_WAIT(); asm volatile("" ::: "memory");
}
__device__ __forceinline__ bool tr_matrix(int& r, const float* W, int K, int N, bf16* WT, LAS float* scr, int lane) {
    const int nblk = N / 32, items = (K / 64) * nblk;
    if (r < items) { tr_item(W, N, 0, nullptr, WT, K, 0, 0, scr, r / nblk, r % nblk, lane); return true; }
    r -= items; return false;
}
__device__ __forceinline__ bool tr_rwproj(int& r, const float* W, int ncols, const float* mu, bf16* BT1, int drow0, LAS float* scr, int lane) {
    const int nblk = ncols / 32, items = 16 * nblk * 2;
    if (r < items) { const int half = r / (16 * nblk), q = r % (16 * nblk); tr_item(W, ncols, 0, half ? mu : nullptr, BT1, KRKV, drow0, half * 1024, scr, q / nblk, q % nblk, lane); return true; }
    r -= items; return false;
}
__device__ __forceinline__ void conv_weights(const Args& a, const Ids& id, LAS unsigned char* lds, int layer) {
    LAS float* scr = (LAS float*)(lds + id.wave * 16384);
    const int j = layer >> 1;
    bf16* W1T = (bf16*)(a.ws + id.z + W_W1T); bf16* W2T = (bf16*)(a.ws + id.z + W_W2T);
    const float* mw1 = a.in[30 + id.z] + (size_t)layer * D * FF; const float* mw2 = a.in[31 + id.z] + (size_t)layer * D * FF;
    if ((layer & 1) == 0) {
        bf16* WINT = (bf16*)(a.ws + id.z + W_WINT); bf16* WOUTT = (bf16*)(a.ws + id.z + W_WOUTT);
        const float* win = a.in[12 + id.z] + (size_t)j * D * NQKV; const float* wout = a.in[13 + id.z] + (size_t)j * D * D;
        const int total = 2048 + 2048 + 1152 + 512;
        for (int it = id.gw; it < total; it += id.ngw) {
            int r = it;
            if (tr_matrix(r, mw1, D, FF, W1T, scr, id.lane)) continue;
            if (tr_matrix(r, mw2, FF, D, W2T, scr, id.lane)) continue;
            if (r < 1152) {
                const int kb = r / 72, nb = r % 72; tr_item(win, NQKV, 0, nullptr, WINT, D, 0, 0, scr, kb, nb, id.lane, (nb & ~7) + 4 * (nb & 1) + ((nb >> 1) & 3)); continue; }
            r -= 1152;
            tr_matrix(r, wout, D, D, WOUTT, scr, id.lane);
        }
    } else {
        bf16* BTR = (bf16*)(a.ws + id.z + W_BTR); bf16* BT1 = (bf16*)(a.ws + id.z + W_BTL); bf16* WOT = (bf16*)(a.ws + id.z + W_WOT);
        const float* mu = a.in[17 + id.z] + (size_t)j * 6 * D;
        const float* wrkv = a.in[18 + id.z] + (size_t)j * 3 * D * D;
        const float* w1 = a.in[21 + id.z] + (size_t)j * 2 * D * 64; const float* a1 = a.in[24 + id.z] + (size_t)j * 2 * D * 64; const float* g1 = a.in[26 + id.z] + (size_t)j * D * 128;
        const float* wo = a.in[19 + id.z] + (size_t)j * D * D;
        bf16* BT2 = (bf16*)(a.ws + id.z + W_BT2); const float* w2 = a.in[22 + id.z] + (size_t)j * 2 * 64 * D; const float* a2 = a.in[25 + id.z] + (size_t)j * 2 * 64 * D; const float* g2 = a.in[27 + id.z] + (size_t)j * 128 * D;
        const int total = 2048 + 2048 + 1536 + 256 + 128 + 512 + 128 + 4 * 32 + 64 + 5120;
        for (int it = id.gw; it < total; it += id.ngw) {
            int r = it;
            if (tr_matrix(r, mw1, D, FF, W1T, scr, id.lane)) continue;
            if (tr_matrix(r, mw2, FF, D, W2T, scr, id.lane)) continue;
            if (tr_matrix(r, wrkv, D, D, BTR, scr, id.lane)) continue;
            if (tr_matrix(r, wrkv + (size_t)D * D, D, D, BTR + (size_t)D * D, scr, id.lane)) continue;
            if (tr_matrix(r, wrkv + (size_t)2 * D * D, D, D, BTR + (size_t)2 * D * D, scr, id.lane)) continue;
            if (tr_rwproj(r, w1, 64, mu + 1 * D, BT1, 0, scr, id.lane)) continue;
            if (tr_rwproj(r, w1 + (size_t)D * 64, 64, mu + 1 * D, BT1, 64, scr, id.lane)) continue;
            if (tr_rwproj(r, a1, 64, mu + 4 * D, BT1, 128, scr, id.lane)) continue;
            if (tr_rwproj(r, a1 + (size_t)D * 64, 64, mu + 4 * D, BT1, 192, scr, id.lane)) continue;
            if (tr_rwproj(r, g1, 128, mu + 5 * D, BT1, 256, scr, id.lane)) continue;
            if (tr_matrix(r, wo, D, D, WOT, scr, id.lane)) continue;
            if (r < 128) {
                v4u z = (v4u){0u, 0u, 0u, 0u}; v4u* p = (v4u*)(BT1 + (size_t)(384 + r) * KRKV);
#pragma unroll
                for (int q = 0; q < 4; ++q) p[id.lane + 64 * q] = z;
                continue; }
            r -= 128;
            if (r < 128) { const int i = r >> 5, q = r & 31; const float* W = (i < 2 ? a2 : w2) + (size_t)(i & 1) * 64 * D; tr_item(W, D, 0, nullptr, BT2, 384, 1024 * i, 64 * (i ^ 2), scr, 0, q, id.lane); continue; }
            r -= 128;
            if (r < 64) { tr_item(g2, D, 0, nullptr, BT2, 384, 4096, 256, scr, r >> 5, r & 31, id.lane); continue; }
            r -= 64;
            { const int blk = r >> 10; const int c0 = (blk < 4) ? 8 * (blk ^ 2) : 32, c1 = (blk < 4) ? 8 * (blk ^ 2) + 8 : 48;
              if (id.lane < 48 && (id.lane < c0 || id.lane >= c1)) *(v4u*)(BT2 + (size_t)r * 384 + 8 * id.lane) = (v4u){0u, 0u, 0u, 0u}; }
        }
    }
}

struct RowV { f32x4 v[4]; };
__device__ __forceinline__ void ld_row(RowV& r, const float* p, int lane) {
#pragma unroll
    for (int j = 0; j < 4; ++j) r.v[j] = ((const f32x4*)p)[lane + 64 * j];
}
__device__ __forceinline__ void st_row(const RowV& r, float* p, int lane) {
#pragma unroll
    for (int j = 0; j < 4; ++j) ((f32x4*)p)[lane + 64 * j] = r.v[j];
}
__device__ __forceinline__ void st_row_bf16(const RowV& r, bf16* p, int lane) {
#pragma unroll
    for (int j = 0; j < 4; ++j) { v2u w; w.x = pk2(r.v[j][0], r.v[j][1]); w.y = pk2(r.v[j][2], r.v[j][3]); ((v2u*)p)[lane + 64 * j] = w; }
}
__device__ __forceinline__ float row_rinv(const RowV& r) {
    float s = 0.f;
#pragma unroll
    for (int j = 0; j < 4; ++j) s += (r.v[j][0] * r.v[j][0] + r.v[j][1] * r.v[j][1]) + (r.v[j][2] * r.v[j][2] + r.v[j][3] * r.v[j][3]);
    s = wave_sum(s);
    return 1.0f / sqrtf(s * (1.0f / 1024.0f) + 1e-6f);
}
__device__ __forceinline__ void norm_mod(RowV& h, const RowV& x, const float* g, const float* sc, const float* sh, int lane) {
    const float ri = row_rinv(x);
#pragma unroll
    for (int j = 0; j < 4; ++j) { const f32x4 gv = ((const f32x4*)g)[lane + 64 * j], scv = ((const f32x4*)sc)[lane + 64 * j], shv = ((const f32x4*)sh)[lane + 64 * j];
        h.v[j] = (x.v[j] * ri) * gv * (scv + 1.0f) + shv; }
}
__device__ __forceinline__ void resid_add(RowV& x, const RowV& m, const float* g, const float* gt, int lane) {
    const float ri = row_rinv(m);
#pragma unroll
    for (int j = 0; j < 4; ++j) { const f32x4 gv = ((const f32x4*)g)[lane + 64 * j], gtv = ((const f32x4*)gt)[lane + 64 * j];
        x.v[j] = x.v[j] + gtv * ((m.v[j] * ri) * gv); }
}

__device__ __forceinline__ float rope_inv(int jj) {
    const float t[16] = {1.0f, 0.5623413324356079f, 0.3162277638912201f, 0.17782793939113617f, 0.10000000149011612f, 0.05623412877321243f, 0.03162277862429619f, 0.017782794311642647f,
                         0.009999999776482582f, 0.005623413249850273f, 0.003162277862429619f, 0.0017782794311642647f, 0.0010000000474974513f, 0.000562341301701963f, 0.0003162277862429619f, 0.00017782794020604342f};
    float r = t[0];
#pragma unroll
    for (int i = 1; i < 16; ++i) r = (jj == i) ? t[i] : r;
    return r;
}
__device__ __forceinline__ void ph_prologue(const Args& a, const Ids& id, LAS unsigned char* lds) {
    float* MOD = (float*)(a.ws + id.z + WS_MOD);
    { LAS float* red = (LAS float*)lds;
      for (int it = blockIdx.x; it < 4 * 96; it += gridDim.x) {
        const int i = it / 96, n = (it % 96) * 64 + id.lane;
        float acc[5];
#pragma unroll
        for (int c = 0; c < 5; ++c) acc[c] = 0.f;
        const float* W = a.in[9 + id.z] + (size_t)i * 1024 * 6144 + n;
#pragma unroll 1
        for (int k0 = 128 * id.wave; k0 < 128 * id.wave + 128; k0 += 64) {
            float sv[5];
#pragma unroll
            for (int c = 0; c < 5; ++c) { const float x = (c < 4) ? a.in[2 + id.z][c * 1024 + k0 + id.lane] : a.in[8 + id.z][k0 + id.lane]; sv[c] = x / (1.0f + __expf(-x)); }
#pragma unroll 16
            for (int kk = 0; kk < 64; ++kk) { const float w = W[(size_t)(k0 + kk) * 6144];
#pragma unroll
                for (int c = 0; c < 5; ++c) acc[c] += w * __shfl(sv[c], kk); }
        }
#pragma unroll
        for (int c = 0; c < 5; ++c) red[(id.wave * 5 + c) * 64 + id.lane] = acc[c];
        __syncthreads();
        if (id.wave < 5) { float s = a.in[10 + id.z][i * 6144 + n];
#pragma unroll
            for (int w8 = 0; w8 < 8; ++w8) s += red[(w8 * 5 + id.wave) * 64 + id.lane];
            MOD[(size_t)(id.wave * 4 + i) * 6144 + n] = s; }
        __syncthreads();
      } }
    { float* RC = (float*)(a.ws + id.z + WS_ROPE); float* RS = RC + 2048 * 64;
      for (int e = id.gw * 64 + id.lane; e < 2048 * 64; e += id.ngw * 64) { const int t = e >> 6, d = e & 63; const int pos = (d < 32) ? (t >> 6) : (t & 63);
          const float ang = (float)pos * rope_inv(d & 15); RC[e] = __cosf(ang); RS[e] = __sinf(ang); } }
    { const f32x4* s0 = (const f32x4*)a.in[0 + id.z]; const f32x4* s1 = (const f32x4*)a.in[1 + id.z]; f32x4* dst = (f32x4*)(a.out + id.z + O_X); const int n4 = NPR * D / 4;
      for (int e = id.gw * 64 + id.lane; e < n4; e += id.ngw * 64) { dst[e] = s0[e]; dst[n4 + e] = s1[e]; } }
    conv_weights(a, id, lds, 0);
}

__device__ __forceinline__ void ph_norm0(const Args& a, const Ids& id) {
    bf16* H = (bf16*)(a.ws + id.z + A_H); const float* g0 = a.in[11 + id.z] + (size_t)(0 * 4 + 0) * D;
    for (int m = id.gw; m < NTOK; m += id.ngw) { RowV x, h; ld_row(x, a.out + id.z + O_X + (size_t)m * D, id.lane); const float* md = mod_ptr_(a, id, cond_of(m), 0);
        norm_mod(h, x, g0, md + 1024, md + 0, id.lane); st_row_bf16(h, H + (size_t)m * D, id.lane); }
}
__device__ __forceinline__ void ph_resid_norm(const Args& a, const Ids& id, int layer, bool dummy = false) {
    bf16* H = (bf16*)(a.ws + id.z + (dummy ? AR + 224 * MiB : A_H)); float* xout = dummy ? (float*)(a.ws + id.z + A_F) : a.out + id.z + O_X; const float* M = (const float*)(a.ws + id.z + A_M); const float* g1 = a.in[11 + id.z] + (size_t)(layer * 4 + 1) * D; const float* g2 = a.in[11 + id.z] + (size_t)(layer * 4 + 2) * D;
    for (int m = id.gw; m < NTOK; m += id.ngw) { RowV x, mm, h; float* xp = a.out + id.z + O_X + (size_t)m * D; ld_row(x, xp, id.lane); ld_row(mm, M + (size_t)m * D, id.lane);
        const float* md = mod_ptr_(a, id, cond_of(m), layer);
        resid_add(x, mm, g1, md + 2048, id.lane); st_row(x, xout + (size_t)m * D, id.lane);
        norm_mod(h, x, g2, md + 4096, md + 3072, id.lane); st_row_bf16(h, H + (size_t)m * D, id.lane); }
}
__device__ __forceinline__ void ph_resid_end(const Args& a, const Ids& id, LAS unsigned char* lds, int layer, bool dummy = false) {
    bf16* H = (bf16*)(a.ws + id.z + (dummy ? AR + 96 * MiB : A_H)); float* xout = dummy ? (float*)(a.ws + id.z + AR + 32 * MiB) : a.out + id.z + O_X; const float* F = (const float*)(a.ws + id.z + A_F); const float* g3 = a.in[11 + id.z] + (size_t)(layer * 4 + 3) * D;
    const bool next_attn = (layer + 1 < DEPTH) && (((layer + 1) & 1) == 0);
    const float* g0n = a.in[11 + id.z] + (size_t)((layer + 1) * 4 + 0) * D;
    for (int m = id.gw; m < NTOK; m += id.ngw) { RowV x, ff; float* xp = a.out + id.z + O_X + (size_t)m * D; ld_row(x, xp, id.lane); ld_row(ff, F + (size_t)m * D, id.lane);
        const float* md = mod_ptr_(a, id, cond_of(m), layer);
        resid_add(x, ff, g3, md + 5120, id.lane); st_row(x, xout + (size_t)m * D, id.lane);
        if (next_attn) { RowV h; const float* mdn = mod_ptr_(a, id, cond_of(m), layer + 1); norm_mod(h, x, g0n, mdn + 1024, mdn + 0, id.lane); st_row_bf16(h, H + (size_t)m * D, id.lane); } }
    if (layer + 1 < DEPTH) conv_weights(a, id, lds, layer + 1);
}
__device__ __forceinline__ void ph_rw_mix(const Args& a, const Ids& id, int layer) {
    bf16* A2 = (bf16*)(a.ws + id.z + A_A2); bf16* XS = (bf16*)(a.ws + id.z + A_XS); const float* g0 = a.in[11 + id.z] + (size_t)(layer * 4 + 0) * D; const float* mu6 = a.in[17 + id.z] + (size_t)(layer >> 1) * 6 * D;
    for (int g8 = id.gw; g8 < NTOK / 8; g8 += id.ngw) {
        const int m0 = g8 * 8; const int t0 = (m0 < NPR) ? (m0 & (TP - 1)) : ((m0 - NPR) & (TS - 1)); const int T = (m0 < NPR) ? TP : TS;
        const float* md = mod_ptr_(a, id, cond_of(m0), layer); const float* xp = a.out + id.z + O_X + (size_t)m0 * D;
        RowV hp, hc, hn, xr;
#pragma unroll
        for (int q = 0; q < 4; ++q) hp.v[q] = (f32x4){0.f, 0.f, 0.f, 0.f};
        if (t0 > 0) { ld_row(xr, xp - D, id.lane); norm_mod(hp, xr, g0, md + 1024, md + 0, id.lane); }
        ld_row(xr, xp, id.lane); norm_mod(hc, xr, g0, md + 1024, md + 0, id.lane);
#pragma unroll 1
        for (int i = 0; i < 8; ++i) {
#pragma unroll
            for (int q = 0; q < 4; ++q) hn.v[q] = (f32x4){0.f, 0.f, 0.f, 0.f};
            if (t0 + i + 1 < T) { ld_row(xr, xp + (size_t)(i + 1) * D, id.lane); norm_mod(hn, xr, g0, md + 1024, md + 0, id.lane); }
            RowV xx;
#pragma unroll
            for (int q = 0; q < 4; ++q) xx.v[q] = (hp.v[q] + hn.v[q]) * 0.5f - hc.v[q];
            st_row_bf16(hc, A2 + (size_t)(m0 + i) * KRKV, id.lane); st_row_bf16(xx, A2 + (size_t)(m0 + i) * KRKV + D, id.lane);
#pragma unroll
            for (int p = 0; p < 3; ++p) { const float* mu = mu6 + (size_t)(p == 0 ? 0 : p + 1) * D; RowV xm;
#pragma unroll
                for (int q = 0; q < 4; ++q) xm.v[q] = hc.v[q] + xx.v[q] * ((const f32x4*)mu)[id.lane + 64 * q];
                st_row_bf16(xm, XS + ((size_t)p * NTOK + m0 + i) * D, id.lane); }
            hp = hc; hc = hn;
        }
    }
}

__device__ __forceinline__ void row16_sum4(float& a, float& b, float& c, float& d) {
    asm("s_nop 1\n\t"
        "v_add_f32_dpp %0, %0, %0 row_ror:8 row_mask:0xf bank_mask:0xf\n\tv_add_f32_dpp %1, %1, %1 row_ror:8 row_mask:0xf bank_mask:0xf\n\tv_add_f32_dpp %2, %2, %2 row_ror:8 row_mask:0xf bank_mask:0xf\n\tv_add_f32_dpp %3, %3, %3 row_ror:8 row_mask:0xf bank_mask:0xf\n\t"
        "v_add_f32_dpp %0, %0, %0 row_ror:4 row_mask:0xf bank_mask:0xf\n\tv_add_f32_dpp %1, %1, %1 row_ror:4 row_mask:0xf bank_mask:0xf\n\tv_add_f32_dpp %2, %2, %2 row_ror:4 row_mask:0xf bank_mask:0xf\n\tv_add_f32_dpp %3, %3, %3 row_ror:4 row_mask:0xf bank_mask:0xf\n\t"
        "v_add_f32_dpp %0, %0, %0 row_ror:2 row_mask:0xf bank_mask:0xf\n\tv_add_f32_dpp %1, %1, %1 row_ror:2 row_mask:0xf bank_mask:0xf\n\tv_add_f32_dpp %2, %2, %2 row_ror:2 row_mask:0xf bank_mask:0xf\n\tv_add_f32_dpp %3, %3, %3 row_ror:2 row_mask:0xf bank_mask:0xf\n\t"
        "v_add_f32_dpp %0, %0, %0 row_ror:1 row_mask:0xf bank_mask:0xf\n\tv_add_f32_dpp %1, %1, %1 row_ror:1 row_mask:0xf bank_mask:0xf\n\tv_add_f32_dpp %2, %2, %2 row_ror:1 row_mask:0xf bank_mask:0xf\n\tv_add_f32_dpp %3, %3, %3 row_ror:1 row_mask:0xf bank_mask:0xf"
        : "+v"(a), "+v"(b), "+v"(c), "+v"(d));
}
__device__ __forceinline__ f32x4 ld_bf4(const bf16* p) { const v2u w = *(const v2u*)p; return (f32x4){bflo(w.x), bfhi(w.x), bflo(w.y), bfhi(w.y)}; }
__device__ __forceinline__ void ph_att_cache(const Args& a, const Ids& id, int layer) {
    const int j = layer >> 1, lane = id.lane;
    bf16 *KAS = (bf16*)(a.ws + id.z + A_KAS), *VAS = (bf16*)(a.ws + id.z + A_VAS), *KBS = (bf16*)(a.ws + id.z + A_KBS), *VBS = (bf16*)(a.ws + id.z + A_VBS);
    for (int r = id.gw; r < 4 * PAST; r += id.ngw) {
        const int b = r >> 9, pos = r & (PAST - 1);
        const size_t src = (size_t)((b * 2 + j) * PAST + pos), dst = (size_t)(b * SKV + pos);
#pragma unroll
        for (int q = 0; q < 2; ++q) { const int e = lane + 64 * q; KAS[dst * 128 + e] = (bf16)f2bf(a.in[3 + id.z][src * 128 + e]); VAS[dst * 128 + e] = (bf16)f2bf(a.in[4 + id.z][src * 128 + e]); }
#pragma unroll
        for (int q = 0; q < 8; ++q) { const int e = lane + 64 * q; KBS[dst * 512 + e] = (bf16)f2bf(a.in[5 + id.z][src * 512 + e]); VBS[dst * 512 + e] = (bf16)f2bf(a.in[6 + id.z][src * 512 + e]); }
    }
}

typedef short bf16x8_t __attribute__((ext_vector_type(8)));
typedef float f32x16 __attribute__((ext_vector_type(16)));
typedef short v4i16_t __attribute__((ext_vector_type(4)));
constexpr float AT_THR = 8.0f;
constexpr int AT_KP = 144, AT_KBUF = 64 * AT_KP, AT_VOFF = 2 * AT_KBUF, AT_VBUFMAX = 64 * 288, AT_WSF = AT_VOFF + 2 * AT_VBUFMAX;
static_assert(AT_WSF + 8 * 128 <= RING_BYTES, "attention LDS");
template <int NDT>
__device__ __forceinline__ void attn_unit(const bf16* Qrow0, int ldq, const bf16* Kb, int ldk, const bf16* Vb, int ldv, int S, bf16* Obf, float* Of32, int ldo, LAS unsigned char* lds, const Ids& id) {
    constexpr int VP = (NDT == 2) ? 144 : 288, NVL = NDT / 2;
    const int lane = id.lane, w = id.wave, r32 = lane & 31, hi = lane >> 5, tid = id.tid;
    bf16x8_t qf[4];
    { const bf16* qrow = Qrow0 + (size_t)(32 * w + r32) * ldq;
#pragma unroll
      for (int s = 0; s < 4; ++s) qf[s] = *(const bf16x8_t*)(qrow + 16 * s + 8 * hi); }
    f32x16 o[NDT];
#pragma unroll
    for (int dt = 0; dt < NDT; ++dt)
#pragma unroll
        for (int r = 0; r < 16; ++r) o[dt][r] = 0.f;
    float m_run = 0.f, l_run = 0.f;
    const int NT = S >> 6;
    LAS float* wsf = (LAS float*)(lds + AT_WSF + w * 128);
    const int krow = tid >> 3, kch = tid & 7;
    v4u kreg, vreg[NVL];
#define AT_GLOAD(t) do { kreg = *(const v4u*)(Kb + (size_t)((t) * 64 + krow) * ldk + 8 * kch); \
        if (NDT == 2) vreg[0] = *(const v4u*)(Vb + (size_t)((t) * 64 + krow) * ldv + 8 * kch); \
        else { _Pragma("unroll") for (int i_ = 0; i_ < NVL; ++i_) { const int ix_ = tid + 512 * i_; vreg[i_] = *(const v4u*)(Vb + (size_t)((t) * 64 + (ix_ >> 4)) * ldv + 8 * (ix_ & 15)); } } } while (0)
#define AT_LSTORE(b) do { *(LAS v4u*)(lds + (b) * AT_KBUF + krow * AT_KP + 16 * kch) = kreg; \
        if (NDT == 2) *(LAS v4u*)(lds + AT_VOFF + (b) * AT_VBUFMAX + krow * VP + 16 * kch) = vreg[0]; \
        else { _Pragma("unroll") for (int i_ = 0; i_ < NVL; ++i_) { const int ix_ = tid + 512 * i_; *(LAS v4u*)(lds + AT_VOFF + (b) * AT_VBUFMAX + (ix_ >> 4) * VP + 16 * (ix_ & 15)) = vreg[i_]; } } } while (0)
    AT_GLOAD(0); AT_LSTORE(0);
    __syncthreads();
    const int vbase = (4 * hi + ((lane & 15) >> 2)) * VP + 32 * ((lane >> 4) & 1) + 8 * (lane & 3);
#pragma unroll 1
    for (int t = 0; t < NT; ++t) {
        const int b = t & 1;
        if (t + 1 < NT) AT_GLOAD(t + 1);
        const LAS unsigned char* Kt = lds + b * AT_KBUF + r32 * AT_KP + 16 * hi;
        const LAS unsigned char* Vt = lds + AT_VOFF + b * AT_VBUFMAX + vbase;
        f32x16 p0, p1;
        { const float nm = -m_run;
#pragma unroll
          for (int r = 0; r < 16; ++r) { p0[r] = nm; p1[r] = nm; } }
#pragma unroll
        for (int s = 0; s < 4; ++s) { const bf16x8_t k0 = *(const LAS bf16x8_t*)(Kt + 32 * s), k1 = *(const LAS bf16x8_t*)(Kt + 32 * AT_KP + 32 * s);
            p0 = __builtin_amdgcn_mfma_f32_32x32x16_bf16(k0, qf[s], p0, 0, 0, 0); p1 = __builtin_amdgcn_mfma_f32_32x32x16_bf16(k1, qf[s], p1, 0, 0, 0); }
        float mx = __builtin_fmaxf(p0[0], p1[0]);
#pragma unroll
        for (int r = 1; r < 16; ++r) mx = __builtin_fmaxf(__builtin_fmaxf(mx, p0[r]), p1[r]);
        mx = fmaxf(mx, __shfl_xor(mx, 32));
        if (t == 0 || __any(mx > AT_THR)) {
            const float dl = (t == 0) ? mx : fmaxf(mx, 0.f), al = __builtin_amdgcn_exp2f(-dl); m_run += dl; l_run *= al;
#pragma unroll
            for (int r = 0; r < 16; ++r) { p0[r] -= dl; p1[r] -= dl; }
            if (hi == 0) wsf[r32] = al;
            LDS_WAIT(); asm volatile("" ::: "memory");
            { f32x4 a4[4];
#pragma unroll
              for (int g4 = 0; g4 < 4; ++g4) a4[g4] = *(const LAS f32x4*)(wsf + 8 * g4 + 4 * hi);
#pragma unroll
              for (int dt = 0; dt < NDT; ++dt)
#pragma unroll
                  for (int r = 0; r < 16; ++r) o[dt][r] *= a4[r >> 2][r & 3]; }
            LDS_WAIT(); asm volatile("" ::: "memory");
        }
        float rs = 0.f;
#pragma unroll
        for (int r = 0; r < 16; ++r) { p0[r] = __builtin_amdgcn_exp2f(p0[r]); p1[r] = __builtin_amdgcn_exp2f(p1[r]); rs += p0[r] + p1[r]; }
        l_run += rs;
        bf16x8_t pf[4];
#pragma unroll
        for (int ks = 0; ks < 4; ++ks) { v4u pw;
#pragma unroll
            for (int dd = 0; dd < 4; ++dd) { const int r = 8 * (ks & 1) + 2 * dd; pw[dd] = (ks < 2) ? pk2(p0[r], p0[r + 1]) : pk2(p1[r], p1[r + 1]); }
            pf[ks] = __builtin_bit_cast(bf16x8_t, pw); }
#pragma unroll
        for (int ks = 0; ks < 4; ++ks)
#pragma unroll
            for (int dt = 0; dt < NDT; ++dt) {
                const v4i16_t lo = __builtin_amdgcn_ds_read_tr16_b64_v4i16((LAS v4i16_t*)(Vt + (16 * ks) * VP + 64 * dt));
                const v4i16_t hh = __builtin_amdgcn_ds_read_tr16_b64_v4i16((LAS v4i16_t*)(Vt + (16 * ks + 8) * VP + 64 * dt));
                const bf16x8_t vf = (bf16x8_t){lo[0], lo[1], lo[2], lo[3], hh[0], hh[1], hh[2], hh[3]};
                o[dt] = __builtin_amdgcn_mfma_f32_32x32x16_bf16(pf[ks], vf, o[dt], 0, 0, 0); }
        if (t + 1 < NT) AT_LSTORE(b ^ 1);
        __syncthreads();
    }
#undef AT_GLOAD
#undef AT_LSTORE
    const float lt = l_run + __shfl_xor(l_run, 32);
    int lane_e = lane; asm volatile("" : "+v"(lane_e));
    const int r32e = lane_e & 31, hie = lane_e >> 5;
    if (hi == 0) wsf[r32] = 1.0f / lt;
    LDS_WAIT(); asm volatile("" ::: "memory");
    f32x4 a4[4];
#pragma unroll
    for (int g4 = 0; g4 < 4; ++g4) a4[g4] = *(const LAS f32x4*)(wsf + 8 * g4 + 4 * hi);
    LDS_WAIT(); asm volatile("" ::: "memory");
#pragma unroll
    for (int dt = 0; dt < NDT; ++dt)
#pragma unroll
        for (int r = 0; r < 16; ++r) { const float val = o[dt][r] * a4[r >> 2][r & 3]; const int off = (32 * w + (r & 3) + 8 * (r >> 2) + 4 * hie) * ldo + 32 * dt + r32e;
            if (NDT == 2) Obf[off] = (bf16)f2bf(val); else Of32[off] = val; }
}
__device__ __forceinline__ void ph_attn(const Args& a, const Ids& id, LAS unsigned char* lds, int G, int vcu) {
    const bf16 *QA = (const bf16*)(a.ws + id.z + A_QA), *QB = (const bf16*)(a.ws + id.z + A_QB), *KAP = (const bf16*)(a.ws + id.z + A_KAP), *VAP = (const bf16*)(a.ws + id.z + A_VAP), *KBP = (const bf16*)(a.ws + id.z + A_KBP), *VBP = (const bf16*)(a.ws + id.z + A_VBP);
    const bf16 *KAS = (const bf16*)(a.ws + id.z + A_KAS), *VAS = (const bf16*)(a.ws + id.z + A_VAS), *KBS = (const bf16*)(a.ws + id.z + A_KBS), *VBS = (const bf16*)(a.ws + id.z + A_VBS);
    bf16* H = (bf16*)(a.ws + id.z + A_H); float* DT = (float*)(a.ws + id.z + A_DT);
    for (int s = vcu; s < 256; s += G) {
        const int h8 = s & 7;
#pragma unroll 1
        for (int pass = 0; pass < 2; ++pass) {
            size_t m0, kvrow; int S;
            if (pass == 0) { const int b = s >> 6, qb = (s >> 3) & 7; m0 = (size_t)NPR + b * TS + qb * 256; kvrow = (size_t)b * SKV; S = SKV; }
            else { const int b = s >> 3; m0 = (size_t)b * TP; kvrow = m0; S = TP; }
            const bf16* Ka = (pass == 0 ? KAS : KAP) + kvrow * 128 + (h8 >> 2) * 64; const bf16* Va = (pass == 0 ? VAS : VAP) + kvrow * 128 + (h8 >> 2) * 64;
            const bf16* Kd = (pass == 0 ? KBS : KBP) + kvrow * 512 + h8 * 64; const bf16* Vd = (pass == 0 ? VBS : VBP) + kvrow * 512 + (h8 >> 1) * 128;
            attn_unit<2>(QA + m0 * 512 + h8 * 64, 512, Ka, 128, Va, 128, S, H + m0 * D + h8 * 64, nullptr, D, lds, id);
            attn_unit<4>(QB + m0 * 512 + h8 * 64, 512, Kd, 512, Vd, 512, S, nullptr, DT + m0 * D + h8 * 128, D, lds, id);
        }
    }
}
__device__ __forceinline__ void ph_att_comb(const Args& a, const Ids& id, int layer) {
    const int j = layer >> 1, lane = id.lane; const float lam_init = (layer == 0) ? 0.2f : 0.4707130183435842f;
    const float* lf = a.in[15 + id.z] + j * 256; const float* sg = a.in[16 + id.z] + j * 128;
    const float s01 = wave_sum(lf[lane] * lf[64 + lane]), s23 = wave_sum(lf[128 + lane] * lf[192 + lane]);
    const float lam = expf(s01) - expf(s23) + lam_init;
    const float* DT = (const float*)(a.ws + id.z + A_DT); bf16* H = (bf16*)(a.ws + id.z + A_H);
    const f32x4 gg = *(const f32x4*)(sg + 4 * (lane & 31)) * (1.0f - lam_init);
    for (int m = id.gw; m < NTOK; m += id.ngw) {
        f32x4 v[4];
#pragma unroll
        for (int hd = 0; hd < 4; ++hd) v[hd] = *(const f32x4*)(DT + (size_t)m * D + 256 * hd + 4 * lane);
        float ss[4];
#pragma unroll
        for (int hd = 0; hd < 4; ++hd) { f32x4 o; o[0] = __shfl_xor(v[hd][0], 32); o[1] = __shfl_xor(v[hd][1], 32); o[2] = __shfl_xor(v[hd][2], 32); o[3] = __shfl_xor(v[hd][3], 32);
            v[hd] = v[hd] - o * lam;
            ss[hd] = (lane < 32) ? (v[hd][0] * v[hd][0] + v[hd][1] * v[hd][1]) + (v[hd][2] * v[hd][2] + v[hd][3] * v[hd][3]) : 0.f; }
        row16_sum4(ss[0], ss[1], ss[2], ss[3]);
#pragma unroll
        for (int hd = 0; hd < 4; ++hd) { const float tot = ss[hd] + __shfl_xor(ss[hd], 16); const float ri = 1.0f / sqrtf(tot * (1.0f / 128.0f) + 1e-6f); const f32x4 o = v[hd] * ri * gg;
            if (lane < 32) *(v2u*)(H + (size_t)m * D + 512 + hd * 128 + 4 * lane) = (v2u){pk2(o[0], o[1]), pk2(o[2], o[3])}; }
    }
}

__device__ __forceinline__ void ph_rw_prep(const Args& a, const Ids& id, int layer) {
    const int j = layer >> 1, lane = id.lane;
    const bf16* RKV = (const bf16*)(a.ws + id.z + A_RKV); float* INV = (float*)(a.ws + id.z + WS_INV); float* Y = (float*)(a.ws + id.z + A_Y);
    const float* kk_c = a.in[28 + id.z] + (size_t)(j * 3 + 0) * D;
    for (int m = id.gw; m < NTOK; m += id.ngw) {
#pragma unroll 4
        for (int h = 0; h < 16; ++h) { const float kv = bf2f(RKV[(size_t)m * 3072 + 1024 + h * 64 + lane]) * kk_c[h * 64 + lane]; const float ss = wave_sum(kv * kv); if (lane == 0) INV[m * 16 + h] = 1.0f / sqrtf(ss + 1e-12f); }
        f32x4* yp = (f32x4*)(Y + (size_t)m * D);
#pragma unroll
        for (int q = 0; q < 4; ++q) yp[lane + 64 * q] = (f32x4){0.f, 0.f, 0.f, 0.f};
    }
}

constexpr int SC_TC = 16, SC_ROWF = 352;
constexpr int SC_OPF = SC_TC * SC_ROWF;
constexpr int SC_YOFF = 4 * SC_OPF;
static_assert((SC_YOFF + 4 * SC_TC * 32) * 4 <= RING_BYTES, "scan LDS");
struct ScDesc { int mbase, T, h, dir, half, b; };
__device__ __forceinline__ void sc_desc(ScDesc& d, int slot, int grp, int c) {
    if (grp == 0) { const int cs = slot >> 1; d.b = cs >> 5; d.h = (cs >> 1) & 15; d.dir = cs & 1; d.half = slot & 1; d.T = TS; d.mbase = NPR + d.b * TS; }
    else { const int pu = slot * 8 + (c >> 4), cp = pu >> 1; d.b = cp >> 5; d.h = (cp >> 1) & 15; d.dir = cp & 1; d.half = pu & 1; d.T = TP; d.mbase = d.b * TP; }
}
__device__ __forceinline__ int sc_tok(const ScDesc& d, int grp, int c, int i) { const int s = (grp == 0 ? c : (c & 15)) * SC_TC + i; return d.mbase + (d.dir ? d.T - 1 - s : s); }
__device__ __forceinline__ float fma_s(float a, float b, float c) { float r; asm("v_fma_f32 %0, %1, %2, %3" : "=v"(r) : "v"(a), "v"(b), "v"(c)); return r; }
__device__ __forceinline__ float fnma_s(float a, float b, float c) { float r; asm("v_fma_f32 %0, -%1, %2, %3" : "=v"(r) : "v"(a), "v"(b), "v"(c)); return r; }
__device__ __forceinline__ float mul_s(float a, float b) { float r; asm("v_mul_f32_e32 %0, %1, %2" : "=v"(r) : "v"(a), "v"(b)); return r; }
__device__ __forceinline__ float add_s(float a, float b) { float r; asm("v_add_f32_e32 %0, %1, %2" : "=v"(r) : "v"(a), "v"(b)); return r; }
__device__ __forceinline__ void oct_sum4(float& a, float& b, float& c, float& d) {
    asm("s_nop 1\n\t"
        "v_add_f32_dpp %0, %0, %0 quad_perm:[1,0,3,2] row_mask:0xf bank_mask:0xf\n\tv_add_f32_dpp %1, %1, %1 quad_perm:[1,0,3,2] row_mask:0xf bank_mask:0xf\n\tv_add_f32_dpp %2, %2, %2 quad_perm:[1,0,3,2] row_mask:0xf bank_mask:0xf\n\tv_add_f32_dpp %3, %3, %3 quad_perm:[1,0,3,2] row_mask:0xf bank_mask:0xf\n\t"
        "v_add_f32_dpp %0, %0, %0 quad_perm:[2,3,0,1] row_mask:0xf bank_mask:0xf\n\tv_add_f32_dpp %1, %1, %1 quad_perm:[2,3,0,1] row_mask:0xf bank_mask:0xf\n\tv_add_f32_dpp %2, %2, %2 quad_perm:[2,3,0,1] row_mask:0xf bank_mask:0xf\n\tv_add_f32_dpp %3, %3, %3 quad_perm:[2,3,0,1] row_mask:0xf bank_mask:0xf\n\t"
        "v_add_f32_dpp %0, %0, %0 row_half_mirror row_mask:0xf bank_mask:0xf\n\tv_add_f32_dpp %1, %1, %1 row_half_mirror row_mask:0xf bank_mask:0xf\n\tv_add_f32_dpp %2, %2, %2 row_half_mirror row_mask:0xf bank_mask:0xf\n\tv_add_f32_dpp %3, %3, %3 row_half_mirror row_mask:0xf bank_mask:0xf"
        : "+v"(a), "+v"(b), "+v"(c), "+v"(d));
}
struct ScOps { f32x4 w[2], kd[2], kk[2], ka[2], r[2]; float va, vb; };
__device__ __forceinline__ void sc_ldops(ScOps& o, const LAS float* p, int kg, int ra) {
#pragma unroll
    for (int hq = 0; hq < 2; ++hq) { o.w[hq] = *(const LAS f32x4*)(p + 8 * kg + 4 * hq); o.kd[hq] = *(const LAS f32x4*)(p + 64 + 8 * kg + 4 * hq); o.kk[hq] = *(const LAS f32x4*)(p + 128 + 8 * kg + 4 * hq);
        o.ka[hq] = *(const LAS f32x4*)(p + 192 + 8 * kg + 4 * hq); o.r[hq] = *(const LAS f32x4*)(p + 256 + 8 * kg + 4 * hq); }
    o.va = p[320 + ra]; o.vb = p[321 + ra];
}
__device__ __forceinline__ float dot8_s(const float (&S)[8], const f32x4 (&x)[2]) {
    const float p0 = fma_s(S[3], x[0][3], fma_s(S[2], x[0][2], fma_s(S[1], x[0][1], mul_s(S[0], x[0][0]))));
    const float p1 = fma_s(S[7], x[1][3], fma_s(S[6], x[1][2], fma_s(S[5], x[1][1], mul_s(S[4], x[1][0]))));
    return add_s(p0, p1);
}
struct ScRaw { float r[8], k[8], a[8], e[8], v[8], iv[8]; };
__device__ __forceinline__ void sc_load(ScRaw& R, const Args& a, const Ids& id, int hw, int slot, int c) {
    const int grp = hw >> 1, lane = id.lane; ScDesc d; sc_desc(d, slot, grp, c);
    const bf16* RKV = (const bf16*)(a.ws + id.z + A_RKV); const float* INV = (const float*)(a.ws + id.z + WS_INV);
    const bf16* Ad = (const bf16*)(a.ws + id.z + (d.dir ? A_A1 : A_A0)); const bf16* EWd = (const bf16*)(a.ws + id.z + (d.dir ? A_EW1 : A_EW0));
#pragma unroll
    for (int q = 0; q < 8; ++q) { const int m = sc_tok(d, grp, c, (hw & 1) * 8 + q); const size_t o = (size_t)m * 3072 + d.h * 64 + lane, o2 = (size_t)m * D + d.h * 64 + lane;
        R.r[q] = bf2f(RKV[o]); R.k[q] = bf2f(RKV[o + 1024]); R.a[q] = bf2f(Ad[o2]); R.e[q] = bf2f(EWd[o2]); R.iv[q] = INV[m * 16 + d.h];
        R.v[q] = bf2f(RKV[(size_t)m * 3072 + 2048 + d.h * 64 + d.half * 32 + (lane & 31)]); }
}
__device__ __forceinline__ void sc_derive(const ScRaw& R, const Args& a, const Ids& id, LAS float* L, int layer, int hw, int slot, int c, int buf) {
    const int grp = hw >> 1, lane = id.lane, j = layer >> 1; ScDesc d; sc_desc(d, slot, grp, c);
    const float kkc = a.in[28 + id.z][(size_t)(j * 3 + 0) * D + d.h * 64 + lane], kac = a.in[28 + id.z][(size_t)(j * 3 + 1) * D + d.h * 64 + lane];
#pragma unroll
    for (int q = 0; q < 8; ++q) { LAS float* p = L + (buf * 2 + grp) * SC_OPF + ((hw & 1) * 8 + q) * SC_ROWF;
        const float kk = R.k[q] * kkc * R.iv[q];
        p[lane] = __builtin_amdgcn_exp2f(-R.e[q]); p[64 + lane] = R.k[q] * (1.0f + (R.a[q] - 1.0f) * kac); p[128 + lane] = kk; p[192 + lane] = kk * R.a[q]; p[256 + lane] = R.r[q];
        if (lane < 32) p[320 + lane] = R.v[q]; }
}
__device__ __forceinline__ void sc_flush(const Args& a, const Ids& id, const LAS float* L, int hw, int slot, int c) {
    float* Y = (float*)(a.ws + id.z + A_Y);
#pragma unroll
    for (int q = 0; q < 4; ++q) { const int idx = hw * 64 + id.lane + 256 * q, fg = idx >> 9, s = (idx >> 5) & 15, row = idx & 31; ScDesc d; sc_desc(d, slot, fg, c);
        const float yv = L[SC_YOFF + ((c & 1) * 2 + fg) * SC_TC * 32 + s * 32 + row];
        atomicAdd(&Y[(size_t)sc_tok(d, fg, c, s) * D + d.h * 64 + d.half * 32 + row], yv); }
}
__device__ __forceinline__ void ph_rw_scan(const Args& a, const Ids& id, LAS unsigned char* lds, int layer, int G, int vcu) {
    const int j = layer >> 1, lane = id.lane, w = id.wave;
    LAS float* L = (LAS float*)lds;
    constexpr int NC = TS / SC_TC;
    for (int slot = vcu; slot < 256; slot += G) {
        if (w >= 4) {
            const int hw = w - 4; ScRaw R;
            sc_load(R, a, id, hw, slot, 0); sc_derive(R, a, id, L, layer, hw, slot, 0, 0);
            __syncthreads();
#pragma unroll 1
            for (int c = 0; c < NC; ++c) {
                if (c + 1 < NC) sc_load(R, a, id, hw, slot, c + 1);
                if (c > 0) sc_flush(a, id, L, hw, slot, c - 1);
                if (c + 1 < NC) sc_derive(R, a, id, L, layer, hw, slot, c + 1, (c & 1) ^ 1);
                __syncthreads();
            }
            sc_flush(a, id, L, hw, slot, NC - 1);
        } else {
            const int grp = w >> 1, kg = lane & 7, ra = 16 * (w & 1) + 2 * (lane >> 3);
            float Sa[8], Sb[8];
            { ScDesc d; sc_desc(d, slot, 0, 0);
              if (grp == 0) { const float* sp = a.in[7 + id.z] + ((((size_t)(d.b * 2 + j) * 2 + d.dir) * 16 + d.h) * 64 + d.half * 32 + ra) * 64 + 8 * kg;
                  const f32x4 t0 = *(const f32x4*)sp, t1 = *(const f32x4*)(sp + 4), t2 = *(const f32x4*)(sp + 64), t3 = *(const f32x4*)(sp + 68);
#pragma unroll
                  for (int e2 = 0; e2 < 4; ++e2) { Sa[e2] = t0[e2]; Sa[4 + e2] = t1[e2]; Sb[e2] = t2[e2]; Sb[4 + e2] = t3[e2]; } }
              else {
#pragma unroll
                  for (int e2 = 0; e2 < 8; ++e2) { Sa[e2] = 0.f; Sb[e2] = 0.f; } } }
            __syncthreads();
#pragma unroll 1
            for (int c = 0; c < NC; ++c) {
                const int buf = c & 1;
                if (grp == 1 && (c & 15) == 0) {
#pragma unroll
                    for (int e2 = 0; e2 < 8; ++e2) { Sa[e2] = 0.f; Sb[e2] = 0.f; } }
                const LAS float* ob = L + (buf * 2 + grp) * SC_OPF; LAS float* yb = L + SC_YOFF + (buf * 2 + grp) * SC_TC * 32 + ra;
                {
                    ScOps cur, nxt; sc_ldops(cur, ob, kg, ra);
                    float ypa = 0.f, ypb = 0.f;
#pragma unroll
                    for (int i = 0; i < SC_TC; ++i) {
                        if (i + 1 < SC_TC) sc_ldops(nxt, ob + (i + 1) * SC_ROWF, kg, ra);
                        float ua[8], ub[8];
#pragma unroll
                        for (int e2 = 0; e2 < 8; ++e2) { ua[e2] = fma_s(Sa[e2], cur.w[e2 >> 2][e2 & 3], mul_s(cur.va, cur.kd[e2 >> 2][e2 & 3])); ub[e2] = fma_s(Sb[e2], cur.w[e2 >> 2][e2 & 3], mul_s(cur.vb, cur.kd[e2 >> 2][e2 & 3])); }
                        float ska = dot8_s(Sa, cur.kk), skb = dot8_s(Sb, cur.kk);
                        oct_sum4(ska, skb, ypa, ypb);
                        if (i > 0 && kg == 0) { yb[(i - 1) * 32] = ypa; yb[(i - 1) * 32 + 1] = ypb; }
#pragma unroll
                        for (int e2 = 0; e2 < 8; ++e2) { Sa[e2] = fnma_s(ska, cur.ka[e2 >> 2][e2 & 3], ua[e2]); Sb[e2] = fnma_s(skb, cur.ka[e2 >> 2][e2 & 3], ub[e2]); }
                        ypa = dot8_s(Sa, cur.r); ypb = dot8_s(Sb, cur.r);
                        if (i + 1 < SC_TC) cur = nxt;
                    }
                    float z0 = 0.f, z1 = 0.f; oct_sum4(ypa, ypb, z0, z1);
                    if (kg == 0) { yb[(SC_TC - 1) * 32] = ypa; yb[(SC_TC - 1) * 32 + 1] = ypb; }
                }
                if (grp == 1 && (c & 15) == 15) { ScDesc d; sc_desc(d, slot, 1, c);
                    float* dp = a.out + id.z + O_ST + ((((size_t)(d.b * 2 + j) * 2 + d.dir) * 16 + d.h) * 64 + d.half * 32 + ra) * 64 + 8 * kg;
                    *(f32x4*)dp = (f32x4){Sa[0], Sa[1], Sa[2], Sa[3]}; *(f32x4*)(dp + 4) = (f32x4){Sa[4], Sa[5], Sa[6], Sa[7]};
                    *(f32x4*)(dp + 64) = (f32x4){Sb[0], Sb[1], Sb[2], Sb[3]}; *(f32x4*)(dp + 68) = (f32x4){Sb[4], Sb[5], Sb[6], Sb[7]}; }
                __syncthreads();
            }
        }
        __syncthreads();
    }
}
__device__ __forceinline__ void ph_rw_post(const Args& a, const Ids& id, int layer) {
    const int j = layer >> 1, lane = id.lane;
    const bf16* RKV = (const bf16*)(a.ws + id.z + A_RKV); const float* Y = (const float*)(a.ws + id.z + A_Y);
    const bf16 *A0 = (const bf16*)(a.ws + id.z + A_A0), *A1 = (const bf16*)(a.ws + id.z + A_A1); bf16* H = (bf16*)(a.ws + id.z + A_H);
    const float* kvec = a.in[28 + id.z] + (size_t)j * 3 * D; const float* lnx = a.in[29 + id.z] + (size_t)j * 2 * D;
    f32x4 ka[4], rk[4], l0[4], l1[4];
#pragma unroll
    for (int q = 0; q < 4; ++q) { const int c = 4 * lane + 256 * q; ka[q] = *(const f32x4*)(kvec + D + c); rk[q] = *(const f32x4*)(kvec + 2 * D + c); l0[q] = *(const f32x4*)(lnx + c); l1[q] = *(const f32x4*)(lnx + D + c); }
    for (int m = id.gw; m < NTOK; m += id.ngw) {
        f32x4 y[4], r[4], k[4], v[4], a0[4], a1[4], g[4];
#pragma unroll
        for (int q = 0; q < 4; ++q) { const int c = 4 * lane + 256 * q; y[q] = *(const f32x4*)(Y + (size_t)m * D + c);
            r[q] = ld_bf4(RKV + (size_t)m * 3072 + c); k[q] = ld_bf4(RKV + (size_t)m * 3072 + 1024 + c); v[q] = ld_bf4(RKV + (size_t)m * 3072 + 2048 + c);
            a0[q] = ld_bf4(A0 + (size_t)m * D + c); a1[q] = ld_bf4(A1 + (size_t)m * D + c); g[q] = ld_bf4(H + (size_t)m * D + c); }
        float s[4], qv[4], bs[4];
#pragma unroll
        for (int q = 0; q < 4; ++q) s[q] = (y[q][0] + y[q][1]) + (y[q][2] + y[q][3]);
        row16_sum4(s[0], s[1], s[2], s[3]);
#pragma unroll
        for (int q = 0; q < 4; ++q) { const float mean = s[q] * (1.0f / 64.0f); y[q] = y[q] - mean; qv[q] = (y[q][0] * y[q][0] + y[q][1] * y[q][1]) + (y[q][2] * y[q][2] + y[q][3] * y[q][3]);
            const f32x4 kds = k[q] * ((a0[q] - 1.0f) * ka[q] + 1.0f) + k[q] * ((a1[q] - 1.0f) * ka[q] + 1.0f); const f32x4 t = r[q] * kds * rk[q]; bs[q] = (t[0] + t[1]) + (t[2] + t[3]); }
        row16_sum4(qv[0], qv[1], qv[2], qv[3]);
        row16_sum4(bs[0], bs[1], bs[2], bs[3]);
#pragma unroll
        for (int q = 0; q < 4; ++q) { const float ri = 1.0f / sqrtf(qv[q] * (1.0f / 64.0f) + 64e-5f); const f32x4 o = ((y[q] * ri) * l0[q] + l1[q] + v[q] * bs[q]) * g[q];
            *(v2u*)(H + (size_t)m * D + 4 * lane + 256 * q) = (v2u){pk2(o[0], o[1]), pk2(o[2], o[3])}; }
    }
}

enum Kind { K_PRO = 0, K_NORM0 = 1, K_QKV = 2, K_APOST = 3, K_ATTN = 4, K_ACOMB = 5, K_MIXOUT = 6, K_RNORM = 7, K_MLP1 = 8, K_MLP2 = 9, K_REND = 10,
            K_RMIX = 11, K_RKV = 12, K_RPREP = 13, K_RSCAN = 14, K_RPOST = 15 };
constexpr int NPH = 38;
__host__ __device__ __forceinline__ void decode_phase(int ph, int& kind, int& layer) {
    if (ph < 2) { kind = ph; layer = 0; return; }
    const int p = ph - 2, pair = p / 19, q = p % 19;
    if (q < 9) { layer = 2 * pair; kind = K_QKV + q; }
    else { layer = 2 * pair + 1; const int q2 = q - 9; kind = (q2 < 5) ? (K_RMIX + q2) : (K_MIXOUT + (q2 - 5)); }
}

#ifndef PROBE_MASK
#define PROBE_MASK 0
#endif
#ifndef PROBE_REPS
#define PROBE_REPS 1
#endif
template <int KIND, int LAYER>
__device__ __forceinline__ void run_phase(const Args& a, LAS unsigned char* lds, int G, int bx, int vcu, int wave_s, int rep) {
    Ids id; { int lv; asm volatile("v_mbcnt_lo_u32_b32 %0, -1, 0\n\tv_mbcnt_hi_u32_b32 %0, -1, %0" : "=v"(lv)); int zz; asm volatile("s_mov_b32 %0, 0" : "=s"(zz)); id.lane = lv; id.z = zz; }
    id.wave = wave_s; id.tid = wave_s * 64 + id.lane; id.gw = vcu * NWAVES + id.wave; id.ngw = G * NWAVES;
    constexpr int layer = LAYER;
    if constexpr (KIND == K_PRO) ph_prologue(a, id, lds);
    else if constexpr (KIND == K_NORM0) ph_norm0(a, id);
    else if constexpr (KIND == K_QKV) {
        constexpr int j = layer >> 1;
        pg8::Gemm g{(const bf16*)(a.ws + id.z + A_H), (const bf16*)(a.ws + id.z + W_WINT), NTOK, NQKV, D}; pg8::StaticOrder S; S.init(NTOK, NQKV, G, bx);
        const float* RC = (const float*)(a.ws + id.z + WS_ROPE);
        pg8::EpiQkv<QkvMap> E{a.ws + id.z, a.out + id.z, a.in[14 + id.z] + j * 128, RC, RC + 2048 * 64, j};
        pg8::gemm_phase<pg8::EpiQkv<QkvMap>, pg8::StaticOrder, true, true>(lds + RING_OFF, g, S, E, id.wave);
        { Ids id2 = id; int lv; asm volatile("v_mbcnt_lo_u32_b32 %0, -1, 0\n\tv_mbcnt_hi_u32_b32 %0, -1, %0" : "=v"(lv)); int zz; asm volatile("s_mov_b32 %0, 0" : "=s"(zz));
          id2.lane = lv; id2.z = zz; id2.tid = id.wave * 64 + lv; ph_att_cache(a, id2, layer); }
    }
    else if constexpr (KIND == K_MIXOUT) {
        pg8::Gemm g{(const bf16*)(a.ws + id.z + A_H), (const bf16*)(a.ws + id.z + ((layer & 1) ? W_WOT : W_WOUTT)), NTOK, D, D}; pg8::StaticOrder S; S.init(NTOK, D, G, bx);
        pg8::EpiF32 E{(float*)(a.ws + id.z + A_M), D};
        pg8::gemm_phase<pg8::EpiF32, pg8::StaticOrder, true, true>(lds + RING_OFF, g, S, E, id.wave);
    }
    else if constexpr (KIND == K_MLP2) {
        pg8::Gemm g{(const bf16*)(a.ws + id.z + A_HID), (const bf16*)(a.ws + id.z + W_W2T), NTOK, D, FF}; pg8::StaticOrder S; S.init(NTOK, D, G, bx);
        pg8::EpiF32 E{(float*)(a.ws + id.z + A_F), D};
        pg8::gemm_phase<pg8::EpiF32, pg8::StaticOrder, true, true>(lds + RING_OFF, g, S, E, id.wave);
    }
    else if constexpr (KIND == K_MLP1) {
        pg8::Gemm g{(const bf16*)(a.ws + id.z + A_H), (const bf16*)(a.ws + id.z + W_W1T), NTOK, FF, D}; pg8::StaticOrder S; S.init(NTOK, FF, G, bx);
        pg8::EpiBf16<2> E{(bf16*)(a.ws + id.z + A_HID), FF, 1 << 20, nullptr, 0};
        pg8::gemm_phase<pg8::EpiBf16<2>, pg8::StaticOrder, true, true>(lds + RING_OFF, g, S, E, id.wave);
    }
    else if constexpr (KIND == K_RKV) {
        {
            pg8::Gemm g{(const bf16*)(a.ws + id.z + A_A2), (const bf16*)(a.ws + id.z + W_BTL), NTOK, 512, KRKV}; pg8::StaticOrder S; S.init(NTOK, 512, G, bx);
            pg8::EpiL1 E{(bf16*)(a.ws + id.z + A_L1)};
            pg8::gemm_phase<pg8::EpiL1, pg8::StaticOrder, true, true>(lds + RING_OFF, g, S, E, id.wave); }
        {
            pg8::Gemm g{(const bf16*)(a.ws + id.z + A_XS), (const bf16*)(a.ws + id.z + W_BTR), 3 * NTOK, 3072, D}; pg8::RkvOrder S{bx};
            pg8::EpiRkv3 E{(bf16*)(a.ws + id.z + A_RKV)};
            pg8::gemm_phase<pg8::EpiRkv3, pg8::RkvOrder, true, true>(lds + RING_OFF, g, S, E, id.wave); }
    }
    else if constexpr (KIND == K_RPREP) {
        constexpr int j = layer >> 1;
        pg8::Gemm g{(const bf16*)(a.ws + id.z + A_L1), (const bf16*)(a.ws + id.z + W_BT2), NTOK, 5120, 384}; pg8::StaticOrder S; S.init(NTOK, 5120, G, bx);
        static_assert(A_A1 - A_A0 == 32 * MiB && A_EW0 - A_A0 == 64 * MiB && A_EW1 - A_A0 == 96 * MiB, "EpiLora2 output stride");
        pg8::EpiLora2 E{(bf16*)(a.ws + id.z + A_A0), (size_t)16 * MiB, (bf16*)(a.ws + id.z + A_G), a.in[23 + id.z] + (size_t)j * 2 * D, a.in[20 + id.z] + (size_t)j * 2 * D};
        pg8::gemm_phase<pg8::EpiLora2, pg8::StaticOrder, true, true>(lds + RING_OFF, g, S, E, id.wave);
        { Ids id2 = id; int lv; asm volatile("v_mbcnt_lo_u32_b32 %0, -1, 0\n\tv_mbcnt_hi_u32_b32 %0, -1, %0" : "=v"(lv)); int zz; asm volatile("s_mov_b32 %0, 0" : "=s"(zz));
          id2.lane = lv; id2.z = zz; id2.tid = id.wave * 64 + lv; ph_rw_prep(a, id2, layer); }
    }
    else if constexpr (KIND == K_ATTN) ph_attn(a, id, lds, G, vcu);
    else if constexpr (KIND == K_ACOMB) ph_att_comb(a, id, layer);
    else if constexpr (KIND == K_RNORM) ph_resid_norm(a, id, layer, rep + 1 < (((PROBE_MASK >> K_RNORM) & 1) ? PROBE_REPS : 1));
    else if constexpr (KIND == K_REND) ph_resid_end(a, id, lds, layer, rep + 1 < (((PROBE_MASK >> K_REND) & 1) ? PROBE_REPS : 1));
    else if constexpr (KIND == K_RMIX) ph_rw_mix(a, id, layer);
    else if constexpr (KIND == K_RSCAN) { if (rep > 0) { ph_rw_prep(a, id, layer); __syncthreads(); cg::this_grid().sync(); } ph_rw_scan(a, id, lds, layer, G, vcu); }
    else if constexpr (KIND == K_RPOST) ph_rw_post(a, id, layer);
}

__global__ void __launch_bounds__(NWAVES * 64, 2) mega_fwd(Args a) {
    extern __shared__ __attribute__((aligned(16))) unsigned char lds_raw[];
    LAS unsigned char* lds = (LAS unsigned char*)lds_raw;
    const int G = gridDim.x, bx = blockIdx.x; const int vcu = (G % 8 == 0) ? (bx % 8) * (G / 8) + bx / 8 : bx;
    volatile LAS unsigned* MISC = (volatile LAS unsigned*)(lds + MISC_OFF);
    for (int u = threadIdx.x; u < (LDS_BYTES - LDSCTL_OFF) / 4; u += NWAVES * 64) ((LAS unsigned*)(lds + LDSCTL_OFF))[u] = 0u;
    __syncthreads();
#if MK_N_LAUNCHES == 1 && !MK_CG_BARRIER
    XcdBarrier bar = xcd_barrier_post((unsigned*)(a.ws + WS_CTL) + CW_BAR, MISC + 8, threadIdx.x == 0);
#endif
    (void)MISC;
    const int lo = a.ph_lo, hi = a.ph_hi;
    const int wave_s = __builtin_amdgcn_readfirstlane(threadIdx.x >> 6);
#if MK_N_LAUNCHES == 1
#if MK_CG_BARRIER
#define GRID_BAR(ph) cg::this_grid().sync()
#else
#define GRID_BAR(ph) do { if ((ph) == 0) cg::this_grid().sync(); else { int l_; asm volatile("v_mbcnt_lo_u32_b32 %0, -1, 0\n\tv_mbcnt_hi_u32_b32 %0, -1, %0" : "=v"(l_)); xcd_barrier(bar, wave_s == 0 && l_ == 0); } } while (0)
#endif
#else
#define GRID_BAR(ph) do { } while (0)
#endif
#define PHASE(ph, KIND, LAYER) do { if (lo <= (ph) && (ph) < hi) { constexpr int nrep_ = ((PROBE_MASK >> (KIND)) & 1) ? PROBE_REPS : 1; \
        _Pragma("unroll 1") for (int rep_ = 0; rep_ < nrep_; ++rep_) { run_phase<KIND, LAYER>(a, lds, G, bx, vcu, wave_s, rep_); if (rep_ + 1 < nrep_) { __syncthreads(); cg::this_grid().sync(); } } \
        if ((ph) + 1 < hi) GRID_BAR(ph); } } while (0)
#define ATTN_LAYER(p0, L) PHASE((p0) + 0, K_QKV, L); PHASE((p0) + 1, K_ATTN, L); PHASE((p0) + 2, K_ACOMB, L); PHASE((p0) + 3, K_MIXOUT, L); \
        PHASE((p0) + 4, K_RNORM, L); PHASE((p0) + 5, K_MLP1, L); PHASE((p0) + 6, K_MLP2, L); PHASE((p0) + 7, K_REND, L)
#define RWKV_LAYER(p0, L) PHASE((p0) + 0, K_RMIX, L); PHASE((p0) + 1, K_RKV, L); PHASE((p0) + 2, K_RPREP, L); PHASE((p0) + 3, K_RSCAN, L); PHASE((p0) + 4, K_RPOST, L); PHASE((p0) + 5, K_MIXOUT, L); \
        PHASE((p0) + 6, K_RNORM, L); PHASE((p0) + 7, K_MLP1, L); PHASE((p0) + 8, K_MLP2, L); PHASE((p0) + 9, K_REND, L)
    PHASE(0, K_PRO, 0); PHASE(1, K_NORM0, 0);
    ATTN_LAYER(2, 0); RWKV_LAYER(10, 1); ATTN_LAYER(20, 2); RWKV_LAYER(28, 3);
#undef PHASE
#undef ATTN_LAYER
#undef RWKV_LAYER
#undef GRID_BAR
}

extern "C" void kernel_launch(void* const* d_in, const int* in_sizes, int n_in, void* d_out, int out_size, void* d_ws, size_t ws_size, hipStream_t stream) {
    static int grid = 0;
    if (grid == 0) {
        if (n_in != 32 || (size_t)out_size != OUT_TOTAL || ws_size < WS_END) { fprintf(stderr, "kernel_launch: unexpected problem (n_in %d, out %d, ws %zu; need ws >= %zu); nothing launched\n", n_in, out_size, ws_size, (size_t)WS_END); grid = -1; return; }
        int dev = 0, cus = 0, per_cu = 0;
        if (hipGetDevice(&dev) != hipSuccess || hipDeviceGetAttribute(&cus, hipDeviceAttributeMultiprocessorCount, dev) != hipSuccess) { grid = -1; return; }
        if (hipFuncSetAttribute((const void*)mega_fwd, hipFuncAttributeMaxDynamicSharedMemorySize, LDS_BYTES) != hipSuccess) { fprintf(stderr, "kernel_launch: hipFuncSetAttribute failed\n"); grid = -1; return; }
        if (hipOccupancyMaxActiveBlocksPerMultiprocessor(&per_cu, (const void*)mega_fwd, NWAVES * 64, LDS_BYTES) != hipSuccess || per_cu < 1) { fprintf(stderr, "kernel_launch: occupancy query failed (%d)\n", per_cu); (void)hipGetLastError(); per_cu = 1; }
        grid = cus * (per_cu < 1 ? 1 : 1);
        fprintf(stderr, "kernel_launch: %d CUs, occupancy %d/CU, grid %d\n", cus, per_cu, grid);
    }
    if (grid < 0) return;
    (void)in_sizes;
    if (hipMemsetAsync((char*)d_ws + WS_CTL, 0, CTL_ZERO_BYTES, stream) != hipSuccess) { fprintf(stderr, "kernel_launch: memset failed\n"); return; }
    Args a{};
    for (int i = 0; i < 32; ++i) a.in[i] = (const float*)d_in[i];
    a.out = (float*)d_out; a.ws = (unsigned char*)d_ws;
#if MK_N_LAUNCHES == 1
    a.ph_lo = 0; a.ph_hi = NPH;
    void* args[] = {&a};
    hipError_t e = hipLaunchCooperativeKernel((const void*)mega_fwd, dim3(grid), dim3(NWAVES * 64), args, LDS_BYTES, stream);
    if (e != hipSuccess) fprintf(stderr, "kernel_launch: cooperative launch failed: %s (grid %d)\n", hipGetErrorString(e), grid);
#else
    for (int ph = 0; ph < NPH; ++ph) {
        a.ph_lo = ph; a.ph_hi = ph + 1;
        hipLaunchKernelGGL(mega_fwd, dim3(grid), dim3(NWAVES * 64), LDS_BYTES, stream, a);
    }
#endif
}
```

```cpp
#include <hip/hip_runtime.h>
#include <hip/hip_cooperative_groups.h>
#include <cstdio>
#include <cstdint>
namespace cg = cooperative_groups;
namespace pg8 {
#define PG8_LAS __attribute__((address_space(3)))
typedef unsigned short bf16_t;
typedef short bf16x8 __attribute__((ext_vector_type(8)));
typedef float f32x4 __attribute__((ext_vector_type(4)));
typedef unsigned u32x4 __attribute__((ext_vector_type(4)));
constexpr int BM = 256, BK = 64, HALF = 128, HTB = HALF * BK * 2  , STAGE_BYTES = 8 * HTB, NXCD = 8, WGM = 8;

__host__ __device__ __forceinline__ int lds_byte(int r, int c) { const int st = (r >> 4) * 2 + (c >> 5), rr = r & 15, cc = c & 31, ob = rr * 64 + cc * 2; return st * 1024 + (ob ^ (((ob >> 9) & 1) << 5)); }
__host__ __device__ __forceinline__ void stage_rc(int b, int& R, int& C) { const int st = b / 1024, sb = b % 1024, swz = sb ^ (((sb >> 9) & 1) << 5); R = (st >> 1) * 16 + swz / 64; C = (st & 1) * 32 + (swz % 64) / 2; }
__host__ __device__ __forceinline__ int perm32(int rho) { const int n = rho >> 4, i = rho & 15; return 8 * (i >> 2) + 4 * n + (i & 3); }

struct Unit { int pm, pn; };
struct Gemm { const bf16_t* A; const bf16_t* Bt; int M, N, K; };

struct StaticOrder {
    int nM, nN, nwg, G, c;
    __host__ __device__ void init(int M, int N, int G_, int c_) { nM = M / BM; nN = N / BM; nwg = nM * nN; G = G_; c = c_; }
    __host__ __device__ bool next(int i, Unit& u) const {
        const long L = (long)i * G + c; if (L >= nwg) return false;
        int wgid = (int)L; { const int q = nwg / NXCD, r = nwg % NXCD, xcd = wgid % NXCD, off = wgid / NXCD; wgid = (xcd < r ? xcd * (q + 1) : r * (q + 1) + (xcd - r) * q) + off; }
        const int nig = WGM * nN, gid = wgid / nig, fm = gid * WGM, gsz = (nM - fm) < WGM ? (nM - fm) : WGM;
        u.pm = fm + ((wgid % nig) % gsz); u.pn = (wgid % nig) / gsz; return true;
    }
    __device__ __forceinline__ void a_ready(const Unit&) const {}
    __device__ __forceinline__ void done(const Unit&) const {}
};


__device__ __forceinline__ unsigned cvt_pk_bf16(float lo, float hi) { unsigned r; asm volatile("v_cvt_pk_bf16_f32 %0, %1, %2" : "=v"(r) : "v"(lo), "v"(hi)); return r; }

struct EpiF32 {
    static constexpr bool PERM = false, AFTER_DRAIN = false;
    float* C; int ldc;
    __device__ __forceinline__ void operator()(const f32x4 (&acc)[2][2][4][2], const Unit& u, int wr, int wc, int fr, int fq) const {
        const int row0 = u.pm * BM + wr * 64 + fr, col0 = u.pn * BM + wc * 32 + 4 * fq;
#pragma unroll
        for (int ai = 0; ai < 2; ++ai)
#pragma unroll
            for (int m = 0; m < 4; ++m) { float* rowp = C + (size_t)(row0 + ai * HALF + m * 16) * ldc + col0;
#pragma unroll
                for (int bj = 0; bj < 2; ++bj)
#pragma unroll
                    for (int n = 0; n < 2; ++n) *(f32x4*)(rowp + bj * HALF + n * 16) = acc[ai][bj][m][n]; }
    }
    __device__ __forceinline__ void fused(f32x4 (&)[2][2][4][2], const Unit&, int, int, int, int, PG8_LAS unsigned char*, int, int) const {}
};

template <int ACT> struct EpiBf16 {
    static constexpr bool PERM = true, AFTER_DRAIN = false;
    bf16_t* O0; int ld0; int nt0; bf16_t* O1; int ld1;
    __device__ __forceinline__ void operator()(const f32x4 (&acc)[2][2][4][2], const Unit& u, int wr, int wc, int fr, int fq) const {
        const int row0 = u.pm * BM + wr * 64 + fr;
        bf16_t* base; int ldc, colt;
        if (u.pn < nt0) { base = O0; ldc = ld0; colt = u.pn * BM; } else { base = O1; ldc = ld1; colt = (u.pn - nt0) * BM; }
        const int col0 = colt + wc * 32 + 8 * fq;
#pragma unroll
        for (int ai = 0; ai < 2; ++ai)
#pragma unroll
            for (int m = 0; m < 4; ++m) { bf16_t* rowp = base + (size_t)(row0 + ai * HALF + m * 16) * ldc + col0;
#pragma unroll
                for (int bj = 0; bj < 2; ++bj) { f32x4 v0 = acc[ai][bj][m][0], v1 = acc[ai][bj][m][1];
                    if (ACT == 2) {
#pragma unroll
                        for (int e = 0; e < 4; ++e) { float a = v0[e] > 0.f ? v0[e] : 0.f; v0[e] = a * a; float b = v1[e] > 0.f ? v1[e] : 0.f; v1[e] = b * b; } }
                    u32x4 w; w.x = cvt_pk_bf16(v0[0], v0[1]); w.y = cvt_pk_bf16(v0[2], v0[3]); w.z = cvt_pk_bf16(v1[0], v1[1]); w.w = cvt_pk_bf16(v1[2], v1[3]);
                    *(u32x4*)(rowp + bj * HALF) = w; } }
    }
    __device__ __forceinline__ void fused(f32x4 (&)[2][2][4][2], const Unit&, int, int, int, int, PG8_LAS unsigned char*, int, int) const {}
};


__device__ __forceinline__ float sig_f(float x) { return 1.0f / (1.0f + __expf(-x)); }
struct RkvOrder {
    int c;
    __device__ __forceinline__ bool next(int i, Unit& u) const {
        int L; if (c < 128) { if (i >= 2) return false; L = c * 2 + i; } else { if (i >= 4) return false; L = 256 + (c - 128) * 4 + i; }
        const int which = L >> 8, r = L & 255; u.pm = which * 64 + (r >> 2); u.pn = which * 4 + (r & 3); return true; }
    __device__ __forceinline__ void a_ready(const Unit&) const {}
    __device__ __forceinline__ void done(const Unit&) const {}
};
struct EpiRkv3 {
    static constexpr bool PERM = true, AFTER_DRAIN = false;
    bf16_t* RKV;
    __device__ __forceinline__ void operator()(const f32x4 (&acc)[2][2][4][2], const Unit& u, int wr, int wc, int fr, int fq) const {
        const int row0 = (u.pm & 63) * BM + wr * 64 + fr, col0 = u.pn * BM + wc * 32 + 8 * fq;
#pragma unroll
        for (int ai = 0; ai < 2; ++ai)
#pragma unroll
            for (int m = 0; m < 4; ++m) { bf16_t* rowp = RKV + (size_t)(row0 + ai * HALF + m * 16) * 3072 + col0;
#pragma unroll
                for (int bj = 0; bj < 2; ++bj) { const f32x4 v0 = acc[ai][bj][m][0], v1 = acc[ai][bj][m][1];
                    u32x4 w; w.x = cvt_pk_bf16(v0[0], v0[1]); w.y = cvt_pk_bf16(v0[2], v0[3]); w.z = cvt_pk_bf16(v1[0], v1[1]); w.w = cvt_pk_bf16(v1[2], v1[3]);
                    *(u32x4*)(rowp + bj * HALF) = w; } }
    }
};
struct EpiL1 {
    static constexpr bool PERM = true, AFTER_DRAIN = false;
    bf16_t* L1;
    __device__ __forceinline__ void operator()(const f32x4 (&acc)[2][2][4][2], const Unit& u, int wr, int wc, int fr, int fq) const {
        const int row0 = u.pm * BM + wr * 64 + fr, colt = u.pn * BM, col0 = colt + wc * 32 + 8 * fq;
#pragma unroll
        for (int ai = 0; ai < 2; ++ai)
#pragma unroll
            for (int m = 0; m < 4; ++m) { bf16_t* rowp = L1 + (size_t)(row0 + ai * HALF + m * 16) * 384 + col0;
#pragma unroll
                for (int bj = 0; bj < 2; ++bj) { f32x4 v0 = acc[ai][bj][m][0], v1 = acc[ai][bj][m][1];
                    const int cb = colt + bj * HALF;
                    if (cb >= 384) continue;
                    if (cb == 0) {
#pragma unroll
                        for (int e = 0; e < 4; ++e) { v0[e] = 1.0f - 2.0f / (1.0f + __expf(2.0f * v0[e])); v1[e] = 1.0f - 2.0f / (1.0f + __expf(2.0f * v1[e])); } }
                    else if (cb == 256) {
#pragma unroll
                        for (int e = 0; e < 4; ++e) { v0[e] = sig_f(v0[e]); v1[e] = sig_f(v1[e]); } }
                    u32x4 w; w.x = cvt_pk_bf16(v0[0], v0[1]); w.y = cvt_pk_bf16(v0[2], v0[3]); w.z = cvt_pk_bf16(v1[0], v1[1]); w.w = cvt_pk_bf16(v1[2], v1[3]);
                    *(u32x4*)(rowp + bj * HALF) = w; } }
    }
};
struct EpiLora2 {
    static constexpr bool PERM = true, AFTER_DRAIN = false;
    bf16_t* o4; size_t ostride; bf16_t* og; const float* a0; const float* w0;
    __device__ __forceinline__ void operator()(const f32x4 (&acc)[2][2][4][2], const Unit& u, int wr, int wc, int fr, int fq) const {
        const int row0 = u.pm * BM + wr * 64 + fr; const int blk = u.pn >> 2, colt = (u.pn & 3) * BM;
        bf16_t* base = (blk < 4) ? o4 + (size_t)blk * ostride : og;
        const float* bs = ((blk < 2) ? a0 : w0) + (blk & 1) * 1024;
        const int col0 = colt + wc * 32 + 8 * fq;
        const float sc = (blk >= 2) ? 0.8750387749719753f : 1.0f;
#pragma unroll
        for (int bj = 0; bj < 2; ++bj) {
            f32x4 b0 = (f32x4){0.f, 0.f, 0.f, 0.f}, b1 = b0;
            if (blk < 4) { b0 = *(const f32x4*)(bs + col0 + bj * HALF); b1 = *(const f32x4*)(bs + col0 + bj * HALF + 4); }
#pragma unroll
            for (int ai = 0; ai < 2; ++ai)
#pragma unroll
                for (int m = 0; m < 4; ++m) { bf16_t* rowp = base + (size_t)(row0 + ai * HALF + m * 16) * 1024 + col0;
                    f32x4 v0 = acc[ai][bj][m][0] + b0, v1 = acc[ai][bj][m][1] + b1;
                    if (blk < 4) {
#pragma unroll
                        for (int e = 0; e < 4; ++e) { v0[e] = sc * sig_f(v0[e]); v1[e] = sc * sig_f(v1[e]); } }
                    u32x4 w; w.x = cvt_pk_bf16(v0[0], v0[1]); w.y = cvt_pk_bf16(v0[2], v0[3]); w.z = cvt_pk_bf16(v1[0], v1[1]); w.w = cvt_pk_bf16(v1[2], v1[3]);
                    *(u32x4*)(rowp + bj * HALF) = w; } }
    }
};


template <class MP> struct EpiQkv {
    static constexpr bool PERM = true, AFTER_DRAIN = false;
    unsigned char* ws; float* out; const float* gain; const float* RC; const float* RS; int j;
    static constexpr size_t oQA = MP::oQA, oQB = MP::oQB, oKAP = MP::oKAP, oVAP = MP::oVAP, oKBP = MP::oKBP, oVBP = MP::oVBP, oKAS = MP::oKAS, oVAS = MP::oVAS, oKBS = MP::oKBS, oVBS = MP::oVBS;
    static constexpr size_t oKG = MP::oKG, oVG = MP::oVG, oKD = MP::oKD, oVD = MP::oVD;
    __device__ __forceinline__ void operator()(const f32x4 (&acc)[2][2][4][2], const Unit& u, int wr, int wc, int fr, int fq) const {
        const int ch = 4 * u.pn + wc; const bool smp = u.pm >= 32;
        const bool isq = (ch < 8) || (ch >= 12 && ch < 20), isk = (ch == 8 || ch == 9) || (ch >= 20 && ch < 28);
        const int dl = 8 * fq;
        const bool hi2 = (fq & 2) != 0;
        f32x4 g[2][2];
#pragma unroll
        for (int bj = 0; bj < 2; ++bj)
#pragma unroll
            for (int n = 0; n < 2; ++n) g[bj][n] = (ch < 10) ? *(const f32x4*)(gain + (ch < 8 ? 0 : 64) + bj * 32 + dl + 4 * n) : (f32x4){1.f, 1.f, 1.f, 1.f};
        constexpr float QS = 0.18033688011112042f;
#pragma unroll
        for (int ai = 0; ai < 2; ++ai)
#pragma unroll
            for (int m = 0; m < 4; ++m) {
                const int mrow = u.pm * BM + ai * HALF + wr * 64 + m * 16 + fr;
                const int b = smp ? ((mrow - 8192) >> 11) : (mrow >> 8), t = smp ? ((mrow - 8192) & 2047) : (mrow & 255);
                f32x4 v[2][2];
#pragma unroll
                for (int bj = 0; bj < 2; ++bj)
#pragma unroll
                    for (int n = 0; n < 2; ++n) v[bj][n] = acc[ai][bj][m][n];
                if (ch < 10) { float ss = 0.f;
#pragma unroll
                    for (int bj = 0; bj < 2; ++bj)
#pragma unroll
                        for (int n = 0; n < 2; ++n) ss += (v[bj][n][0] * v[bj][n][0] + v[bj][n][1] * v[bj][n][1]) + (v[bj][n][2] * v[bj][n][2] + v[bj][n][3] * v[bj][n][3]);
                    ss += __shfl_xor(ss, 16); ss += __shfl_xor(ss, 32);
                    const float ri = 1.0f / sqrtf(ss * (1.0f / 64.0f) + 1e-6f);
#pragma unroll
                    for (int bj = 0; bj < 2; ++bj)
#pragma unroll
                        for (int n = 0; n < 2; ++n) v[bj][n] = v[bj][n] * ri * g[bj][n]; }
                f32x4 vr[2][2];
#pragma unroll
                for (int bj = 0; bj < 2; ++bj)
#pragma unroll
                    for (int n = 0; n < 2; ++n) { vr[bj][n] = v[bj][n];
                        if (smp && (isq || isk)) { f32x4 p; p[0] = __shfl_xor(v[bj][n][0], 32); p[1] = __shfl_xor(v[bj][n][1], 32); p[2] = __shfl_xor(v[bj][n][2], 32); p[3] = __shfl_xor(v[bj][n][3], 32);
                            const f32x4 cs = *(const f32x4*)(RC + t * 64 + bj * 32 + dl + 4 * n), sn = *(const f32x4*)(RS + t * 64 + bj * 32 + dl + 4 * n);
                            const f32x4 rot = hi2 ? p : -p; vr[bj][n] = v[bj][n] * cs + rot * sn; } }
#define EQ_PK8(x0, x1) ((u32x4){cvt_pk_bf16((x0)[0], (x0)[1]), cvt_pk_bf16((x0)[2], (x0)[3]), cvt_pk_bf16((x1)[0], (x1)[1]), cvt_pk_bf16((x1)[2], (x1)[3])})
                const size_t srow = (size_t)(b * 2560 + 512 + t), prow = (size_t)((b * 2 + j) * 256 + t);
#pragma unroll
                for (int bj = 0; bj < 2; ++bj) {
                    const int f0 = bj * 32 + dl;
                    if (isq) { const f32x4 s0 = vr[bj][0] * QS, s1 = vr[bj][1] * QS; const size_t o = (ch < 8) ? oQA + ((size_t)mrow * 512 + ch * 64 + f0) * 2 : oQB + ((size_t)mrow * 512 + (ch - 12) * 64 + f0) * 2;
                        *(u32x4*)(ws + o) = EQ_PK8(s0, s1); }
                    else {
                        const bool gq = ch < 12, kk = isk;
                        const int e = gq ? ((ch & 1) * 64 + f0) : ((ch - (kk ? 20 : 28)) * 64 + f0); const int wdt = gq ? 128 : 512;
                        if (!smp) { const size_t of = (gq ? (kk ? oKG : oVG) : (kk ? oKD : oVD)) + prow * wdt + e; *(f32x4*)(out + of) = v[bj][0]; *(f32x4*)(out + of + 4) = v[bj][1];
                            const size_t o = (gq ? (kk ? oKAP : oVAP) : (kk ? oKBP : oVBP)) + ((size_t)mrow * wdt + e) * 2; *(u32x4*)(ws + o) = EQ_PK8(v[bj][0], v[bj][1]); }
                        else { const size_t o = (gq ? (kk ? oKAS : oVAS) : (kk ? oKBS : oVBS)) + (srow * wdt + e) * 2; *(u32x4*)(ws + o) = EQ_PK8(vr[bj][0], vr[bj][1]); } }
                }
#undef EQ_PK8
            }
    }
};

template <class Epi, class Sched, bool ALIGN_EPI = false, bool SP2 = false>
__device__ __forceinline__ void gemm_phase(PG8_LAS unsigned char* lds, const Gemm g, const Sched& S, const Epi& E, const int wave_index) {
    int lane_o; asm volatile("v_mbcnt_lo_u32_b32 %0, -1, 0\n\tv_mbcnt_hi_u32_b32 %0, -1, %0" : "=v"(lane_o));
    const int wid = wave_index, lane = lane_o, tid = wid * 64 + lane, wr = wid >> 2, wc = wid & 3, fr = lane & 15, fq = lane >> 4;
    const int K = g.K, nt = K / BK;
    unsigned voffA[2], voffB[2];
#pragma unroll
    for (int i = 0; i < 2; ++i) { int R, C; stage_rc(tid * 16 + i * 8192, R, C); const int Rb = Epi::PERM ? ((R & ~31) + perm32(R & 31)) : R;
        voffA[i] = (unsigned)(R * K + C) * 2u; voffB[i] = (unsigned)(Rb * K + C) * 2u; }
    const size_t kstep = (size_t)(BK * 2);
    const size_t hstep = (size_t)HALF * K * 2;
    const size_t tstep = 2 * hstep;
    const unsigned ldsw = (unsigned)wid * 1024u;
    const int aoff = lds_byte(wr * 64 + fr, fq * 8), boff = lds_byte(wc * 32 + fr, fq * 8);
#define PG8_SA(b, h) (((b) * 2 + (h)) * HTB)
#define PG8_SB(b, h) ((4 + (b) * 2 + (h)) * HTB)
#define PG8_STAGE(bufoff, gbase, voff) do { _Pragma("unroll") for (int _i = 0; _i < 2; ++_i) \
        __builtin_amdgcn_global_load_lds((const unsigned*)((const char*)(gbase) + (voff)[_i]), (PG8_LAS unsigned*)(lds + (bufoff) + ldsw + _i * 8192), 16, 0, 0); } while (0)
#define PG8_LDA(dst, b, h) do { _Pragma("unroll") for (int m = 0; m < 4; ++m) _Pragma("unroll") for (int k = 0; k < 2; ++k) dst[m][k] = *(const PG8_LAS bf16x8*)(lds + PG8_SA(b, h) + aoff + m * 2048 + k * 1024); } while (0)
#define PG8_LDB(dst, b, h) do { _Pragma("unroll") for (int n = 0; n < 2; ++n) _Pragma("unroll") for (int k = 0; k < 2; ++k) dst[n][k] = *(const PG8_LAS bf16x8*)(lds + PG8_SB(b, h) + boff + n * 2048 + k * 1024); } while (0)
#define PG8_MMA(ai, bj, At, Bt) do { __builtin_amdgcn_s_setprio(1); _Pragma("unroll") for (int m = 0; m < 4; ++m) _Pragma("unroll") for (int n = 0; n < 2; ++n) _Pragma("unroll") for (int k = 0; k < 2; ++k) \
        acc[ai][bj][m][n] = __builtin_amdgcn_mfma_f32_16x16x32_bf16(Bt[n][k], At[m][k], acc[ai][bj][m][n], 0, 0, 0); __builtin_amdgcn_s_setprio(0); } while (0)
#define PG8_WAIT_V(n) asm volatile("s_waitcnt vmcnt(" #n ")" ::: "memory")
#define PG8_WAIT_L(n) asm volatile("s_waitcnt lgkmcnt(" #n ")" ::: "memory")
#define PG8_BAR __builtin_amdgcn_s_barrier()
#define PG8_SCHED __builtin_amdgcn_sched_barrier(0)
    Unit cur, nxt; int ui = 0;
    if (!S.next(0, cur)) return;
    f32x4 acc[2][2][4][2];
#pragma unroll
    for (int a = 0; a < 2; ++a)
#pragma unroll
        for (int b = 0; b < 2; ++b)
#pragma unroll
            for (int m = 0; m < 4; ++m)
#pragma unroll
                for (int n = 0; n < 2; ++n) acc[a][b][m][n] = (f32x4){0.f, 0.f, 0.f, 0.f};
    bf16x8 At[4][2], B0[2][2], B1[2][2];
    const char* cA = (const char*)g.A + (size_t)cur.pm * tstep; const char* cB = (const char*)g.Bt + (size_t)cur.pn * tstep;
    S.a_ready(cur);
    if constexpr (SP2) {
        PG8_STAGE(PG8_SB(0, 0), cB, voffB); PG8_STAGE(PG8_SB(0, 1), cB + hstep, voffB); PG8_STAGE(PG8_SA(0, 0), cA, voffA); PG8_STAGE(PG8_SA(0, 1), cA + hstep, voffA);
        if (wr == 1) PG8_BAR;
        PG8_WAIT_V(2); PG8_BAR;
        PG8_STAGE(PG8_SB(1, 0), cB + kstep, voffB); PG8_STAGE(PG8_SA(1, 0), cA + kstep, voffA); PG8_STAGE(PG8_SB(1, 1), cB + hstep + kstep, voffB);
        PG8_WAIT_V(6); PG8_BAR;
    } else {
        PG8_STAGE(PG8_SB(0, 0), cB, voffB); PG8_STAGE(PG8_SA(0, 0), cA, voffA); PG8_STAGE(PG8_SB(0, 1), cB + hstep, voffB); PG8_STAGE(PG8_SA(0, 1), cA + hstep, voffA);
        if (wr == 1) PG8_BAR;
        PG8_WAIT_V(4); PG8_BAR;
        PG8_STAGE(PG8_SB(1, 0), cB + kstep, voffB); PG8_STAGE(PG8_SA(1, 0), cA + kstep, voffA); PG8_STAGE(PG8_SB(1, 1), cB + hstep + kstep, voffB);
        PG8_WAIT_V(6); PG8_BAR;
    }
    for (;;) {
        const bool has_next = S.next(ui + 1, nxt);
        const char* nA = has_next ? (const char*)g.A + (size_t)nxt.pm * tstep : cA; const char* nB = has_next ? (const char*)g.Bt + (size_t)nxt.pn * tstep : cB;
#pragma unroll 1
        for (int t = 0; t < nt; t += 2) {
            const bool last = (t == nt - 2);
            const char* a1 = cA + (size_t)(t + 1) * kstep;
            const char* a2 = last ? nA : cA + (size_t)(t + 2) * kstep; const char* b2 = last ? nB : cB + (size_t)(t + 2) * kstep;
            const char* a3 = a2 + kstep; const char* b3 = b2 + kstep;
            if (last && has_next) S.a_ready(nxt);
            if constexpr (SP2) {
            PG8_LDB(B0, 0, 0); PG8_LDB(B1, 0, 1); PG8_SCHED; PG8_LDA(At, 0, 0); PG8_STAGE(PG8_SA(1, 1), a1 + hstep, voffA);
            PG8_WAIT_V(8); PG8_WAIT_L(0); PG8_BAR; PG8_MMA(0, 0, At, B0); PG8_MMA(0, 1, At, B1); PG8_BAR; PG8_SCHED;
            PG8_LDA(At, 0, 1); PG8_STAGE(PG8_SB(0, 0), b2, voffB); PG8_STAGE(PG8_SB(0, 1), b2 + hstep, voffB); PG8_STAGE(PG8_SA(0, 0), a2, voffA);
            PG8_WAIT_V(8); PG8_WAIT_L(0); PG8_BAR; PG8_MMA(1, 0, At, B0); PG8_MMA(1, 1, At, B1); PG8_BAR; PG8_SCHED;
            PG8_LDB(B0, 1, 0); PG8_LDB(B1, 1, 1); PG8_SCHED; PG8_LDA(At, 1, 0); PG8_STAGE(PG8_SA(0, 1), a2 + hstep, voffA);
            PG8_WAIT_V(8); PG8_WAIT_L(0); PG8_BAR; PG8_MMA(0, 0, At, B0); PG8_MMA(0, 1, At, B1); PG8_BAR; PG8_SCHED;
            PG8_LDA(At, 1, 1); PG8_STAGE(PG8_SB(1, 0), b3, voffB); PG8_STAGE(PG8_SB(1, 1), b3 + hstep, voffB); PG8_STAGE(PG8_SA(1, 0), a3, voffA);
            PG8_WAIT_V(8); PG8_WAIT_L(0); PG8_BAR; PG8_MMA(1, 0, At, B0); PG8_MMA(1, 1, At, B1); PG8_BAR; PG8_SCHED;
            } else {
            PG8_LDB(B0, 0, 0); PG8_SCHED; PG8_LDA(At, 0, 0); PG8_STAGE(PG8_SA(1, 1), a1 + hstep, voffA);
            PG8_WAIT_L(8); PG8_BAR; PG8_WAIT_L(0); PG8_MMA(0, 0, At, B0); PG8_BAR; PG8_SCHED;
            PG8_LDB(B1, 0, 1); PG8_STAGE(PG8_SB(0, 0), b2, voffB);
            PG8_BAR; PG8_WAIT_L(0); PG8_MMA(0, 1, At, B1); PG8_BAR;
            PG8_LDA(At, 0, 1); PG8_STAGE(PG8_SA(0, 0), a2, voffA);
            PG8_BAR; PG8_WAIT_L(0); PG8_MMA(1, 0, At, B0); PG8_BAR; PG8_SCHED;
            PG8_STAGE(PG8_SB(0, 1), b2 + hstep, voffB);
            PG8_WAIT_V(6); PG8_BAR; PG8_MMA(1, 1, At, B1); PG8_BAR;
            PG8_LDB(B0, 1, 0); PG8_SCHED; PG8_LDA(At, 1, 0); PG8_STAGE(PG8_SA(0, 1), a2 + hstep, voffA);
            PG8_WAIT_L(8); PG8_BAR; PG8_WAIT_L(0); PG8_MMA(0, 0, At, B0); PG8_BAR; PG8_SCHED;
            PG8_LDB(B1, 1, 1); PG8_STAGE(PG8_SB(1, 0), b3, voffB);
            PG8_BAR; PG8_WAIT_L(0); PG8_MMA(0, 1, At, B1); PG8_BAR;
            PG8_LDA(At, 1, 1); PG8_STAGE(PG8_SA(1, 0), a3, voffA);
            PG8_BAR; PG8_WAIT_L(0); PG8_MMA(1, 0, At, B0); PG8_BAR; PG8_SCHED;
            PG8_STAGE(PG8_SB(1, 1), b3 + hstep, voffB);
            PG8_WAIT_V(6); PG8_BAR; PG8_MMA(1, 1, At, B1); PG8_BAR;
            }
        }
        if constexpr (ALIGN_EPI) { if (wr == 0) PG8_BAR; }
        if constexpr (!Epi::AFTER_DRAIN) { E(acc, cur, wr, wc, fr, fq); S.done(cur); }
        if (!has_next) break;
#pragma unroll
        for (int a = 0; a < 2; ++a)
#pragma unroll
            for (int b = 0; b < 2; ++b)
#pragma unroll
                for (int m = 0; m < 4; ++m)
#pragma unroll
                    for (int n = 0; n < 2; ++n) acc[a][b][m][n] = (f32x4){0.f, 0.f, 0.f, 0.f};
        cur = nxt; cA = nA; cB = nB; ++ui;
        if constexpr (ALIGN_EPI) { if (wr == 1) PG8_BAR; }
    }
    PG8_WAIT_V(0);
    if constexpr (!ALIGN_EPI) { if (wr == 0) PG8_BAR; }
    PG8_BAR;
    if constexpr (Epi::AFTER_DRAIN) { E.fused(acc, cur, wr, wc, fr, fq, lds, wid, lane); S.done(cur); }
#undef PG8_SA
#undef PG8_SB
#undef PG8_STAGE
#undef PG8_LDA
#undef PG8_LDB
#undef PG8_MMA
#undef PG8_WAIT_V
#undef PG8_WAIT_L
#undef PG8_BAR
#undef PG8_SCHED
}
}

#define GAS __attribute__((address_space(1)))
#define LAS __attribute__((address_space(3)))
typedef unsigned short bf16;
typedef unsigned v4u __attribute__((ext_vector_type(4)));
typedef unsigned v2u __attribute__((ext_vector_type(2)));
typedef float f32x4 __attribute__((ext_vector_type(4)));
#define LDS_WAIT() asm volatile("s_waitcnt lgkmcnt(0)" ::: "memory")

#ifndef MK_N_LAUNCHES
#define MK_N_LAUNCHES 1
#endif
#ifndef MK_CG_BARRIER
#define MK_CG_BARRIER 0
#endif

constexpr int D = 1024, NTOK = 16384, NPR = 8192, TP = 256, TS = 2048, PAST = 512, SKV = 2560, FF = 4096, DEPTH = 4;
constexpr int NQKV = 2304, NRKV = 3584, KRKV = 2048;
constexpr int NWAVES = 8;
constexpr size_t O_X = 0, O_KG = 16777216, O_VG = 18874368, O_KD = 20971520, O_VD = 29360128, O_ST = 37748736, OUT_TOTAL = 46137344;
constexpr size_t MiB = 1u << 20;
constexpr size_t WS_CTL = 0, CTL_ZERO_BYTES = 1 * MiB;
constexpr size_t WS_MOD = 65536;
constexpr size_t WS_ROPE = 1 * MiB;
constexpr size_t WS_INV = 2 * MiB;
constexpr size_t WS_W = 4 * MiB;
constexpr size_t W_W1T = WS_W, W_W2T = WS_W + 8 * MiB, W_MIX = WS_W + 16 * MiB;
constexpr size_t W_WINT = W_MIX, W_WOUTT = W_MIX + 6 * MiB;
constexpr size_t W_BTR = W_MIX, W_BTL = W_MIX + 6 * MiB, W_WOT = W_MIX + 14 * MiB, W_BT2 = W_MIX + 16 * MiB;
constexpr size_t AR = 40 * MiB;
constexpr size_t A_H = AR;
constexpr size_t A_QKVRAW = AR + 32 * MiB;
constexpr size_t A_DT = AR + 32 * MiB;
constexpr size_t A_M = AR + 96 * MiB;
constexpr size_t A_QA = AR + 176 * MiB, A_QB = AR + 192 * MiB, A_KAP = AR + 208 * MiB, A_VAP = AR + 210 * MiB, A_KBP = AR + 212 * MiB, A_VBP = AR + 220 * MiB;
constexpr size_t A_KAS = AR + 228 * MiB, A_VAS = AR + 231 * MiB, A_KBS = AR + 234 * MiB, A_VBS = AR + 244 * MiB;
constexpr size_t A_HID = AR + 32 * MiB;
constexpr size_t A_F = AR + 160 * MiB;
constexpr size_t A_A2 = AR + 32 * MiB;
constexpr size_t A_XS = AR + 208 * MiB;
constexpr size_t A_Y = AR + 32 * MiB;
constexpr size_t A_RKV = AR + 96 * MiB;
constexpr size_t A_L1 = AR + 192 * MiB;
constexpr size_t A_G = A_H;
constexpr size_t A_A0 = AR + 208 * MiB, A_A1 = AR + 240 * MiB, A_EW0 = AR + 272 * MiB, A_EW1 = AR + 304 * MiB;
constexpr size_t WS_END = AR + 336 * MiB;
struct QkvMap { static constexpr size_t oQA = A_QA, oQB = A_QB, oKAP = A_KAP, oVAP = A_VAP, oKBP = A_KBP, oVBP = A_VBP, oKAS = A_KAS, oVAS = A_VAS, oKBS = A_KBS, oVBS = A_VBS, oKG = O_KG, oVG = O_VG, oKD = O_KD, oVD = O_VD; };
constexpr int CW_BAR = 4096;

constexpr int RING_OFF = 0, RING_BYTES = 131072;
constexpr int LDSCTL_OFF = RING_BYTES, MISC_OFF = LDSCTL_OFF + 320;
constexpr int LDS_BYTES = 147456;

typedef float f32x2_t __attribute__((ext_vector_type(2))); typedef __bf16 bf16x2_t __attribute__((ext_vector_type(2)));
__device__ __forceinline__ unsigned pk2(float lo, float hi) { const f32x2_t v = {lo, hi}; return __builtin_bit_cast(unsigned, __builtin_convertvector(v, bf16x2_t)); }
__device__ __forceinline__ unsigned f2bf(float f) { return pk2(f, 0.f) & 0xffffu; }
__device__ __forceinline__ float bf2f(unsigned short h) { return __builtin_bit_cast(float, (unsigned)h << 16); }
__device__ __forceinline__ float bflo(unsigned w) { return __builtin_bit_cast(float, w << 16); }
__device__ __forceinline__ float bfhi(unsigned w) { return __builtin_bit_cast(float, w & 0xffff0000u); }
__device__ __forceinline__ float wave_sum(float v) {
#pragma unroll
    for (int o = 1; o < 64; o <<= 1) v += __shfl_xor(v, o);
    return v;
}
__device__ __forceinline__ float sigmoidf_(float x) { return 1.0f / (1.0f + __expf(-x)); }
__device__ __forceinline__ float rdl(float x, int l) { return __builtin_bit_cast(float, __builtin_amdgcn_readlane(__builtin_bit_cast(int, x), l)); }

#define XB_TMO      128
#define XB_XCNT(j)  (256  + 64 * (j))
#define XB_XSUB(j)  (1280 + 64 * (j))
#define XB_XGEN(j)  (2304 + 64 * (j))
#define XB_TOP      3328
#define XB_TOPGEN   3392
#define XCD_BAR_WORDS 3456
#define XB_SPIN_CAP (1u << 18)

__device__ __forceinline__ unsigned xb_ld(unsigned* p)              { return __hip_atomic_load(p, __ATOMIC_RELAXED, __HIP_MEMORY_SCOPE_AGENT); }
__device__ __forceinline__ unsigned xb_add(unsigned* p, unsigned v) { return __hip_atomic_fetch_add(p, v, __ATOMIC_RELAXED, __HIP_MEMORY_SCOPE_AGENT); }
__device__ __forceinline__ unsigned xb_xcc_id() { return (unsigned)__builtin_amdgcn_s_getreg((3 << 11) | 20) & 0xFu; }
#define XB_SPIN(cond, bar) do { unsigned _sp = 0; while (cond) { __builtin_amdgcn_s_sleep(1); \
    if ((++_sp & 255u) == 0u) { if (xb_ld(&(bar)[XB_TMO])) break; if (_sp > XB_SPIN_CAP) { atomicAdd(&(bar)[XB_TMO], 1u); break; } } } } while (0)

struct XcdBarrier {
    unsigned* bar; unsigned x;
    volatile LAS unsigned* st;
};

__device__ __forceinline__ XcdBarrier xcd_barrier_post(unsigned* bar, volatile LAS unsigned* st, bool leader) {
    XcdBarrier b; b.bar = bar; b.x = xb_xcc_id(); b.st = st;
    if (leader) (void)xb_add(&bar[XB_XCNT(b.x)], 1u);
    return b;
}
__device__ __forceinline__ void xcd_barrier_complete(unsigned* bar, unsigned x, unsigned& nloc, unsigned& nx) {
    const unsigned G = gridDim.x * gridDim.y * gridDim.z;
    unsigned sum, cnt, mine, sp = 0u;
    for (;;) {
        sum = 0u; cnt = 0u; mine = 0u;
#pragma unroll
        for (unsigned j = 0; j < 16; ++j) { const unsigned c = xb_ld(&bar[XB_XCNT(j)]); sum += c; cnt += (c > 0u) ? 1u : 0u; mine = (j == x) ? c : mine; }
        if (sum == G) break;
        __builtin_amdgcn_s_sleep(1);
        if ((++sp & 255u) == 0u) { if (xb_ld(&bar[XB_TMO])) break; if (sp > XB_SPIN_CAP) { atomicAdd(&bar[XB_TMO], 1u); break; } }
    }
    nloc = mine > 0u ? mine : 1u; nx = cnt > 0u ? cnt : 1u;
}

__device__ __forceinline__ void xcd_barrier(const XcdBarrier& b, bool leader) {
    asm volatile("s_waitcnt vmcnt(0)" ::: "memory");
    __syncthreads();
    if (leader) {
        unsigned* bar = b.bar;
        __builtin_amdgcn_s_waitcnt(0);
        unsigned nloc = b.st[0], nx = b.st[1];
        if (nloc == 0u) { xcd_barrier_complete(bar, b.x, nloc, nx); b.st[0] = nloc; b.st[1] = nx; }
        const unsigned old = xb_add(&bar[XB_XSUB(b.x)], 1u);
        const unsigned gen = old / nloc;
        if (old + 1u == (gen + 1u) * nloc) {
            __builtin_amdgcn_fence(__ATOMIC_RELEASE, "agent");
            asm volatile("s_waitcnt vmcnt(0)" ::: "memory");
            const unsigned og = xb_add(&bar[XB_TOP], 1u);
            const unsigned tg = og / nx;
            if (og + 1u == (tg + 1u) * nx) xb_add(&bar[XB_TOPGEN], 1u);
            else XB_SPIN(xb_ld(&bar[XB_TOPGEN]) == tg, bar);
            __builtin_amdgcn_fence(__ATOMIC_ACQUIRE, "agent");
            xb_add(&bar[XB_XGEN(b.x)], 1u);
            asm volatile("s_waitcnt vmcnt(0)" ::: "memory");
        } else {
            XB_SPIN(xb_ld(&bar[XB_XGEN(b.x)]) == gen, bar);
            __builtin_amdgcn_fence(__ATOMIC_ACQUIRE, "agent");
            asm volatile("s_waitcnt vmcnt(0)" ::: "memory");
        }
    }
    __syncthreads();
}

struct Args { const float* in[32]; float* out; unsigned char* ws; int ph_lo, ph_hi; };
struct Ids { int tid, lane, wave, gw, ngw, z; };

__device__ __forceinline__ int cond_of(int m) { return m < NPR ? 4 : ((m - NPR) >> 11); }
__device__ __forceinline__ const float* mod_ptr_(const Args& a, const Ids& id, int cond, int layer) { return (const float*)(a.ws + id.z + WS_MOD) + (size_t)(cond * 4 + layer) * 6144; }

__device__ __forceinline__ void tr_item(const float* W, int ldw, int col0, const float* scale, bf16* WT, int ldt, int drow0, int dcol0, LAS float* scr, int kb, int nb, int lane, int dnb = -1) {
    const int k0 = 64 * kb, n0 = 32 * nb, dn0 = 32 * (dnb < 0 ? nb : dnb);
#pragma unroll 8
    for (int i = 0; i < 32; ++i) { const int kk = 2 * i + (lane >> 5); float v = W[(size_t)(k0 + kk) * ldw + col0 + n0 + (lane & 31)]; if (scale) v *= scale[k0 + kk]; scr[kk * 33 + (lane & 31)] = v; }
    LDS_WAIT(); asm volatile("" ::: "memory");
    const int c = lane & 7;
#pragma unroll
    for (int j = 0; j < 4; ++j) { const int n = (lane >> 3) + 8 * j; const LAS float* s = scr + (8 * c) * 33 + n;
        v4u o; o.x = pk2(s[0 * 33], s[1 * 33]); o.y = pk2(s[2 * 33], s[3 * 33]); o.z = pk2(s[4 * 33], s[5 * 33]); o.w = pk2(s[6 * 33], s[7 * 33]);
        *(v4u*)(WT + (size_t)(drow0 + dn0 + n) * ldt + dcol0 + k0 + 8 * c) = o; }
    LDS_WAIT(); asm volatile("" ::: "memory");
}
__device__ __forceinline__ bool tr_matrix(int& r, const float* W, int K, int N, bf16* WT, LAS float* scr, int lane) {
    const int nblk = N / 32, items = (K / 64) * nblk;
    if (r < items) { tr_item(W, N, 0, nullptr, WT, K, 0, 0, scr, r / nblk, r % nblk, lane); return true; }
    r -= items; return false;
}
__device__ __forceinline__ bool tr_rwproj(int& r, const float* W, int ncols, const float* mu, bf16* BT1, int drow0, LAS float* scr, int lane) {
    const int nblk = ncols / 32, items = 16 * nblk * 2;
    if (r < items) { const int half = r / (16 * nblk), q = r % (16 * nblk); tr_item(W, ncols, 0, half ? mu : nullptr, BT1, KRKV, drow0, half * 1024, scr, q / nblk, q % nblk, lane); return true; }
    r -= items; return false;
}
__device__ __forceinline__ void conv_weights(const Args& a, const Ids& id, LAS unsigned char* lds, int layer) {
    LAS float* scr = (LAS float*)(lds + id.wave * 16384);
    const int j = layer >> 1;
    bf16* W1T = (bf16*)(a.ws + id.z + W_W1T); bf16* W2T = (bf16*)(a.ws + id.z + W_W2T);
    const float* mw1 = a.in[30 + id.z] + (size_t)layer * D * FF; const float* mw2 = a.in[31 + id.z] + (size_t)layer * D * FF;
    if ((layer & 1) == 0) {
        bf16* WINT = (bf16*)(a.ws + id.z + W_WINT); bf16* WOUTT = (bf16*)(a.ws + id.z + W_WOUTT);
        const float* win = a.in[12 + id.z] + (size_t)j * D * NQKV; const float* wout = a.in[13 + id.z] + (size_t)j * D * D;
        const int total = 2048 + 2048 + 1152 + 512;
        for (int it = id.gw; it < total; it += id.ngw) {
            int r = it;
            if (tr_matrix(r, mw1, D, FF, W1T, scr, id.lane)) continue;
            if (tr_matrix(r, mw2, FF, D, W2T, scr, id.lane)) continue;
            if (r < 1152) {
                const int kb = r / 72, nb = r % 72; tr_item(win, NQKV, 0, nullptr, WINT, D, 0, 0, scr, kb, nb, id.lane, (nb & ~7) + 4 * (nb & 1) + ((nb >> 1) & 3)); continue; }
            r -= 1152;
            tr_matrix(r, wout, D, D, WOUTT, scr, id.lane);
        }
    } else {
        bf16* BTR = (bf16*)(a.ws + id.z + W_BTR); bf16* BT1 = (bf16*)(a.ws + id.z + W_BTL); bf16* WOT = (bf16*)(a.ws + id.z + W_WOT);
        const float* mu = a.in[17 + id.z] + (size_t)j * 6 * D;
        const float* wrkv = a.in[18 + id.z] + (size_t)j * 3 * D * D;
        const float* w1 = a.in[21 + id.z] + (size_t)j * 2 * D * 64; const float* a1 = a.in[24 + id.z] + (size_t)j * 2 * D * 64; const float* g1 = a.in[26 + id.z] + (size_t)j * D * 128;
        const float* wo = a.in[19 + id.z] + (size_t)j * D * D;
        bf16* BT2 = (bf16*)(a.ws + id.z + W_BT2); const float* w2 = a.in[22 + id.z] + (size_t)j * 2 * 64 * D; const float* a2 = a.in[25 + id.z] + (size_t)j * 2 * 64 * D; const float* g2 = a.in[27 + id.z] + (size_t)j * 128 * D;
        const int total = 2048 + 2048 + 1536 + 256 + 128 + 512 + 128 + 4 * 32 + 64 + 5120;
        for (int it = id.gw; it < total; it += id.ngw) {
            int r = it;
            if (tr_matrix(r, mw1, D, FF, W1T, scr, id.lane)) continue;
            if (tr_matrix(r, mw2, FF, D, W2T, scr, id.lane)) continue;
            if (tr_matrix(r, wrkv, D, D, BTR, scr, id.lane)) continue;
            if (tr_matrix(r, wrkv + (size_t)D * D, D, D, BTR + (size_t)D * D, scr, id.lane)) continue;
            if (tr_matrix(r, wrkv + (size_t)2 * D * D, D, D, BTR + (size_t)2 * D * D, scr, id.lane)) continue;
            if (tr_rwproj(r, w1, 64, mu + 1 * D, BT1, 0, scr, id.lane)) continue;
            if (tr_rwproj(r, w1 + (size_t)D * 64, 64, mu + 1 * D, BT1, 64, scr, id.lane)) continue;
            if (tr_rwproj(r, a1, 64, mu + 4 * D, BT1, 128, scr, id.lane)) continue;
            if (tr_rwproj(r, a1 + (size_t)D * 64, 64, mu + 4 * D, BT1, 192, scr, id.lane)) continue;
            if (tr_rwproj(r, g1, 128, mu + 5 * D, BT1, 256, scr, id.lane)) continue;
            if (tr_matrix(r, wo, D, D, WOT, scr, id.lane)) continue;
            if (r < 128) {
                v4u z = (v4u){0u, 0u, 0u, 0u}; v4u* p = (v4u*)(BT1 + (size_t)(384 + r) * KRKV);
#pragma unroll
                for (int q = 0; q < 4; ++q) p[id.lane + 64 * q] = z;
                continue; }
            r -= 128;
            if (r < 128) { const int i = r >> 5, q = r & 31; const float* W = (i < 2 ? a2 : w2) + (size_t)(i & 1) * 64 * D; tr_item(W, D, 0, nullptr, BT2, 384, 1024 * i, 64 * (i ^ 2), scr, 0, q, id.lane); continue; }
            r -= 128;
            if (r < 64) { tr_item(g2, D, 0, nullptr, BT2, 384, 4096, 256, scr, r >> 5, r & 31, id.lane); continue; }
            r -= 64;
            { const int blk = r >> 10; const int c0 = (blk < 4) ? 8 * (blk ^ 2) : 32, c1 = (blk < 4) ? 8 * (blk ^ 2) + 8 : 48;
              if (id.lane < 48 && (id.lane < c0 || id.lane >= c1)) *(v4u*)(BT2 + (size_t)r * 384 + 8 * id.lane) = (v4u){0u, 0u, 0u, 0u}; }
        }
    }
}

struct RowV { f32x4 v[4]; };
__device__ __forceinline__ void ld_row(RowV& r, const float* p, int lane) {
#pragma unroll
    for (int j = 0; j < 4; ++j) r.v[j] = ((const f32x4*)p)[lane + 64 * j];
}
__device__ __forceinline__ void st_row(const RowV& r, float* p, int lane) {
#pragma unroll
    for (int j = 0; j < 4; ++j) ((f32x4*)p)[lane + 64 * j] = r.v[j];
}
__device__ __forceinline__ void st_row_bf16(const RowV& r, bf16* p, int lane) {
#pragma unroll
    for (int j = 0; j < 4; ++j) { v2u w; w.x = pk2(r.v[j][0], r.v[j][1]); w.y = pk2(r.v[j][2], r.v[j][3]); ((v2u*)p)[lane + 64 * j] = w; }
}
__device__ __forceinline__ float row_rinv(const RowV& r) {
    float s = 0.f;
#pragma unroll
    for (int j = 0; j < 4; ++j) s += (r.v[j][0] * r.v[j][0] + r.v[j][1] * r.v[j][1]) + (r.v[j][2] * r.v[j][2] + r.v[j][3] * r.v[j][3]);
    s = wave_sum(s);
    return 1.0f / sqrtf(s * (1.0f / 1024.0f) + 1e-6f);
}
__device__ __forceinline__ void norm_mod(RowV& h, const RowV& x, const float* g, const float* sc, const float* sh, int lane) {
    const float ri = row_rinv(x);
#pragma unroll
    for (int j = 0; j < 4; ++j) { const f32x4 gv = ((const f32x4*)g)[lane + 64 * j], scv = ((const f32x4*)sc)[lane + 64 * j], shv = ((const f32x4*)sh)[lane + 64 * j];
        h.v[j] = (x.v[j] * ri) * gv * (scv + 1.0f) + shv; }
}
__device__ __forceinline__ void resid_add(RowV& x, const RowV& m, const float* g, const float* gt, int lane) {
    const float ri = row_rinv(m);
#pragma unroll
    for (int j = 0; j < 4; ++j) { const f32x4 gv = ((const f32x4*)g)[lane + 64 * j], gtv = ((const f32x4*)gt)[lane + 64 * j];
        x.v[j] = x.v[j] + gtv * ((m.v[j] * ri) * gv); }
}

__device__ __forceinline__ float rope_inv(int jj) {
    const float t[16] = {1.0f, 0.5623413324356079f, 0.3162277638912201f, 0.17782793939113617f, 0.10000000149011612f, 0.05623412877321243f, 0.03162277862429619f, 0.017782794311642647f,
                         0.009999999776482582f, 0.005623413249850273f, 0.003162277862429619f, 0.0017782794311642647f, 0.0010000000474974513f, 0.000562341301701963f, 0.0003162277862429619f, 0.00017782794020604342f};
    float r = t[0];
#pragma unroll
    for (int i = 1; i < 16; ++i) r = (jj == i) ? t[i] : r;
    return r;
}
__device__ __forceinline__ void ph_prologue(const Args& a, const Ids& id, LAS unsigned char* lds) {
    float* MOD = (float*)(a.ws + id.z + WS_MOD);
    { LAS float* red = (LAS float*)lds;
      for (int it = blockIdx.x; it < 4 * 96; it += gridDim.x) {
        const int i = it / 96, n = (it % 96) * 64 + id.lane;
        float acc[5];
#pragma unroll
        for (int c = 0; c < 5; ++c) acc[c] = 0.f;
        const float* W = a.in[9 + id.z] + (size_t)i * 1024 * 6144 + n;
#pragma unroll 1
        for (int k0 = 128 * id.wave; k0 < 128 * id.wave + 128; k0 += 64) {
            float sv[5];
#pragma unroll
            for (int c = 0; c < 5; ++c) { const float x = (c < 4) ? a.in[2 + id.z][c * 1024 + k0 + id.lane] : a.in[8 + id.z][k0 + id.lane]; sv[c] = x / (1.0f + __expf(-x)); }
#pragma unroll 16
            for (int kk = 0; kk < 64; ++kk) { const float w = W[(size_t)(k0 + kk) * 6144];
#pragma unroll
                for (int c = 0; c < 5; ++c) acc[c] += w * __shfl(sv[c], kk); }
        }
#pragma unroll
        for (int c = 0; c < 5; ++c) red[(id.wave * 5 + c) * 64 + id.lane] = acc[c];
        __syncthreads();
        if (id.wave < 5) { float s = a.in[10 + id.z][i * 6144 + n];
#pragma unroll
            for (int w8 = 0; w8 < 8; ++w8) s += red[(w8 * 5 + id.wave) * 64 + id.lane];
            MOD[(size_t)(id.wave * 4 + i) * 6144 + n] = s; }
        __syncthreads();
      } }
    { float* RC = (float*)(a.ws + id.z + WS_ROPE); float* RS = RC + 2048 * 64;
      for (int e = id.gw * 64 + id.lane; e < 2048 * 64; e += id.ngw * 64) { const int t = e >> 6, d = e & 63; const int pos = (d < 32) ? (t >> 6) : (t & 63);
          const float ang = (float)pos * rope_inv(d & 15); RC[e] = __cosf(ang); RS[e] = __sinf(ang); } }
    { const f32x4* s0 = (const f32x4*)a.in[0 + id.z]; const f32x4* s1 = (const f32x4*)a.in[1 + id.z]; f32x4* dst = (f32x4*)(a.out + id.z + O_X); const int n4 = NPR * D / 4;
      for (int e = id.gw * 64 + id.lane; e < n4; e += id.ngw * 64) { dst[e] = s0[e]; dst[n4 + e] = s1[e]; } }
    conv_weights(a, id, lds, 0);
}

__device__ __forceinline__ void ph_norm0(const Args& a, const Ids& id) {
    bf16* H = (bf16*)(a.ws + id.z + A_H); const float* g0 = a.in[11 + id.z] + (size_t)(0 * 4 + 0) * D;
    for (int m = id.gw; m < NTOK; m += id.ngw) { RowV x, h; ld_row(x, a.out + id.z + O_X + (size_t)m * D, id.lane); const float* md = mod_ptr_(a, id, cond_of(m), 0);
        norm_mod(h, x, g0, md + 1024, md + 0, id.lane); st_row_bf16(h, H + (size_t)m * D, id.lane); }
}
__device__ __forceinline__ void ph_resid_norm(const Args& a, const Ids& id, int layer, bool dummy = false) {
    bf16* H = (bf16*)(a.ws + id.z + (dummy ? AR + 224 * MiB : A_H)); float* xout = dummy ? (float*)(a.ws + id.z + A_F) : a.out + id.z + O_X; const float* M = (const float*)(a.ws + id.z + A_M); const float* g1 = a.in[11 + id.z] + (size_t)(layer * 4 + 1) * D; const float* g2 = a.in[11 + id.z] + (size_t)(layer * 4 + 2) * D;
    for (int m = id.gw; m < NTOK; m += id.ngw) { RowV x, mm, h; float* xp = a.out + id.z + O_X + (size_t)m * D; ld_row(x, xp, id.lane); ld_row(mm, M + (size_t)m * D, id.lane);
        const float* md = mod_ptr_(a, id, cond_of(m), layer);
        resid_add(x, mm, g1, md + 2048, id.lane); st_row(x, xout + (size_t)m * D, id.lane);
        norm_mod(h, x, g2, md + 4096, md + 3072, id.lane); st_row_bf16(h, H + (size_t)m * D, id.lane); }
}
__device__ __forceinline__ void ph_resid_end(const Args& a, const Ids& id, LAS unsigned char* lds, int layer, bool dummy = false) {
    bf16* H = (bf16*)(a.ws + id.z + (dummy ? AR + 96 * MiB : A_H)); float* xout = dummy ? (float*)(a.ws + id.z + AR + 32 * MiB) : a.out + id.z + O_X; const float* F = (const float*)(a.ws + id.z + A_F); const float* g3 = a.in[11 + id.z] + (size_t)(layer * 4 + 3) * D;
    const bool next_attn = (layer + 1 < DEPTH) && (((layer + 1) & 1) == 0);
    const float* g0n = a.in[11 + id.z] + (size_t)((layer + 1) * 4 + 0) * D;
    for (int m = id.gw; m < NTOK; m += id.ngw) { RowV x, ff; float* xp = a.out + id.z + O_X + (size_t)m * D; ld_row(x, xp, id.lane); ld_row(ff, F + (size_t)m * D, id.lane);
        const float* md = mod_ptr_(a, id, cond_of(m), layer);
        resid_add(x, ff, g3, md + 5120, id.lane); st_row(x, xout + (size_t)m * D, id.lane);
        if (next_attn) { RowV h; const float* mdn = mod_ptr_(a, id, cond_of(m), layer + 1); norm_mod(h, x, g0n, mdn + 1024, mdn + 0, id.lane); st_row_bf16(h, H + (size_t)m * D, id.lane); } }
    if (layer + 1 < DEPTH) conv_weights(a, id, lds, layer + 1);
}
__device__ __forceinline__ void ph_rw_mix(const Args& a, const Ids& id, int layer) {
    bf16* A2 = (bf16*)(a.ws + id.z + A_A2); bf16* XS = (bf16*)(a.ws + id.z + A_XS); const float* g0 = a.in[11 + id.z] + (size_t)(layer * 4 + 0) * D; const float* mu6 = a.in[17 + id.z] + (size_t)(layer >> 1) * 6 * D;
    for (int g8 = id.gw; g8 < NTOK / 8; g8 += id.ngw) {
        const int m0 = g8 * 8; const int t0 = (m0 < NPR) ? (m0 & (TP - 1)) : ((m0 - NPR) & (TS - 1)); const int T = (m0 < NPR) ? TP : TS;
        const float* md = mod_ptr_(a, id, cond_of(m0), layer); const float* xp = a.out + id.z + O_X + (size_t)m0 * D;
        RowV hp, hc, hn, xr;
#pragma unroll
        for (int q = 0; q < 4; ++q) hp.v[q] = (f32x4){0.f, 0.f, 0.f, 0.f};
        if (t0 > 0) { ld_row(xr, xp - D, id.lane); norm_mod(hp, xr, g0, md + 1024, md + 0, id.lane); }
        ld_row(xr, xp, id.lane); norm_mod(hc, xr, g0, md + 1024, md + 0, id.lane);
#pragma unroll 1
        for (int i = 0; i < 8; ++i) {
#pragma unroll
            for (int q = 0; q < 4; ++q) hn.v[q] = (f32x4){0.f, 0.f, 0.f, 0.f};
            if (t0 + i + 1 < T) { ld_row(xr, xp + (size_t)(i + 1) * D, id.lane); norm_mod(hn, xr, g0, md + 1024, md + 0, id.lane); }
            RowV xx;
#pragma unroll
            for (int q = 0; q < 4; ++q) xx.v[q] = (hp.v[q] + hn.v[q]) * 0.5f - hc.v[q];
            st_row_bf16(hc, A2 + (size_t)(m0 + i) * KRKV, id.lane); st_row_bf16(xx, A2 + (size_t)(m0 + i) * KRKV + D, id.lane);
#pragma unroll
            for (int p = 0; p < 3; ++p) { const float* mu = mu6 + (size_t)(p == 0 ? 0 : p + 1) * D; RowV xm;
#pragma unroll
                for (int q = 0; q < 4; ++q) xm.v[q] = hc.v[q] + xx.v[q] * ((const f32x4*)mu)[id.lane + 64 * q];
                st_row_bf16(xm, XS + ((size_t)p * NTOK + m0 + i) * D, id.lane); }
            hp = hc; hc = hn;
        }
    }
}

__device__ __forceinline__ void row16_sum4(float& a, float& b, float& c, float& d) {
    asm("s_nop 1\n\t"
        "v_add_f32_dpp %0, %0, %0 row_ror:8 row_mask:0xf bank_mask:0xf\n\tv_add_f32_dpp %1, %1, %1 row_ror:8 row_mask:0xf bank_mask:0xf\n\tv_add_f32_dpp %2, %2, %2 row_ror:8 row_mask:0xf bank_mask:0xf\n\tv_add_f32_dpp %3, %3, %3 row_ror:8 row_mask:0xf bank_mask:0xf\n\t"
        "v_add_f32_dpp %0, %0, %0 row_ror:4 row_mask:0xf bank_mask:0xf\n\tv_add_f32_dpp %1, %1, %1 row_ror:4 row_mask:0xf bank_mask:0xf\n\tv_add_f32_dpp %2, %2, %2 row_ror:4 row_mask:0xf bank_mask:0xf\n\tv_add_f32_dpp %3, %3, %3 row_ror:4 row_mask:0xf bank_mask:0xf\n\t"
        "v_add_f32_dpp %0, %0, %0 row_ror:2 row_mask:0xf bank_mask:0xf\n\tv_add_f32_dpp %1, %1, %1 row_ror:2 row_mask:0xf bank_mask:0xf\n\tv_add_f32_dpp %2, %2, %2 row_ror:2 row_mask:0xf bank_mask:0xf\n\tv_add_f32_dpp %3, %3, %3 row_ror:2 row_mask:0xf bank_mask:0xf\n\t"
        "v_add_f32_dpp %0, %0, %0 row_ror:1 row_mask:0xf bank_mask:0xf\n\tv_add_f32_dpp %1, %1, %1 row_ror:1 row_mask:0xf bank_mask:0xf\n\tv_add_f32_dpp %2, %2, %2 row_ror:1 row_mask:0xf bank_mask:0xf\n\tv_add_f32_dpp %3, %3, %3 row_ror:1 row_mask:0xf bank_mask:0xf"
        : "+v"(a), "+v"(b), "+v"(c), "+v"(d));
}
__device__ __forceinline__ f32x4 ld_bf4(const bf16* p) { const v2u w = *(const v2u*)p; return (f32x4){bflo(w.x), bfhi(w.x), bflo(w.y), bfhi(w.y)}; }
__device__ __forceinline__ void ph_att_cache(const Args& a, const Ids& id, int layer) {
    const int j = layer >> 1, lane = id.lane;
    bf16 *KAS = (bf16*)(a.ws + id.z + A_KAS), *VAS = (bf16*)(a.ws + id.z + A_VAS), *KBS = (bf16*)(a.ws + id.z + A_KBS), *VBS = (bf16*)(a.ws + id.z + A_VBS);
    for (int r = id.gw; r < 4 * PAST; r += id.ngw) {
        const int b = r >> 9, pos = r & (PAST - 1);
        const size_t src = (size_t)((b * 2 + j) * PAST + pos), dst = (size_t)(b * SKV + pos);
#pragma unroll
        for (int q = 0; q < 2; ++q) { const int e = lane + 64 * q; KAS[dst * 128 + e] = (bf16)f2bf(a.in[3 + id.z][src * 128 + e]); VAS[dst * 128 + e] = (bf16)f2bf(a.in[4 + id.z][src * 128 + e]); }
#pragma unroll
        for (int q = 0; q < 8; ++q) { const int e = lane + 64 * q; KBS[dst * 512 + e] = (bf16)f2bf(a.in[5 + id.z][src * 512 + e]); VBS[dst * 512 + e] = (bf16)f2bf(a.in[6 + id.z][src * 512 + e]); }
    }
}

typedef short bf16x8_t __attribute__((ext_vector_type(8)));
typedef float f32x16 __attribute__((ext_vector_type(16)));
typedef short v4i16_t __attribute__((ext_vector_type(4)));
constexpr float AT_THR = 8.0f;
constexpr int AT_KP = 144, AT_KBUF = 64 * AT_KP, AT_VOFF = 2 * AT_KBUF, AT_VBUFMAX = 64 * 288, AT_WSF = AT_VOFF + 2 * AT_VBUFMAX;
static_assert(AT_WSF + 8 * 128 <= RING_BYTES, "attention LDS");
template <int NDT>
__device__ __forceinline__ void attn_unit(const bf16* Qrow0, int ldq, const bf16* Kb, int ldk, const bf16* Vb, int ldv, int S, bf16* Obf, float* Of32, int ldo, LAS unsigned char* lds, const Ids& id) {
    constexpr int VP = (NDT == 2) ? 144 : 288, NVL = NDT / 2;
    const int lane = id.lane, w = id.wave, r32 = lane & 31, hi = lane >> 5, tid = id.tid;
    bf16x8_t qf[4];
    { const bf16* qrow = Qrow0 + (size_t)(32 * w + r32) * ldq;
#pragma unroll
      for (int s = 0; s < 4; ++s) qf[s] = *(const bf16x8_t*)(qrow + 16 * s + 8 * hi); }
    f32x16 o[NDT];
#pragma unroll
    for (int dt = 0; dt < NDT; ++dt)
#pragma unroll
        for (int r = 0; r < 16; ++r) o[dt][r] = 0.f;
    float m_run = 0.f, l_run = 0.f;
    const int NT = S >> 6;
    LAS float* wsf = (LAS float*)(lds + AT_WSF + w * 128);
    const int krow = tid >> 3, kch = tid & 7;
    v4u kreg, vreg[NVL];
#define AT_GLOAD(t) do { kreg = *(const v4u*)(Kb + (size_t)((t) * 64 + krow) * ldk + 8 * kch); \
        if (NDT == 2) vreg[0] = *(const v4u*)(Vb + (size_t)((t) * 64 + krow) * ldv + 8 * kch); \
        else { _Pragma("unroll") for (int i_ = 0; i_ < NVL; ++i_) { const int ix_ = tid + 512 * i_; vreg[i_] = *(const v4u*)(Vb + (size_t)((t) * 64 + (ix_ >> 4)) * ldv + 8 * (ix_ & 15)); } } } while (0)
#define AT_LSTORE(b) do { *(LAS v4u*)(lds + (b) * AT_KBUF + krow * AT_KP + 16 * kch) = kreg; \
        if (NDT == 2) *(LAS v4u*)(lds + AT_VOFF + (b) * AT_VBUFMAX + krow * VP + 16 * kch) = vreg[0]; \
        else { _Pragma("unroll") for (int i_ = 0; i_ < NVL; ++i_) { const int ix_ = tid + 512 * i_; *(LAS v4u*)(lds + AT_VOFF + (b) * AT_VBUFMAX + (ix_ >> 4) * VP + 16 * (ix_ & 15)) = vreg[i_]; } } } while (0)
    AT_GLOAD(0); AT_LSTORE(0);
    __syncthreads();
    const int vbase = (4 * hi + ((lane & 15) >> 2)) * VP + 32 * ((lane >> 4) & 1) + 8 * (lane & 3);
#pragma unroll 1
    for (int t = 0; t < NT; ++t) {
        const int b = t & 1;
        if (t + 1 < NT) AT_GLOAD(t + 1);
        const LAS unsigned char* Kt = lds + b * AT_KBUF + r32 * AT_KP + 16 * hi;
        const LAS unsigned char* Vt = lds + AT_VOFF + b * AT_VBUFMAX + vbase;
        f32x16 p0, p1;
        { const float nm = -m_run;
#pragma unroll
          for (int r = 0; r < 16; ++r) { p0[r] = nm; p1[r] = nm; } }
#pragma unroll
        for (int s = 0; s < 4; ++s) { const bf16x8_t k0 = *(const LAS bf16x8_t*)(Kt + 32 * s), k1 = *(const LAS bf16x8_t*)(Kt + 32 * AT_KP + 32 * s);
            p0 = __builtin_amdgcn_mfma_f32_32x32x16_bf16(k0, qf[s], p0, 0, 0, 0); p1 = __builtin_amdgcn_mfma_f32_32x32x16_bf16(k1, qf[s], p1, 0, 0, 0); }
        float mx = __builtin_fmaxf(p0[0], p1[0]);
#pragma unroll
        for (int r = 1; r < 16; ++r) mx = __builtin_fmaxf(__builtin_fmaxf(mx, p0[r]), p1[r]);
        mx = fmaxf(mx, __shfl_xor(mx, 32));
        if (t == 0 || __any(mx > AT_THR)) {
            const float dl = (t == 0) ? mx : fmaxf(mx, 0.f), al = __builtin_amdgcn_exp2f(-dl); m_run += dl; l_run *= al;
#pragma unroll
            for (int r = 0; r < 16; ++r) { p0[r] -= dl; p1[r] -= dl; }
            if (hi == 0) wsf[r32] = al;
            LDS_WAIT(); asm volatile("" ::: "memory");
            { f32x4 a4[4];
#pragma unroll
              for (int g4 = 0; g4 < 4; ++g4) a4[g4] = *(const LAS f32x4*)(wsf + 8 * g4 + 4 * hi);
#pragma unroll
              for (int dt = 0; dt < NDT; ++dt)
#pragma unroll
                  for (int r = 0; r < 16; ++r) o[dt][r] *= a4[r >> 2][r & 3]; }
            LDS_WAIT(); asm volatile("" ::: "memory");
        }
        float rs = 0.f;
#pragma unroll
        for (int r = 0; r < 16; ++r) { p0[r] = __builtin_amdgcn_exp2f(p0[r]); p1[r] = __builtin_amdgcn_exp2f(p1[r]); rs += p0[r] + p1[r]; }
        l_run += rs;
        bf16x8_t pf[4];
#pragma unroll
        for (int ks = 0; ks < 4; ++ks) { v4u pw;
#pragma unroll
            for (int dd = 0; dd < 4; ++dd) { const int r = 8 * (ks & 1) + 2 * dd; pw[dd] = (ks < 2) ? pk2(p0[r], p0[r + 1]) : pk2(p1[r], p1[r + 1]); }
            pf[ks] = __builtin_bit_cast(bf16x8_t, pw); }
#pragma unroll
        for (int ks = 0; ks < 4; ++ks)
#pragma unroll
            for (int dt = 0; dt < NDT; ++dt) {
                const v4i16_t lo = __builtin_amdgcn_ds_read_tr16_b64_v4i16((LAS v4i16_t*)(Vt + (16 * ks) * VP + 64 * dt));
                const v4i16_t hh = __builtin_amdgcn_ds_read_tr16_b64_v4i16((LAS v4i16_t*)(Vt + (16 * ks + 8) * VP + 64 * dt));
                const bf16x8_t vf = (bf16x8_t){lo[0], lo[1], lo[2], lo[3], hh[0], hh[1], hh[2], hh[3]};
                o[dt] = __builtin_amdgcn_mfma_f32_32x32x16_bf16(pf[ks], vf, o[dt], 0, 0, 0); }
        if (t + 1 < NT) AT_LSTORE(b ^ 1);
        __syncthreads();
    }
#undef AT_GLOAD
#undef AT_LSTORE
    const float lt = l_run + __shfl_xor(l_run, 32);
    int lane_e = lane; asm volatile("" : "+v"(lane_e));
    const int r32e = lane_e & 31, hie = lane_e >> 5;
    if (hi == 0) wsf[r32] = 1.0f / lt;
    LDS_WAIT(); asm volatile("" ::: "memory");
    f32x4 a4[4];
#pragma unroll
    for (int g4 = 0; g4 < 4; ++g4) a4[g4] = *(const LAS f32x4*)(wsf + 8 * g4 + 4 * hi);
    LDS_WAIT(); asm volatile("" ::: "memory");
#pragma unroll
    for (int dt = 0; dt < NDT; ++dt)
#pragma unroll
        for (int r = 0; r < 16; ++r) { const float val = o[dt][r] * a4[r >> 2][r & 3]; const int off = (32 * w + (r & 3) + 8 * (r >> 2) + 4 * hie) * ldo + 32 * dt + r32e;
            if (NDT == 2) Obf[off] = (bf16)f2bf(val); else Of32[off] = val; }
}
__device__ __forceinline__ void ph_attn(const Args& a, const Ids& id, LAS unsigned char* lds, int G, int vcu) {
    const bf16 *QA = (const bf16*)(a.ws + id.z + A_QA), *QB = (const bf16*)(a.ws + id.z + A_QB), *KAP = (const bf16*)(a.ws + id.z + A_KAP), *VAP = (const bf16*)(a.ws + id.z + A_VAP), *KBP = (const bf16*)(a.ws + id.z + A_KBP), *VBP = (const bf16*)(a.ws + id.z + A_VBP);
    const bf16 *KAS = (const bf16*)(a.ws + id.z + A_KAS), *VAS = (const bf16*)(a.ws + id.z + A_VAS), *KBS = (const bf16*)(a.ws + id.z + A_KBS), *VBS = (const bf16*)(a.ws + id.z + A_VBS);
    bf16* H = (bf16*)(a.ws + id.z + A_H); float* DT = (float*)(a.ws + id.z + A_DT);
    for (int s = vcu; s < 256; s += G) {
        const int h8 = s & 7;
#pragma unroll 1
        for (int pass = 0; pass < 2; ++pass) {
            size_t m0, kvrow; int S;
            if (pass == 0) { const int b = s >> 6, qb = (s >> 3) & 7; m0 = (size_t)NPR + b * TS + qb * 256; kvrow = (size_t)b * SKV; S = SKV; }
            else { const int b = s >> 3; m0 = (size_t)b * TP; kvrow = m0; S = TP; }
            const bf16* Ka = (pass == 0 ? KAS : KAP) + kvrow * 128 + (h8 >> 2) * 64; const bf16* Va = (pass == 0 ? VAS : VAP) + kvrow * 128 + (h8 >> 2) * 64;
            const bf16* Kd = (pass == 0 ? KBS : KBP) + kvrow * 512 + h8 * 64; const bf16* Vd = (pass == 0 ? VBS : VBP) + kvrow * 512 + (h8 >> 1) * 128;
            attn_unit<2>(QA + m0 * 512 + h8 * 64, 512, Ka, 128, Va, 128, S, H + m0 * D + h8 * 64, nullptr, D, lds, id);
            attn_unit<4>(QB + m0 * 512 + h8 * 64, 512, Kd, 512, Vd, 512, S, nullptr, DT + m0 * D + h8 * 128, D, lds, id);
        }
    }
}
__device__ __forceinline__ void ph_att_comb(const Args& a, const Ids& id, int layer) {
    const int j = layer >> 1, lane = id.lane; const float lam_init = (layer == 0) ? 0.2f : 0.4707130183435842f;
    const float* lf = a.in[15 + id.z] + j * 256; const float* sg = a.in[16 + id.z] + j * 128;
    const float s01 = wave_sum(lf[lane] * lf[64 + lane]), s23 = wave_sum(lf[128 + lane] * lf[192 + lane]);
    const float lam = expf(s01) - expf(s23) + lam_init;
    const float* DT = (const float*)(a.ws + id.z + A_DT); bf16* H = (bf16*)(a.ws + id.z + A_H);
    const f32x4 gg = *(const f32x4*)(sg + 4 * (lane & 31)) * (1.0f - lam_init);
    for (int m = id.gw; m < NTOK; m += id.ngw) {
        f32x4 v[4];
#pragma unroll
        for (int hd = 0; hd < 4; ++hd) v[hd] = *(const f32x4*)(DT + (size_t)m * D + 256 * hd + 4 * lane);
        float ss[4];
#pragma unroll
        for (int hd = 0; hd < 4; ++hd) { f32x4 o; o[0] = __shfl_xor(v[hd][0], 32); o[1] = __shfl_xor(v[hd][1], 32); o[2] = __shfl_xor(v[hd][2], 32); o[3] = __shfl_xor(v[hd][3], 32);
            v[hd] = v[hd] - o * lam;
            ss[hd] = (lane < 32) ? (v[hd][0] * v[hd][0] + v[hd][1] * v[hd][1]) + (v[hd][2] * v[hd][2] + v[hd][3] * v[hd][3]) : 0.f; }
        row16_sum4(ss[0], ss[1], ss[2], ss[3]);
#pragma unroll
        for (int hd = 0; hd < 4; ++hd) { const float tot = ss[hd] + __shfl_xor(ss[hd], 16); const float ri = 1.0f / sqrtf(tot * (1.0f / 128.0f) + 1e-6f); const f32x4 o = v[hd] * ri * gg;
            if (lane < 32) *(v2u*)(H + (size_t)m * D + 512 + hd * 128 + 4 * lane) = (v2u){pk2(o[0], o[1]), pk2(o[2], o[3])}; }
    }
}

__device__ __forceinline__ void ph_rw_prep(const Args& a, const Ids& id, int layer) {
    const int j = layer >> 1, lane = id.lane;
    const bf16* RKV = (const bf16*)(a.ws + id.z + A_RKV); float* INV = (float*)(a.ws + id.z + WS_INV); float* Y = (float*)(a.ws + id.z + A_Y);
    const float* kk_c = a.in[28 + id.z] + (size_t)(j * 3 + 0) * D;
    for (int m = id.gw; m < NTOK; m += id.ngw) {
#pragma unroll 4
        for (int h = 0; h < 16; ++h) { const float kv = bf2f(RKV[(size_t)m * 3072 + 1024 + h * 64 + lane]) * kk_c[h * 64 + lane]; const float ss = wave_sum(kv * kv); if (lane == 0) INV[m * 16 + h] = 1.0f / sqrtf(ss + 1e-12f); }
        f32x4* yp = (f32x4*)(Y + (size_t)m * D);
#pragma unroll
        for (int q = 0; q < 4; ++q) yp[lane + 64 * q] = (f32x4){0.f, 0.f, 0.f, 0.f};
    }
}

constexpr int SC_TC = 16, SC_ROWF = 352;
constexpr int SC_OPF = SC_TC * SC_ROWF;
constexpr int SC_YOFF = 4 * SC_OPF;
static_assert((SC_YOFF + 4 * SC_TC * 32) * 4 <= RING_BYTES, "scan LDS");
struct ScDesc { int mbase, T, h, dir, half, b; };
__device__ __forceinline__ void sc_desc(ScDesc& d, int slot, int grp, int c) {
    if (grp == 0) { const int cs = slot >> 1; d.b = cs >> 5; d.h = (cs >> 1) & 15; d.dir = cs & 1; d.half = slot & 1; d.T = TS; d.mbase = NPR + d.b * TS; }
    else { const int pu = slot * 8 + (c >> 4), cp = pu >> 1; d.b = cp >> 5; d.h = (cp >> 1) & 15; d.dir = cp & 1; d.half = pu & 1; d.T = TP; d.mbase = d.b * TP; }
}
__device__ __forceinline__ int sc_tok(const ScDesc& d, int grp, int c, int i) { const int s = (grp == 0 ? c : (c & 15)) * SC_TC + i; return d.mbase + (d.dir ? d.T - 1 - s : s); }
__device__ __forceinline__ float fma_s(float a, float b, float c) { float r; asm("v_fma_f32 %0, %1, %2, %3" : "=v"(r) : "v"(a), "v"(b), "v"(c)); return r; }
__device__ __forceinline__ float fnma_s(float a, float b, float c) { float r; asm("v_fma_f32 %0, -%1, %2, %3" : "=v"(r) : "v"(a), "v"(b), "v"(c)); return r; }
__device__ __forceinline__ float mul_s(float a, float b) { float r; asm("v_mul_f32_e32 %0, %1, %2" : "=v"(r) : "v"(a), "v"(b)); return r; }
__device__ __forceinline__ float add_s(float a, float b) { float r; asm("v_add_f32_e32 %0, %1, %2" : "=v"(r) : "v"(a), "v"(b)); return r; }
__device__ __forceinline__ void oct_sum4(float& a, float& b, float& c, float& d) {
    asm("s_nop 1\n\t"
        "v_add_f32_dpp %0, %0, %0 quad_perm:[1,0,3,2] row_mask:0xf bank_mask:0xf\n\tv_add_f32_dpp %1, %1, %1 quad_perm:[1,0,3,2] row_mask:0xf bank_mask:0xf\n\tv_add_f32_dpp %2, %2, %2 quad_perm:[1,0,3,2] row_mask:0xf bank_mask:0xf\n\tv_add_f32_dpp %3, %3, %3 quad_perm:[1,0,3,2] row_mask:0xf bank_mask:0xf\n\t"
        "v_add_f32_dpp %0, %0, %0 quad_perm:[2,3,0,1] row_mask:0xf bank_mask:0xf\n\tv_add_f32_dpp %1, %1, %1 quad_perm:[2,3,0,1] row_mask:0xf bank_mask:0xf\n\tv_add_f32_dpp %2, %2, %2 quad_perm:[2,3,0,1] row_mask:0xf bank_mask:0xf\n\tv_add_f32_dpp %3, %3, %3 quad_perm:[2,3,0,1] row_mask:0xf bank_mask:0xf\n\t"
        "v_add_f32_dpp %0, %0, %0 row_half_mirror row_mask:0xf bank_mask:0xf\n\tv_add_f32_dpp %1, %1, %1 row_half_mirror row_mask:0xf bank_mask:0xf\n\tv_add_f32_dpp %2, %2, %2 row_half_mirror row_mask:0xf bank_mask:0xf\n\tv_add_f32_dpp %3, %3, %3 row_half_mirror row_mask:0xf bank_mask:0xf"
        : "+v"(a), "+v"(b), "+v"(c), "+v"(d));
}
typedef float f32x2 __attribute__((ext_vector_type(2)));
struct ScOps { f32x2 w[4], kd[4], kk[4], ka[4], r[4]; float va, vb; };
__device__ __forceinline__ void sc_ldops(ScOps& o, const LAS float* p, int kg, int ra) {
#pragma unroll
    for (int hq = 0; hq < 2; ++hq) { const f32x4 a0 = *(const LAS f32x4*)(p + 8 * kg + 4 * hq), a1 = *(const LAS f32x4*)(p + 64 + 8 * kg + 4 * hq), a2 = *(const LAS f32x4*)(p + 128 + 8 * kg + 4 * hq),
                                                 a3 = *(const LAS f32x4*)(p + 192 + 8 * kg + 4 * hq), a4 = *(const LAS f32x4*)(p + 256 + 8 * kg + 4 * hq);
        o.w[2 * hq] = __builtin_shufflevector(a0, a0, 0, 1); o.w[2 * hq + 1] = __builtin_shufflevector(a0, a0, 2, 3); o.kd[2 * hq] = __builtin_shufflevector(a1, a1, 0, 1); o.kd[2 * hq + 1] = __builtin_shufflevector(a1, a1, 2, 3);
        o.kk[2 * hq] = __builtin_shufflevector(a2, a2, 0, 1); o.kk[2 * hq + 1] = __builtin_shufflevector(a2, a2, 2, 3); o.ka[2 * hq] = __builtin_shufflevector(a3, a3, 0, 1); o.ka[2 * hq + 1] = __builtin_shufflevector(a3, a3, 2, 3);
        o.r[2 * hq] = __builtin_shufflevector(a4, a4, 0, 1); o.r[2 * hq + 1] = __builtin_shufflevector(a4, a4, 2, 3); }
    o.va = p[320 + ra]; o.vb = p[321 + ra];
}
__device__ __forceinline__ float dot8_p(const f32x2 (&S)[4], const f32x2 (&x)[4]) {
    f32x2 d = S[0] * x[0]; d = __builtin_elementwise_fma(S[1], x[1], d); d = __builtin_elementwise_fma(S[2], x[2], d); d = __builtin_elementwise_fma(S[3], x[3], d);
    return d[0] + d[1];
}
struct ScRaw { float r[8], k[8], a[8], e[8], v[8], iv[8]; };
__device__ __forceinline__ void sc_load(ScRaw& R, const Args& a, const Ids& id, int hw, int slot, int c) {
    const int grp = hw >> 1, lane = id.lane; ScDesc d; sc_desc(d, slot, grp, c);
    const bf16* RKV = (const bf16*)(a.ws + id.z + A_RKV); const float* INV = (const float*)(a.ws + id.z + WS_INV);
    const bf16* Ad = (const bf16*)(a.ws + id.z + (d.dir ? A_A1 : A_A0)); const bf16* EWd = (const bf16*)(a.ws + id.z + (d.dir ? A_EW1 : A_EW0));
#pragma unroll
    for (int q = 0; q < 8; ++q) { const int m = sc_tok(d, grp, c, (hw & 1) * 8 + q); const size_t o = (size_t)m * 3072 + d.h * 64 + lane, o2 = (size_t)m * D + d.h * 64 + lane;
        R.r[q] = bf2f(RKV[o]); R.k[q] = bf2f(RKV[o + 1024]); R.a[q] = bf2f(Ad[o2]); R.e[q] = bf2f(EWd[o2]); R.iv[q] = INV[m * 16 + d.h];
        R.v[q] = bf2f(RKV[(size_t)m * 3072 + 2048 + d.h * 64 + d.half * 32 + (lane & 31)]); }
}
__device__ __forceinline__ void sc_derive(const ScRaw& R, const Args& a, const Ids& id, LAS float* L, int layer, int hw, int slot, int c, int buf) {
    const int grp = hw >> 1, lane = id.lane, j = layer >> 1; ScDesc d; sc_desc(d, slot, grp, c);
    const float kkc = a.in[28 + id.z][(size_t)(j * 3 + 0) * D + d.h * 64 + lane], kac = a.in[28 + id.z][(size_t)(j * 3 + 1) * D + d.h * 64 + lane];
#pragma unroll
    for (int q = 0; q < 8; ++q) { LAS float* p = L + (buf * 2 + grp) * SC_OPF + ((hw & 1) * 8 + q) * SC_ROWF;
        const float kk = R.k[q] * kkc * R.iv[q];
        p[lane] = __builtin_amdgcn_exp2f(-R.e[q]); p[64 + lane] = R.k[q] * (1.0f + (R.a[q] - 1.0f) * kac); p[128 + lane] = kk; p[192 + lane] = kk * R.a[q]; p[256 + lane] = R.r[q];
        if (lane < 32) p[320 + lane] = R.v[q]; }
}
__device__ __forceinline__ void sc_flush(const Args& a, const Ids& id, const LAS float* L, int hw, int slot, int c) {
    float* Y = (float*)(a.ws + id.z + A_Y);
#pragma unroll
    for (int q = 0; q < 4; ++q) { const int idx = hw * 64 + id.lane + 256 * q, fg = idx >> 9, s = (idx >> 5) & 15, row = idx & 31; ScDesc d; sc_desc(d, slot, fg, c);
        const float yv = L[SC_YOFF + ((c & 1) * 2 + fg) * SC_TC * 32 + s * 32 + row];
        atomicAdd(&Y[(size_t)sc_tok(d, fg, c, s) * D + d.h * 64 + d.half * 32 + row], yv); }
}
__device__ __forceinline__ void ph_rw_scan(const Args& a, const Ids& id, LAS unsigned char* lds, int layer, int G, int vcu) {
    const int j = layer >> 1, lane = id.lane, w = id.wave;
    LAS float* L = (LAS float*)lds;
    constexpr int NC = TS / SC_TC;
    for (int slot = vcu; slot < 256; slot += G) {
        if (w >= 4) {
            const int hw = w - 4; ScRaw R;
            sc_load(R, a, id, hw, slot, 0); sc_derive(R, a, id, L, layer, hw, slot, 0, 0);
            __syncthreads();
#pragma unroll 1
            for (int c = 0; c < NC; ++c) {
                if (c + 1 < NC) sc_load(R, a, id, hw, slot, c + 1);
                if (c > 0) sc_flush(a, id, L, hw, slot, c - 1);
                if (c + 1 < NC) sc_derive(R, a, id, L, layer, hw, slot, c + 1, (c & 1) ^ 1);
                __syncthreads();
            }
            sc_flush(a, id, L, hw, slot, NC - 1);
        } else {
            const int grp = w >> 1, kg = lane & 7, ra = 16 * (w & 1) + 2 * (lane >> 3);
            f32x2 Sa[4], Sb[4];
            { ScDesc d; sc_desc(d, slot, 0, 0);
              if (grp == 0) { const float* sp = a.in[7 + id.z] + ((((size_t)(d.b * 2 + j) * 2 + d.dir) * 16 + d.h) * 64 + d.half * 32 + ra) * 64 + 8 * kg;
                  const f32x4 t0 = *(const f32x4*)sp, t1 = *(const f32x4*)(sp + 4), t2 = *(const f32x4*)(sp + 64), t3 = *(const f32x4*)(sp + 68);
                  Sa[0] = (f32x2){t0[0], t0[1]}; Sa[1] = (f32x2){t0[2], t0[3]}; Sa[2] = (f32x2){t1[0], t1[1]}; Sa[3] = (f32x2){t1[2], t1[3]};
                  Sb[0] = (f32x2){t2[0], t2[1]}; Sb[1] = (f32x2){t2[2], t2[3]}; Sb[2] = (f32x2){t3[0], t3[1]}; Sb[3] = (f32x2){t3[2], t3[3]}; }
              else {
#pragma unroll
                  for (int e2 = 0; e2 < 4; ++e2) { Sa[e2] = (f32x2){0.f, 0.f}; Sb[e2] = (f32x2){0.f, 0.f}; } } }
            __syncthreads();
#pragma unroll 1
            for (int c = 0; c < NC; ++c) {
                const int buf = c & 1;
                if (grp == 1 && (c & 15) == 0) {
#pragma unroll
                    for (int e2 = 0; e2 < 4; ++e2) { Sa[e2] = (f32x2){0.f, 0.f}; Sb[e2] = (f32x2){0.f, 0.f}; } }
                const LAS float* ob = L + (buf * 2 + grp) * SC_OPF; LAS float* yb = L + SC_YOFF + (buf * 2 + grp) * SC_TC * 32 + ra;
                {
                    ScOps cur, nxt; sc_ldops(cur, ob, kg, ra);
                    float ypa = 0.f, ypb = 0.f;
#pragma unroll
                    for (int i = 0; i < SC_TC; ++i) {
                        if (i + 1 < SC_TC) sc_ldops(nxt, ob + (i + 1) * SC_ROWF, kg, ra);
                        const f32x2 va2 = (f32x2){cur.va, cur.va}, vb2 = (f32x2){cur.vb, cur.vb};
                        f32x2 ua[4], ub[4];
#pragma unroll
                        for (int e2 = 0; e2 < 4; ++e2) { ua[e2] = __builtin_elementwise_fma(Sa[e2], cur.w[e2], va2 * cur.kd[e2]); ub[e2] = __builtin_elementwise_fma(Sb[e2], cur.w[e2], vb2 * cur.kd[e2]); }
                        float ska = dot8_p(Sa, cur.kk), skb = dot8_p(Sb, cur.kk);
                        oct_sum4(ska, skb, ypa, ypb);
                        if (i > 0 && kg == 0) { yb[(i - 1) * 32] = ypa; yb[(i - 1) * 32 + 1] = ypb; }
                        const f32x2 na2 = (f32x2){-ska, -ska}, nb2 = (f32x2){-skb, -skb};
#pragma unroll
                        for (int e2 = 0; e2 < 4; ++e2) { Sa[e2] = __builtin_elementwise_fma(na2, cur.ka[e2], ua[e2]); Sb[e2] = __builtin_elementwise_fma(nb2, cur.ka[e2], ub[e2]); }
                        ypa = dot8_p(Sa, cur.r); ypb = dot8_p(Sb, cur.r);
                        if (i + 1 < SC_TC) cur = nxt;
                    }
                    float z0 = 0.f, z1 = 0.f; oct_sum4(ypa, ypb, z0, z1);
                    if (kg == 0) { yb[(SC_TC - 1) * 32] = ypa; yb[(SC_TC - 1) * 32 + 1] = ypb; }
                }
                if (grp == 1 && (c & 15) == 15) { ScDesc d; sc_desc(d, slot, 1, c);
                    float* dp = a.out + id.z + O_ST + ((((size_t)(d.b * 2 + j) * 2 + d.dir) * 16 + d.h) * 64 + d.half * 32 + ra) * 64 + 8 * kg;
                    *(f32x4*)dp = (f32x4){Sa[0][0], Sa[0][1], Sa[1][0], Sa[1][1]}; *(f32x4*)(dp + 4) = (f32x4){Sa[2][0], Sa[2][1], Sa[3][0], Sa[3][1]};
                    *(f32x4*)(dp + 64) = (f32x4){Sb[0][0], Sb[0][1], Sb[1][0], Sb[1][1]}; *(f32x4*)(dp + 68) = (f32x4){Sb[2][0], Sb[2][1], Sb[3][0], Sb[3][1]}; }
                __syncthreads();
            }
        }
        __syncthreads();
    }
}
__device__ __forceinline__ void ph_rw_post(const Args& a, const Ids& id, int layer) {
    const int j = layer >> 1, lane = id.lane;
    const bf16* RKV = (const bf16*)(a.ws + id.z + A_RKV); const float* Y = (const float*)(a.ws + id.z + A_Y);
    const bf16 *A0 = (const bf16*)(a.ws + id.z + A_A0), *A1 = (const bf16*)(a.ws + id.z + A_A1); bf16* H = (bf16*)(a.ws + id.z + A_H);
    const float* kvec = a.in[28 + id.z] + (size_t)j * 3 * D; const float* lnx = a.in[29 + id.z] + (size_t)j * 2 * D;
    f32x4 ka[4], rk[4], l0[4], l1[4];
#pragma unroll
    for (int q = 0; q < 4; ++q) { const int c = 4 * lane + 256 * q; ka[q] = *(const f32x4*)(kvec + D + c); rk[q] = *(const f32x4*)(kvec + 2 * D + c); l0[q] = *(const f32x4*)(lnx + c); l1[q] = *(const f32x4*)(lnx + D + c); }
    for (int m = id.gw; m < NTOK; m += id.ngw) {
        f32x4 y[4], r[4], k[4], v[4], a0[4], a1[4], g[4];
#pragma unroll
        for (int q = 0; q < 4; ++q) { const int c = 4 * lane + 256 * q; y[q] = *(const f32x4*)(Y + (size_t)m * D + c);
            r[q] = ld_bf4(RKV + (size_t)m * 3072 + c); k[q] = ld_bf4(RKV + (size_t)m * 3072 + 1024 + c); v[q] = ld_bf4(RKV + (size_t)m * 3072 + 2048 + c);
            a0[q] = ld_bf4(A0 + (size_t)m * D + c); a1[q] = ld_bf4(A1 + (size_t)m * D + c); g[q] = ld_bf4(H + (size_t)m * D + c); }
        float s[4], qv[4], bs[4];
#pragma unroll
        for (int q = 0; q < 4; ++q) s[q] = (y[q][0] + y[q][1]) + (y[q][2] + y[q][3]);
        row16_sum4(s[0], s[1], s[2], s[3]);
#pragma unroll
        for (int q = 0; q < 4; ++q) { const float mean = s[q] * (1.0f / 64.0f); y[q] = y[q] - mean; qv[q] = (y[q][0] * y[q][0] + y[q][1] * y[q][1]) + (y[q][2] * y[q][2] + y[q][3] * y[q][3]);
            const f32x4 kds = k[q] * ((a0[q] - 1.0f) * ka[q] + 1.0f) + k[q] * ((a1[q] - 1.0f) * ka[q] + 1.0f); const f32x4 t = r[q] * kds * rk[q]; bs[q] = (t[0] + t[1]) + (t[2] + t[3]); }
        row16_sum4(qv[0], qv[1], qv[2], qv[3]);
        row16_sum4(bs[0], bs[1], bs[2], bs[3]);
#pragma unroll
        for (int q = 0; q < 4; ++q) { const float ri = 1.0f / sqrtf(qv[q] * (1.0f / 64.0f) + 64e-5f); const f32x4 o = ((y[q] * ri) * l0[q] + l1[q] + v[q] * bs[q]) * g[q];
            *(v2u*)(H + (size_t)m * D + 4 * lane + 256 * q) = (v2u){pk2(o[0], o[1]), pk2(o[2], o[3])}; }
    }
}

enum Kind { K_PRO = 0, K_NORM0 = 1, K_QKV = 2, K_APOST = 3, K_ATTN = 4, K_ACOMB = 5, K_MIXOUT = 6, K_RNORM = 7, K_MLP1 = 8, K_MLP2 = 9, K_REND = 10,
            K_RMIX = 11, K_RKV = 12, K_RPREP = 13, K_RSCAN = 14, K_RPOST = 15 };
constexpr int NPH = 38;
__host__ __device__ __forceinline__ void decode_phase(int ph, int& kind, int& layer) {
    if (ph < 2) { kind = ph; layer = 0; return; }
    const int p = ph - 2, pair = p / 19, q = p % 19;
    if (q < 9) { layer = 2 * pair; kind = K_QKV + q; }
    else { layer = 2 * pair + 1; const int q2 = q - 9; kind = (q2 < 5) ? (K_RMIX + q2) : (K_MIXOUT + (q2 - 5)); }
}

#ifndef PROBE_MASK
#define PROBE_MASK 0
#endif
#ifndef PROBE_REPS
#define PROBE_REPS 1
#endif
template <int KIND, int LAYER>
__device__ __forceinline__ void run_phase(const Args& a, LAS unsigned char* lds, int G, int bx, int vcu, int wave_s, int rep) {
    Ids id; { int lv; asm volatile("v_mbcnt_lo_u32_b32 %0, -1, 0\n\tv_mbcnt_hi_u32_b32 %0, -1, %0" : "=v"(lv)); int zz; asm volatile("s_mov_b32 %0, 0" : "=s"(zz)); id.lane = lv; id.z = zz; }
    id.wave = wave_s; id.tid = wave_s * 64 + id.lane; id.gw = vcu * NWAVES + id.wave; id.ngw = G * NWAVES;
    constexpr int layer = LAYER;
    if constexpr (KIND == K_PRO) ph_prologue(a, id, lds);
    else if constexpr (KIND == K_NORM0) ph_norm0(a, id);
    else if constexpr (KIND == K_QKV) {
        constexpr int j = layer >> 1;
        pg8::Gemm g{(const bf16*)(a.ws + id.z + A_H), (const bf16*)(a.ws + id.z + W_WINT), NTOK, NQKV, D}; pg8::StaticOrder S; S.init(NTOK, NQKV, G, bx);
        const float* RC = (const float*)(a.ws + id.z + WS_ROPE);
        pg8::EpiQkv<QkvMap> E{a.ws + id.z, a.out + id.z, a.in[14 + id.z] + j * 128, RC, RC + 2048 * 64, j};
        pg8::gemm_phase<pg8::EpiQkv<QkvMap>, pg8::StaticOrder, true, true>(lds + RING_OFF, g, S, E, id.wave);
        { Ids id2 = id; int lv; asm volatile("v_mbcnt_lo_u32_b32 %0, -1, 0\n\tv_mbcnt_hi_u32_b32 %0, -1, %0" : "=v"(lv)); int zz; asm volatile("s_mov_b32 %0, 0" : "=s"(zz));
          id2.lane = lv; id2.z = zz; id2.tid = id.wave * 64 + lv; ph_att_cache(a, id2, layer); }
    }
    else if constexpr (KIND == K_MIXOUT) {
        pg8::Gemm g{(const bf16*)(a.ws + id.z + A_H), (const bf16*)(a.ws + id.z + ((layer & 1) ? W_WOT : W_WOUTT)), NTOK, D, D}; pg8::StaticOrder S; S.init(NTOK, D, G, bx);
        pg8::EpiF32 E{(float*)(a.ws + id.z + A_M), D};
        pg8::gemm_phase<pg8::EpiF32, pg8::StaticOrder, true, true>(lds + RING_OFF, g, S, E, id.wave);
    }
    else if constexpr (KIND == K_MLP2) {
        pg8::Gemm g{(const bf16*)(a.ws + id.z + A_HID), (const bf16*)(a.ws + id.z + W_W2T), NTOK, D, FF}; pg8::StaticOrder S; S.init(NTOK, D, G, bx);
        pg8::EpiF32 E{(float*)(a.ws + id.z + A_F), D};
        pg8::gemm_phase<pg8::EpiF32, pg8::StaticOrder, true, true>(lds + RING_OFF, g, S, E, id.wave);
    }
    else if constexpr (KIND == K_MLP1) {
        pg8::Gemm g{(const bf16*)(a.ws + id.z + A_H), (const bf16*)(a.ws + id.z + W_W1T), NTOK, FF, D}; pg8::StaticOrder S; S.init(NTOK, FF, G, bx);
        pg8::EpiBf16<2> E{(bf16*)(a.ws + id.z + A_HID), FF, 1 << 20, nullptr, 0};
        pg8::gemm_phase<pg8::EpiBf16<2>, pg8::StaticOrder, true, true>(lds + RING_OFF, g, S, E, id.wave);
    }
    else if constexpr (KIND == K_RKV) {
        {
            pg8::Gemm g{(const bf16*)(a.ws + id.z + A_A2), (const bf16*)(a.ws + id.z + W_BTL), NTOK, 512, KRKV}; pg8::StaticOrder S; S.init(NTOK, 512, G, bx);
            pg8::EpiL1 E{(bf16*)(a.ws + id.z + A_L1)};
            pg8::gemm_phase<pg8::EpiL1, pg8::StaticOrder, true, true>(lds + RING_OFF, g, S, E, id.wave); }
        {
            pg8::Gemm g{(const bf16*)(a.ws + id.z + A_XS), (const bf16*)(a.ws + id.z + W_BTR), 3 * NTOK, 3072, D}; pg8::RkvOrder S{bx};
            pg8::EpiRkv3 E{(bf16*)(a.ws + id.z + A_RKV)};
            pg8::gemm_phase<pg8::EpiRkv3, pg8::RkvOrder, true, true>(lds + RING_OFF, g, S, E, id.wave); }
    }
    else if constexpr (KIND == K_RPREP) {
        constexpr int j = layer >> 1;
        pg8::Gemm g{(const bf16*)(a.ws + id.z + A_L1), (const bf16*)(a.ws + id.z + W_BT2), NTOK, 5120, 384}; pg8::StaticOrder S; S.init(NTOK, 5120, G, bx);
        static_assert(A_A1 - A_A0 == 32 * MiB && A_EW0 - A_A0 == 64 * MiB && A_EW1 - A_A0 == 96 * MiB, "EpiLora2 output stride");
        pg8::EpiLora2 E{(bf16*)(a.ws + id.z + A_A0), (size_t)16 * MiB, (bf16*)(a.ws + id.z + A_G), a.in[23 + id.z] + (size_t)j * 2 * D, a.in[20 + id.z] + (size_t)j * 2 * D};
        pg8::gemm_phase<pg8::EpiLora2, pg8::StaticOrder, true, true>(lds + RING_OFF, g, S, E, id.wave);
        { Ids id2 = id; int lv; asm volatile("v_mbcnt_lo_u32_b32 %0, -1, 0\n\tv_mbcnt_hi_u32_b32 %0, -1, %0" : "=v"(lv)); int zz; asm volatile("s_mov_b32 %0, 0" : "=s"(zz));
          id2.lane = lv; id2.z = zz; id2.tid = id.wave * 64 + lv; ph_rw_prep(a, id2, layer); }
    }
    else if constexpr (KIND == K_ATTN) ph_attn(a, id, lds, G, vcu);
    else if constexpr (KIND == K_ACOMB) ph_att_comb(a, id, layer);
    else if constexpr (KIND == K_RNORM) ph_resid_norm(a, id, layer, rep + 1 < (((PROBE_MASK >> K_RNORM) & 1) ? PROBE_REPS : 1));
    else if constexpr (KIND == K_REND) ph_resid_end(a, id, lds, layer, rep + 1 < (((PROBE_MASK >> K_REND) & 1) ? PROBE_REPS : 1));
    else if constexpr (KIND == K_RMIX) ph_rw_mix(a, id, layer);
    else if constexpr (KIND == K_RSCAN) { if (rep > 0) { ph_rw_prep(a, id, layer); __syncthreads(); cg::this_grid().sync(); } ph_rw_scan(a, id, lds, layer, G, vcu); }
    else if constexpr (KIND == K_RPOST) ph_rw_post(a, id, layer);
}

__global__ void __launch_bounds__(NWAVES * 64, 2) mega_fwd(Args a) {
    extern __shared__ __attribute__((aligned(16))) unsigned char lds_raw[];
    LAS unsigned char* lds = (LAS unsigned char*)lds_raw;
    const int G = gridDim.x, bx = blockIdx.x; const int vcu = (G % 8 == 0) ? (bx % 8) * (G / 8) + bx / 8 : bx;
    volatile LAS unsigned* MISC = (volatile LAS unsigned*)(lds + MISC_OFF);
    for (int u = threadIdx.x; u < (LDS_BYTES - LDSCTL_OFF) / 4; u += NWAVES * 64) ((LAS unsigned*)(lds + LDSCTL_OFF))[u] = 0u;
    __syncthreads();
#if MK_N_LAUNCHES == 1 && !MK_CG_BARRIER
    XcdBarrier bar = xcd_barrier_post((unsigned*)(a.ws + WS_CTL) + CW_BAR, MISC + 8, threadIdx.x == 0);
#endif
    (void)MISC;
    const int lo = a.ph_lo, hi = a.ph_hi;
    const int wave_s = __builtin_amdgcn_readfirstlane(threadIdx.x >> 6);
#if MK_N_LAUNCHES == 1
#if MK_CG_BARRIER
#define GRID_BAR(ph) cg::this_grid().sync()
#else
#define GRID_BAR(ph) do { if ((ph) == 0) cg::this_grid().sync(); else { int l_; asm volatile("v_mbcnt_lo_u32_b32 %0, -1, 0\n\tv_mbcnt_hi_u32_b32 %0, -1, %0" : "=v"(l_)); xcd_barrier(bar, wave_s == 0 && l_ == 0); } } while (0)
#endif
#else
#define GRID_BAR(ph) do { } while (0)
#endif
#define PHASE(ph, KIND, LAYER) do { if (lo <= (ph) && (ph) < hi) { constexpr int nrep_ = ((PROBE_MASK >> (KIND)) & 1) ? PROBE_REPS : 1; \
        _Pragma("unroll 1") for (int rep_ = 0; rep_ < nrep_; ++rep_) { run_phase<KIND, LAYER>(a, lds, G, bx, vcu, wave_s, rep_); if (rep_ + 1 < nrep_) { __syncthreads(); cg::this_grid().sync(); } } \
        if ((ph) + 1 < hi) GRID_BAR(ph); } } while (0)
#define ATTN_LAYER(p0, L) PHASE((p0) + 0, K_QKV, L); PHASE((p0) + 1, K_ATTN, L); PHASE((p0) + 2, K_ACOMB, L); PHASE((p0) + 3, K_MIXOUT, L); \
        PHASE((p0) + 4, K_RNORM, L); PHASE((p0) + 5, K_MLP1, L); PHASE((p0) + 6, K_MLP2, L); PHASE((p0) + 7, K_REND, L)
#define RWKV_LAYER(p0, L) PHASE((p0) + 0, K_RMIX, L); PHASE((p0) + 1, K_RKV, L); PHASE((p0) + 2, K_RPREP, L); PHASE((p0) + 3, K_RSCAN, L); PHASE((p0) + 4, K_RPOST, L); PHASE((p0) + 5, K_MIXOUT, L); \
        PHASE((p0) + 6, K_RNORM, L); PHASE((p0) + 7, K_MLP1, L); PHASE((p0) + 8, K_MLP2, L); PHASE((p0) + 9, K_REND, L)
    PHASE(0, K_PRO, 0); PHASE(1, K_NORM0, 0);
    ATTN_LAYER(2, 0); RWKV_LAYER(10, 1); ATTN_LAYER(20, 2); RWKV_LAYER(28, 3);
#undef PHASE
#undef ATTN_LAYER
#undef RWKV_LAYER
#undef GRID_BAR
}

extern "C" void kernel_launch(void* const* d_in, const int* in_sizes, int n_in, void* d_out, int out_size, void* d_ws, size_t ws_size, hipStream_t stream) {
    static int grid = 0;
    if (grid == 0) {
        if (n_in != 32 || (size_t)out_size != OUT_TOTAL || ws_size < WS_END) { fprintf(stderr, "kernel_launch: unexpected problem (n_in %d, out %d, ws %zu; need ws >= %zu); nothing launched\n", n_in, out_size, ws_size, (size_t)WS_END); grid = -1; return; }
        int dev = 0, cus = 0, per_cu = 0;
        if (hipGetDevice(&dev) != hipSuccess || hipDeviceGetAttribute(&cus, hipDeviceAttributeMultiprocessorCount, dev) != hipSuccess) { grid = -1; return; }
        if (hipFuncSetAttribute((const void*)mega_fwd, hipFuncAttributeMaxDynamicSharedMemorySize, LDS_BYTES) != hipSuccess) { fprintf(stderr, "kernel_launch: hipFuncSetAttribute failed\n"); grid = -1; return; }
        if (hipOccupancyMaxActiveBlocksPerMultiprocessor(&per_cu, (const void*)mega_fwd, NWAVES * 64, LDS_BYTES) != hipSuccess || per_cu < 1) { fprintf(stderr, "kernel_launch: occupancy query failed (%d)\n", per_cu); (void)hipGetLastError(); per_cu = 1; }
        grid = cus * (per_cu < 1 ? 1 : 1);
        fprintf(stderr, "kernel_launch: %d CUs, occupancy %d/CU, grid %d\n", cus, per_cu, grid);
    }
    if (grid < 0) return;
    (void)in_sizes;
    if (hipMemsetAsync((char*)d_ws + WS_CTL, 0, CTL_ZERO_BYTES, stream) != hipSuccess) { fprintf(stderr, "kernel_launch: memset failed\n"); return; }
    Args a{};
    for (int i = 0; i < 32; ++i) a.in[i] = (const float*)d_in[i];
    a.out = (float*)d_out; a.ws = (unsigned char*)d_ws;
#if MK_N_LAUNCHES == 1
    a.ph_lo = 0; a.ph_hi = NPH;
    void* args[] = {&a};
    hipError_t e = hipLaunchCooperativeKernel((const void*)mega_fwd, dim3(grid), dim3(NWAVES * 64), args, LDS_BYTES, stream);
    if (e != hipSuccess) fprintf(stderr, "kernel_launch: cooperative launch failed: %s (grid %d)\n", hipGetErrorString(e), grid);
#else
    for (int ph = 0; ph < NPH; ++ph) {
        a.ph_lo = ph; a.ph_hi = ph + 1;
        hipLaunchKernelGGL(mega_fwd, dim3(grid), dim3(NWAVES * 64), LDS_BYTES, stream, a);
    }
#endif
}
```

```cpp
#include <hip/hip_runtime.h>
#include <hip/hip_cooperative_groups.h>
#include <cstdio>
#include <cstdint>
namespace cg = cooperative_groups;
namespace pg8 {
#define PG8_LAS __attribute__((address_space(3)))
typedef unsigned short bf16_t;
typedef short bf16x8 __attribute__((ext_vector_type(8)));
typedef float f32x4 __attribute__((ext_vector_type(4)));
typedef unsigned u32x4 __attribute__((ext_vector_type(4)));
constexpr int BM = 256, BK = 64, HALF = 128, HTB = HALF * BK * 2  , STAGE_BYTES = 8 * HTB, NXCD = 8, WGM = 8;

__host__ __device__ __forceinline__ int lds_byte(int r, int c) { const int st = (r >> 4) * 2 + (c >> 5), rr = r & 15, cc = c & 31, ob = rr * 64 + cc * 2; return st * 1024 + (ob ^ (((ob >> 9) & 1) << 5)); }
__host__ __device__ __forceinline__ void stage_rc(int b, int& R, int& C) { const int st = b / 1024, sb = b % 1024, swz = sb ^ (((sb >> 9) & 1) << 5); R = (st >> 1) * 16 + swz / 64; C = (st & 1) * 32 + (swz % 64) / 2; }
__host__ __device__ __forceinline__ int perm32(int rho) { const int n = rho >> 4, i = rho & 15; return 8 * (i >> 2) + 4 * n + (i & 3); }

struct Unit { int pm, pn; };
struct Gemm { const bf16_t* A; const bf16_t* Bt; int M, N, K; };

struct StaticOrder {
    int nM, nN, nwg, G, c;
    __host__ __device__ void init(int M, int N, int G_, int c_) { nM = M / BM; nN = N / BM; nwg = nM * nN; G = G_; c = c_; }
    __host__ __device__ bool next(int i, Unit& u) const {
        const long L = (long)i * G + c; if (L >= nwg) return false;
        int wgid = (int)L; { const int q = nwg / NXCD, r = nwg % NXCD, xcd = wgid % NXCD, off = wgid / NXCD; wgid = (xcd < r ? xcd * (q + 1) : r * (q + 1) + (xcd - r) * q) + off; }
        const int nig = WGM * nN, gid = wgid / nig, fm = gid * WGM, gsz = (nM - fm) < WGM ? (nM - fm) : WGM;
        u.pm = fm + ((wgid % nig) % gsz); u.pn = (wgid % nig) / gsz; return true;
    }
    __device__ __forceinline__ void a_ready(const Unit&) const {}
    __device__ __forceinline__ void done(const Unit&) const {}
};


__device__ __forceinline__ unsigned cvt_pk_bf16(float lo, float hi) { unsigned r; asm volatile("v_cvt_pk_bf16_f32 %0, %1, %2" : "=v"(r) : "v"(lo), "v"(hi)); return r; }

template <int ACT> struct EpiBf16 {
    static constexpr bool PERM = true, AFTER_DRAIN = false;
    bf16_t* O0; int ld0; int nt0; bf16_t* O1; int ld1;
    __device__ __forceinline__ void operator()(const f32x4 (&acc)[2][2][4][2], const Unit& u, int wr, int wc, int fr, int fq) const {
        const int row0 = u.pm * BM + wr * 64 + fr;
        bf16_t* base; int ldc, colt;
        if (u.pn < nt0) { base = O0; ldc = ld0; colt = u.pn * BM; } else { base = O1; ldc = ld1; colt = (u.pn - nt0) * BM; }
        const int col0 = colt + wc * 32 + 8 * fq;
#pragma unroll
        for (int ai = 0; ai < 2; ++ai)
#pragma unroll
            for (int m = 0; m < 4; ++m) { bf16_t* rowp = base + (size_t)(row0 + ai * HALF + m * 16) * ldc + col0;
#pragma unroll
                for (int bj = 0; bj < 2; ++bj) { f32x4 v0 = acc[ai][bj][m][0], v1 = acc[ai][bj][m][1];
                    if (ACT == 2) {
#pragma unroll
                        for (int e = 0; e < 4; ++e) { float a = v0[e] > 0.f ? v0[e] : 0.f; v0[e] = a * a; float b = v1[e] > 0.f ? v1[e] : 0.f; v1[e] = b * b; } }
                    u32x4 w; w.x = cvt_pk_bf16(v0[0], v0[1]); w.y = cvt_pk_bf16(v0[2], v0[3]); w.z = cvt_pk_bf16(v1[0], v1[1]); w.w = cvt_pk_bf16(v1[2], v1[3]);
                    *(u32x4*)(rowp + bj * HALF) = w; } }
    }
    __device__ __forceinline__ void fused(f32x4 (&)[2][2][4][2], const Unit&, int, int, int, int, PG8_LAS unsigned char*, int, int) const {}
};


__device__ __forceinline__ float sig_f(float x) { return 1.0f / (1.0f + __expf(-x)); }
struct RkvOrder {
    int c;
    __device__ __forceinline__ bool next(int i, Unit& u) const {
        int L; if (c < 128) { if (i >= 2) return false; L = c * 2 + i; } else { if (i >= 4) return false; L = 256 + (c - 128) * 4 + i; }
        const int which = L >> 8, r = L & 255; u.pm = which * 64 + (r >> 2); u.pn = which * 4 + (r & 3); return true; }
    __device__ __forceinline__ void a_ready(const Unit&) const {}
    __device__ __forceinline__ void done(const Unit&) const {}
};
struct EpiRkv3 {
    static constexpr bool PERM = true, AFTER_DRAIN = false;
    bf16_t* RKV;
    __device__ __forceinline__ void operator()(const f32x4 (&acc)[2][2][4][2], const Unit& u, int wr, int wc, int fr, int fq) const {
        const int row0 = (u.pm & 63) * BM + wr * 64 + fr, col0 = u.pn * BM + wc * 32 + 8 * fq;
#pragma unroll
        for (int ai = 0; ai < 2; ++ai)
#pragma unroll
            for (int m = 0; m < 4; ++m) { bf16_t* rowp = RKV + (size_t)(row0 + ai * HALF + m * 16) * 3072 + col0;
#pragma unroll
                for (int bj = 0; bj < 2; ++bj) { const f32x4 v0 = acc[ai][bj][m][0], v1 = acc[ai][bj][m][1];
                    u32x4 w; w.x = cvt_pk_bf16(v0[0], v0[1]); w.y = cvt_pk_bf16(v0[2], v0[3]); w.z = cvt_pk_bf16(v1[0], v1[1]); w.w = cvt_pk_bf16(v1[2], v1[3]);
                    *(u32x4*)(rowp + bj * HALF) = w; } }
    }
};
struct EpiL1 {
    static constexpr bool PERM = true, AFTER_DRAIN = false;
    bf16_t* L1;
    __device__ __forceinline__ void operator()(const f32x4 (&acc)[2][2][4][2], const Unit& u, int wr, int wc, int fr, int fq) const {
        const int row0 = u.pm * BM + wr * 64 + fr, colt = u.pn * BM, col0 = colt + wc * 32 + 8 * fq;
#pragma unroll
        for (int ai = 0; ai < 2; ++ai)
#pragma unroll
            for (int m = 0; m < 4; ++m) { bf16_t* rowp = L1 + (size_t)(row0 + ai * HALF + m * 16) * 384 + col0;
#pragma unroll
                for (int bj = 0; bj < 2; ++bj) { f32x4 v0 = acc[ai][bj][m][0], v1 = acc[ai][bj][m][1];
                    const int cb = colt + bj * HALF;
                    if (cb >= 384) continue;
                    if (cb == 0) {
#pragma unroll
                        for (int e = 0; e < 4; ++e) { v0[e] = 1.0f - 2.0f / (1.0f + __expf(2.0f * v0[e])); v1[e] = 1.0f - 2.0f / (1.0f + __expf(2.0f * v1[e])); } }
                    else if (cb == 256) {
#pragma unroll
                        for (int e = 0; e < 4; ++e) { v0[e] = sig_f(v0[e]); v1[e] = sig_f(v1[e]); } }
                    u32x4 w; w.x = cvt_pk_bf16(v0[0], v0[1]); w.y = cvt_pk_bf16(v0[2], v0[3]); w.z = cvt_pk_bf16(v1[0], v1[1]); w.w = cvt_pk_bf16(v1[2], v1[3]);
                    *(u32x4*)(rowp + bj * HALF) = w; } }
    }
};
struct EpiLora2 {
    static constexpr bool PERM = true, AFTER_DRAIN = false;
    bf16_t* o4; size_t ostride; bf16_t* og; const float* a0; const float* w0;
    __device__ __forceinline__ void operator()(const f32x4 (&acc)[2][2][4][2], const Unit& u, int wr, int wc, int fr, int fq) const {
        const int row0 = u.pm * BM + wr * 64 + fr; const int blk = u.pn >> 2, colt = (u.pn & 3) * BM;
        bf16_t* base = (blk < 4) ? o4 + (size_t)blk * ostride : og;
        const float* bs = ((blk < 2) ? a0 : w0) + (blk & 1) * 1024;
        const int col0 = colt + wc * 32 + 8 * fq;
        const float sc = (blk >= 2) ? 0.8750387749719753f : 1.0f;
#pragma unroll
        for (int bj = 0; bj < 2; ++bj) {
            f32x4 b0 = (f32x4){0.f, 0.f, 0.f, 0.f}, b1 = b0;
            if (blk < 4) { b0 = *(const f32x4*)(bs + col0 + bj * HALF); b1 = *(const f32x4*)(bs + col0 + bj * HALF + 4); }
#pragma unroll
            for (int ai = 0; ai < 2; ++ai)
#pragma unroll
                for (int m = 0; m < 4; ++m) { bf16_t* rowp = base + (size_t)(row0 + ai * HALF + m * 16) * 1024 + col0;
                    f32x4 v0 = acc[ai][bj][m][0] + b0, v1 = acc[ai][bj][m][1] + b1;
                    if (blk < 4) {
#pragma unroll
                        for (int e = 0; e < 4; ++e) { v0[e] = sc * sig_f(v0[e]); v1[e] = sc * sig_f(v1[e]); } }
                    u32x4 w; w.x = cvt_pk_bf16(v0[0], v0[1]); w.y = cvt_pk_bf16(v0[2], v0[3]); w.z = cvt_pk_bf16(v1[0], v1[1]); w.w = cvt_pk_bf16(v1[2], v1[3]);
                    *(u32x4*)(rowp + bj * HALF) = w; } }
    }
};


template <class MP> struct EpiQkv {
    static constexpr bool PERM = true, AFTER_DRAIN = false;
    unsigned char* ws; float* out; const float* gain; const float* RC; const float* RS; int j;
    static constexpr size_t oQA = MP::oQA, oQB = MP::oQB, oKAP = MP::oKAP, oVAP = MP::oVAP, oKBP = MP::oKBP, oVBP = MP::oVBP, oKAS = MP::oKAS, oVAS = MP::oVAS, oKBS = MP::oKBS, oVBS = MP::oVBS;
    static constexpr size_t oKG = MP::oKG, oVG = MP::oVG, oKD = MP::oKD, oVD = MP::oVD;
    __device__ __forceinline__ void operator()(const f32x4 (&acc)[2][2][4][2], const Unit& u, int wr, int wc, int fr, int fq) const {
        const int ch = 4 * u.pn + wc; const bool smp = u.pm >= 32;
        const bool isq = (ch < 8) || (ch >= 12 && ch < 20), isk = (ch == 8 || ch == 9) || (ch >= 20 && ch < 28);
        const int dl = 8 * fq;
        const bool hi2 = (fq & 2) != 0;
        f32x4 g[2][2];
#pragma unroll
        for (int bj = 0; bj < 2; ++bj)
#pragma unroll
            for (int n = 0; n < 2; ++n) g[bj][n] = (ch < 10) ? *(const f32x4*)(gain + (ch < 8 ? 0 : 64) + bj * 32 + dl + 4 * n) : (f32x4){1.f, 1.f, 1.f, 1.f};
        constexpr float QS = 0.18033688011112042f;
#pragma unroll
        for (int ai = 0; ai < 2; ++ai)
#pragma unroll
            for (int m = 0; m < 4; ++m) {
                const int mrow = u.pm * BM + ai * HALF + wr * 64 + m * 16 + fr;
                const int b = smp ? ((mrow - 8192) >> 11) : (mrow >> 8), t = smp ? ((mrow - 8192) & 2047) : (mrow & 255);
                f32x4 v[2][2];
#pragma unroll
                for (int bj = 0; bj < 2; ++bj)
#pragma unroll
                    for (int n = 0; n < 2; ++n) v[bj][n] = acc[ai][bj][m][n];
                if (ch < 10) { float ss = 0.f;
#pragma unroll
                    for (int bj = 0; bj < 2; ++bj)
#pragma unroll
                        for (int n = 0; n < 2; ++n) ss += (v[bj][n][0] * v[bj][n][0] + v[bj][n][1] * v[bj][n][1]) + (v[bj][n][2] * v[bj][n][2] + v[bj][n][3] * v[bj][n][3]);
                    ss += __shfl_xor(ss, 16); ss += __shfl_xor(ss, 32);
                    const float ri = 1.0f / sqrtf(ss * (1.0f / 64.0f) + 1e-6f);
#pragma unroll
                    for (int bj = 0; bj < 2; ++bj)
#pragma unroll
                        for (int n = 0; n < 2; ++n) v[bj][n] = v[bj][n] * ri * g[bj][n]; }
                f32x4 vr[2][2];
#pragma unroll
                for (int bj = 0; bj < 2; ++bj)
#pragma unroll
                    for (int n = 0; n < 2; ++n) { vr[bj][n] = v[bj][n];
                        if (smp && (isq || isk)) { f32x4 p; p[0] = __shfl_xor(v[bj][n][0], 32); p[1] = __shfl_xor(v[bj][n][1], 32); p[2] = __shfl_xor(v[bj][n][2], 32); p[3] = __shfl_xor(v[bj][n][3], 32);
                            const f32x4 cs = *(const f32x4*)(RC + t * 64 + bj * 32 + dl + 4 * n), sn = *(const f32x4*)(RS + t * 64 + bj * 32 + dl + 4 * n);
                            const f32x4 rot = hi2 ? p : -p; vr[bj][n] = v[bj][n] * cs + rot * sn; } }
#define EQ_PK8(x0, x1) ((u32x4){cvt_pk_bf16((x0)[0], (x0)[1]), cvt_pk_bf16((x0)[2], (x0)[3]), cvt_pk_bf16((x1)[0], (x1)[1]), cvt_pk_bf16((x1)[2], (x1)[3])})
                const size_t srow = (size_t)(b * 2560 + 512 + t), prow = (size_t)((b * 2 + j) * 256 + t);
#pragma unroll
                for (int bj = 0; bj < 2; ++bj) {
                    const int f0 = bj * 32 + dl;
                    if (isq) { const f32x4 s0 = vr[bj][0] * QS, s1 = vr[bj][1] * QS; const size_t o = (ch < 8) ? oQA + ((size_t)mrow * 512 + ch * 64 + f0) * 2 : oQB + ((size_t)mrow * 512 + (ch - 12) * 64 + f0) * 2;
                        *(u32x4*)(ws + o) = EQ_PK8(s0, s1); }
                    else {
                        const bool gq = ch < 12, kk = isk;
                        const int e = gq ? ((ch & 1) * 64 + f0) : ((ch - (kk ? 20 : 28)) * 64 + f0); const int wdt = gq ? 128 : 512;
                        if (!smp) { const size_t of = (gq ? (kk ? oKG : oVG) : (kk ? oKD : oVD)) + prow * wdt + e; *(f32x4*)(out + of) = v[bj][0]; *(f32x4*)(out + of + 4) = v[bj][1];
                            const size_t o = (gq ? (kk ? oKAP : oVAP) : (kk ? oKBP : oVBP)) + ((size_t)mrow * wdt + e) * 2; *(u32x4*)(ws + o) = EQ_PK8(v[bj][0], v[bj][1]); }
                        else { const size_t o = (gq ? (kk ? oKAS : oVAS) : (kk ? oKBS : oVBS)) + (srow * wdt + e) * 2; *(u32x4*)(ws + o) = EQ_PK8(vr[bj][0], vr[bj][1]); } }
                }
#undef EQ_PK8
            }
    }
};

template <class Epi, class Sched, bool ALIGN_EPI = false, bool SP2 = false>
__device__ __forceinline__ void gemm_phase(PG8_LAS unsigned char* lds, const Gemm g, const Sched& S, const Epi& E, const int wave_index) {
    int lane_o; asm volatile("v_mbcnt_lo_u32_b32 %0, -1, 0\n\tv_mbcnt_hi_u32_b32 %0, -1, %0" : "=v"(lane_o));
    const int wid = wave_index, lane = lane_o, tid = wid * 64 + lane, wr = wid >> 2, wc = wid & 3, fr = lane & 15, fq = lane >> 4;
    const int K = g.K, nt = K / BK;
    unsigned voffA[2], voffB[2];
#pragma unroll
    for (int i = 0; i < 2; ++i) { int R, C; stage_rc(tid * 16 + i * 8192, R, C); const int Rb = Epi::PERM ? ((R & ~31) + perm32(R & 31)) : R;
        voffA[i] = (unsigned)(R * K + C) * 2u; voffB[i] = (unsigned)(Rb * K + C) * 2u; }
    const size_t kstep = (size_t)(BK * 2);
    const size_t hstep = (size_t)HALF * K * 2;
    const size_t tstep = 2 * hstep;
    const unsigned ldsw = (unsigned)wid * 1024u;
    const int aoff = lds_byte(wr * 64 + fr, fq * 8), boff = lds_byte(wc * 32 + fr, fq * 8);
#define PG8_SA(b, h) (((b) * 2 + (h)) * HTB)
#define PG8_SB(b, h) ((4 + (b) * 2 + (h)) * HTB)
#define PG8_STAGE(bufoff, gbase, voff) do { _Pragma("unroll") for (int _i = 0; _i < 2; ++_i) \
        __builtin_amdgcn_global_load_lds((const unsigned*)((const char*)(gbase) + (voff)[_i]), (PG8_LAS unsigned*)(lds + (bufoff) + ldsw + _i * 8192), 16, 0, 0); } while (0)
#define PG8_LDA(dst, b, h) do { _Pragma("unroll") for (int m = 0; m < 4; ++m) _Pragma("unroll") for (int k = 0; k < 2; ++k) dst[m][k] = *(const PG8_LAS bf16x8*)(lds + PG8_SA(b, h) + aoff + m * 2048 + k * 1024); } while (0)
#define PG8_LDB(dst, b, h) do { _Pragma("unroll") for (int n = 0; n < 2; ++n) _Pragma("unroll") for (int k = 0; k < 2; ++k) dst[n][k] = *(const PG8_LAS bf16x8*)(lds + PG8_SB(b, h) + boff + n * 2048 + k * 1024); } while (0)
#define PG8_MMA(ai, bj, At, Bt) do { __builtin_amdgcn_s_setprio(1); _Pragma("unroll") for (int m = 0; m < 4; ++m) _Pragma("unroll") for (int n = 0; n < 2; ++n) _Pragma("unroll") for (int k = 0; k < 2; ++k) \
        acc[ai][bj][m][n] = __builtin_amdgcn_mfma_f32_16x16x32_bf16(Bt[n][k], At[m][k], acc[ai][bj][m][n], 0, 0, 0); __builtin_amdgcn_s_setprio(0); } while (0)
#define PG8_WAIT_V(n) asm volatile("s_waitcnt vmcnt(" #n ")" ::: "memory")
#define PG8_WAIT_L(n) asm volatile("s_waitcnt lgkmcnt(" #n ")" ::: "memory")
#define PG8_BAR __builtin_amdgcn_s_barrier()
#define PG8_SCHED __builtin_amdgcn_sched_barrier(0)
    Unit cur, nxt; int ui = 0;
    if (!S.next(0, cur)) return;
    f32x4 acc[2][2][4][2];
#pragma unroll
    for (int a = 0; a < 2; ++a)
#pragma unroll
        for (int b = 0; b < 2; ++b)
#pragma unroll
            for (int m = 0; m < 4; ++m)
#pragma unroll
                for (int n = 0; n < 2; ++n) acc[a][b][m][n] = (f32x4){0.f, 0.f, 0.f, 0.f};
    bf16x8 At[4][2], B0[2][2], B1[2][2];
    const char* cA = (const char*)g.A + (size_t)cur.pm * tstep; const char* cB = (const char*)g.Bt + (size_t)cur.pn * tstep;
    S.a_ready(cur);
    if constexpr (SP2) {
        PG8_STAGE(PG8_SB(0, 0), cB, voffB); PG8_STAGE(PG8_SB(0, 1), cB + hstep, voffB); PG8_STAGE(PG8_SA(0, 0), cA, voffA); PG8_STAGE(PG8_SA(0, 1), cA + hstep, voffA);
        if (wr == 1) PG8_BAR;
        PG8_WAIT_V(2); PG8_BAR;
        PG8_STAGE(PG8_SB(1, 0), cB + kstep, voffB); PG8_STAGE(PG8_SA(1, 0), cA + kstep, voffA); PG8_STAGE(PG8_SB(1, 1), cB + hstep + kstep, voffB);
        PG8_WAIT_V(6); PG8_BAR;
    } else {
        PG8_STAGE(PG8_SB(0, 0), cB, voffB); PG8_STAGE(PG8_SA(0, 0), cA, voffA); PG8_STAGE(PG8_SB(0, 1), cB + hstep, voffB); PG8_STAGE(PG8_SA(0, 1), cA + hstep, voffA);
        if (wr == 1) PG8_BAR;
        PG8_WAIT_V(4); PG8_BAR;
        PG8_STAGE(PG8_SB(1, 0), cB + kstep, voffB); PG8_STAGE(PG8_SA(1, 0), cA + kstep, voffA); PG8_STAGE(PG8_SB(1, 1), cB + hstep + kstep, voffB);
        PG8_WAIT_V(6); PG8_BAR;
    }
    for (;;) {
        const bool has_next = S.next(ui + 1, nxt);
        const char* nA = has_next ? (const char*)g.A + (size_t)nxt.pm * tstep : cA; const char* nB = has_next ? (const char*)g.Bt + (size_t)nxt.pn * tstep : cB;
#pragma unroll 1
        for (int t = 0; t < nt; t += 2) {
            const bool last = (t == nt - 2);
            const char* a1 = cA + (size_t)(t + 1) * kstep;
            const char* a2 = last ? nA : cA + (size_t)(t + 2) * kstep; const char* b2 = last ? nB : cB + (size_t)(t + 2) * kstep;
            const char* a3 = a2 + kstep; const char* b3 = b2 + kstep;
            if (last && has_next) S.a_ready(nxt);
            if constexpr (SP2) {
            PG8_LDB(B0, 0, 0); PG8_LDB(B1, 0, 1); PG8_SCHED; PG8_LDA(At, 0, 0); PG8_STAGE(PG8_SA(1, 1), a1 + hstep, voffA);
            PG8_WAIT_V(8); PG8_WAIT_L(0); PG8_BAR; PG8_MMA(0, 0, At, B0); PG8_MMA(0, 1, At, B1); PG8_BAR; PG8_SCHED;
            PG8_LDA(At, 0, 1); PG8_STAGE(PG8_SB(0, 0), b2, voffB); PG8_STAGE(PG8_SB(0, 1), b2 + hstep, voffB); PG8_STAGE(PG8_SA(0, 0), a2, voffA);
            PG8_WAIT_V(8); PG8_WAIT_L(0); PG8_BAR; PG8_MMA(1, 0, At, B0); PG8_MMA(1, 1, At, B1); PG8_BAR; PG8_SCHED;
            PG8_LDB(B0, 1, 0); PG8_LDB(B1, 1, 1); PG8_SCHED; PG8_LDA(At, 1, 0); PG8_STAGE(PG8_SA(0, 1), a2 + hstep, voffA);
            PG8_WAIT_V(8); PG8_WAIT_L(0); PG8_BAR; PG8_MMA(0, 0, At, B0); PG8_MMA(0, 1, At, B1); PG8_BAR; PG8_SCHED;
            PG8_LDA(At, 1, 1); PG8_STAGE(PG8_SB(1, 0), b3, voffB); PG8_STAGE(PG8_SB(1, 1), b3 + hstep, voffB); PG8_STAGE(PG8_SA(1, 0), a3, voffA);
            PG8_WAIT_V(8); PG8_WAIT_L(0); PG8_BAR; PG8_MMA(1, 0, At, B0); PG8_MMA(1, 1, At, B1); PG8_BAR; PG8_SCHED;
            } else {
            PG8_LDB(B0, 0, 0); PG8_SCHED; PG8_LDA(At, 0, 0); PG8_STAGE(PG8_SA(1, 1), a1 + hstep, voffA);
            PG8_WAIT_L(8); PG8_BAR; PG8_WAIT_L(0); PG8_MMA(0, 0, At, B0); PG8_BAR; PG8_SCHED;
            PG8_LDB(B1, 0, 1); PG8_STAGE(PG8_SB(0, 0), b2, voffB);
            PG8_BAR; PG8_WAIT_L(0); PG8_MMA(0, 1, At, B1); PG8_BAR;
            PG8_LDA(At, 0, 1); PG8_STAGE(PG8_SA(0, 0), a2, voffA);
            PG8_BAR; PG8_WAIT_L(0); PG8_MMA(1, 0, At, B0); PG8_BAR; PG8_SCHED;
            PG8_STAGE(PG8_SB(0, 1), b2 + hstep, voffB);
            PG8_WAIT_V(6); PG8_BAR; PG8_MMA(1, 1, At, B1); PG8_BAR;
            PG8_LDB(B0, 1, 0); PG8_SCHED; PG8_LDA(At, 1, 0); PG8_STAGE(PG8_SA(0, 1), a2 + hstep, voffA);
            PG8_WAIT_L(8); PG8_BAR; PG8_WAIT_L(0); PG8_MMA(0, 0, At, B0); PG8_BAR; PG8_SCHED;
            PG8_LDB(B1, 1, 1); PG8_STAGE(PG8_SB(1, 0), b3, voffB);
            PG8_BAR; PG8_WAIT_L(0); PG8_MMA(0, 1, At, B1); PG8_BAR;
            PG8_LDA(At, 1, 1); PG8_STAGE(PG8_SA(1, 0), a3, voffA);
            PG8_BAR; PG8_WAIT_L(0); PG8_MMA(1, 0, At, B0); PG8_BAR; PG8_SCHED;
            PG8_STAGE(PG8_SB(1, 1), b3 + hstep, voffB);
            PG8_WAIT_V(6); PG8_BAR; PG8_MMA(1, 1, At, B1); PG8_BAR;
            }
        }
        if constexpr (ALIGN_EPI) { if (wr == 0) PG8_BAR; }
        if constexpr (!Epi::AFTER_DRAIN) { E(acc, cur, wr, wc, fr, fq); S.done(cur); }
        if (!has_next) break;
#pragma unroll
        for (int a = 0; a < 2; ++a)
#pragma unroll
            for (int b = 0; b < 2; ++b)
#pragma unroll
                for (int m = 0; m < 4; ++m)
#pragma unroll
                    for (int n = 0; n < 2; ++n) acc[a][b][m][n] = (f32x4){0.f, 0.f, 0.f, 0.f};
        cur = nxt; cA = nA; cB = nB; ++ui;
        if constexpr (ALIGN_EPI) { if (wr == 1) PG8_BAR; }
    }
    PG8_WAIT_V(0);
    if constexpr (!ALIGN_EPI) { if (wr == 0) PG8_BAR; }
    PG8_BAR;
    if constexpr (Epi::AFTER_DRAIN) { E.fused(acc, cur, wr, wc, fr, fq, lds, wid, lane); S.done(cur); }
#undef PG8_SA
#undef PG8_SB
#undef PG8_STAGE
#undef PG8_LDA
#undef PG8_LDB
#undef PG8_MMA
#undef PG8_WAIT_V
#undef PG8_WAIT_L
#undef PG8_BAR
#undef PG8_SCHED
}
}

#define GAS __attribute__((address_space(1)))
#define LAS __attribute__((address_space(3)))
typedef unsigned short bf16;
typedef unsigned v4u __attribute__((ext_vector_type(4)));
typedef unsigned v2u __attribute__((ext_vector_type(2)));
typedef float f32x4 __attribute__((ext_vector_type(4)));
#define LDS_WAIT() asm volatile("s_waitcnt lgkmcnt(0)" ::: "memory")

#ifndef MK_N_LAUNCHES
#define MK_N_LAUNCHES 1
#endif
#ifndef MK_CG_BARRIER
#define MK_CG_BARRIER 0
#endif

constexpr int D = 1024, NTOK = 16384, NPR = 8192, TP = 256, TS = 2048, PAST = 512, SKV = 2560, FF = 4096, DEPTH = 4;
constexpr int NQKV = 2304, NRKV = 3584, KRKV = 2048;
constexpr int NWAVES = 8;
constexpr size_t O_X = 0, O_KG = 16777216, O_VG = 18874368, O_KD = 20971520, O_VD = 29360128, O_ST = 37748736, OUT_TOTAL = 46137344;
constexpr size_t MiB = 1u << 20;
constexpr size_t WS_CTL = 0, CTL_ZERO_BYTES = 1 * MiB;
constexpr size_t WS_MOD = 65536;
constexpr size_t WS_ROPE = 1 * MiB;
constexpr size_t WS_INV = 2 * MiB;
constexpr size_t WS_W = 4 * MiB;
constexpr size_t W_W1T = WS_W, W_W2T = WS_W + 8 * MiB, W_MIX = WS_W + 16 * MiB;
constexpr size_t W_WINT = W_MIX, W_WOUTT = W_MIX + 6 * MiB;
constexpr size_t W_BTR = W_MIX, W_BTL = W_MIX + 6 * MiB, W_WOT = W_MIX + 14 * MiB, W_BT2 = W_MIX + 16 * MiB;
constexpr size_t AR = 40 * MiB;
constexpr size_t A_H = AR;
constexpr size_t A_QKVRAW = AR + 32 * MiB;
constexpr size_t A_DT = AR + 32 * MiB;
constexpr size_t A_M = AR + 96 * MiB;
constexpr size_t A_QA = AR + 176 * MiB, A_QB = AR + 192 * MiB, A_KAP = AR + 208 * MiB, A_VAP = AR + 210 * MiB, A_KBP = AR + 212 * MiB, A_VBP = AR + 220 * MiB;
constexpr size_t A_KAS = AR + 228 * MiB, A_VAS = AR + 231 * MiB, A_KBS = AR + 234 * MiB, A_VBS = AR + 244 * MiB;
constexpr size_t A_HID = AR + 32 * MiB;
constexpr size_t A_F = AR + 160 * MiB;
constexpr size_t A_A2 = AR + 32 * MiB;
constexpr size_t A_XS = AR + 208 * MiB;
constexpr size_t A_Y = AR + 32 * MiB;
constexpr size_t A_RKV = AR + 96 * MiB;
constexpr size_t A_L1 = AR + 192 * MiB;
constexpr size_t A_G = A_H;
constexpr size_t A_A0 = AR + 208 * MiB, A_A1 = AR + 240 * MiB, A_EW0 = AR + 272 * MiB, A_EW1 = AR + 304 * MiB;
constexpr size_t WS_END = AR + 336 * MiB;
struct QkvMap { static constexpr size_t oQA = A_QA, oQB = A_QB, oKAP = A_KAP, oVAP = A_VAP, oKBP = A_KBP, oVBP = A_VBP, oKAS = A_KAS, oVAS = A_VAS, oKBS = A_KBS, oVBS = A_VBS, oKG = O_KG, oVG = O_VG, oKD = O_KD, oVD = O_VD; };
constexpr int CW_BAR = 4096;

constexpr int RING_OFF = 0, RING_BYTES = 131072;
constexpr int LDSCTL_OFF = RING_BYTES, MISC_OFF = LDSCTL_OFF + 320;
constexpr int LDS_BYTES = 147456;

typedef float f32x2_t __attribute__((ext_vector_type(2))); typedef __bf16 bf16x2_t __attribute__((ext_vector_type(2)));
__device__ __forceinline__ unsigned pk2(float lo, float hi) { const f32x2_t v = {lo, hi}; return __builtin_bit_cast(unsigned, __builtin_convertvector(v, bf16x2_t)); }
__device__ __forceinline__ unsigned f2bf(float f) { return pk2(f, 0.f) & 0xffffu; }
__device__ __forceinline__ float bf2f(unsigned short h) { return __builtin_bit_cast(float, (unsigned)h << 16); }
__device__ __forceinline__ float bflo(unsigned w) { return __builtin_bit_cast(float, w << 16); }
__device__ __forceinline__ float bfhi(unsigned w) { return __builtin_bit_cast(float, w & 0xffff0000u); }
__device__ __forceinline__ float wave_sum(float v) {
#pragma unroll
    for (int o = 1; o < 64; o <<= 1) v += __shfl_xor(v, o);
    return v;
}
__device__ __forceinline__ float sigmoidf_(float x) { return 1.0f / (1.0f + __expf(-x)); }
__device__ __forceinline__ float rdl(float x, int l) { return __builtin_bit_cast(float, __builtin_amdgcn_readlane(__builtin_bit_cast(int, x), l)); }

#define XB_TMO      128
#define XB_XCNT(j)  (256  + 64 * (j))
#define XB_XSUB(j)  (1280 + 64 * (j))
#define XB_XGEN(j)  (2304 + 64 * (j))
#define XB_TOP      3328
#define XB_TOPGEN   3392
#define XCD_BAR_WORDS 3456
#define XB_SPIN_CAP (1u << 18)

__device__ __forceinline__ unsigned xb_ld(unsigned* p)              { return __hip_atomic_load(p, __ATOMIC_RELAXED, __HIP_MEMORY_SCOPE_AGENT); }
__device__ __forceinline__ unsigned xb_add(unsigned* p, unsigned v) { return __hip_atomic_fetch_add(p, v, __ATOMIC_RELAXED, __HIP_MEMORY_SCOPE_AGENT); }
__device__ __forceinline__ unsigned xb_xcc_id() { return (unsigned)__builtin_amdgcn_s_getreg((3 << 11) | 20) & 0xFu; }
#define XB_SPIN(cond, bar) do { unsigned _sp = 0; while (cond) { __builtin_amdgcn_s_sleep(1); \
    if ((++_sp & 255u) == 0u) { if (xb_ld(&(bar)[XB_TMO])) break; if (_sp > XB_SPIN_CAP) { atomicAdd(&(bar)[XB_TMO], 1u); break; } } } } while (0)

struct XcdBarrier {
    unsigned* bar; unsigned x;
    volatile LAS unsigned* st;
};

__device__ __forceinline__ XcdBarrier xcd_barrier_post(unsigned* bar, volatile LAS unsigned* st, bool leader) {
    XcdBarrier b; b.bar = bar; b.x = xb_xcc_id(); b.st = st;
    if (leader) (void)xb_add(&bar[XB_XCNT(b.x)], 1u);
    return b;
}
__device__ __forceinline__ void xcd_barrier_complete(unsigned* bar, unsigned x, unsigned& nloc, unsigned& nx) {
    const unsigned G = gridDim.x * gridDim.y * gridDim.z;
    unsigned sum, cnt, mine, sp = 0u;
    for (;;) {
        sum = 0u; cnt = 0u; mine = 0u;
#pragma unroll
        for (unsigned j = 0; j < 16; ++j) { const unsigned c = xb_ld(&bar[XB_XCNT(j)]); sum += c; cnt += (c > 0u) ? 1u : 0u; mine = (j == x) ? c : mine; }
        if (sum == G) break;
        __builtin_amdgcn_s_sleep(1);
        if ((++sp & 255u) == 0u) { if (xb_ld(&bar[XB_TMO])) break; if (sp > XB_SPIN_CAP) { atomicAdd(&bar[XB_TMO], 1u); break; } }
    }
    nloc = mine > 0u ? mine : 1u; nx = cnt > 0u ? cnt : 1u;
}

__device__ __forceinline__ void xcd_barrier(const XcdBarrier& b, bool leader) {
    asm volatile("s_waitcnt vmcnt(0)" ::: "memory");
    __syncthreads();
    if (leader) {
        unsigned* bar = b.bar;
        __builtin_amdgcn_s_waitcnt(0);
        unsigned nloc = b.st[0], nx = b.st[1];
        if (nloc == 0u) { xcd_barrier_complete(bar, b.x, nloc, nx); b.st[0] = nloc; b.st[1] = nx; }
        const unsigned old = xb_add(&bar[XB_XSUB(b.x)], 1u);
        const unsigned gen = old / nloc;
        if (old + 1u == (gen + 1u) * nloc) {
            __builtin_amdgcn_fence(__ATOMIC_RELEASE, "agent");
            asm volatile("s_waitcnt vmcnt(0)" ::: "memory");
            const unsigned og = xb_add(&bar[XB_TOP], 1u);
            const unsigned tg = og / nx;
            if (og + 1u == (tg + 1u) * nx) xb_add(&bar[XB_TOPGEN], 1u);
            else XB_SPIN(xb_ld(&bar[XB_TOPGEN]) == tg, bar);
            __builtin_amdgcn_fence(__ATOMIC_ACQUIRE, "agent");
            xb_add(&bar[XB_XGEN(b.x)], 1u);
            asm volatile("s_waitcnt vmcnt(0)" ::: "memory");
        } else {
            XB_SPIN(xb_ld(&bar[XB_XGEN(b.x)]) == gen, bar);
            __builtin_amdgcn_fence(__ATOMIC_ACQUIRE, "agent");
            asm volatile("s_waitcnt vmcnt(0)" ::: "memory");
        }
    }
    __syncthreads();
}

struct Args { const float* in[32]; float* out; unsigned char* ws; int ph_lo, ph_hi; };
struct Ids { int tid, lane, wave, gw, ngw, z; };

__device__ __forceinline__ int cond_of(int m) { return m < NPR ? 4 : ((m - NPR) >> 11); }
__device__ __forceinline__ const float* mod_ptr_(const Args& a, const Ids& id, int cond, int layer) { return (const float*)(a.ws + id.z + WS_MOD) + (size_t)(cond * 4 + layer) * 6144; }

__device__ __forceinline__ void tr_item(const float* W, int ldw, int col0, const float* scale, bf16* WT, int ldt, int drow0, int dcol0, LAS float* scr, int kb, int nb, int lane, int dnb = -1) {
    const int k0 = 64 * kb, n0 = 32 * nb, dn0 = 32 * (dnb < 0 ? nb : dnb);
#pragma unroll 8
    for (int i = 0; i < 32; ++i) { const int kk = 2 * i + (lane >> 5); float v = W[(size_t)(k0 + kk) * ldw + col0 + n0 + (lane & 31)]; if (scale) v *= scale[k0 + kk]; scr[kk * 33 + (lane & 31)] = v; }
    LDS_WAIT(); asm volatile("" ::: "memory");
    const int c = lane & 7;
#pragma unroll
    for (int j = 0; j < 4; ++j) { const int n = (lane >> 3) + 8 * j; const LAS float* s = scr + (8 * c) * 33 + n;
        v4u o; o.x = pk2(s[0 * 33], s[1 * 33]); o.y = pk2(s[2 * 33], s[3 * 33]); o.z = pk2(s[4 * 33], s[5 * 33]); o.w = pk2(s[6 * 33], s[7 * 33]);
        *(v4u*)(WT + (size_t)(drow0 + dn0 + n) * ldt + dcol0 + k0 + 8 * c) = o; }
    LDS_WAIT(); asm volatile("" ::: "memory");
}
__device__ __forceinline__ bool tr_matrix(int& r, const float* W, int K, int N, bf16* WT, LAS float* scr, int lane) {
    const int nblk = N / 32, items = (K / 64) * nblk;
    if (r < items) { tr_item(W, N, 0, nullptr, WT, K, 0, 0, scr, r / nblk, r % nblk, lane); return true; }
    r -= items; return false;
}
__device__ __forceinline__ bool tr_rwproj(int& r, const float* W, int ncols, const float* mu, bf16* BT1, int drow0, LAS float* scr, int lane) {
    const int nblk = ncols / 32, items = 16 * nblk * 2;
    if (r < items) { const int half = r / (16 * nblk), q = r % (16 * nblk); tr_item(W, ncols, 0, half ? mu : nullptr, BT1, KRKV, drow0, half * 1024, scr, q / nblk, q % nblk, lane); return true; }
    r -= items; return false;
}
__device__ __forceinline__ void conv_weights(const Args& a, const Ids& id, LAS unsigned char* lds, int layer) {
    LAS float* scr = (LAS float*)(lds + id.wave * 16384);
    const int j = layer >> 1;
    bf16* W1T = (bf16*)(a.ws + id.z + W_W1T); bf16* W2T = (bf16*)(a.ws + id.z + W_W2T);
    const float* mw1 = a.in[30 + id.z] + (size_t)layer * D * FF; const float* mw2 = a.in[31 + id.z] + (size_t)layer * D * FF;
    if ((layer & 1) == 0) {
        bf16* WINT = (bf16*)(a.ws + id.z + W_WINT); bf16* WOUTT = (bf16*)(a.ws + id.z + W_WOUTT);
        const float* win = a.in[12 + id.z] + (size_t)j * D * NQKV; const float* wout = a.in[13 + id.z] + (size_t)j * D * D;
        const int total = 2048 + 2048 + 1152 + 512;
        for (int it = id.gw; it < total; it += id.ngw) {
            int r = it;
            if (tr_matrix(r, mw1, D, FF, W1T, scr, id.lane)) continue;
            if (tr_matrix(r, mw2, FF, D, W2T, scr, id.lane)) continue;
            if (r < 1152) {
                const int kb = r / 72, nb = r % 72; tr_item(win, NQKV, 0, nullptr, WINT, D, 0, 0, scr, kb, nb, id.lane, (nb & ~7) + 4 * (nb & 1) + ((nb >> 1) & 3)); continue; }
            r -= 1152;
            tr_matrix(r, wout, D, D, WOUTT, scr, id.lane);
        }
    } else {
        bf16* BTR = (bf16*)(a.ws + id.z + W_BTR); bf16* BT1 = (bf16*)(a.ws + id.z + W_BTL); bf16* WOT = (bf16*)(a.ws + id.z + W_WOT);
        const float* mu = a.in[17 + id.z] + (size_t)j * 6 * D;
        const float* wrkv = a.in[18 + id.z] + (size_t)j * 3 * D * D;
        const float* w1 = a.in[21 + id.z] + (size_t)j * 2 * D * 64; const float* a1 = a.in[24 + id.z] + (size_t)j * 2 * D * 64; const float* g1 = a.in[26 + id.z] + (size_t)j * D * 128;
        const float* wo = a.in[19 + id.z] + (size_t)j * D * D;
        bf16* BT2 = (bf16*)(a.ws + id.z + W_BT2); const float* w2 = a.in[22 + id.z] + (size_t)j * 2 * 64 * D; const float* a2 = a.in[25 + id.z] + (size_t)j * 2 * 64 * D; const float* g2 = a.in[27 + id.z] + (size_t)j * 128 * D;
        const int total = 2048 + 2048 + 1536 + 256 + 128 + 512 + 128 + 4 * 32 + 64 + 5120;
        for (int it = id.gw; it < total; it += id.ngw) {
            int r = it;
            if (tr_matrix(r, mw1, D, FF, W1T, scr, id.lane)) continue;
            if (tr_matrix(r, mw2, FF, D, W2T, scr, id.lane)) continue;
            if (tr_matrix(r, wrkv, D, D, BTR, scr, id.lane)) continue;
            if (tr_matrix(r, wrkv + (size_t)D * D, D, D, BTR + (size_t)D * D, scr, id.lane)) continue;
            if (tr_matrix(r, wrkv + (size_t)2 * D * D, D, D, BTR + (size_t)2 * D * D, scr, id.lane)) continue;
            if (tr_rwproj(r, w1, 64, mu + 1 * D, BT1, 0, scr, id.lane)) continue;
            if (tr_rwproj(r, w1 + (size_t)D * 64, 64, mu + 1 * D, BT1, 64, scr, id.lane)) continue;
            if (tr_rwproj(r, a1, 64, mu + 4 * D, BT1, 128, scr, id.lane)) continue;
            if (tr_rwproj(r, a1 + (size_t)D * 64, 64, mu + 4 * D, BT1, 192, scr, id.lane)) continue;
            if (tr_rwproj(r, g1, 128, mu + 5 * D, BT1, 256, scr, id.lane)) continue;
            if (tr_matrix(r, wo, D, D, WOT, scr, id.lane)) continue;
            if (r < 128) {
                v4u z = (v4u){0u, 0u, 0u, 0u}; v4u* p = (v4u*)(BT1 + (size_t)(384 + r) * KRKV);
#pragma unroll
                for (int q = 0; q < 4; ++q) p[id.lane + 64 * q] = z;
                continue; }
            r -= 128;
            if (r < 128) { const int i = r >> 5, q = r & 31; const float* W = (i < 2 ? a2 : w2) + (size_t)(i & 1) * 64 * D; tr_item(W, D, 0, nullptr, BT2, 384, 1024 * i, 64 * (i ^ 2), scr, 0, q, id.lane); continue; }
            r -= 128;
            if (r < 64) { tr_item(g2, D, 0, nullptr, BT2, 384, 4096, 256, scr, r >> 5, r & 31, id.lane); continue; }
            r -= 64;
            { const int blk = r >> 10; const int c0 = (blk < 4) ? 8 * (blk ^ 2) : 32, c1 = (blk < 4) ? 8 * (blk ^ 2) + 8 : 48;
              if (id.lane < 48 && (id.lane < c0 || id.lane >= c1)) *(v4u*)(BT2 + (size_t)r * 384 + 8 * id.lane) = (v4u){0u, 0u, 0u, 0u}; }
        }
    }
}

struct RowV { f32x4 v[4]; };
__device__ __forceinline__ void ld_row(RowV& r, const float* p, int lane) {
#pragma unroll
    for (int j = 0; j < 4; ++j) r.v[j] = ((const f32x4*)p)[lane + 64 * j];
}
__device__ __forceinline__ void ld_row_bf16(RowV& r, const bf16* p, int lane) {
#pragma unroll
    for (int j = 0; j < 4; ++j) { const v2u w = ((const v2u*)p)[lane + 64 * j]; r.v[j] = (f32x4){bflo(w.x), bfhi(w.x), bflo(w.y), bfhi(w.y)}; }
}
__device__ __forceinline__ void st_row(const RowV& r, float* p, int lane) {
#pragma unroll
    for (int j = 0; j < 4; ++j) ((f32x4*)p)[lane + 64 * j] = r.v[j];
}
__device__ __forceinline__ void st_row_bf16(const RowV& r, bf16* p, int lane) {
#pragma unroll
    for (int j = 0; j < 4; ++j) { v2u w; w.x = pk2(r.v[j][0], r.v[j][1]); w.y = pk2(r.v[j][2], r.v[j][3]); ((v2u*)p)[lane + 64 * j] = w; }
}
__device__ __forceinline__ float row_rinv(const RowV& r) {
    float s = 0.f;
#pragma unroll
    for (int j = 0; j < 4; ++j) s += (r.v[j][0] * r.v[j][0] + r.v[j][1] * r.v[j][1]) + (r.v[j][2] * r.v[j][2] + r.v[j][3] * r.v[j][3]);
    s = wave_sum(s);
    return 1.0f / sqrtf(s * (1.0f / 1024.0f) + 1e-6f);
}
__device__ __forceinline__ void norm_mod(RowV& h, const RowV& x, const float* g, const float* sc, const float* sh, int lane) {
    const float ri = row_rinv(x);
#pragma unroll
    for (int j = 0; j < 4; ++j) { const f32x4 gv = ((const f32x4*)g)[lane + 64 * j], scv = ((const f32x4*)sc)[lane + 64 * j], shv = ((const f32x4*)sh)[lane + 64 * j];
        h.v[j] = (x.v[j] * ri) * gv * (scv + 1.0f) + shv; }
}
__device__ __forceinline__ void resid_add(RowV& x, const RowV& m, const float* g, const float* gt, int lane) {
    const float ri = row_rinv(m);
#pragma unroll
    for (int j = 0; j < 4; ++j) { const f32x4 gv = ((const f32x4*)g)[lane + 64 * j], gtv = ((const f32x4*)gt)[lane + 64 * j];
        x.v[j] = x.v[j] + gtv * ((m.v[j] * ri) * gv); }
}

__device__ __forceinline__ float rope_inv(int jj) {
    const float t[16] = {1.0f, 0.5623413324356079f, 0.3162277638912201f, 0.17782793939113617f, 0.10000000149011612f, 0.05623412877321243f, 0.03162277862429619f, 0.017782794311642647f,
                         0.009999999776482582f, 0.005623413249850273f, 0.003162277862429619f, 0.0017782794311642647f, 0.0010000000474974513f, 0.000562341301701963f, 0.0003162277862429619f, 0.00017782794020604342f};
    float r = t[0];
#pragma unroll
    for (int i = 1; i < 16; ++i) r = (jj == i) ? t[i] : r;
    return r;
}
__device__ __forceinline__ void ph_prologue(const Args& a, const Ids& id, LAS unsigned char* lds) {
    float* MOD = (float*)(a.ws + id.z + WS_MOD);
    { LAS float* red = (LAS float*)lds;
      for (int it = blockIdx.x; it < 4 * 96; it += gridDim.x) {
        const int i = it / 96, n = (it % 96) * 64 + id.lane;
        float acc[5];
#pragma unroll
        for (int c = 0; c < 5; ++c) acc[c] = 0.f;
        const float* W = a.in[9 + id.z] + (size_t)i * 1024 * 6144 + n;
#pragma unroll 1
        for (int k0 = 128 * id.wave; k0 < 128 * id.wave + 128; k0 += 64) {
            float sv[5];
#pragma unroll
            for (int c = 0; c < 5; ++c) { const float x = (c < 4) ? a.in[2 + id.z][c * 1024 + k0 + id.lane] : a.in[8 + id.z][k0 + id.lane]; sv[c] = x / (1.0f + __expf(-x)); }
#pragma unroll 16
            for (int kk = 0; kk < 64; ++kk) { const float w = W[(size_t)(k0 + kk) * 6144];
#pragma unroll
                for (int c = 0; c < 5; ++c) acc[c] += w * __shfl(sv[c], kk); }
        }
#pragma unroll
        for (int c = 0; c < 5; ++c) red[(id.wave * 5 + c) * 64 + id.lane] = acc[c];
        __syncthreads();
        if (id.wave < 5) { float s = a.in[10 + id.z][i * 6144 + n];
#pragma unroll
            for (int w8 = 0; w8 < 8; ++w8) s += red[(w8 * 5 + id.wave) * 64 + id.lane];
            MOD[(size_t)(id.wave * 4 + i) * 6144 + n] = s; }
        __syncthreads();
      } }
    { float* RC = (float*)(a.ws + id.z + WS_ROPE); float* RS = RC + 2048 * 64;
      for (int e = id.gw * 64 + id.lane; e < 2048 * 64; e += id.ngw * 64) { const int t = e >> 6, d = e & 63; const int pos = (d < 32) ? (t >> 6) : (t & 63);
          const float ang = (float)pos * rope_inv(d & 15); RC[e] = __cosf(ang); RS[e] = __sinf(ang); } }
    conv_weights(a, id, lds, 0);
}

struct RawBf { v2u v[4]; };
__device__ __forceinline__ void ld_raw_bf(RawBf& r, const bf16* p, int lane) {
#pragma unroll
    for (int j = 0; j < 4; ++j) r.v[j] = ((const v2u*)p)[lane + 64 * j];
}
__device__ __forceinline__ void cvt_raw_bf(RowV& o, const RawBf& r) {
#pragma unroll
    for (int j = 0; j < 4; ++j) o.v[j] = (f32x4){bflo(r.v[j].x), bfhi(r.v[j].x), bflo(r.v[j].y), bfhi(r.v[j].y)};
}
__device__ __forceinline__ const float* x_row_ptr(const Args& a, const Ids& id, int layer, int m) {
    return (layer == 0) ? ((m < NPR) ? a.in[0 + id.z] + (size_t)m * D : a.in[1 + id.z] + (size_t)(m - NPR) * D) : a.out + id.z + O_X + (size_t)m * D;
}
__device__ __forceinline__ void ph_norm0(const Args& a, const Ids& id) {
    bf16* H = (bf16*)(a.ws + id.z + A_H); const float* g0 = a.in[11 + id.z] + (size_t)(0 * 4 + 0) * D;
    int m = id.gw; RowV xn; if (m < NTOK) ld_row(xn, x_row_ptr(a, id, 0, m), id.lane);
    for (; m < NTOK; m += id.ngw) { RowV x = xn, h; if (m + id.ngw < NTOK) ld_row(xn, x_row_ptr(a, id, 0, m + id.ngw), id.lane);
        const float* md = mod_ptr_(a, id, cond_of(m), 0);
        norm_mod(h, x, g0, md + 1024, md + 0, id.lane); st_row_bf16(h, H + (size_t)m * D, id.lane); }
}
__device__ __forceinline__ void ph_resid_norm(const Args& a, const Ids& id, int layer, bool dummy = false) {
    bf16* H = (bf16*)(a.ws + id.z + (dummy ? AR + 224 * MiB : A_H)); float* xout = dummy ? (float*)(a.ws + id.z + A_F) : a.out + id.z + O_X; const bf16* M = (const bf16*)(a.ws + id.z + A_M); const float* g1 = a.in[11 + id.z] + (size_t)(layer * 4 + 1) * D; const float* g2 = a.in[11 + id.z] + (size_t)(layer * 4 + 2) * D;
    int m = id.gw; RowV xn; RawBf mn; if (m < NTOK) { ld_row(xn, x_row_ptr(a, id, layer, m), id.lane); ld_raw_bf(mn, M + (size_t)m * D, id.lane); }
    for (; m < NTOK; m += id.ngw) { RowV x = xn, mm, h; cvt_raw_bf(mm, mn);
        if (m + id.ngw < NTOK) { ld_row(xn, x_row_ptr(a, id, layer, m + id.ngw), id.lane); ld_raw_bf(mn, M + (size_t)(m + id.ngw) * D, id.lane); }
        const float* md = mod_ptr_(a, id, cond_of(m), layer);
        resid_add(x, mm, g1, md + 2048, id.lane); st_row(x, xout + (size_t)m * D, id.lane);
        norm_mod(h, x, g2, md + 4096, md + 3072, id.lane); st_row_bf16(h, H + (size_t)m * D, id.lane); }
}
__device__ __forceinline__ void ph_resid_end(const Args& a, const Ids& id, LAS unsigned char* lds, int layer, bool dummy = false) {
    bf16* H = (bf16*)(a.ws + id.z + (dummy ? AR + 96 * MiB : A_H)); float* xout = dummy ? (float*)(a.ws + id.z + AR + 32 * MiB) : a.out + id.z + O_X; const bf16* F = (const bf16*)(a.ws + id.z + A_F); const float* g3 = a.in[11 + id.z] + (size_t)(layer * 4 + 3) * D;
    const bool next_attn = (layer + 1 < DEPTH) && (((layer + 1) & 1) == 0);
    const float* g0n = a.in[11 + id.z] + (size_t)((layer + 1) * 4 + 0) * D;
    int m = id.gw; RowV xn; RawBf fn; if (m < NTOK) { ld_row(xn, a.out + id.z + O_X + (size_t)m * D, id.lane); ld_raw_bf(fn, F + (size_t)m * D, id.lane); }
    for (; m < NTOK; m += id.ngw) { RowV x = xn, ff; cvt_raw_bf(ff, fn);
        if (m + id.ngw < NTOK) { ld_row(xn, a.out + id.z + O_X + (size_t)(m + id.ngw) * D, id.lane); ld_raw_bf(fn, F + (size_t)(m + id.ngw) * D, id.lane); }
        const float* md = mod_ptr_(a, id, cond_of(m), layer);
        resid_add(x, ff, g3, md + 5120, id.lane); st_row(x, xout + (size_t)m * D, id.lane);
        if (next_attn) { RowV h; const float* mdn = mod_ptr_(a, id, cond_of(m), layer + 1); norm_mod(h, x, g0n, mdn + 1024, mdn + 0, id.lane); st_row_bf16(h, H + (size_t)m * D, id.lane); } }
    if (layer + 1 < DEPTH) conv_weights(a, id, lds, layer + 1);
}
__device__ __forceinline__ void ph_rw_mix(const Args& a, const Ids& id, int layer) {
    bf16* A2 = (bf16*)(a.ws + id.z + A_A2); bf16* XS = (bf16*)(a.ws + id.z + A_XS); const float* g0 = a.in[11 + id.z] + (size_t)(layer * 4 + 0) * D; const float* mu6 = a.in[17 + id.z] + (size_t)(layer >> 1) * 6 * D;
    for (int g8 = id.gw; g8 < NTOK / 8; g8 += id.ngw) {
        const int m0 = g8 * 8; const int t0 = (m0 < NPR) ? (m0 & (TP - 1)) : ((m0 - NPR) & (TS - 1)); const int T = (m0 < NPR) ? TP : TS;
        const float* md = mod_ptr_(a, id, cond_of(m0), layer); const float* xp = a.out + id.z + O_X + (size_t)m0 * D;
        RowV hp, hc, hn, xr;
#pragma unroll
        for (int q = 0; q < 4; ++q) hp.v[q] = (f32x4){0.f, 0.f, 0.f, 0.f};
        if (t0 > 0) { ld_row(xr, xp - D, id.lane); norm_mod(hp, xr, g0, md + 1024, md + 0, id.lane); }
        ld_row(xr, xp, id.lane); norm_mod(hc, xr, g0, md + 1024, md + 0, id.lane);
#pragma unroll 1
        for (int i = 0; i < 8; ++i) {
#pragma unroll
            for (int q = 0; q < 4; ++q) hn.v[q] = (f32x4){0.f, 0.f, 0.f, 0.f};
            if (t0 + i + 1 < T) { ld_row(xr, xp + (size_t)(i + 1) * D, id.lane); norm_mod(hn, xr, g0, md + 1024, md + 0, id.lane); }
            RowV xx;
#pragma unroll
            for (int q = 0; q < 4; ++q) xx.v[q] = (hp.v[q] + hn.v[q]) * 0.5f - hc.v[q];
            st_row_bf16(hc, A2 + (size_t)(m0 + i) * KRKV, id.lane); st_row_bf16(xx, A2 + (size_t)(m0 + i) * KRKV + D, id.lane);
#pragma unroll
            for (int p = 0; p < 3; ++p) { const float* mu = mu6 + (size_t)(p == 0 ? 0 : p + 1) * D; RowV xm;
#pragma unroll
                for (int q = 0; q < 4; ++q) xm.v[q] = hc.v[q] + xx.v[q] * ((const f32x4*)mu)[id.lane + 64 * q];
                st_row_bf16(xm, XS + ((size_t)p * NTOK + m0 + i) * D, id.lane); }
            hp = hc; hc = hn;
        }
    }
}

__device__ __forceinline__ void row16_sum4(float& a, float& b, float& c, float& d) {
    asm("s_nop 1\n\t"
        "v_add_f32_dpp %0, %0, %0 row_ror:8 row_mask:0xf bank_mask:0xf\n\tv_add_f32_dpp %1, %1, %1 row_ror:8 row_mask:0xf bank_mask:0xf\n\tv_add_f32_dpp %2, %2, %2 row_ror:8 row_mask:0xf bank_mask:0xf\n\tv_add_f32_dpp %3, %3, %3 row_ror:8 row_mask:0xf bank_mask:0xf\n\t"
        "v_add_f32_dpp %0, %0, %0 row_ror:4 row_mask:0xf bank_mask:0xf\n\tv_add_f32_dpp %1, %1, %1 row_ror:4 row_mask:0xf bank_mask:0xf\n\tv_add_f32_dpp %2, %2, %2 row_ror:4 row_mask:0xf bank_mask:0xf\n\tv_add_f32_dpp %3, %3, %3 row_ror:4 row_mask:0xf bank_mask:0xf\n\t"
        "v_add_f32_dpp %0, %0, %0 row_ror:2 row_mask:0xf bank_mask:0xf\n\tv_add_f32_dpp %1, %1, %1 row_ror:2 row_mask:0xf bank_mask:0xf\n\tv_add_f32_dpp %2, %2, %2 row_ror:2 row_mask:0xf bank_mask:0xf\n\tv_add_f32_dpp %3, %3, %3 row_ror:2 row_mask:0xf bank_mask:0xf\n\t"
        "v_add_f32_dpp %0, %0, %0 row_ror:1 row_mask:0xf bank_mask:0xf\n\tv_add_f32_dpp %1, %1, %1 row_ror:1 row_mask:0xf bank_mask:0xf\n\tv_add_f32_dpp %2, %2, %2 row_ror:1 row_mask:0xf bank_mask:0xf\n\tv_add_f32_dpp %3, %3, %3 row_ror:1 row_mask:0xf bank_mask:0xf"
        : "+v"(a), "+v"(b), "+v"(c), "+v"(d));
}
__device__ __forceinline__ f32x4 ld_bf4(const bf16* p) { const v2u w = *(const v2u*)p; return (f32x4){bflo(w.x), bfhi(w.x), bflo(w.y), bfhi(w.y)}; }
__device__ __forceinline__ void ph_att_cache(const Args& a, const Ids& id, int layer) {
    const int j = layer >> 1, lane = id.lane;
    bf16 *KAS = (bf16*)(a.ws + id.z + A_KAS), *VAS = (bf16*)(a.ws + id.z + A_VAS), *KBS = (bf16*)(a.ws + id.z + A_KBS), *VBS = (bf16*)(a.ws + id.z + A_VBS);
    for (int r = id.gw; r < 4 * PAST; r += id.ngw) {
        const int b = r >> 9, pos = r & (PAST - 1);
        const size_t src = (size_t)((b * 2 + j) * PAST + pos), dst = (size_t)(b * SKV + pos);
#pragma unroll
        for (int q = 0; q < 2; ++q) { const int e = lane + 64 * q; KAS[dst * 128 + e] = (bf16)f2bf(a.in[3 + id.z][src * 128 + e]); VAS[dst * 128 + e] = (bf16)f2bf(a.in[4 + id.z][src * 128 + e]); }
#pragma unroll
        for (int q = 0; q < 8; ++q) { const int e = lane + 64 * q; KBS[dst * 512 + e] = (bf16)f2bf(a.in[5 + id.z][src * 512 + e]); VBS[dst * 512 + e] = (bf16)f2bf(a.in[6 + id.z][src * 512 + e]); }
    }
}

typedef short bf16x8_t __attribute__((ext_vector_type(8)));
typedef float f32x16 __attribute__((ext_vector_type(16)));
typedef short v4i16_t __attribute__((ext_vector_type(4)));
constexpr float AT_THR = 8.0f;
constexpr int AT_KP = 144, AT_KBUF = 64 * AT_KP, AT_VOFF = 2 * AT_KBUF, AT_VBUFMAX = 64 * 288, AT_WSF = AT_VOFF + 2 * AT_VBUFMAX;
static_assert(AT_WSF + 8 * 128 <= RING_BYTES, "attention LDS");
template <int NDT>
__device__ __forceinline__ void attn_unit(const bf16* Qrow0, int ldq, const bf16* Kb, int ldk, const bf16* Vb, int ldv, int S, bf16* Obf, float* Of32, int ldo, LAS unsigned char* lds, const Ids& id) {
    constexpr int VP = (NDT == 2) ? 144 : 288, NVL = NDT / 2;
    const int lane = id.lane, w = id.wave, r32 = lane & 31, hi = lane >> 5, tid = id.tid;
    bf16x8_t qf[4];
    { const bf16* qrow = Qrow0 + (size_t)(32 * w + r32) * ldq;
#pragma unroll
      for (int s = 0; s < 4; ++s) qf[s] = *(const bf16x8_t*)(qrow + 16 * s + 8 * hi); }
    f32x16 o[NDT];
#pragma unroll
    for (int dt = 0; dt < NDT; ++dt)
#pragma unroll
        for (int r = 0; r < 16; ++r) o[dt][r] = 0.f;
    float m_run = 0.f, l_run = 0.f;
    const int NT = S >> 6;
    LAS float* wsf = (LAS float*)(lds + AT_WSF + w * 128);
    const int krow = tid >> 3, kch = tid & 7;
    v4u kreg, vreg[NVL];
#define AT_GLOAD(t) do { kreg = *(const v4u*)(Kb + (size_t)((t) * 64 + krow) * ldk + 8 * kch); \
        if (NDT == 2) vreg[0] = *(const v4u*)(Vb + (size_t)((t) * 64 + krow) * ldv + 8 * kch); \
        else { _Pragma("unroll") for (int i_ = 0; i_ < NVL; ++i_) { const int ix_ = tid + 512 * i_; vreg[i_] = *(const v4u*)(Vb + (size_t)((t) * 64 + (ix_ >> 4)) * ldv + 8 * (ix_ & 15)); } } } while (0)
#define AT_LSTORE(b) do { *(LAS v4u*)(lds + (b) * AT_KBUF + krow * AT_KP + 16 * kch) = kreg; \
        if (NDT == 2) *(LAS v4u*)(lds + AT_VOFF + (b) * AT_VBUFMAX + krow * VP + 16 * kch) = vreg[0]; \
        else { _Pragma("unroll") for (int i_ = 0; i_ < NVL; ++i_) { const int ix_ = tid + 512 * i_; *(LAS v4u*)(lds + AT_VOFF + (b) * AT_VBUFMAX + (ix_ >> 4) * VP + 16 * (ix_ & 15)) = vreg[i_]; } } } while (0)
    AT_GLOAD(0); AT_LSTORE(0);
    __syncthreads();
    const int vbase = (4 * hi + ((lane & 15) >> 2)) * VP + 32 * ((lane >> 4) & 1) + 8 * (lane & 3);
#pragma unroll 1
    for (int t = 0; t < NT; ++t) {
        const int b = t & 1;
        if (t + 1 < NT) AT_GLOAD(t + 1);
        const LAS unsigned char* Kt = lds + b * AT_KBUF + r32 * AT_KP + 16 * hi;
        const LAS unsigned char* Vt = lds + AT_VOFF + b * AT_VBUFMAX + vbase;
        f32x16 p0, p1;
        { const float nm = -m_run;
#pragma unroll
          for (int r = 0; r < 16; ++r) { p0[r] = nm; p1[r] = nm; } }
#pragma unroll
        for (int s = 0; s < 4; ++s) { const bf16x8_t k0 = *(const LAS bf16x8_t*)(Kt + 32 * s), k1 = *(const LAS bf16x8_t*)(Kt + 32 * AT_KP + 32 * s);
            p0 = __builtin_amdgcn_mfma_f32_32x32x16_bf16(k0, qf[s], p0, 0, 0, 0); p1 = __builtin_amdgcn_mfma_f32_32x32x16_bf16(k1, qf[s], p1, 0, 0, 0); }
        float mx = __builtin_fmaxf(p0[0], p1[0]);
#pragma unroll
        for (int r = 1; r < 16; ++r) mx = __builtin_fmaxf(__builtin_fmaxf(mx, p0[r]), p1[r]);
        mx = fmaxf(mx, __shfl_xor(mx, 32));
        if (t == 0 || __any(mx > AT_THR)) {
            const float dl = (t == 0) ? mx : fmaxf(mx, 0.f), al = __builtin_amdgcn_exp2f(-dl); m_run += dl; l_run *= al;
#pragma unroll
            for (int r = 0; r < 16; ++r) { p0[r] -= dl; p1[r] -= dl; }
            if (hi == 0) wsf[r32] = al;
            LDS_WAIT(); asm volatile("" ::: "memory");
            { f32x4 a4[4];
#pragma unroll
              for (int g4 = 0; g4 < 4; ++g4) a4[g4] = *(const LAS f32x4*)(wsf + 8 * g4 + 4 * hi);
#pragma unroll
              for (int dt = 0; dt < NDT; ++dt)
#pragma unroll
                  for (int r = 0; r < 16; ++r) o[dt][r] *= a4[r >> 2][r & 3]; }
            LDS_WAIT(); asm volatile("" ::: "memory");
        }
        float rs = 0.f;
#pragma unroll
        for (int r = 0; r < 16; ++r) { p0[r] = __builtin_amdgcn_exp2f(p0[r]); p1[r] = __builtin_amdgcn_exp2f(p1[r]); rs += p0[r] + p1[r]; }
        l_run += rs;
        bf16x8_t pf[4];
#pragma unroll
        for (int ks = 0; ks < 4; ++ks) { v4u pw;
#pragma unroll
            for (int dd = 0; dd < 4; ++dd) { const int r = 8 * (ks & 1) + 2 * dd; pw[dd] = (ks < 2) ? pk2(p0[r], p0[r + 1]) : pk2(p1[r], p1[r + 1]); }
            pf[ks] = __builtin_bit_cast(bf16x8_t, pw); }
#pragma unroll
        for (int ks = 0; ks < 4; ++ks)
#pragma unroll
            for (int dt = 0; dt < NDT; ++dt) {
                const v4i16_t lo = __builtin_amdgcn_ds_read_tr16_b64_v4i16((LAS v4i16_t*)(Vt + (16 * ks) * VP + 64 * dt));
                const v4i16_t hh = __builtin_amdgcn_ds_read_tr16_b64_v4i16((LAS v4i16_t*)(Vt + (16 * ks + 8) * VP + 64 * dt));
                const bf16x8_t vf = (bf16x8_t){lo[0], lo[1], lo[2], lo[3], hh[0], hh[1], hh[2], hh[3]};
                o[dt] = __builtin_amdgcn_mfma_f32_32x32x16_bf16(pf[ks], vf, o[dt], 0, 0, 0); }
        if (t + 1 < NT) AT_LSTORE(b ^ 1);
        __syncthreads();
    }
#undef AT_GLOAD
#undef AT_LSTORE
    const float lt = l_run + __shfl_xor(l_run, 32);
    int lane_e = lane; asm volatile("" : "+v"(lane_e));
    const int r32e = lane_e & 31, hie = lane_e >> 5;
    if (hi == 0) wsf[r32] = 1.0f / lt;
    LDS_WAIT(); asm volatile("" ::: "memory");
    f32x4 a4[4];
#pragma unroll
    for (int g4 = 0; g4 < 4; ++g4) a4[g4] = *(const LAS f32x4*)(wsf + 8 * g4 + 4 * hi);
    LDS_WAIT(); asm volatile("" ::: "memory");
#pragma unroll
    for (int dt = 0; dt < NDT; ++dt)
#pragma unroll
        for (int r = 0; r < 16; ++r) { const float val = o[dt][r] * a4[r >> 2][r & 3]; const int off = (32 * w + (r & 3) + 8 * (r >> 2) + 4 * hie) * ldo + 32 * dt + r32e;
            if (NDT == 2) Obf[off] = (bf16)f2bf(val); else Of32[off] = val; }
}
__device__ __forceinline__ void ph_attn(const Args& a, const Ids& id, LAS unsigned char* lds, int G, int vcu) {
    const bf16 *QA = (const bf16*)(a.ws + id.z + A_QA), *QB = (const bf16*)(a.ws + id.z + A_QB), *KAP = (const bf16*)(a.ws + id.z + A_KAP), *VAP = (const bf16*)(a.ws + id.z + A_VAP), *KBP = (const bf16*)(a.ws + id.z + A_KBP), *VBP = (const bf16*)(a.ws + id.z + A_VBP);
    const bf16 *KAS = (const bf16*)(a.ws + id.z + A_KAS), *VAS = (const bf16*)(a.ws + id.z + A_VAS), *KBS = (const bf16*)(a.ws + id.z + A_KBS), *VBS = (const bf16*)(a.ws + id.z + A_VBS);
    bf16* H = (bf16*)(a.ws + id.z + A_H); float* DT = (float*)(a.ws + id.z + A_DT);
    for (int s = vcu; s < 256; s += G) {
        const int h8 = s & 7;
#pragma unroll 1
        for (int pass = 0; pass < 2; ++pass) {
            size_t m0, kvrow; int S;
            if (pass == 0) { const int b = s >> 6, qb = (s >> 3) & 7; m0 = (size_t)NPR + b * TS + qb * 256; kvrow = (size_t)b * SKV; S = SKV; }
            else { const int b = s >> 3; m0 = (size_t)b * TP; kvrow = m0; S = TP; }
            const bf16* Ka = (pass == 0 ? KAS : KAP) + kvrow * 128 + (h8 >> 2) * 64; const bf16* Va = (pass == 0 ? VAS : VAP) + kvrow * 128 + (h8 >> 2) * 64;
            const bf16* Kd = (pass == 0 ? KBS : KBP) + kvrow * 512 + h8 * 64; const bf16* Vd = (pass == 0 ? VBS : VBP) + kvrow * 512 + (h8 >> 1) * 128;
            attn_unit<2>(QA + m0 * 512 + h8 * 64, 512, Ka, 128, Va, 128, S, H + m0 * D + h8 * 64, nullptr, D, lds, id);
            attn_unit<4>(QB + m0 * 512 + h8 * 64, 512, Kd, 512, Vd, 512, S, nullptr, DT + m0 * D + h8 * 128, D, lds, id);
        }
    }
}
__device__ __forceinline__ void ph_att_comb(const Args& a, const Ids& id, int layer) {
    const int j = layer >> 1, lane = id.lane; const float lam_init = (layer == 0) ? 0.2f : 0.4707130183435842f;
    const float* lf = a.in[15 + id.z] + j * 256; const float* sg = a.in[16 + id.z] + j * 128;
    const float s01 = wave_sum(lf[lane] * lf[64 + lane]), s23 = wave_sum(lf[128 + lane] * lf[192 + lane]);
    const float lam = expf(s01) - expf(s23) + lam_init;
    const float* DT = (const float*)(a.ws + id.z + A_DT); bf16* H = (bf16*)(a.ws + id.z + A_H);
    const f32x4 gg = *(const f32x4*)(sg + 4 * (lane & 31)) * (1.0f - lam_init);
    for (int m = id.gw; m < NTOK; m += id.ngw) {
        f32x4 v[4];
#pragma unroll
        for (int hd = 0; hd < 4; ++hd) v[hd] = *(const f32x4*)(DT + (size_t)m * D + 256 * hd + 4 * lane);
        float ss[4];
#pragma unroll
        for (int hd = 0; hd < 4; ++hd) { f32x4 o; o[0] = __shfl_xor(v[hd][0], 32); o[1] = __shfl_xor(v[hd][1], 32); o[2] = __shfl_xor(v[hd][2], 32); o[3] = __shfl_xor(v[hd][3], 32);
            v[hd] = v[hd] - o * lam;
            ss[hd] = (lane < 32) ? (v[hd][0] * v[hd][0] + v[hd][1] * v[hd][1]) + (v[hd][2] * v[hd][2] + v[hd][3] * v[hd][3]) : 0.f; }
        row16_sum4(ss[0], ss[1], ss[2], ss[3]);
#pragma unroll
        for (int hd = 0; hd < 4; ++hd) { const float tot = ss[hd] + __shfl_xor(ss[hd], 16); const float ri = 1.0f / sqrtf(tot * (1.0f / 128.0f) + 1e-6f); const f32x4 o = v[hd] * ri * gg;
            if (lane < 32) *(v2u*)(H + (size_t)m * D + 512 + hd * 128 + 4 * lane) = (v2u){pk2(o[0], o[1]), pk2(o[2], o[3])}; }
    }
}

__device__ __forceinline__ void ph_rw_prep(const Args& a, const Ids& id, int layer) {
    const int j = layer >> 1, lane = id.lane;
    const bf16* RKV = (const bf16*)(a.ws + id.z + A_RKV); float* INV = (float*)(a.ws + id.z + WS_INV); float* Y = (float*)(a.ws + id.z + A_Y);
    const float* kk_c = a.in[28 + id.z] + (size_t)(j * 3 + 0) * D;
    for (int m = id.gw; m < NTOK; m += id.ngw) {
#pragma unroll 4
        for (int h = 0; h < 16; ++h) { const float kv = bf2f(RKV[(size_t)m * 3072 + 1024 + h * 64 + lane]) * kk_c[h * 64 + lane]; const float ss = wave_sum(kv * kv); if (lane == 0) INV[m * 16 + h] = 1.0f / sqrtf(ss + 1e-12f); }
        f32x4* yp = (f32x4*)(Y + (size_t)m * D);
#pragma unroll
        for (int q = 0; q < 4; ++q) yp[lane + 64 * q] = (f32x4){0.f, 0.f, 0.f, 0.f};
    }
}

constexpr int SC_TC = 16, SC_ROWF = 352;
constexpr int SC_OPF = SC_TC * SC_ROWF;
constexpr int SC_YOFF = 4 * SC_OPF;
static_assert((SC_YOFF + 4 * SC_TC * 32) * 4 <= RING_BYTES, "scan LDS");
struct ScDesc { int mbase, T, h, dir, half, b; };
__device__ __forceinline__ void sc_desc(ScDesc& d, int slot, int grp, int c) {
    if (grp == 0) { const int cs = slot >> 1; d.b = cs >> 5; d.h = (cs >> 1) & 15; d.dir = cs & 1; d.half = slot & 1; d.T = TS; d.mbase = NPR + d.b * TS; }
    else { const int pu = slot * 8 + (c >> 4), cp = pu >> 1; d.b = cp >> 5; d.h = (cp >> 1) & 15; d.dir = cp & 1; d.half = pu & 1; d.T = TP; d.mbase = d.b * TP; }
}
__device__ __forceinline__ int sc_tok(const ScDesc& d, int grp, int c, int i) { const int s = (grp == 0 ? c : (c & 15)) * SC_TC + i; return d.mbase + (d.dir ? d.T - 1 - s : s); }
__device__ __forceinline__ float fma_s(float a, float b, float c) { float r; asm("v_fma_f32 %0, %1, %2, %3" : "=v"(r) : "v"(a), "v"(b), "v"(c)); return r; }
__device__ __forceinline__ float fnma_s(float a, float b, float c) { float r; asm("v_fma_f32 %0, -%1, %2, %3" : "=v"(r) : "v"(a), "v"(b), "v"(c)); return r; }
__device__ __forceinline__ float mul_s(float a, float b) { float r; asm("v_mul_f32_e32 %0, %1, %2" : "=v"(r) : "v"(a), "v"(b)); return r; }
__device__ __forceinline__ float add_s(float a, float b) { float r; asm("v_add_f32_e32 %0, %1, %2" : "=v"(r) : "v"(a), "v"(b)); return r; }
__device__ __forceinline__ void oct_sum4(float& a, float& b, float& c, float& d) {
    asm("s_nop 1\n\t"
        "v_add_f32_dpp %0, %0, %0 quad_perm:[1,0,3,2] row_mask:0xf bank_mask:0xf\n\tv_add_f32_dpp %1, %1, %1 quad_perm:[1,0,3,2] row_mask:0xf bank_mask:0xf\n\tv_add_f32_dpp %2, %2, %2 quad_perm:[1,0,3,2] row_mask:0xf bank_mask:0xf\n\tv_add_f32_dpp %3, %3, %3 quad_perm:[1,0,3,2] row_mask:0xf bank_mask:0xf\n\t"
        "v_add_f32_dpp %0, %0, %0 quad_perm:[2,3,0,1] row_mask:0xf bank_mask:0xf\n\tv_add_f32_dpp %1, %1, %1 quad_perm:[2,3,0,1] row_mask:0xf bank_mask:0xf\n\tv_add_f32_dpp %2, %2, %2 quad_perm:[2,3,0,1] row_mask:0xf bank_mask:0xf\n\tv_add_f32_dpp %3, %3, %3 quad_perm:[2,3,0,1] row_mask:0xf bank_mask:0xf\n\t"
        "v_add_f32_dpp %0, %0, %0 row_half_mirror row_mask:0xf bank_mask:0xf\n\tv_add_f32_dpp %1, %1, %1 row_half_mirror row_mask:0xf bank_mask:0xf\n\tv_add_f32_dpp %2, %2, %2 row_half_mirror row_mask:0xf bank_mask:0xf\n\tv_add_f32_dpp %3, %3, %3 row_half_mirror row_mask:0xf bank_mask:0xf"
        : "+v"(a), "+v"(b), "+v"(c), "+v"(d));
}
typedef float f32x2 __attribute__((ext_vector_type(2)));
struct ScOps { f32x2 w[4], kd[4], kk[4], ka[4], r[4]; float va, vb; };
__device__ __forceinline__ void sc_ldops(ScOps& o, const LAS float* p, int kg, int ra) {
#pragma unroll
    for (int hq = 0; hq < 2; ++hq) { const f32x4 a0 = *(const LAS f32x4*)(p + 8 * kg + 4 * hq), a1 = *(const LAS f32x4*)(p + 64 + 8 * kg + 4 * hq), a2 = *(const LAS f32x4*)(p + 128 + 8 * kg + 4 * hq),
                                                 a3 = *(const LAS f32x4*)(p + 192 + 8 * kg + 4 * hq), a4 = *(const LAS f32x4*)(p + 256 + 8 * kg + 4 * hq);
        o.w[2 * hq] = __builtin_shufflevector(a0, a0, 0, 1); o.w[2 * hq + 1] = __builtin_shufflevector(a0, a0, 2, 3); o.kd[2 * hq] = __builtin_shufflevector(a1, a1, 0, 1); o.kd[2 * hq + 1] = __builtin_shufflevector(a1, a1, 2, 3);
        o.kk[2 * hq] = __builtin_shufflevector(a2, a2, 0, 1); o.kk[2 * hq + 1] = __builtin_shufflevector(a2, a2, 2, 3); o.ka[2 * hq] = __builtin_shufflevector(a3, a3, 0, 1); o.ka[2 * hq + 1] = __builtin_shufflevector(a3, a3, 2, 3);
        o.r[2 * hq] = __builtin_shufflevector(a4, a4, 0, 1); o.r[2 * hq + 1] = __builtin_shufflevector(a4, a4, 2, 3); }
    o.va = p[320 + ra]; o.vb = p[321 + ra];
}
__device__ __forceinline__ float dot8_p(const f32x2 (&S)[4], const f32x2 (&x)[4]) {
    f32x2 d = S[0] * x[0]; d = __builtin_elementwise_fma(S[1], x[1], d); d = __builtin_elementwise_fma(S[2], x[2], d); d = __builtin_elementwise_fma(S[3], x[3], d);
    return d[0] + d[1];
}
struct ScRaw { float r[8], k[8], a[8], e[8], v[8], iv[8]; };
__device__ __forceinline__ void sc_load(ScRaw& R, const Args& a, const Ids& id, int hw, int slot, int c) {
    const int grp = hw >> 1, lane = id.lane; ScDesc d; sc_desc(d, slot, grp, c);
    const bf16* RKV = (const bf16*)(a.ws + id.z + A_RKV); const float* INV = (const float*)(a.ws + id.z + WS_INV);
    const bf16* Ad = (const bf16*)(a.ws + id.z + (d.dir ? A_A1 : A_A0)); const bf16* EWd = (const bf16*)(a.ws + id.z + (d.dir ? A_EW1 : A_EW0));
#pragma unroll
    for (int q = 0; q < 8; ++q) { const int m = sc_tok(d, grp, c, (hw & 1) * 8 + q); const size_t o = (size_t)m * 3072 + d.h * 64 + lane, o2 = (size_t)m * D + d.h * 64 + lane;
        R.r[q] = bf2f(RKV[o]); R.k[q] = bf2f(RKV[o + 1024]); R.a[q] = bf2f(Ad[o2]); R.e[q] = bf2f(EWd[o2]); R.iv[q] = INV[m * 16 + d.h];
        R.v[q] = bf2f(RKV[(size_t)m * 3072 + 2048 + d.h * 64 + d.half * 32 + (lane & 31)]); }
}
__device__ __forceinline__ void sc_derive(const ScRaw& R, const Args& a, const Ids& id, LAS float* L, int layer, int hw, int slot, int c, int buf) {
    const int grp = hw >> 1, lane = id.lane, j = layer >> 1; ScDesc d; sc_desc(d, slot, grp, c);
    const float kkc = a.in[28 + id.z][(size_t)(j * 3 + 0) * D + d.h * 64 + lane], kac = a.in[28 + id.z][(size_t)(j * 3 + 1) * D + d.h * 64 + lane];
#pragma unroll
    for (int q = 0; q < 8; ++q) { LAS float* p = L + (buf * 2 + grp) * SC_OPF + ((hw & 1) * 8 + q) * SC_ROWF;
        const float kk = R.k[q] * kkc * R.iv[q];
        p[lane] = __builtin_amdgcn_exp2f(-R.e[q]); p[64 + lane] = R.k[q] * (1.0f + (R.a[q] - 1.0f) * kac); p[128 + lane] = kk; p[192 + lane] = kk * R.a[q]; p[256 + lane] = R.r[q];
        if (lane < 32) p[320 + lane] = R.v[q]; }
}
__device__ __forceinline__ void sc_flush(const Args& a, const Ids& id, const LAS float* L, int hw, int slot, int c) {
    float* Y = (float*)(a.ws + id.z + A_Y);
#pragma unroll
    for (int q = 0; q < 4; ++q) { const int idx = hw * 64 + id.lane + 256 * q, fg = idx >> 9, s = (idx >> 5) & 15, row = idx & 31; ScDesc d; sc_desc(d, slot, fg, c);
        const float yv = L[SC_YOFF + ((c & 1) * 2 + fg) * SC_TC * 32 + s * 32 + row];
        atomicAdd(&Y[(size_t)sc_tok(d, fg, c, s) * D + d.h * 64 + d.half * 32 + row], yv); }
}
__device__ __forceinline__ void ph_rw_scan(const Args& a, const Ids& id, LAS unsigned char* lds, int layer, int G, int vcu) {
    const int j = layer >> 1, lane = id.lane, w = id.wave;
    LAS float* L = (LAS float*)lds;
    constexpr int NC = TS / SC_TC;
    for (int slot = vcu; slot < 256; slot += G) {
        if (w >= 4) {
            const int hw = w - 4; ScRaw R;
            sc_load(R, a, id, hw, slot, 0); sc_derive(R, a, id, L, layer, hw, slot, 0, 0);
            __syncthreads();
#pragma unroll 1
            for (int c = 0; c < NC; ++c) {
                if (c + 1 < NC) sc_load(R, a, id, hw, slot, c + 1);
                if (c > 0) sc_flush(a, id, L, hw, slot, c - 1);
                if (c + 1 < NC) sc_derive(R, a, id, L, layer, hw, slot, c + 1, (c & 1) ^ 1);
                __syncthreads();
            }
            sc_flush(a, id, L, hw, slot, NC - 1);
        } else {
            const int grp = w >> 1, kg = lane & 7, ra = 16 * (w & 1) + 2 * (lane >> 3);
            f32x2 Sa[4], Sb[4];
            { ScDesc d; sc_desc(d, slot, 0, 0);
              if (grp == 0) { const float* sp = a.in[7 + id.z] + ((((size_t)(d.b * 2 + j) * 2 + d.dir) * 16 + d.h) * 64 + d.half * 32 + ra) * 64 + 8 * kg;
                  const f32x4 t0 = *(const f32x4*)sp, t1 = *(const f32x4*)(sp + 4), t2 = *(const f32x4*)(sp + 64), t3 = *(const f32x4*)(sp + 68);
                  Sa[0] = (f32x2){t0[0], t0[1]}; Sa[1] = (f32x2){t0[2], t0[3]}; Sa[2] = (f32x2){t1[0], t1[1]}; Sa[3] = (f32x2){t1[2], t1[3]};
                  Sb[0] = (f32x2){t2[0], t2[1]}; Sb[1] = (f32x2){t2[2], t2[3]}; Sb[2] = (f32x2){t3[0], t3[1]}; Sb[3] = (f32x2){t3[2], t3[3]}; }
              else {
#pragma unroll
                  for (int e2 = 0; e2 < 4; ++e2) { Sa[e2] = (f32x2){0.f, 0.f}; Sb[e2] = (f32x2){0.f, 0.f}; } } }
            __syncthreads();
#pragma unroll 1
            for (int c = 0; c < NC; ++c) {
                const int buf = c & 1;
                if (grp == 1 && (c & 15) == 0) {
#pragma unroll
                    for (int e2 = 0; e2 < 4; ++e2) { Sa[e2] = (f32x2){0.f, 0.f}; Sb[e2] = (f32x2){0.f, 0.f}; } }
                const LAS float* ob = L + (buf * 2 + grp) * SC_OPF; LAS float* yb = L + SC_YOFF + (buf * 2 + grp) * SC_TC * 32 + ra;
                {
                    ScOps cur, nxt; sc_ldops(cur, ob, kg, ra);
                    float ypa = 0.f, ypb = 0.f;
#pragma unroll
                    for (int i = 0; i < SC_TC; ++i) {
                        if (i + 1 < SC_TC) sc_ldops(nxt, ob + (i + 1) * SC_ROWF, kg, ra);
                        const f32x2 va2 = (f32x2){cur.va, cur.va}, vb2 = (f32x2){cur.vb, cur.vb};
                        f32x2 ua[4], ub[4];
#pragma unroll
                        for (int e2 = 0; e2 < 4; ++e2) { ua[e2] = __builtin_elementwise_fma(Sa[e2], cur.w[e2], va2 * cur.kd[e2]); ub[e2] = __builtin_elementwise_fma(Sb[e2], cur.w[e2], vb2 * cur.kd[e2]); }
                        float ska = dot8_p(Sa, cur.kk), skb = dot8_p(Sb, cur.kk);
                        oct_sum4(ska, skb, ypa, ypb);
                        if (i > 0 && kg == 0) { yb[(i - 1) * 32] = ypa; yb[(i - 1) * 32 + 1] = ypb; }
                        const f32x2 na2 = (f32x2){-ska, -ska}, nb2 = (f32x2){-skb, -skb};
#pragma unroll
                        for (int e2 = 0; e2 < 4; ++e2) { Sa[e2] = __builtin_elementwise_fma(na2, cur.ka[e2], ua[e2]); Sb[e2] = __builtin_elementwise_fma(nb2, cur.ka[e2], ub[e2]); }
                        ypa = dot8_p(Sa, cur.r); ypb = dot8_p(Sb, cur.r);
                        if (i + 1 < SC_TC) cur = nxt;
                    }
                    float z0 = 0.f, z1 = 0.f; oct_sum4(ypa, ypb, z0, z1);
                    if (kg == 0) { yb[(SC_TC - 1) * 32] = ypa; yb[(SC_TC - 1) * 32 + 1] = ypb; }
                }
                if (grp == 1 && (c & 15) == 15) { ScDesc d; sc_desc(d, slot, 1, c);
                    float* dp = a.out + id.z + O_ST + ((((size_t)(d.b * 2 + j) * 2 + d.dir) * 16 + d.h) * 64 + d.half * 32 + ra) * 64 + 8 * kg;
                    *(f32x4*)dp = (f32x4){Sa[0][0], Sa[0][1], Sa[1][0], Sa[1][1]}; *(f32x4*)(dp + 4) = (f32x4){Sa[2][0], Sa[2][1], Sa[3][0], Sa[3][1]};
                    *(f32x4*)(dp + 64) = (f32x4){Sb[0][0], Sb[0][1], Sb[1][0], Sb[1][1]}; *(f32x4*)(dp + 68) = (f32x4){Sb[2][0], Sb[2][1], Sb[3][0], Sb[3][1]}; }
                __syncthreads();
            }
        }
        __syncthreads();
    }
}
__device__ __forceinline__ void ph_rw_post(const Args& a, const Ids& id, int layer) {
    const int j = layer >> 1, lane = id.lane;
    const bf16* RKV = (const bf16*)(a.ws + id.z + A_RKV); const float* Y = (const float*)(a.ws + id.z + A_Y);
    const bf16 *A0 = (const bf16*)(a.ws + id.z + A_A0), *A1 = (const bf16*)(a.ws + id.z + A_A1); bf16* H = (bf16*)(a.ws + id.z + A_H);
    const float* kvec = a.in[28 + id.z] + (size_t)j * 3 * D; const float* lnx = a.in[29 + id.z] + (size_t)j * 2 * D;
    f32x4 ka[4], rk[4], l0[4], l1[4];
#pragma unroll
    for (int q = 0; q < 4; ++q) { const int c = 4 * lane + 256 * q; ka[q] = *(const f32x4*)(kvec + D + c); rk[q] = *(const f32x4*)(kvec + 2 * D + c); l0[q] = *(const f32x4*)(lnx + c); l1[q] = *(const f32x4*)(lnx + D + c); }
    for (int m = id.gw; m < NTOK; m += id.ngw) {
        f32x4 y[4], r[4], k[4], v[4], a0[4], a1[4], g[4];
#pragma unroll
        for (int q = 0; q < 4; ++q) { const int c = 4 * lane + 256 * q; y[q] = *(const f32x4*)(Y + (size_t)m * D + c);
            r[q] = ld_bf4(RKV + (size_t)m * 3072 + c); k[q] = ld_bf4(RKV + (size_t)m * 3072 + 1024 + c); v[q] = ld_bf4(RKV + (size_t)m * 3072 + 2048 + c);
            a0[q] = ld_bf4(A0 + (size_t)m * D + c); a1[q] = ld_bf4(A1 + (size_t)m * D + c); g[q] = ld_bf4(H + (size_t)m * D + c); }
        float s[4], qv[4], bs[4];
#pragma unroll
        for (int q = 0; q < 4; ++q) s[q] = (y[q][0] + y[q][1]) + (y[q][2] + y[q][3]);
        row16_sum4(s[0], s[1], s[2], s[3]);
#pragma unroll
        for (int q = 0; q < 4; ++q) { const float mean = s[q] * (1.0f / 64.0f); y[q] = y[q] - mean; qv[q] = (y[q][0] * y[q][0] + y[q][1] * y[q][1]) + (y[q][2] * y[q][2] + y[q][3] * y[q][3]);
            const f32x4 kds = k[q] * ((a0[q] - 1.0f) * ka[q] + 1.0f) + k[q] * ((a1[q] - 1.0f) * ka[q] + 1.0f); const f32x4 t = r[q] * kds * rk[q]; bs[q] = (t[0] + t[1]) + (t[2] + t[3]); }
        row16_sum4(qv[0], qv[1], qv[2], qv[3]);
        row16_sum4(bs[0], bs[1], bs[2], bs[3]);
#pragma unroll
        for (int q = 0; q < 4; ++q) { const float ri = 1.0f / sqrtf(qv[q] * (1.0f / 64.0f) + 64e-5f); const f32x4 o = ((y[q] * ri) * l0[q] + l1[q] + v[q] * bs[q]) * g[q];
            *(v2u*)(H + (size_t)m * D + 4 * lane + 256 * q) = (v2u){pk2(o[0], o[1]), pk2(o[2], o[3])}; }
    }
}

enum Kind { K_PRO = 0, K_NORM0 = 1, K_QKV = 2, K_APOST = 3, K_ATTN = 4, K_ACOMB = 5, K_MIXOUT = 6, K_RNORM = 7, K_MLP1 = 8, K_MLP2 = 9, K_REND = 10,
            K_RMIX = 11, K_RKV = 12, K_RPREP = 13, K_RSCAN = 14, K_RPOST = 15 };
constexpr int NPH = 38;
#ifndef PROBE_MASK
#define PROBE_MASK 0
#endif
#ifndef PROBE_REPS
#define PROBE_REPS 1
#endif
template <int KIND, int LAYER>
__device__ __forceinline__ void run_phase(const Args& a, LAS unsigned char* lds, int G, int bx, int vcu, int wave_s, int rep) {
    Ids id; { int lv; asm volatile("v_mbcnt_lo_u32_b32 %0, -1, 0\n\tv_mbcnt_hi_u32_b32 %0, -1, %0" : "=v"(lv)); int zz; asm volatile("s_mov_b32 %0, 0" : "=s"(zz)); id.lane = lv; id.z = zz; }
    id.wave = wave_s; id.tid = wave_s * 64 + id.lane; id.gw = vcu * NWAVES + id.wave; id.ngw = G * NWAVES;
    constexpr int layer = LAYER;
    if constexpr (KIND == K_PRO) ph_prologue(a, id, lds);
    else if constexpr (KIND == K_NORM0) ph_norm0(a, id);
    else if constexpr (KIND == K_QKV) {
        constexpr int j = layer >> 1;
        pg8::Gemm g{(const bf16*)(a.ws + id.z + A_H), (const bf16*)(a.ws + id.z + W_WINT), NTOK, NQKV, D}; pg8::StaticOrder S; S.init(NTOK, NQKV, G, bx);
        const float* RC = (const float*)(a.ws + id.z + WS_ROPE);
        pg8::EpiQkv<QkvMap> E{a.ws + id.z, a.out + id.z, a.in[14 + id.z] + j * 128, RC, RC + 2048 * 64, j};
        pg8::gemm_phase<pg8::EpiQkv<QkvMap>, pg8::StaticOrder, true, true>(lds + RING_OFF, g, S, E, id.wave);
        { Ids id2 = id; int lv; asm volatile("v_mbcnt_lo_u32_b32 %0, -1, 0\n\tv_mbcnt_hi_u32_b32 %0, -1, %0" : "=v"(lv)); int zz; asm volatile("s_mov_b32 %0, 0" : "=s"(zz));
          id2.lane = lv; id2.z = zz; id2.tid = id.wave * 64 + lv; ph_att_cache(a, id2, layer); }
    }
    else if constexpr (KIND == K_MIXOUT) {
        pg8::Gemm g{(const bf16*)(a.ws + id.z + A_H), (const bf16*)(a.ws + id.z + ((layer & 1) ? W_WOT : W_WOUTT)), NTOK, D, D}; pg8::StaticOrder S; S.init(NTOK, D, G, bx);
        pg8::EpiBf16<0> E{(bf16*)(a.ws + id.z + A_M), D, 1 << 20, nullptr, 0};
        pg8::gemm_phase<pg8::EpiBf16<0>, pg8::StaticOrder, true, true>(lds + RING_OFF, g, S, E, id.wave);
    }
    else if constexpr (KIND == K_MLP2) {
        pg8::Gemm g{(const bf16*)(a.ws + id.z + A_HID), (const bf16*)(a.ws + id.z + W_W2T), NTOK, D, FF}; pg8::StaticOrder S; S.init(NTOK, D, G, bx);
        pg8::EpiBf16<0> E{(bf16*)(a.ws + id.z + A_F), D, 1 << 20, nullptr, 0};
        pg8::gemm_phase<pg8::EpiBf16<0>, pg8::StaticOrder, true, true>(lds + RING_OFF, g, S, E, id.wave);
    }
    else if constexpr (KIND == K_MLP1) {
        pg8::Gemm g{(const bf16*)(a.ws + id.z + A_H), (const bf16*)(a.ws + id.z + W_W1T), NTOK, FF, D}; pg8::StaticOrder S; S.init(NTOK, FF, G, bx);
        pg8::EpiBf16<2> E{(bf16*)(a.ws + id.z + A_HID), FF, 1 << 20, nullptr, 0};
        pg8::gemm_phase<pg8::EpiBf16<2>, pg8::StaticOrder, true, true>(lds + RING_OFF, g, S, E, id.wave);
    }
    else if constexpr (KIND == K_RKV) {
        {
            pg8::Gemm g{(const bf16*)(a.ws + id.z + A_A2), (const bf16*)(a.ws + id.z + W_BTL), NTOK, 512, KRKV}; pg8::StaticOrder S; S.init(NTOK, 512, G, bx);
            pg8::EpiL1 E{(bf16*)(a.ws + id.z + A_L1)};
            pg8::gemm_phase<pg8::EpiL1, pg8::StaticOrder, true, true>(lds + RING_OFF, g, S, E, id.wave); }
        {
            pg8::Gemm g{(const bf16*)(a.ws + id.z + A_XS), (const bf16*)(a.ws + id.z + W_BTR), 3 * NTOK, 3072, D}; pg8::RkvOrder S{bx};
            pg8::EpiRkv3 E{(bf16*)(a.ws + id.z + A_RKV)};
            pg8::gemm_phase<pg8::EpiRkv3, pg8::RkvOrder, true, true>(lds + RING_OFF, g, S, E, id.wave); }
    }
    else if constexpr (KIND == K_RPREP) {
        constexpr int j = layer >> 1;
        pg8::Gemm g{(const bf16*)(a.ws + id.z + A_L1), (const bf16*)(a.ws + id.z + W_BT2), NTOK, 5120, 384}; pg8::StaticOrder S; S.init(NTOK, 5120, G, bx);
        static_assert(A_A1 - A_A0 == 32 * MiB && A_EW0 - A_A0 == 64 * MiB && A_EW1 - A_A0 == 96 * MiB, "EpiLora2 output stride");
        pg8::EpiLora2 E{(bf16*)(a.ws + id.z + A_A0), (size_t)16 * MiB, (bf16*)(a.ws + id.z + A_G), a.in[23 + id.z] + (size_t)j * 2 * D, a.in[20 + id.z] + (size_t)j * 2 * D};
        pg8::gemm_phase<pg8::EpiLora2, pg8::StaticOrder, true, true>(lds + RING_OFF, g, S, E, id.wave);
        { Ids id2 = id; int lv; asm volatile("v_mbcnt_lo_u32_b32 %0, -1, 0\n\tv_mbcnt_hi_u32_b32 %0, -1, %0" : "=v"(lv)); int zz; asm volatile("s_mov_b32 %0, 0" : "=s"(zz));
          id2.lane = lv; id2.z = zz; id2.tid = id.wave * 64 + lv; ph_rw_prep(a, id2, layer); }
    }
    else if constexpr (KIND == K_ATTN) ph_attn(a, id, lds, G, vcu);
    else if constexpr (KIND == K_ACOMB) ph_att_comb(a, id, layer);
    else if constexpr (KIND == K_RNORM) ph_resid_norm(a, id, layer, rep + 1 < (((PROBE_MASK >> K_RNORM) & 1) ? PROBE_REPS : 1));
    else if constexpr (KIND == K_REND) ph_resid_end(a, id, lds, layer, rep + 1 < (((PROBE_MASK >> K_REND) & 1) ? PROBE_REPS : 1));
    else if constexpr (KIND == K_RMIX) ph_rw_mix(a, id, layer);
    else if constexpr (KIND == K_RSCAN) { if (rep > 0) { ph_rw_prep(a, id, layer); __syncthreads(); cg::this_grid().sync(); } ph_rw_scan(a, id, lds, layer, G, vcu); }
    else if constexpr (KIND == K_RPOST) ph_rw_post(a, id, layer);
}

__global__ void __launch_bounds__(NWAVES * 64, 2) mega_fwd(Args a) {
    extern __shared__ __attribute__((aligned(16))) unsigned char lds_raw[];
    LAS unsigned char* lds = (LAS unsigned char*)lds_raw;
    const int G = gridDim.x, bx = blockIdx.x; const int vcu = (G % 8 == 0) ? (bx % 8) * (G / 8) + bx / 8 : bx;
    volatile LAS unsigned* MISC = (volatile LAS unsigned*)(lds + MISC_OFF);
    for (int u = threadIdx.x; u < (LDS_BYTES - LDSCTL_OFF) / 4; u += NWAVES * 64) ((LAS unsigned*)(lds + LDSCTL_OFF))[u] = 0u;
    __syncthreads();
#if MK_N_LAUNCHES == 1 && !MK_CG_BARRIER
    XcdBarrier bar = xcd_barrier_post((unsigned*)(a.ws + WS_CTL) + CW_BAR, MISC + 8, threadIdx.x == 0);
#endif
    (void)MISC;
    const int lo = a.ph_lo, hi = a.ph_hi;
    const int wave_s = __builtin_amdgcn_readfirstlane(threadIdx.x >> 6);
#if MK_N_LAUNCHES == 1
#if MK_CG_BARRIER
#define GRID_BAR(ph) cg::this_grid().sync()
#else
#define GRID_BAR(ph) do { if ((ph) == 0) cg::this_grid().sync(); else { int l_; asm volatile("v_mbcnt_lo_u32_b32 %0, -1, 0\n\tv_mbcnt_hi_u32_b32 %0, -1, %0" : "=v"(l_)); xcd_barrier(bar, wave_s == 0 && l_ == 0); } } while (0)
#endif
#else
#define GRID_BAR(ph) do { } while (0)
#endif
#define PHASE(ph, KIND, LAYER) do { if (lo <= (ph) && (ph) < hi) { constexpr int nrep_ = ((PROBE_MASK >> (KIND)) & 1) ? PROBE_REPS : 1; \
        _Pragma("unroll 1") for (int rep_ = 0; rep_ < nrep_; ++rep_) { run_phase<KIND, LAYER>(a, lds, G, bx, vcu, wave_s, rep_); if (rep_ + 1 < nrep_) { __syncthreads(); cg::this_grid().sync(); } } \
        if ((ph) + 1 < hi) GRID_BAR(ph); } } while (0)
#define ATTN_LAYER(p0, L) PHASE((p0) + 0, K_QKV, L); PHASE((p0) + 1, K_ATTN, L); PHASE((p0) + 2, K_ACOMB, L); PHASE((p0) + 3, K_MIXOUT, L); \
        PHASE((p0) + 4, K_RNORM, L); PHASE((p0) + 5, K_MLP1, L); PHASE((p0) + 6, K_MLP2, L); PHASE((p0) + 7, K_REND, L)
#define RWKV_LAYER(p0, L) PHASE((p0) + 0, K_RMIX, L); PHASE((p0) + 1, K_RKV, L); PHASE((p0) + 2, K_RPREP, L); PHASE((p0) + 3, K_RSCAN, L); PHASE((p0) + 4, K_RPOST, L); PHASE((p0) + 5, K_MIXOUT, L); \
        PHASE((p0) + 6, K_RNORM, L); PHASE((p0) + 7, K_MLP1, L); PHASE((p0) + 8, K_MLP2, L); PHASE((p0) + 9, K_REND, L)
    PHASE(0, K_PRO, 0); PHASE(1, K_NORM0, 0);
    ATTN_LAYER(2, 0); RWKV_LAYER(10, 1); ATTN_LAYER(20, 2); RWKV_LAYER(28, 3);
#undef PHASE
#undef ATTN_LAYER
#undef RWKV_LAYER
#undef GRID_BAR
}

extern "C" void kernel_launch(void* const* d_in, const int* in_sizes, int n_in, void* d_out, int out_size, void* d_ws, size_t ws_size, hipStream_t stream) {
    static int grid = 0;
    if (grid == 0) {
        if (n_in != 32 || (size_t)out_size != OUT_TOTAL || ws_size < WS_END) { fprintf(stderr, "kernel_launch: unexpected problem (n_in %d, out %d, ws %zu; need ws >= %zu); nothing launched\n", n_in, out_size, ws_size, (size_t)WS_END); grid = -1; return; }
        int dev = 0, cus = 0, per_cu = 0;
        if (hipGetDevice(&dev) != hipSuccess || hipDeviceGetAttribute(&cus, hipDeviceAttributeMultiprocessorCount, dev) != hipSuccess) { grid = -1; return; }
        if (hipFuncSetAttribute((const void*)mega_fwd, hipFuncAttributeMaxDynamicSharedMemorySize, LDS_BYTES) != hipSuccess) { fprintf(stderr, "kernel_launch: hipFuncSetAttribute failed\n"); grid = -1; return; }
        if (hipOccupancyMaxActiveBlocksPerMultiprocessor(&per_cu, (const void*)mega_fwd, NWAVES * 64, LDS_BYTES) != hipSuccess || per_cu < 1) { fprintf(stderr, "kernel_launch: occupancy query failed (%d)\n", per_cu); (void)hipGetLastError(); per_cu = 1; }
        grid = cus * (per_cu < 1 ? 1 : 1);
        fprintf(stderr, "kernel_launch: %d CUs, occupancy %d/CU, grid %d\n", cus, per_cu, grid);
    }
    if (grid < 0) return;
    (void)in_sizes;
    if (hipMemsetAsync((char*)d_ws + WS_CTL, 0, CTL_ZERO_BYTES, stream) != hipSuccess) { fprintf(stderr, "kernel_launch: memset failed\n"); return; }
    Args a{};
    for (int i = 0; i < 32; ++i) a.in[i] = (const float*)d_in[i];
    a.out = (float*)d_out; a.ws = (unsigned char*)d_ws;
#if MK_N_LAUNCHES == 1
    a.ph_lo = 0; a.ph_hi = NPH;
    void* args[] = {&a};
    hipError_t e = hipLaunchCooperativeKernel((const void*)mega_fwd, dim3(grid), dim3(NWAVES * 64), args, LDS_BYTES, stream);
    if (e != hipSuccess) fprintf(stderr, "kernel_launch: cooperative launch failed: %s (grid %d)\n", hipGetErrorString(e), grid);
#else
    for (int ph = 0; ph < NPH; ++ph) {
        a.ph_lo = ph; a.ph_hi = ph + 1;
        hipLaunchKernelGGL(mega_fwd, dim3(grid), dim3(NWAVES * 64), LDS_BYTES, stream, a);
    }
#endif
}
```

```cpp
#include <hip/hip_runtime.h>
#include <hip/hip_cooperative_groups.h>
#include <cstdio>
#include <cstdint>
namespace cg = cooperative_groups;
namespace pg8 {
#define PG8_LAS __attribute__((address_space(3)))
typedef unsigned short bf16_t;
typedef short bf16x8 __attribute__((ext_vector_type(8)));
typedef float f32x4 __attribute__((ext_vector_type(4)));
typedef unsigned u32x4 __attribute__((ext_vector_type(4)));
constexpr int BM = 256, BK = 64, HALF = 128, HTB = HALF * BK * 2  , STAGE_BYTES = 8 * HTB, NXCD = 8, WGM = 8;

__host__ __device__ __forceinline__ int lds_byte(int r, int c) { const int st = (r >> 4) * 2 + (c >> 5), rr = r & 15, cc = c & 31, ob = rr * 64 + cc * 2; return st * 1024 + (ob ^ (((ob >> 9) & 1) << 5)); }
__host__ __device__ __forceinline__ void stage_rc(int b, int& R, int& C) { const int st = b / 1024, sb = b % 1024, swz = sb ^ (((sb >> 9) & 1) << 5); R = (st >> 1) * 16 + swz / 64; C = (st & 1) * 32 + (swz % 64) / 2; }
__host__ __device__ __forceinline__ int perm32(int rho) { const int n = rho >> 4, i = rho & 15; return 8 * (i >> 2) + 4 * n + (i & 3); }

struct Unit { int pm, pn; };
struct Gemm { const bf16_t* A; const bf16_t* Bt; int M, N, K; };

struct StaticOrder {
    int nM, nN, nwg, G, c;
    __host__ __device__ void init(int M, int N, int G_, int c_) { nM = M / BM; nN = N / BM; nwg = nM * nN; G = G_; c = c_; }
    __host__ __device__ bool next(int i, Unit& u) const {
        const long L = (long)i * G + c; if (L >= nwg) return false;
        int wgid = (int)L; { const int q = nwg / NXCD, r = nwg % NXCD, xcd = wgid % NXCD, off = wgid / NXCD; wgid = (xcd < r ? xcd * (q + 1) : r * (q + 1) + (xcd - r) * q) + off; }
        const int nig = WGM * nN, gid = wgid / nig, fm = gid * WGM, gsz = (nM - fm) < WGM ? (nM - fm) : WGM;
        u.pm = fm + ((wgid % nig) % gsz); u.pn = (wgid % nig) / gsz; return true;
    }
    __device__ __forceinline__ void a_ready(const Unit&) const {}
    __device__ __forceinline__ void done(const Unit&) const {}
};


__device__ __forceinline__ unsigned cvt_pk_bf16(float lo, float hi) { unsigned r; asm volatile("v_cvt_pk_bf16_f32 %0, %1, %2" : "=v"(r) : "v"(lo), "v"(hi)); return r; }

template <int ACT> struct EpiBf16 {
    static constexpr bool PERM = true, AFTER_DRAIN = false;
    bf16_t* O0; int ld0; int nt0; bf16_t* O1; int ld1;
    __device__ __forceinline__ void operator()(const f32x4 (&acc)[2][2][4][2], const Unit& u, int wr, int wc, int fr, int fq) const {
        const int row0 = u.pm * BM + wr * 64 + fr;
        bf16_t* base; int ldc, colt;
        if (u.pn < nt0) { base = O0; ldc = ld0; colt = u.pn * BM; } else { base = O1; ldc = ld1; colt = (u.pn - nt0) * BM; }
        const int col0 = colt + wc * 32 + 8 * fq;
#pragma unroll
        for (int ai = 0; ai < 2; ++ai)
#pragma unroll
            for (int m = 0; m < 4; ++m) { bf16_t* rowp = base + (size_t)(row0 + ai * HALF + m * 16) * ldc + col0;
#pragma unroll
                for (int bj = 0; bj < 2; ++bj) { f32x4 v0 = acc[ai][bj][m][0], v1 = acc[ai][bj][m][1];
                    if (ACT == 2) {
#pragma unroll
                        for (int e = 0; e < 4; ++e) { float a = v0[e] > 0.f ? v0[e] : 0.f; v0[e] = a * a; float b = v1[e] > 0.f ? v1[e] : 0.f; v1[e] = b * b; } }
                    u32x4 w; w.x = cvt_pk_bf16(v0[0], v0[1]); w.y = cvt_pk_bf16(v0[2], v0[3]); w.z = cvt_pk_bf16(v1[0], v1[1]); w.w = cvt_pk_bf16(v1[2], v1[3]);
                    *(u32x4*)(rowp + bj * HALF) = w; } }
    }
    __device__ __forceinline__ void fused(f32x4 (&)[2][2][4][2], const Unit&, int, int, int, int, PG8_LAS unsigned char*, int, int) const {}
};


__device__ __forceinline__ float sig_f(float x) { return 1.0f / (1.0f + __expf(-x)); }
struct RkvOrder {
    int c;
    __device__ __forceinline__ bool next(int i, Unit& u) const {
        int L; if (c < 128) { if (i >= 2) return false; L = c * 2 + i; } else { if (i >= 4) return false; L = 256 + (c - 128) * 4 + i; }
        const int which = L >> 8, r = L & 255; u.pm = which * 64 + (r >> 2); u.pn = which * 4 + (r & 3); return true; }
    __device__ __forceinline__ void a_ready(const Unit&) const {}
    __device__ __forceinline__ void done(const Unit&) const {}
};
struct EpiRkv3 {
    static constexpr bool PERM = true, AFTER_DRAIN = false;
    bf16_t* RKV;
    __device__ __forceinline__ void operator()(const f32x4 (&acc)[2][2][4][2], const Unit& u, int wr, int wc, int fr, int fq) const {
        const int row0 = (u.pm & 63) * BM + wr * 64 + fr, col0 = u.pn * BM + wc * 32 + 8 * fq;
#pragma unroll
        for (int ai = 0; ai < 2; ++ai)
#pragma unroll
            for (int m = 0; m < 4; ++m) { bf16_t* rowp = RKV + (size_t)(row0 + ai * HALF + m * 16) * 3072 + col0;
#pragma unroll
                for (int bj = 0; bj < 2; ++bj) { const f32x4 v0 = acc[ai][bj][m][0], v1 = acc[ai][bj][m][1];
                    u32x4 w; w.x = cvt_pk_bf16(v0[0], v0[1]); w.y = cvt_pk_bf16(v0[2], v0[3]); w.z = cvt_pk_bf16(v1[0], v1[1]); w.w = cvt_pk_bf16(v1[2], v1[3]);
                    *(u32x4*)(rowp + bj * HALF) = w; } }
    }
};
struct EpiL1 {
    static constexpr bool PERM = true, AFTER_DRAIN = false;
    bf16_t* L1;
    __device__ __forceinline__ void operator()(const f32x4 (&acc)[2][2][4][2], const Unit& u, int wr, int wc, int fr, int fq) const {
        const int row0 = u.pm * BM + wr * 64 + fr, colt = u.pn * BM, col0 = colt + wc * 32 + 8 * fq;
#pragma unroll
        for (int ai = 0; ai < 2; ++ai)
#pragma unroll
            for (int m = 0; m < 4; ++m) { bf16_t* rowp = L1 + (size_t)(row0 + ai * HALF + m * 16) * 384 + col0;
#pragma unroll
                for (int bj = 0; bj < 2; ++bj) { f32x4 v0 = acc[ai][bj][m][0], v1 = acc[ai][bj][m][1];
                    const int cb = colt + bj * HALF;
                    if (cb >= 384) continue;
                    if (cb == 0) {
#pragma unroll
                        for (int e = 0; e < 4; ++e) { v0[e] = 1.0f - 2.0f / (1.0f + __expf(2.0f * v0[e])); v1[e] = 1.0f - 2.0f / (1.0f + __expf(2.0f * v1[e])); } }
                    else if (cb == 256) {
#pragma unroll
                        for (int e = 0; e < 4; ++e) { v0[e] = sig_f(v0[e]); v1[e] = sig_f(v1[e]); } }
                    u32x4 w; w.x = cvt_pk_bf16(v0[0], v0[1]); w.y = cvt_pk_bf16(v0[2], v0[3]); w.z = cvt_pk_bf16(v1[0], v1[1]); w.w = cvt_pk_bf16(v1[2], v1[3]);
                    *(u32x4*)(rowp + bj * HALF) = w; } }
    }
};
struct EpiLora2 {
    static constexpr bool PERM = true, AFTER_DRAIN = false;
    bf16_t* o4; size_t ostride; bf16_t* og; const float* a0; const float* w0;
    __device__ __forceinline__ void operator()(const f32x4 (&acc)[2][2][4][2], const Unit& u, int wr, int wc, int fr, int fq) const {
        const int row0 = u.pm * BM + wr * 64 + fr; const int blk = u.pn >> 2, colt = (u.pn & 3) * BM;
        bf16_t* base = (blk < 4) ? o4 + (size_t)blk * ostride : og;
        const float* bs = ((blk < 2) ? a0 : w0) + (blk & 1) * 1024;
        const int col0 = colt + wc * 32 + 8 * fq;
        const float sc = (blk >= 2) ? 0.8750387749719753f : 1.0f;
#pragma unroll
        for (int bj = 0; bj < 2; ++bj) {
            f32x4 b0 = (f32x4){0.f, 0.f, 0.f, 0.f}, b1 = b0;
            if (blk < 4) { b0 = *(const f32x4*)(bs + col0 + bj * HALF); b1 = *(const f32x4*)(bs + col0 + bj * HALF + 4); }
#pragma unroll
            for (int ai = 0; ai < 2; ++ai)
#pragma unroll
                for (int m = 0; m < 4; ++m) { bf16_t* rowp = base + (size_t)(row0 + ai * HALF + m * 16) * 1024 + col0;
                    f32x4 v0 = acc[ai][bj][m][0] + b0, v1 = acc[ai][bj][m][1] + b1;
                    if (blk < 4) {
#pragma unroll
                        for (int e = 0; e < 4; ++e) { v0[e] = sc * sig_f(v0[e]); v1[e] = sc * sig_f(v1[e]); } }
                    u32x4 w; w.x = cvt_pk_bf16(v0[0], v0[1]); w.y = cvt_pk_bf16(v0[2], v0[3]); w.z = cvt_pk_bf16(v1[0], v1[1]); w.w = cvt_pk_bf16(v1[2], v1[3]);
                    *(u32x4*)(rowp + bj * HALF) = w; } }
    }
};


template <class MP> struct EpiQkv {
    static constexpr bool PERM = true, AFTER_DRAIN = false;
    unsigned char* ws; float* out; const float* gain; const float* RC; const float* RS; int j;
    static constexpr size_t oQA = MP::oQA, oQB = MP::oQB, oKAP = MP::oKAP, oVAP = MP::oVAP, oKBP = MP::oKBP, oVBP = MP::oVBP, oKAS = MP::oKAS, oVAS = MP::oVAS, oKBS = MP::oKBS, oVBS = MP::oVBS;
    static constexpr size_t oKG = MP::oKG, oVG = MP::oVG, oKD = MP::oKD, oVD = MP::oVD;
    __device__ __forceinline__ void operator()(const f32x4 (&acc)[2][2][4][2], const Unit& u, int wr, int wc, int fr, int fq) const {
        const int ch = 4 * u.pn + wc; const bool smp = u.pm >= 32;
        const bool isq = (ch < 8) || (ch >= 12 && ch < 20), isk = (ch == 8 || ch == 9) || (ch >= 20 && ch < 28);
        const int dl = 8 * fq;
        const bool hi2 = (fq & 2) != 0;
        f32x4 g[2][2];
#pragma unroll
        for (int bj = 0; bj < 2; ++bj)
#pragma unroll
            for (int n = 0; n < 2; ++n) g[bj][n] = (ch < 10) ? *(const f32x4*)(gain + (ch < 8 ? 0 : 64) + bj * 32 + dl + 4 * n) : (f32x4){1.f, 1.f, 1.f, 1.f};
        constexpr float QS = 0.18033688011112042f;
#pragma unroll
        for (int ai = 0; ai < 2; ++ai)
#pragma unroll
            for (int m = 0; m < 4; ++m) {
                const int mrow = u.pm * BM + ai * HALF + wr * 64 + m * 16 + fr;
                const int b = smp ? ((mrow - 8192) >> 11) : (mrow >> 8), t = smp ? ((mrow - 8192) & 2047) : (mrow & 255);
                f32x4 v[2][2];
#pragma unroll
                for (int bj = 0; bj < 2; ++bj)
#pragma unroll
                    for (int n = 0; n < 2; ++n) v[bj][n] = acc[ai][bj][m][n];
                if (ch < 10) { float ss = 0.f;
#pragma unroll
                    for (int bj = 0; bj < 2; ++bj)
#pragma unroll
                        for (int n = 0; n < 2; ++n) ss += (v[bj][n][0] * v[bj][n][0] + v[bj][n][1] * v[bj][n][1]) + (v[bj][n][2] * v[bj][n][2] + v[bj][n][3] * v[bj][n][3]);
                    ss += __shfl_xor(ss, 16); ss += __shfl_xor(ss, 32);
                    const float ri = 1.0f / sqrtf(ss * (1.0f / 64.0f) + 1e-6f);
#pragma unroll
                    for (int bj = 0; bj < 2; ++bj)
#pragma unroll
                        for (int n = 0; n < 2; ++n) v[bj][n] = v[bj][n] * ri * g[bj][n]; }
                f32x4 vr[2][2];
#pragma unroll
                for (int bj = 0; bj < 2; ++bj)
#pragma unroll
                    for (int n = 0; n < 2; ++n) { vr[bj][n] = v[bj][n];
                        if (smp && (isq || isk)) { f32x4 p; p[0] = __shfl_xor(v[bj][n][0], 32); p[1] = __shfl_xor(v[bj][n][1], 32); p[2] = __shfl_xor(v[bj][n][2], 32); p[3] = __shfl_xor(v[bj][n][3], 32);
                            const f32x4 cs = *(const f32x4*)(RC + t * 64 + bj * 32 + dl + 4 * n), sn = *(const f32x4*)(RS + t * 64 + bj * 32 + dl + 4 * n);
                            const f32x4 rot = hi2 ? p : -p; vr[bj][n] = v[bj][n] * cs + rot * sn; } }
#define EQ_PK8(x0, x1) ((u32x4){cvt_pk_bf16((x0)[0], (x0)[1]), cvt_pk_bf16((x0)[2], (x0)[3]), cvt_pk_bf16((x1)[0], (x1)[1]), cvt_pk_bf16((x1)[2], (x1)[3])})
                const size_t srow = (size_t)(b * 2560 + 512 + t), prow = (size_t)((b * 2 + j) * 256 + t);
#pragma unroll
                for (int bj = 0; bj < 2; ++bj) {
                    const int f0 = bj * 32 + dl;
                    if (isq) { const f32x4 s0 = vr[bj][0] * QS, s1 = vr[bj][1] * QS; const size_t o = (ch < 8) ? oQA + ((size_t)mrow * 512 + ch * 64 + f0) * 2 : oQB + ((size_t)mrow * 512 + (ch - 12) * 64 + f0) * 2;
                        *(u32x4*)(ws + o) = EQ_PK8(s0, s1); }
                    else {
                        const bool gq = ch < 12, kk = isk;
                        const int e = gq ? ((ch & 1) * 64 + f0) : ((ch - (kk ? 20 : 28)) * 64 + f0); const int wdt = gq ? 128 : 512;
                        if (!smp) { const size_t of = (gq ? (kk ? oKG : oVG) : (kk ? oKD : oVD)) + prow * wdt + e; *(f32x4*)(out + of) = v[bj][0]; *(f32x4*)(out + of + 4) = v[bj][1];
                            const size_t o = (gq ? (kk ? oKAP : oVAP) : (kk ? oKBP : oVBP)) + ((size_t)mrow * wdt + e) * 2; *(u32x4*)(ws + o) = EQ_PK8(v[bj][0], v[bj][1]); }
                        else { const size_t o = (gq ? (kk ? oKAS : oVAS) : (kk ? oKBS : oVBS)) + (srow * wdt + e) * 2; *(u32x4*)(ws + o) = EQ_PK8(vr[bj][0], vr[bj][1]); } }
                }
#undef EQ_PK8
            }
    }
};

template <class Epi, class Sched, bool ALIGN_EPI = false, bool SP2 = false>
__device__ __forceinline__ void gemm_phase(PG8_LAS unsigned char* lds, const Gemm g, const Sched& S, const Epi& E, const int wave_index) {
    int lane_o; asm volatile("v_mbcnt_lo_u32_b32 %0, -1, 0\n\tv_mbcnt_hi_u32_b32 %0, -1, %0" : "=v"(lane_o));
    const int wid = wave_index, lane = lane_o, tid = wid * 64 + lane, wr = wid >> 2, wc = wid & 3, fr = lane & 15, fq = lane >> 4;
    const int K = g.K, nt = K / BK;
    unsigned voffA[2], voffB[2];
#pragma unroll
    for (int i = 0; i < 2; ++i) { int R, C; stage_rc(tid * 16 + i * 8192, R, C); const int Rb = Epi::PERM ? ((R & ~31) + perm32(R & 31)) : R;
        voffA[i] = (unsigned)(R * K + C) * 2u; voffB[i] = (unsigned)(Rb * K + C) * 2u; }
    const size_t kstep = (size_t)(BK * 2);
    const size_t hstep = (size_t)HALF * K * 2;
    const size_t tstep = 2 * hstep;
    const unsigned ldsw = (unsigned)wid * 1024u;
    const int aoff = lds_byte(wr * 64 + fr, fq * 8), boff = lds_byte(wc * 32 + fr, fq * 8);
#define PG8_SA(b, h) (((b) * 2 + (h)) * HTB)
#define PG8_SB(b, h) ((4 + (b) * 2 + (h)) * HTB)
#define PG8_STAGE(bufoff, gbase, voff) do { _Pragma("unroll") for (int _i = 0; _i < 2; ++_i) \
        __builtin_amdgcn_global_load_lds((const unsigned*)((const char*)(gbase) + (voff)[_i]), (PG8_LAS unsigned*)(lds + (bufoff) + ldsw + _i * 8192), 16, 0, 0); } while (0)
#define PG8_LDA(dst, b, h) do { _Pragma("unroll") for (int m = 0; m < 4; ++m) _Pragma("unroll") for (int k = 0; k < 2; ++k) dst[m][k] = *(const PG8_LAS bf16x8*)(lds + PG8_SA(b, h) + aoff + m * 2048 + k * 1024); } while (0)
#define PG8_LDB(dst, b, h) do { _Pragma("unroll") for (int n = 0; n < 2; ++n) _Pragma("unroll") for (int k = 0; k < 2; ++k) dst[n][k] = *(const PG8_LAS bf16x8*)(lds + PG8_SB(b, h) + boff + n * 2048 + k * 1024); } while (0)
#define PG8_MMA(ai, bj, At, Bt) do { __builtin_amdgcn_s_setprio(1); _Pragma("unroll") for (int m = 0; m < 4; ++m) _Pragma("unroll") for (int n = 0; n < 2; ++n) _Pragma("unroll") for (int k = 0; k < 2; ++k) \
        acc[ai][bj][m][n] = __builtin_amdgcn_mfma_f32_16x16x32_bf16(Bt[n][k], At[m][k], acc[ai][bj][m][n], 0, 0, 0); __builtin_amdgcn_s_setprio(0); } while (0)
#define PG8_WAIT_V(n) asm volatile("s_waitcnt vmcnt(" #n ")" ::: "memory")
#define PG8_WAIT_L(n) asm volatile("s_waitcnt lgkmcnt(" #n ")" ::: "memory")
#define PG8_BAR __builtin_amdgcn_s_barrier()
#define PG8_SCHED __builtin_amdgcn_sched_barrier(0)
    Unit cur, nxt; int ui = 0;
    if (!S.next(0, cur)) return;
    f32x4 acc[2][2][4][2];
#pragma unroll
    for (int a = 0; a < 2; ++a)
#pragma unroll
        for (int b = 0; b < 2; ++b)
#pragma unroll
            for (int m = 0; m < 4; ++m)
#pragma unroll
                for (int n = 0; n < 2; ++n) acc[a][b][m][n] = (f32x4){0.f, 0.f, 0.f, 0.f};
    bf16x8 At[4][2], B0[2][2], B1[2][2];
    const char* cA = (const char*)g.A + (size_t)cur.pm * tstep; const char* cB = (const char*)g.Bt + (size_t)cur.pn * tstep;
    S.a_ready(cur);
    if constexpr (SP2) {
        PG8_STAGE(PG8_SB(0, 0), cB, voffB); PG8_STAGE(PG8_SB(0, 1), cB + hstep, voffB); PG8_STAGE(PG8_SA(0, 0), cA, voffA); PG8_STAGE(PG8_SA(0, 1), cA + hstep, voffA);
        if (wr == 1) PG8_BAR;
        PG8_WAIT_V(2); PG8_BAR;
        PG8_STAGE(PG8_SB(1, 0), cB + kstep, voffB); PG8_STAGE(PG8_SA(1, 0), cA + kstep, voffA); PG8_STAGE(PG8_SB(1, 1), cB + hstep + kstep, voffB);
        PG8_WAIT_V(6); PG8_BAR;
    } else {
        PG8_STAGE(PG8_SB(0, 0), cB, voffB); PG8_STAGE(PG8_SA(0, 0), cA, voffA); PG8_STAGE(PG8_SB(0, 1), cB + hstep, voffB); PG8_STAGE(PG8_SA(0, 1), cA + hstep, voffA);
        if (wr == 1) PG8_BAR;
        PG8_WAIT_V(4); PG8_BAR;
        PG8_STAGE(PG8_SB(1, 0), cB + kstep, voffB); PG8_STAGE(PG8_SA(1, 0), cA + kstep, voffA); PG8_STAGE(PG8_SB(1, 1), cB + hstep + kstep, voffB);
        PG8_WAIT_V(6); PG8_BAR;
    }
    for (;;) {
        const bool has_next = S.next(ui + 1, nxt);
        const char* nA = has_next ? (const char*)g.A + (size_t)nxt.pm * tstep : cA; const char* nB = has_next ? (const char*)g.Bt + (size_t)nxt.pn * tstep : cB;
#pragma unroll 1
        for (int t = 0; t < nt; t += 2) {
            const bool last = (t == nt - 2);
            const char* a1 = cA + (size_t)(t + 1) * kstep;
            const char* a2 = last ? nA : cA + (size_t)(t + 2) * kstep; const char* b2 = last ? nB : cB + (size_t)(t + 2) * kstep;
            const char* a3 = a2 + kstep; const char* b3 = b2 + kstep;
            if (last && has_next) S.a_ready(nxt);
            if constexpr (SP2) {
            PG8_LDB(B0, 0, 0); PG8_LDB(B1, 0, 1); PG8_SCHED; PG8_LDA(At, 0, 0); PG8_STAGE(PG8_SA(1, 1), a1 + hstep, voffA);
            PG8_WAIT_V(8); PG8_WAIT_L(0); PG8_BAR; PG8_MMA(0, 0, At, B0); PG8_MMA(0, 1, At, B1); PG8_BAR; PG8_SCHED;
            PG8_LDA(At, 0, 1); PG8_STAGE(PG8_SB(0, 0), b2, voffB); PG8_STAGE(PG8_SB(0, 1), b2 + hstep, voffB); PG8_STAGE(PG8_SA(0, 0), a2, voffA);
            PG8_WAIT_V(8); PG8_WAIT_L(0); PG8_BAR; PG8_MMA(1, 0, At, B0); PG8_MMA(1, 1, At, B1); PG8_BAR; PG8_SCHED;
            PG8_LDB(B0, 1, 0); PG8_LDB(B1, 1, 1); PG8_SCHED; PG8_LDA(At, 1, 0); PG8_STAGE(PG8_SA(0, 1), a2 + hstep, voffA);
            PG8_WAIT_V(8); PG8_WAIT_L(0); PG8_BAR; PG8_MMA(0, 0, At, B0); PG8_MMA(0, 1, At, B1); PG8_BAR; PG8_SCHED;
            PG8_LDA(At, 1, 1); PG8_STAGE(PG8_SB(1, 0), b3, voffB); PG8_STAGE(PG8_SB(1, 1), b3 + hstep, voffB); PG8_STAGE(PG8_SA(1, 0), a3, voffA);
            PG8_WAIT_V(8); PG8_WAIT_L(0); PG8_BAR; PG8_MMA(1, 0, At, B0); PG8_MMA(1, 1, At, B1); PG8_BAR; PG8_SCHED;
            } else {
            PG8_LDB(B0, 0, 0); PG8_SCHED; PG8_LDA(At, 0, 0); PG8_STAGE(PG8_SA(1, 1), a1 + hstep, voffA);
            PG8_WAIT_L(8); PG8_BAR; PG8_WAIT_L(0); PG8_MMA(0, 0, At, B0); PG8_BAR; PG8_SCHED;
            PG8_LDB(B1, 0, 1); PG8_STAGE(PG8_SB(0, 0), b2, voffB);
            PG8_BAR; PG8_WAIT_L(0); PG8_MMA(0, 1, At, B1); PG8_BAR;
            PG8_LDA(At, 0, 1); PG8_STAGE(PG8_SA(0, 0), a2, voffA);
            PG8_BAR; PG8_WAIT_L(0); PG8_MMA(1, 0, At, B0); PG8_BAR; PG8_SCHED;
            PG8_STAGE(PG8_SB(0, 1), b2 + hstep, voffB);
            PG8_WAIT_V(6); PG8_BAR; PG8_MMA(1, 1, At, B1); PG8_BAR;
            PG8_LDB(B0, 1, 0); PG8_SCHED; PG8_LDA(At, 1, 0); PG8_STAGE(PG8_SA(0, 1), a2 + hstep, voffA);
            PG8_WAIT_L(8); PG8_BAR; PG8_WAIT_L(0); PG8_MMA(0, 0, At, B0); PG8_BAR; PG8_SCHED;
            PG8_LDB(B1, 1, 1); PG8_STAGE(PG8_SB(1, 0), b3, voffB);
            PG8_BAR; PG8_WAIT_L(0); PG8_MMA(0, 1, At, B1); PG8_BAR;
            PG8_LDA(At, 1, 1); PG8_STAGE(PG8_SA(1, 0), a3, voffA);
            PG8_BAR; PG8_WAIT_L(0); PG8_MMA(1, 0, At, B0); PG8_BAR; PG8_SCHED;
            PG8_STAGE(PG8_SB(1, 1), b3 + hstep, voffB);
            PG8_WAIT_V(6); PG8_BAR; PG8_MMA(1, 1, At, B1); PG8_BAR;
            }
        }
        if constexpr (ALIGN_EPI) { if (wr == 0) PG8_BAR; }
        if constexpr (!Epi::AFTER_DRAIN) { E(acc, cur, wr, wc, fr, fq); S.done(cur); }
        if (!has_next) break;
#pragma unroll
        for (int a = 0; a < 2; ++a)
#pragma unroll
            for (int b = 0; b < 2; ++b)
#pragma unroll
                for (int m = 0; m < 4; ++m)
#pragma unroll
                    for (int n = 0; n < 2; ++n) acc[a][b][m][n] = (f32x4){0.f, 0.f, 0.f, 0.f};
        cur = nxt; cA = nA; cB = nB; ++ui;
        if constexpr (ALIGN_EPI) { if (wr == 1) PG8_BAR; }
    }
    PG8_WAIT_V(0);
    if constexpr (!ALIGN_EPI) { if (wr == 0) PG8_BAR; }
    PG8_BAR;
    if constexpr (Epi::AFTER_DRAIN) { E.fused(acc, cur, wr, wc, fr, fq, lds, wid, lane); S.done(cur); }
#undef PG8_SA
#undef PG8_SB
#undef PG8_STAGE
#undef PG8_LDA
#undef PG8_LDB
#undef PG8_MMA
#undef PG8_WAIT_V
#undef PG8_WAIT_L
#undef PG8_BAR
#undef PG8_SCHED
}
}

#define GAS __attribute__((address_space(1)))
#define LAS __attribute__((address_space(3)))
typedef unsigned short bf16;
typedef unsigned v4u __attribute__((ext_vector_type(4)));
typedef unsigned v2u __attribute__((ext_vector_type(2)));
typedef float f32x4 __attribute__((ext_vector_type(4)));
#define LDS_WAIT() asm volatile("s_waitcnt lgkmcnt(0)" ::: "memory")

#ifndef MK_N_LAUNCHES
#define MK_N_LAUNCHES 1
#endif
#ifndef MK_CG_BARRIER
#define MK_CG_BARRIER 0
#endif

constexpr int D = 1024, NTOK = 16384, NPR = 8192, TP = 256, TS = 2048, PAST = 512, SKV = 2560, FF = 4096, DEPTH = 4;
constexpr int NQKV = 2304, NRKV = 3584, KRKV = 2048;
constexpr int NWAVES = 8;
constexpr size_t O_X = 0, O_KG = 16777216, O_VG = 18874368, O_KD = 20971520, O_VD = 29360128, O_ST = 37748736, OUT_TOTAL = 46137344;
constexpr size_t MiB = 1u << 20;
constexpr size_t WS_CTL = 0, CTL_ZERO_BYTES = 1 * MiB;
constexpr size_t WS_MOD = 65536;
constexpr size_t WS_ROPE = 1 * MiB;
constexpr size_t WS_INV = 2 * MiB;
constexpr size_t WS_W = 4 * MiB;
constexpr size_t W_W1T = WS_W, W_W2T = WS_W + 8 * MiB, W_MIX = WS_W + 16 * MiB;
constexpr size_t W_WINT = W_MIX, W_WOUTT = W_MIX + 6 * MiB;
constexpr size_t W_BTR = W_MIX, W_BTL = W_MIX + 6 * MiB, W_WOT = W_MIX + 14 * MiB, W_BT2 = W_MIX + 16 * MiB;
constexpr size_t AR = 40 * MiB;
constexpr size_t A_H = AR;
constexpr size_t A_QKVRAW = AR + 32 * MiB;
constexpr size_t A_DT = AR + 32 * MiB;
constexpr size_t A_M = AR + 96 * MiB;
constexpr size_t A_QA = AR + 176 * MiB, A_QB = AR + 192 * MiB, A_KAP = AR + 208 * MiB, A_VAP = AR + 210 * MiB, A_KBP = AR + 212 * MiB, A_VBP = AR + 220 * MiB;
constexpr size_t A_KAS = AR + 228 * MiB, A_VAS = AR + 231 * MiB, A_KBS = AR + 234 * MiB, A_VBS = AR + 244 * MiB;
constexpr size_t A_HID = AR + 32 * MiB;
constexpr size_t A_F = AR + 160 * MiB;
constexpr size_t A_A2 = AR + 32 * MiB;
constexpr size_t A_XS = AR + 208 * MiB;
constexpr size_t A_Y = AR + 32 * MiB;
constexpr size_t A_RKV = AR + 96 * MiB;
constexpr size_t A_L1 = AR + 192 * MiB;
constexpr size_t A_G = A_H;
constexpr size_t A_A0 = AR + 208 * MiB, A_A1 = AR + 240 * MiB, A_EW0 = AR + 272 * MiB, A_EW1 = AR + 304 * MiB;
constexpr size_t WS_END = AR + 336 * MiB;
struct QkvMap { static constexpr size_t oQA = A_QA, oQB = A_QB, oKAP = A_KAP, oVAP = A_VAP, oKBP = A_KBP, oVBP = A_VBP, oKAS = A_KAS, oVAS = A_VAS, oKBS = A_KBS, oVBS = A_VBS, oKG = O_KG, oVG = O_VG, oKD = O_KD, oVD = O_VD; };
constexpr int CW_BAR = 4096;

constexpr int RING_OFF = 0, RING_BYTES = 131072;
constexpr int LDSCTL_OFF = RING_BYTES, MISC_OFF = LDSCTL_OFF + 320;
constexpr int LDS_BYTES = 147456;

typedef float f32x2_t __attribute__((ext_vector_type(2))); typedef __bf16 bf16x2_t __attribute__((ext_vector_type(2)));
__device__ __forceinline__ unsigned pk2(float lo, float hi) { const f32x2_t v = {lo, hi}; return __builtin_bit_cast(unsigned, __builtin_convertvector(v, bf16x2_t)); }
__device__ __forceinline__ unsigned f2bf(float f) { return pk2(f, 0.f) & 0xffffu; }
__device__ __forceinline__ float bf2f(unsigned short h) { return __builtin_bit_cast(float, (unsigned)h << 16); }
__device__ __forceinline__ float bflo(unsigned w) { return __builtin_bit_cast(float, w << 16); }
__device__ __forceinline__ float bfhi(unsigned w) { return __builtin_bit_cast(float, w & 0xffff0000u); }
__device__ __forceinline__ float wave_sum(float v) {
#pragma unroll
    for (int o = 1; o < 64; o <<= 1) v += __shfl_xor(v, o);
    return v;
}
__device__ __forceinline__ float sigmoidf_(float x) { return 1.0f / (1.0f + __expf(-x)); }
__device__ __forceinline__ float rdl(float x, int l) { return __builtin_bit_cast(float, __builtin_amdgcn_readlane(__builtin_bit_cast(int, x), l)); }

#define XB_TMO      128
#define XB_XCNT(j)  (256  + 64 * (j))
#define XB_XSUB(j)  (1280 + 64 * (j))
#define XB_XGEN(j)  (2304 + 64 * (j))
#define XB_TOP      3328
#define XB_TOPGEN   3392
#define XCD_BAR_WORDS 3456
#define XB_SPIN_CAP (1u << 18)

__device__ __forceinline__ unsigned xb_ld(unsigned* p)              { return __hip_atomic_load(p, __ATOMIC_RELAXED, __HIP_MEMORY_SCOPE_AGENT); }
__device__ __forceinline__ unsigned xb_add(unsigned* p, unsigned v) { return __hip_atomic_fetch_add(p, v, __ATOMIC_RELAXED, __HIP_MEMORY_SCOPE_AGENT); }
__device__ __forceinline__ unsigned xb_xcc_id() { return (unsigned)__builtin_amdgcn_s_getreg((3 << 11) | 20) & 0xFu; }
#define XB_SPIN(cond, bar) do { unsigned _sp = 0; while (cond) { __builtin_amdgcn_s_sleep(1); \
    if ((++_sp & 255u) == 0u) { if (xb_ld(&(bar)[XB_TMO])) break; if (_sp > XB_SPIN_CAP) { atomicAdd(&(bar)[XB_TMO], 1u); break; } } } } while (0)

struct XcdBarrier {
    unsigned* bar; unsigned x;
    volatile LAS unsigned* st;
};

__device__ __forceinline__ XcdBarrier xcd_barrier_post(unsigned* bar, volatile LAS unsigned* st, bool leader) {
    XcdBarrier b; b.bar = bar; b.x = xb_xcc_id(); b.st = st;
    if (leader) (void)xb_add(&bar[XB_XCNT(b.x)], 1u);
    return b;
}
__device__ __forceinline__ void xcd_barrier_complete(unsigned* bar, unsigned x, unsigned& nloc, unsigned& nx) {
    const unsigned G = gridDim.x * gridDim.y * gridDim.z;
    unsigned sum, cnt, mine, sp = 0u;
    for (;;) {
        sum = 0u; cnt = 0u; mine = 0u;
#pragma unroll
        for (unsigned j = 0; j < 16; ++j) { const unsigned c = xb_ld(&bar[XB_XCNT(j)]); sum += c; cnt += (c > 0u) ? 1u : 0u; mine = (j == x) ? c : mine; }
        if (sum == G) break;
        __builtin_amdgcn_s_sleep(1);
        if ((++sp & 255u) == 0u) { if (xb_ld(&bar[XB_TMO])) break; if (sp > XB_SPIN_CAP) { atomicAdd(&bar[XB_TMO], 1u); break; } }
    }
    nloc = mine > 0u ? mine : 1u; nx = cnt > 0u ? cnt : 1u;
}

__device__ __forceinline__ void xcd_barrier(const XcdBarrier& b, bool leader) {
    asm volatile("s_waitcnt vmcnt(0)" ::: "memory");
    __syncthreads();
    if (leader) {
        unsigned* bar = b.bar;
        __builtin_amdgcn_s_waitcnt(0);
        unsigned nloc = b.st[0], nx = b.st[1];
        if (nloc == 0u) { xcd_barrier_complete(bar, b.x, nloc, nx); b.st[0] = nloc; b.st[1] = nx; }
        const unsigned old = xb_add(&bar[XB_XSUB(b.x)], 1u);
        const unsigned gen = old / nloc;
        if (old + 1u == (gen + 1u) * nloc) {
            __builtin_amdgcn_fence(__ATOMIC_RELEASE, "agent");
            asm volatile("s_waitcnt vmcnt(0)" ::: "memory");
            const unsigned og = xb_add(&bar[XB_TOP], 1u);
            const unsigned tg = og / nx;
            if (og + 1u == (tg + 1u) * nx) xb_add(&bar[XB_TOPGEN], 1u);
            else XB_SPIN(xb_ld(&bar[XB_TOPGEN]) == tg, bar);
            __builtin_amdgcn_fence(__ATOMIC_ACQUIRE, "agent");
            xb_add(&bar[XB_XGEN(b.x)], 1u);
            asm volatile("s_waitcnt vmcnt(0)" ::: "memory");
        } else {
            XB_SPIN(xb_ld(&bar[XB_XGEN(b.x)]) == gen, bar);
            __builtin_amdgcn_fence(__ATOMIC_ACQUIRE, "agent");
            asm volatile("s_waitcnt vmcnt(0)" ::: "memory");
        }
    }
    __syncthreads();
}

struct Args { const float* in[32]; float* out; unsigned char* ws; int ph_lo, ph_hi; };
struct Ids { int tid, lane, wave, gw, ngw, z; };

__device__ __forceinline__ int cond_of(int m) { return m < NPR ? 4 : ((m - NPR) >> 11); }
__device__ __forceinline__ const float* mod_ptr_(const Args& a, const Ids& id, int cond, int layer) { return (const float*)(a.ws + id.z + WS_MOD) + (size_t)(cond * 4 + layer) * 6144; }

__device__ __forceinline__ void tr_item(const float* W, int ldw, int col0, const float* scale, bf16* WT, int ldt, int drow0, int dcol0, LAS float* scr, int kb, int nb, int lane, int dnb = -1) {
    const int k0 = 64 * kb, n0 = 32 * nb, dn0 = 32 * (dnb < 0 ? nb : dnb);
#pragma unroll 8
    for (int i = 0; i < 32; ++i) { const int kk = 2 * i + (lane >> 5); float v = W[(size_t)(k0 + kk) * ldw + col0 + n0 + (lane & 31)]; if (scale) v *= scale[k0 + kk]; scr[kk * 33 + (lane & 31)] = v; }
    LDS_WAIT(); asm volatile("" ::: "memory");
    const int c = lane & 7;
#pragma unroll
    for (int j = 0; j < 4; ++j) { const int n = (lane >> 3) + 8 * j; const LAS float* s = scr + (8 * c) * 33 + n;
        v4u o; o.x = pk2(s[0 * 33], s[1 * 33]); o.y = pk2(s[2 * 33], s[3 * 33]); o.z = pk2(s[4 * 33], s[5 * 33]); o.w = pk2(s[6 * 33], s[7 * 33]);
        *(v4u*)(WT + (size_t)(drow0 + dn0 + n) * ldt + dcol0 + k0 + 8 * c) = o; }
    LDS_WAIT(); asm volatile("" ::: "memory");
}
__device__ __forceinline__ bool tr_matrix(int& r, const float* W, int K, int N, bf16* WT, LAS float* scr, int lane) {
    const int nblk = N / 32, items = (K / 64) * nblk;
    if (r < items) { tr_item(W, N, 0, nullptr, WT, K, 0, 0, scr, r / nblk, r % nblk, lane); return true; }
    r -= items; return false;
}
__device__ __forceinline__ bool tr_rwproj(int& r, const float* W, int ncols, const float* mu, bf16* BT1, int drow0, LAS float* scr, int lane) {
    const int nblk = ncols / 32, items = 16 * nblk * 2;
    if (r < items) { const int half = r / (16 * nblk), q = r % (16 * nblk); tr_item(W, ncols, 0, half ? mu : nullptr, BT1, KRKV, drow0, half * 1024, scr, q / nblk, q % nblk, lane); return true; }
    r -= items; return false;
}
__device__ __forceinline__ void conv_weights(const Args& a, const Ids& id, LAS unsigned char* lds, int layer) {
    LAS float* scr = (LAS float*)(lds + id.wave * 16384);
    const int j = layer >> 1;
    bf16* W1T = (bf16*)(a.ws + id.z + W_W1T); bf16* W2T = (bf16*)(a.ws + id.z + W_W2T);
    const float* mw1 = a.in[30 + id.z] + (size_t)layer * D * FF; const float* mw2 = a.in[31 + id.z] + (size_t)layer * D * FF;
    if ((layer & 1) == 0) {
        bf16* WINT = (bf16*)(a.ws + id.z + W_WINT); bf16* WOUTT = (bf16*)(a.ws + id.z + W_WOUTT);
        const float* win = a.in[12 + id.z] + (size_t)j * D * NQKV; const float* wout = a.in[13 + id.z] + (size_t)j * D * D;
        const int total = 2048 + 2048 + 1152 + 512;
        for (int it = id.gw; it < total; it += id.ngw) {
            int r = it;
            if (tr_matrix(r, mw1, D, FF, W1T, scr, id.lane)) continue;
            if (tr_matrix(r, mw2, FF, D, W2T, scr, id.lane)) continue;
            if (r < 1152) {
                const int kb = r / 72, nb = r % 72; tr_item(win, NQKV, 0, nullptr, WINT, D, 0, 0, scr, kb, nb, id.lane, (nb & ~7) + 4 * (nb & 1) + ((nb >> 1) & 3)); continue; }
            r -= 1152;
            tr_matrix(r, wout, D, D, WOUTT, scr, id.lane);
        }
    } else {
        bf16* BTR = (bf16*)(a.ws + id.z + W_BTR); bf16* BT1 = (bf16*)(a.ws + id.z + W_BTL); bf16* WOT = (bf16*)(a.ws + id.z + W_WOT);
        const float* mu = a.in[17 + id.z] + (size_t)j * 6 * D;
        const float* wrkv = a.in[18 + id.z] + (size_t)j * 3 * D * D;
        const float* w1 = a.in[21 + id.z] + (size_t)j * 2 * D * 64; const float* a1 = a.in[24 + id.z] + (size_t)j * 2 * D * 64; const float* g1 = a.in[26 + id.z] + (size_t)j * D * 128;
        const float* wo = a.in[19 + id.z] + (size_t)j * D * D;
        bf16* BT2 = (bf16*)(a.ws + id.z + W_BT2); const float* w2 = a.in[22 + id.z] + (size_t)j * 2 * 64 * D; const float* a2 = a.in[25 + id.z] + (size_t)j * 2 * 64 * D; const float* g2 = a.in[27 + id.z] + (size_t)j * 128 * D;
        const int total = 2048 + 2048 + 1536 + 256 + 128 + 512 + 128 + 4 * 32 + 64 + 5120;
        for (int it = id.gw; it < total; it += id.ngw) {
            int r = it;
            if (tr_matrix(r, mw1, D, FF, W1T, scr, id.lane)) continue;
            if (tr_matrix(r, mw2, FF, D, W2T, scr, id.lane)) continue;
            if (tr_matrix(r, wrkv, D, D, BTR, scr, id.lane)) continue;
            if (tr_matrix(r, wrkv + (size_t)D * D, D, D, BTR + (size_t)D * D, scr, id.lane)) continue;
            if (tr_matrix(r, wrkv + (size_t)2 * D * D, D, D, BTR + (size_t)2 * D * D, scr, id.lane)) continue;
            if (tr_rwproj(r, w1, 64, mu + 1 * D, BT1, 0, scr, id.lane)) continue;
            if (tr_rwproj(r, w1 + (size_t)D * 64, 64, mu + 1 * D, BT1, 64, scr, id.lane)) continue;
            if (tr_rwproj(r, a1, 64, mu + 4 * D, BT1, 128, scr, id.lane)) continue;
            if (tr_rwproj(r, a1 + (size_t)D * 64, 64, mu + 4 * D, BT1, 192, scr, id.lane)) continue;
            if (tr_rwproj(r, g1, 128, mu + 5 * D, BT1, 256, scr, id.lane)) continue;
            if (tr_matrix(r, wo, D, D, WOT, scr, id.lane)) continue;
            if (r < 128) {
                v4u z = (v4u){0u, 0u, 0u, 0u}; v4u* p = (v4u*)(BT1 + (size_t)(384 + r) * KRKV);
#pragma unroll
                for (int q = 0; q < 4; ++q) p[id.lane + 64 * q] = z;
                continue; }
            r -= 128;
            if (r < 128) { const int i = r >> 5, q = r & 31; const float* W = (i < 2 ? a2 : w2) + (size_t)(i & 1) * 64 * D; tr_item(W, D, 0, nullptr, BT2, 384, 1024 * i, 64 * (i ^ 2), scr, 0, q, id.lane); continue; }
            r -= 128;
            if (r < 64) { tr_item(g2, D, 0, nullptr, BT2, 384, 4096, 256, scr, r >> 5, r & 31, id.lane); continue; }
            r -= 64;
            { const int blk = r >> 10; const int c0 = (blk < 4) ? 8 * (blk ^ 2) : 32, c1 = (blk < 4) ? 8 * (blk ^ 2) + 8 : 48;
              if (id.lane < 48 && (id.lane < c0 || id.lane >= c1)) *(v4u*)(BT2 + (size_t)r * 384 + 8 * id.lane) = (v4u){0u, 0u, 0u, 0u}; }
        }
    }
}

struct RowV { f32x4 v[4]; };
__device__ __forceinline__ void ld_row(RowV& r, const float* p, int lane) {
#pragma unroll
    for (int j = 0; j < 4; ++j) r.v[j] = ((const f32x4*)p)[lane + 64 * j];
}
__device__ __forceinline__ void ld_row_bf16(RowV& r, const bf16* p, int lane) {
#pragma unroll
    for (int j = 0; j < 4; ++j) { const v2u w = ((const v2u*)p)[lane + 64 * j]; r.v[j] = (f32x4){bflo(w.x), bfhi(w.x), bflo(w.y), bfhi(w.y)}; }
}
__device__ __forceinline__ void st_row(const RowV& r, float* p, int lane) {
#pragma unroll
    for (int j = 0; j < 4; ++j) ((f32x4*)p)[lane + 64 * j] = r.v[j];
}
__device__ __forceinline__ void st_row_bf16(const RowV& r, bf16* p, int lane) {
#pragma unroll
    for (int j = 0; j < 4; ++j) { v2u w; w.x = pk2(r.v[j][0], r.v[j][1]); w.y = pk2(r.v[j][2], r.v[j][3]); ((v2u*)p)[lane + 64 * j] = w; }
}
__device__ __forceinline__ float row_rinv(const RowV& r) {
    float s = 0.f;
#pragma unroll
    for (int j = 0; j < 4; ++j) s += (r.v[j][0] * r.v[j][0] + r.v[j][1] * r.v[j][1]) + (r.v[j][2] * r.v[j][2] + r.v[j][3] * r.v[j][3]);
    s = wave_sum(s);
    return 1.0f / sqrtf(s * (1.0f / 1024.0f) + 1e-6f);
}
__device__ __forceinline__ void norm_mod(RowV& h, const RowV& x, const float* g, const float* sc, const float* sh, int lane) {
    const float ri = row_rinv(x);
#pragma unroll
    for (int j = 0; j < 4; ++j) { const f32x4 gv = ((const f32x4*)g)[lane + 64 * j], scv = ((const f32x4*)sc)[lane + 64 * j], shv = ((const f32x4*)sh)[lane + 64 * j];
        h.v[j] = (x.v[j] * ri) * gv * (scv + 1.0f) + shv; }
}
__device__ __forceinline__ void resid_add(RowV& x, const RowV& m, const float* g, const float* gt, int lane) {
    const float ri = row_rinv(m);
#pragma unroll
    for (int j = 0; j < 4; ++j) { const f32x4 gv = ((const f32x4*)g)[lane + 64 * j], gtv = ((const f32x4*)gt)[lane + 64 * j];
        x.v[j] = x.v[j] + gtv * ((m.v[j] * ri) * gv); }
}

__device__ __forceinline__ float rope_inv(int jj) {
    const float t[16] = {1.0f, 0.5623413324356079f, 0.3162277638912201f, 0.17782793939113617f, 0.10000000149011612f, 0.05623412877321243f, 0.03162277862429619f, 0.017782794311642647f,
                         0.009999999776482582f, 0.005623413249850273f, 0.003162277862429619f, 0.0017782794311642647f, 0.0010000000474974513f, 0.000562341301701963f, 0.0003162277862429619f, 0.00017782794020604342f};
    float r = t[0];
#pragma unroll
    for (int i = 1; i < 16; ++i) r = (jj == i) ? t[i] : r;
    return r;
}
__device__ __forceinline__ void ph_prologue(const Args& a, const Ids& id, LAS unsigned char* lds) {
    float* MOD = (float*)(a.ws + id.z + WS_MOD);
    { LAS float* red = (LAS float*)lds;
      for (int it = blockIdx.x; it < 4 * 96; it += gridDim.x) {
        const int i = it / 96, n = (it % 96) * 64 + id.lane;
        float acc[5];
#pragma unroll
        for (int c = 0; c < 5; ++c) acc[c] = 0.f;
        const float* W = a.in[9 + id.z] + (size_t)i * 1024 * 6144 + n;
#pragma unroll 1
        for (int k0 = 128 * id.wave; k0 < 128 * id.wave + 128; k0 += 64) {
            float sv[5];
#pragma unroll
            for (int c = 0; c < 5; ++c) { const float x = (c < 4) ? a.in[2 + id.z][c * 1024 + k0 + id.lane] : a.in[8 + id.z][k0 + id.lane]; sv[c] = x / (1.0f + __expf(-x)); }
#pragma unroll 16
            for (int kk = 0; kk < 64; ++kk) { const float w = W[(size_t)(k0 + kk) * 6144];
#pragma unroll
                for (int c = 0; c < 5; ++c) acc[c] += w * __shfl(sv[c], kk); }
        }
#pragma unroll
        for (int c = 0; c < 5; ++c) red[(id.wave * 5 + c) * 64 + id.lane] = acc[c];
        __syncthreads();
        if (id.wave < 5) { float s = a.in[10 + id.z][i * 6144 + n];
#pragma unroll
            for (int w8 = 0; w8 < 8; ++w8) s += red[(w8 * 5 + id.wave) * 64 + id.lane];
            MOD[(size_t)(id.wave * 4 + i) * 6144 + n] = s; }
        __syncthreads();
      } }
    { float* RC = (float*)(a.ws + id.z + WS_ROPE); float* RS = RC + 2048 * 64;
      for (int e = id.gw * 64 + id.lane; e < 2048 * 64; e += id.ngw * 64) { const int t = e >> 6, d = e & 63; const int pos = (d < 32) ? (t >> 6) : (t & 63);
          const float ang = (float)pos * rope_inv(d & 15); RC[e] = __cosf(ang); RS[e] = __sinf(ang); } }
    conv_weights(a, id, lds, 0);
}

struct RawBf { v2u v[4]; };
__device__ __forceinline__ void ld_raw_bf(RawBf& r, const bf16* p, int lane) {
#pragma unroll
    for (int j = 0; j < 4; ++j) r.v[j] = ((const v2u*)p)[lane + 64 * j];
}
__device__ __forceinline__ void cvt_raw_bf(RowV& o, const RawBf& r) {
#pragma unroll
    for (int j = 0; j < 4; ++j) o.v[j] = (f32x4){bflo(r.v[j].x), bfhi(r.v[j].x), bflo(r.v[j].y), bfhi(r.v[j].y)};
}
__device__ __forceinline__ const float* x_row_ptr(const Args& a, const Ids& id, int layer, int m) {
    return (layer == 0) ? ((m < NPR) ? a.in[0 + id.z] + (size_t)m * D : a.in[1 + id.z] + (size_t)(m - NPR) * D) : a.out + id.z + O_X + (size_t)m * D;
}
__device__ __forceinline__ void ph_norm0(const Args& a, const Ids& id) {
    bf16* H = (bf16*)(a.ws + id.z + A_H); const float* g0 = a.in[11 + id.z] + (size_t)(0 * 4 + 0) * D;
    int m = id.gw; RowV xn; if (m < NTOK) ld_row(xn, x_row_ptr(a, id, 0, m), id.lane);
    for (; m < NTOK; m += id.ngw) { RowV x = xn, h; if (m + id.ngw < NTOK) ld_row(xn, x_row_ptr(a, id, 0, m + id.ngw), id.lane);
        const float* md = mod_ptr_(a, id, cond_of(m), 0);
        norm_mod(h, x, g0, md + 1024, md + 0, id.lane); st_row_bf16(h, H + (size_t)m * D, id.lane); }
}
__device__ __forceinline__ void ph_resid_norm(const Args& a, const Ids& id, int layer, bool dummy = false) {
    bf16* H = (bf16*)(a.ws + id.z + (dummy ? AR + 224 * MiB : A_H)); float* xout = dummy ? (float*)(a.ws + id.z + A_F) : a.out + id.z + O_X; const bf16* M = (const bf16*)(a.ws + id.z + A_M); const float* g1 = a.in[11 + id.z] + (size_t)(layer * 4 + 1) * D; const float* g2 = a.in[11 + id.z] + (size_t)(layer * 4 + 2) * D;
    int m = id.gw; RowV xn; RawBf mn; if (m < NTOK) { ld_row(xn, x_row_ptr(a, id, layer, m), id.lane); ld_raw_bf(mn, M + (size_t)m * D, id.lane); }
    for (; m < NTOK; m += id.ngw) { RowV x = xn, mm, h; cvt_raw_bf(mm, mn);
        if (m + id.ngw < NTOK) { ld_row(xn, x_row_ptr(a, id, layer, m + id.ngw), id.lane); ld_raw_bf(mn, M + (size_t)(m + id.ngw) * D, id.lane); }
        const float* md = mod_ptr_(a, id, cond_of(m), layer);
        resid_add(x, mm, g1, md + 2048, id.lane); st_row(x, xout + (size_t)m * D, id.lane);
        norm_mod(h, x, g2, md + 4096, md + 3072, id.lane); st_row_bf16(h, H + (size_t)m * D, id.lane); }
}
__device__ __forceinline__ void ph_resid_end(const Args& a, const Ids& id, LAS unsigned char* lds, int layer, bool dummy = false) {
    bf16* H = (bf16*)(a.ws + id.z + (dummy ? AR + 96 * MiB : A_H)); float* xout = dummy ? (float*)(a.ws + id.z + AR + 32 * MiB) : a.out + id.z + O_X; const bf16* F = (const bf16*)(a.ws + id.z + A_F); const float* g3 = a.in[11 + id.z] + (size_t)(layer * 4 + 3) * D;
    const bool next_attn = (layer + 1 < DEPTH) && (((layer + 1) & 1) == 0);
    const float* g0n = a.in[11 + id.z] + (size_t)((layer + 1) * 4 + 0) * D;
    int m = id.gw; RowV xn; RawBf fn; if (m < NTOK) { ld_row(xn, a.out + id.z + O_X + (size_t)m * D, id.lane); ld_raw_bf(fn, F + (size_t)m * D, id.lane); }
    for (; m < NTOK; m += id.ngw) { RowV x = xn, ff; cvt_raw_bf(ff, fn);
        if (m + id.ngw < NTOK) { ld_row(xn, a.out + id.z + O_X + (size_t)(m + id.ngw) * D, id.lane); ld_raw_bf(fn, F + (size_t)(m + id.ngw) * D, id.lane); }
        const float* md = mod_ptr_(a, id, cond_of(m), layer);
        resid_add(x, ff, g3, md + 5120, id.lane); st_row(x, xout + (size_t)m * D, id.lane);
        if (next_attn) { RowV h; const float* mdn = mod_ptr_(a, id, cond_of(m), layer + 1); norm_mod(h, x, g0n, mdn + 1024, mdn + 0, id.lane); st_row_bf16(h, H + (size_t)m * D, id.lane); } }
    if (layer + 1 < DEPTH) conv_weights(a, id, lds, layer + 1);
}
__device__ __forceinline__ void ph_rw_mix(const Args& a, const Ids& id, int layer) {
    bf16* A2 = (bf16*)(a.ws + id.z + A_A2); bf16* XS = (bf16*)(a.ws + id.z + A_XS); const float* g0 = a.in[11 + id.z] + (size_t)(layer * 4 + 0) * D; const float* mu6 = a.in[17 + id.z] + (size_t)(layer >> 1) * 6 * D;
    for (int g8 = id.gw; g8 < NTOK / 8; g8 += id.ngw) {
        const int m0 = g8 * 8; const int t0 = (m0 < NPR) ? (m0 & (TP - 1)) : ((m0 - NPR) & (TS - 1)); const int T = (m0 < NPR) ? TP : TS;
        const float* md = mod_ptr_(a, id, cond_of(m0), layer); const float* xp = a.out + id.z + O_X + (size_t)m0 * D;
        RowV hp, hc, hn, xr;
#pragma unroll
        for (int q = 0; q < 4; ++q) hp.v[q] = (f32x4){0.f, 0.f, 0.f, 0.f};
        if (t0 > 0) { ld_row(xr, xp - D, id.lane); norm_mod(hp, xr, g0, md + 1024, md + 0, id.lane); }
        ld_row(xr, xp, id.lane); norm_mod(hc, xr, g0, md + 1024, md + 0, id.lane);
#pragma unroll 1
        for (int i = 0; i < 8; ++i) {
#pragma unroll
            for (int q = 0; q < 4; ++q) hn.v[q] = (f32x4){0.f, 0.f, 0.f, 0.f};
            if (t0 + i + 1 < T) { ld_row(xr, xp + (size_t)(i + 1) * D, id.lane); norm_mod(hn, xr, g0, md + 1024, md + 0, id.lane); }
            RowV xx;
#pragma unroll
            for (int q = 0; q < 4; ++q) xx.v[q] = (hp.v[q] + hn.v[q]) * 0.5f - hc.v[q];
            st_row_bf16(hc, A2 + (size_t)(m0 + i) * KRKV, id.lane); st_row_bf16(xx, A2 + (size_t)(m0 + i) * KRKV + D, id.lane);
#pragma unroll
            for (int p = 0; p < 3; ++p) { const float* mu = mu6 + (size_t)(p == 0 ? 0 : p + 1) * D; RowV xm;
#pragma unroll
                for (int q = 0; q < 4; ++q) xm.v[q] = hc.v[q] + xx.v[q] * ((const f32x4*)mu)[id.lane + 64 * q];
                st_row_bf16(xm, XS + ((size_t)p * NTOK + m0 + i) * D, id.lane); }
            hp = hc; hc = hn;
        }
    }
}

__device__ __forceinline__ void row16_sum4(float& a, float& b, float& c, float& d) {
    asm("s_nop 1\n\t"
        "v_add_f32_dpp %0, %0, %0 row_ror:8 row_mask:0xf bank_mask:0xf\n\tv_add_f32_dpp %1, %1, %1 row_ror:8 row_mask:0xf bank_mask:0xf\n\tv_add_f32_dpp %2, %2, %2 row_ror:8 row_mask:0xf bank_mask:0xf\n\tv_add_f32_dpp %3, %3, %3 row_ror:8 row_mask:0xf bank_mask:0xf\n\t"
        "v_add_f32_dpp %0, %0, %0 row_ror:4 row_mask:0xf bank_mask:0xf\n\tv_add_f32_dpp %1, %1, %1 row_ror:4 row_mask:0xf bank_mask:0xf\n\tv_add_f32_dpp %2, %2, %2 row_ror:4 row_mask:0xf bank_mask:0xf\n\tv_add_f32_dpp %3, %3, %3 row_ror:4 row_mask:0xf bank_mask:0xf\n\t"
        "v_add_f32_dpp %0, %0, %0 row_ror:2 row_mask:0xf bank_mask:0xf\n\tv_add_f32_dpp %1, %1, %1 row_ror:2 row_mask:0xf bank_mask:0xf\n\tv_add_f32_dpp %2, %2, %2 row_ror:2 row_mask:0xf bank_mask:0xf\n\tv_add_f32_dpp %3, %3, %3 row_ror:2 row_mask:0xf bank_mask:0xf\n\t"
        "v_add_f32_dpp %0, %0, %0 row_ror:1 row_mask:0xf bank_mask:0xf\n\tv_add_f32_dpp %1, %1, %1 row_ror:1 row_mask:0xf bank_mask:0xf\n\tv_add_f32_dpp %2, %2, %2 row_ror:1 row_mask:0xf bank_mask:0xf\n\tv_add_f32_dpp %3, %3, %3 row_ror:1 row_mask:0xf bank_mask:0xf"
        : "+v"(a), "+v"(b), "+v"(c), "+v"(d));
}
__device__ __forceinline__ f32x4 ld_bf4(const bf16* p) { const v2u w = *(const v2u*)p; return (f32x4){bflo(w.x), bfhi(w.x), bflo(w.y), bfhi(w.y)}; }
__device__ __forceinline__ void ph_att_cache(const Args& a, const Ids& id, int layer) {
    const int j = layer >> 1, lane = id.lane;
    bf16 *KAS = (bf16*)(a.ws + id.z + A_KAS), *VAS = (bf16*)(a.ws + id.z + A_VAS), *KBS = (bf16*)(a.ws + id.z + A_KBS), *VBS = (bf16*)(a.ws + id.z + A_VBS);
    for (int r = id.gw; r < 4 * PAST; r += id.ngw) {
        const int b = r >> 9, pos = r & (PAST - 1);
        const size_t src = (size_t)((b * 2 + j) * PAST + pos), dst = (size_t)(b * SKV + pos);
#pragma unroll
        for (int q = 0; q < 2; ++q) { const int e = lane + 64 * q; KAS[dst * 128 + e] = (bf16)f2bf(a.in[3 + id.z][src * 128 + e]); VAS[dst * 128 + e] = (bf16)f2bf(a.in[4 + id.z][src * 128 + e]); }
#pragma unroll
        for (int q = 0; q < 8; ++q) { const int e = lane + 64 * q; KBS[dst * 512 + e] = (bf16)f2bf(a.in[5 + id.z][src * 512 + e]); VBS[dst * 512 + e] = (bf16)f2bf(a.in[6 + id.z][src * 512 + e]); }
    }
}

typedef short bf16x8_t __attribute__((ext_vector_type(8)));
typedef float f32x16 __attribute__((ext_vector_type(16)));
typedef short v4i16_t __attribute__((ext_vector_type(4)));
constexpr float AT_THR = 8.0f;
constexpr int AT_KP = 144, AT_KBUF = 64 * AT_KP, AT_VOFF = 2 * AT_KBUF, AT_VBUFMAX = 64 * 288, AT_WSF = AT_VOFF + 2 * AT_VBUFMAX;
static_assert(AT_WSF + 8 * 128 <= RING_BYTES, "attention LDS");
template <int NDT>
__device__ __forceinline__ void attn_unit(const bf16* Qrow0, int ldq, const bf16* Kb, int ldk, const bf16* Vb, int ldv, int S, bf16* Obf, bf16* Od, int ldo, LAS unsigned char* lds, const Ids& id) {
    constexpr int VP = (NDT == 2) ? 144 : 288, NVL = NDT / 2;
    const int lane = id.lane, w = id.wave, r32 = lane & 31, hi = lane >> 5, tid = id.tid;
    bf16x8_t qf[4];
    { const bf16* qrow = Qrow0 + (size_t)(32 * w + r32) * ldq;
#pragma unroll
      for (int s = 0; s < 4; ++s) qf[s] = *(const bf16x8_t*)(qrow + 16 * s + 8 * hi); }
    f32x16 o[NDT];
#pragma unroll
    for (int dt = 0; dt < NDT; ++dt)
#pragma unroll
        for (int r = 0; r < 16; ++r) o[dt][r] = 0.f;
    float m_run = 0.f, l_run = 0.f;
    const int NT = S >> 6;
    LAS float* wsf = (LAS float*)(lds + AT_WSF + w * 128);
    const int krow = tid >> 3, kch = tid & 7;
    v4u kreg, vreg[NVL];
#define AT_GLOAD(t) do { kreg = *(const v4u*)(Kb + (size_t)((t) * 64 + krow) * ldk + 8 * kch); \
        if (NDT == 2) vreg[0] = *(const v4u*)(Vb + (size_t)((t) * 64 + krow) * ldv + 8 * kch); \
        else { _Pragma("unroll") for (int i_ = 0; i_ < NVL; ++i_) { const int ix_ = tid + 512 * i_; vreg[i_] = *(const v4u*)(Vb + (size_t)((t) * 64 + (ix_ >> 4)) * ldv + 8 * (ix_ & 15)); } } } while (0)
#define AT_LSTORE(b) do { *(LAS v4u*)(lds + (b) * AT_KBUF + krow * AT_KP + 16 * kch) = kreg; \
        if (NDT == 2) *(LAS v4u*)(lds + AT_VOFF + (b) * AT_VBUFMAX + krow * VP + 16 * kch) = vreg[0]; \
        else { _Pragma("unroll") for (int i_ = 0; i_ < NVL; ++i_) { const int ix_ = tid + 512 * i_; *(LAS v4u*)(lds + AT_VOFF + (b) * AT_VBUFMAX + (ix_ >> 4) * VP + 16 * (ix_ & 15)) = vreg[i_]; } } } while (0)
    AT_GLOAD(0); AT_LSTORE(0);
    __syncthreads();
    const int vbase = (4 * hi + ((lane & 15) >> 2)) * VP + 32 * ((lane >> 4) & 1) + 8 * (lane & 3);
#pragma unroll 1
    for (int t = 0; t < NT; ++t) {
        const int b = t & 1;
        if (t + 1 < NT) AT_GLOAD(t + 1);
        const LAS unsigned char* Kt = lds + b * AT_KBUF + r32 * AT_KP + 16 * hi;
        const LAS unsigned char* Vt = lds + AT_VOFF + b * AT_VBUFMAX + vbase;
        f32x16 p0, p1;
        { const float nm = -m_run;
#pragma unroll
          for (int r = 0; r < 16; ++r) { p0[r] = nm; p1[r] = nm; } }
#pragma unroll
        for (int s = 0; s < 4; ++s) { const bf16x8_t k0 = *(const LAS bf16x8_t*)(Kt + 32 * s), k1 = *(const LAS bf16x8_t*)(Kt + 32 * AT_KP + 32 * s);
            p0 = __builtin_amdgcn_mfma_f32_32x32x16_bf16(k0, qf[s], p0, 0, 0, 0); p1 = __builtin_amdgcn_mfma_f32_32x32x16_bf16(k1, qf[s], p1, 0, 0, 0); }
        float mx = __builtin_fmaxf(p0[0], p1[0]);
#pragma unroll
        for (int r = 1; r < 16; ++r) mx = __builtin_fmaxf(__builtin_fmaxf(mx, p0[r]), p1[r]);
        mx = fmaxf(mx, __shfl_xor(mx, 32));
        if (t == 0 || __any(mx > AT_THR)) {
            const float dl = (t == 0) ? mx : fmaxf(mx, 0.f), al = __builtin_amdgcn_exp2f(-dl); m_run += dl; l_run *= al;
#pragma unroll
            for (int r = 0; r < 16; ++r) { p0[r] -= dl; p1[r] -= dl; }
            if (hi == 0) wsf[r32] = al;
            LDS_WAIT(); asm volatile("" ::: "memory");
            { f32x4 a4[4];
#pragma unroll
              for (int g4 = 0; g4 < 4; ++g4) a4[g4] = *(const LAS f32x4*)(wsf + 8 * g4 + 4 * hi);
#pragma unroll
              for (int dt = 0; dt < NDT; ++dt)
#pragma unroll
                  for (int r = 0; r < 16; ++r) o[dt][r] *= a4[r >> 2][r & 3]; }
            LDS_WAIT(); asm volatile("" ::: "memory");
        }
        float rs = 0.f;
#pragma unroll
        for (int r = 0; r < 16; ++r) { p0[r] = __builtin_amdgcn_exp2f(p0[r]); p1[r] = __builtin_amdgcn_exp2f(p1[r]); rs += p0[r] + p1[r]; }
        l_run += rs;
        bf16x8_t pf[4];
#pragma unroll
        for (int ks = 0; ks < 4; ++ks) { v4u pw;
#pragma unroll
            for (int dd = 0; dd < 4; ++dd) { const int r = 8 * (ks & 1) + 2 * dd; pw[dd] = (ks < 2) ? pk2(p0[r], p0[r + 1]) : pk2(p1[r], p1[r + 1]); }
            pf[ks] = __builtin_bit_cast(bf16x8_t, pw); }
#pragma unroll
        for (int ks = 0; ks < 4; ++ks)
#pragma unroll
            for (int dt = 0; dt < NDT; ++dt) {
                const v4i16_t lo = __builtin_amdgcn_ds_read_tr16_b64_v4i16((LAS v4i16_t*)(Vt + (16 * ks) * VP + 64 * dt));
                const v4i16_t hh = __builtin_amdgcn_ds_read_tr16_b64_v4i16((LAS v4i16_t*)(Vt + (16 * ks + 8) * VP + 64 * dt));
                const bf16x8_t vf = (bf16x8_t){lo[0], lo[1], lo[2], lo[3], hh[0], hh[1], hh[2], hh[3]};
                o[dt] = __builtin_amdgcn_mfma_f32_32x32x16_bf16(pf[ks], vf, o[dt], 0, 0, 0); }
        if (t + 1 < NT) AT_LSTORE(b ^ 1);
        __syncthreads();
    }
#undef AT_GLOAD
#undef AT_LSTORE
    const float lt = l_run + __shfl_xor(l_run, 32);
    int lane_e = lane; asm volatile("" : "+v"(lane_e));
    const int r32e = lane_e & 31, hie = lane_e >> 5;
    if (hi == 0) wsf[r32] = 1.0f / lt;
    LDS_WAIT(); asm volatile("" ::: "memory");
    f32x4 a4[4];
#pragma unroll
    for (int g4 = 0; g4 < 4; ++g4) a4[g4] = *(const LAS f32x4*)(wsf + 8 * g4 + 4 * hi);
    LDS_WAIT(); asm volatile("" ::: "memory");
#pragma unroll
    for (int dt = 0; dt < NDT; ++dt)
#pragma unroll
        for (int r = 0; r < 16; ++r) { const float val = o[dt][r] * a4[r >> 2][r & 3]; const int off = (32 * w + (r & 3) + 8 * (r >> 2) + 4 * hie) * ldo + 32 * dt + r32e;
            (NDT == 2 ? Obf : Od)[off] = (bf16)f2bf(val); }
}
__device__ __forceinline__ void ph_attn(const Args& a, const Ids& id, LAS unsigned char* lds, int G, int vcu) {
    const bf16 *QA = (const bf16*)(a.ws + id.z + A_QA), *QB = (const bf16*)(a.ws + id.z + A_QB), *KAP = (const bf16*)(a.ws + id.z + A_KAP), *VAP = (const bf16*)(a.ws + id.z + A_VAP), *KBP = (const bf16*)(a.ws + id.z + A_KBP), *VBP = (const bf16*)(a.ws + id.z + A_VBP);
    const bf16 *KAS = (const bf16*)(a.ws + id.z + A_KAS), *VAS = (const bf16*)(a.ws + id.z + A_VAS), *KBS = (const bf16*)(a.ws + id.z + A_KBS), *VBS = (const bf16*)(a.ws + id.z + A_VBS);
    bf16* H = (bf16*)(a.ws + id.z + A_H); bf16* DT = (bf16*)(a.ws + id.z + A_DT);
    for (int s = vcu; s < 256; s += G) {
        const int h8 = s & 7;
#pragma unroll 1
        for (int pass = 0; pass < 2; ++pass) {
            size_t m0, kvrow; int S;
            if (pass == 0) { const int b = s >> 6, qb = (s >> 3) & 7; m0 = (size_t)NPR + b * TS + qb * 256; kvrow = (size_t)b * SKV; S = SKV; }
            else { const int b = s >> 3; m0 = (size_t)b * TP; kvrow = m0; S = TP; }
            const bf16* Ka = (pass == 0 ? KAS : KAP) + kvrow * 128 + (h8 >> 2) * 64; const bf16* Va = (pass == 0 ? VAS : VAP) + kvrow * 128 + (h8 >> 2) * 64;
            const bf16* Kd = (pass == 0 ? KBS : KBP) + kvrow * 512 + h8 * 64; const bf16* Vd = (pass == 0 ? VBS : VBP) + kvrow * 512 + (h8 >> 1) * 128;
            attn_unit<2>(QA + m0 * 512 + h8 * 64, 512, Ka, 128, Va, 128, S, H + m0 * D + h8 * 64, nullptr, D, lds, id);
            attn_unit<4>(QB + m0 * 512 + h8 * 64, 512, Kd, 512, Vd, 512, S, nullptr, DT + m0 * D + h8 * 128, D, lds, id);
        }
    }
}
__device__ __forceinline__ void ph_att_comb(const Args& a, const Ids& id, int layer) {
    const int j = layer >> 1, lane = id.lane; const float lam_init = (layer == 0) ? 0.2f : 0.4707130183435842f;
    const float* lf = a.in[15 + id.z] + j * 256; const float* sg = a.in[16 + id.z] + j * 128;
    const float s01 = wave_sum(lf[lane] * lf[64 + lane]), s23 = wave_sum(lf[128 + lane] * lf[192 + lane]);
    const float lam = expf(s01) - expf(s23) + lam_init;
    const bf16* DT = (const bf16*)(a.ws + id.z + A_DT); bf16* H = (bf16*)(a.ws + id.z + A_H);
    const f32x4 gg = *(const f32x4*)(sg + 4 * (lane & 31)) * (1.0f - lam_init);
    for (int m = id.gw; m < NTOK; m += id.ngw) {
        f32x4 v[4];
#pragma unroll
        for (int hd = 0; hd < 4; ++hd) v[hd] = ld_bf4(DT + (size_t)m * D + 256 * hd + 4 * lane);
        float ss[4];
#pragma unroll
        for (int hd = 0; hd < 4; ++hd) { f32x4 o; o[0] = __shfl_xor(v[hd][0], 32); o[1] = __shfl_xor(v[hd][1], 32); o[2] = __shfl_xor(v[hd][2], 32); o[3] = __shfl_xor(v[hd][3], 32);
            v[hd] = v[hd] - o * lam;
            ss[hd] = (lane < 32) ? (v[hd][0] * v[hd][0] + v[hd][1] * v[hd][1]) + (v[hd][2] * v[hd][2] + v[hd][3] * v[hd][3]) : 0.f; }
        row16_sum4(ss[0], ss[1], ss[2], ss[3]);
#pragma unroll
        for (int hd = 0; hd < 4; ++hd) { const float tot = ss[hd] + __shfl_xor(ss[hd], 16); const float ri = 1.0f / sqrtf(tot * (1.0f / 128.0f) + 1e-6f); const f32x4 o = v[hd] * ri * gg;
            if (lane < 32) *(v2u*)(H + (size_t)m * D + 512 + hd * 128 + 4 * lane) = (v2u){pk2(o[0], o[1]), pk2(o[2], o[3])}; }
    }
}

__device__ __forceinline__ void ph_rw_prep(const Args& a, const Ids& id, int layer) {
    const int j = layer >> 1, lane = id.lane;
    const bf16* RKV = (const bf16*)(a.ws + id.z + A_RKV); float* INV = (float*)(a.ws + id.z + WS_INV);
    const float* kk_c = a.in[28 + id.z] + (size_t)(j * 3 + 0) * D;
    for (int m = id.gw; m < NTOK; m += id.ngw) {
#pragma unroll 4
        for (int h = 0; h < 16; ++h) { const float kv = bf2f(RKV[(size_t)m * 3072 + 1024 + h * 64 + lane]) * kk_c[h * 64 + lane]; const float ss = wave_sum(kv * kv); if (lane == 0) INV[m * 16 + h] = 1.0f / sqrtf(ss + 1e-12f); }
    }
}

constexpr int SC_TC = 16, SC_ROWF = 352;
constexpr int SC_OPF = SC_TC * SC_ROWF;
constexpr int SC_YOFF = 4 * SC_OPF;
static_assert((SC_YOFF + 4 * SC_TC * 32) * 4 <= RING_BYTES, "scan LDS");
struct ScDesc { int mbase, T, h, dir, half, b; };
__device__ __forceinline__ void sc_desc(ScDesc& d, int slot, int grp, int c) {
    if (grp == 0) { const int cs = slot >> 1; d.b = cs >> 5; d.h = (cs >> 1) & 15; d.dir = cs & 1; d.half = slot & 1; d.T = TS; d.mbase = NPR + d.b * TS; }
    else { const int pu = slot * 8 + (c >> 4), cp = pu >> 1; d.b = cp >> 5; d.h = (cp >> 1) & 15; d.dir = cp & 1; d.half = pu & 1; d.T = TP; d.mbase = d.b * TP; }
}
__device__ __forceinline__ int sc_tok(const ScDesc& d, int grp, int c, int i) { const int s = (grp == 0 ? c : (c & 15)) * SC_TC + i; return d.mbase + (d.dir ? d.T - 1 - s : s); }
__device__ __forceinline__ float fma_s(float a, float b, float c) { float r; asm("v_fma_f32 %0, %1, %2, %3" : "=v"(r) : "v"(a), "v"(b), "v"(c)); return r; }
__device__ __forceinline__ float fnma_s(float a, float b, float c) { float r; asm("v_fma_f32 %0, -%1, %2, %3" : "=v"(r) : "v"(a), "v"(b), "v"(c)); return r; }
__device__ __forceinline__ float mul_s(float a, float b) { float r; asm("v_mul_f32_e32 %0, %1, %2" : "=v"(r) : "v"(a), "v"(b)); return r; }
__device__ __forceinline__ float add_s(float a, float b) { float r; asm("v_add_f32_e32 %0, %1, %2" : "=v"(r) : "v"(a), "v"(b)); return r; }
__device__ __forceinline__ void oct_sum4(float& a, float& b, float& c, float& d) {
    asm("s_nop 1\n\t"
        "v_add_f32_dpp %0, %0, %0 quad_perm:[1,0,3,2] row_mask:0xf bank_mask:0xf\n\tv_add_f32_dpp %1, %1, %1 quad_perm:[1,0,3,2] row_mask:0xf bank_mask:0xf\n\tv_add_f32_dpp %2, %2, %2 quad_perm:[1,0,3,2] row_mask:0xf bank_mask:0xf\n\tv_add_f32_dpp %3, %3, %3 quad_perm:[1,0,3,2] row_mask:0xf bank_mask:0xf\n\t"
        "v_add_f32_dpp %0, %0, %0 quad_perm:[2,3,0,1] row_mask:0xf bank_mask:0xf\n\tv_add_f32_dpp %1, %1, %1 quad_perm:[2,3,0,1] row_mask:0xf bank_mask:0xf\n\tv_add_f32_dpp %2, %2, %2 quad_perm:[2,3,0,1] row_mask:0xf bank_mask:0xf\n\tv_add_f32_dpp %3, %3, %3 quad_perm:[2,3,0,1] row_mask:0xf bank_mask:0xf\n\t"
        "v_add_f32_dpp %0, %0, %0 row_half_mirror row_mask:0xf bank_mask:0xf\n\tv_add_f32_dpp %1, %1, %1 row_half_mirror row_mask:0xf bank_mask:0xf\n\tv_add_f32_dpp %2, %2, %2 row_half_mirror row_mask:0xf bank_mask:0xf\n\tv_add_f32_dpp %3, %3, %3 row_half_mirror row_mask:0xf bank_mask:0xf"
        : "+v"(a), "+v"(b), "+v"(c), "+v"(d));
}
typedef float f32x2 __attribute__((ext_vector_type(2)));
struct ScOps { f32x2 w[4], kd[4], kk[4], ka[4], r[4]; float va, vb; };
__device__ __forceinline__ void sc_ldops(ScOps& o, const LAS float* p, int kg, int ra) {
#pragma unroll
    for (int hq = 0; hq < 2; ++hq) { const f32x4 a0 = *(const LAS f32x4*)(p + 8 * kg + 4 * hq), a1 = *(const LAS f32x4*)(p + 64 + 8 * kg + 4 * hq), a2 = *(const LAS f32x4*)(p + 128 + 8 * kg + 4 * hq),
                                                 a3 = *(const LAS f32x4*)(p + 192 + 8 * kg + 4 * hq), a4 = *(const LAS f32x4*)(p + 256 + 8 * kg + 4 * hq);
        o.w[2 * hq] = __builtin_shufflevector(a0, a0, 0, 1); o.w[2 * hq + 1] = __builtin_shufflevector(a0, a0, 2, 3); o.kd[2 * hq] = __builtin_shufflevector(a1, a1, 0, 1); o.kd[2 * hq + 1] = __builtin_shufflevector(a1, a1, 2, 3);
        o.kk[2 * hq] = __builtin_shufflevector(a2, a2, 0, 1); o.kk[2 * hq + 1] = __builtin_shufflevector(a2, a2, 2, 3); o.ka[2 * hq] = __builtin_shufflevector(a3, a3, 0, 1); o.ka[2 * hq + 1] = __builtin_shufflevector(a3, a3, 2, 3);
        o.r[2 * hq] = __builtin_shufflevector(a4, a4, 0, 1); o.r[2 * hq + 1] = __builtin_shufflevector(a4, a4, 2, 3); }
    o.va = p[320 + ra]; o.vb = p[321 + ra];
}
__device__ __forceinline__ float dot8_p(const f32x2 (&S)[4], const f32x2 (&x)[4]) {
    f32x2 d = S[0] * x[0]; d = __builtin_elementwise_fma(S[1], x[1], d); d = __builtin_elementwise_fma(S[2], x[2], d); d = __builtin_elementwise_fma(S[3], x[3], d);
    return d[0] + d[1];
}
struct ScRaw { unsigned r[4], k[4], a[4], e[4], v[4]; float iv[4]; };
__device__ __forceinline__ void sc_load(ScRaw& R, const Args& a, const Ids& id, int hw, int slot, int c) {
    const int grp = hw >> 1, lane = id.lane, kp = lane & 31, hs = lane >> 5; ScDesc d; sc_desc(d, slot, grp, c);
    const int s0 = (grp == 0 ? c : (c & 15)) * SC_TC + (hw & 1) * 8 + hs; const int m0 = d.mbase + (d.dir ? d.T - 1 - s0 : s0); const long mstep = d.dir ? -2 : 2;
    const bf16* pr = (const bf16*)(a.ws + id.z + A_RKV) + (size_t)m0 * 3072 + d.h * 64 + 2 * kp;
    const bf16* pa = (const bf16*)(a.ws + id.z + (d.dir ? A_A1 : A_A0)) + (size_t)m0 * D + d.h * 64 + 2 * kp;
    const bf16* pe = (const bf16*)(a.ws + id.z + (d.dir ? A_EW1 : A_EW0)) + (size_t)m0 * D + d.h * 64 + 2 * kp;
    const bf16* pv = (const bf16*)(a.ws + id.z + A_RKV) + (size_t)m0 * 3072 + 2048 + d.h * 64 + d.half * 32 + 2 * (kp & 15);
    const float* pi = (const float*)(a.ws + id.z + WS_INV) + (size_t)m0 * 16 + d.h;
#pragma unroll
    for (int it = 0; it < 4; ++it) { const long o = mstep * it;
        R.r[it] = *(const unsigned*)(pr + o * 3072); R.k[it] = *(const unsigned*)(pr + o * 3072 + 1024); R.a[it] = *(const unsigned*)(pa + o * D); R.e[it] = *(const unsigned*)(pe + o * D);
        R.v[it] = *(const unsigned*)(pv + o * 3072); R.iv[it] = pi[o * 16]; }
}
__device__ __forceinline__ void sc_derive(const ScRaw& R, const Args& a, const Ids& id, LAS float* L, int layer, int hw, int slot, int c, int buf) {
    const int grp = hw >> 1, lane = id.lane, kp = lane & 31, hs = lane >> 5, j = layer >> 1; ScDesc d; sc_desc(d, slot, grp, c);
    const f32x2 kkc = *(const f32x2*)(a.in[28 + id.z] + (size_t)(j * 3 + 0) * D + d.h * 64 + 2 * kp), kac = *(const f32x2*)(a.in[28 + id.z] + (size_t)(j * 3 + 1) * D + d.h * 64 + 2 * kp);
    LAS float* p0 = L + (buf * 2 + grp) * SC_OPF + ((hw & 1) * 8 + hs) * SC_ROWF + 2 * kp;
#pragma unroll
    for (int it = 0; it < 4; ++it) { LAS float* p = p0 + 2 * it * SC_ROWF;
        const f32x2 k2 = (f32x2){bflo(R.k[it]), bfhi(R.k[it])}, a2 = (f32x2){bflo(R.a[it]), bfhi(R.a[it])};
        const f32x2 kk = k2 * kkc * R.iv[it];
        *(LAS f32x2*)p = (f32x2){__builtin_amdgcn_exp2f(-bflo(R.e[it])), __builtin_amdgcn_exp2f(-bfhi(R.e[it]))};
        *(LAS f32x2*)(p + 64) = k2 * ((a2 - 1.0f) * kac + 1.0f); *(LAS f32x2*)(p + 128) = kk; *(LAS f32x2*)(p + 192) = kk * a2; *(LAS f32x2*)(p + 256) = (f32x2){bflo(R.r[it]), bfhi(R.r[it])};
        if (kp < 16) *(LAS f32x2*)(p + 320 - 2 * kp + 2 * kp) = (f32x2){bflo(R.v[it]), bfhi(R.v[it])}; }
}
__device__ __forceinline__ void sc_flush(const Args& a, const Ids& id, const LAS float* L, int hw, int slot, int c) {
    bf16* Y = (bf16*)(a.ws + id.z + A_Y);
#pragma unroll
    for (int q = 0; q < 2; ++q) { const int idx = hw * 64 + id.lane + 256 * q, fg = idx >> 8, s = (idx >> 4) & 15, rp = idx & 15; ScDesc d; sc_desc(d, slot, fg, c);
        const f32x2 yv = *(const LAS f32x2*)(L + SC_YOFF + ((c & 1) * 2 + fg) * SC_TC * 32 + s * 32 + 2 * rp);
        *(unsigned*)(Y + ((size_t)d.dir * NTOK + sc_tok(d, fg, c, s)) * D + d.h * 64 + d.half * 32 + 2 * rp) = pk2(yv[0], yv[1]); }
}
__device__ __forceinline__ void ph_rw_scan(const Args& a, const Ids& id, LAS unsigned char* lds, int layer, int G, int vcu) {
    const int j = layer >> 1, lane = id.lane, w = id.wave;
    LAS float* L = (LAS float*)lds;
    constexpr int NC = TS / SC_TC;
    for (int slot = vcu; slot < 256; slot += G) {
        if (w >= 4) {
            const int hw = w - 4; ScRaw R;
            sc_load(R, a, id, hw, slot, 0); sc_derive(R, a, id, L, layer, hw, slot, 0, 0);
            __syncthreads();
#pragma unroll 1
            for (int c = 0; c < NC; ++c) {
                if (c + 1 < NC) sc_load(R, a, id, hw, slot, c + 1);
                if (c > 0) sc_flush(a, id, L, hw, slot, c - 1);
                if (c + 1 < NC) sc_derive(R, a, id, L, layer, hw, slot, c + 1, (c & 1) ^ 1);
                __syncthreads();
            }
            sc_flush(a, id, L, hw, slot, NC - 1);
        } else {
            const int grp = w >> 1, kg = lane & 7, ra = 16 * (w & 1) + 2 * (lane >> 3);
            f32x2 Sa[4], Sb[4];
            { ScDesc d; sc_desc(d, slot, 0, 0);
              if (grp == 0) { const float* sp = a.in[7 + id.z] + ((((size_t)(d.b * 2 + j) * 2 + d.dir) * 16 + d.h) * 64 + d.half * 32 + ra) * 64 + 8 * kg;
                  const f32x4 t0 = *(const f32x4*)sp, t1 = *(const f32x4*)(sp + 4), t2 = *(const f32x4*)(sp + 64), t3 = *(const f32x4*)(sp + 68);
                  Sa[0] = (f32x2){t0[0], t0[1]}; Sa[1] = (f32x2){t0[2], t0[3]}; Sa[2] = (f32x2){t1[0], t1[1]}; Sa[3] = (f32x2){t1[2], t1[3]};
                  Sb[0] = (f32x2){t2[0], t2[1]}; Sb[1] = (f32x2){t2[2], t2[3]}; Sb[2] = (f32x2){t3[0], t3[1]}; Sb[3] = (f32x2){t3[2], t3[3]}; }
              else {
#pragma unroll
                  for (int e2 = 0; e2 < 4; ++e2) { Sa[e2] = (f32x2){0.f, 0.f}; Sb[e2] = (f32x2){0.f, 0.f}; } } }
            __syncthreads();
#pragma unroll 1
            for (int c = 0; c < NC; ++c) {
                const int buf = c & 1;
                if (grp == 1 && (c & 15) == 0) {
#pragma unroll
                    for (int e2 = 0; e2 < 4; ++e2) { Sa[e2] = (f32x2){0.f, 0.f}; Sb[e2] = (f32x2){0.f, 0.f}; } }
                const LAS float* ob = L + (buf * 2 + grp) * SC_OPF; LAS float* yb = L + SC_YOFF + (buf * 2 + grp) * SC_TC * 32 + ra;
                {
                    ScOps cur, nxt; sc_ldops(cur, ob, kg, ra);
                    float ypa = 0.f, ypb = 0.f;
#pragma unroll
                    for (int i = 0; i < SC_TC; ++i) {
                        if (i + 1 < SC_TC) sc_ldops(nxt, ob + (i + 1) * SC_ROWF, kg, ra);
                        const f32x2 va2 = (f32x2){cur.va, cur.va}, vb2 = (f32x2){cur.vb, cur.vb};
                        f32x2 ua[4], ub[4];
#pragma unroll
                        for (int e2 = 0; e2 < 4; ++e2) { ua[e2] = __builtin_elementwise_fma(Sa[e2], cur.w[e2], va2 * cur.kd[e2]); ub[e2] = __builtin_elementwise_fma(Sb[e2], cur.w[e2], vb2 * cur.kd[e2]); }
                        float ska = dot8_p(Sa, cur.kk), skb = dot8_p(Sb, cur.kk);
                        oct_sum4(ska, skb, ypa, ypb);
                        if (i > 0 && kg == 0) { yb[(i - 1) * 32] = ypa; yb[(i - 1) * 32 + 1] = ypb; }
                        const f32x2 na2 = (f32x2){-ska, -ska}, nb2 = (f32x2){-skb, -skb};
#pragma unroll
                        for (int e2 = 0; e2 < 4; ++e2) { Sa[e2] = __builtin_elementwise_fma(na2, cur.ka[e2], ua[e2]); Sb[e2] = __builtin_elementwise_fma(nb2, cur.ka[e2], ub[e2]); }
                        ypa = dot8_p(Sa, cur.r); ypb = dot8_p(Sb, cur.r);
                        if (i + 1 < SC_TC) cur = nxt;
                    }
                    float z0 = 0.f, z1 = 0.f; oct_sum4(ypa, ypb, z0, z1);
                    if (kg == 0) { yb[(SC_TC - 1) * 32] = ypa; yb[(SC_TC - 1) * 32 + 1] = ypb; }
                }
                if (grp == 1 && (c & 15) == 15) { ScDesc d; sc_desc(d, slot, 1, c);
                    float* dp = a.out + id.z + O_ST + ((((size_t)(d.b * 2 + j) * 2 + d.dir) * 16 + d.h) * 64 + d.half * 32 + ra) * 64 + 8 * kg;
                    *(f32x4*)dp = (f32x4){Sa[0][0], Sa[0][1], Sa[1][0], Sa[1][1]}; *(f32x4*)(dp + 4) = (f32x4){Sa[2][0], Sa[2][1], Sa[3][0], Sa[3][1]};
                    *(f32x4*)(dp + 64) = (f32x4){Sb[0][0], Sb[0][1], Sb[1][0], Sb[1][1]}; *(f32x4*)(dp + 68) = (f32x4){Sb[2][0], Sb[2][1], Sb[3][0], Sb[3][1]}; }
                __syncthreads();
            }
        }
        __syncthreads();
    }
}
__device__ __forceinline__ void ph_rw_post(const Args& a, const Ids& id, int layer) {
    const int j = layer >> 1, lane = id.lane;
    const bf16* RKV = (const bf16*)(a.ws + id.z + A_RKV); const bf16* Y = (const bf16*)(a.ws + id.z + A_Y);
    const bf16 *A0 = (const bf16*)(a.ws + id.z + A_A0), *A1 = (const bf16*)(a.ws + id.z + A_A1); bf16* H = (bf16*)(a.ws + id.z + A_H);
    const float* kvec = a.in[28 + id.z] + (size_t)j * 3 * D; const float* lnx = a.in[29 + id.z] + (size_t)j * 2 * D;
    f32x4 ka[4], rk[4], l0[4], l1[4];
#pragma unroll
    for (int q = 0; q < 4; ++q) { const int c = 4 * lane + 256 * q; ka[q] = *(const f32x4*)(kvec + D + c); rk[q] = *(const f32x4*)(kvec + 2 * D + c); l0[q] = *(const f32x4*)(lnx + c); l1[q] = *(const f32x4*)(lnx + D + c); }
    for (int m = id.gw; m < NTOK; m += id.ngw) {
        f32x4 y[4], r[4], k[4], v[4], a0[4], a1[4], g[4];
#pragma unroll
        for (int q = 0; q < 4; ++q) { const int c = 4 * lane + 256 * q; y[q] = ld_bf4(Y + (size_t)m * D + c) + ld_bf4(Y + ((size_t)NTOK + m) * D + c);
            r[q] = ld_bf4(RKV + (size_t)m * 3072 + c); k[q] = ld_bf4(RKV + (size_t)m * 3072 + 1024 + c); v[q] = ld_bf4(RKV + (size_t)m * 3072 + 2048 + c);
            a0[q] = ld_bf4(A0 + (size_t)m * D + c); a1[q] = ld_bf4(A1 + (size_t)m * D + c); g[q] = ld_bf4(H + (size_t)m * D + c); }
        float s[4], qv[4], bs[4];
#pragma unroll
        for (int q = 0; q < 4; ++q) s[q] = (y[q][0] + y[q][1]) + (y[q][2] + y[q][3]);
        row16_sum4(s[0], s[1], s[2], s[3]);
#pragma unroll
        for (int q = 0; q < 4; ++q) { const float mean = s[q] * (1.0f / 64.0f); y[q] = y[q] - mean; qv[q] = (y[q][0] * y[q][0] + y[q][1] * y[q][1]) + (y[q][2] * y[q][2] + y[q][3] * y[q][3]);
            const f32x4 kds = k[q] * ((a0[q] - 1.0f) * ka[q] + 1.0f) + k[q] * ((a1[q] - 1.0f) * ka[q] + 1.0f); const f32x4 t = r[q] * kds * rk[q]; bs[q] = (t[0] + t[1]) + (t[2] + t[3]); }
        row16_sum4(qv[0], qv[1], qv[2], qv[3]);
        row16_sum4(bs[0], bs[1], bs[2], bs[3]);
#pragma unroll
        for (int q = 0; q < 4; ++q) { const float ri = 1.0f / sqrtf(qv[q] * (1.0f / 64.0f) + 64e-5f); const f32x4 o = ((y[q] * ri) * l0[q] + l1[q] + v[q] * bs[q]) * g[q];
            *(v2u*)(H + (size_t)m * D + 4 * lane + 256 * q) = (v2u){pk2(o[0], o[1]), pk2(o[2], o[3])}; }
    }
}

enum Kind { K_PRO = 0, K_NORM0 = 1, K_QKV = 2, K_APOST = 3, K_ATTN = 4, K_ACOMB = 5, K_MIXOUT = 6, K_RNORM = 7, K_MLP1 = 8, K_MLP2 = 9, K_REND = 10,
            K_RMIX = 11, K_RKV = 12, K_RPREP = 13, K_RSCAN = 14, K_RPOST = 15 };
constexpr int NPH = 38;
#ifndef PROBE_MASK
#define PROBE_MASK 0
#endif
#ifndef PROBE_REPS
#define PROBE_REPS 1
#endif
template <int KIND, int LAYER>
__device__ __forceinline__ void run_phase(const Args& a, LAS unsigned char* lds, int G, int bx, int vcu, int wave_s, int rep) {
    Ids id; { int lv; asm volatile("v_mbcnt_lo_u32_b32 %0, -1, 0\n\tv_mbcnt_hi_u32_b32 %0, -1, %0" : "=v"(lv)); int zz; asm volatile("s_mov_b32 %0, 0" : "=s"(zz)); id.lane = lv; id.z = zz; }
    id.wave = wave_s; id.tid = wave_s * 64 + id.lane; id.gw = vcu * NWAVES + id.wave; id.ngw = G * NWAVES;
    constexpr int layer = LAYER;
    if constexpr (KIND == K_PRO) ph_prologue(a, id, lds);
    else if constexpr (KIND == K_NORM0) ph_norm0(a, id);
    else if constexpr (KIND == K_QKV) {
        constexpr int j = layer >> 1;
        pg8::Gemm g{(const bf16*)(a.ws + id.z + A_H), (const bf16*)(a.ws + id.z + W_WINT), NTOK, NQKV, D}; pg8::StaticOrder S; S.init(NTOK, NQKV, G, bx);
        const float* RC = (const float*)(a.ws + id.z + WS_ROPE);
        pg8::EpiQkv<QkvMap> E{a.ws + id.z, a.out + id.z, a.in[14 + id.z] + j * 128, RC, RC + 2048 * 64, j};
        pg8::gemm_phase<pg8::EpiQkv<QkvMap>, pg8::StaticOrder, true, true>(lds + RING_OFF, g, S, E, id.wave);
        { Ids id2 = id; int lv; asm volatile("v_mbcnt_lo_u32_b32 %0, -1, 0\n\tv_mbcnt_hi_u32_b32 %0, -1, %0" : "=v"(lv)); int zz; asm volatile("s_mov_b32 %0, 0" : "=s"(zz));
          id2.lane = lv; id2.z = zz; id2.tid = id.wave * 64 + lv; ph_att_cache(a, id2, layer); }
    }
    else if constexpr (KIND == K_MIXOUT) {
        pg8::Gemm g{(const bf16*)(a.ws + id.z + A_H), (const bf16*)(a.ws + id.z + ((layer & 1) ? W_WOT : W_WOUTT)), NTOK, D, D}; pg8::StaticOrder S; S.init(NTOK, D, G, bx);
        pg8::EpiBf16<0> E{(bf16*)(a.ws + id.z + A_M), D, 1 << 20, nullptr, 0};
        pg8::gemm_phase<pg8::EpiBf16<0>, pg8::StaticOrder, true, true>(lds + RING_OFF, g, S, E, id.wave);
    }
    else if constexpr (KIND == K_MLP2) {
        pg8::Gemm g{(const bf16*)(a.ws + id.z + A_HID), (const bf16*)(a.ws + id.z + W_W2T), NTOK, D, FF}; pg8::StaticOrder S; S.init(NTOK, D, G, bx);
        pg8::EpiBf16<0> E{(bf16*)(a.ws + id.z + A_F), D, 1 << 20, nullptr, 0};
        pg8::gemm_phase<pg8::EpiBf16<0>, pg8::StaticOrder, true, true>(lds + RING_OFF, g, S, E, id.wave);
    }
    else if constexpr (KIND == K_MLP1) {
        pg8::Gemm g{(const bf16*)(a.ws + id.z + A_H), (const bf16*)(a.ws + id.z + W_W1T), NTOK, FF, D}; pg8::StaticOrder S; S.init(NTOK, FF, G, bx);
        pg8::EpiBf16<2> E{(bf16*)(a.ws + id.z + A_HID), FF, 1 << 20, nullptr, 0};
        pg8::gemm_phase<pg8::EpiBf16<2>, pg8::StaticOrder, true, true>(lds + RING_OFF, g, S, E, id.wave);
    }
    else if constexpr (KIND == K_RKV) {
        {
            pg8::Gemm g{(const bf16*)(a.ws + id.z + A_A2), (const bf16*)(a.ws + id.z + W_BTL), NTOK, 512, KRKV}; pg8::StaticOrder S; S.init(NTOK, 512, G, bx);
            pg8::EpiL1 E{(bf16*)(a.ws + id.z + A_L1)};
            pg8::gemm_phase<pg8::EpiL1, pg8::StaticOrder, true, true>(lds + RING_OFF, g, S, E, id.wave); }
        {
            pg8::Gemm g{(const bf16*)(a.ws + id.z + A_XS), (const bf16*)(a.ws + id.z + W_BTR), 3 * NTOK, 3072, D}; pg8::RkvOrder S{bx};
            pg8::EpiRkv3 E{(bf16*)(a.ws + id.z + A_RKV)};
            pg8::gemm_phase<pg8::EpiRkv3, pg8::RkvOrder, true, true>(lds + RING_OFF, g, S, E, id.wave); }
    }
    else if constexpr (KIND == K_RPREP) {
        constexpr int j = layer >> 1;
        pg8::Gemm g{(const bf16*)(a.ws + id.z + A_L1), (const bf16*)(a.ws + id.z + W_BT2), NTOK, 5120, 384}; pg8::StaticOrder S; S.init(NTOK, 5120, G, bx);
        static_assert(A_A1 - A_A0 == 32 * MiB && A_EW0 - A_A0 == 64 * MiB && A_EW1 - A_A0 == 96 * MiB, "EpiLora2 output stride");
        pg8::EpiLora2 E{(bf16*)(a.ws + id.z + A_A0), (size_t)16 * MiB, (bf16*)(a.ws + id.z + A_G), a.in[23 + id.z] + (size_t)j * 2 * D, a.in[20 + id.z] + (size_t)j * 2 * D};
        pg8::gemm_phase<pg8::EpiLora2, pg8::StaticOrder, true, true>(lds + RING_OFF, g, S, E, id.wave);
        { Ids id2 = id; int lv; asm volatile("v_mbcnt_lo_u32_b32 %0, -1, 0\n\tv_mbcnt_hi_u32_b32 %0, -1, %0" : "=v"(lv)); int zz; asm volatile("s_mov_b32 %0, 0" : "=s"(zz));
          id2.lane = lv; id2.z = zz; id2.tid = id.wave * 64 + lv; ph_rw_prep(a, id2, layer); }
    }
    else if constexpr (KIND == K_ATTN) ph_attn(a, id, lds, G, vcu);
    else if constexpr (KIND == K_ACOMB) ph_att_comb(a, id, layer);
    else if constexpr (KIND == K_RNORM) ph_resid_norm(a, id, layer, rep + 1 < (((PROBE_MASK >> K_RNORM) & 1) ? PROBE_REPS : 1));
    else if constexpr (KIND == K_REND) ph_resid_end(a, id, lds, layer, rep + 1 < (((PROBE_MASK >> K_REND) & 1) ? PROBE_REPS : 1));
    else if constexpr (KIND == K_RMIX) ph_rw_mix(a, id, layer);
    else if constexpr (KIND == K_RSCAN) { if (rep > 0) { ph_rw_prep(a, id, layer); __syncthreads(); cg::this_grid().sync(); } ph_rw_scan(a, id, lds, layer, G, vcu); }
    else if constexpr (KIND == K_RPOST) ph_rw_post(a, id, layer);
}

__global__ void __launch_bounds__(NWAVES * 64, 2) mega_fwd(Args a) {
    extern __shared__ __attribute__((aligned(16))) unsigned char lds_raw[];
    LAS unsigned char* lds = (LAS unsigned char*)lds_raw;
    const int G = gridDim.x, bx = blockIdx.x; const int vcu = (G % 8 == 0) ? (bx % 8) * (G / 8) + bx / 8 : bx;
    volatile LAS unsigned* MISC = (volatile LAS unsigned*)(lds + MISC_OFF);
    for (int u = threadIdx.x; u < (LDS_BYTES - LDSCTL_OFF) / 4; u += NWAVES * 64) ((LAS unsigned*)(lds + LDSCTL_OFF))[u] = 0u;
    __syncthreads();
#if MK_N_LAUNCHES == 1 && !MK_CG_BARRIER
    XcdBarrier bar = xcd_barrier_post((unsigned*)(a.ws + WS_CTL) + CW_BAR, MISC + 8, threadIdx.x == 0);
#endif
    (void)MISC;
    const int lo = a.ph_lo, hi = a.ph_hi;
    const int wave_s = __builtin_amdgcn_readfirstlane(threadIdx.x >> 6);
#if MK_N_LAUNCHES == 1
#if MK_CG_BARRIER
#define GRID_BAR(ph) cg::this_grid().sync()
#else
#define GRID_BAR(ph) do { if ((ph) == 0) cg::this_grid().sync(); else { int l_; asm volatile("v_mbcnt_lo_u32_b32 %0, -1, 0\n\tv_mbcnt_hi_u32_b32 %0, -1, %0" : "=v"(l_)); xcd_barrier(bar, wave_s == 0 && l_ == 0); } } while (0)
#endif
#else
#define GRID_BAR(ph) do { } while (0)
#endif
#define PHASE(ph, KIND, LAYER) do { if (lo <= (ph) && (ph) < hi) { constexpr int nrep_ = ((PROBE_MASK >> (KIND)) & 1) ? PROBE_REPS : 1; \
        _Pragma("unroll 1") for (int rep_ = 0; rep_ < nrep_; ++rep_) { run_phase<KIND, LAYER>(a, lds, G, bx, vcu, wave_s, rep_); if (rep_ + 1 < nrep_) { __syncthreads(); cg::this_grid().sync(); } } \
        if ((ph) + 1 < hi) GRID_BAR(ph); } } while (0)
#define ATTN_LAYER(p0, L) PHASE((p0) + 0, K_QKV, L); PHASE((p0) + 1, K_ATTN, L); PHASE((p0) + 2, K_ACOMB, L); PHASE((p0) + 3, K_MIXOUT, L); \
        PHASE((p0) + 4, K_RNORM, L); PHASE((p0) + 5, K_MLP1, L); PHASE((p0) + 6, K_MLP2, L); PHASE((p0) + 7, K_REND, L)
#define RWKV_LAYER(p0, L) PHASE((p0) + 0, K_RMIX, L); PHASE((p0) + 1, K_RKV, L); PHASE((p0) + 2, K_RPREP, L); PHASE((p0) + 3, K_RSCAN, L); PHASE((p0) + 4, K_RPOST, L); PHASE((p0) + 5, K_MIXOUT, L); \
        PHASE((p0) + 6, K_RNORM, L); PHASE((p0) + 7, K_MLP1, L); PHASE((p0) + 8, K_MLP2, L); PHASE((p0) + 9, K_REND, L)
    PHASE(0, K_PRO, 0); PHASE(1, K_NORM0, 0);
    ATTN_LAYER(2, 0); RWKV_LAYER(10, 1); ATTN_LAYER(20, 2); RWKV_LAYER(28, 3);
#undef PHASE
#undef ATTN_LAYER
#undef RWKV_LAYER
#undef GRID_BAR
}

extern "C" void kernel_launch(void* const* d_in, const int* in_sizes, int n_in, void* d_out, int out_size, void* d_ws, size_t ws_size, hipStream_t stream) {
    static int grid = 0;
    if (grid == 0) {
        if (n_in != 32 || (size_t)out_size != OUT_TOTAL || ws_size < WS_END) { fprintf(stderr, "kernel_launch: unexpected problem (n_in %d, out %d, ws %zu; need ws >= %zu); nothing launched\n", n_in, out_size, ws_size, (size_t)WS_END); grid = -1; return; }
        int dev = 0, cus = 0, per_cu = 0;
        if (hipGetDevice(&dev) != hipSuccess || hipDeviceGetAttribute(&cus, hipDeviceAttributeMultiprocessorCount, dev) != hipSuccess) { grid = -1; return; }
        if (hipFuncSetAttribute((const void*)mega_fwd, hipFuncAttributeMaxDynamicSharedMemorySize, LDS_BYTES) != hipSuccess) { fprintf(stderr, "kernel_launch: hipFuncSetAttribute failed\n"); grid = -1; return; }
        if (hipOccupancyMaxActiveBlocksPerMultiprocessor(&per_cu, (const void*)mega_fwd, NWAVES * 64, LDS_BYTES) != hipSuccess || per_cu < 1) { fprintf(stderr, "kernel_launch: occupancy query failed (%d)\n", per_cu); (void)hipGetLastError(); per_cu = 1; }
        grid = cus * (per_cu < 1 ? 1 : 1);
        fprintf(stderr, "kernel_launch: %d CUs, occupancy %d/CU, grid %d\n", cus, per_cu, grid);
    }
    if (grid < 0) return;
    (void)in_sizes;
    if (hipMemsetAsync((char*)d_ws + WS_CTL, 0, CTL_ZERO_BYTES, stream) != hipSuccess) { fprintf(stderr, "kernel_launch: memset failed\n"); return; }
    Args a{};
    for (int i = 0; i < 32; ++i) a.in[i] = (const float*)d_in[i];
    a.out = (float*)d_out; a.ws = (unsigned char*)d_ws;
#if MK_N_LAUNCHES == 1
    a.ph_lo = 0; a.ph_hi = NPH;
    void* args[] = {&a};
    hipError_t e = hipLaunchCooperativeKernel((const void*)mega_fwd, dim3(grid), dim3(NWAVES * 64), args, LDS_BYTES, stream);
    if (e != hipSuccess) fprintf(stderr, "kernel_launch: cooperative launch failed: %s (grid %d)\n", hipGetErrorString(e), grid);
#else
    for (int ph = 0; ph < NPH; ++ph) {
        a.ph_lo = ph; a.ph_hi = ph + 1;
        hipLaunchKernelGGL(mega_fwd, dim3(grid), dim3(NWAVES * 64), LDS_BYTES, stream, a);
    }
#endif
}
```

```cpp
#include <hip/hip_runtime.h>
#include <hip/hip_cooperative_groups.h>
#include <cstdio>
#include <cstdint>
namespace cg = cooperative_groups;
namespace pg8 {
#define PG8_LAS __attribute__((address_space(3)))
typedef unsigned short bf16_t;
typedef short bf16x8 __attribute__((ext_vector_type(8)));
typedef float f32x4 __attribute__((ext_vector_type(4)));
typedef unsigned u32x4 __attribute__((ext_vector_type(4)));
constexpr int BM = 256, BK = 64, HALF = 128, HTB = HALF * BK * 2  , STAGE_BYTES = 8 * HTB, NXCD = 8, WGM = 8;

__host__ __device__ __forceinline__ int lds_byte(int r, int c) { const int st = (r >> 4) * 2 + (c >> 5), rr = r & 15, cc = c & 31, ob = rr * 64 + cc * 2; return st * 1024 + (ob ^ (((ob >> 9) & 1) << 5)); }
__host__ __device__ __forceinline__ void stage_rc(int b, int& R, int& C) { const int st = b / 1024, sb = b % 1024, swz = sb ^ (((sb >> 9) & 1) << 5); R = (st >> 1) * 16 + swz / 64; C = (st & 1) * 32 + (swz % 64) / 2; }
__host__ __device__ __forceinline__ int perm32(int rho) { const int n = rho >> 4, i = rho & 15; return 8 * (i >> 2) + 4 * n + (i & 3); }

struct Unit { int pm, pn; };
struct Gemm { const bf16_t* A; const bf16_t* Bt; int M, N, K; };

struct StaticOrder {
    int nM, nN, nwg, G, c;
    __host__ __device__ void init(int M, int N, int G_, int c_) { nM = M / BM; nN = N / BM; nwg = nM * nN; G = G_; c = c_; }
    __host__ __device__ bool next(int i, Unit& u) const {
        const long L = (long)i * G + c; if (L >= nwg) return false;
        int wgid = (int)L; { const int q = nwg / NXCD, r = nwg % NXCD, xcd = wgid % NXCD, off = wgid / NXCD; wgid = (xcd < r ? xcd * (q + 1) : r * (q + 1) + (xcd - r) * q) + off; }
        const int nig = WGM * nN, gid = wgid / nig, fm = gid * WGM, gsz = (nM - fm) < WGM ? (nM - fm) : WGM;
        u.pm = fm + ((wgid % nig) % gsz); u.pn = (wgid % nig) / gsz; return true;
    }
    __device__ __forceinline__ void a_ready(const Unit&) const {}
    __device__ __forceinline__ void done(const Unit&) const {}
};


__device__ __forceinline__ unsigned cvt_pk_bf16(float lo, float hi) { unsigned r; asm volatile("v_cvt_pk_bf16_f32 %0, %1, %2" : "=v"(r) : "v"(lo), "v"(hi)); return r; }

template <int ACT> struct EpiBf16 {
    static constexpr bool PERM = true, AFTER_DRAIN = false;
    bf16_t* O0; int ld0; int nt0; bf16_t* O1; int ld1;
    __device__ __forceinline__ void operator()(const f32x4 (&acc)[2][2][4][2], const Unit& u, int wr, int wc, int fr, int fq) const {
        const int row0 = u.pm * BM + wr * 64 + fr;
        bf16_t* base; int ldc, colt;
        if (u.pn < nt0) { base = O0; ldc = ld0; colt = u.pn * BM; } else { base = O1; ldc = ld1; colt = (u.pn - nt0) * BM; }
        const int col0 = colt + wc * 32 + 8 * fq;
#pragma unroll
        for (int ai = 0; ai < 2; ++ai)
#pragma unroll
            for (int m = 0; m < 4; ++m) { bf16_t* rowp = base + (size_t)(row0 + ai * HALF + m * 16) * ldc + col0;
#pragma unroll
                for (int bj = 0; bj < 2; ++bj) { f32x4 v0 = acc[ai][bj][m][0], v1 = acc[ai][bj][m][1];
                    if (ACT == 2) {
#pragma unroll
                        for (int e = 0; e < 4; ++e) { float a = v0[e] > 0.f ? v0[e] : 0.f; v0[e] = a * a; float b = v1[e] > 0.f ? v1[e] : 0.f; v1[e] = b * b; } }
                    u32x4 w; w.x = cvt_pk_bf16(v0[0], v0[1]); w.y = cvt_pk_bf16(v0[2], v0[3]); w.z = cvt_pk_bf16(v1[0], v1[1]); w.w = cvt_pk_bf16(v1[2], v1[3]);
                    *(u32x4*)(rowp + bj * HALF) = w; } }
    }
    __device__ __forceinline__ void fused(f32x4 (&)[2][2][4][2], const Unit&, int, int, int, int, PG8_LAS unsigned char*, int, int) const {}
};


__device__ __forceinline__ float sig_f(float x) { return 1.0f / (1.0f + __expf(-x)); }
struct RkvOrder {
    int c;
    __device__ __forceinline__ bool next(int i, Unit& u) const {
        int L; if (c < 128) { if (i >= 2) return false; L = c * 2 + i; } else { if (i >= 4) return false; L = 256 + (c - 128) * 4 + i; }
        const int which = L >> 8, r = L & 255; u.pm = which * 64 + (r >> 2); u.pn = which * 4 + (r & 3); return true; }
    __device__ __forceinline__ void a_ready(const Unit&) const {}
    __device__ __forceinline__ void done(const Unit&) const {}
};
struct EpiRkv3 {
    static constexpr bool PERM = true, AFTER_DRAIN = false;
    bf16_t* RKV;
    __device__ __forceinline__ void operator()(const f32x4 (&acc)[2][2][4][2], const Unit& u, int wr, int wc, int fr, int fq) const {
        const int row0 = (u.pm & 63) * BM + wr * 64 + fr, col0 = u.pn * BM + wc * 32 + 8 * fq;
#pragma unroll
        for (int ai = 0; ai < 2; ++ai)
#pragma unroll
            for (int m = 0; m < 4; ++m) { bf16_t* rowp = RKV + (size_t)(row0 + ai * HALF + m * 16) * 3072 + col0;
#pragma unroll
                for (int bj = 0; bj < 2; ++bj) { const f32x4 v0 = acc[ai][bj][m][0], v1 = acc[ai][bj][m][1];
                    u32x4 w; w.x = cvt_pk_bf16(v0[0], v0[1]); w.y = cvt_pk_bf16(v0[2], v0[3]); w.z = cvt_pk_bf16(v1[0], v1[1]); w.w = cvt_pk_bf16(v1[2], v1[3]);
                    *(u32x4*)(rowp + bj * HALF) = w; } }
    }
};
struct EpiL1 {
    static constexpr bool PERM = true, AFTER_DRAIN = false;
    bf16_t* L1;
    __device__ __forceinline__ void operator()(const f32x4 (&acc)[2][2][4][2], const Unit& u, int wr, int wc, int fr, int fq) const {
        const int row0 = u.pm * BM + wr * 64 + fr, colt = u.pn * BM, col0 = colt + wc * 32 + 8 * fq;
#pragma unroll
        for (int ai = 0; ai < 2; ++ai)
#pragma unroll
            for (int m = 0; m < 4; ++m) { bf16_t* rowp = L1 + (size_t)(row0 + ai * HALF + m * 16) * 384 + col0;
#pragma unroll
                for (int bj = 0; bj < 2; ++bj) { f32x4 v0 = acc[ai][bj][m][0], v1 = acc[ai][bj][m][1];
                    const int cb = colt + bj * HALF;
                    if (cb >= 384) continue;
                    if (cb == 0) {
#pragma unroll
                        for (int e = 0; e < 4; ++e) { v0[e] = 1.0f - 2.0f / (1.0f + __expf(2.0f * v0[e])); v1[e] = 1.0f - 2.0f / (1.0f + __expf(2.0f * v1[e])); } }
                    else if (cb == 256) {
#pragma unroll
                        for (int e = 0; e < 4; ++e) { v0[e] = sig_f(v0[e]); v1[e] = sig_f(v1[e]); } }
                    u32x4 w; w.x = cvt_pk_bf16(v0[0], v0[1]); w.y = cvt_pk_bf16(v0[2], v0[3]); w.z = cvt_pk_bf16(v1[0], v1[1]); w.w = cvt_pk_bf16(v1[2], v1[3]);
                    *(u32x4*)(rowp + bj * HALF) = w; } }
    }
};
struct EpiLora2 {
    static constexpr bool PERM = true, AFTER_DRAIN = false;
    bf16_t* o4; size_t ostride; bf16_t* og; const float* a0; const float* w0;
    __device__ __forceinline__ void operator()(const f32x4 (&acc)[2][2][4][2], const Unit& u, int wr, int wc, int fr, int fq) const {
        const int row0 = u.pm * BM + wr * 64 + fr; const int blk = u.pn >> 2, colt = (u.pn & 3) * BM;
        bf16_t* base = (blk < 4) ? o4 + (size_t)blk * ostride : og;
        const float* bs = ((blk < 2) ? a0 : w0) + (blk & 1) * 1024;
        const int col0 = colt + wc * 32 + 8 * fq;
        const float sc = (blk >= 2) ? 0.8750387749719753f : 1.0f;
#pragma unroll
        for (int bj = 0; bj < 2; ++bj) {
            f32x4 b0 = (f32x4){0.f, 0.f, 0.f, 0.f}, b1 = b0;
            if (blk < 4) { b0 = *(const f32x4*)(bs + col0 + bj * HALF); b1 = *(const f32x4*)(bs + col0 + bj * HALF + 4); }
#pragma unroll
            for (int ai = 0; ai < 2; ++ai)
#pragma unroll
                for (int m = 0; m < 4; ++m) { bf16_t* rowp = base + (size_t)(row0 + ai * HALF + m * 16) * 1024 + col0;
                    f32x4 v0 = acc[ai][bj][m][0] + b0, v1 = acc[ai][bj][m][1] + b1;
                    if (blk < 4) {
#pragma unroll
                        for (int e = 0; e < 4; ++e) { v0[e] = sc * sig_f(v0[e]); v1[e] = sc * sig_f(v1[e]); } }
                    u32x4 w; w.x = cvt_pk_bf16(v0[0], v0[1]); w.y = cvt_pk_bf16(v0[2], v0[3]); w.z = cvt_pk_bf16(v1[0], v1[1]); w.w = cvt_pk_bf16(v1[2], v1[3]);
                    *(u32x4*)(rowp + bj * HALF) = w; } }
    }
};


template <class MP> struct EpiQkv {
    static constexpr bool PERM = true, AFTER_DRAIN = false;
    unsigned char* ws; float* out; const float* gain; const float* RC; const float* RS; int j;
    static constexpr size_t oQA = MP::oQA, oQB = MP::oQB, oKAP = MP::oKAP, oVAP = MP::oVAP, oKBP = MP::oKBP, oVBP = MP::oVBP, oKAS = MP::oKAS, oVAS = MP::oVAS, oKBS = MP::oKBS, oVBS = MP::oVBS;
    static constexpr size_t oKG = MP::oKG, oVG = MP::oVG, oKD = MP::oKD, oVD = MP::oVD;
    __device__ __forceinline__ void operator()(const f32x4 (&acc)[2][2][4][2], const Unit& u, int wr, int wc, int fr, int fq) const {
        const int ch = 4 * u.pn + wc; const bool smp = u.pm >= 32;
        const bool isq = (ch < 8) || (ch >= 12 && ch < 20), isk = (ch == 8 || ch == 9) || (ch >= 20 && ch < 28);
        const int dl = 8 * fq;
        const bool hi2 = (fq & 2) != 0;
        f32x4 g[2][2];
#pragma unroll
        for (int bj = 0; bj < 2; ++bj)
#pragma unroll
            for (int n = 0; n < 2; ++n) g[bj][n] = (ch < 10) ? *(const f32x4*)(gain + (ch < 8 ? 0 : 64) + bj * 32 + dl + 4 * n) : (f32x4){1.f, 1.f, 1.f, 1.f};
        constexpr float QS = 0.18033688011112042f;
#pragma unroll
        for (int ai = 0; ai < 2; ++ai)
#pragma unroll
            for (int m = 0; m < 4; ++m) {
                const int mrow = u.pm * BM + ai * HALF + wr * 64 + m * 16 + fr;
                const int b = smp ? ((mrow - 8192) >> 11) : (mrow >> 8), t = smp ? ((mrow - 8192) & 2047) : (mrow & 255);
                f32x4 v[2][2];
#pragma unroll
                for (int bj = 0; bj < 2; ++bj)
#pragma unroll
                    for (int n = 0; n < 2; ++n) v[bj][n] = acc[ai][bj][m][n];
                if (ch < 10) { float ss = 0.f;
#pragma unroll
                    for (int bj = 0; bj < 2; ++bj)
#pragma unroll
                        for (int n = 0; n < 2; ++n) ss += (v[bj][n][0] * v[bj][n][0] + v[bj][n][1] * v[bj][n][1]) + (v[bj][n][2] * v[bj][n][2] + v[bj][n][3] * v[bj][n][3]);
                    ss += __shfl_xor(ss, 16); ss += __shfl_xor(ss, 32);
                    const float ri = 1.0f / sqrtf(ss * (1.0f / 64.0f) + 1e-6f);
#pragma unroll
                    for (int bj = 0; bj < 2; ++bj)
#pragma unroll
                        for (int n = 0; n < 2; ++n) v[bj][n] = v[bj][n] * ri * g[bj][n]; }
                f32x4 vr[2][2];
#pragma unroll
                for (int bj = 0; bj < 2; ++bj)
#pragma unroll
                    for (int n = 0; n < 2; ++n) { vr[bj][n] = v[bj][n];
                        if (smp && (isq || isk)) { f32x4 p; p[0] = __shfl_xor(v[bj][n][0], 32); p[1] = __shfl_xor(v[bj][n][1], 32); p[2] = __shfl_xor(v[bj][n][2], 32); p[3] = __shfl_xor(v[bj][n][3], 32);
                            const f32x4 cs = *(const f32x4*)(RC + t * 64 + bj * 32 + dl + 4 * n), sn = *(const f32x4*)(RS + t * 64 + bj * 32 + dl + 4 * n);
                            const f32x4 rot = hi2 ? p : -p; vr[bj][n] = v[bj][n] * cs + rot * sn; } }
#define EQ_PK8(x0, x1) ((u32x4){cvt_pk_bf16((x0)[0], (x0)[1]), cvt_pk_bf16((x0)[2], (x0)[3]), cvt_pk_bf16((x1)[0], (x1)[1]), cvt_pk_bf16((x1)[2], (x1)[3])})
                const size_t srow = (size_t)(b * 2560 + 512 + t), prow = (size_t)((b * 2 + j) * 256 + t);
#pragma unroll
                for (int bj = 0; bj < 2; ++bj) {
                    const int f0 = bj * 32 + dl;
                    if (isq) { const f32x4 s0 = vr[bj][0] * QS, s1 = vr[bj][1] * QS; const size_t o = (ch < 8) ? oQA + ((size_t)mrow * 512 + ch * 64 + f0) * 2 : oQB + ((size_t)mrow * 512 + (ch - 12) * 64 + f0) * 2;
                        *(u32x4*)(ws + o) = EQ_PK8(s0, s1); }
                    else {
                        const bool gq = ch < 12, kk = isk;
                        const int e = gq ? ((ch & 1) * 64 + f0) : ((ch - (kk ? 20 : 28)) * 64 + f0); const int wdt = gq ? 128 : 512;
                        if (!smp) { const size_t of = (gq ? (kk ? oKG : oVG) : (kk ? oKD : oVD)) + prow * wdt + e; *(f32x4*)(out + of) = v[bj][0]; *(f32x4*)(out + of + 4) = v[bj][1];
                            const size_t o = (gq ? (kk ? oKAP : oVAP) : (kk ? oKBP : oVBP)) + ((size_t)mrow * wdt + e) * 2; *(u32x4*)(ws + o) = EQ_PK8(v[bj][0], v[bj][1]); }
                        else { const size_t o = (gq ? (kk ? oKAS : oVAS) : (kk ? oKBS : oVBS)) + (srow * wdt + e) * 2; *(u32x4*)(ws + o) = EQ_PK8(vr[bj][0], vr[bj][1]); } }
                }
#undef EQ_PK8
            }
    }
};

template <class Epi, class Sched, bool ALIGN_EPI = false, bool SP2 = false>
__device__ __forceinline__ void gemm_phase(PG8_LAS unsigned char* lds, const Gemm g, const Sched& S, const Epi& E, const int wave_index) {
    int lane_o; asm volatile("v_mbcnt_lo_u32_b32 %0, -1, 0\n\tv_mbcnt_hi_u32_b32 %0, -1, %0" : "=v"(lane_o));
    const int wid = wave_index, lane = lane_o, tid = wid * 64 + lane, wr = wid >> 2, wc = wid & 3, fr = lane & 15, fq = lane >> 4;
    const int K = g.K, nt = K / BK;
    unsigned voffA[2], voffB[2];
#pragma unroll
    for (int i = 0; i < 2; ++i) { int R, C; stage_rc(tid * 16 + i * 8192, R, C); const int Rb = Epi::PERM ? ((R & ~31) + perm32(R & 31)) : R;
        voffA[i] = (unsigned)(R * K + C) * 2u; voffB[i] = (unsigned)(Rb * K + C) * 2u; }
    const size_t kstep = (size_t)(BK * 2);
    const size_t hstep = (size_t)HALF * K * 2;
    const size_t tstep = 2 * hstep;
    const unsigned ldsw = (unsigned)wid * 1024u;
    const int aoff = lds_byte(wr * 64 + fr, fq * 8), boff = lds_byte(wc * 32 + fr, fq * 8);
#define PG8_SA(b, h) (((b) * 2 + (h)) * HTB)
#define PG8_SB(b, h) ((4 + (b) * 2 + (h)) * HTB)
#define PG8_STAGE(bufoff, gbase, voff) do { _Pragma("unroll") for (int _i = 0; _i < 2; ++_i) \
        __builtin_amdgcn_global_load_lds((const unsigned*)((const char*)(gbase) + (voff)[_i]), (PG8_LAS unsigned*)(lds + (bufoff) + ldsw + _i * 8192), 16, 0, 0); } while (0)
#define PG8_LDA(dst, b, h) do { _Pragma("unroll") for (int m = 0; m < 4; ++m) _Pragma("unroll") for (int k = 0; k < 2; ++k) dst[m][k] = *(const PG8_LAS bf16x8*)(lds + PG8_SA(b, h) + aoff + m * 2048 + k * 1024); } while (0)
#define PG8_LDB(dst, b, h) do { _Pragma("unroll") for (int n = 0; n < 2; ++n) _Pragma("unroll") for (int k = 0; k < 2; ++k) dst[n][k] = *(const PG8_LAS bf16x8*)(lds + PG8_SB(b, h) + boff + n * 2048 + k * 1024); } while (0)
#define PG8_MMA(ai, bj, At, Bt) do { __builtin_amdgcn_s_setprio(1); _Pragma("unroll") for (int m = 0; m < 4; ++m) _Pragma("unroll") for (int n = 0; n < 2; ++n) _Pragma("unroll") for (int k = 0; k < 2; ++k) \
        acc[ai][bj][m][n] = __builtin_amdgcn_mfma_f32_16x16x32_bf16(Bt[n][k], At[m][k], acc[ai][bj][m][n], 0, 0, 0); __builtin_amdgcn_s_setprio(0); } while (0)
#define PG8_WAIT_V(n) asm volatile("s_waitcnt vmcnt(" #n ")" ::: "memory")
#define PG8_WAIT_L(n) asm volatile("s_waitcnt lgkmcnt(" #n ")" ::: "memory")
#define PG8_BAR __builtin_amdgcn_s_barrier()
#define PG8_SCHED __builtin_amdgcn_sched_barrier(0)
    Unit cur, nxt; int ui = 0;
    if (!S.next(0, cur)) return;
    f32x4 acc[2][2][4][2];
#pragma unroll
    for (int a = 0; a < 2; ++a)
#pragma unroll
        for (int b = 0; b < 2; ++b)
#pragma unroll
            for (int m = 0; m < 4; ++m)
#pragma unroll
                for (int n = 0; n < 2; ++n) acc[a][b][m][n] = (f32x4){0.f, 0.f, 0.f, 0.f};
    bf16x8 At[4][2], B0[2][2], B1[2][2];
    const char* cA = (const char*)g.A + (size_t)cur.pm * tstep; const char* cB = (const char*)g.Bt + (size_t)cur.pn * tstep;
    S.a_ready(cur);
    if constexpr (SP2) {
        PG8_STAGE(PG8_SB(0, 0), cB, voffB); PG8_STAGE(PG8_SB(0, 1), cB + hstep, voffB); PG8_STAGE(PG8_SA(0, 0), cA, voffA); PG8_STAGE(PG8_SA(0, 1), cA + hstep, voffA);
        if (wr == 1) PG8_BAR;
        PG8_WAIT_V(2); PG8_BAR;
        PG8_STAGE(PG8_SB(1, 0), cB + kstep, voffB); PG8_STAGE(PG8_SA(1, 0), cA + kstep, voffA); PG8_STAGE(PG8_SB(1, 1), cB + hstep + kstep, voffB);
        PG8_WAIT_V(6); PG8_BAR;
    } else {
        PG8_STAGE(PG8_SB(0, 0), cB, voffB); PG8_STAGE(PG8_SA(0, 0), cA, voffA); PG8_STAGE(PG8_SB(0, 1), cB + hstep, voffB); PG8_STAGE(PG8_SA(0, 1), cA + hstep, voffA);
        if (wr == 1) PG8_BAR;
        PG8_WAIT_V(4); PG8_BAR;
        PG8_STAGE(PG8_SB(1, 0), cB + kstep, voffB); PG8_STAGE(PG8_SA(1, 0), cA + kstep, voffA); PG8_STAGE(PG8_SB(1, 1), cB + hstep + kstep, voffB);
        PG8_WAIT_V(6); PG8_BAR;
    }
    for (;;) {
        const bool has_next = S.next(ui + 1, nxt);
        const char* nA = has_next ? (const char*)g.A + (size_t)nxt.pm * tstep : cA; const char* nB = has_next ? (const char*)g.Bt + (size_t)nxt.pn * tstep : cB;
#pragma unroll 1
        for (int t = 0; t < nt; t += 2) {
            const bool last = (t == nt - 2);
            const char* a1 = cA + (size_t)(t + 1) * kstep;
            const char* a2 = last ? nA : cA + (size_t)(t + 2) * kstep; const char* b2 = last ? nB : cB + (size_t)(t + 2) * kstep;
            const char* a3 = a2 + kstep; const char* b3 = b2 + kstep;
            if (last && has_next) S.a_ready(nxt);
            if constexpr (SP2) {
            PG8_LDB(B0, 0, 0); PG8_LDB(B1, 0, 1); PG8_SCHED; PG8_LDA(At, 0, 0); PG8_STAGE(PG8_SA(1, 1), a1 + hstep, voffA);
            PG8_WAIT_V(8); PG8_WAIT_L(0); PG8_BAR; PG8_MMA(0, 0, At, B0); PG8_MMA(0, 1, At, B1); PG8_BAR; PG8_SCHED;
            PG8_LDA(At, 0, 1); PG8_STAGE(PG8_SB(0, 0), b2, voffB); PG8_STAGE(PG8_SB(0, 1), b2 + hstep, voffB); PG8_STAGE(PG8_SA(0, 0), a2, voffA);
            PG8_WAIT_V(8); PG8_WAIT_L(0); PG8_BAR; PG8_MMA(1, 0, At, B0); PG8_MMA(1, 1, At, B1); PG8_BAR; PG8_SCHED;
            PG8_LDB(B0, 1, 0); PG8_LDB(B1, 1, 1); PG8_SCHED; PG8_LDA(At, 1, 0); PG8_STAGE(PG8_SA(0, 1), a2 + hstep, voffA);
            PG8_WAIT_V(8); PG8_WAIT_L(0); PG8_BAR; PG8_MMA(0, 0, At, B0); PG8_MMA(0, 1, At, B1); PG8_BAR; PG8_SCHED;
            PG8_LDA(At, 1, 1); PG8_STAGE(PG8_SB(1, 0), b3, voffB); PG8_STAGE(PG8_SB(1, 1), b3 + hstep, voffB); PG8_STAGE(PG8_SA(1, 0), a3, voffA);
            PG8_WAIT_V(8); PG8_WAIT_L(0); PG8_BAR; PG8_MMA(1, 0, At, B0); PG8_MMA(1, 1, At, B1); PG8_BAR; PG8_SCHED;
            } else {
            PG8_LDB(B0, 0, 0); PG8_SCHED; PG8_LDA(At, 0, 0); PG8_STAGE(PG8_SA(1, 1), a1 + hstep, voffA);
            PG8_WAIT_L(8); PG8_BAR; PG8_WAIT_L(0); PG8_MMA(0, 0, At, B0); PG8_BAR; PG8_SCHED;
            PG8_LDB(B1, 0, 1); PG8_STAGE(PG8_SB(0, 0), b2, voffB);
            PG8_BAR; PG8_WAIT_L(0); PG8_MMA(0, 1, At, B1); PG8_BAR;
            PG8_LDA(At, 0, 1); PG8_STAGE(PG8_SA(0, 0), a2, voffA);
            PG8_BAR; PG8_WAIT_L(0); PG8_MMA(1, 0, At, B0); PG8_BAR; PG8_SCHED;
            PG8_STAGE(PG8_SB(0, 1), b2 + hstep, voffB);
            PG8_WAIT_V(6); PG8_BAR; PG8_MMA(1, 1, At, B1); PG8_BAR;
            PG8_LDB(B0, 1, 0); PG8_SCHED; PG8_LDA(At, 1, 0); PG8_STAGE(PG8_SA(0, 1), a2 + hstep, voffA);
            PG8_WAIT_L(8); PG8_BAR; PG8_WAIT_L(0); PG8_MMA(0, 0, At, B0); PG8_BAR; PG8_SCHED;
            PG8_LDB(B1, 1, 1); PG8_STAGE(PG8_SB(1, 0), b3, voffB);
            PG8_BAR; PG8_WAIT_L(0); PG8_MMA(0, 1, At, B1); PG8_BAR;
            PG8_LDA(At, 1, 1); PG8_STAGE(PG8_SA(1, 0), a3, voffA);
            PG8_BAR; PG8_WAIT_L(0); PG8_MMA(1, 0, At, B0); PG8_BAR; PG8_SCHED;
            PG8_STAGE(PG8_SB(1, 1), b3 + hstep, voffB);
            PG8_WAIT_V(6); PG8_BAR; PG8_MMA(1, 1, At, B1); PG8_BAR;
            }
        }
        if constexpr (ALIGN_EPI) { if (wr == 0) PG8_BAR; }
        if constexpr (!Epi::AFTER_DRAIN) { E(acc, cur, wr, wc, fr, fq); S.done(cur); }
        if (!has_next) break;
#pragma unroll
        for (int a = 0; a < 2; ++a)
#pragma unroll
            for (int b = 0; b < 2; ++b)
#pragma unroll
                for (int m = 0; m < 4; ++m)
#pragma unroll
                    for (int n = 0; n < 2; ++n) acc[a][b][m][n] = (f32x4){0.f, 0.f, 0.f, 0.f};
        cur = nxt; cA = nA; cB = nB; ++ui;
        if constexpr (ALIGN_EPI) { if (wr == 1) PG8_BAR; }
    }
    PG8_WAIT_V(0);
    if constexpr (!ALIGN_EPI) { if (wr == 0) PG8_BAR; }
    PG8_BAR;
    if constexpr (Epi::AFTER_DRAIN) { E.fused(acc, cur, wr, wc, fr, fq, lds, wid, lane); S.done(cur); }
#undef PG8_SA
#undef PG8_SB
#undef PG8_STAGE
#undef PG8_LDA
#undef PG8_LDB
#undef PG8_MMA
#undef PG8_WAIT_V
#undef PG8_WAIT_L
#undef PG8_BAR
#undef PG8_SCHED
}
}

#define GAS __attribute__((address_space(1)))
#define LAS __attribute__((address_space(3)))
typedef unsigned short bf16;
typedef unsigned v4u __attribute__((ext_vector_type(4)));
typedef unsigned v2u __attribute__((ext_vector_type(2)));
typedef float f32x4 __attribute__((ext_vector_type(4)));
#define LDS_WAIT() asm volatile("s_waitcnt lgkmcnt(0)" ::: "memory")

#ifndef MK_N_LAUNCHES
#define MK_N_LAUNCHES 1
#endif
#ifndef MK_CG_BARRIER
#define MK_CG_BARRIER 0
#endif

constexpr int D = 1024, NTOK = 16384, NPR = 8192, TP = 256, TS = 2048, PAST = 512, SKV = 2560, FF = 4096, DEPTH = 4;
constexpr int NQKV = 2304, NRKV = 3584, KRKV = 2048;
constexpr int NWAVES = 8;
constexpr size_t O_X = 0, O_KG = 16777216, O_VG = 18874368, O_KD = 20971520, O_VD = 29360128, O_ST = 37748736, OUT_TOTAL = 46137344;
constexpr size_t MiB = 1u << 20;
constexpr size_t WS_CTL = 0, CTL_ZERO_BYTES = 1 * MiB;
constexpr size_t WS_MOD = 65536;
constexpr size_t WS_ROPE = 1 * MiB;
constexpr size_t WS_INV = 2 * MiB;
constexpr size_t WS_W = 4 * MiB;
constexpr size_t W_W1T = WS_W, W_W2T = WS_W + 8 * MiB, W_MIX = WS_W + 16 * MiB;
constexpr size_t W_WINT = W_MIX, W_WOUTT = W_MIX + 6 * MiB;
constexpr size_t W_BTR = W_MIX, W_BTL = W_MIX + 6 * MiB, W_WOT = W_MIX + 14 * MiB, W_BT2 = W_MIX + 16 * MiB;
constexpr size_t AR = 40 * MiB;
constexpr size_t A_H = AR;
constexpr size_t A_QKVRAW = AR + 32 * MiB;
constexpr size_t A_DT = AR + 32 * MiB;
constexpr size_t A_M = AR + 96 * MiB;
constexpr size_t A_QA = AR + 176 * MiB, A_QB = AR + 192 * MiB, A_KAP = AR + 208 * MiB, A_VAP = AR + 210 * MiB, A_KBP = AR + 212 * MiB, A_VBP = AR + 220 * MiB;
constexpr size_t A_KAS = AR + 228 * MiB, A_VAS = AR + 231 * MiB, A_KBS = AR + 234 * MiB, A_VBS = AR + 244 * MiB;
constexpr size_t A_HID = AR + 32 * MiB;
constexpr size_t A_F = AR + 160 * MiB;
constexpr size_t A_A2 = AR + 32 * MiB;
constexpr size_t A_XS = AR + 208 * MiB;
constexpr size_t A_Y = AR + 32 * MiB;
constexpr size_t A_RKV = AR + 96 * MiB;
constexpr size_t A_L1 = AR + 192 * MiB;
constexpr size_t A_G = A_H;
constexpr size_t A_A0 = AR + 208 * MiB, A_A1 = AR + 240 * MiB, A_EW0 = AR + 272 * MiB, A_EW1 = AR + 304 * MiB;
constexpr size_t WS_END = AR + 336 * MiB;
struct QkvMap { static constexpr size_t oQA = A_QA, oQB = A_QB, oKAP = A_KAP, oVAP = A_VAP, oKBP = A_KBP, oVBP = A_VBP, oKAS = A_KAS, oVAS = A_VAS, oKBS = A_KBS, oVBS = A_VBS, oKG = O_KG, oVG = O_VG, oKD = O_KD, oVD = O_VD; };
constexpr int CW_BAR = 4096;

constexpr int RING_OFF = 0, RING_BYTES = 131072;
constexpr int LDSCTL_OFF = RING_BYTES, MISC_OFF = LDSCTL_OFF + 320;
constexpr int LDS_BYTES = 147456;

typedef float f32x2_t __attribute__((ext_vector_type(2))); typedef __bf16 bf16x2_t __attribute__((ext_vector_type(2)));
__device__ __forceinline__ unsigned pk2(float lo, float hi) { const f32x2_t v = {lo, hi}; return __builtin_bit_cast(unsigned, __builtin_convertvector(v, bf16x2_t)); }
__device__ __forceinline__ unsigned f2bf(float f) { return pk2(f, 0.f) & 0xffffu; }
__device__ __forceinline__ float bf2f(unsigned short h) { return __builtin_bit_cast(float, (unsigned)h << 16); }
__device__ __forceinline__ float bflo(unsigned w) { return __builtin_bit_cast(float, w << 16); }
__device__ __forceinline__ float bfhi(unsigned w) { return __builtin_bit_cast(float, w & 0xffff0000u); }
__device__ __forceinline__ float wave_sum(float v) {
#pragma unroll
    for (int o = 1; o < 64; o <<= 1) v += __shfl_xor(v, o);
    return v;
}
__device__ __forceinline__ float sigmoidf_(float x) { return 1.0f / (1.0f + __expf(-x)); }
__device__ __forceinline__ float rdl(float x, int l) { return __builtin_bit_cast(float, __builtin_amdgcn_readlane(__builtin_bit_cast(int, x), l)); }

#define XB_TMO      128
#define XB_XCNT(j)  (256  + 64 * (j))
#define XB_XSUB(j)  (1280 + 64 * (j))
#define XB_XGEN(j)  (2304 + 64 * (j))
#define XB_TOP      3328
#define XB_TOPGEN   3392
#define XCD_BAR_WORDS 3456
#define XB_SPIN_CAP (1u << 18)

__device__ __forceinline__ unsigned xb_ld(unsigned* p)              { return __hip_atomic_load(p, __ATOMIC_RELAXED, __HIP_MEMORY_SCOPE_AGENT); }
__device__ __forceinline__ unsigned xb_add(unsigned* p, unsigned v) { return __hip_atomic_fetch_add(p, v, __ATOMIC_RELAXED, __HIP_MEMORY_SCOPE_AGENT); }
__device__ __forceinline__ unsigned xb_xcc_id() { return (unsigned)__builtin_amdgcn_s_getreg((3 << 11) | 20) & 0xFu; }
#define XB_SPIN(cond, bar) do { unsigned _sp = 0; while (cond) { __builtin_amdgcn_s_sleep(1); \
    if ((++_sp & 255u) == 0u) { if (xb_ld(&(bar)[XB_TMO])) break; if (_sp > XB_SPIN_CAP) { atomicAdd(&(bar)[XB_TMO], 1u); break; } } } } while (0)

struct XcdBarrier {
    unsigned* bar; unsigned x;
    volatile LAS unsigned* st;
};

__device__ __forceinline__ XcdBarrier xcd_barrier_post(unsigned* bar, volatile LAS unsigned* st, bool leader) {
    XcdBarrier b; b.bar = bar; b.x = xb_xcc_id(); b.st = st;
    if (leader) (void)xb_add(&bar[XB_XCNT(b.x)], 1u);
    return b;
}
__device__ __forceinline__ void xcd_barrier_complete(unsigned* bar, unsigned x, unsigned& nloc, unsigned& nx) {
    const unsigned G = gridDim.x * gridDim.y * gridDim.z;
    unsigned sum, cnt, mine, sp = 0u;
    for (;;) {
        sum = 0u; cnt = 0u; mine = 0u;
#pragma unroll
        for (unsigned j = 0; j < 16; ++j) { const unsigned c = xb_ld(&bar[XB_XCNT(j)]); sum += c; cnt += (c > 0u) ? 1u : 0u; mine = (j == x) ? c : mine; }
        if (sum == G) break;
        __builtin_amdgcn_s_sleep(1);
        if ((++sp & 255u) == 0u) { if (xb_ld(&bar[XB_TMO])) break; if (sp > XB_SPIN_CAP) { atomicAdd(&bar[XB_TMO], 1u); break; } }
    }
    nloc = mine > 0u ? mine : 1u; nx = cnt > 0u ? cnt : 1u;
}

__device__ __forceinline__ void xcd_barrier(const XcdBarrier& b, bool leader) {
    asm volatile("s_waitcnt vmcnt(0)" ::: "memory");
    __syncthreads();
    if (leader) {
        unsigned* bar = b.bar;
        __builtin_amdgcn_s_waitcnt(0);
        unsigned nloc = b.st[0], nx = b.st[1];
        if (nloc == 0u) { xcd_barrier_complete(bar, b.x, nloc, nx); b.st[0] = nloc; b.st[1] = nx; }
        const unsigned old = xb_add(&bar[XB_XSUB(b.x)], 1u);
        const unsigned gen = old / nloc;
        if (old + 1u == (gen + 1u) * nloc) {
            __builtin_amdgcn_fence(__ATOMIC_RELEASE, "agent");
            asm volatile("s_waitcnt vmcnt(0)" ::: "memory");
            const unsigned og = xb_add(&bar[XB_TOP], 1u);
            const unsigned tg = og / nx;
            if (og + 1u == (tg + 1u) * nx) xb_add(&bar[XB_TOPGEN], 1u);
            else XB_SPIN(xb_ld(&bar[XB_TOPGEN]) == tg, bar);
            __builtin_amdgcn_fence(__ATOMIC_ACQUIRE, "agent");
            xb_add(&bar[XB_XGEN(b.x)], 1u);
            asm volatile("s_waitcnt vmcnt(0)" ::: "memory");
        } else {
            XB_SPIN(xb_ld(&bar[XB_XGEN(b.x)]) == gen, bar);
            __builtin_amdgcn_fence(__ATOMIC_ACQUIRE, "agent");
            asm volatile("s_waitcnt vmcnt(0)" ::: "memory");
        }
    }
    __syncthreads();
}

struct Args { const float* in[32]; float* out; unsigned char* ws; int ph_lo, ph_hi; };
struct Ids { int tid, lane, wave, gw, ngw, z; };

__device__ __forceinline__ int cond_of(int m) { return m < NPR ? 4 : ((m - NPR) >> 11); }
__device__ __forceinline__ const float* mod_ptr_(const Args& a, const Ids& id, int cond, int layer) { return (const float*)(a.ws + id.z + WS_MOD) + (size_t)(cond * 4 + layer) * 6144; }

__device__ __forceinline__ void tr_item(const float* W, int ldw, int col0, const float* scale, bf16* WT, int ldt, int drow0, int dcol0, LAS float* scr, int kb, int nb, int lane, int dnb = -1) {
    const int k0 = 64 * kb, n0 = 32 * nb, dn0 = 32 * (dnb < 0 ? nb : dnb);
#pragma unroll 8
    for (int i = 0; i < 32; ++i) { const int kk = 2 * i + (lane >> 5); float v = W[(size_t)(k0 + kk) * ldw + col0 + n0 + (lane & 31)]; if (scale) v *= scale[k0 + kk]; scr[kk * 33 + (lane & 31)] = v; }
    LDS_WAIT(); asm volatile("" ::: "memory");
    const int c = lane & 7;
#pragma unroll
    for (int j = 0; j < 4; ++j) { const int n = (lane >> 3) + 8 * j; const LAS float* s = scr + (8 * c) * 33 + n;
        v4u o; o.x = pk2(s[0 * 33], s[1 * 33]); o.y = pk2(s[2 * 33], s[3 * 33]); o.z = pk2(s[4 * 33], s[5 * 33]); o.w = pk2(s[6 * 33], s[7 * 33]);
        *(v4u*)(WT + (size_t)(drow0 + dn0 + n) * ldt + dcol0 + k0 + 8 * c) = o; }
    LDS_WAIT(); asm volatile("" ::: "memory");
}
__device__ __forceinline__ bool tr_matrix(int& r, const float* W, int K, int N, bf16* WT, LAS float* scr, int lane) {
    const int nblk = N / 32, items = (K / 64) * nblk;
    if (r < items) { tr_item(W, N, 0, nullptr, WT, K, 0, 0, scr, r / nblk, r % nblk, lane); return true; }
    r -= items; return false;
}
__device__ __forceinline__ bool tr_rwproj(int& r, const float* W, int ncols, const float* mu, bf16* BT1, int drow0, LAS float* scr, int lane) {
    const int nblk = ncols / 32, items = 16 * nblk * 2;
    if (r < items) { const int half = r / (16 * nblk), q = r % (16 * nblk); tr_item(W, ncols, 0, half ? mu : nullptr, BT1, KRKV, drow0, half * 1024, scr, q / nblk, q % nblk, lane); return true; }
    r -= items; return false;
}
__device__ __forceinline__ void conv_weights(const Args& a, const Ids& id, LAS unsigned char* lds, int layer, int parts = 3) {
    LAS float* scr = (LAS float*)(lds + id.wave * 16384);
    const int j = layer >> 1;
    bf16* W1T = (bf16*)(a.ws + id.z + W_W1T); bf16* W2T = (bf16*)(a.ws + id.z + W_W2T);
    const float* mw1 = a.in[30 + id.z] + (size_t)layer * D * FF; const float* mw2 = a.in[31 + id.z] + (size_t)layer * D * FF;
    if ((layer & 1) == 0) {
        bf16* WINT = (bf16*)(a.ws + id.z + W_WINT); bf16* WOUTT = (bf16*)(a.ws + id.z + W_WOUTT);
        const float* win = a.in[12 + id.z] + (size_t)j * D * NQKV; const float* wout = a.in[13 + id.z] + (size_t)j * D * D;
        const int lo = (parts & 2) ? 0 : 4096, hi = (parts & 1) ? 2048 + 2048 + 1152 + 512 : 4096;
        for (int it = lo + id.gw; it < hi; it += id.ngw) {
            int r = it;
            if (tr_matrix(r, mw1, D, FF, W1T, scr, id.lane)) continue;
            if (tr_matrix(r, mw2, FF, D, W2T, scr, id.lane)) continue;
            if (r < 1152) {
                const int kb = r / 72, nb = r % 72; tr_item(win, NQKV, 0, nullptr, WINT, D, 0, 0, scr, kb, nb, id.lane, (nb & ~7) + 4 * (nb & 1) + ((nb >> 1) & 3)); continue; }
            r -= 1152;
            tr_matrix(r, wout, D, D, WOUTT, scr, id.lane);
        }
    } else {
        bf16* BTR = (bf16*)(a.ws + id.z + W_BTR); bf16* BT1 = (bf16*)(a.ws + id.z + W_BTL); bf16* WOT = (bf16*)(a.ws + id.z + W_WOT);
        const float* mu = a.in[17 + id.z] + (size_t)j * 6 * D;
        const float* wrkv = a.in[18 + id.z] + (size_t)j * 3 * D * D;
        const float* w1 = a.in[21 + id.z] + (size_t)j * 2 * D * 64; const float* a1 = a.in[24 + id.z] + (size_t)j * 2 * D * 64; const float* g1 = a.in[26 + id.z] + (size_t)j * D * 128;
        const float* wo = a.in[19 + id.z] + (size_t)j * D * D;
        bf16* BT2 = (bf16*)(a.ws + id.z + W_BT2); const float* w2 = a.in[22 + id.z] + (size_t)j * 2 * 64 * D; const float* a2 = a.in[25 + id.z] + (size_t)j * 2 * 64 * D; const float* g2 = a.in[27 + id.z] + (size_t)j * 128 * D;
        const int total = 2048 + 2048 + 1536 + 256 + 128 + 512 + 128 + 4 * 32 + 64 + 5120;
        for (int it = id.gw; it < total; it += id.ngw) {
            int r = it;
            if (tr_matrix(r, mw1, D, FF, W1T, scr, id.lane)) continue;
            if (tr_matrix(r, mw2, FF, D, W2T, scr, id.lane)) continue;
            if (tr_matrix(r, wrkv, D, D, BTR, scr, id.lane)) continue;
            if (tr_matrix(r, wrkv + (size_t)D * D, D, D, BTR + (size_t)D * D, scr, id.lane)) continue;
            if (tr_matrix(r, wrkv + (size_t)2 * D * D, D, D, BTR + (size_t)2 * D * D, scr, id.lane)) continue;
            if (tr_rwproj(r, w1, 64, mu + 1 * D, BT1, 0, scr, id.lane)) continue;
            if (tr_rwproj(r, w1 + (size_t)D * 64, 64, mu + 1 * D, BT1, 64, scr, id.lane)) continue;
            if (tr_rwproj(r, a1, 64, mu + 4 * D, BT1, 128, scr, id.lane)) continue;
            if (tr_rwproj(r, a1 + (size_t)D * 64, 64, mu + 4 * D, BT1, 192, scr, id.lane)) continue;
            if (tr_rwproj(r, g1, 128, mu + 5 * D, BT1, 256, scr, id.lane)) continue;
            if (tr_matrix(r, wo, D, D, WOT, scr, id.lane)) continue;
            if (r < 128) {
                v4u z = (v4u){0u, 0u, 0u, 0u}; v4u* p = (v4u*)(BT1 + (size_t)(384 + r) * KRKV);
#pragma unroll
                for (int q = 0; q < 4; ++q) p[id.lane + 64 * q] = z;
                continue; }
            r -= 128;
            if (r < 128) { const int i = r >> 5, q = r & 31; const float* W = (i < 2 ? a2 : w2) + (size_t)(i & 1) * 64 * D; tr_item(W, D, 0, nullptr, BT2, 384, 1024 * i, 64 * (i ^ 2), scr, 0, q, id.lane); continue; }
            r -= 128;
            if (r < 64) { tr_item(g2, D, 0, nullptr, BT2, 384, 4096, 256, scr, r >> 5, r & 31, id.lane); continue; }
            r -= 64;
            { const int blk = r >> 10; const int c0 = (blk < 4) ? 8 * (blk ^ 2) : 32, c1 = (blk < 4) ? 8 * (blk ^ 2) + 8 : 48;
              if (id.lane < 48 && (id.lane < c0 || id.lane >= c1)) *(v4u*)(BT2 + (size_t)r * 384 + 8 * id.lane) = (v4u){0u, 0u, 0u, 0u}; }
        }
    }
}

struct RowV { f32x4 v[4]; };
__device__ __forceinline__ void ld_row(RowV& r, const float* p, int lane) {
#pragma unroll
    for (int j = 0; j < 4; ++j) r.v[j] = ((const f32x4*)p)[lane + 64 * j];
}
__device__ __forceinline__ void ld_row_bf16(RowV& r, const bf16* p, int lane) {
#pragma unroll
    for (int j = 0; j < 4; ++j) { const v2u w = ((const v2u*)p)[lane + 64 * j]; r.v[j] = (f32x4){bflo(w.x), bfhi(w.x), bflo(w.y), bfhi(w.y)}; }
}
__device__ __forceinline__ void st_row(const RowV& r, float* p, int lane) {
#pragma unroll
    for (int j = 0; j < 4; ++j) ((f32x4*)p)[lane + 64 * j] = r.v[j];
}
__device__ __forceinline__ void st_row_bf16(const RowV& r, bf16* p, int lane) {
#pragma unroll
    for (int j = 0; j < 4; ++j) { v2u w; w.x = pk2(r.v[j][0], r.v[j][1]); w.y = pk2(r.v[j][2], r.v[j][3]); ((v2u*)p)[lane + 64 * j] = w; }
}
__device__ __forceinline__ float row_rinv(const RowV& r) {
    float s = 0.f;
#pragma unroll
    for (int j = 0; j < 4; ++j) s += (r.v[j][0] * r.v[j][0] + r.v[j][1] * r.v[j][1]) + (r.v[j][2] * r.v[j][2] + r.v[j][3] * r.v[j][3]);
    s = wave_sum(s);
    return 1.0f / sqrtf(s * (1.0f / 1024.0f) + 1e-6f);
}
__device__ __forceinline__ void norm_mod(RowV& h, const RowV& x, const float* g, const float* sc, const float* sh, int lane) {
    const float ri = row_rinv(x);
#pragma unroll
    for (int j = 0; j < 4; ++j) { const f32x4 gv = ((const f32x4*)g)[lane + 64 * j], scv = ((const f32x4*)sc)[lane + 64 * j], shv = ((const f32x4*)sh)[lane + 64 * j];
        h.v[j] = (x.v[j] * ri) * gv * (scv + 1.0f) + shv; }
}
__device__ __forceinline__ void resid_add(RowV& x, const RowV& m, const float* g, const float* gt, int lane) {
    const float ri = row_rinv(m);
#pragma unroll
    for (int j = 0; j < 4; ++j) { const f32x4 gv = ((const f32x4*)g)[lane + 64 * j], gtv = ((const f32x4*)gt)[lane + 64 * j];
        x.v[j] = x.v[j] + gtv * ((m.v[j] * ri) * gv); }
}

__device__ __forceinline__ float rope_inv(int jj) {
    const float t[16] = {1.0f, 0.5623413324356079f, 0.3162277638912201f, 0.17782793939113617f, 0.10000000149011612f, 0.05623412877321243f, 0.03162277862429619f, 0.017782794311642647f,
                         0.009999999776482582f, 0.005623413249850273f, 0.003162277862429619f, 0.0017782794311642647f, 0.0010000000474974513f, 0.000562341301701963f, 0.0003162277862429619f, 0.00017782794020604342f};
    float r = t[0];
#pragma unroll
    for (int i = 1; i < 16; ++i) r = (jj == i) ? t[i] : r;
    return r;
}
__device__ __forceinline__ void ph_prologue(const Args& a, const Ids& id, LAS unsigned char* lds) {
    float* MOD = (float*)(a.ws + id.z + WS_MOD);
    { LAS float* red = (LAS float*)lds;
      for (int it = blockIdx.x; it < 4 * 96; it += gridDim.x) {
        const int i = it / 96, n = (it % 96) * 64 + id.lane;
        float acc[5];
#pragma unroll
        for (int c = 0; c < 5; ++c) acc[c] = 0.f;
        const float* W = a.in[9 + id.z] + (size_t)i * 1024 * 6144 + n;
#pragma unroll 1
        for (int k0 = 128 * id.wave; k0 < 128 * id.wave + 128; k0 += 64) {
            float sv[5];
#pragma unroll
            for (int c = 0; c < 5; ++c) { const float x = (c < 4) ? a.in[2 + id.z][c * 1024 + k0 + id.lane] : a.in[8 + id.z][k0 + id.lane]; sv[c] = x / (1.0f + __expf(-x)); }
#pragma unroll 16
            for (int kk = 0; kk < 64; ++kk) { const float w = W[(size_t)(k0 + kk) * 6144];
#pragma unroll
                for (int c = 0; c < 5; ++c) acc[c] += w * __shfl(sv[c], kk); }
        }
#pragma unroll
        for (int c = 0; c < 5; ++c) red[(id.wave * 5 + c) * 64 + id.lane] = acc[c];
        __syncthreads();
        if (id.wave < 5) { float s = a.in[10 + id.z][i * 6144 + n];
#pragma unroll
            for (int w8 = 0; w8 < 8; ++w8) s += red[(w8 * 5 + id.wave) * 64 + id.lane];
            MOD[(size_t)(id.wave * 4 + i) * 6144 + n] = s; }
        __syncthreads();
      } }
    { float* RC = (float*)(a.ws + id.z + WS_ROPE); float* RS = RC + 2048 * 64;
      for (int e = id.gw * 64 + id.lane; e < 2048 * 64; e += id.ngw * 64) { const int t = e >> 6, d = e & 63; const int pos = (d < 32) ? (t >> 6) : (t & 63);
          const float ang = (float)pos * rope_inv(d & 15); RC[e] = __cosf(ang); RS[e] = __sinf(ang); } }
    conv_weights(a, id, lds, 0, 1);
}

struct RawBf { v2u v[4]; };
__device__ __forceinline__ void ld_raw_bf(RawBf& r, const bf16* p, int lane) {
#pragma unroll
    for (int j = 0; j < 4; ++j) r.v[j] = ((const v2u*)p)[lane + 64 * j];
}
__device__ __forceinline__ void cvt_raw_bf(RowV& o, const RawBf& r) {
#pragma unroll
    for (int j = 0; j < 4; ++j) o.v[j] = (f32x4){bflo(r.v[j].x), bfhi(r.v[j].x), bflo(r.v[j].y), bfhi(r.v[j].y)};
}
__device__ __forceinline__ const float* x_row_ptr(const Args& a, const Ids& id, int layer, int m) {
    return (layer == 0) ? ((m < NPR) ? a.in[0 + id.z] + (size_t)m * D : a.in[1 + id.z] + (size_t)(m - NPR) * D) : a.out + id.z + O_X + (size_t)m * D;
}
__device__ __forceinline__ void ph_norm0(const Args& a, const Ids& id) {
    bf16* H = (bf16*)(a.ws + id.z + A_H); const float* g0 = a.in[11 + id.z] + (size_t)(0 * 4 + 0) * D;
    int m = id.gw; RowV xn; if (m < NTOK) ld_row(xn, x_row_ptr(a, id, 0, m), id.lane);
    for (; m < NTOK; m += id.ngw) { RowV x = xn, h; if (m + id.ngw < NTOK) ld_row(xn, x_row_ptr(a, id, 0, m + id.ngw), id.lane);
        const float* md = mod_ptr_(a, id, cond_of(m), 0);
        norm_mod(h, x, g0, md + 1024, md + 0, id.lane); st_row_bf16(h, H + (size_t)m * D, id.lane); }
}
__device__ __forceinline__ void ph_resid_norm(const Args& a, const Ids& id, int layer, bool dummy = false) {
    bf16* H = (bf16*)(a.ws + id.z + (dummy ? AR + 224 * MiB : A_H)); float* xout = dummy ? (float*)(a.ws + id.z + A_F) : a.out + id.z + O_X; const bf16* M = (const bf16*)(a.ws + id.z + A_M); const float* g1 = a.in[11 + id.z] + (size_t)(layer * 4 + 1) * D; const float* g2 = a.in[11 + id.z] + (size_t)(layer * 4 + 2) * D;
    int m = id.gw; RowV xn; RawBf mn; if (m < NTOK) { ld_row(xn, x_row_ptr(a, id, layer, m), id.lane); ld_raw_bf(mn, M + (size_t)m * D, id.lane); }
    for (; m < NTOK; m += id.ngw) { RowV x = xn, mm, h; cvt_raw_bf(mm, mn);
        if (m + id.ngw < NTOK) { ld_row(xn, x_row_ptr(a, id, layer, m + id.ngw), id.lane); ld_raw_bf(mn, M + (size_t)(m + id.ngw) * D, id.lane); }
        const float* md = mod_ptr_(a, id, cond_of(m), layer);
        resid_add(x, mm, g1, md + 2048, id.lane); st_row(x, xout + (size_t)m * D, id.lane);
        norm_mod(h, x, g2, md + 4096, md + 3072, id.lane); st_row_bf16(h, H + (size_t)m * D, id.lane); }
}
__device__ __forceinline__ void ph_resid_end(const Args& a, const Ids& id, LAS unsigned char* lds, int layer, bool dummy = false) {
    bf16* H = (bf16*)(a.ws + id.z + (dummy ? AR + 96 * MiB : A_H)); float* xout = dummy ? (float*)(a.ws + id.z + AR + 32 * MiB) : a.out + id.z + O_X; const bf16* F = (const bf16*)(a.ws + id.z + A_F); const float* g3 = a.in[11 + id.z] + (size_t)(layer * 4 + 3) * D;
    const bool next_attn = (layer + 1 < DEPTH) && (((layer + 1) & 1) == 0);
    const float* g0n = a.in[11 + id.z] + (size_t)((layer + 1) * 4 + 0) * D;
    int m = id.gw; RowV xn; RawBf fn; if (m < NTOK) { ld_row(xn, a.out + id.z + O_X + (size_t)m * D, id.lane); ld_raw_bf(fn, F + (size_t)m * D, id.lane); }
    for (; m < NTOK; m += id.ngw) { RowV x = xn, ff; cvt_raw_bf(ff, fn);
        if (m + id.ngw < NTOK) { ld_row(xn, a.out + id.z + O_X + (size_t)(m + id.ngw) * D, id.lane); ld_raw_bf(fn, F + (size_t)(m + id.ngw) * D, id.lane); }
        const float* md = mod_ptr_(a, id, cond_of(m), layer);
        resid_add(x, ff, g3, md + 5120, id.lane); st_row(x, xout + (size_t)m * D, id.lane);
        if (next_attn) { RowV h; const float* mdn = mod_ptr_(a, id, cond_of(m), layer + 1); norm_mod(h, x, g0n, mdn + 1024, mdn + 0, id.lane); st_row_bf16(h, H + (size_t)m * D, id.lane); } }
    if (layer + 1 < DEPTH) conv_weights(a, id, lds, layer + 1, next_attn ? 1 : 3);
}
__device__ __forceinline__ void ph_rw_mix(const Args& a, const Ids& id, int layer) {
    bf16* A2 = (bf16*)(a.ws + id.z + A_A2); bf16* XS = (bf16*)(a.ws + id.z + A_XS); const float* g0 = a.in[11 + id.z] + (size_t)(layer * 4 + 0) * D; const float* mu6 = a.in[17 + id.z] + (size_t)(layer >> 1) * 6 * D;
    for (int g8 = id.gw; g8 < NTOK / 8; g8 += id.ngw) {
        const int m0 = g8 * 8; const int t0 = (m0 < NPR) ? (m0 & (TP - 1)) : ((m0 - NPR) & (TS - 1)); const int T = (m0 < NPR) ? TP : TS;
        const float* md = mod_ptr_(a, id, cond_of(m0), layer); const float* xp = a.out + id.z + O_X + (size_t)m0 * D;
        RowV hp, hc, hn, xr;
#pragma unroll
        for (int q = 0; q < 4; ++q) hp.v[q] = (f32x4){0.f, 0.f, 0.f, 0.f};
        if (t0 > 0) { ld_row(xr, xp - D, id.lane); norm_mod(hp, xr, g0, md + 1024, md + 0, id.lane); }
        ld_row(xr, xp, id.lane); norm_mod(hc, xr, g0, md + 1024, md + 0, id.lane);
#pragma unroll 1
        for (int i = 0; i < 8; ++i) {
#pragma unroll
            for (int q = 0; q < 4; ++q) hn.v[q] = (f32x4){0.f, 0.f, 0.f, 0.f};
            if (t0 + i + 1 < T) { ld_row(xr, xp + (size_t)(i + 1) * D, id.lane); norm_mod(hn, xr, g0, md + 1024, md + 0, id.lane); }
            RowV xx;
#pragma unroll
            for (int q = 0; q < 4; ++q) xx.v[q] = (hp.v[q] + hn.v[q]) * 0.5f - hc.v[q];
            st_row_bf16(hc, A2 + (size_t)(m0 + i) * KRKV, id.lane); st_row_bf16(xx, A2 + (size_t)(m0 + i) * KRKV + D, id.lane);
#pragma unroll
            for (int p = 0; p < 3; ++p) { const float* mu = mu6 + (size_t)(p == 0 ? 0 : p + 1) * D; RowV xm;
#pragma unroll
                for (int q = 0; q < 4; ++q) xm.v[q] = hc.v[q] + xx.v[q] * ((const f32x4*)mu)[id.lane + 64 * q];
                st_row_bf16(xm, XS + ((size_t)p * NTOK + m0 + i) * D, id.lane); }
            hp = hc; hc = hn;
        }
    }
}

__device__ __forceinline__ void row16_sum4(float& a, float& b, float& c, float& d) {
    asm("s_nop 1\n\t"
        "v_add_f32_dpp %0, %0, %0 row_ror:8 row_mask:0xf bank_mask:0xf\n\tv_add_f32_dpp %1, %1, %1 row_ror:8 row_mask:0xf bank_mask:0xf\n\tv_add_f32_dpp %2, %2, %2 row_ror:8 row_mask:0xf bank_mask:0xf\n\tv_add_f32_dpp %3, %3, %3 row_ror:8 row_mask:0xf bank_mask:0xf\n\t"
        "v_add_f32_dpp %0, %0, %0 row_ror:4 row_mask:0xf bank_mask:0xf\n\tv_add_f32_dpp %1, %1, %1 row_ror:4 row_mask:0xf bank_mask:0xf\n\tv_add_f32_dpp %2, %2, %2 row_ror:4 row_mask:0xf bank_mask:0xf\n\tv_add_f32_dpp %3, %3, %3 row_ror:4 row_mask:0xf bank_mask:0xf\n\t"
        "v_add_f32_dpp %0, %0, %0 row_ror:2 row_mask:0xf bank_mask:0xf\n\tv_add_f32_dpp %1, %1, %1 row_ror:2 row_mask:0xf bank_mask:0xf\n\tv_add_f32_dpp %2, %2, %2 row_ror:2 row_mask:0xf bank_mask:0xf\n\tv_add_f32_dpp %3, %3, %3 row_ror:2 row_mask:0xf bank_mask:0xf\n\t"
        "v_add_f32_dpp %0, %0, %0 row_ror:1 row_mask:0xf bank_mask:0xf\n\tv_add_f32_dpp %1, %1, %1 row_ror:1 row_mask:0xf bank_mask:0xf\n\tv_add_f32_dpp %2, %2, %2 row_ror:1 row_mask:0xf bank_mask:0xf\n\tv_add_f32_dpp %3, %3, %3 row_ror:1 row_mask:0xf bank_mask:0xf"
        : "+v"(a), "+v"(b), "+v"(c), "+v"(d));
}
__device__ __forceinline__ f32x4 ld_bf4(const bf16* p) { const v2u w = *(const v2u*)p; return (f32x4){bflo(w.x), bfhi(w.x), bflo(w.y), bfhi(w.y)}; }
__device__ __forceinline__ void ph_att_cache(const Args& a, const Ids& id, int layer) {
    const int j = layer >> 1, lane = id.lane;
    bf16 *KAS = (bf16*)(a.ws + id.z + A_KAS), *VAS = (bf16*)(a.ws + id.z + A_VAS), *KBS = (bf16*)(a.ws + id.z + A_KBS), *VBS = (bf16*)(a.ws + id.z + A_VBS);
    for (int r = id.gw; r < 4 * PAST; r += id.ngw) {
        const int b = r >> 9, pos = r & (PAST - 1);
        const size_t src = (size_t)((b * 2 + j) * PAST + pos), dst = (size_t)(b * SKV + pos);
#pragma unroll
        for (int q = 0; q < 2; ++q) { const int e = lane + 64 * q; KAS[dst * 128 + e] = (bf16)f2bf(a.in[3 + id.z][src * 128 + e]); VAS[dst * 128 + e] = (bf16)f2bf(a.in[4 + id.z][src * 128 + e]); }
#pragma unroll
        for (int q = 0; q < 8; ++q) { const int e = lane + 64 * q; KBS[dst * 512 + e] = (bf16)f2bf(a.in[5 + id.z][src * 512 + e]); VBS[dst * 512 + e] = (bf16)f2bf(a.in[6 + id.z][src * 512 + e]); }
    }
}

typedef short bf16x8_t __attribute__((ext_vector_type(8)));
typedef float f32x16 __attribute__((ext_vector_type(16)));
typedef short v4i16_t __attribute__((ext_vector_type(4)));
constexpr float AT_THR = 8.0f;
constexpr int AT_KP = 144, AT_KBUF = 64 * AT_KP, AT_VOFF = 2 * AT_KBUF, AT_VBUFMAX = 64 * 288, AT_WSF = AT_VOFF + 2 * AT_VBUFMAX;
static_assert(AT_WSF + 8 * 128 <= RING_BYTES, "attention LDS");
template <int NDT>
__device__ __forceinline__ void attn_unit(const bf16* Qrow0, int ldq, const bf16* Kb, int ldk, const bf16* Vb, int ldv, int S, bf16* Obf, bf16* Od, int ldo, LAS unsigned char* lds, const Ids& id) {
    constexpr int VP = (NDT == 2) ? 144 : 288, NVL = NDT / 2;
    const int lane = id.lane, w = id.wave, r32 = lane & 31, hi = lane >> 5, tid = id.tid;
    bf16x8_t qf[4];
    { const bf16* qrow = Qrow0 + (size_t)(32 * w + r32) * ldq;
#pragma unroll
      for (int s = 0; s < 4; ++s) qf[s] = *(const bf16x8_t*)(qrow + 16 * s + 8 * hi); }
    f32x16 o[NDT];
#pragma unroll
    for (int dt = 0; dt < NDT; ++dt)
#pragma unroll
        for (int r = 0; r < 16; ++r) o[dt][r] = 0.f;
    float m_run = 0.f, l_run = 0.f;
    const int NT = S >> 6;
    LAS float* wsf = (LAS float*)(lds + AT_WSF + w * 128);
    const int krow = tid >> 3, kch = tid & 7;
    v4u kreg, vreg[NVL];
#define AT_GLOAD(t) do { kreg = *(const v4u*)(Kb + (size_t)((t) * 64 + krow) * ldk + 8 * kch); \
        if (NDT == 2) vreg[0] = *(const v4u*)(Vb + (size_t)((t) * 64 + krow) * ldv + 8 * kch); \
        else { _Pragma("unroll") for (int i_ = 0; i_ < NVL; ++i_) { const int ix_ = tid + 512 * i_; vreg[i_] = *(const v4u*)(Vb + (size_t)((t) * 64 + (ix_ >> 4)) * ldv + 8 * (ix_ & 15)); } } } while (0)
#define AT_LSTORE(b) do { *(LAS v4u*)(lds + (b) * AT_KBUF + krow * AT_KP + 16 * kch) = kreg; \
        if (NDT == 2) *(LAS v4u*)(lds + AT_VOFF + (b) * AT_VBUFMAX + krow * VP + 16 * kch) = vreg[0]; \
        else { _Pragma("unroll") for (int i_ = 0; i_ < NVL; ++i_) { const int ix_ = tid + 512 * i_; *(LAS v4u*)(lds + AT_VOFF + (b) * AT_VBUFMAX + (ix_ >> 4) * VP + 16 * (ix_ & 15)) = vreg[i_]; } } } while (0)
    AT_GLOAD(0); AT_LSTORE(0);
    __syncthreads();
    const int vbase = (4 * hi + ((lane & 15) >> 2)) * VP + 32 * ((lane >> 4) & 1) + 8 * (lane & 3);
#pragma unroll 1
    for (int t = 0; t < NT; ++t) {
        const int b = t & 1;
        if (t + 1 < NT) AT_GLOAD(t + 1);
        const LAS unsigned char* Kt = lds + b * AT_KBUF + r32 * AT_KP + 16 * hi;
        const LAS unsigned char* Vt = lds + AT_VOFF + b * AT_VBUFMAX + vbase;
        f32x16 p0, p1;
        { const float nm = -m_run;
#pragma unroll
          for (int r = 0; r < 16; ++r) { p0[r] = nm; p1[r] = nm; } }
#pragma unroll
        for (int s = 0; s < 4; ++s) { const bf16x8_t k0 = *(const LAS bf16x8_t*)(Kt + 32 * s), k1 = *(const LAS bf16x8_t*)(Kt + 32 * AT_KP + 32 * s);
            p0 = __builtin_amdgcn_mfma_f32_32x32x16_bf16(k0, qf[s], p0, 0, 0, 0); p1 = __builtin_amdgcn_mfma_f32_32x32x16_bf16(k1, qf[s], p1, 0, 0, 0); }
        float mx = __builtin_fmaxf(p0[0], p1[0]);
#pragma unroll
        for (int r = 1; r < 16; ++r) mx = __builtin_fmaxf(__builtin_fmaxf(mx, p0[r]), p1[r]);
        mx = fmaxf(mx, __shfl_xor(mx, 32));
        if (t == 0 || __any(mx > AT_THR)) {
            const float dl = (t == 0) ? mx : fmaxf(mx, 0.f), al = __builtin_amdgcn_exp2f(-dl); m_run += dl; l_run *= al;
#pragma unroll
            for (int r = 0; r < 16; ++r) { p0[r] -= dl; p1[r] -= dl; }
            if (hi == 0) wsf[r32] = al;
            LDS_WAIT(); asm volatile("" ::: "memory");
            { f32x4 a4[4];
#pragma unroll
              for (int g4 = 0; g4 < 4; ++g4) a4[g4] = *(const LAS f32x4*)(wsf + 8 * g4 + 4 * hi);
#pragma unroll
              for (int dt = 0; dt < NDT; ++dt)
#pragma unroll
                  for (int r = 0; r < 16; ++r) o[dt][r] *= a4[r >> 2][r & 3]; }
            LDS_WAIT(); asm volatile("" ::: "memory");
        }
        float rs = 0.f;
#pragma unroll
        for (int r = 0; r < 16; ++r) { p0[r] = __builtin_amdgcn_exp2f(p0[r]); p1[r] = __builtin_amdgcn_exp2f(p1[r]); rs += p0[r] + p1[r]; }
        l_run += rs;
        bf16x8_t pf[4];
#pragma unroll
        for (int ks = 0; ks < 4; ++ks) { v4u pw;
#pragma unroll
            for (int dd = 0; dd < 4; ++dd) { const int r = 8 * (ks & 1) + 2 * dd; pw[dd] = (ks < 2) ? pk2(p0[r], p0[r + 1]) : pk2(p1[r], p1[r + 1]); }
            pf[ks] = __builtin_bit_cast(bf16x8_t, pw); }
#pragma unroll
        for (int ks = 0; ks < 4; ++ks)
#pragma unroll
            for (int dt = 0; dt < NDT; ++dt) {
                const v4i16_t lo = __builtin_amdgcn_ds_read_tr16_b64_v4i16((LAS v4i16_t*)(Vt + (16 * ks) * VP + 64 * dt));
                const v4i16_t hh = __builtin_amdgcn_ds_read_tr16_b64_v4i16((LAS v4i16_t*)(Vt + (16 * ks + 8) * VP + 64 * dt));
                const bf16x8_t vf = (bf16x8_t){lo[0], lo[1], lo[2], lo[3], hh[0], hh[1], hh[2], hh[3]};
                o[dt] = __builtin_amdgcn_mfma_f32_32x32x16_bf16(pf[ks], vf, o[dt], 0, 0, 0); }
        if (t + 1 < NT) AT_LSTORE(b ^ 1);
        __syncthreads();
    }
#undef AT_GLOAD
#undef AT_LSTORE
    const float lt = l_run + __shfl_xor(l_run, 32);
    int lane_e = lane; asm volatile("" : "+v"(lane_e));
    const int r32e = lane_e & 31, hie = lane_e >> 5;
    if (hi == 0) wsf[r32] = 1.0f / lt;
    LDS_WAIT(); asm volatile("" ::: "memory");
    f32x4 a4[4];
#pragma unroll
    for (int g4 = 0; g4 < 4; ++g4) a4[g4] = *(const LAS f32x4*)(wsf + 8 * g4 + 4 * hi);
    LDS_WAIT(); asm volatile("" ::: "memory");
#pragma unroll
    for (int dt = 0; dt < NDT; ++dt)
#pragma unroll
        for (int r = 0; r < 16; ++r) { const float val = o[dt][r] * a4[r >> 2][r & 3]; const int off = (32 * w + (r & 3) + 8 * (r >> 2) + 4 * hie) * ldo + 32 * dt + r32e;
            (NDT == 2 ? Obf : Od)[off] = (bf16)f2bf(val); }
}
__device__ __forceinline__ void ph_attn(const Args& a, const Ids& id, LAS unsigned char* lds, int G, int vcu) {
    const bf16 *QA = (const bf16*)(a.ws + id.z + A_QA), *QB = (const bf16*)(a.ws + id.z + A_QB), *KAP = (const bf16*)(a.ws + id.z + A_KAP), *VAP = (const bf16*)(a.ws + id.z + A_VAP), *KBP = (const bf16*)(a.ws + id.z + A_KBP), *VBP = (const bf16*)(a.ws + id.z + A_VBP);
    const bf16 *KAS = (const bf16*)(a.ws + id.z + A_KAS), *VAS = (const bf16*)(a.ws + id.z + A_VAS), *KBS = (const bf16*)(a.ws + id.z + A_KBS), *VBS = (const bf16*)(a.ws + id.z + A_VBS);
    bf16* H = (bf16*)(a.ws + id.z + A_H); bf16* DT = (bf16*)(a.ws + id.z + A_DT);
    for (int s = vcu; s < 256; s += G) {
        const int h8 = s & 7;
#pragma unroll 1
        for (int pass = 0; pass < 2; ++pass) {
            size_t m0, kvrow; int S;
            if (pass == 0) { const int b = s >> 6, qb = (s >> 3) & 7; m0 = (size_t)NPR + b * TS + qb * 256; kvrow = (size_t)b * SKV; S = SKV; }
            else { const int b = s >> 3; m0 = (size_t)b * TP; kvrow = m0; S = TP; }
            const bf16* Ka = (pass == 0 ? KAS : KAP) + kvrow * 128 + (h8 >> 2) * 64; const bf16* Va = (pass == 0 ? VAS : VAP) + kvrow * 128 + (h8 >> 2) * 64;
            const bf16* Kd = (pass == 0 ? KBS : KBP) + kvrow * 512 + h8 * 64; const bf16* Vd = (pass == 0 ? VBS : VBP) + kvrow * 512 + (h8 >> 1) * 128;
            attn_unit<2>(QA + m0 * 512 + h8 * 64, 512, Ka, 128, Va, 128, S, H + m0 * D + h8 * 64, nullptr, D, lds, id);
            attn_unit<4>(QB + m0 * 512 + h8 * 64, 512, Kd, 512, Vd, 512, S, nullptr, DT + m0 * D + h8 * 128, D, lds, id);
        }
    }
}
__device__ __forceinline__ void ph_att_comb(const Args& a, const Ids& id, int layer) {
    const int j = layer >> 1, lane = id.lane; const float lam_init = (layer == 0) ? 0.2f : 0.4707130183435842f;
    const float* lf = a.in[15 + id.z] + j * 256; const float* sg = a.in[16 + id.z] + j * 128;
    const float s01 = wave_sum(lf[lane] * lf[64 + lane]), s23 = wave_sum(lf[128 + lane] * lf[192 + lane]);
    const float lam = expf(s01) - expf(s23) + lam_init;
    const bf16* DT = (const bf16*)(a.ws + id.z + A_DT); bf16* H = (bf16*)(a.ws + id.z + A_H);
    const f32x4 gg = *(const f32x4*)(sg + 4 * (lane & 31)) * (1.0f - lam_init);
    for (int m = id.gw; m < NTOK; m += id.ngw) {
        f32x4 v[4];
#pragma unroll
        for (int hd = 0; hd < 4; ++hd) v[hd] = ld_bf4(DT + (size_t)m * D + 256 * hd + 4 * lane);
        float ss[4];
#pragma unroll
        for (int hd = 0; hd < 4; ++hd) { f32x4 o; o[0] = __shfl_xor(v[hd][0], 32); o[1] = __shfl_xor(v[hd][1], 32); o[2] = __shfl_xor(v[hd][2], 32); o[3] = __shfl_xor(v[hd][3], 32);
            v[hd] = v[hd] - o * lam;
            ss[hd] = (lane < 32) ? (v[hd][0] * v[hd][0] + v[hd][1] * v[hd][1]) + (v[hd][2] * v[hd][2] + v[hd][3] * v[hd][3]) : 0.f; }
        row16_sum4(ss[0], ss[1], ss[2], ss[3]);
#pragma unroll
        for (int hd = 0; hd < 4; ++hd) { const float tot = ss[hd] + __shfl_xor(ss[hd], 16); const float ri = 1.0f / sqrtf(tot * (1.0f / 128.0f) + 1e-6f); const f32x4 o = v[hd] * ri * gg;
            if (lane < 32) *(v2u*)(H + (size_t)m * D + 512 + hd * 128 + 4 * lane) = (v2u){pk2(o[0], o[1]), pk2(o[2], o[3])}; }
    }
}

__device__ __forceinline__ void ph_rw_prep(const Args& a, const Ids& id, int layer) {
    const int j = layer >> 1, lane = id.lane;
    const bf16* RKV = (const bf16*)(a.ws + id.z + A_RKV); float* INV = (float*)(a.ws + id.z + WS_INV);
    const float* kk_c = a.in[28 + id.z] + (size_t)(j * 3 + 0) * D;
    for (int m = id.gw; m < NTOK; m += id.ngw) {
#pragma unroll 4
        for (int h = 0; h < 16; ++h) { const float kv = bf2f(RKV[(size_t)m * 3072 + 1024 + h * 64 + lane]) * kk_c[h * 64 + lane]; const float ss = wave_sum(kv * kv); if (lane == 0) INV[m * 16 + h] = 1.0f / sqrtf(ss + 1e-12f); }
    }
}

constexpr int SC_TC = 16, SC_ROWF = 352;
constexpr int SC_OPF = SC_TC * SC_ROWF;
constexpr int SC_YOFF = 4 * SC_OPF;
static_assert((SC_YOFF + 4 * SC_TC * 32) * 4 <= RING_BYTES, "scan LDS");
struct ScDesc { int mbase, T, h, dir, half, b; };
__device__ __forceinline__ void sc_desc(ScDesc& d, int slot, int grp, int c) {
    if (grp == 0) { const int cs = slot >> 1; d.b = cs >> 5; d.h = (cs >> 1) & 15; d.dir = cs & 1; d.half = slot & 1; d.T = TS; d.mbase = NPR + d.b * TS; }
    else { const int pu = slot * 8 + (c >> 4), cp = pu >> 1; d.b = cp >> 5; d.h = (cp >> 1) & 15; d.dir = cp & 1; d.half = pu & 1; d.T = TP; d.mbase = d.b * TP; }
}
__device__ __forceinline__ int sc_tok(const ScDesc& d, int grp, int c, int i) { const int s = (grp == 0 ? c : (c & 15)) * SC_TC + i; return d.mbase + (d.dir ? d.T - 1 - s : s); }
__device__ __forceinline__ float fma_s(float a, float b, float c) { float r; asm("v_fma_f32 %0, %1, %2, %3" : "=v"(r) : "v"(a), "v"(b), "v"(c)); return r; }
__device__ __forceinline__ float fnma_s(float a, float b, float c) { float r; asm("v_fma_f32 %0, -%1, %2, %3" : "=v"(r) : "v"(a), "v"(b), "v"(c)); return r; }
__device__ __forceinline__ float mul_s(float a, float b) { float r; asm("v_mul_f32_e32 %0, %1, %2" : "=v"(r) : "v"(a), "v"(b)); return r; }
__device__ __forceinline__ float add_s(float a, float b) { float r; asm("v_add_f32_e32 %0, %1, %2" : "=v"(r) : "v"(a), "v"(b)); return r; }
__device__ __forceinline__ void oct_sum4(float& a, float& b, float& c, float& d) {
    asm("s_nop 1\n\t"
        "v_add_f32_dpp %0, %0, %0 quad_perm:[1,0,3,2] row_mask:0xf bank_mask:0xf\n\tv_add_f32_dpp %1, %1, %1 quad_perm:[1,0,3,2] row_mask:0xf bank_mask:0xf\n\tv_add_f32_dpp %2, %2, %2 quad_perm:[1,0,3,2] row_mask:0xf bank_mask:0xf\n\tv_add_f32_dpp %3, %3, %3 quad_perm:[1,0,3,2] row_mask:0xf bank_mask:0xf\n\t"
        "v_add_f32_dpp %0, %0, %0 quad_perm:[2,3,0,1] row_mask:0xf bank_mask:0xf\n\tv_add_f32_dpp %1, %1, %1 quad_perm:[2,3,0,1] row_mask:0xf bank_mask:0xf\n\tv_add_f32_dpp %2, %2, %2 quad_perm:[2,3,0,1] row_mask:0xf bank_mask:0xf\n\tv_add_f32_dpp %3, %3, %3 quad_perm:[2,3,0,1] row_mask:0xf bank_mask:0xf\n\t"
        "v_add_f32_dpp %0, %0, %0 row_half_mirror row_mask:0xf bank_mask:0xf\n\tv_add_f32_dpp %1, %1, %1 row_half_mirror row_mask:0xf bank_mask:0xf\n\tv_add_f32_dpp %2, %2, %2 row_half_mirror row_mask:0xf bank_mask:0xf\n\tv_add_f32_dpp %3, %3, %3 row_half_mirror row_mask:0xf bank_mask:0xf"
        : "+v"(a), "+v"(b), "+v"(c), "+v"(d));
}
typedef float f32x2 __attribute__((ext_vector_type(2)));
struct ScOps { f32x2 w[4], kd[4], kk[4], ka[4], r[4]; float va, vb; };
__device__ __forceinline__ void sc_ldops(ScOps& o, const LAS float* p, int kg, int ra) {
#pragma unroll
    for (int hq = 0; hq < 2; ++hq) { const f32x4 a0 = *(const LAS f32x4*)(p + 8 * kg + 4 * hq), a1 = *(const LAS f32x4*)(p + 64 + 8 * kg + 4 * hq), a2 = *(const LAS f32x4*)(p + 128 + 8 * kg + 4 * hq),
                                                 a3 = *(const LAS f32x4*)(p + 192 + 8 * kg + 4 * hq), a4 = *(const LAS f32x4*)(p + 256 + 8 * kg + 4 * hq);
        o.w[2 * hq] = __builtin_shufflevector(a0, a0, 0, 1); o.w[2 * hq + 1] = __builtin_shufflevector(a0, a0, 2, 3); o.kd[2 * hq] = __builtin_shufflevector(a1, a1, 0, 1); o.kd[2 * hq + 1] = __builtin_shufflevector(a1, a1, 2, 3);
        o.kk[2 * hq] = __builtin_shufflevector(a2, a2, 0, 1); o.kk[2 * hq + 1] = __builtin_shufflevector(a2, a2, 2, 3); o.ka[2 * hq] = __builtin_shufflevector(a3, a3, 0, 1); o.ka[2 * hq + 1] = __builtin_shufflevector(a3, a3, 2, 3);
        o.r[2 * hq] = __builtin_shufflevector(a4, a4, 0, 1); o.r[2 * hq + 1] = __builtin_shufflevector(a4, a4, 2, 3); }
    o.va = p[320 + ra]; o.vb = p[321 + ra];
}
__device__ __forceinline__ float dot8_p(const f32x2 (&S)[4], const f32x2 (&x)[4]) {
    f32x2 d = S[0] * x[0]; d = __builtin_elementwise_fma(S[1], x[1], d); d = __builtin_elementwise_fma(S[2], x[2], d); d = __builtin_elementwise_fma(S[3], x[3], d);
    return d[0] + d[1];
}
struct ScRaw { unsigned r[4], k[4], a[4], e[4], v[4]; float iv[4]; };
__device__ __forceinline__ void sc_load(ScRaw& R, const Args& a, const Ids& id, int hw, int slot, int c) {
    const int grp = hw >> 1, lane = id.lane, kp = lane & 31, hs = lane >> 5; ScDesc d; sc_desc(d, slot, grp, c);
    const int s0 = (grp == 0 ? c : (c & 15)) * SC_TC + (hw & 1) * 8 + hs; const int m0 = d.mbase + (d.dir ? d.T - 1 - s0 : s0); const long mstep = d.dir ? -2 : 2;
    const bf16* pr = (const bf16*)(a.ws + id.z + A_RKV) + (size_t)m0 * 3072 + d.h * 64 + 2 * kp;
    const bf16* pa = (const bf16*)(a.ws + id.z + (d.dir ? A_A1 : A_A0)) + (size_t)m0 * D + d.h * 64 + 2 * kp;
    const bf16* pe = (const bf16*)(a.ws + id.z + (d.dir ? A_EW1 : A_EW0)) + (size_t)m0 * D + d.h * 64 + 2 * kp;
    const bf16* pv = (const bf16*)(a.ws + id.z + A_RKV) + (size_t)m0 * 3072 + 2048 + d.h * 64 + d.half * 32 + 2 * (kp & 15);
    const float* pi = (const float*)(a.ws + id.z + WS_INV) + (size_t)m0 * 16 + d.h;
#pragma unroll
    for (int it = 0; it < 4; ++it) { const long o = mstep * it;
        R.r[it] = *(const unsigned*)(pr + o * 3072); R.k[it] = *(const unsigned*)(pr + o * 3072 + 1024); R.a[it] = *(const unsigned*)(pa + o * D); R.e[it] = *(const unsigned*)(pe + o * D);
        R.v[it] = *(const unsigned*)(pv + o * 3072); R.iv[it] = pi[o * 16]; }
}
__device__ __forceinline__ void sc_derive(const ScRaw& R, const Args& a, const Ids& id, LAS float* L, int layer, int hw, int slot, int c, int buf) {
    const int grp = hw >> 1, lane = id.lane, kp = lane & 31, hs = lane >> 5, j = layer >> 1; ScDesc d; sc_desc(d, slot, grp, c);
    const f32x2 kkc = *(const f32x2*)(a.in[28 + id.z] + (size_t)(j * 3 + 0) * D + d.h * 64 + 2 * kp), kac = *(const f32x2*)(a.in[28 + id.z] + (size_t)(j * 3 + 1) * D + d.h * 64 + 2 * kp);
    LAS float* p0 = L + (buf * 2 + grp) * SC_OPF + ((hw & 1) * 8 + hs) * SC_ROWF + 2 * kp;
#pragma unroll
    for (int it = 0; it < 4; ++it) { LAS float* p = p0 + 2 * it * SC_ROWF;
        const f32x2 k2 = (f32x2){bflo(R.k[it]), bfhi(R.k[it])}, a2 = (f32x2){bflo(R.a[it]), bfhi(R.a[it])};
        const f32x2 kk = k2 * kkc * R.iv[it];
        *(LAS f32x2*)p = (f32x2){__builtin_amdgcn_exp2f(-bflo(R.e[it])), __builtin_amdgcn_exp2f(-bfhi(R.e[it]))};
        *(LAS f32x2*)(p + 64) = k2 * ((a2 - 1.0f) * kac + 1.0f); *(LAS f32x2*)(p + 128) = kk; *(LAS f32x2*)(p + 192) = kk * a2; *(LAS f32x2*)(p + 256) = (f32x2){bflo(R.r[it]), bfhi(R.r[it])};
        if (kp < 16) *(LAS f32x2*)(p + 320 - 2 * kp + 2 * kp) = (f32x2){bflo(R.v[it]), bfhi(R.v[it])}; }
}
__device__ __forceinline__ void sc_flush(const Args& a, const Ids& id, const LAS float* L, int hw, int slot, int c) {
    bf16* Y = (bf16*)(a.ws + id.z + A_Y);
#pragma unroll
    for (int q = 0; q < 2; ++q) { const int idx = hw * 64 + id.lane + 256 * q, fg = idx >> 8, s = (idx >> 4) & 15, rp = idx & 15; ScDesc d; sc_desc(d, slot, fg, c);
        const f32x2 yv = *(const LAS f32x2*)(L + SC_YOFF + ((c & 1) * 2 + fg) * SC_TC * 32 + s * 32 + 2 * rp);
        *(unsigned*)(Y + ((size_t)d.dir * NTOK + sc_tok(d, fg, c, s)) * D + d.h * 64 + d.half * 32 + 2 * rp) = pk2(yv[0], yv[1]); }
}
__device__ __forceinline__ void ph_rw_scan(const Args& a, const Ids& id, LAS unsigned char* lds, int layer, int G, int vcu) {
    const int j = layer >> 1, lane = id.lane, w = id.wave;
    LAS float* L = (LAS float*)lds;
    constexpr int NC = TS / SC_TC;
    for (int slot = vcu; slot < 256; slot += G) {
        if (w >= 4) {
            const int hw = w - 4; ScRaw R;
            sc_load(R, a, id, hw, slot, 0); sc_derive(R, a, id, L, layer, hw, slot, 0, 0);
            __syncthreads();
#pragma unroll 1
            for (int c = 0; c < NC; ++c) {
                if (c + 1 < NC) sc_load(R, a, id, hw, slot, c + 1);
                if (c > 0) sc_flush(a, id, L, hw, slot, c - 1);
                if (c + 1 < NC) sc_derive(R, a, id, L, layer, hw, slot, c + 1, (c & 1) ^ 1);
                __syncthreads();
            }
            sc_flush(a, id, L, hw, slot, NC - 1);
        } else {
            const int grp = w >> 1, kg = lane & 7, ra = 16 * (w & 1) + 2 * (lane >> 3);
            f32x2 Sa[4], Sb[4];
            { ScDesc d; sc_desc(d, slot, 0, 0);
              if (grp == 0) { const float* sp = a.in[7 + id.z] + ((((size_t)(d.b * 2 + j) * 2 + d.dir) * 16 + d.h) * 64 + d.half * 32 + ra) * 64 + 8 * kg;
                  const f32x4 t0 = *(const f32x4*)sp, t1 = *(const f32x4*)(sp + 4), t2 = *(const f32x4*)(sp + 64), t3 = *(const f32x4*)(sp + 68);
                  Sa[0] = (f32x2){t0[0], t0[1]}; Sa[1] = (f32x2){t0[2], t0[3]}; Sa[2] = (f32x2){t1[0], t1[1]}; Sa[3] = (f32x2){t1[2], t1[3]};
                  Sb[0] = (f32x2){t2[0], t2[1]}; Sb[1] = (f32x2){t2[2], t2[3]}; Sb[2] = (f32x2){t3[0], t3[1]}; Sb[3] = (f32x2){t3[2], t3[3]}; }
              else {
#pragma unroll
                  for (int e2 = 0; e2 < 4; ++e2) { Sa[e2] = (f32x2){0.f, 0.f}; Sb[e2] = (f32x2){0.f, 0.f}; } } }
            __syncthreads();
#pragma unroll 1
            for (int c = 0; c < NC; ++c) {
                const int buf = c & 1;
                if (grp == 1 && (c & 15) == 0) {
#pragma unroll
                    for (int e2 = 0; e2 < 4; ++e2) { Sa[e2] = (f32x2){0.f, 0.f}; Sb[e2] = (f32x2){0.f, 0.f}; } }
                const LAS float* ob = L + (buf * 2 + grp) * SC_OPF; LAS float* yb = L + SC_YOFF + (buf * 2 + grp) * SC_TC * 32 + ra;
                {
                    ScOps cur, nxt; sc_ldops(cur, ob, kg, ra);
                    float ypa = 0.f, ypb = 0.f;
#pragma unroll
                    for (int i = 0; i < SC_TC; ++i) {
                        if (i + 1 < SC_TC) sc_ldops(nxt, ob + (i + 1) * SC_ROWF, kg, ra);
                        const f32x2 va2 = (f32x2){cur.va, cur.va}, vb2 = (f32x2){cur.vb, cur.vb};
                        f32x2 ua[4], ub[4];
#pragma unroll
                        for (int e2 = 0; e2 < 4; ++e2) { ua[e2] = __builtin_elementwise_fma(Sa[e2], cur.w[e2], va2 * cur.kd[e2]); ub[e2] = __builtin_elementwise_fma(Sb[e2], cur.w[e2], vb2 * cur.kd[e2]); }
                        float ska = dot8_p(Sa, cur.kk), skb = dot8_p(Sb, cur.kk);
                        oct_sum4(ska, skb, ypa, ypb);
                        if (i > 0 && kg == 0) { yb[(i - 1) * 32] = ypa; yb[(i - 1) * 32 + 1] = ypb; }
                        const f32x2 na2 = (f32x2){-ska, -ska}, nb2 = (f32x2){-skb, -skb};
#pragma unroll
                        for (int e2 = 0; e2 < 4; ++e2) { Sa[e2] = __builtin_elementwise_fma(na2, cur.ka[e2], ua[e2]); Sb[e2] = __builtin_elementwise_fma(nb2, cur.ka[e2], ub[e2]); }
                        ypa = dot8_p(Sa, cur.r); ypb = dot8_p(Sb, cur.r);
                        if (i + 1 < SC_TC) cur = nxt;
                    }
                    float z0 = 0.f, z1 = 0.f; oct_sum4(ypa, ypb, z0, z1);
                    if (kg == 0) { yb[(SC_TC - 1) * 32] = ypa; yb[(SC_TC - 1) * 32 + 1] = ypb; }
                }
                if (grp == 1 && (c & 15) == 15) { ScDesc d; sc_desc(d, slot, 1, c);
                    float* dp = a.out + id.z + O_ST + ((((size_t)(d.b * 2 + j) * 2 + d.dir) * 16 + d.h) * 64 + d.half * 32 + ra) * 64 + 8 * kg;
                    *(f32x4*)dp = (f32x4){Sa[0][0], Sa[0][1], Sa[1][0], Sa[1][1]}; *(f32x4*)(dp + 4) = (f32x4){Sa[2][0], Sa[2][1], Sa[3][0], Sa[3][1]};
                    *(f32x4*)(dp + 64) = (f32x4){Sb[0][0], Sb[0][1], Sb[1][0], Sb[1][1]}; *(f32x4*)(dp + 68) = (f32x4){Sb[2][0], Sb[2][1], Sb[3][0], Sb[3][1]}; }
                __syncthreads();
            }
        }
        __syncthreads();
    }
}
__device__ __forceinline__ void ph_rw_post(const Args& a, const Ids& id, int layer) {
    const int j = layer >> 1, lane = id.lane;
    const bf16* RKV = (const bf16*)(a.ws + id.z + A_RKV); const bf16* Y = (const bf16*)(a.ws + id.z + A_Y);
    const bf16 *A0 = (const bf16*)(a.ws + id.z + A_A0), *A1 = (const bf16*)(a.ws + id.z + A_A1); bf16* H = (bf16*)(a.ws + id.z + A_H);
    const float* kvec = a.in[28 + id.z] + (size_t)j * 3 * D; const float* lnx = a.in[29 + id.z] + (size_t)j * 2 * D;
    f32x4 ka[4], rk[4], l0[4], l1[4];
#pragma unroll
    for (int q = 0; q < 4; ++q) { const int c = 4 * lane + 256 * q; ka[q] = *(const f32x4*)(kvec + D + c); rk[q] = *(const f32x4*)(kvec + 2 * D + c); l0[q] = *(const f32x4*)(lnx + c); l1[q] = *(const f32x4*)(lnx + D + c); }
    for (int m = id.gw; m < NTOK; m += id.ngw) {
        f32x4 y[4], r[4], k[4], v[4], a0[4], a1[4], g[4];
#pragma unroll
        for (int q = 0; q < 4; ++q) { const int c = 4 * lane + 256 * q; y[q] = ld_bf4(Y + (size_t)m * D + c) + ld_bf4(Y + ((size_t)NTOK + m) * D + c);
            r[q] = ld_bf4(RKV + (size_t)m * 3072 + c); k[q] = ld_bf4(RKV + (size_t)m * 3072 + 1024 + c); v[q] = ld_bf4(RKV + (size_t)m * 3072 + 2048 + c);
            a0[q] = ld_bf4(A0 + (size_t)m * D + c); a1[q] = ld_bf4(A1 + (size_t)m * D + c); g[q] = ld_bf4(H + (size_t)m * D + c); }
        float s[4], qv[4], bs[4];
#pragma unroll
        for (int q = 0; q < 4; ++q) s[q] = (y[q][0] + y[q][1]) + (y[q][2] + y[q][3]);
        row16_sum4(s[0], s[1], s[2], s[3]);
#pragma unroll
        for (int q = 0; q < 4; ++q) { const float mean = s[q] * (1.0f / 64.0f); y[q] = y[q] - mean; qv[q] = (y[q][0] * y[q][0] + y[q][1] * y[q][1]) + (y[q][2] * y[q][2] + y[q][3] * y[q][3]);
            const f32x4 kds = k[q] * ((a0[q] - 1.0f) * ka[q] + 1.0f) + k[q] * ((a1[q] - 1.0f) * ka[q] + 1.0f); const f32x4 t = r[q] * kds * rk[q]; bs[q] = (t[0] + t[1]) + (t[2] + t[3]); }
        row16_sum4(qv[0], qv[1], qv[2], qv[3]);
        row16_sum4(bs[0], bs[1], bs[2], bs[3]);
#pragma unroll
        for (int q = 0; q < 4; ++q) { const float ri = 1.0f / sqrtf(qv[q] * (1.0f / 64.0f) + 64e-5f); const f32x4 o = ((y[q] * ri) * l0[q] + l1[q] + v[q] * bs[q]) * g[q];
            *(v2u*)(H + (size_t)m * D + 4 * lane + 256 * q) = (v2u){pk2(o[0], o[1]), pk2(o[2], o[3])}; }
    }
}

enum Kind { K_PRO = 0, K_NORM0 = 1, K_QKV = 2, K_APOST = 3, K_ATTN = 4, K_ACOMB = 5, K_MIXOUT = 6, K_RNORM = 7, K_MLP1 = 8, K_MLP2 = 9, K_REND = 10,
            K_RMIX = 11, K_RKV = 12, K_RPREP = 13, K_RSCAN = 14, K_RPOST = 15 };
constexpr int NPH = 38;
#ifndef PROBE_MASK
#define PROBE_MASK 0
#endif
#ifndef PROBE_REPS
#define PROBE_REPS 1
#endif
template <int KIND, int LAYER>
__device__ __forceinline__ void run_phase(const Args& a, LAS unsigned char* lds, int G, int bx, int vcu, int wave_s, int rep) {
    Ids id; { int lv; asm volatile("v_mbcnt_lo_u32_b32 %0, -1, 0\n\tv_mbcnt_hi_u32_b32 %0, -1, %0" : "=v"(lv)); int zz; asm volatile("s_mov_b32 %0, 0" : "=s"(zz)); id.lane = lv; id.z = zz; }
    id.wave = wave_s; id.tid = wave_s * 64 + id.lane; id.gw = vcu * NWAVES + id.wave; id.ngw = G * NWAVES;
    constexpr int layer = LAYER;
    if constexpr (KIND == K_PRO) ph_prologue(a, id, lds);
    else if constexpr (KIND == K_NORM0) ph_norm0(a, id);
    else if constexpr (KIND == K_QKV) {
        constexpr int j = layer >> 1;
        pg8::Gemm g{(const bf16*)(a.ws + id.z + A_H), (const bf16*)(a.ws + id.z + W_WINT), NTOK, NQKV, D}; pg8::StaticOrder S; S.init(NTOK, NQKV, G, bx);
        const float* RC = (const float*)(a.ws + id.z + WS_ROPE);
        pg8::EpiQkv<QkvMap> E{a.ws + id.z, a.out + id.z, a.in[14 + id.z] + j * 128, RC, RC + 2048 * 64, j};
        pg8::gemm_phase<pg8::EpiQkv<QkvMap>, pg8::StaticOrder, true, true>(lds + RING_OFF, g, S, E, id.wave);
        { Ids id2 = id; int lv; asm volatile("v_mbcnt_lo_u32_b32 %0, -1, 0\n\tv_mbcnt_hi_u32_b32 %0, -1, %0" : "=v"(lv)); int zz; asm volatile("s_mov_b32 %0, 0" : "=s"(zz));
          id2.lane = lv; id2.z = zz; id2.tid = id.wave * 64 + lv;
          if (G == 256) { if (bx >= 64) { id2.gw = (bx - 64) * NWAVES + id.wave; id2.ngw = 192 * NWAVES; ph_att_cache(a, id2, layer); conv_weights(a, id2, lds, layer, 2); } }
          else { ph_att_cache(a, id2, layer); conv_weights(a, id2, lds, layer, 2); } }
    }
    else if constexpr (KIND == K_MIXOUT) {
        pg8::Gemm g{(const bf16*)(a.ws + id.z + A_H), (const bf16*)(a.ws + id.z + ((layer & 1) ? W_WOT : W_WOUTT)), NTOK, D, D}; pg8::StaticOrder S; S.init(NTOK, D, G, bx);
        pg8::EpiBf16<0> E{(bf16*)(a.ws + id.z + A_M), D, 1 << 20, nullptr, 0};
        pg8::gemm_phase<pg8::EpiBf16<0>, pg8::StaticOrder, true, true>(lds + RING_OFF, g, S, E, id.wave);
    }
    else if constexpr (KIND == K_MLP2) {
        pg8::Gemm g{(const bf16*)(a.ws + id.z + A_HID), (const bf16*)(a.ws + id.z + W_W2T), NTOK, D, FF}; pg8::StaticOrder S; S.init(NTOK, D, G, bx);
        pg8::EpiBf16<0> E{(bf16*)(a.ws + id.z + A_F), D, 1 << 20, nullptr, 0};
        pg8::gemm_phase<pg8::EpiBf16<0>, pg8::StaticOrder, true, true>(lds + RING_OFF, g, S, E, id.wave);
    }
    else if constexpr (KIND == K_MLP1) {
        pg8::Gemm g{(const bf16*)(a.ws + id.z + A_H), (const bf16*)(a.ws + id.z + W_W1T), NTOK, FF, D}; pg8::StaticOrder S; S.init(NTOK, FF, G, bx);
        pg8::EpiBf16<2> E{(bf16*)(a.ws + id.z + A_HID), FF, 1 << 20, nullptr, 0};
        pg8::gemm_phase<pg8::EpiBf16<2>, pg8::StaticOrder, true, true>(lds + RING_OFF, g, S, E, id.wave);
    }
    else if constexpr (KIND == K_RKV) {
        {
            pg8::Gemm g{(const bf16*)(a.ws + id.z + A_A2), (const bf16*)(a.ws + id.z + W_BTL), NTOK, 512, KRKV}; pg8::StaticOrder S; S.init(NTOK, 512, G, bx);
            pg8::EpiL1 E{(bf16*)(a.ws + id.z + A_L1)};
            pg8::gemm_phase<pg8::EpiL1, pg8::StaticOrder, true, true>(lds + RING_OFF, g, S, E, id.wave); }
        {
            pg8::Gemm g{(const bf16*)(a.ws + id.z + A_XS), (const bf16*)(a.ws + id.z + W_BTR), 3 * NTOK, 3072, D}; pg8::RkvOrder S{bx};
            pg8::EpiRkv3 E{(bf16*)(a.ws + id.z + A_RKV)};
            pg8::gemm_phase<pg8::EpiRkv3, pg8::RkvOrder, true, true>(lds + RING_OFF, g, S, E, id.wave); }
    }
    else if constexpr (KIND == K_RPREP) {
        constexpr int j = layer >> 1;
        pg8::Gemm g{(const bf16*)(a.ws + id.z + A_L1), (const bf16*)(a.ws + id.z + W_BT2), NTOK, 5120, 384}; pg8::StaticOrder S; S.init(NTOK, 5120, G, bx);
        static_assert(A_A1 - A_A0 == 32 * MiB && A_EW0 - A_A0 == 64 * MiB && A_EW1 - A_A0 == 96 * MiB, "EpiLora2 output stride");
        pg8::EpiLora2 E{(bf16*)(a.ws + id.z + A_A0), (size_t)16 * MiB, (bf16*)(a.ws + id.z + A_G), a.in[23 + id.z] + (size_t)j * 2 * D, a.in[20 + id.z] + (size_t)j * 2 * D};
        pg8::gemm_phase<pg8::EpiLora2, pg8::StaticOrder, true, true>(lds + RING_OFF, g, S, E, id.wave);
        { Ids id2 = id; int lv; asm volatile("v_mbcnt_lo_u32_b32 %0, -1, 0\n\tv_mbcnt_hi_u32_b32 %0, -1, %0" : "=v"(lv)); int zz; asm volatile("s_mov_b32 %0, 0" : "=s"(zz));
          id2.lane = lv; id2.z = zz; id2.tid = id.wave * 64 + lv; ph_rw_prep(a, id2, layer); }
    }
    else if constexpr (KIND == K_ATTN) ph_attn(a, id, lds, G, vcu);
    else if constexpr (KIND == K_ACOMB) ph_att_comb(a, id, layer);
    else if constexpr (KIND == K_RNORM) ph_resid_norm(a, id, layer, rep + 1 < (((PROBE_MASK >> K_RNORM) & 1) ? PROBE_REPS : 1));
    else if constexpr (KIND == K_REND) ph_resid_end(a, id, lds, layer, rep + 1 < (((PROBE_MASK >> K_REND) & 1) ? PROBE_REPS : 1));
    else if constexpr (KIND == K_RMIX) ph_rw_mix(a, id, layer);
    else if constexpr (KIND == K_RSCAN) { if (rep > 0) { ph_rw_prep(a, id, layer); __syncthreads(); cg::this_grid().sync(); } ph_rw_scan(a, id, lds, layer, G, vcu); }
    else if constexpr (KIND == K_RPOST) ph_rw_post(a, id, layer);
}

__global__ void __launch_bounds__(NWAVES * 64, 2) mega_fwd(Args a) {
    extern __shared__ __attribute__((aligned(16))) unsigned char lds_raw[];
    LAS unsigned char* lds = (LAS unsigned char*)lds_raw;
    const int G = gridDim.x, bx = blockIdx.x; const int vcu = (G % 8 == 0) ? (bx % 8) * (G / 8) + bx / 8 : bx;
    volatile LAS unsigned* MISC = (volatile LAS unsigned*)(lds + MISC_OFF);
    for (int u = threadIdx.x; u < (LDS_BYTES - LDSCTL_OFF) / 4; u += NWAVES * 64) ((LAS unsigned*)(lds + LDSCTL_OFF))[u] = 0u;
    __syncthreads();
#if MK_N_LAUNCHES == 1 && !MK_CG_BARRIER
    XcdBarrier bar = xcd_barrier_post((unsigned*)(a.ws + WS_CTL) + CW_BAR, MISC + 8, threadIdx.x == 0);
#endif
    (void)MISC;
    const int lo = a.ph_lo, hi = a.ph_hi;
    const int wave_s = __builtin_amdgcn_readfirstlane(threadIdx.x >> 6);
#if MK_N_LAUNCHES == 1
#if MK_CG_BARRIER
#define GRID_BAR(ph) cg::this_grid().sync()
#else
#define GRID_BAR(ph) do { if ((ph) == 0) cg::this_grid().sync(); else { int l_; asm volatile("v_mbcnt_lo_u32_b32 %0, -1, 0\n\tv_mbcnt_hi_u32_b32 %0, -1, %0" : "=v"(l_)); xcd_barrier(bar, wave_s == 0 && l_ == 0); } } while (0)
#endif
#else
#define GRID_BAR(ph) do { } while (0)
#endif
#define PHASE(ph, KIND, LAYER) do { if (lo <= (ph) && (ph) < hi) { constexpr int nrep_ = ((PROBE_MASK >> (KIND)) & 1) ? PROBE_REPS : 1; \
        _Pragma("unroll 1") for (int rep_ = 0; rep_ < nrep_; ++rep_) { run_phase<KIND, LAYER>(a, lds, G, bx, vcu, wave_s, rep_); if (rep_ + 1 < nrep_) { __syncthreads(); cg::this_grid().sync(); } } \
        if ((ph) + 1 < hi) GRID_BAR(ph); } } while (0)
#define ATTN_LAYER(p0, L) PHASE((p0) + 0, K_QKV, L); PHASE((p0) + 1, K_ATTN, L); PHASE((p0) + 2, K_ACOMB, L); PHASE((p0) + 3, K_MIXOUT, L); \
        PHASE((p0) + 4, K_RNORM, L); PHASE((p0) + 5, K_MLP1, L); PHASE((p0) + 6, K_MLP2, L); PHASE((p0) + 7, K_REND, L)
#define RWKV_LAYER(p0, L) PHASE((p0) + 0, K_RMIX, L); PHASE((p0) + 1, K_RKV, L); PHASE((p0) + 2, K_RPREP, L); PHASE((p0) + 3, K_RSCAN, L); PHASE((p0) + 4, K_RPOST, L); PHASE((p0) + 5, K_MIXOUT, L); \
        PHASE((p0) + 6, K_RNORM, L); PHASE((p0) + 7, K_MLP1, L); PHASE((p0) + 8, K_MLP2, L); PHASE((p0) + 9, K_REND, L)
    PHASE(0, K_PRO, 0); PHASE(1, K_NORM0, 0);
    ATTN_LAYER(2, 0); RWKV_LAYER(10, 1); ATTN_LAYER(20, 2); RWKV_LAYER(28, 3);
#undef PHASE
#undef ATTN_LAYER
#undef RWKV_LAYER
#undef GRID_BAR
}

extern "C" void kernel_launch(void* const* d_in, const int* in_sizes, int n_in, void* d_out, int out_size, void* d_ws, size_t ws_size, hipStream_t stream) {
    static int grid = 0;
    if (grid == 0) {
        if (n_in != 32 || (size_t)out_size != OUT_TOTAL || ws_size < WS_END) { fprintf(stderr, "kernel_launch: unexpected problem (n_in %d, out %d, ws %zu; need ws >= %zu); nothing launched\n", n_in, out_size, ws_size, (size_t)WS_END); grid = -1; return; }
        int dev = 0, cus = 0, per_cu = 0;
        if (hipGetDevice(&dev) != hipSuccess || hipDeviceGetAttribute(&cus, hipDeviceAttributeMultiprocessorCount, dev) != hipSuccess) { grid = -1; return; }
        if (hipFuncSetAttribute((const void*)mega_fwd, hipFuncAttributeMaxDynamicSharedMemorySize, LDS_BYTES) != hipSuccess) { fprintf(stderr, "kernel_launch: hipFuncSetAttribute failed\n"); grid = -1; return; }
        if (hipOccupancyMaxActiveBlocksPerMultiprocessor(&per_cu, (const void*)mega_fwd, NWAVES * 64, LDS_BYTES) != hipSuccess || per_cu < 1) { fprintf(stderr, "kernel_launch: occupancy query failed (%d)\n", per_cu); (void)hipGetLastError(); per_cu = 1; }
        grid = cus * (per_cu < 1 ? 1 : 1);
        fprintf(stderr, "kernel_launch: %d CUs, occupancy %d/CU, grid %d\n", cus, per_cu, grid);
    }
    if (grid < 0) return;
    (void)in_sizes;
    if (hipMemsetAsync((char*)d_ws + WS_CTL, 0, CTL_ZERO_BYTES, stream) != hipSuccess) { fprintf(stderr, "kernel_launch: memset failed\n"); return; }
    Args a{};
    for (int i = 0; i < 32; ++i) a.in[i] = (const float*)d_in[i];
    a.out = (float*)d_out; a.ws = (unsigned char*)d_ws;
#if MK_N_LAUNCHES == 1
    a.ph_lo = 0; a.ph_hi = NPH;
    void* args[] = {&a};
    hipError_t e = hipLaunchCooperativeKernel((const void*)mega_fwd, dim3(grid), dim3(NWAVES * 64), args, LDS_BYTES, stream);
    if (e != hipSuccess) fprintf(stderr, "kernel_launch: cooperative launch failed: %s (grid %d)\n", hipGetErrorString(e), grid);
#else
    for (int ph = 0; ph < NPH; ++ph) {
        a.ph_lo = ph; a.ph_hi = ph + 1;
        hipLaunchKernelGGL(mega_fwd, dim3(grid), dim3(NWAVES * 64), LDS_BYTES, stream, a);
    }
#endif
}
```

```cpp
#include <hip/hip_runtime.h>
#include <hip/hip_cooperative_groups.h>
#include <cstdio>
#include <cstdint>
namespace cg = cooperative_groups;
namespace pg8 {
#define PG8_LAS __attribute__((address_space(3)))
typedef unsigned short bf16_t;
typedef short bf16x8 __attribute__((ext_vector_type(8)));
typedef float f32x4 __attribute__((ext_vector_type(4)));
typedef unsigned u32x4 __attribute__((ext_vector_type(4)));
constexpr int BM = 256, BK = 64, HALF = 128, HTB = HALF * BK * 2  , STAGE_BYTES = 8 * HTB, NXCD = 8, WGM = 8;

__host__ __device__ __forceinline__ int lds_byte(int r, int c) { const int st = (r >> 4) * 2 + (c >> 5), rr = r & 15, cc = c & 31, ob = rr * 64 + cc * 2; return st * 1024 + (ob ^ (((ob >> 9) & 1) << 5)); }
__host__ __device__ __forceinline__ void stage_rc(int b, int& R, int& C) { const int st = b / 1024, sb = b % 1024, swz = sb ^ (((sb >> 9) & 1) << 5); R = (st >> 1) * 16 + swz / 64; C = (st & 1) * 32 + (swz % 64) / 2; }
__host__ __device__ __forceinline__ int perm32(int rho) { const int n = rho >> 4, i = rho & 15; return 8 * (i >> 2) + 4 * n + (i & 3); }

struct Unit { int pm, pn; };
struct Gemm { const bf16_t* A; const bf16_t* Bt; int M, N, K; };

struct StaticOrder {
    int nM, nN, nwg, G, c;
    __host__ __device__ void init(int M, int N, int G_, int c_) { nM = M / BM; nN = N / BM; nwg = nM * nN; G = G_; c = c_; }
    __host__ __device__ bool next(int i, Unit& u) const {
        const long L = (long)i * G + c; if (L >= nwg) return false;
        int wgid = (int)L; { const int q = nwg / NXCD, r = nwg % NXCD, xcd = wgid % NXCD, off = wgid / NXCD; wgid = (xcd < r ? xcd * (q + 1) : r * (q + 1) + (xcd - r) * q) + off; }
        const int nig = WGM * nN, gid = wgid / nig, fm = gid * WGM, gsz = (nM - fm) < WGM ? (nM - fm) : WGM;
        u.pm = fm + ((wgid % nig) % gsz); u.pn = (wgid % nig) / gsz; return true;
    }
    __device__ __forceinline__ void a_ready(const Unit&) const {}
    __device__ __forceinline__ void done(const Unit&) const {}
};


__device__ __forceinline__ unsigned cvt_pk_bf16(float lo, float hi) { unsigned r; asm volatile("v_cvt_pk_bf16_f32 %0, %1, %2" : "=v"(r) : "v"(lo), "v"(hi)); return r; }

template <int ACT> struct EpiBf16 {
    static constexpr bool PERM = true, AFTER_DRAIN = false;
    bf16_t* O0; int ld0; int nt0; bf16_t* O1; int ld1;
    __device__ __forceinline__ void operator()(const f32x4 (&acc)[2][2][4][2], const Unit& u, int wr, int wc, int fr, int fq) const {
        const int row0 = u.pm * BM + wr * 64 + fr;
        bf16_t* base; int ldc, colt;
        if (u.pn < nt0) { base = O0; ldc = ld0; colt = u.pn * BM; } else { base = O1; ldc = ld1; colt = (u.pn - nt0) * BM; }
        const int col0 = colt + wc * 32 + 8 * fq;
#pragma unroll
        for (int ai = 0; ai < 2; ++ai)
#pragma unroll
            for (int m = 0; m < 4; ++m) { bf16_t* rowp = base + (size_t)(row0 + ai * HALF + m * 16) * ldc + col0;
#pragma unroll
                for (int bj = 0; bj < 2; ++bj) { f32x4 v0 = acc[ai][bj][m][0], v1 = acc[ai][bj][m][1];
                    if (ACT == 2) {
#pragma unroll
                        for (int e = 0; e < 4; ++e) { float a = v0[e] > 0.f ? v0[e] : 0.f; v0[e] = a * a; float b = v1[e] > 0.f ? v1[e] : 0.f; v1[e] = b * b; } }
                    u32x4 w; w.x = cvt_pk_bf16(v0[0], v0[1]); w.y = cvt_pk_bf16(v0[2], v0[3]); w.z = cvt_pk_bf16(v1[0], v1[1]); w.w = cvt_pk_bf16(v1[2], v1[3]);
                    *(u32x4*)(rowp + bj * HALF) = w; } }
    }
    __device__ __forceinline__ void fused(f32x4 (&)[2][2][4][2], const Unit&, int, int, int, int, PG8_LAS unsigned char*, int, int) const {}
};


__device__ __forceinline__ float sig_f(float x) { return 1.0f / (1.0f + __expf(-x)); }
struct RkvOrder {
    int c;
    __device__ __forceinline__ bool next(int i, Unit& u) const {
        int L; if (c < 128) { if (i >= 2) return false; L = c * 2 + i; } else { if (i >= 4) return false; L = 256 + (c - 128) * 4 + i; }
        const int which = L >> 8, r = L & 255; u.pm = which * 64 + (r >> 2); u.pn = which * 4 + (r & 3); return true; }
    __device__ __forceinline__ void a_ready(const Unit&) const {}
    __device__ __forceinline__ void done(const Unit&) const {}
};
struct EpiRkv3 {
    static constexpr bool PERM = true, AFTER_DRAIN = false;
    bf16_t* RKV;
    __device__ __forceinline__ void operator()(const f32x4 (&acc)[2][2][4][2], const Unit& u, int wr, int wc, int fr, int fq) const {
        const int row0 = (u.pm & 63) * BM + wr * 64 + fr, col0 = u.pn * BM + wc * 32 + 8 * fq;
#pragma unroll
        for (int ai = 0; ai < 2; ++ai)
#pragma unroll
            for (int m = 0; m < 4; ++m) { bf16_t* rowp = RKV + (size_t)(row0 + ai * HALF + m * 16) * 3072 + col0;
#pragma unroll
                for (int bj = 0; bj < 2; ++bj) { const f32x4 v0 = acc[ai][bj][m][0], v1 = acc[ai][bj][m][1];
                    u32x4 w; w.x = cvt_pk_bf16(v0[0], v0[1]); w.y = cvt_pk_bf16(v0[2], v0[3]); w.z = cvt_pk_bf16(v1[0], v1[1]); w.w = cvt_pk_bf16(v1[2], v1[3]);
                    *(u32x4*)(rowp + bj * HALF) = w; } }
    }
};
struct EpiL1 {
    static constexpr bool PERM = true, AFTER_DRAIN = false;
    bf16_t* L1;
    __device__ __forceinline__ void operator()(const f32x4 (&acc)[2][2][4][2], const Unit& u, int wr, int wc, int fr, int fq) const {
        const int row0 = u.pm * BM + wr * 64 + fr, colt = u.pn * BM, col0 = colt + wc * 32 + 8 * fq;
#pragma unroll
        for (int ai = 0; ai < 2; ++ai)
#pragma unroll
            for (int m = 0; m < 4; ++m) { bf16_t* rowp = L1 + (size_t)(row0 + ai * HALF + m * 16) * 384 + col0;
#pragma unroll
                for (int bj = 0; bj < 2; ++bj) { f32x4 v0 = acc[ai][bj][m][0], v1 = acc[ai][bj][m][1];
                    const int cb = colt + bj * HALF;
                    if (cb >= 384) continue;
                    if (cb == 0) {
#pragma unroll
                        for (int e = 0; e < 4; ++e) { v0[e] = 1.0f - 2.0f / (1.0f + __expf(2.0f * v0[e])); v1[e] = 1.0f - 2.0f / (1.0f + __expf(2.0f * v1[e])); } }
                    else if (cb == 256) {
#pragma unroll
                        for (int e = 0; e < 4; ++e) { v0[e] = sig_f(v0[e]); v1[e] = sig_f(v1[e]); } }
                    u32x4 w; w.x = cvt_pk_bf16(v0[0], v0[1]); w.y = cvt_pk_bf16(v0[2], v0[3]); w.z = cvt_pk_bf16(v1[0], v1[1]); w.w = cvt_pk_bf16(v1[2], v1[3]);
                    *(u32x4*)(rowp + bj * HALF) = w; } }
    }
};
struct EpiLora2 {
    static constexpr bool PERM = true, AFTER_DRAIN = false;
    bf16_t* o4; size_t ostride; bf16_t* og; const float* a0; const float* w0;
    __device__ __forceinline__ void operator()(const f32x4 (&acc)[2][2][4][2], const Unit& u, int wr, int wc, int fr, int fq) const {
        const int row0 = u.pm * BM + wr * 64 + fr; const int blk = u.pn >> 2, colt = (u.pn & 3) * BM;
        bf16_t* base = (blk < 4) ? o4 + (size_t)blk * ostride : og;
        const float* bs = ((blk < 2) ? a0 : w0) + (blk & 1) * 1024;
        const int col0 = colt + wc * 32 + 8 * fq;
        const float sc = (blk >= 2) ? 0.8750387749719753f : 1.0f;
#pragma unroll
        for (int bj = 0; bj < 2; ++bj) {
            f32x4 b0 = (f32x4){0.f, 0.f, 0.f, 0.f}, b1 = b0;
            if (blk < 4) { b0 = *(const f32x4*)(bs + col0 + bj * HALF); b1 = *(const f32x4*)(bs + col0 + bj * HALF + 4); }
#pragma unroll
            for (int ai = 0; ai < 2; ++ai)
#pragma unroll
                for (int m = 0; m < 4; ++m) { bf16_t* rowp = base + (size_t)(row0 + ai * HALF + m * 16) * 1024 + col0;
                    f32x4 v0 = acc[ai][bj][m][0] + b0, v1 = acc[ai][bj][m][1] + b1;
                    if (blk < 4) {
#pragma unroll
                        for (int e = 0; e < 4; ++e) { v0[e] = sc * sig_f(v0[e]); v1[e] = sc * sig_f(v1[e]); } }
                    u32x4 w; w.x = cvt_pk_bf16(v0[0], v0[1]); w.y = cvt_pk_bf16(v0[2], v0[3]); w.z = cvt_pk_bf16(v1[0], v1[1]); w.w = cvt_pk_bf16(v1[2], v1[3]);
                    *(u32x4*)(rowp + bj * HALF) = w; } }
    }
};


template <class MP> struct EpiQkv {
    static constexpr bool PERM = true, AFTER_DRAIN = false;
    unsigned char* ws; float* out; const float* gain; const float* RC; const float* RS; int j;
    static constexpr size_t oQA = MP::oQA, oQB = MP::oQB, oKAP = MP::oKAP, oVAP = MP::oVAP, oKBP = MP::oKBP, oVBP = MP::oVBP, oKAS = MP::oKAS, oVAS = MP::oVAS, oKBS = MP::oKBS, oVBS = MP::oVBS;
    static constexpr size_t oKG = MP::oKG, oVG = MP::oVG, oKD = MP::oKD, oVD = MP::oVD;
    __device__ __forceinline__ void operator()(const f32x4 (&acc)[2][2][4][2], const Unit& u, int wr, int wc, int fr, int fq) const {
        const int ch = 4 * u.pn + wc; const bool smp = u.pm >= 32;
        const bool isq = (ch < 8) || (ch >= 12 && ch < 20), isk = (ch == 8 || ch == 9) || (ch >= 20 && ch < 28);
        const int dl = 8 * fq;
        const bool hi2 = (fq & 2) != 0;
        f32x4 g[2][2];
#pragma unroll
        for (int bj = 0; bj < 2; ++bj)
#pragma unroll
            for (int n = 0; n < 2; ++n) g[bj][n] = (ch < 10) ? *(const f32x4*)(gain + (ch < 8 ? 0 : 64) + bj * 32 + dl + 4 * n) : (f32x4){1.f, 1.f, 1.f, 1.f};
        constexpr float QS = 0.18033688011112042f;
#pragma unroll
        for (int ai = 0; ai < 2; ++ai)
#pragma unroll
            for (int m = 0; m < 4; ++m) {
                const int mrow = u.pm * BM + ai * HALF + wr * 64 + m * 16 + fr;
                const int b = smp ? ((mrow - 8192) >> 11) : (mrow >> 8), t = smp ? ((mrow - 8192) & 2047) : (mrow & 255);
                f32x4 v[2][2];
#pragma unroll
                for (int bj = 0; bj < 2; ++bj)
#pragma unroll
                    for (int n = 0; n < 2; ++n) v[bj][n] = acc[ai][bj][m][n];
                if (ch < 10) { float ss = 0.f;
#pragma unroll
                    for (int bj = 0; bj < 2; ++bj)
#pragma unroll
                        for (int n = 0; n < 2; ++n) ss += (v[bj][n][0] * v[bj][n][0] + v[bj][n][1] * v[bj][n][1]) + (v[bj][n][2] * v[bj][n][2] + v[bj][n][3] * v[bj][n][3]);
                    ss += __shfl_xor(ss, 16); ss += __shfl_xor(ss, 32);
                    const float ri = 1.0f / sqrtf(ss * (1.0f / 64.0f) + 1e-6f);
#pragma unroll
                    for (int bj = 0; bj < 2; ++bj)
#pragma unroll
                        for (int n = 0; n < 2; ++n) v[bj][n] = v[bj][n] * ri * g[bj][n]; }
                f32x4 vr[2][2];
#pragma unroll
                for (int bj = 0; bj < 2; ++bj)
#pragma unroll
                    for (int n = 0; n < 2; ++n) { vr[bj][n] = v[bj][n];
                        if (smp && (isq || isk)) { f32x4 p; p[0] = __shfl_xor(v[bj][n][0], 32); p[1] = __shfl_xor(v[bj][n][1], 32); p[2] = __shfl_xor(v[bj][n][2], 32); p[3] = __shfl_xor(v[bj][n][3], 32);
                            const f32x4 cs = *(const f32x4*)(RC + t * 64 + bj * 32 + dl + 4 * n), sn = *(const f32x4*)(RS + t * 64 + bj * 32 + dl + 4 * n);
                            const f32x4 rot = hi2 ? p : -p; vr[bj][n] = v[bj][n] * cs + rot * sn; } }
#define EQ_PK8(x0, x1) ((u32x4){cvt_pk_bf16((x0)[0], (x0)[1]), cvt_pk_bf16((x0)[2], (x0)[3]), cvt_pk_bf16((x1)[0], (x1)[1]), cvt_pk_bf16((x1)[2], (x1)[3])})
                const size_t srow = (size_t)(b * 2560 + 512 + t), prow = (size_t)((b * 2 + j) * 256 + t);
#pragma unroll
                for (int bj = 0; bj < 2; ++bj) {
                    const int f0 = bj * 32 + dl;
                    if (isq) { const f32x4 s0 = vr[bj][0] * QS, s1 = vr[bj][1] * QS; const size_t o = (ch < 8) ? oQA + ((size_t)mrow * 512 + ch * 64 + f0) * 2 : oQB + ((size_t)mrow * 512 + (ch - 12) * 64 + f0) * 2;
                        *(u32x4*)(ws + o) = EQ_PK8(s0, s1); }
                    else {
                        const bool gq = ch < 12, kk = isk;
                        const int e = gq ? ((ch & 1) * 64 + f0) : ((ch - (kk ? 20 : 28)) * 64 + f0); const int wdt = gq ? 128 : 512;
                        if (!smp) { const size_t of = (gq ? (kk ? oKG : oVG) : (kk ? oKD : oVD)) + prow * wdt + e; *(f32x4*)(out + of) = v[bj][0]; *(f32x4*)(out + of + 4) = v[bj][1];
                            const size_t o = (gq ? (kk ? oKAP : oVAP) : (kk ? oKBP : oVBP)) + ((size_t)mrow * wdt + e) * 2; *(u32x4*)(ws + o) = EQ_PK8(v[bj][0], v[bj][1]); }
                        else { const size_t o = (gq ? (kk ? oKAS : oVAS) : (kk ? oKBS : oVBS)) + (srow * wdt + e) * 2; *(u32x4*)(ws + o) = EQ_PK8(vr[bj][0], vr[bj][1]); } }
                }
#undef EQ_PK8
            }
    }
};

template <class Epi, class Sched, bool ALIGN_EPI = false, bool SP2 = false>
__device__ __forceinline__ void gemm_phase(PG8_LAS unsigned char* lds, const Gemm g, const Sched& S, const Epi& E, const int wave_index) {
    int lane_o; asm volatile("v_mbcnt_lo_u32_b32 %0, -1, 0\n\tv_mbcnt_hi_u32_b32 %0, -1, %0" : "=v"(lane_o));
    const int wid = wave_index, lane = lane_o, tid = wid * 64 + lane, wr = wid >> 2, wc = wid & 3, fr = lane & 15, fq = lane >> 4;
    const int K = g.K, nt = K / BK;
    unsigned voffA[2], voffB[2];
#pragma unroll
    for (int i = 0; i < 2; ++i) { int R, C; stage_rc(tid * 16 + i * 8192, R, C); const int Rb = Epi::PERM ? ((R & ~31) + perm32(R & 31)) : R;
        voffA[i] = (unsigned)(R * K + C) * 2u; voffB[i] = (unsigned)(Rb * K + C) * 2u; }
    const size_t kstep = (size_t)(BK * 2);
    const size_t hstep = (size_t)HALF * K * 2;
    const size_t tstep = 2 * hstep;
    const unsigned ldsw = (unsigned)wid * 1024u;
    const int aoff = lds_byte(wr * 64 + fr, fq * 8), boff = lds_byte(wc * 32 + fr, fq * 8);
#define PG8_SA(b, h) (((b) * 2 + (h)) * HTB)
#define PG8_SB(b, h) ((4 + (b) * 2 + (h)) * HTB)
#define PG8_STAGE(bufoff, gbase, voff) do { _Pragma("unroll") for (int _i = 0; _i < 2; ++_i) \
        __builtin_amdgcn_global_load_lds((const unsigned*)((const char*)(gbase) + (voff)[_i]), (PG8_LAS unsigned*)(lds + (bufoff) + ldsw + _i * 8192), 16, 0, 0); } while (0)
#define PG8_LDA(dst, b, h) do { _Pragma("unroll") for (int m = 0; m < 4; ++m) _Pragma("unroll") for (int k = 0; k < 2; ++k) dst[m][k] = *(const PG8_LAS bf16x8*)(lds + PG8_SA(b, h) + aoff + m * 2048 + k * 1024); } while (0)
#define PG8_LDB(dst, b, h) do { _Pragma("unroll") for (int n = 0; n < 2; ++n) _Pragma("unroll") for (int k = 0; k < 2; ++k) dst[n][k] = *(const PG8_LAS bf16x8*)(lds + PG8_SB(b, h) + boff + n * 2048 + k * 1024); } while (0)
#define PG8_MMA(ai, bj, At, Bt) do { __builtin_amdgcn_s_setprio(1); _Pragma("unroll") for (int m = 0; m < 4; ++m) _Pragma("unroll") for (int n = 0; n < 2; ++n) _Pragma("unroll") for (int k = 0; k < 2; ++k) \
        acc[ai][bj][m][n] = __builtin_amdgcn_mfma_f32_16x16x32_bf16(Bt[n][k], At[m][k], acc[ai][bj][m][n], 0, 0, 0); __builtin_amdgcn_s_setprio(0); } while (0)
#define PG8_WAIT_V(n) asm volatile("s_waitcnt vmcnt(" #n ")" ::: "memory")
#define PG8_WAIT_L(n) asm volatile("s_waitcnt lgkmcnt(" #n ")" ::: "memory")
#define PG8_BAR __builtin_amdgcn_s_barrier()
#define PG8_SCHED __builtin_amdgcn_sched_barrier(0)
    Unit cur, nxt; int ui = 0;
    if (!S.next(0, cur)) return;
    f32x4 acc[2][2][4][2];
#pragma unroll
    for (int a = 0; a < 2; ++a)
#pragma unroll
        for (int b = 0; b < 2; ++b)
#pragma unroll
            for (int m = 0; m < 4; ++m)
#pragma unroll
                for (int n = 0; n < 2; ++n) acc[a][b][m][n] = (f32x4){0.f, 0.f, 0.f, 0.f};
    bf16x8 At[4][2], B0[2][2], B1[2][2];
    const char* cA = (const char*)g.A + (size_t)cur.pm * tstep; const char* cB = (const char*)g.Bt + (size_t)cur.pn * tstep;
    S.a_ready(cur);
    if constexpr (SP2) {
        PG8_STAGE(PG8_SB(0, 0), cB, voffB); PG8_STAGE(PG8_SB(0, 1), cB + hstep, voffB); PG8_STAGE(PG8_SA(0, 0), cA, voffA); PG8_STAGE(PG8_SA(0, 1), cA + hstep, voffA);
        if (wr == 1) PG8_BAR;
        PG8_WAIT_V(2); PG8_BAR;
        PG8_STAGE(PG8_SB(1, 0), cB + kstep, voffB); PG8_STAGE(PG8_SA(1, 0), cA + kstep, voffA); PG8_STAGE(PG8_SB(1, 1), cB + hstep + kstep, voffB);
        PG8_WAIT_V(6); PG8_BAR;
    } else {
        PG8_STAGE(PG8_SB(0, 0), cB, voffB); PG8_STAGE(PG8_SA(0, 0), cA, voffA); PG8_STAGE(PG8_SB(0, 1), cB + hstep, voffB); PG8_STAGE(PG8_SA(0, 1), cA + hstep, voffA);
        if (wr == 1) PG8_BAR;
        PG8_WAIT_V(4); PG8_BAR;
        PG8_STAGE(PG8_SB(1, 0), cB + kstep, voffB); PG8_STAGE(PG8_SA(1, 0), cA + kstep, voffA); PG8_STAGE(PG8_SB(1, 1), cB + hstep + kstep, voffB);
        PG8_WAIT_V(6); PG8_BAR;
    }
    for (;;) {
        const bool has_next = S.next(ui + 1, nxt);
        const char* nA = has_next ? (const char*)g.A + (size_t)nxt.pm * tstep : cA; const char* nB = has_next ? (const char*)g.Bt + (size_t)nxt.pn * tstep : cB;
#pragma unroll 1
        for (int t = 0; t < nt; t += 2) {
            const bool last = (t == nt - 2);
            const char* a1 = cA + (size_t)(t + 1) * kstep;
            const char* a2 = last ? nA : cA + (size_t)(t + 2) * kstep; const char* b2 = last ? nB : cB + (size_t)(t + 2) * kstep;
            const char* a3 = a2 + kstep; const char* b3 = b2 + kstep;
            if (last && has_next) S.a_ready(nxt);
            if constexpr (SP2) {
            PG8_LDB(B0, 0, 0); PG8_LDB(B1, 0, 1); PG8_SCHED; PG8_LDA(At, 0, 0); PG8_STAGE(PG8_SA(1, 1), a1 + hstep, voffA);
            PG8_WAIT_V(8); PG8_WAIT_L(0); PG8_BAR; PG8_MMA(0, 0, At, B0); PG8_MMA(0, 1, At, B1); PG8_BAR; PG8_SCHED;
            PG8_LDA(At, 0, 1); PG8_STAGE(PG8_SB(0, 0), b2, voffB); PG8_STAGE(PG8_SB(0, 1), b2 + hstep, voffB); PG8_STAGE(PG8_SA(0, 0), a2, voffA);
            PG8_WAIT_V(8); PG8_WAIT_L(0); PG8_BAR; PG8_MMA(1, 0, At, B0); PG8_MMA(1, 1, At, B1); PG8_BAR; PG8_SCHED;
            PG8_LDB(B0, 1, 0); PG8_LDB(B1, 1, 1); PG8_SCHED; PG8_LDA(At, 1, 0); PG8_STAGE(PG8_SA(0, 1), a2 + hstep, voffA);
            PG8_WAIT_V(8); PG8_WAIT_L(0); PG8_BAR; PG8_MMA(0, 0, At, B0); PG8_MMA(0, 1, At, B1); PG8_BAR; PG8_SCHED;
            PG8_LDA(At, 1, 1); PG8_STAGE(PG8_SB(1, 0), b3, voffB); PG8_STAGE(PG8_SB(1, 1), b3 + hstep, voffB); PG8_STAGE(PG8_SA(1, 0), a3, voffA);
            PG8_WAIT_V(8); PG8_WAIT_L(0); PG8_BAR; PG8_MMA(1, 0, At, B0); PG8_MMA(1, 1, At, B1); PG8_BAR; PG8_SCHED;
            } else {
            PG8_LDB(B0, 0, 0); PG8_SCHED; PG8_LDA(At, 0, 0); PG8_STAGE(PG8_SA(1, 1), a1 + hstep, voffA);
            PG8_WAIT_L(8); PG8_BAR; PG8_WAIT_L(0); PG8_MMA(0, 0, At, B0); PG8_BAR; PG8_SCHED;
            PG8_LDB(B1, 0, 1); PG8_STAGE(PG8_SB(0, 0), b2, voffB);
            PG8_BAR; PG8_WAIT_L(0); PG8_MMA(0, 1, At, B1); PG8_BAR;
            PG8_LDA(At, 0, 1); PG8_STAGE(PG8_SA(0, 0), a2, voffA);
            PG8_BAR; PG8_WAIT_L(0); PG8_MMA(1, 0, At, B0); PG8_BAR; PG8_SCHED;
            PG8_STAGE(PG8_SB(0, 1), b2 + hstep, voffB);
            PG8_WAIT_V(6); PG8_BAR; PG8_MMA(1, 1, At, B1); PG8_BAR;
            PG8_LDB(B0, 1, 0); PG8_SCHED; PG8_LDA(At, 1, 0); PG8_STAGE(PG8_SA(0, 1), a2 + hstep, voffA);
            PG8_WAIT_L(8); PG8_BAR; PG8_WAIT_L(0); PG8_MMA(0, 0, At, B0); PG8_BAR; PG8_SCHED;
            PG8_LDB(B1, 1, 1); PG8_STAGE(PG8_SB(1, 0), b3, voffB);
            PG8_BAR; PG8_WAIT_L(0); PG8_MMA(0, 1, At, B1); PG8_BAR;
            PG8_LDA(At, 1, 1); PG8_STAGE(PG8_SA(1, 0), a3, voffA);
            PG8_BAR; PG8_WAIT_L(0); PG8_MMA(1, 0, At, B0); PG8_BAR; PG8_SCHED;
            PG8_STAGE(PG8_SB(1, 1), b3 + hstep, voffB);
            PG8_WAIT_V(6); PG8_BAR; PG8_MMA(1, 1, At, B1); PG8_BAR;
            }
        }
        if constexpr (ALIGN_EPI) { if (wr == 0) PG8_BAR; }
        if constexpr (!Epi::AFTER_DRAIN) { E(acc, cur, wr, wc, fr, fq); S.done(cur); }
        if (!has_next) break;
#pragma unroll
        for (int a = 0; a < 2; ++a)
#pragma unroll
            for (int b = 0; b < 2; ++b)
#pragma unroll
                for (int m = 0; m < 4; ++m)
#pragma unroll
                    for (int n = 0; n < 2; ++n) acc[a][b][m][n] = (f32x4){0.f, 0.f, 0.f, 0.f};
        cur = nxt; cA = nA; cB = nB; ++ui;
        if constexpr (ALIGN_EPI) { if (wr == 1) PG8_BAR; }
    }
    PG8_WAIT_V(0);
    if constexpr (!ALIGN_EPI) { if (wr == 0) PG8_BAR; }
    PG8_BAR;
    if constexpr (Epi::AFTER_DRAIN) { E.fused(acc, cur, wr, wc, fr, fq, lds, wid, lane); S.done(cur); }
#undef PG8_SA
#undef PG8_SB
#undef PG8_STAGE
#undef PG8_LDA
#undef PG8_LDB
#undef PG8_MMA
#undef PG8_WAIT_V
#undef PG8_WAIT_L
#undef PG8_BAR
#undef PG8_SCHED
}
}

#define GAS __attribute__((address_space(1)))
#define LAS __attribute__((address_space(3)))
typedef unsigned short bf16;
typedef unsigned v4u __attribute__((ext_vector_type(4)));
typedef unsigned v2u __attribute__((ext_vector_type(2)));
typedef float f32x4 __attribute__((ext_vector_type(4)));
#define LDS_WAIT() asm volatile("s_waitcnt lgkmcnt(0)" ::: "memory")

#ifndef MK_N_LAUNCHES
#define MK_N_LAUNCHES 1
#endif
#ifndef MK_CG_BARRIER
#define MK_CG_BARRIER 0
#endif

constexpr int D = 1024, NTOK = 16384, NPR = 8192, TP = 256, TS = 2048, PAST = 512, SKV = 2560, FF = 4096, DEPTH = 4;
constexpr int NQKV = 2304, NRKV = 3584, KRKV = 2048;
constexpr int NWAVES = 8;
constexpr size_t O_X = 0, O_KG = 16777216, O_VG = 18874368, O_KD = 20971520, O_VD = 29360128, O_ST = 37748736, OUT_TOTAL = 46137344;
constexpr size_t MiB = 1u << 20;
constexpr size_t WS_CTL = 0, CTL_ZERO_BYTES = 1 * MiB;
constexpr size_t WS_MOD = 65536;
constexpr size_t WS_ROPE = 1 * MiB;
constexpr size_t WS_INV = 2 * MiB;
constexpr size_t WS_W = 4 * MiB;
constexpr size_t W_W1T = WS_W, W_W2T = WS_W + 8 * MiB, W_MIX = WS_W + 16 * MiB;
constexpr size_t W_WINT = W_MIX, W_WOUTT = W_MIX + 6 * MiB;
constexpr size_t W_BTR = W_MIX, W_BTL = W_MIX + 6 * MiB, W_WOT = W_MIX + 14 * MiB, W_BT2 = W_MIX + 16 * MiB;
constexpr size_t AR = 40 * MiB;
constexpr size_t A_H = AR;
constexpr size_t A_QKVRAW = AR + 32 * MiB;
constexpr size_t A_DT = AR + 32 * MiB;
constexpr size_t A_M = AR + 96 * MiB;
constexpr size_t A_QA = AR + 176 * MiB, A_QB = AR + 192 * MiB, A_KAP = AR + 208 * MiB, A_VAP = AR + 210 * MiB, A_KBP = AR + 212 * MiB, A_VBP = AR + 220 * MiB;
constexpr size_t A_KAS = AR + 228 * MiB, A_VAS = AR + 231 * MiB, A_KBS = AR + 234 * MiB, A_VBS = AR + 244 * MiB;
constexpr size_t A_HID = AR + 32 * MiB;
constexpr size_t A_F = AR + 160 * MiB;
constexpr size_t A_A2 = AR + 32 * MiB;
constexpr size_t A_XS = AR + 208 * MiB;
constexpr size_t A_Y = AR + 32 * MiB;
constexpr size_t A_RKV = AR + 96 * MiB;
constexpr size_t A_L1 = AR + 192 * MiB;
constexpr size_t A_G = A_H;
constexpr size_t A_A0 = AR + 208 * MiB, A_A1 = AR + 240 * MiB, A_EW0 = AR + 272 * MiB, A_EW1 = AR + 304 * MiB;
constexpr size_t WS_END = AR + 336 * MiB;
struct QkvMap { static constexpr size_t oQA = A_QA, oQB = A_QB, oKAP = A_KAP, oVAP = A_VAP, oKBP = A_KBP, oVBP = A_VBP, oKAS = A_KAS, oVAS = A_VAS, oKBS = A_KBS, oVBS = A_VBS, oKG = O_KG, oVG = O_VG, oKD = O_KD, oVD = O_VD; };
constexpr int CW_BAR = 4096;

constexpr int RING_OFF = 0, RING_BYTES = 131072;
constexpr int LDSCTL_OFF = RING_BYTES, MISC_OFF = LDSCTL_OFF + 320;
constexpr int LDS_BYTES = 147456;

typedef float f32x2_t __attribute__((ext_vector_type(2))); typedef __bf16 bf16x2_t __attribute__((ext_vector_type(2)));
__device__ __forceinline__ unsigned pk2(float lo, float hi) { const f32x2_t v = {lo, hi}; return __builtin_bit_cast(unsigned, __builtin_convertvector(v, bf16x2_t)); }
__device__ __forceinline__ unsigned f2bf(float f) { return pk2(f, 0.f) & 0xffffu; }
__device__ __forceinline__ float bf2f(unsigned short h) { return __builtin_bit_cast(float, (unsigned)h << 16); }
__device__ __forceinline__ float bflo(unsigned w) { return __builtin_bit_cast(float, w << 16); }
__device__ __forceinline__ float bfhi(unsigned w) { return __builtin_bit_cast(float, w & 0xffff0000u); }
__device__ __forceinline__ float wave_sum(float v) {
#pragma unroll
    for (int o = 1; o < 64; o <<= 1) v += __shfl_xor(v, o);
    return v;
}
__device__ __forceinline__ float sigmoidf_(float x) { return 1.0f / (1.0f + __expf(-x)); }
__device__ __forceinline__ float rdl(float x, int l) { return __builtin_bit_cast(float, __builtin_amdgcn_readlane(__builtin_bit_cast(int, x), l)); }

#define XB_TMO      128
#define XB_XCNT(j)  (256  + 64 * (j))
#define XB_XSUB(j)  (1280 + 64 * (j))
#define XB_XGEN(j)  (2304 + 64 * (j))
#define XB_TOP      3328
#define XB_TOPGEN   3392
#define XCD_BAR_WORDS 3456
#define XB_SPIN_CAP (1u << 18)

__device__ __forceinline__ unsigned xb_ld(unsigned* p)              { return __hip_atomic_load(p, __ATOMIC_RELAXED, __HIP_MEMORY_SCOPE_AGENT); }
__device__ __forceinline__ unsigned xb_add(unsigned* p, unsigned v) { return __hip_atomic_fetch_add(p, v, __ATOMIC_RELAXED, __HIP_MEMORY_SCOPE_AGENT); }
__device__ __forceinline__ unsigned xb_xcc_id() { return (unsigned)__builtin_amdgcn_s_getreg((3 << 11) | 20) & 0xFu; }
#define XB_SPIN(cond, bar) do { unsigned _sp = 0; while (cond) { __builtin_amdgcn_s_sleep(1); \
    if ((++_sp & 255u) == 0u) { if (xb_ld(&(bar)[XB_TMO])) break; if (_sp > XB_SPIN_CAP) { atomicAdd(&(bar)[XB_TMO], 1u); break; } } } } while (0)

struct XcdBarrier {
    unsigned* bar; unsigned x;
    volatile LAS unsigned* st;
};

__device__ __forceinline__ XcdBarrier xcd_barrier_post(unsigned* bar, volatile LAS unsigned* st, bool leader) {
    XcdBarrier b; b.bar = bar; b.x = xb_xcc_id(); b.st = st;
    if (leader) (void)xb_add(&bar[XB_XCNT(b.x)], 1u);
    return b;
}
__device__ __forceinline__ void xcd_barrier_complete(unsigned* bar, unsigned x, unsigned& nloc, unsigned& nx) {
    const unsigned G = gridDim.x * gridDim.y * gridDim.z;
    unsigned sum, cnt, mine, sp = 0u;
    for (;;) {
        sum = 0u; cnt = 0u; mine = 0u;
#pragma unroll
        for (unsigned j = 0; j < 16; ++j) { const unsigned c = xb_ld(&bar[XB_XCNT(j)]); sum += c; cnt += (c > 0u) ? 1u : 0u; mine = (j == x) ? c : mine; }
        if (sum == G) break;
        __builtin_amdgcn_s_sleep(1);
        if ((++sp & 255u) == 0u) { if (xb_ld(&bar[XB_TMO])) break; if (sp > XB_SPIN_CAP) { atomicAdd(&bar[XB_TMO], 1u); break; } }
    }
    nloc = mine > 0u ? mine : 1u; nx = cnt > 0u ? cnt : 1u;
}

__device__ __forceinline__ void xcd_barrier(const XcdBarrier& b, bool leader) {
    asm volatile("s_waitcnt vmcnt(0)" ::: "memory");
    __syncthreads();
    if (leader) {
        unsigned* bar = b.bar;
        __builtin_amdgcn_s_waitcnt(0);
        unsigned nloc = b.st[0], nx = b.st[1];
        if (nloc == 0u) { xcd_barrier_complete(bar, b.x, nloc, nx); b.st[0] = nloc; b.st[1] = nx; }
        const unsigned old = xb_add(&bar[XB_XSUB(b.x)], 1u);
        const unsigned gen = old / nloc;
        if (old + 1u == (gen + 1u) * nloc) {
            __builtin_amdgcn_fence(__ATOMIC_RELEASE, "agent");
            asm volatile("s_waitcnt vmcnt(0)" ::: "memory");
            const unsigned og = xb_add(&bar[XB_TOP], 1u);
            const unsigned tg = og / nx;
            if (og + 1u == (tg + 1u) * nx) xb_add(&bar[XB_TOPGEN], 1u);
            else XB_SPIN(xb_ld(&bar[XB_TOPGEN]) == tg, bar);
            __builtin_amdgcn_fence(__ATOMIC_ACQUIRE, "agent");
            xb_add(&bar[XB_XGEN(b.x)], 1u);
            asm volatile("s_waitcnt vmcnt(0)" ::: "memory");
        } else {
            XB_SPIN(xb_ld(&bar[XB_XGEN(b.x)]) == gen, bar);
            __builtin_amdgcn_fence(__ATOMIC_ACQUIRE, "agent");
            asm volatile("s_waitcnt vmcnt(0)" ::: "memory");
        }
    }
    __syncthreads();
}

struct Args { const float* in[32]; float* out; unsigned char* ws; int ph_lo, ph_hi; };
struct Ids { int tid, lane, wave, gw, ngw, z; };

__device__ __forceinline__ int cond_of(int m) { return m < NPR ? 4 : ((m - NPR) >> 11); }
__device__ __forceinline__ const float* mod_ptr_(const Args& a, const Ids& id, int cond, int layer) { return (const float*)(a.ws + id.z + WS_MOD) + (size_t)(cond * 4 + layer) * 6144; }

__device__ __forceinline__ void tr_item(const float* W, int ldw, int col0, const float* scale, bf16* WT, int ldt, int drow0, int dcol0, LAS float* scr, int kb, int nb, int lane, int dnb = -1) {
    const int k0 = 64 * kb, n0 = 32 * nb, dn0 = 32 * (dnb < 0 ? nb : dnb);
#pragma unroll 8
    for (int i = 0; i < 32; ++i) { const int kk = 2 * i + (lane >> 5); float v = W[(size_t)(k0 + kk) * ldw + col0 + n0 + (lane & 31)]; if (scale) v *= scale[k0 + kk]; scr[kk * 33 + (lane & 31)] = v; }
    LDS_WAIT(); asm volatile("" ::: "memory");
    const int c = lane & 7;
#pragma unroll
    for (int j = 0; j < 4; ++j) { const int n = (lane >> 3) + 8 * j; const LAS float* s = scr + (8 * c) * 33 + n;
        v4u o; o.x = pk2(s[0 * 33], s[1 * 33]); o.y = pk2(s[2 * 33], s[3 * 33]); o.z = pk2(s[4 * 33], s[5 * 33]); o.w = pk2(s[6 * 33], s[7 * 33]);
        *(v4u*)(WT + (size_t)(drow0 + dn0 + n) * ldt + dcol0 + k0 + 8 * c) = o; }
    LDS_WAIT(); asm volatile("" ::: "memory");
}
__device__ __forceinline__ bool tr_matrix(int& r, const float* W, int K, int N, bf16* WT, LAS float* scr, int lane) {
    const int nblk = N / 32, items = (K / 64) * nblk;
    if (r < items) { tr_item(W, N, 0, nullptr, WT, K, 0, 0, scr, r / nblk, r % nblk, lane); return true; }
    r -= items; return false;
}
__device__ __forceinline__ bool tr_rwproj(int& r, const float* W, int ncols, const float* mu, bf16* BT1, int drow0, LAS float* scr, int lane) {
    const int nblk = ncols / 32, items = 16 * nblk * 2;
    if (r < items) { const int half = r / (16 * nblk), q = r % (16 * nblk); tr_item(W, ncols, 0, half ? mu : nullptr, BT1, KRKV, drow0, half * 1024, scr, q / nblk, q % nblk, lane); return true; }
    r -= items; return false;
}
__device__ __forceinline__ void conv_weights(const Args& a, const Ids& id, LAS unsigned char* lds, int layer, int parts = 3) {
    LAS float* scr = (LAS float*)(lds + id.wave * 16384);
    const int j = layer >> 1;
    bf16* W1T = (bf16*)(a.ws + id.z + W_W1T); bf16* W2T = (bf16*)(a.ws + id.z + W_W2T);
    const float* mw1 = a.in[30 + id.z] + (size_t)layer * D * FF; const float* mw2 = a.in[31 + id.z] + (size_t)layer * D * FF;
    if ((layer & 1) == 0) {
        bf16* WINT = (bf16*)(a.ws + id.z + W_WINT); bf16* WOUTT = (bf16*)(a.ws + id.z + W_WOUTT);
        const float* win = a.in[12 + id.z] + (size_t)j * D * NQKV; const float* wout = a.in[13 + id.z] + (size_t)j * D * D;
        const int lo = (parts & 2) ? 0 : 4096, hi = (parts & 1) ? 2048 + 2048 + 1152 + 512 : 4096;
        for (int it = lo + id.gw; it < hi; it += id.ngw) {
            int r = it;
            if (tr_matrix(r, mw1, D, FF, W1T, scr, id.lane)) continue;
            if (tr_matrix(r, mw2, FF, D, W2T, scr, id.lane)) continue;
            if (r < 1152) {
                const int kb = r / 72, nb = r % 72; tr_item(win, NQKV, 0, nullptr, WINT, D, 0, 0, scr, kb, nb, id.lane, (nb & ~7) + 4 * (nb & 1) + ((nb >> 1) & 3)); continue; }
            r -= 1152;
            tr_matrix(r, wout, D, D, WOUTT, scr, id.lane);
        }
    } else {
        bf16* BTR = (bf16*)(a.ws + id.z + W_BTR); bf16* BT1 = (bf16*)(a.ws + id.z + W_BTL); bf16* WOT = (bf16*)(a.ws + id.z + W_WOT);
        const float* mu = a.in[17 + id.z] + (size_t)j * 6 * D;
        const float* wrkv = a.in[18 + id.z] + (size_t)j * 3 * D * D;
        const float* w1 = a.in[21 + id.z] + (size_t)j * 2 * D * 64; const float* a1 = a.in[24 + id.z] + (size_t)j * 2 * D * 64; const float* g1 = a.in[26 + id.z] + (size_t)j * D * 128;
        const float* wo = a.in[19 + id.z] + (size_t)j * D * D;
        bf16* BT2 = (bf16*)(a.ws + id.z + W_BT2); const float* w2 = a.in[22 + id.z] + (size_t)j * 2 * 64 * D; const float* a2 = a.in[25 + id.z] + (size_t)j * 2 * 64 * D; const float* g2 = a.in[27 + id.z] + (size_t)j * 128 * D;
        const int total = 2048 + 2048 + 1536 + 256 + 128 + 512 + 128 + 4 * 32 + 64 + 5120;
        for (int it = id.gw; it < total; it += id.ngw) {
            int r = it;
            if (tr_matrix(r, mw1, D, FF, W1T, scr, id.lane)) continue;
            if (tr_matrix(r, mw2, FF, D, W2T, scr, id.lane)) continue;
            if (tr_matrix(r, wrkv, D, D, BTR, scr, id.lane)) continue;
            if (tr_matrix(r, wrkv + (size_t)D * D, D, D, BTR + (size_t)D * D, scr, id.lane)) continue;
            if (tr_matrix(r, wrkv + (size_t)2 * D * D, D, D, BTR + (size_t)2 * D * D, scr, id.lane)) continue;
            if (tr_rwproj(r, w1, 64, mu + 1 * D, BT1, 0, scr, id.lane)) continue;
            if (tr_rwproj(r, w1 + (size_t)D * 64, 64, mu + 1 * D, BT1, 64, scr, id.lane)) continue;
            if (tr_rwproj(r, a1, 64, mu + 4 * D, BT1, 128, scr, id.lane)) continue;
            if (tr_rwproj(r, a1 + (size_t)D * 64, 64, mu + 4 * D, BT1, 192, scr, id.lane)) continue;
            if (tr_rwproj(r, g1, 128, mu + 5 * D, BT1, 256, scr, id.lane)) continue;
            if (tr_matrix(r, wo, D, D, WOT, scr, id.lane)) continue;
            if (r < 128) {
                v4u z = (v4u){0u, 0u, 0u, 0u}; v4u* p = (v4u*)(BT1 + (size_t)(384 + r) * KRKV);
#pragma unroll
                for (int q = 0; q < 4; ++q) p[id.lane + 64 * q] = z;
                continue; }
            r -= 128;
            if (r < 128) { const int i = r >> 5, q = r & 31; const float* W = (i < 2 ? a2 : w2) + (size_t)(i & 1) * 64 * D; tr_item(W, D, 0, nullptr, BT2, 384, 1024 * i, 64 * (i ^ 2), scr, 0, q, id.lane); continue; }
            r -= 128;
            if (r < 64) { tr_item(g2, D, 0, nullptr, BT2, 384, 4096, 256, scr, r >> 5, r & 31, id.lane); continue; }
            r -= 64;
            { const int blk = r >> 10; const int c0 = (blk < 4) ? 8 * (blk ^ 2) : 32, c1 = (blk < 4) ? 8 * (blk ^ 2) + 8 : 48;
              if (id.lane < 48 && (id.lane < c0 || id.lane >= c1)) *(v4u*)(BT2 + (size_t)r * 384 + 8 * id.lane) = (v4u){0u, 0u, 0u, 0u}; }
        }
    }
}

struct RowV { f32x4 v[4]; };
__device__ __forceinline__ void ld_row(RowV& r, const float* p, int lane) {
#pragma unroll
    for (int j = 0; j < 4; ++j) r.v[j] = ((const f32x4*)p)[lane + 64 * j];
}
__device__ __forceinline__ void ld_row_bf16(RowV& r, const bf16* p, int lane) {
#pragma unroll
    for (int j = 0; j < 4; ++j) { const v2u w = ((const v2u*)p)[lane + 64 * j]; r.v[j] = (f32x4){bflo(w.x), bfhi(w.x), bflo(w.y), bfhi(w.y)}; }
}
__device__ __forceinline__ void st_row(const RowV& r, float* p, int lane) {
#pragma unroll
    for (int j = 0; j < 4; ++j) ((f32x4*)p)[lane + 64 * j] = r.v[j];
}
__device__ __forceinline__ void st_row_bf16(const RowV& r, bf16* p, int lane) {
#pragma unroll
    for (int j = 0; j < 4; ++j) { v2u w; w.x = pk2(r.v[j][0], r.v[j][1]); w.y = pk2(r.v[j][2], r.v[j][3]); ((v2u*)p)[lane + 64 * j] = w; }
}
__device__ __forceinline__ float row_rinv(const RowV& r) {
    float s = 0.f;
#pragma unroll
    for (int j = 0; j < 4; ++j) s += (r.v[j][0] * r.v[j][0] + r.v[j][1] * r.v[j][1]) + (r.v[j][2] * r.v[j][2] + r.v[j][3] * r.v[j][3]);
    s = wave_sum(s);
    return 1.0f / sqrtf(s * (1.0f / 1024.0f) + 1e-6f);
}
__device__ __forceinline__ void norm_mod(RowV& h, const RowV& x, const float* g, const float* sc, const float* sh, int lane) {
    const float ri = row_rinv(x);
#pragma unroll
    for (int j = 0; j < 4; ++j) { const f32x4 gv = ((const f32x4*)g)[lane + 64 * j], scv = ((const f32x4*)sc)[lane + 64 * j], shv = ((const f32x4*)sh)[lane + 64 * j];
        h.v[j] = (x.v[j] * ri) * gv * (scv + 1.0f) + shv; }
}
__device__ __forceinline__ void resid_add(RowV& x, const RowV& m, const float* g, const float* gt, int lane) {
    const float ri = row_rinv(m);
#pragma unroll
    for (int j = 0; j < 4; ++j) { const f32x4 gv = ((const f32x4*)g)[lane + 64 * j], gtv = ((const f32x4*)gt)[lane + 64 * j];
        x.v[j] = x.v[j] + gtv * ((m.v[j] * ri) * gv); }
}

__device__ __forceinline__ float rope_inv(int jj) {
    const float t[16] = {1.0f, 0.5623413324356079f, 0.3162277638912201f, 0.17782793939113617f, 0.10000000149011612f, 0.05623412877321243f, 0.03162277862429619f, 0.017782794311642647f,
                         0.009999999776482582f, 0.005623413249850273f, 0.003162277862429619f, 0.0017782794311642647f, 0.0010000000474974513f, 0.000562341301701963f, 0.0003162277862429619f, 0.00017782794020604342f};
    float r = t[0];
#pragma unroll
    for (int i = 1; i < 16; ++i) r = (jj == i) ? t[i] : r;
    return r;
}
__device__ __forceinline__ void ph_prologue(const Args& a, const Ids& id, LAS unsigned char* lds) {
    float* MOD = (float*)(a.ws + id.z + WS_MOD);
    { LAS float* red = (LAS float*)lds;
      for (int it = blockIdx.x; it < 4 * 96; it += gridDim.x) {
        const int i = it / 96, n = (it % 96) * 64 + id.lane;
        float acc[5];
#pragma unroll
        for (int c = 0; c < 5; ++c) acc[c] = 0.f;
        const float* W = a.in[9 + id.z] + (size_t)i * 1024 * 6144 + n;
#pragma unroll 1
        for (int k0 = 128 * id.wave; k0 < 128 * id.wave + 128; k0 += 64) {
            float sv[5];
#pragma unroll
            for (int c = 0; c < 5; ++c) { const float x = (c < 4) ? a.in[2 + id.z][c * 1024 + k0 + id.lane] : a.in[8 + id.z][k0 + id.lane]; sv[c] = x / (1.0f + __expf(-x)); }
#pragma unroll 16
            for (int kk = 0; kk < 64; ++kk) { const float w = W[(size_t)(k0 + kk) * 6144];
#pragma unroll
                for (int c = 0; c < 5; ++c) acc[c] += w * __shfl(sv[c], kk); }
        }
#pragma unroll
        for (int c = 0; c < 5; ++c) red[(id.wave * 5 + c) * 64 + id.lane] = acc[c];
        __syncthreads();
        if (id.wave < 5) { float s = a.in[10 + id.z][i * 6144 + n];
#pragma unroll
            for (int w8 = 0; w8 < 8; ++w8) s += red[(w8 * 5 + id.wave) * 64 + id.lane];
            MOD[(size_t)(id.wave * 4 + i) * 6144 + n] = s; }
        __syncthreads();
      } }
    { float* RC = (float*)(a.ws + id.z + WS_ROPE); float* RS = RC + 2048 * 64;
      for (int e = id.gw * 64 + id.lane; e < 2048 * 64; e += id.ngw * 64) { const int t = e >> 6, d = e & 63; const int pos = (d < 32) ? (t >> 6) : (t & 63);
          const float ang = (float)pos * rope_inv(d & 15); RC[e] = __cosf(ang); RS[e] = __sinf(ang); } }
    conv_weights(a, id, lds, 0, 1);
}

struct RawBf { v2u v[4]; };
__device__ __forceinline__ void ld_raw_bf(RawBf& r, const bf16* p, int lane) {
#pragma unroll
    for (int j = 0; j < 4; ++j) r.v[j] = ((const v2u*)p)[lane + 64 * j];
}
__device__ __forceinline__ void cvt_raw_bf(RowV& o, const RawBf& r) {
#pragma unroll
    for (int j = 0; j < 4; ++j) o.v[j] = (f32x4){bflo(r.v[j].x), bfhi(r.v[j].x), bflo(r.v[j].y), bfhi(r.v[j].y)};
}
__device__ __forceinline__ const float* x_row_ptr(const Args& a, const Ids& id, int layer, int m) {
    return (layer == 0) ? ((m < NPR) ? a.in[0 + id.z] + (size_t)m * D : a.in[1 + id.z] + (size_t)(m - NPR) * D) : a.out + id.z + O_X + (size_t)m * D;
}
__device__ __forceinline__ void ph_norm0(const Args& a, const Ids& id) {
    bf16* H = (bf16*)(a.ws + id.z + A_H); const float* g0 = a.in[11 + id.z] + (size_t)(0 * 4 + 0) * D;
    int m = id.gw; RowV xn; if (m < NTOK) ld_row(xn, x_row_ptr(a, id, 0, m), id.lane);
    for (; m < NTOK; m += id.ngw) { RowV x = xn, h; if (m + id.ngw < NTOK) ld_row(xn, x_row_ptr(a, id, 0, m + id.ngw), id.lane);
        const float* md = mod_ptr_(a, id, cond_of(m), 0);
        norm_mod(h, x, g0, md + 1024, md + 0, id.lane); st_row_bf16(h, H + (size_t)m * D, id.lane); }
}
__device__ __forceinline__ void ph_resid_norm(const Args& a, const Ids& id, int layer, bool dummy = false) {
    bf16* H = (bf16*)(a.ws + id.z + (dummy ? AR + 224 * MiB : A_H)); float* xout = dummy ? (float*)(a.ws + id.z + A_F) : a.out + id.z + O_X; const bf16* M = (const bf16*)(a.ws + id.z + A_M); const float* g1 = a.in[11 + id.z] + (size_t)(layer * 4 + 1) * D; const float* g2 = a.in[11 + id.z] + (size_t)(layer * 4 + 2) * D;
    int m = id.gw; RowV xn; RawBf mn; if (m < NTOK) { ld_row(xn, x_row_ptr(a, id, layer, m), id.lane); ld_raw_bf(mn, M + (size_t)m * D, id.lane); }
    for (; m < NTOK; m += id.ngw) { RowV x = xn, mm, h; cvt_raw_bf(mm, mn);
        if (m + id.ngw < NTOK) { ld_row(xn, x_row_ptr(a, id, layer, m + id.ngw), id.lane); ld_raw_bf(mn, M + (size_t)(m + id.ngw) * D, id.lane); }
        const float* md = mod_ptr_(a, id, cond_of(m), layer);
        resid_add(x, mm, g1, md + 2048, id.lane); st_row(x, xout + (size_t)m * D, id.lane);
        norm_mod(h, x, g2, md + 4096, md + 3072, id.lane); st_row_bf16(h, H + (size_t)m * D, id.lane); }
}
__device__ __forceinline__ void ph_resid_end(const Args& a, const Ids& id, LAS unsigned char* lds, int layer, bool dummy = false) {
    bf16* H = (bf16*)(a.ws + id.z + (dummy ? AR + 96 * MiB : A_H)); float* xout = dummy ? (float*)(a.ws + id.z + AR + 32 * MiB) : a.out + id.z + O_X; const bf16* F = (const bf16*)(a.ws + id.z + A_F); const float* g3 = a.in[11 + id.z] + (size_t)(layer * 4 + 3) * D;
    const bool next_attn = (layer + 1 < DEPTH) && (((layer + 1) & 1) == 0);
    const float* g0n = a.in[11 + id.z] + (size_t)((layer + 1) * 4 + 0) * D;
    int m = id.gw; RowV xn; RawBf fn; if (m < NTOK) { ld_row(xn, a.out + id.z + O_X + (size_t)m * D, id.lane); ld_raw_bf(fn, F + (size_t)m * D, id.lane); }
    for (; m < NTOK; m += id.ngw) { RowV x = xn, ff; cvt_raw_bf(ff, fn);
        if (m + id.ngw < NTOK) { ld_row(xn, a.out + id.z + O_X + (size_t)(m + id.ngw) * D, id.lane); ld_raw_bf(fn, F + (size_t)(m + id.ngw) * D, id.lane); }
        const float* md = mod_ptr_(a, id, cond_of(m), layer);
        resid_add(x, ff, g3, md + 5120, id.lane); st_row(x, xout + (size_t)m * D, id.lane);
        if (next_attn) { RowV h; const float* mdn = mod_ptr_(a, id, cond_of(m), layer + 1); norm_mod(h, x, g0n, mdn + 1024, mdn + 0, id.lane); st_row_bf16(h, H + (size_t)m * D, id.lane); } }
    if (layer + 1 < DEPTH) conv_weights(a, id, lds, layer + 1, next_attn ? 1 : 3);
}
__device__ __forceinline__ void ph_rw_mix(const Args& a, const Ids& id, int layer) {
    bf16* A2 = (bf16*)(a.ws + id.z + A_A2); bf16* XS = (bf16*)(a.ws + id.z + A_XS); const float* g0 = a.in[11 + id.z] + (size_t)(layer * 4 + 0) * D; const float* mu6 = a.in[17 + id.z] + (size_t)(layer >> 1) * 6 * D;
    for (int g8 = id.gw; g8 < NTOK / 8; g8 += id.ngw) {
        const int m0 = g8 * 8; const int t0 = (m0 < NPR) ? (m0 & (TP - 1)) : ((m0 - NPR) & (TS - 1)); const int T = (m0 < NPR) ? TP : TS;
        const float* md = mod_ptr_(a, id, cond_of(m0), layer); const float* xp = a.out + id.z + O_X + (size_t)m0 * D;
        RowV hp, hc, hn, xr;
#pragma unroll
        for (int q = 0; q < 4; ++q) hp.v[q] = (f32x4){0.f, 0.f, 0.f, 0.f};
        if (t0 > 0) { ld_row(xr, xp - D, id.lane); norm_mod(hp, xr, g0, md + 1024, md + 0, id.lane); }
        ld_row(xr, xp, id.lane); norm_mod(hc, xr, g0, md + 1024, md + 0, id.lane);
#pragma unroll 1
        for (int i = 0; i < 8; ++i) {
#pragma unroll
            for (int q = 0; q < 4; ++q) hn.v[q] = (f32x4){0.f, 0.f, 0.f, 0.f};
            if (t0 + i + 1 < T) { ld_row(xr, xp + (size_t)(i + 1) * D, id.lane); norm_mod(hn, xr, g0, md + 1024, md + 0, id.lane); }
            RowV xx;
#pragma unroll
            for (int q = 0; q < 4; ++q) xx.v[q] = (hp.v[q] + hn.v[q]) * 0.5f - hc.v[q];
            st_row_bf16(hc, A2 + (size_t)(m0 + i) * KRKV, id.lane); st_row_bf16(xx, A2 + (size_t)(m0 + i) * KRKV + D, id.lane);
#pragma unroll
            for (int p = 0; p < 3; ++p) { const float* mu = mu6 + (size_t)(p == 0 ? 0 : p + 1) * D; RowV xm;
#pragma unroll
                for (int q = 0; q < 4; ++q) xm.v[q] = hc.v[q] + xx.v[q] * ((const f32x4*)mu)[id.lane + 64 * q];
                st_row_bf16(xm, XS + ((size_t)p * NTOK + m0 + i) * D, id.lane); }
            hp = hc; hc = hn;
        }
    }
}

__device__ __forceinline__ void row16_sum4(float& a, float& b, float& c, float& d) {
    asm("s_nop 1\n\t"
        "v_add_f32_dpp %0, %0, %0 row_ror:8 row_mask:0xf bank_mask:0xf\n\tv_add_f32_dpp %1, %1, %1 row_ror:8 row_mask:0xf bank_mask:0xf\n\tv_add_f32_dpp %2, %2, %2 row_ror:8 row_mask:0xf bank_mask:0xf\n\tv_add_f32_dpp %3, %3, %3 row_ror:8 row_mask:0xf bank_mask:0xf\n\t"
        "v_add_f32_dpp %0, %0, %0 row_ror:4 row_mask:0xf bank_mask:0xf\n\tv_add_f32_dpp %1, %1, %1 row_ror:4 row_mask:0xf bank_mask:0xf\n\tv_add_f32_dpp %2, %2, %2 row_ror:4 row_mask:0xf bank_mask:0xf\n\tv_add_f32_dpp %3, %3, %3 row_ror:4 row_mask:0xf bank_mask:0xf\n\t"
        "v_add_f32_dpp %0, %0, %0 row_ror:2 row_mask:0xf bank_mask:0xf\n\tv_add_f32_dpp %1, %1, %1 row_ror:2 row_mask:0xf bank_mask:0xf\n\tv_add_f32_dpp %2, %2, %2 row_ror:2 row_mask:0xf bank_mask:0xf\n\tv_add_f32_dpp %3, %3, %3 row_ror:2 row_mask:0xf bank_mask:0xf\n\t"
        "v_add_f32_dpp %0, %0, %0 row_ror:1 row_mask:0xf bank_mask:0xf\n\tv_add_f32_dpp %1, %1, %1 row_ror:1 row_mask:0xf bank_mask:0xf\n\tv_add_f32_dpp %2, %2, %2 row_ror:1 row_mask:0xf bank_mask:0xf\n\tv_add_f32_dpp %3, %3, %3 row_ror:1 row_mask:0xf bank_mask:0xf"
        : "+v"(a), "+v"(b), "+v"(c), "+v"(d));
}
__device__ __forceinline__ f32x4 ld_bf4(const bf16* p) { const v2u w = *(const v2u*)p; return (f32x4){bflo(w.x), bfhi(w.x), bflo(w.y), bfhi(w.y)}; }
__device__ __forceinline__ void ph_att_cache(const Args& a, const Ids& id, int layer) {
    const int j = layer >> 1, lane = id.lane;
    bf16 *KAS = (bf16*)(a.ws + id.z + A_KAS), *VAS = (bf16*)(a.ws + id.z + A_VAS), *KBS = (bf16*)(a.ws + id.z + A_KBS), *VBS = (bf16*)(a.ws + id.z + A_VBS);
    for (int r = id.gw; r < 4 * PAST; r += id.ngw) {
        const int b = r >> 9, pos = r & (PAST - 1);
        const size_t src = (size_t)((b * 2 + j) * PAST + pos), dst = (size_t)(b * SKV + pos);
#pragma unroll
        for (int q = 0; q < 2; ++q) { const int e = lane + 64 * q; KAS[dst * 128 + e] = (bf16)f2bf(a.in[3 + id.z][src * 128 + e]); VAS[dst * 128 + e] = (bf16)f2bf(a.in[4 + id.z][src * 128 + e]); }
#pragma unroll
        for (int q = 0; q < 8; ++q) { const int e = lane + 64 * q; KBS[dst * 512 + e] = (bf16)f2bf(a.in[5 + id.z][src * 512 + e]); VBS[dst * 512 + e] = (bf16)f2bf(a.in[6 + id.z][src * 512 + e]); }
    }
}

typedef short bf16x8_t __attribute__((ext_vector_type(8)));
typedef float f32x16 __attribute__((ext_vector_type(16)));
typedef short v4i16_t __attribute__((ext_vector_type(4)));
constexpr float AT_THR = 8.0f;
constexpr int AT_KP = 144, AT_KBUF = 64 * AT_KP, AT_VOFF = 2 * AT_KBUF, AT_VBUFMAX = 64 * 288, AT_WSF = AT_VOFF + 2 * AT_VBUFMAX;
static_assert(AT_WSF + 8 * 128 <= RING_BYTES, "attention LDS");
template <int NDT>
__device__ __forceinline__ void attn_unit(const bf16* Qrow0, int ldq, const bf16* Kb, int ldk, const bf16* Vb, int ldv, int S, bf16* Obf, bf16* Od, int ldo, LAS unsigned char* lds, const Ids& id) {
    constexpr int VP = (NDT == 2) ? 144 : 288, NVL = NDT / 2;
    const int lane = id.lane, w = id.wave, r32 = lane & 31, hi = lane >> 5, tid = id.tid;
    bf16x8_t qf[4];
    { const bf16* qrow = Qrow0 + (size_t)(32 * w + r32) * ldq;
#pragma unroll
      for (int s = 0; s < 4; ++s) qf[s] = *(const bf16x8_t*)(qrow + 16 * s + 8 * hi); }
    f32x16 o[NDT];
#pragma unroll
    for (int dt = 0; dt < NDT; ++dt)
#pragma unroll
        for (int r = 0; r < 16; ++r) o[dt][r] = 0.f;
    float m_run = 0.f, l_run = 0.f;
    const int NT = S >> 6;
    LAS float* wsf = (LAS float*)(lds + AT_WSF + w * 128);
    const int krow = tid >> 3, kch = tid & 7;
    v4u kreg, vreg[NVL];
#define AT_GLOAD(t) do { kreg = *(const v4u*)(Kb + (size_t)((t) * 64 + krow) * ldk + 8 * kch); \
        if (NDT == 2) vreg[0] = *(const v4u*)(Vb + (size_t)((t) * 64 + krow) * ldv + 8 * kch); \
        else { _Pragma("unroll") for (int i_ = 0; i_ < NVL; ++i_) { const int ix_ = tid + 512 * i_; vreg[i_] = *(const v4u*)(Vb + (size_t)((t) * 64 + (ix_ >> 4)) * ldv + 8 * (ix_ & 15)); } } } while (0)
#define AT_LSTORE(b) do { *(LAS v4u*)(lds + (b) * AT_KBUF + krow * AT_KP + 16 * kch) = kreg; \
        if (NDT == 2) *(LAS v4u*)(lds + AT_VOFF + (b) * AT_VBUFMAX + krow * VP + 16 * kch) = vreg[0]; \
        else { _Pragma("unroll") for (int i_ = 0; i_ < NVL; ++i_) { const int ix_ = tid + 512 * i_; *(LAS v4u*)(lds + AT_VOFF + (b) * AT_VBUFMAX + (ix_ >> 4) * VP + 16 * (ix_ & 15)) = vreg[i_]; } } } while (0)
    AT_GLOAD(0); AT_LSTORE(0);
    __syncthreads();
    const int vbase = (4 * hi + ((lane & 15) >> 2)) * VP + 32 * ((lane >> 4) & 1) + 8 * (lane & 3);
#pragma unroll 1
    for (int t = 0; t < NT; ++t) {
        const int b = t & 1;
        if (t + 1 < NT) AT_GLOAD(t + 1);
        const LAS unsigned char* Kt = lds + b * AT_KBUF + r32 * AT_KP + 16 * hi;
        const LAS unsigned char* Vt = lds + AT_VOFF + b * AT_VBUFMAX + vbase;
        f32x16 p0, p1;
        { const float nm = -m_run;
#pragma unroll
          for (int r = 0; r < 16; ++r) { p0[r] = nm; p1[r] = nm; } }
#pragma unroll
        for (int s = 0; s < 4; ++s) { const bf16x8_t k0 = *(const LAS bf16x8_t*)(Kt + 32 * s), k1 = *(const LAS bf16x8_t*)(Kt + 32 * AT_KP + 32 * s);
            p0 = __builtin_amdgcn_mfma_f32_32x32x16_bf16(k0, qf[s], p0, 0, 0, 0); p1 = __builtin_amdgcn_mfma_f32_32x32x16_bf16(k1, qf[s], p1, 0, 0, 0); }
        float mx = __builtin_fmaxf(p0[0], p1[0]);
#pragma unroll
        for (int r = 1; r < 16; ++r) mx = __builtin_fmaxf(__builtin_fmaxf(mx, p0[r]), p1[r]);
        mx = fmaxf(mx, __shfl_xor(mx, 32));
        if (t == 0 || __any(mx > AT_THR)) {
            const float dl = (t == 0) ? mx : fmaxf(mx, 0.f), al = __builtin_amdgcn_exp2f(-dl); m_run += dl; l_run *= al;
#pragma unroll
            for (int r = 0; r < 16; ++r) { p0[r] -= dl; p1[r] -= dl; }
            if (hi == 0) wsf[r32] = al;
            LDS_WAIT(); asm volatile("" ::: "memory");
            { f32x4 a4[4];
#pragma unroll
              for (int g4 = 0; g4 < 4; ++g4) a4[g4] = *(const LAS f32x4*)(wsf + 8 * g4 + 4 * hi);
#pragma unroll
              for (int dt = 0; dt < NDT; ++dt)
#pragma unroll
                  for (int r = 0; r < 16; ++r) o[dt][r] *= a4[r >> 2][r & 3]; }
            LDS_WAIT(); asm volatile("" ::: "memory");
        }
        float rs = 0.f;
#pragma unroll
        for (int r = 0; r < 16; ++r) { p0[r] = __builtin_amdgcn_exp2f(p0[r]); p1[r] = __builtin_amdgcn_exp2f(p1[r]); rs += p0[r] + p1[r]; }
        l_run += rs;
        bf16x8_t pf[4];
#pragma unroll
        for (int ks = 0; ks < 4; ++ks) { v4u pw;
#pragma unroll
            for (int dd = 0; dd < 4; ++dd) { const int r = 8 * (ks & 1) + 2 * dd; pw[dd] = (ks < 2) ? pk2(p0[r], p0[r + 1]) : pk2(p1[r], p1[r + 1]); }
            pf[ks] = __builtin_bit_cast(bf16x8_t, pw); }
#pragma unroll
        for (int ks = 0; ks < 4; ++ks)
#pragma unroll
            for (int dt = 0; dt < NDT; ++dt) {
                const v4i16_t lo = __builtin_amdgcn_ds_read_tr16_b64_v4i16((LAS v4i16_t*)(Vt + (16 * ks) * VP + 64 * dt));
                const v4i16_t hh = __builtin_amdgcn_ds_read_tr16_b64_v4i16((LAS v4i16_t*)(Vt + (16 * ks + 8) * VP + 64 * dt));
                const bf16x8_t vf = (bf16x8_t){lo[0], lo[1], lo[2], lo[3], hh[0], hh[1], hh[2], hh[3]};
                o[dt] = __builtin_amdgcn_mfma_f32_32x32x16_bf16(pf[ks], vf, o[dt], 0, 0, 0); }
        if (t + 1 < NT) AT_LSTORE(b ^ 1);
        __syncthreads();
    }
#undef AT_GLOAD
#undef AT_LSTORE
    const float lt = l_run + __shfl_xor(l_run, 32);
    int lane_e = lane; asm volatile("" : "+v"(lane_e));
    const int r32e = lane_e & 31, hie = lane_e >> 5;
    if (hi == 0) wsf[r32] = 1.0f / lt;
    LDS_WAIT(); asm volatile("" ::: "memory");
    f32x4 a4[4];
#pragma unroll
    for (int g4 = 0; g4 < 4; ++g4) a4[g4] = *(const LAS f32x4*)(wsf + 8 * g4 + 4 * hi);
    LDS_WAIT(); asm volatile("" ::: "memory");
#pragma unroll
    for (int dt = 0; dt < NDT; ++dt)
#pragma unroll
        for (int r = 0; r < 16; ++r) { const float val = o[dt][r] * a4[r >> 2][r & 3]; const int off = (32 * w + (r & 3) + 8 * (r >> 2) + 4 * hie) * ldo + 32 * dt + r32e;
            (NDT == 2 ? Obf : Od)[off] = (bf16)f2bf(val); }
}
__device__ __forceinline__ void ph_attn(const Args& a, const Ids& id, LAS unsigned char* lds, int G, int vcu) {
    const bf16 *QA = (const bf16*)(a.ws + id.z + A_QA), *QB = (const bf16*)(a.ws + id.z + A_QB), *KAP = (const bf16*)(a.ws + id.z + A_KAP), *VAP = (const bf16*)(a.ws + id.z + A_VAP), *KBP = (const bf16*)(a.ws + id.z + A_KBP), *VBP = (const bf16*)(a.ws + id.z + A_VBP);
    const bf16 *KAS = (const bf16*)(a.ws + id.z + A_KAS), *VAS = (const bf16*)(a.ws + id.z + A_VAS), *KBS = (const bf16*)(a.ws + id.z + A_KBS), *VBS = (const bf16*)(a.ws + id.z + A_VBS);
    bf16* H = (bf16*)(a.ws + id.z + A_H); bf16* DT = (bf16*)(a.ws + id.z + A_DT);
    for (int s = vcu; s < 256; s += G) {
        const int h8 = s & 7;
#pragma unroll 1
        for (int pass = 0; pass < 2; ++pass) {
            size_t m0, kvrow; int S;
            if (pass == 0) { const int b = s >> 6, qb = (s >> 3) & 7; m0 = (size_t)NPR + b * TS + qb * 256; kvrow = (size_t)b * SKV; S = SKV; }
            else { const int b = s >> 3; m0 = (size_t)b * TP; kvrow = m0; S = TP; }
            const bf16* Ka = (pass == 0 ? KAS : KAP) + kvrow * 128 + (h8 >> 2) * 64; const bf16* Va = (pass == 0 ? VAS : VAP) + kvrow * 128 + (h8 >> 2) * 64;
            const bf16* Kd = (pass == 0 ? KBS : KBP) + kvrow * 512 + h8 * 64; const bf16* Vd = (pass == 0 ? VBS : VBP) + kvrow * 512 + (h8 >> 1) * 128;
            attn_unit<2>(QA + m0 * 512 + h8 * 64, 512, Ka, 128, Va, 128, S, H + m0 * D + h8 * 64, nullptr, D, lds, id);
            attn_unit<4>(QB + m0 * 512 + h8 * 64, 512, Kd, 512, Vd, 512, S, nullptr, DT + m0 * D + h8 * 128, D, lds, id);
        }
    }
}
__device__ __forceinline__ void ph_att_comb(const Args& a, const Ids& id, int layer) {
    const int j = layer >> 1, lane = id.lane; const float lam_init = (layer == 0) ? 0.2f : 0.4707130183435842f;
    const float* lf = a.in[15 + id.z] + j * 256; const float* sg = a.in[16 + id.z] + j * 128;
    const float s01 = wave_sum(lf[lane] * lf[64 + lane]), s23 = wave_sum(lf[128 + lane] * lf[192 + lane]);
    const float lam = expf(s01) - expf(s23) + lam_init;
    const bf16* DT = (const bf16*)(a.ws + id.z + A_DT); bf16* H = (bf16*)(a.ws + id.z + A_H);
    const f32x4 gg = *(const f32x4*)(sg + 4 * (lane & 31)) * (1.0f - lam_init);
    for (int m = id.gw; m < NTOK; m += id.ngw) {
        f32x4 v[4];
#pragma unroll
        for (int hd = 0; hd < 4; ++hd) v[hd] = ld_bf4(DT + (size_t)m * D + 256 * hd + 4 * lane);
        float ss[4];
#pragma unroll
        for (int hd = 0; hd < 4; ++hd) { f32x4 o; o[0] = __shfl_xor(v[hd][0], 32); o[1] = __shfl_xor(v[hd][1], 32); o[2] = __shfl_xor(v[hd][2], 32); o[3] = __shfl_xor(v[hd][3], 32);
            v[hd] = v[hd] - o * lam;
            ss[hd] = (lane < 32) ? (v[hd][0] * v[hd][0] + v[hd][1] * v[hd][1]) + (v[hd][2] * v[hd][2] + v[hd][3] * v[hd][3]) : 0.f; }
        row16_sum4(ss[0], ss[1], ss[2], ss[3]);
#pragma unroll
        for (int hd = 0; hd < 4; ++hd) { const float tot = ss[hd] + __shfl_xor(ss[hd], 16); const float ri = 1.0f / sqrtf(tot * (1.0f / 128.0f) + 1e-6f); const f32x4 o = v[hd] * ri * gg;
            if (lane < 32) *(v2u*)(H + (size_t)m * D + 512 + hd * 128 + 4 * lane) = (v2u){pk2(o[0], o[1]), pk2(o[2], o[3])}; }
    }
}

__device__ __forceinline__ void ph_rw_prep(const Args& a, const Ids& id, int layer) {
    const int j = layer >> 1, lane = id.lane;
    const bf16* RKV = (const bf16*)(a.ws + id.z + A_RKV); float* INV = (float*)(a.ws + id.z + WS_INV);
    const float* kk_c = a.in[28 + id.z] + (size_t)(j * 3 + 0) * D;
    for (int m = id.gw; m < NTOK; m += id.ngw) {
#pragma unroll 4
        for (int h = 0; h < 16; ++h) { const float kv = bf2f(RKV[(size_t)m * 3072 + 1024 + h * 64 + lane]) * kk_c[h * 64 + lane]; const float ss = wave_sum(kv * kv); if (lane == 0) INV[m * 16 + h] = 1.0f / sqrtf(ss + 1e-12f); }
    }
}

constexpr int SC_TC = 16;
constexpr int CK_SLOT = 12288, CK_AH = 0, CK_RH = 2304, CK_KCT = 4608, CK_BCT = 6656, CK_VT = 8704, CK_TM = 9728, CK_LAK = 10240, CK_MRB = 10752, CK_MRK = 11264, CK_GC = 11776;
constexpr int CK_TMP = 8 * CK_SLOT, CK_TMPW = 4608;
constexpr int SC_YOFF = (CK_TMP + 4 * CK_TMPW) / 4;
static_assert((SC_YOFF + 4 * SC_TC * 32) * 4 <= RING_BYTES, "scan LDS");
struct ScDesc { int mbase, T, h, dir, half, b; };
__device__ __forceinline__ void sc_desc(ScDesc& d, int slot, int grp, int c) {
    if (grp == 0) { const int cs = slot >> 1; d.b = cs >> 5; d.h = (cs >> 1) & 15; d.dir = cs & 1; d.half = slot & 1; d.T = TS; d.mbase = NPR + d.b * TS; }
    else { const int pu = slot * 8 + (c >> 4), cp = pu >> 1; d.b = cp >> 5; d.h = (cp >> 1) & 15; d.dir = cp & 1; d.half = pu & 1; d.T = TP; d.mbase = d.b * TP; }
}
__device__ __forceinline__ int sc_tok(const ScDesc& d, int grp, int c, int i) { const int s = (grp == 0 ? c : (c & 15)) * SC_TC + i; return d.mbase + (d.dir ? d.T - 1 - s : s); }
typedef float f32x2 __attribute__((ext_vector_type(2)));
typedef short bf16x4_t __attribute__((ext_vector_type(4)));
#define MF16(a_, b_, c_) __builtin_amdgcn_mfma_f32_16x16x16bf16_1k(a_, b_, c_, 0, 0, 0)
#define MF32(a_, b_, c_) __builtin_amdgcn_mfma_f32_16x16x32_bf16(a_, b_, c_, 0, 0, 0)
__device__ __forceinline__ v2u pk4u(const f32x4 v) { return (v2u){pk2(v[0], v[1]), pk2(v[2], v[3])}; }
__device__ __forceinline__ bf16x4_t pk4(const f32x4 v) { return __builtin_bit_cast(bf16x4_t, pk4u(v)); }
__device__ __forceinline__ f32x2 exp2v(const f32x2 x) { return (f32x2){__builtin_amdgcn_exp2f(x[0]), __builtin_amdgcn_exp2f(x[1])}; }
struct CkRaw { unsigned r[8], k[8], a[8], e[8]; float iv[8]; unsigned v[4]; };
__device__ __forceinline__ void ck_load(CkRaw& R, const Args& a, const Ids& id, int grp, int slot, int c) {
    const int lane = id.lane, kp = lane & 31, th = lane >> 5; ScDesc d; sc_desc(d, slot, grp, c);
    const int sc = (grp == 0 ? c : (c & 15)) * SC_TC, s0 = sc + 8 * th; const int m0 = d.mbase + (d.dir ? d.T - 1 - s0 : s0); const int ms = d.dir ? -1 : 1;
    const unsigned char* bR = a.ws + id.z + A_RKV; const unsigned char* bA = a.ws + id.z + (d.dir ? A_A1 : A_A0); const unsigned char* bE = a.ws + id.z + (d.dir ? A_EW1 : A_EW0); const unsigned char* bI = a.ws + id.z + WS_INV;
    const unsigned oR = (unsigned)m0 * 6144u + (unsigned)(d.h * 128 + 4 * kp), oA = (unsigned)m0 * 2048u + (unsigned)(d.h * 128 + 4 * kp), oI = (unsigned)m0 * 64u + (unsigned)(d.h * 4);
    const unsigned sR = (unsigned)(ms * 6144), sA = (unsigned)(ms * 2048), sI = (unsigned)(ms * 64);
#pragma unroll
    for (int it = 0; it < 8; ++it) {
        R.r[it] = *(const unsigned*)(bR + (oR + it * sR)); R.k[it] = *(const unsigned*)(bR + (oR + it * sR + 2048u)); R.a[it] = *(const unsigned*)(bA + (oA + it * sA)); R.e[it] = *(const unsigned*)(bE + (oA + it * sA));
        R.iv[it] = *(const float*)(bI + (oI + it * sI)); }
    const int ip = lane & 15, tq = lane >> 4, sv = sc + 4 * tq; const int mv = d.mbase + (d.dir ? d.T - 1 - sv : sv);
    const unsigned oV = (unsigned)mv * 6144u + (unsigned)(4096 + d.h * 128 + d.half * 64 + 4 * ip);
#pragma unroll
    for (int x = 0; x < 4; ++x) R.v[x] = *(const unsigned*)(bR + (oV + x * sR));
}
__device__ __forceinline__ void ck_derive(const CkRaw& Rin, const Args& a, const Ids& id, LAS unsigned char* sb, LAS unsigned char* tb, int layer, int grp, int slot, int c) {
    CkRaw R = Rin;
#pragma unroll
    for (int it = 0; it < 8; ++it) asm volatile("" : "+v"(R.r[it]), "+v"(R.k[it]), "+v"(R.a[it]), "+v"(R.e[it]), "+v"(R.iv[it]));
#pragma unroll
    for (int x = 0; x < 4; ++x) asm volatile("" : "+v"(R.v[x]));
    const int lane = id.lane, kp = lane & 31, th = lane >> 5, j = layer >> 1; ScDesc d; sc_desc(d, slot, grp, c);
    const f32x2 kkc = *(const f32x2*)(a.in[28 + id.z] + (size_t)(j * 3 + 0) * D + d.h * 64 + 2 * kp), kac = *(const f32x2*)(a.in[28 + id.z] + (size_t)(j * 3 + 1) * D + d.h * 64 + 2 * kp);
    f32x2 cs = (f32x2){0.f, 0.f};
#pragma unroll
    for (int it = 0; it < 8; ++it) cs = cs + (f32x2){bflo(R.e[it]), bfhi(R.e[it])};
    const f32x2 oth = (f32x2){__shfl_xor(cs[0], 32), __shfl_xor(cs[1], 32)};
    const f32x2 carry = th ? oth : (f32x2){0.f, 0.f}, cumC = cs + oth;
    const f32x2 gC = exp2v(-cumC);
    f32x2 gprev = exp2v(-carry), cum = carry;
    unsigned kct0[4], kct1[4], bct0[4], bct1[4]; f32x2 kcp = (f32x2){0.f, 0.f}, bcp = (f32x2){0.f, 0.f};
#pragma unroll
    for (int it = 0; it < 8; ++it) {
        cum = cum + (f32x2){bflo(R.e[it]), bfhi(R.e[it])}; const f32x2 g = exp2v(-cum), ig = exp2v(cum);
        const f32x2 k2 = (f32x2){bflo(R.k[it]), bfhi(R.k[it])}, a2 = (f32x2){bflo(R.a[it]), bfhi(R.a[it])}, r2 = (f32x2){bflo(R.r[it]), bfhi(R.r[it])};
        const f32x2 kk = k2 * kkc * R.iv[it], Ah = kk * gprev, Bh = kk * a2 * ig, Kh = k2 * ((a2 - 1.0f) * kac + 1.0f) * ig, Rh = r2 * g, Kc = Kh * gC, Bc = Bh * gC;
        gprev = g;
        const int ro = (8 * th + it) * 144 + 4 * kp;
        *(LAS unsigned*)(sb + CK_AH + ro) = pk2(Ah[0], Ah[1]); *(LAS unsigned*)(sb + CK_RH + ro) = pk2(Rh[0], Rh[1]);
        *(LAS unsigned*)(tb + ro) = pk2(Bh[0], Bh[1]); *(LAS unsigned*)(tb + 2304 + ro) = pk2(Kh[0], Kh[1]);
        if (it & 1) { kct0[it >> 1] = pk2(kcp[0], Kc[0]); kct1[it >> 1] = pk2(kcp[1], Kc[1]); bct0[it >> 1] = pk2(bcp[0], Bc[0]); bct1[it >> 1] = pk2(bcp[1], Bc[1]); }
        else { kcp = Kc; bcp = Bc; }
    }
    *(LAS v4u*)(sb + CK_KCT + (2 * kp) * 32 + 16 * th) = (v4u){kct0[0], kct0[1], kct0[2], kct0[3]}; *(LAS v4u*)(sb + CK_KCT + (2 * kp + 1) * 32 + 16 * th) = (v4u){kct1[0], kct1[1], kct1[2], kct1[3]};
    *(LAS v4u*)(sb + CK_BCT + (2 * kp) * 32 + 16 * th) = (v4u){bct0[0], bct0[1], bct0[2], bct0[3]}; *(LAS v4u*)(sb + CK_BCT + (2 * kp + 1) * 32 + 16 * th) = (v4u){bct1[0], bct1[1], bct1[2], bct1[3]};
    if (th == 0) *(LAS f32x2*)(sb + CK_GC + 8 * kp) = gC;
    const int ip = lane & 15, tq = lane >> 4;
    *(LAS v2u*)(sb + CK_VT + (2 * ip) * 32 + 8 * tq) = (v2u){(R.v[0] & 0xffffu) | (R.v[1] << 16), (R.v[2] & 0xffffu) | (R.v[3] << 16)};
    *(LAS v2u*)(sb + CK_VT + (2 * ip + 1) * 32 + 8 * tq) = (v2u){(R.v[0] >> 16) | (R.v[1] & 0xffff0000u), (R.v[2] >> 16) | (R.v[3] & 0xffff0000u)};
}
__device__ __forceinline__ void ck_products(const Ids& id, LAS unsigned char* sb, const LAS unsigned char* tb) {
    const int ln = id.lane & 15, q = id.lane >> 4;
    const f32x4 zero = (f32x4){0.f, 0.f, 0.f, 0.f};
    f32x4 P0 = zero, P1 = zero, P2 = zero, P3 = zero, P4 = zero;
#pragma unroll
    for (int ks = 0; ks < 2; ++ks) { const int fo = ln * 144 + 64 * ks + 16 * q;
        const bf16x8_t ah = *(const LAS bf16x8_t*)(sb + CK_AH + fo), rh = *(const LAS bf16x8_t*)(sb + CK_RH + fo), bh = *(const LAS bf16x8_t*)(tb + fo), kh = *(const LAS bf16x8_t*)(tb + 2304 + fo);
        P0 = MF32(ah, bh, P0);
        P1 = MF32(bh, ah, P1);
        P2 = MF32(kh, ah, P2);
        P3 = MF32(bh, rh, P3);
        P4 = MF32(kh, rh, P4); }
    f32x4 b1, a1, z0, lak, mrb, mrk;
#pragma unroll
    for (int jj = 0; jj < 4; ++jj) { const int row = 4 * q + jj;
        b1[jj] = (ln < row) ? -P0[jj] : 0.f;
        a1[jj] = (row < ln) ? -P1[jj] : 0.f;
        z0[jj] = a1[jj] + ((row == ln) ? 1.f : 0.f);
        lak[jj] = (row < ln) ? P2[jj] : 0.f; mrb[jj] = (row <= ln) ? P3[jj] : 0.f; mrk[jj] = (row <= ln) ? P4[jj] : 0.f; }
    *(LAS v2u*)(sb + CK_LAK + ln * 32 + 8 * q) = pk4u(lak); *(LAS v2u*)(sb + CK_MRB + ln * 32 + 8 * q) = pk4u(mrb); *(LAS v2u*)(sb + CK_MRK + ln * 32 + 8 * q) = pk4u(mrk);
    const bf16x4_t a1b = pk4(a1), b1b = pk4(b1);
    const f32x4 b2 = MF16(a1b, b1b, zero), a2 = MF16(b1b, a1b, zero);
    const bf16x4_t b2b = pk4(b2), a2b = pk4(a2);
    const f32x4 z1 = MF16(b2b, pk4(z0), z0);
    const f32x4 b4 = MF16(a2b, b2b, zero), a4 = MF16(b2b, a2b, zero);
    const bf16x4_t b4b = pk4(b4), a4b = pk4(a4);
    const f32x4 z2 = MF16(b4b, pk4(z1), z1);
    const f32x4 b8 = MF16(a4b, b4b, zero);
    const f32x4 z3 = MF16(pk4(b8), pk4(z2), z2);
    *(LAS v2u*)(sb + CK_TM + ln * 32 + 8 * q) = pk4u(z3);
}
__device__ __forceinline__ void sc_flush(const Args& a, const Ids& id, const LAS float* L, int hw, int slot, int c) {
    bf16* Y = (bf16*)(a.ws + id.z + A_Y);
#pragma unroll
    for (int q = 0; q < 2; ++q) { const int idx = hw * 64 + id.lane + 256 * q, fg = idx >> 8, s = (idx >> 4) & 15, rp = idx & 15; ScDesc d; sc_desc(d, slot, fg, c);
        const f32x2 yv = *(const LAS f32x2*)(L + SC_YOFF + ((c & 1) * 2 + fg) * SC_TC * 32 + s * 32 + 2 * rp);
        *(unsigned*)(Y + ((size_t)d.dir * NTOK + sc_tok(d, fg, c, s)) * D + d.h * 64 + d.half * 32 + 2 * rp) = pk2(yv[0], yv[1]); }
}
__device__ __forceinline__ void ph_rw_scan(const Args& a, const Ids& id, LAS unsigned char* lds, int layer, int G, int vcu) {
    const int j = layer >> 1, lane = id.lane, w = id.wave;
    LAS float* L = (LAS float*)lds;
    constexpr int NC = TS / SC_TC;
    for (int slot = vcu; slot < 256; slot += G) {
        if (w >= 4) {
            const int hw = w - 4, hg = hw >> 1, hp = hw & 1; CkRaw R;
            LAS unsigned char* tb = lds + CK_TMP + hw * CK_TMPW;
            ck_load(R, a, id, hg, slot, hp);
            ck_derive(R, a, id, lds + (hg * 4 + hp) * CK_SLOT, tb, layer, hg, slot, hp);
            if (hp == 0) { ck_products(id, lds + (hg * 4) * CK_SLOT, tb); ck_load(R, a, id, hg, slot, 2); }
            __syncthreads();
#pragma unroll 1
            for (int n = 0; n < NC; ++n) {
                if ((n & 1) == hp) { if (n + 2 < NC) ck_derive(R, a, id, lds + (hg * 4 + ((n + 2) & 3)) * CK_SLOT, tb, layer, hg, slot, n + 2); }
                else { if (n + 3 < NC) ck_load(R, a, id, hg, slot, n + 3); if (n + 1 < NC) ck_products(id, lds + (hg * 4 + ((n + 1) & 3)) * CK_SLOT, tb); }
                if (n > 0) sc_flush(a, id, L, hw, slot, n - 1);
                __syncthreads();
            }
            sc_flush(a, id, L, hw, slot, NC - 1);
        } else {
            const int grp = w >> 1, ln = lane & 15, q = lane >> 4, i0l = 16 * (w & 1);
            const f32x4 zero = (f32x4){0.f, 0.f, 0.f, 0.f};
            f32x4 S0 = zero, S1 = zero, S2 = zero, S3 = zero;
            if (grp == 0) { ScDesc d; sc_desc(d, slot, 0, 0);
                const float* sp = a.in[7 + id.z] + ((((size_t)(d.b * 2 + j) * 2 + d.dir) * 16 + d.h) * 64 + d.half * 32 + i0l + ln) * 64 + 4 * q;
                S0 = *(const f32x4*)sp; S1 = *(const f32x4*)(sp + 16); S2 = *(const f32x4*)(sp + 32); S3 = *(const f32x4*)(sp + 48); }
            __syncthreads();
#pragma unroll 1
            for (int c = 0; c < NC; ++c) {
                if (grp == 1 && (c & 15) == 0) { S0 = zero; S1 = zero; S2 = zero; S3 = zero; }
                const LAS unsigned char* sb = lds + (grp * 4 + (c & 3)) * CK_SLOT;
                const bf16x8_t sf0 = __builtin_bit_cast(bf16x8_t, (v4u){pk2(S0[0], S0[1]), pk2(S0[2], S0[3]), pk2(S1[0], S1[1]), pk2(S1[2], S1[3])});
                const bf16x8_t sf1 = __builtin_bit_cast(bf16x8_t, (v4u){pk2(S2[0], S2[1]), pk2(S2[2], S2[3]), pk2(S3[0], S3[1]), pk2(S3[2], S3[3])});
                const int po = ln * 144 + 8 * q;
                const v2u ah0 = *(const LAS v2u*)(sb + CK_AH + po), ah1 = *(const LAS v2u*)(sb + CK_AH + po + 32), ah2 = *(const LAS v2u*)(sb + CK_AH + po + 64), ah3 = *(const LAS v2u*)(sb + CK_AH + po + 96);
                const v2u rh0 = *(const LAS v2u*)(sb + CK_RH + po), rh1 = *(const LAS v2u*)(sb + CK_RH + po + 32), rh2 = *(const LAS v2u*)(sb + CK_RH + po + 64), rh3 = *(const LAS v2u*)(sb + CK_RH + po + 96);
                const int so = ln * 32 + 8 * q;
                const bf16x4_t vt = *(const LAS bf16x4_t*)(sb + CK_VT + i0l * 32 + so), lak = *(const LAS bf16x4_t*)(sb + CK_LAK + so), mrk = *(const LAS bf16x4_t*)(sb + CK_MRK + so),
                               mrb = *(const LAS bf16x4_t*)(sb + CK_MRB + so), tm = *(const LAS bf16x4_t*)(sb + CK_TM + so);
                f32x4 u0 = MF16(lak, vt, zero), y = MF16(mrk, vt, zero);
                u0 = MF32(__builtin_bit_cast(bf16x8_t, (v4u){ah0.x, ah0.y, ah1.x, ah1.y}), sf0, u0); u0 = MF32(__builtin_bit_cast(bf16x8_t, (v4u){ah2.x, ah2.y, ah3.x, ah3.y}), sf1, u0);
                y = MF32(__builtin_bit_cast(bf16x8_t, (v4u){rh0.x, rh0.y, rh1.x, rh1.y}), sf0, y); y = MF32(__builtin_bit_cast(bf16x8_t, (v4u){rh2.x, rh2.y, rh3.x, rh3.y}), sf1, y);
                const f32x4 gc0 = *(const LAS f32x4*)(sb + CK_GC + 16 * q), gc1 = *(const LAS f32x4*)(sb + CK_GC + 64 + 16 * q), gc2 = *(const LAS f32x4*)(sb + CK_GC + 128 + 16 * q), gc3 = *(const LAS f32x4*)(sb + CK_GC + 192 + 16 * q);
                S0 = MF16(*(const LAS bf16x4_t*)(sb + CK_KCT + so), vt, S0 * gc0); S1 = MF16(*(const LAS bf16x4_t*)(sb + CK_KCT + 512 + so), vt, S1 * gc1);
                S2 = MF16(*(const LAS bf16x4_t*)(sb + CK_KCT + 1024 + so), vt, S2 * gc2); S3 = MF16(*(const LAS bf16x4_t*)(sb + CK_KCT + 1536 + so), vt, S3 * gc3);
                const f32x4 u = MF16(tm, pk4(u0), zero);
                const bf16x4_t nub = pk4(-u);
                y = MF16(mrb, nub, y);
                S0 = MF16(*(const LAS bf16x4_t*)(sb + CK_BCT + so), nub, S0); S1 = MF16(*(const LAS bf16x4_t*)(sb + CK_BCT + 512 + so), nub, S1);
                S2 = MF16(*(const LAS bf16x4_t*)(sb + CK_BCT + 1024 + so), nub, S2); S3 = MF16(*(const LAS bf16x4_t*)(sb + CK_BCT + 1536 + so), nub, S3);
                LAS float* yb = L + SC_YOFF + ((c & 1) * 2 + grp) * SC_TC * 32 + i0l + ln;
#pragma unroll
                for (int jj = 0; jj < 4; ++jj) yb[(4 * q + jj) * 32] = y[jj];
                if (grp == 1 && (c & 15) == 15) { ScDesc d; sc_desc(d, slot, 1, c);
                    float* dp = a.out + id.z + O_ST + ((((size_t)(d.b * 2 + j) * 2 + d.dir) * 16 + d.h) * 64 + d.half * 32 + i0l + ln) * 64 + 4 * q;
                    *(f32x4*)dp = S0; *(f32x4*)(dp + 16) = S1; *(f32x4*)(dp + 32) = S2; *(f32x4*)(dp + 48) = S3; }
                __syncthreads();
            }
        }
        __syncthreads();
    }
}
__device__ __forceinline__ void ph_rw_post(const Args& a, const Ids& id, int layer) {
    const int j = layer >> 1, lane = id.lane;
    const bf16* RKV = (const bf16*)(a.ws + id.z + A_RKV); const bf16* Y = (const bf16*)(a.ws + id.z + A_Y);
    const bf16 *A0 = (const bf16*)(a.ws + id.z + A_A0), *A1 = (const bf16*)(a.ws + id.z + A_A1); bf16* H = (bf16*)(a.ws + id.z + A_H);
    const float* kvec = a.in[28 + id.z] + (size_t)j * 3 * D; const float* lnx = a.in[29 + id.z] + (size_t)j * 2 * D;
    f32x4 ka[4], rk[4], l0[4], l1[4];
#pragma unroll
    for (int q = 0; q < 4; ++q) { const int c = 4 * lane + 256 * q; ka[q] = *(const f32x4*)(kvec + D + c); rk[q] = *(const f32x4*)(kvec + 2 * D + c); l0[q] = *(const f32x4*)(lnx + c); l1[q] = *(const f32x4*)(lnx + D + c); }
    for (int m = id.gw; m < NTOK; m += id.ngw) {
        f32x4 y[4], r[4], k[4], v[4], a0[4], a1[4], g[4];
#pragma unroll
        for (int q = 0; q < 4; ++q) { const int c = 4 * lane + 256 * q; y[q] = ld_bf4(Y + (size_t)m * D + c) + ld_bf4(Y + ((size_t)NTOK + m) * D + c);
            r[q] = ld_bf4(RKV + (size_t)m * 3072 + c); k[q] = ld_bf4(RKV + (size_t)m * 3072 + 1024 + c); v[q] = ld_bf4(RKV + (size_t)m * 3072 + 2048 + c);
            a0[q] = ld_bf4(A0 + (size_t)m * D + c); a1[q] = ld_bf4(A1 + (size_t)m * D + c); g[q] = ld_bf4(H + (size_t)m * D + c); }
        float s[4], qv[4], bs[4];
#pragma unroll
        for (int q = 0; q < 4; ++q) s[q] = (y[q][0] + y[q][1]) + (y[q][2] + y[q][3]);
        row16_sum4(s[0], s[1], s[2], s[3]);
#pragma unroll
        for (int q = 0; q < 4; ++q) { const float mean = s[q] * (1.0f / 64.0f); y[q] = y[q] - mean; qv[q] = (y[q][0] * y[q][0] + y[q][1] * y[q][1]) + (y[q][2] * y[q][2] + y[q][3] * y[q][3]);
            const f32x4 kds = k[q] * ((a0[q] - 1.0f) * ka[q] + 1.0f) + k[q] * ((a1[q] - 1.0f) * ka[q] + 1.0f); const f32x4 t = r[q] * kds * rk[q]; bs[q] = (t[0] + t[1]) + (t[2] + t[3]); }
        row16_sum4(qv[0], qv[1], qv[2], qv[3]);
        row16_sum4(bs[0], bs[1], bs[2], bs[3]);
#pragma unroll
        for (int q = 0; q < 4; ++q) { const float ri = 1.0f / sqrtf(qv[q] * (1.0f / 64.0f) + 64e-5f); const f32x4 o = ((y[q] * ri) * l0[q] + l1[q] + v[q] * bs[q]) * g[q];
            *(v2u*)(H + (size_t)m * D + 4 * lane + 256 * q) = (v2u){pk2(o[0], o[1]), pk2(o[2], o[3])}; }
    }
}

enum Kind { K_PRO = 0, K_NORM0 = 1, K_QKV = 2, K_APOST = 3, K_ATTN = 4, K_ACOMB = 5, K_MIXOUT = 6, K_RNORM = 7, K_MLP1 = 8, K_MLP2 = 9, K_REND = 10,
            K_RMIX = 11, K_RKV = 12, K_RPREP = 13, K_RSCAN = 14, K_RPOST = 15 };
constexpr int NPH = 38;
#ifndef PROBE_MASK
#define PROBE_MASK 0
#endif
#ifndef PROBE_REPS
#define PROBE_REPS 1
#endif
template <int KIND, int LAYER>
__device__ __forceinline__ void run_phase(const Args& a, LAS unsigned char* lds, int G, int bx, int vcu, int wave_s, int rep) {
    Ids id; { int lv; asm volatile("v_mbcnt_lo_u32_b32 %0, -1, 0\n\tv_mbcnt_hi_u32_b32 %0, -1, %0" : "=v"(lv)); int zz; asm volatile("s_mov_b32 %0, 0" : "=s"(zz)); id.lane = lv; id.z = zz; }
    id.wave = wave_s; id.tid = wave_s * 64 + id.lane; id.gw = vcu * NWAVES + id.wave; id.ngw = G * NWAVES;
    constexpr int layer = LAYER;
    if constexpr (KIND == K_PRO) ph_prologue(a, id, lds);
    else if constexpr (KIND == K_NORM0) ph_norm0(a, id);
    else if constexpr (KIND == K_QKV) {
        constexpr int j = layer >> 1;
        pg8::Gemm g{(const bf16*)(a.ws + id.z + A_H), (const bf16*)(a.ws + id.z + W_WINT), NTOK, NQKV, D}; pg8::StaticOrder S; S.init(NTOK, NQKV, G, bx);
        const float* RC = (const float*)(a.ws + id.z + WS_ROPE);
        pg8::EpiQkv<QkvMap> E{a.ws + id.z, a.out + id.z, a.in[14 + id.z] + j * 128, RC, RC + 2048 * 64, j};
        pg8::gemm_phase<pg8::EpiQkv<QkvMap>, pg8::StaticOrder, true, true>(lds + RING_OFF, g, S, E, id.wave);
        { Ids id2 = id; int lv; asm volatile("v_mbcnt_lo_u32_b32 %0, -1, 0\n\tv_mbcnt_hi_u32_b32 %0, -1, %0" : "=v"(lv)); int zz; asm volatile("s_mov_b32 %0, 0" : "=s"(zz));
          id2.lane = lv; id2.z = zz; id2.tid = id.wave * 64 + lv;
          if (G == 256) { if (bx >= 64) { id2.gw = (bx - 64) * NWAVES + id.wave; id2.ngw = 192 * NWAVES; ph_att_cache(a, id2, layer); conv_weights(a, id2, lds, layer, 2); } }
          else { ph_att_cache(a, id2, layer); conv_weights(a, id2, lds, layer, 2); } }
    }
    else if constexpr (KIND == K_MIXOUT) {
        pg8::Gemm g{(const bf16*)(a.ws + id.z + A_H), (const bf16*)(a.ws + id.z + ((layer & 1) ? W_WOT : W_WOUTT)), NTOK, D, D}; pg8::StaticOrder S; S.init(NTOK, D, G, bx);
        pg8::EpiBf16<0> E{(bf16*)(a.ws + id.z + A_M), D, 1 << 20, nullptr, 0};
        pg8::gemm_phase<pg8::EpiBf16<0>, pg8::StaticOrder, true, true>(lds + RING_OFF, g, S, E, id.wave);
    }
    else if constexpr (KIND == K_MLP2) {
        pg8::Gemm g{(const bf16*)(a.ws + id.z + A_HID), (const bf16*)(a.ws + id.z + W_W2T), NTOK, D, FF}; pg8::StaticOrder S; S.init(NTOK, D, G, bx);
        pg8::EpiBf16<0> E{(bf16*)(a.ws + id.z + A_F), D, 1 << 20, nullptr, 0};
        pg8::gemm_phase<pg8::EpiBf16<0>, pg8::StaticOrder, true, true>(lds + RING_OFF, g, S, E, id.wave);
    }
    else if constexpr (KIND == K_MLP1) {
        pg8::Gemm g{(const bf16*)(a.ws + id.z + A_H), (const bf16*)(a.ws + id.z + W_W1T), NTOK, FF, D}; pg8::StaticOrder S; S.init(NTOK, FF, G, bx);
        pg8::EpiBf16<2> E{(bf16*)(a.ws + id.z + A_HID), FF, 1 << 20, nullptr, 0};
        pg8::gemm_phase<pg8::EpiBf16<2>, pg8::StaticOrder, true, true>(lds + RING_OFF, g, S, E, id.wave);
    }
    else if constexpr (KIND == K_RKV) {
        {
            pg8::Gemm g{(const bf16*)(a.ws + id.z + A_A2), (const bf16*)(a.ws + id.z + W_BTL), NTOK, 512, KRKV}; pg8::StaticOrder S; S.init(NTOK, 512, G, bx);
            pg8::EpiL1 E{(bf16*)(a.ws + id.z + A_L1)};
            pg8::gemm_phase<pg8::EpiL1, pg8::StaticOrder, true, true>(lds + RING_OFF, g, S, E, id.wave); }
        {
            pg8::Gemm g{(const bf16*)(a.ws + id.z + A_XS), (const bf16*)(a.ws + id.z + W_BTR), 3 * NTOK, 3072, D}; pg8::RkvOrder S{bx};
            pg8::EpiRkv3 E{(bf16*)(a.ws + id.z + A_RKV)};
            pg8::gemm_phase<pg8::EpiRkv3, pg8::RkvOrder, true, true>(lds + RING_OFF, g, S, E, id.wave); }
    }
    else if constexpr (KIND == K_RPREP) {
        constexpr int j = layer >> 1;
        pg8::Gemm g{(const bf16*)(a.ws + id.z + A_L1), (const bf16*)(a.ws + id.z + W_BT2), NTOK, 5120, 384}; pg8::StaticOrder S; S.init(NTOK, 5120, G, bx);
        static_assert(A_A1 - A_A0 == 32 * MiB && A_EW0 - A_A0 == 64 * MiB && A_EW1 - A_A0 == 96 * MiB, "EpiLora2 output stride");
        pg8::EpiLora2 E{(bf16*)(a.ws + id.z + A_A0), (size_t)16 * MiB, (bf16*)(a.ws + id.z + A_G), a.in[23 + id.z] + (size_t)j * 2 * D, a.in[20 + id.z] + (size_t)j * 2 * D};
        pg8::gemm_phase<pg8::EpiLora2, pg8::StaticOrder, true, true>(lds + RING_OFF, g, S, E, id.wave);
        { Ids id2 = id; int lv; asm volatile("v_mbcnt_lo_u32_b32 %0, -1, 0\n\tv_mbcnt_hi_u32_b32 %0, -1, %0" : "=v"(lv)); int zz; asm volatile("s_mov_b32 %0, 0" : "=s"(zz));
          id2.lane = lv; id2.z = zz; id2.tid = id.wave * 64 + lv; ph_rw_prep(a, id2, layer); }
    }
    else if constexpr (KIND == K_ATTN) ph_attn(a, id, lds, G, vcu);
    else if constexpr (KIND == K_ACOMB) ph_att_comb(a, id, layer);
    else if constexpr (KIND == K_RNORM) ph_resid_norm(a, id, layer, rep + 1 < (((PROBE_MASK >> K_RNORM) & 1) ? PROBE_REPS : 1));
    else if constexpr (KIND == K_REND) ph_resid_end(a, id, lds, layer, rep + 1 < (((PROBE_MASK >> K_REND) & 1) ? PROBE_REPS : 1));
    else if constexpr (KIND == K_RMIX) ph_rw_mix(a, id, layer);
    else if constexpr (KIND == K_RSCAN) { if (rep > 0) { ph_rw_prep(a, id, layer); __syncthreads(); cg::this_grid().sync(); } ph_rw_scan(a, id, lds, layer, G, vcu); }
    else if constexpr (KIND == K_RPOST) ph_rw_post(a, id, layer);
}

__global__ void __launch_bounds__(NWAVES * 64, 2) mega_fwd(Args a) {
    extern __shared__ __attribute__((aligned(16))) unsigned char lds_raw[];
    LAS unsigned char* lds = (LAS unsigned char*)lds_raw;
    const int G = gridDim.x, bx = blockIdx.x; const int vcu = (G % 8 == 0) ? (bx % 8) * (G / 8) + bx / 8 : bx;
    volatile LAS unsigned* MISC = (volatile LAS unsigned*)(lds + MISC_OFF);
    for (int u = threadIdx.x; u < (LDS_BYTES - LDSCTL_OFF) / 4; u += NWAVES * 64) ((LAS unsigned*)(lds + LDSCTL_OFF))[u] = 0u;
    __syncthreads();
#if MK_N_LAUNCHES == 1 && !MK_CG_BARRIER
    XcdBarrier bar = xcd_barrier_post((unsigned*)(a.ws + WS_CTL) + CW_BAR, MISC + 8, threadIdx.x == 0);
#endif
    (void)MISC;
    const int lo = a.ph_lo, hi = a.ph_hi;
    const int wave_s = __builtin_amdgcn_readfirstlane(threadIdx.x >> 6);
#if MK_N_LAUNCHES == 1
#if MK_CG_BARRIER
#define GRID_BAR(ph) cg::this_grid().sync()
#else
#define GRID_BAR(ph) do { if ((ph) == 0) cg::this_grid().sync(); else { int l_; asm volatile("v_mbcnt_lo_u32_b32 %0, -1, 0\n\tv_mbcnt_hi_u32_b32 %0, -1, %0" : "=v"(l_)); xcd_barrier(bar, wave_s == 0 && l_ == 0); } } while (0)
#endif
#else
#define GRID_BAR(ph) do { } while (0)
#endif
#define PHASE(ph, KIND, LAYER) do { if (lo <= (ph) && (ph) < hi) { constexpr int nrep_ = ((PROBE_MASK >> (KIND)) & 1) ? PROBE_REPS : 1; \
        _Pragma("unroll 1") for (int rep_ = 0; rep_ < nrep_; ++rep_) { run_phase<KIND, LAYER>(a, lds, G, bx, vcu, wave_s, rep_); if (rep_ + 1 < nrep_) { __syncthreads(); cg::this_grid().sync(); } } \
        if ((ph) + 1 < hi) GRID_BAR(ph); } } while (0)
#define ATTN_LAYER(p0, L) PHASE((p0) + 0, K_QKV, L); PHASE((p0) + 1, K_ATTN, L); PHASE((p0) + 2, K_ACOMB, L); PHASE((p0) + 3, K_MIXOUT, L); \
        PHASE((p0) + 4, K_RNORM, L); PHASE((p0) + 5, K_MLP1, L); PHASE((p0) + 6, K_MLP2, L); PHASE((p0) + 7, K_REND, L)
#define RWKV_LAYER(p0, L) PHASE((p0) + 0, K_RMIX, L); PHASE((p0) + 1, K_RKV, L); PHASE((p0) + 2, K_RPREP, L); PHASE((p0) + 3, K_RSCAN, L); PHASE((p0) + 4, K_RPOST, L); PHASE((p0) + 5, K_MIXOUT, L); \
        PHASE((p0) + 6, K_RNORM, L); PHASE((p0) + 7, K_MLP1, L); PHASE((p0) + 8, K_MLP2, L); PHASE((p0) + 9, K_REND, L)
    PHASE(0, K_PRO, 0); PHASE(1, K_NORM0, 0);
    ATTN_LAYER(2, 0); RWKV_LAYER(10, 1); ATTN_LAYER(20, 2); RWKV_LAYER(28, 3);
#undef PHASE
#undef ATTN_LAYER
#undef RWKV_LAYER
#undef GRID_BAR
}

extern "C" void kernel_launch(void* const* d_in, const int* in_sizes, int n_in, void* d_out, int out_size, void* d_ws, size_t ws_size, hipStream_t stream) {
    static int grid = 0;
    if (grid == 0) {
        if (n_in != 32 || (size_t)out_size != OUT_TOTAL || ws_size < WS_END) { fprintf(stderr, "kernel_launch: unexpected problem (n_in %d, out %d, ws %zu; need ws >= %zu); nothing launched\n", n_in, out_size, ws_size, (size_t)WS_END); grid = -1; return; }
        int dev = 0, cus = 0, per_cu = 0;
        if (hipGetDevice(&dev) != hipSuccess || hipDeviceGetAttribute(&cus, hipDeviceAttributeMultiprocessorCount, dev) != hipSuccess) { grid = -1; return; }
        if (hipFuncSetAttribute((const void*)mega_fwd, hipFuncAttributeMaxDynamicSharedMemorySize, LDS_BYTES) != hipSuccess) { fprintf(stderr, "kernel_launch: hipFuncSetAttribute failed\n"); grid = -1; return; }
        if (hipOccupancyMaxActiveBlocksPerMultiprocessor(&per_cu, (const void*)mega_fwd, NWAVES * 64, LDS_BYTES) != hipSuccess || per_cu < 1) { fprintf(stderr, "kernel_launch: occupancy query failed (%d)\n", per_cu); (void)hipGetLastError(); per_cu = 1; }
        grid = cus * (per_cu < 1 ? 1 : 1);
        fprintf(stderr, "kernel_launch: %d CUs, occupancy %d/CU, grid %d\n", cus, per_cu, grid);
    }
    if (grid < 0) return;
    (void)in_sizes;
    if (hipMemsetAsync((char*)d_ws + WS_CTL, 0, CTL_ZERO_BYTES, stream) != hipSuccess) { fprintf(stderr, "kernel_launch: memset failed\n"); return; }
    Args a{};
    for (int i = 0; i < 32; ++i) a.in[i] = (const float*)d_in[i];
    a.out = (float*)d_out; a.ws = (unsigned char*)d_ws;
#if MK_N_LAUNCHES == 1
    a.ph_lo = 0; a.ph_hi = NPH;
    void* args[] = {&a};
    hipError_t e = hipLaunchCooperativeKernel((const void*)mega_fwd, dim3(grid), dim3(NWAVES * 64), args, LDS_BYTES, stream);
    if (e != hipSuccess) fprintf(stderr, "kernel_launch: cooperative launch failed: %s (grid %d)\n", hipGetErrorString(e), grid);
#else
    for (int ph = 0; ph < NPH; ++ph) {
        a.ph_lo = ph; a.ph_hi = ph + 1;
        hipLaunchKernelGGL(mega_fwd, dim3(grid), dim3(NWAVES * 64), LDS_BYTES, stream, a);
    }
#endif
}
```

```cpp
#include <hip/hip_runtime.h>
#include <hip/hip_cooperative_groups.h>
#include <cstdio>
#include <cstdint>
namespace cg = cooperative_groups;
namespace pg8 {
#define PG8_LAS __attribute__((address_space(3)))
typedef unsigned short bf16_t;
typedef short bf16x8 __attribute__((ext_vector_type(8)));
typedef float f32x4 __attribute__((ext_vector_type(4)));
typedef unsigned u32x4 __attribute__((ext_vector_type(4)));
constexpr int BM = 256, BK = 64, HALF = 128, HTB = HALF * BK * 2  , STAGE_BYTES = 8 * HTB, NXCD = 8, WGM = 8;

__host__ __device__ __forceinline__ int lds_byte(int r, int c) { const int st = (r >> 4) * 2 + (c >> 5), rr = r & 15, cc = c & 31, ob = rr * 64 + cc * 2; return st * 1024 + (ob ^ (((ob >> 9) & 1) << 5)); }
__host__ __device__ __forceinline__ void stage_rc(int b, int& R, int& C) { const int st = b / 1024, sb = b % 1024, swz = sb ^ (((sb >> 9) & 1) << 5); R = (st >> 1) * 16 + swz / 64; C = (st & 1) * 32 + (swz % 64) / 2; }
__host__ __device__ __forceinline__ int perm32(int rho) { const int n = rho >> 4, i = rho & 15; return 8 * (i >> 2) + 4 * n + (i & 3); }

struct Unit { int pm, pn; };
struct Gemm { const bf16_t* A; const bf16_t* Bt; int M, N, K; };

struct StaticOrder {
    int nM, nN, nwg, G, c;
    __host__ __device__ void init(int M, int N, int G_, int c_) { nM = M / BM; nN = N / BM; nwg = nM * nN; G = G_; c = c_; }
    __host__ __device__ bool next(int i, Unit& u) const {
        const long L = (long)i * G + c; if (L >= nwg) return false;
        int wgid = (int)L; { const int q = nwg / NXCD, r = nwg % NXCD, xcd = wgid % NXCD, off = wgid / NXCD; wgid = (xcd < r ? xcd * (q + 1) : r * (q + 1) + (xcd - r) * q) + off; }
        const int nig = WGM * nN, gid = wgid / nig, fm = gid * WGM, gsz = (nM - fm) < WGM ? (nM - fm) : WGM;
        u.pm = fm + ((wgid % nig) % gsz); u.pn = (wgid % nig) / gsz; return true;
    }
    __device__ __forceinline__ void a_ready(const Unit&) const {}
    __device__ __forceinline__ void done(const Unit&) const {}
};


__device__ __forceinline__ unsigned cvt_pk_bf16(float lo, float hi) { unsigned r; asm volatile("v_cvt_pk_bf16_f32 %0, %1, %2" : "=v"(r) : "v"(lo), "v"(hi)); return r; }

template <int ACT> struct EpiBf16 {
    static constexpr bool PERM = true, AFTER_DRAIN = false;
    bf16_t* O0; int ld0; int nt0; bf16_t* O1; int ld1;
    __device__ __forceinline__ void operator()(const f32x4 (&acc)[2][2][4][2], const Unit& u, int wr, int wc, int fr, int fq) const {
        const int row0 = u.pm * BM + wr * 64 + fr;
        bf16_t* base; int ldc, colt;
        if (u.pn < nt0) { base = O0; ldc = ld0; colt = u.pn * BM; } else { base = O1; ldc = ld1; colt = (u.pn - nt0) * BM; }
        const int col0 = colt + wc * 32 + 8 * fq;
#pragma unroll
        for (int ai = 0; ai < 2; ++ai)
#pragma unroll
            for (int m = 0; m < 4; ++m) { bf16_t* rowp = base + (size_t)(row0 + ai * HALF + m * 16) * ldc + col0;
#pragma unroll
                for (int bj = 0; bj < 2; ++bj) { f32x4 v0 = acc[ai][bj][m][0], v1 = acc[ai][bj][m][1];
                    if (ACT == 2) {
#pragma unroll
                        for (int e = 0; e < 4; ++e) { float a = v0[e] > 0.f ? v0[e] : 0.f; v0[e] = a * a; float b = v1[e] > 0.f ? v1[e] : 0.f; v1[e] = b * b; } }
                    u32x4 w; w.x = cvt_pk_bf16(v0[0], v0[1]); w.y = cvt_pk_bf16(v0[2], v0[3]); w.z = cvt_pk_bf16(v1[0], v1[1]); w.w = cvt_pk_bf16(v1[2], v1[3]);
                    *(u32x4*)(rowp + bj * HALF) = w; } }
    }
    __device__ __forceinline__ void fused(f32x4 (&)[2][2][4][2], const Unit&, int, int, int, int, PG8_LAS unsigned char*, int, int) const {}
};


__device__ __forceinline__ float sig_f(float x) { return 1.0f / (1.0f + __expf(-x)); }
struct RkvOrder {
    int c;
    __device__ __forceinline__ bool next(int i, Unit& u) const {
        int L; if (c < 128) { if (i >= 2) return false; L = c * 2 + i; } else { if (i >= 4) return false; L = 256 + (c - 128) * 4 + i; }
        const int which = L >> 8, r = L & 255; u.pm = which * 64 + (r >> 2); u.pn = which * 4 + (r & 3); return true; }
    __device__ __forceinline__ void a_ready(const Unit&) const {}
    __device__ __forceinline__ void done(const Unit&) const {}
};
struct EpiRkv3 {
    static constexpr bool PERM = true, AFTER_DRAIN = false;
    bf16_t* RKV;
    __device__ __forceinline__ void operator()(const f32x4 (&acc)[2][2][4][2], const Unit& u, int wr, int wc, int fr, int fq) const {
        const int row0 = (u.pm & 63) * BM + wr * 64 + fr, col0 = u.pn * BM + wc * 32 + 8 * fq;
#pragma unroll
        for (int ai = 0; ai < 2; ++ai)
#pragma unroll
            for (int m = 0; m < 4; ++m) { bf16_t* rowp = RKV + (size_t)(row0 + ai * HALF + m * 16) * 3072 + col0;
#pragma unroll
                for (int bj = 0; bj < 2; ++bj) { const f32x4 v0 = acc[ai][bj][m][0], v1 = acc[ai][bj][m][1];
                    u32x4 w; w.x = cvt_pk_bf16(v0[0], v0[1]); w.y = cvt_pk_bf16(v0[2], v0[3]); w.z = cvt_pk_bf16(v1[0], v1[1]); w.w = cvt_pk_bf16(v1[2], v1[3]);
                    *(u32x4*)(rowp + bj * HALF) = w; } }
    }
};
struct EpiL1 {
    static constexpr bool PERM = true, AFTER_DRAIN = false;
    bf16_t* L1;
    __device__ __forceinline__ void operator()(const f32x4 (&acc)[2][2][4][2], const Unit& u, int wr, int wc, int fr, int fq) const {
        const int row0 = u.pm * BM + wr * 64 + fr, colt = u.pn * BM, col0 = colt + wc * 32 + 8 * fq;
#pragma unroll
        for (int ai = 0; ai < 2; ++ai)
#pragma unroll
            for (int m = 0; m < 4; ++m) { bf16_t* rowp = L1 + (size_t)(row0 + ai * HALF + m * 16) * 384 + col0;
#pragma unroll
                for (int bj = 0; bj < 2; ++bj) { f32x4 v0 = acc[ai][bj][m][0], v1 = acc[ai][bj][m][1];
                    const int cb = colt + bj * HALF;
                    if (cb >= 384) continue;
                    if (cb == 0) {
#pragma unroll
                        for (int e = 0; e < 4; ++e) { v0[e] = 1.0f - 2.0f / (1.0f + __expf(2.0f * v0[e])); v1[e] = 1.0f - 2.0f / (1.0f + __expf(2.0f * v1[e])); } }
                    else if (cb == 256) {
#pragma unroll
                        for (int e = 0; e < 4; ++e) { v0[e] = sig_f(v0[e]); v1[e] = sig_f(v1[e]); } }
                    u32x4 w; w.x = cvt_pk_bf16(v0[0], v0[1]); w.y = cvt_pk_bf16(v0[2], v0[3]); w.z = cvt_pk_bf16(v1[0], v1[1]); w.w = cvt_pk_bf16(v1[2], v1[3]);
                    *(u32x4*)(rowp + bj * HALF) = w; } }
    }
};
struct EpiLora2 {
    static constexpr bool PERM = true, AFTER_DRAIN = false;
    bf16_t* o4; size_t ostride; bf16_t* og; const float* a0; const float* w0;
    __device__ __forceinline__ void operator()(const f32x4 (&acc)[2][2][4][2], const Unit& u, int wr, int wc, int fr, int fq) const {
        const int row0 = u.pm * BM + wr * 64 + fr; const int blk = u.pn >> 2, colt = (u.pn & 3) * BM;
        bf16_t* base = (blk < 4) ? o4 + (size_t)blk * ostride : og;
        const float* bs = ((blk < 2) ? a0 : w0) + (blk & 1) * 1024;
        const int col0 = colt + wc * 32 + 8 * fq;
        const float sc = (blk >= 2) ? 0.8750387749719753f : 1.0f;
#pragma unroll
        for (int bj = 0; bj < 2; ++bj) {
            f32x4 b0 = (f32x4){0.f, 0.f, 0.f, 0.f}, b1 = b0;
            if (blk < 4) { b0 = *(const f32x4*)(bs + col0 + bj * HALF); b1 = *(const f32x4*)(bs + col0 + bj * HALF + 4); }
#pragma unroll
            for (int ai = 0; ai < 2; ++ai)
#pragma unroll
                for (int m = 0; m < 4; ++m) { bf16_t* rowp = base + (size_t)(row0 + ai * HALF + m * 16) * 1024 + col0;
                    f32x4 v0 = acc[ai][bj][m][0] + b0, v1 = acc[ai][bj][m][1] + b1;
                    if (blk < 4) {
#pragma unroll
                        for (int e = 0; e < 4; ++e) { v0[e] = sc * sig_f(v0[e]); v1[e] = sc * sig_f(v1[e]); } }
                    u32x4 w; w.x = cvt_pk_bf16(v0[0], v0[1]); w.y = cvt_pk_bf16(v0[2], v0[3]); w.z = cvt_pk_bf16(v1[0], v1[1]); w.w = cvt_pk_bf16(v1[2], v1[3]);
                    *(u32x4*)(rowp + bj * HALF) = w; } }
    }
};


template <class MP> struct EpiQkv {
    static constexpr bool PERM = true, AFTER_DRAIN = false;
    unsigned char* ws; float* out; const float* gain; const float* RC; const float* RS; int j;
    static constexpr size_t oQA = MP::oQA, oQB = MP::oQB, oKAP = MP::oKAP, oVAP = MP::oVAP, oKBP = MP::oKBP, oVBP = MP::oVBP, oKAS = MP::oKAS, oVAS = MP::oVAS, oKBS = MP::oKBS, oVBS = MP::oVBS;
    static constexpr size_t oKG = MP::oKG, oVG = MP::oVG, oKD = MP::oKD, oVD = MP::oVD;
    __device__ __forceinline__ void operator()(const f32x4 (&acc)[2][2][4][2], const Unit& u, int wr, int wc, int fr, int fq) const {
        const int ch = 4 * u.pn + wc; const bool smp = u.pm >= 32;
        const bool isq = (ch < 8) || (ch >= 12 && ch < 20), isk = (ch == 8 || ch == 9) || (ch >= 20 && ch < 28);
        const int dl = 8 * fq;
        const bool hi2 = (fq & 2) != 0;
        f32x4 g[2][2];
#pragma unroll
        for (int bj = 0; bj < 2; ++bj)
#pragma unroll
            for (int n = 0; n < 2; ++n) g[bj][n] = (ch < 10) ? *(const f32x4*)(gain + (ch < 8 ? 0 : 64) + bj * 32 + dl + 4 * n) : (f32x4){1.f, 1.f, 1.f, 1.f};
        constexpr float QS = 0.18033688011112042f;
#pragma unroll
        for (int ai = 0; ai < 2; ++ai)
#pragma unroll
            for (int m = 0; m < 4; ++m) {
                const int mrow = u.pm * BM + ai * HALF + wr * 64 + m * 16 + fr;
                const int b = smp ? ((mrow - 8192) >> 11) : (mrow >> 8), t = smp ? ((mrow - 8192) & 2047) : (mrow & 255);
                f32x4 v[2][2];
#pragma unroll
                for (int bj = 0; bj < 2; ++bj)
#pragma unroll
                    for (int n = 0; n < 2; ++n) v[bj][n] = acc[ai][bj][m][n];
                if (ch < 10) { float ss = 0.f;
#pragma unroll
                    for (int bj = 0; bj < 2; ++bj)
#pragma unroll
                        for (int n = 0; n < 2; ++n) ss += (v[bj][n][0] * v[bj][n][0] + v[bj][n][1] * v[bj][n][1]) + (v[bj][n][2] * v[bj][n][2] + v[bj][n][3] * v[bj][n][3]);
                    ss += __shfl_xor(ss, 16); ss += __shfl_xor(ss, 32);
                    const float ri = 1.0f / sqrtf(ss * (1.0f / 64.0f) + 1e-6f);
#pragma unroll
                    for (int bj = 0; bj < 2; ++bj)
#pragma unroll
                        for (int n = 0; n < 2; ++n) v[bj][n] = v[bj][n] * ri * g[bj][n]; }
                f32x4 vr[2][2];
#pragma unroll
                for (int bj = 0; bj < 2; ++bj)
#pragma unroll
                    for (int n = 0; n < 2; ++n) { vr[bj][n] = v[bj][n];
                        if (smp && (isq || isk)) { f32x4 p; p[0] = __shfl_xor(v[bj][n][0], 32); p[1] = __shfl_xor(v[bj][n][1], 32); p[2] = __shfl_xor(v[bj][n][2], 32); p[3] = __shfl_xor(v[bj][n][3], 32);
                            const f32x4 cs = *(const f32x4*)(RC + t * 64 + bj * 32 + dl + 4 * n), sn = *(const f32x4*)(RS + t * 64 + bj * 32 + dl + 4 * n);
                            const f32x4 rot = hi2 ? p : -p; vr[bj][n] = v[bj][n] * cs + rot * sn; } }
#define EQ_PK8(x0, x1) ((u32x4){cvt_pk_bf16((x0)[0], (x0)[1]), cvt_pk_bf16((x0)[2], (x0)[3]), cvt_pk_bf16((x1)[0], (x1)[1]), cvt_pk_bf16((x1)[2], (x1)[3])})
                const size_t srow = (size_t)(b * 2560 + 512 + t), prow = (size_t)((b * 2 + j) * 256 + t);
#pragma unroll
                for (int bj = 0; bj < 2; ++bj) {
                    const int f0 = bj * 32 + dl;
                    if (isq) { const f32x4 s0 = vr[bj][0] * QS, s1 = vr[bj][1] * QS; const size_t o = (ch < 8) ? oQA + ((size_t)mrow * 512 + ch * 64 + f0) * 2 : oQB + ((size_t)mrow * 512 + (ch - 12) * 64 + f0) * 2;
                        *(u32x4*)(ws + o) = EQ_PK8(s0, s1); }
                    else {
                        const bool gq = ch < 12, kk = isk;
                        const int e = gq ? ((ch & 1) * 64 + f0) : ((ch - (kk ? 20 : 28)) * 64 + f0); const int wdt = gq ? 128 : 512;
                        if (!smp) { const size_t of = (gq ? (kk ? oKG : oVG) : (kk ? oKD : oVD)) + prow * wdt + e; *(f32x4*)(out + of) = v[bj][0]; *(f32x4*)(out + of + 4) = v[bj][1];
                            const size_t o = (gq ? (kk ? oKAP : oVAP) : (kk ? oKBP : oVBP)) + ((size_t)mrow * wdt + e) * 2; *(u32x4*)(ws + o) = EQ_PK8(v[bj][0], v[bj][1]); }
                        else { const size_t o = (gq ? (kk ? oKAS : oVAS) : (kk ? oKBS : oVBS)) + (srow * wdt + e) * 2; *(u32x4*)(ws + o) = EQ_PK8(vr[bj][0], vr[bj][1]); } }
                }
#undef EQ_PK8
            }
    }
};

template <class Epi, class Sched, bool ALIGN_EPI = false, bool SP2 = false>
__device__ __forceinline__ void gemm_phase(PG8_LAS unsigned char* lds, const Gemm g, const Sched& S, const Epi& E, const int wave_index) {
    int lane_o; asm volatile("v_mbcnt_lo_u32_b32 %0, -1, 0\n\tv_mbcnt_hi_u32_b32 %0, -1, %0" : "=v"(lane_o));
    const int wid = wave_index, lane = lane_o, tid = wid * 64 + lane, wr = wid >> 2, wc = wid & 3, fr = lane & 15, fq = lane >> 4;
    const int K = g.K, nt = K / BK;
    unsigned voffA[2], voffB[2];
#pragma unroll
    for (int i = 0; i < 2; ++i) { int R, C; stage_rc(tid * 16 + i * 8192, R, C); const int Rb = Epi::PERM ? ((R & ~31) + perm32(R & 31)) : R;
        voffA[i] = (unsigned)(R * K + C) * 2u; voffB[i] = (unsigned)(Rb * K + C) * 2u; }
    const size_t kstep = (size_t)(BK * 2);
    const size_t hstep = (size_t)HALF * K * 2;
    const size_t tstep = 2 * hstep;
    const unsigned ldsw = (unsigned)wid * 1024u;
    const int aoff = lds_byte(wr * 64 + fr, fq * 8), boff = lds_byte(wc * 32 + fr, fq * 8);
#define PG8_SA(b, h) (((b) * 2 + (h)) * HTB)
#define PG8_SB(b, h) ((4 + (b) * 2 + (h)) * HTB)
#define PG8_STAGE(bufoff, gbase, voff) do { _Pragma("unroll") for (int _i = 0; _i < 2; ++_i) \
        __builtin_amdgcn_global_load_lds((const unsigned*)((const char*)(gbase) + (voff)[_i]), (PG8_LAS unsigned*)(lds + (bufoff) + ldsw + _i * 8192), 16, 0, 0); } while (0)
#define PG8_LDA(dst, b, h) do { _Pragma("unroll") for (int m = 0; m < 4; ++m) _Pragma("unroll") for (int k = 0; k < 2; ++k) dst[m][k] = *(const PG8_LAS bf16x8*)(lds + PG8_SA(b, h) + aoff + m * 2048 + k * 1024); } while (0)
#define PG8_LDB(dst, b, h) do { _Pragma("unroll") for (int n = 0; n < 2; ++n) _Pragma("unroll") for (int k = 0; k < 2; ++k) dst[n][k] = *(const PG8_LAS bf16x8*)(lds + PG8_SB(b, h) + boff + n * 2048 + k * 1024); } while (0)
#define PG8_MMA(ai, bj, At, Bt) do { __builtin_amdgcn_s_setprio(1); _Pragma("unroll") for (int m = 0; m < 4; ++m) _Pragma("unroll") for (int n = 0; n < 2; ++n) _Pragma("unroll") for (int k = 0; k < 2; ++k) \
        acc[ai][bj][m][n] = __builtin_amdgcn_mfma_f32_16x16x32_bf16(Bt[n][k], At[m][k], acc[ai][bj][m][n], 0, 0, 0); __builtin_amdgcn_s_setprio(0); } while (0)
#define PG8_WAIT_V(n) asm volatile("s_waitcnt vmcnt(" #n ")" ::: "memory")
#define PG8_WAIT_L(n) asm volatile("s_waitcnt lgkmcnt(" #n ")" ::: "memory")
#define PG8_BAR __builtin_amdgcn_s_barrier()
#define PG8_SCHED __builtin_amdgcn_sched_barrier(0)
    Unit cur, nxt; int ui = 0;
    if (!S.next(0, cur)) return;
    f32x4 acc[2][2][4][2];
#pragma unroll
    for (int a = 0; a < 2; ++a)
#pragma unroll
        for (int b = 0; b < 2; ++b)
#pragma unroll
            for (int m = 0; m < 4; ++m)
#pragma unroll
                for (int n = 0; n < 2; ++n) acc[a][b][m][n] = (f32x4){0.f, 0.f, 0.f, 0.f};
    bf16x8 At[4][2], B0[2][2], B1[2][2];
    const char* cA = (const char*)g.A + (size_t)cur.pm * tstep; const char* cB = (const char*)g.Bt + (size_t)cur.pn * tstep;
    S.a_ready(cur);
    if constexpr (SP2) {
        PG8_STAGE(PG8_SB(0, 0), cB, voffB); PG8_STAGE(PG8_SB(0, 1), cB + hstep, voffB); PG8_STAGE(PG8_SA(0, 0), cA, voffA); PG8_STAGE(PG8_SA(0, 1), cA + hstep, voffA);
        if (wr == 1) PG8_BAR;
        PG8_WAIT_V(2); PG8_BAR;
        PG8_STAGE(PG8_SB(1, 0), cB + kstep, voffB); PG8_STAGE(PG8_SA(1, 0), cA + kstep, voffA); PG8_STAGE(PG8_SB(1, 1), cB + hstep + kstep, voffB);
        PG8_WAIT_V(6); PG8_BAR;
    } else {
        PG8_STAGE(PG8_SB(0, 0), cB, voffB); PG8_STAGE(PG8_SA(0, 0), cA, voffA); PG8_STAGE(PG8_SB(0, 1), cB + hstep, voffB); PG8_STAGE(PG8_SA(0, 1), cA + hstep, voffA);
        if (wr == 1) PG8_BAR;
        PG8_WAIT_V(4); PG8_BAR;
        PG8_STAGE(PG8_SB(1, 0), cB + kstep, voffB); PG8_STAGE(PG8_SA(1, 0), cA + kstep, voffA); PG8_STAGE(PG8_SB(1, 1), cB + hstep + kstep, voffB);
        PG8_WAIT_V(6); PG8_BAR;
    }
    for (;;) {
        const bool has_next = S.next(ui + 1, nxt);
        const char* nA = has_next ? (const char*)g.A + (size_t)nxt.pm * tstep : cA; const char* nB = has_next ? (const char*)g.Bt + (size_t)nxt.pn * tstep : cB;
#pragma unroll 1
        for (int t = 0; t < nt; t += 2) {
            const bool last = (t == nt - 2);
            const char* a1 = cA + (size_t)(t + 1) * kstep;
            const char* a2 = last ? nA : cA + (size_t)(t + 2) * kstep; const char* b2 = last ? nB : cB + (size_t)(t + 2) * kstep;
            const char* a3 = a2 + kstep; const char* b3 = b2 + kstep;
            if (last && has_next) S.a_ready(nxt);
            if constexpr (SP2) {
            PG8_LDB(B0, 0, 0); PG8_LDB(B1, 0, 1); PG8_SCHED; PG8_LDA(At, 0, 0); PG8_STAGE(PG8_SA(1, 1), a1 + hstep, voffA);
            PG8_WAIT_V(8); PG8_WAIT_L(0); PG8_BAR; PG8_MMA(0, 0, At, B0); PG8_MMA(0, 1, At, B1); PG8_BAR; PG8_SCHED;
            PG8_LDA(At, 0, 1); PG8_STAGE(PG8_SB(0, 0), b2, voffB); PG8_STAGE(PG8_SB(0, 1), b2 + hstep, voffB); PG8_STAGE(PG8_SA(0, 0), a2, voffA);
            PG8_WAIT_V(8); PG8_WAIT_L(0); PG8_BAR; PG8_MMA(1, 0, At, B0); PG8_MMA(1, 1, At, B1); PG8_BAR; PG8_SCHED;
            PG8_LDB(B0, 1, 0); PG8_LDB(B1, 1, 1); PG8_SCHED; PG8_LDA(At, 1, 0); PG8_STAGE(PG8_SA(0, 1), a2 + hstep, voffA);
            PG8_WAIT_V(8); PG8_WAIT_L(0); PG8_BAR; PG8_MMA(0, 0, At, B0); PG8_MMA(0, 1, At, B1); PG8_BAR; PG8_SCHED;
            PG8_LDA(At, 1, 1); PG8_STAGE(PG8_SB(1, 0), b3, voffB); PG8_STAGE(PG8_SB(1, 1), b3 + hstep, voffB); PG8_STAGE(PG8_SA(1, 0), a3, voffA);
            PG8_WAIT_V(8); PG8_WAIT_L(0); PG8_BAR; PG8_MMA(1, 0, At, B0); PG8_MMA(1, 1, At, B1); PG8_BAR; PG8_SCHED;
            } else {
            PG8_LDB(B0, 0, 0); PG8_SCHED; PG8_LDA(At, 0, 0); PG8_STAGE(PG8_SA(1, 1), a1 + hstep, voffA);
            PG8_WAIT_L(8); PG8_BAR; PG8_WAIT_L(0); PG8_MMA(0, 0, At, B0); PG8_BAR; PG8_SCHED;
            PG8_LDB(B1, 0, 1); PG8_STAGE(PG8_SB(0, 0), b2, voffB);
            PG8_BAR; PG8_WAIT_L(0); PG8_MMA(0, 1, At, B1); PG8_BAR;
            PG8_LDA(At, 0, 1); PG8_STAGE(PG8_SA(0, 0), a2, voffA);
            PG8_BAR; PG8_WAIT_L(0); PG8_MMA(1, 0, At, B0); PG8_BAR; PG8_SCHED;
            PG8_STAGE(PG8_SB(0, 1), b2 + hstep, voffB);
            PG8_WAIT_V(6); PG8_BAR; PG8_MMA(1, 1, At, B1); PG8_BAR;
            PG8_LDB(B0, 1, 0); PG8_SCHED; PG8_LDA(At, 1, 0); PG8_STAGE(PG8_SA(0, 1), a2 + hstep, voffA);
            PG8_WAIT_L(8); PG8_BAR; PG8_WAIT_L(0); PG8_MMA(0, 0, At, B0); PG8_BAR; PG8_SCHED;
            PG8_LDB(B1, 1, 1); PG8_STAGE(PG8_SB(1, 0), b3, voffB);
            PG8_BAR; PG8_WAIT_L(0); PG8_MMA(0, 1, At, B1); PG8_BAR;
            PG8_LDA(At, 1, 1); PG8_STAGE(PG8_SA(1, 0), a3, voffA);
            PG8_BAR; PG8_WAIT_L(0); PG8_MMA(1, 0, At, B0); PG8_BAR; PG8_SCHED;
            PG8_STAGE(PG8_SB(1, 1), b3 + hstep, voffB);
            PG8_WAIT_V(6); PG8_BAR; PG8_MMA(1, 1, At, B1); PG8_BAR;
            }
        }
        if constexpr (ALIGN_EPI) { if (wr == 0) PG8_BAR; }
        if constexpr (!Epi::AFTER_DRAIN) { E(acc, cur, wr, wc, fr, fq); S.done(cur); }
        if (!has_next) break;
#pragma unroll
        for (int a = 0; a < 2; ++a)
#pragma unroll
            for (int b = 0; b < 2; ++b)
#pragma unroll
                for (int m = 0; m < 4; ++m)
#pragma unroll
                    for (int n = 0; n < 2; ++n) acc[a][b][m][n] = (f32x4){0.f, 0.f, 0.f, 0.f};
        cur = nxt; cA = nA; cB = nB; ++ui;
        if constexpr (ALIGN_EPI) { if (wr == 1) PG8_BAR; }
    }
    PG8_WAIT_V(0);
    if constexpr (!ALIGN_EPI) { if (wr == 0) PG8_BAR; }
    PG8_BAR;
    if constexpr (Epi::AFTER_DRAIN) { E.fused(acc, cur, wr, wc, fr, fq, lds, wid, lane); S.done(cur); }
#undef PG8_SA
#undef PG8_SB
#undef PG8_STAGE
#undef PG8_LDA
#undef PG8_LDB
#undef PG8_MMA
#undef PG8_WAIT_V
#undef PG8_WAIT_L
#undef PG8_BAR
#undef PG8_SCHED
}
}

#define GAS __attribute__((address_space(1)))
#define LAS __attribute__((address_space(3)))
typedef unsigned short bf16;
typedef unsigned v4u __attribute__((ext_vector_type(4)));
typedef unsigned v2u __attribute__((ext_vector_type(2)));
typedef float f32x4 __attribute__((ext_vector_type(4)));
#define LDS_WAIT() asm volatile("s_waitcnt lgkmcnt(0)" ::: "memory")

#ifndef MK_N_LAUNCHES
#define MK_N_LAUNCHES 1
#endif
#ifndef MK_CG_BARRIER
#define MK_CG_BARRIER 0
#endif

constexpr int D = 1024, NTOK = 16384, NPR = 8192, TP = 256, TS = 2048, PAST = 512, SKV = 2560, FF = 4096, DEPTH = 4;
constexpr int NQKV = 2304, NRKV = 3584, KRKV = 2048;
constexpr int NWAVES = 8;
constexpr size_t O_X = 0, O_KG = 16777216, O_VG = 18874368, O_KD = 20971520, O_VD = 29360128, O_ST = 37748736, OUT_TOTAL = 46137344;
constexpr size_t MiB = 1u << 20;
constexpr size_t WS_CTL = 0, CTL_ZERO_BYTES = 1 * MiB;
constexpr size_t WS_MOD = 65536;
constexpr size_t WS_ROPE = 1 * MiB;
constexpr size_t WS_INV = 2 * MiB;
constexpr size_t WS_W = 4 * MiB;
constexpr size_t W_W1T = WS_W, W_W2T = WS_W + 8 * MiB, W_MIX = WS_W + 16 * MiB;
constexpr size_t W_WINT = W_MIX, W_WOUTT = W_MIX + 6 * MiB;
constexpr size_t W_BTR = W_MIX, W_BTL = W_MIX + 6 * MiB, W_WOT = W_MIX + 14 * MiB, W_BT2 = W_MIX + 16 * MiB;
constexpr size_t AR = 40 * MiB;
constexpr size_t A_H = AR;
constexpr size_t A_QKVRAW = AR + 32 * MiB;
constexpr size_t A_DT = AR + 32 * MiB;
constexpr size_t A_M = AR + 96 * MiB;
constexpr size_t A_QA = AR + 176 * MiB, A_QB = AR + 192 * MiB, A_KAP = AR + 208 * MiB, A_VAP = AR + 210 * MiB, A_KBP = AR + 212 * MiB, A_VBP = AR + 220 * MiB;
constexpr size_t A_KAS = AR + 228 * MiB, A_VAS = AR + 231 * MiB, A_KBS = AR + 234 * MiB, A_VBS = AR + 244 * MiB;
constexpr size_t A_HID = AR + 32 * MiB;
constexpr size_t A_F = AR + 160 * MiB;
constexpr size_t A_A2 = AR + 32 * MiB;
constexpr size_t A_XS = AR + 208 * MiB;
constexpr size_t A_Y = AR + 32 * MiB;
constexpr size_t A_RKV = AR + 96 * MiB;
constexpr size_t A_L1 = AR + 192 * MiB;
constexpr size_t A_G = A_H;
constexpr size_t A_A0 = AR + 208 * MiB, A_A1 = AR + 240 * MiB, A_EW0 = AR + 272 * MiB, A_EW1 = AR + 304 * MiB;
constexpr size_t WS_END = AR + 336 * MiB;
struct QkvMap { static constexpr size_t oQA = A_QA, oQB = A_QB, oKAP = A_KAP, oVAP = A_VAP, oKBP = A_KBP, oVBP = A_VBP, oKAS = A_KAS, oVAS = A_VAS, oKBS = A_KBS, oVBS = A_VBS, oKG = O_KG, oVG = O_VG, oKD = O_KD, oVD = O_VD; };
constexpr int CW_BAR = 4096;

constexpr int RING_OFF = 0, RING_BYTES = 131072;
constexpr int LDSCTL_OFF = RING_BYTES, MISC_OFF = LDSCTL_OFF + 320;
constexpr int LDS_BYTES = 147456;

typedef float f32x2_t __attribute__((ext_vector_type(2))); typedef __bf16 bf16x2_t __attribute__((ext_vector_type(2)));
__device__ __forceinline__ unsigned pk2(float lo, float hi) { const f32x2_t v = {lo, hi}; return __builtin_bit_cast(unsigned, __builtin_convertvector(v, bf16x2_t)); }
__device__ __forceinline__ unsigned f2bf(float f) { return pk2(f, 0.f) & 0xffffu; }
__device__ __forceinline__ float bf2f(unsigned short h) { return __builtin_bit_cast(float, (unsigned)h << 16); }
__device__ __forceinline__ float bflo(unsigned w) { return __builtin_bit_cast(float, w << 16); }
__device__ __forceinline__ float bfhi(unsigned w) { return __builtin_bit_cast(float, w & 0xffff0000u); }
__device__ __forceinline__ float sigmoidf_(float x) { return 1.0f / (1.0f + __expf(-x)); }
__device__ __forceinline__ float rdl(float x, int l) { return __builtin_bit_cast(float, __builtin_amdgcn_readlane(__builtin_bit_cast(int, x), l)); }
__device__ __forceinline__ float wave_sum(float v) {
    asm("s_nop 1\n\tv_add_f32_dpp %0, %0, %0 row_ror:8 row_mask:0xf bank_mask:0xf\n\ts_nop 1\n\tv_add_f32_dpp %0, %0, %0 row_ror:4 row_mask:0xf bank_mask:0xf\n\ts_nop 1\n\t"
        "v_add_f32_dpp %0, %0, %0 row_ror:2 row_mask:0xf bank_mask:0xf\n\ts_nop 1\n\tv_add_f32_dpp %0, %0, %0 row_ror:1 row_mask:0xf bank_mask:0xf\n\ts_nop 1" : "+v"(v));
    return (rdl(v, 0) + rdl(v, 16)) + (rdl(v, 32) + rdl(v, 48));
}

#define XB_TMO      128
#define XB_XCNT(j)  (256  + 64 * (j))
#define XB_XSUB(j)  (1280 + 64 * (j))
#define XB_XGEN(j)  (2304 + 64 * (j))
#define XB_TOP      3328
#define XB_TOPGEN   3392
#define XCD_BAR_WORDS 3456
#define XB_SPIN_CAP (1u << 18)

__device__ __forceinline__ unsigned xb_ld(unsigned* p)              { return __hip_atomic_load(p, __ATOMIC_RELAXED, __HIP_MEMORY_SCOPE_AGENT); }
__device__ __forceinline__ unsigned xb_add(unsigned* p, unsigned v) { return __hip_atomic_fetch_add(p, v, __ATOMIC_RELAXED, __HIP_MEMORY_SCOPE_AGENT); }
__device__ __forceinline__ unsigned xb_xcc_id() { return (unsigned)__builtin_amdgcn_s_getreg((3 << 11) | 20) & 0xFu; }
#define XB_SPIN(cond, bar) do { unsigned _sp = 0; while (cond) { __builtin_amdgcn_s_sleep(1); \
    if ((++_sp & 255u) == 0u) { if (xb_ld(&(bar)[XB_TMO])) break; if (_sp > XB_SPIN_CAP) { atomicAdd(&(bar)[XB_TMO], 1u); break; } } } } while (0)

struct XcdBarrier {
    unsigned* bar; unsigned x;
    volatile LAS unsigned* st;
};

__device__ __forceinline__ XcdBarrier xcd_barrier_post(unsigned* bar, volatile LAS unsigned* st, bool leader) {
    XcdBarrier b; b.bar = bar; b.x = xb_xcc_id(); b.st = st;
    if (leader) (void)xb_add(&bar[XB_XCNT(b.x)], 1u);
    return b;
}
__device__ __forceinline__ void xcd_barrier_complete(unsigned* bar, unsigned x, unsigned& nloc, unsigned& nx) {
    const unsigned G = gridDim.x * gridDim.y * gridDim.z;
    unsigned sum, cnt, mine, sp = 0u;
    for (;;) {
        sum = 0u; cnt = 0u; mine = 0u;
#pragma unroll
        for (unsigned j = 0; j < 16; ++j) { const unsigned c = xb_ld(&bar[XB_XCNT(j)]); sum += c; cnt += (c > 0u) ? 1u : 0u; mine = (j == x) ? c : mine; }
        if (sum == G) break;
        __builtin_amdgcn_s_sleep(1);
        if ((++sp & 255u) == 0u) { if (xb_ld(&bar[XB_TMO])) break; if (sp > XB_SPIN_CAP) { atomicAdd(&bar[XB_TMO], 1u); break; } }
    }
    nloc = mine > 0u ? mine : 1u; nx = cnt > 0u ? cnt : 1u;
}

__device__ __forceinline__ void xcd_barrier(const XcdBarrier& b, bool leader) {
    asm volatile("s_waitcnt vmcnt(0)" ::: "memory");
    __syncthreads();
    if (leader) {
        unsigned* bar = b.bar;
        __builtin_amdgcn_s_waitcnt(0);
        unsigned nloc = b.st[0], nx = b.st[1];
        if (nloc == 0u) { xcd_barrier_complete(bar, b.x, nloc, nx); b.st[0] = nloc; b.st[1] = nx; }
        const unsigned old = xb_add(&bar[XB_XSUB(b.x)], 1u);
        const unsigned gen = old / nloc;
        if (old + 1u == (gen + 1u) * nloc) {
            __builtin_amdgcn_fence(__ATOMIC_RELEASE, "agent");
            asm volatile("s_waitcnt vmcnt(0)" ::: "memory");
            const unsigned og = xb_add(&bar[XB_TOP], 1u);
            const unsigned tg = og / nx;
            if (og + 1u == (tg + 1u) * nx) xb_add(&bar[XB_TOPGEN], 1u);
            else XB_SPIN(xb_ld(&bar[XB_TOPGEN]) == tg, bar);
            __builtin_amdgcn_fence(__ATOMIC_ACQUIRE, "agent");
            xb_add(&bar[XB_XGEN(b.x)], 1u);
            asm volatile("s_waitcnt vmcnt(0)" ::: "memory");
        } else {
            XB_SPIN(xb_ld(&bar[XB_XGEN(b.x)]) == gen, bar);
            __builtin_amdgcn_fence(__ATOMIC_ACQUIRE, "agent");
            asm volatile("s_waitcnt vmcnt(0)" ::: "memory");
        }
    }
    __syncthreads();
}

struct Args { const float* in[32]; float* out; unsigned char* ws; int ph_lo, ph_hi; };
struct Ids { int tid, lane, wave, gw, ngw, z; };

__device__ __forceinline__ int cond_of(int m) { return m < NPR ? 4 : ((m - NPR) >> 11); }
__device__ __forceinline__ const float* mod_ptr_(const Args& a, const Ids& id, int cond, int layer) { return (const float*)(a.ws + id.z + WS_MOD) + (size_t)(cond * 4 + layer) * 6144; }

__device__ __forceinline__ void tr_item(const float* W, int ldw, int col0, const float* scale, bf16* WT, int ldt, int drow0, int dcol0, LAS float* scr, int kb, int nb, int lane, int dnb = -1) {
    const int k0 = 64 * kb, n0 = 32 * nb, dn0 = 32 * (dnb < 0 ? nb : dnb);
#pragma unroll 8
    for (int i = 0; i < 32; ++i) { const int kk = 2 * i + (lane >> 5); float v = W[(size_t)(k0 + kk) * ldw + col0 + n0 + (lane & 31)]; if (scale) v *= scale[k0 + kk]; scr[kk * 33 + (lane & 31)] = v; }
    LDS_WAIT(); asm volatile("" ::: "memory");
    const int c = lane & 7;
#pragma unroll
    for (int j = 0; j < 4; ++j) { const int n = (lane >> 3) + 8 * j; const LAS float* s = scr + (8 * c) * 33 + n;
        v4u o; o.x = pk2(s[0 * 33], s[1 * 33]); o.y = pk2(s[2 * 33], s[3 * 33]); o.z = pk2(s[4 * 33], s[5 * 33]); o.w = pk2(s[6 * 33], s[7 * 33]);
        *(v4u*)(WT + (size_t)(drow0 + dn0 + n) * ldt + dcol0 + k0 + 8 * c) = o; }
    LDS_WAIT(); asm volatile("" ::: "memory");
}
__device__ __forceinline__ bool tr_matrix(int& r, const float* W, int K, int N, bf16* WT, LAS float* scr, int lane) {
    const int nblk = N / 32, items = (K / 64) * nblk;
    if (r < items) { tr_item(W, N, 0, nullptr, WT, K, 0, 0, scr, r / nblk, r % nblk, lane); return true; }
    r -= items; return false;
}
__device__ __forceinline__ bool tr_rwproj(int& r, const float* W, int ncols, const float* mu, bf16* BT1, int drow0, LAS float* scr, int lane) {
    const int nblk = ncols / 32, items = 16 * nblk * 2;
    if (r < items) { const int half = r / (16 * nblk), q = r % (16 * nblk); tr_item(W, ncols, 0, half ? mu : nullptr, BT1, KRKV, drow0, half * 1024, scr, q / nblk, q % nblk, lane); return true; }
    r -= items; return false;
}
__device__ __forceinline__ void conv_weights(const Args& a, const Ids& id, LAS unsigned char* lds, int layer, int parts = 3) {
    LAS float* scr = (LAS float*)(lds + id.wave * 16384);
    const int j = layer >> 1;
    bf16* W1T = (bf16*)(a.ws + id.z + W_W1T); bf16* W2T = (bf16*)(a.ws + id.z + W_W2T);
    const float* mw1 = a.in[30 + id.z] + (size_t)layer * D * FF; const float* mw2 = a.in[31 + id.z] + (size_t)layer * D * FF;
    if ((layer & 1) == 0) {
        bf16* WINT = (bf16*)(a.ws + id.z + W_WINT); bf16* WOUTT = (bf16*)(a.ws + id.z + W_WOUTT);
        const float* win = a.in[12 + id.z] + (size_t)j * D * NQKV; const float* wout = a.in[13 + id.z] + (size_t)j * D * D;
        const int lo = (parts & 2) ? 0 : 4096, hi = (parts & 1) ? 2048 + 2048 + 1152 + 512 : 4096;
        for (int it = lo + id.gw; it < hi; it += id.ngw) {
            int r = it;
            if (tr_matrix(r, mw1, D, FF, W1T, scr, id.lane)) continue;
            if (tr_matrix(r, mw2, FF, D, W2T, scr, id.lane)) continue;
            if (r < 1152) {
                const int kb = r / 72, nb = r % 72; tr_item(win, NQKV, 0, nullptr, WINT, D, 0, 0, scr, kb, nb, id.lane, (nb & ~7) + 4 * (nb & 1) + ((nb >> 1) & 3)); continue; }
            r -= 1152;
            tr_matrix(r, wout, D, D, WOUTT, scr, id.lane);
        }
    } else {
        bf16* BTR = (bf16*)(a.ws + id.z + W_BTR); bf16* BT1 = (bf16*)(a.ws + id.z + W_BTL); bf16* WOT = (bf16*)(a.ws + id.z + W_WOT);
        const float* mu = a.in[17 + id.z] + (size_t)j * 6 * D;
        const float* wrkv = a.in[18 + id.z] + (size_t)j * 3 * D * D;
        const float* w1 = a.in[21 + id.z] + (size_t)j * 2 * D * 64; const float* a1 = a.in[24 + id.z] + (size_t)j * 2 * D * 64; const float* g1 = a.in[26 + id.z] + (size_t)j * D * 128;
        const float* wo = a.in[19 + id.z] + (size_t)j * D * D;
        bf16* BT2 = (bf16*)(a.ws + id.z + W_BT2); const float* w2 = a.in[22 + id.z] + (size_t)j * 2 * 64 * D; const float* a2 = a.in[25 + id.z] + (size_t)j * 2 * 64 * D; const float* g2 = a.in[27 + id.z] + (size_t)j * 128 * D;
        const int total = 2048 + 2048 + 1536 + 256 + 128 + 512 + 128 + 4 * 32 + 64 + 5120;
        for (int it = id.gw; it < total; it += id.ngw) {
            int r = it;
            if (tr_matrix(r, mw1, D, FF, W1T, scr, id.lane)) continue;
            if (tr_matrix(r, mw2, FF, D, W2T, scr, id.lane)) continue;
            if (tr_matrix(r, wrkv, D, D, BTR, scr, id.lane)) continue;
            if (tr_matrix(r, wrkv + (size_t)D * D, D, D, BTR + (size_t)D * D, scr, id.lane)) continue;
            if (tr_matrix(r, wrkv + (size_t)2 * D * D, D, D, BTR + (size_t)2 * D * D, scr, id.lane)) continue;
            if (tr_rwproj(r, w1, 64, mu + 1 * D, BT1, 0, scr, id.lane)) continue;
            if (tr_rwproj(r, w1 + (size_t)D * 64, 64, mu + 1 * D, BT1, 64, scr, id.lane)) continue;
            if (tr_rwproj(r, a1, 64, mu + 4 * D, BT1, 128, scr, id.lane)) continue;
            if (tr_rwproj(r, a1 + (size_t)D * 64, 64, mu + 4 * D, BT1, 192, scr, id.lane)) continue;
            if (tr_rwproj(r, g1, 128, mu + 5 * D, BT1, 256, scr, id.lane)) continue;
            if (tr_matrix(r, wo, D, D, WOT, scr, id.lane)) continue;
            if (r < 128) {
                v4u z = (v4u){0u, 0u, 0u, 0u}; v4u* p = (v4u*)(BT1 + (size_t)(384 + r) * KRKV);
#pragma unroll
                for (int q = 0; q < 4; ++q) p[id.lane + 64 * q] = z;
                continue; }
            r -= 128;
            if (r < 128) { const int i = r >> 5, q = r & 31; const float* W = (i < 2 ? a2 : w2) + (size_t)(i & 1) * 64 * D; tr_item(W, D, 0, nullptr, BT2, 384, 1024 * i, 64 * (i ^ 2), scr, 0, q, id.lane); continue; }
            r -= 128;
            if (r < 64) { tr_item(g2, D, 0, nullptr, BT2, 384, 4096, 256, scr, r >> 5, r & 31, id.lane); continue; }
            r -= 64;
            { const int blk = r >> 10; const int c0 = (blk < 4) ? 8 * (blk ^ 2) : 32, c1 = (blk < 4) ? 8 * (blk ^ 2) + 8 : 48;
              if (id.lane < 48 && (id.lane < c0 || id.lane >= c1)) *(v4u*)(BT2 + (size_t)r * 384 + 8 * id.lane) = (v4u){0u, 0u, 0u, 0u}; }
        }
    }
}

struct RowV { f32x4 v[4]; };
__device__ __forceinline__ void ld_row(RowV& r, const float* p, int lane) {
#pragma unroll
    for (int j = 0; j < 4; ++j) r.v[j] = ((const f32x4*)p)[lane + 64 * j];
}
__device__ __forceinline__ void ld_row_bf16(RowV& r, const bf16* p, int lane) {
#pragma unroll
    for (int j = 0; j < 4; ++j) { const v2u w = ((const v2u*)p)[lane + 64 * j]; r.v[j] = (f32x4){bflo(w.x), bfhi(w.x), bflo(w.y), bfhi(w.y)}; }
}
__device__ __forceinline__ void st_row(const RowV& r, float* p, int lane) {
#pragma unroll
    for (int j = 0; j < 4; ++j) ((f32x4*)p)[lane + 64 * j] = r.v[j];
}
__device__ __forceinline__ void st_row_bf16(const RowV& r, bf16* p, int lane) {
#pragma unroll
    for (int j = 0; j < 4; ++j) { v2u w; w.x = pk2(r.v[j][0], r.v[j][1]); w.y = pk2(r.v[j][2], r.v[j][3]); ((v2u*)p)[lane + 64 * j] = w; }
}
__device__ __forceinline__ float row_rinv(const RowV& r) {
    float s = 0.f;
#pragma unroll
    for (int j = 0; j < 4; ++j) s += (r.v[j][0] * r.v[j][0] + r.v[j][1] * r.v[j][1]) + (r.v[j][2] * r.v[j][2] + r.v[j][3] * r.v[j][3]);
    s = wave_sum(s);
    return 1.0f / sqrtf(s * (1.0f / 1024.0f) + 1e-6f);
}
__device__ __forceinline__ void norm_mod(RowV& h, const RowV& x, const float* g, const float* sc, const float* sh, int lane) {
    const float ri = row_rinv(x);
#pragma unroll
    for (int j = 0; j < 4; ++j) { const f32x4 gv = ((const f32x4*)g)[lane + 64 * j], scv = ((const f32x4*)sc)[lane + 64 * j], shv = ((const f32x4*)sh)[lane + 64 * j];
        h.v[j] = (x.v[j] * ri) * gv * (scv + 1.0f) + shv; }
}
__device__ __forceinline__ void resid_add(RowV& x, const RowV& m, const float* g, const float* gt, int lane) {
    const float ri = row_rinv(m);
#pragma unroll
    for (int j = 0; j < 4; ++j) { const f32x4 gv = ((const f32x4*)g)[lane + 64 * j], gtv = ((const f32x4*)gt)[lane + 64 * j];
        x.v[j] = x.v[j] + gtv * ((m.v[j] * ri) * gv); }
}

__device__ __forceinline__ float rope_inv(int jj) {
    const float t[16] = {1.0f, 0.5623413324356079f, 0.3162277638912201f, 0.17782793939113617f, 0.10000000149011612f, 0.05623412877321243f, 0.03162277862429619f, 0.017782794311642647f,
                         0.009999999776482582f, 0.005623413249850273f, 0.003162277862429619f, 0.0017782794311642647f, 0.0010000000474974513f, 0.000562341301701963f, 0.0003162277862429619f, 0.00017782794020604342f};
    float r = t[0];
#pragma unroll
    for (int i = 1; i < 16; ++i) r = (jj == i) ? t[i] : r;
    return r;
}
__device__ __forceinline__ void ph_prologue(const Args& a, const Ids& id, LAS unsigned char* lds) {
    float* MOD = (float*)(a.ws + id.z + WS_MOD);
    { LAS float* red = (LAS float*)lds;
      for (int it = blockIdx.x; it < 4 * 96; it += gridDim.x) {
        const int i = it / 96, n = (it % 96) * 64 + id.lane;
        float acc[5];
#pragma unroll
        for (int c = 0; c < 5; ++c) acc[c] = 0.f;
        const float* W = a.in[9 + id.z] + (size_t)i * 1024 * 6144 + n;
#pragma unroll 1
        for (int k0 = 128 * id.wave; k0 < 128 * id.wave + 128; k0 += 64) {
            float sv[5];
#pragma unroll
            for (int c = 0; c < 5; ++c) { const float x = (c < 4) ? a.in[2 + id.z][c * 1024 + k0 + id.lane] : a.in[8 + id.z][k0 + id.lane]; sv[c] = x / (1.0f + __expf(-x)); }
#pragma unroll 16
            for (int kk = 0; kk < 64; ++kk) { const float w = W[(size_t)(k0 + kk) * 6144];
#pragma unroll
                for (int c = 0; c < 5; ++c) acc[c] += w * __shfl(sv[c], kk); }
        }
#pragma unroll
        for (int c = 0; c < 5; ++c) red[(id.wave * 5 + c) * 64 + id.lane] = acc[c];
        __syncthreads();
        if (id.wave < 5) { float s = a.in[10 + id.z][i * 6144 + n];
#pragma unroll
            for (int w8 = 0; w8 < 8; ++w8) s += red[(w8 * 5 + id.wave) * 64 + id.lane];
            MOD[(size_t)(id.wave * 4 + i) * 6144 + n] = s; }
        __syncthreads();
      } }
    { float* RC = (float*)(a.ws + id.z + WS_ROPE); float* RS = RC + 2048 * 64;
      for (int e = id.gw * 64 + id.lane; e < 2048 * 64; e += id.ngw * 64) { const int t = e >> 6, d = e & 63; const int pos = (d < 32) ? (t >> 6) : (t & 63);
          const float ang = (float)pos * rope_inv(d & 15); RC[e] = __cosf(ang); RS[e] = __sinf(ang); } }
    conv_weights(a, id, lds, 0, 1);
}

struct RawBf { v2u v[4]; };
__device__ __forceinline__ void ld_raw_bf(RawBf& r, const bf16* p, int lane) {
#pragma unroll
    for (int j = 0; j < 4; ++j) r.v[j] = ((const v2u*)p)[lane + 64 * j];
}
__device__ __forceinline__ void cvt_raw_bf(RowV& o, const RawBf& r) {
#pragma unroll
    for (int j = 0; j < 4; ++j) o.v[j] = (f32x4){bflo(r.v[j].x), bfhi(r.v[j].x), bflo(r.v[j].y), bfhi(r.v[j].y)};
}
__device__ __forceinline__ const float* x_row_ptr(const Args& a, const Ids& id, int layer, int m) {
    return (layer == 0) ? ((m < NPR) ? a.in[0 + id.z] + (size_t)m * D : a.in[1 + id.z] + (size_t)(m - NPR) * D) : a.out + id.z + O_X + (size_t)m * D;
}
__device__ __forceinline__ void ph_norm0(const Args& a, const Ids& id) {
    bf16* H = (bf16*)(a.ws + id.z + A_H); const float* g0 = a.in[11 + id.z] + (size_t)(0 * 4 + 0) * D;
    int m = id.gw; RowV xn; if (m < NTOK) ld_row(xn, x_row_ptr(a, id, 0, m), id.lane);
    for (; m < NTOK; m += id.ngw) { RowV x = xn, h; if (m + id.ngw < NTOK) ld_row(xn, x_row_ptr(a, id, 0, m + id.ngw), id.lane);
        const float* md = mod_ptr_(a, id, cond_of(m), 0);
        norm_mod(h, x, g0, md + 1024, md + 0, id.lane); st_row_bf16(h, H + (size_t)m * D, id.lane); }
}
__device__ __forceinline__ void ph_resid_norm(const Args& a, const Ids& id, int layer, bool dummy = false) {
    bf16* H = (bf16*)(a.ws + id.z + (dummy ? AR + 224 * MiB : A_H)); float* xout = dummy ? (float*)(a.ws + id.z + A_F) : a.out + id.z + O_X; const bf16* M = (const bf16*)(a.ws + id.z + A_M); const float* g1 = a.in[11 + id.z] + (size_t)(layer * 4 + 1) * D; const float* g2 = a.in[11 + id.z] + (size_t)(layer * 4 + 2) * D;
    int m = id.gw; RowV xn; RawBf xbn, mn;
    if (m < NTOK) { if (layer == 0) ld_row(xn, x_row_ptr(a, id, 0, m), id.lane); else ld_raw_bf(xbn, (const bf16*)(a.out + id.z + O_X + (size_t)m * D) + ((layer & 1) ? 1024 : 0), id.lane); ld_raw_bf(mn, M + (size_t)m * D, id.lane); }
    for (; m < NTOK; m += id.ngw) { RowV x, mm, h; if (layer == 0) x = xn; else cvt_raw_bf(x, xbn); cvt_raw_bf(mm, mn);
        if (m + id.ngw < NTOK) { if (layer == 0) ld_row(xn, x_row_ptr(a, id, 0, m + id.ngw), id.lane); else ld_raw_bf(xbn, (const bf16*)(a.out + id.z + O_X + (size_t)(m + id.ngw) * D) + ((layer & 1) ? 1024 : 0), id.lane);
                                 ld_raw_bf(mn, M + (size_t)(m + id.ngw) * D, id.lane); }
        const float* md = mod_ptr_(a, id, cond_of(m), layer);
        resid_add(x, mm, g1, md + 2048, id.lane); st_row_bf16(x, (bf16*)(xout + (size_t)m * D), id.lane);
        norm_mod(h, x, g2, md + 4096, md + 3072, id.lane); st_row_bf16(h, H + (size_t)m * D, id.lane); }
}
__device__ __forceinline__ void ph_resid_end(const Args& a, const Ids& id, LAS unsigned char* lds, int layer, bool dummy = false) {
    bf16* H = (bf16*)(a.ws + id.z + (dummy ? AR + 96 * MiB : A_H)); float* xout = dummy ? (float*)(a.ws + id.z + AR + 32 * MiB) : a.out + id.z + O_X; const bf16* F = (const bf16*)(a.ws + id.z + A_F); const float* g3 = a.in[11 + id.z] + (size_t)(layer * 4 + 3) * D;
    const bool next_attn = (layer + 1 < DEPTH) && (((layer + 1) & 1) == 0);
    const float* g0n = a.in[11 + id.z] + (size_t)((layer + 1) * 4 + 0) * D;
    int m = id.gw; RawBf xbn, fn; if (m < NTOK) { ld_raw_bf(xbn, (const bf16*)(a.out + id.z + O_X + (size_t)m * D), id.lane); ld_raw_bf(fn, F + (size_t)m * D, id.lane); }
    for (; m < NTOK; m += id.ngw) { RowV x, ff; cvt_raw_bf(x, xbn); cvt_raw_bf(ff, fn);
        if (m + id.ngw < NTOK) { ld_raw_bf(xbn, (const bf16*)(a.out + id.z + O_X + (size_t)(m + id.ngw) * D), id.lane); ld_raw_bf(fn, F + (size_t)(m + id.ngw) * D, id.lane); }
        const float* md = mod_ptr_(a, id, cond_of(m), layer);
        resid_add(x, ff, g3, md + 5120, id.lane);
        if (layer + 1 == DEPTH) st_row(x, xout + (size_t)m * D, id.lane); else st_row_bf16(x, (bf16*)(xout + (size_t)m * D), id.lane);
        if (next_attn) { RowV h; const float* mdn = mod_ptr_(a, id, cond_of(m), layer + 1); norm_mod(h, x, g0n, mdn + 1024, mdn + 0, id.lane); st_row_bf16(h, H + (size_t)m * D, id.lane); } }
    if (layer + 1 < DEPTH) conv_weights(a, id, lds, layer + 1, next_attn ? 1 : 3);
}
__device__ __forceinline__ void ph_rw_mix(const Args& a, const Ids& id, int layer) {
    bf16* A2 = (bf16*)(a.ws + id.z + A_A2); bf16* XS = (bf16*)(a.ws + id.z + A_XS); const float* g0 = a.in[11 + id.z] + (size_t)(layer * 4 + 0) * D; const float* mu6 = a.in[17 + id.z] + (size_t)(layer >> 1) * 6 * D;
    for (int g8 = id.gw; g8 < NTOK / 8; g8 += id.ngw) {
        const int m0 = g8 * 8; const int t0 = (m0 < NPR) ? (m0 & (TP - 1)) : ((m0 - NPR) & (TS - 1)); const int T = (m0 < NPR) ? TP : TS;
        const float* md = mod_ptr_(a, id, cond_of(m0), layer); const float* xp = a.out + id.z + O_X + (size_t)m0 * D;
        RowV hp, hc, hn, xr;
#pragma unroll
        for (int q = 0; q < 4; ++q) hp.v[q] = (f32x4){0.f, 0.f, 0.f, 0.f};
        if (t0 > 0) { ld_row_bf16(xr, (const bf16*)(xp - D), id.lane); norm_mod(hp, xr, g0, md + 1024, md + 0, id.lane); }
        ld_row_bf16(xr, (const bf16*)xp, id.lane); norm_mod(hc, xr, g0, md + 1024, md + 0, id.lane);
        RawBf nx; if (t0 + 1 < T) ld_raw_bf(nx, (const bf16*)(xp + D), id.lane);
#pragma unroll 1
        for (int i = 0; i < 8; ++i) {
#pragma unroll
            for (int q = 0; q < 4; ++q) hn.v[q] = (f32x4){0.f, 0.f, 0.f, 0.f};
            const RawBf cu = nx; if (i + 2 <= 8 && t0 + i + 2 < T) ld_raw_bf(nx, (const bf16*)(xp + (size_t)(i + 2) * D), id.lane);
            if (t0 + i + 1 < T) { cvt_raw_bf(xr, cu); norm_mod(hn, xr, g0, md + 1024, md + 0, id.lane); }
            RowV xx;
#pragma unroll
            for (int q = 0; q < 4; ++q) xx.v[q] = (hp.v[q] + hn.v[q]) * 0.5f - hc.v[q];
            st_row_bf16(hc, A2 + (size_t)(m0 + i) * KRKV, id.lane); st_row_bf16(xx, A2 + (size_t)(m0 + i) * KRKV + D, id.lane);
#pragma unroll
            for (int p = 0; p < 3; ++p) { const float* mu = mu6 + (size_t)(p == 0 ? 0 : p + 1) * D; RowV xm;
#pragma unroll
                for (int q = 0; q < 4; ++q) xm.v[q] = hc.v[q] + xx.v[q] * ((const f32x4*)mu)[id.lane + 64 * q];
                st_row_bf16(xm, XS + ((size_t)p * NTOK + m0 + i) * D, id.lane); }
            hp = hc; hc = hn;
        }
    }
}

__device__ __forceinline__ void ph_rend_mix(const Args& a, const Ids& id, LAS unsigned char* lds, int layer) {
    const int nl = layer + 1;
    bf16* A2 = (bf16*)(a.ws + id.z + A_A2); bf16* XS = (bf16*)(a.ws + id.z + A_XS); const bf16* F = (const bf16*)(a.ws + id.z + A_F);
    const float* g3 = a.in[11 + id.z] + (size_t)(layer * 4 + 3) * D; const float* g0 = a.in[11 + id.z] + (size_t)(nl * 4 + 0) * D; const float* mu6 = a.in[17 + id.z] + (size_t)(nl >> 1) * 6 * D;
    for (int g8 = id.gw; g8 < NTOK / 8; g8 += id.ngw) {
        const int m0 = g8 * 8; const int t0 = (m0 < NPR) ? (m0 & (TP - 1)) : ((m0 - NPR) & (TS - 1)); const int T = (m0 < NPR) ? TP : TS;
        const float* mdp = mod_ptr_(a, id, cond_of(m0), layer); const float* md = mod_ptr_(a, id, cond_of(m0), nl);
        float* xp = a.out + id.z + O_X + (size_t)m0 * D; const bf16* fp = F + (size_t)m0 * D;
        RowV hp, hc, hn, xr, fr; RawBf nx, nf;
#pragma unroll
        for (int q = 0; q < 4; ++q) hp.v[q] = (f32x4){0.f, 0.f, 0.f, 0.f};
        if (t0 > 0) { ld_row_bf16(xr, (const bf16*)(xp - D), id.lane); ld_row_bf16(fr, fp - D, id.lane); resid_add(xr, fr, g3, mdp + 5120, id.lane); norm_mod(hp, xr, g0, md + 1024, md + 0, id.lane); }
        ld_row_bf16(xr, (const bf16*)xp, id.lane); ld_row_bf16(fr, fp, id.lane); resid_add(xr, fr, g3, mdp + 5120, id.lane); st_row_bf16(xr, (bf16*)xp + 1024, id.lane);
        norm_mod(hc, xr, g0, md + 1024, md + 0, id.lane);
        if (t0 + 1 < T) { ld_raw_bf(nx, (const bf16*)(xp + D), id.lane); ld_raw_bf(nf, fp + D, id.lane); }
#pragma unroll 1
        for (int i = 0; i < 8; ++i) {
#pragma unroll
            for (int q = 0; q < 4; ++q) hn.v[q] = (f32x4){0.f, 0.f, 0.f, 0.f};
            const RawBf cu = nx, cf = nf; if (i + 2 <= 8 && t0 + i + 2 < T) { ld_raw_bf(nx, (const bf16*)(xp + (size_t)(i + 2) * D), id.lane); ld_raw_bf(nf, fp + (size_t)(i + 2) * D, id.lane); }
            if (t0 + i + 1 < T) { cvt_raw_bf(xr, cu); cvt_raw_bf(fr, cf); resid_add(xr, fr, g3, mdp + 5120, id.lane);
                if (i + 1 < 8) st_row_bf16(xr, (bf16*)(xp + (size_t)(i + 1) * D) + 1024, id.lane);
                norm_mod(hn, xr, g0, md + 1024, md + 0, id.lane); }
            RowV xx;
#pragma unroll
            for (int q = 0; q < 4; ++q) xx.v[q] = (hp.v[q] + hn.v[q]) * 0.5f - hc.v[q];
            st_row_bf16(hc, A2 + (size_t)(m0 + i) * KRKV, id.lane); st_row_bf16(xx, A2 + (size_t)(m0 + i) * KRKV + D, id.lane);
#pragma unroll
            for (int p = 0; p < 3; ++p) { const float* mu = mu6 + (size_t)(p == 0 ? 0 : p + 1) * D; RowV xm;
#pragma unroll
                for (int q = 0; q < 4; ++q) xm.v[q] = hc.v[q] + xx.v[q] * ((const f32x4*)mu)[id.lane + 64 * q];
                st_row_bf16(xm, XS + ((size_t)p * NTOK + m0 + i) * D, id.lane); }
            hp = hc; hc = hn;
        }
    }
    conv_weights(a, id, lds, nl, 3);
}

__device__ __forceinline__ void row16_sum4(float& a, float& b, float& c, float& d) {
    asm("s_nop 1\n\t"
        "v_add_f32_dpp %0, %0, %0 row_ror:8 row_mask:0xf bank_mask:0xf\n\tv_add_f32_dpp %1, %1, %1 row_ror:8 row_mask:0xf bank_mask:0xf\n\tv_add_f32_dpp %2, %2, %2 row_ror:8 row_mask:0xf bank_mask:0xf\n\tv_add_f32_dpp %3, %3, %3 row_ror:8 row_mask:0xf bank_mask:0xf\n\t"
        "v_add_f32_dpp %0, %0, %0 row_ror:4 row_mask:0xf bank_mask:0xf\n\tv_add_f32_dpp %1, %1, %1 row_ror:4 row_mask:0xf bank_mask:0xf\n\tv_add_f32_dpp %2, %2, %2 row_ror:4 row_mask:0xf bank_mask:0xf\n\tv_add_f32_dpp %3, %3, %3 row_ror:4 row_mask:0xf bank_mask:0xf\n\t"
        "v_add_f32_dpp %0, %0, %0 row_ror:2 row_mask:0xf bank_mask:0xf\n\tv_add_f32_dpp %1, %1, %1 row_ror:2 row_mask:0xf bank_mask:0xf\n\tv_add_f32_dpp %2, %2, %2 row_ror:2 row_mask:0xf bank_mask:0xf\n\tv_add_f32_dpp %3, %3, %3 row_ror:2 row_mask:0xf bank_mask:0xf\n\t"
        "v_add_f32_dpp %0, %0, %0 row_ror:1 row_mask:0xf bank_mask:0xf\n\tv_add_f32_dpp %1, %1, %1 row_ror:1 row_mask:0xf bank_mask:0xf\n\tv_add_f32_dpp %2, %2, %2 row_ror:1 row_mask:0xf bank_mask:0xf\n\tv_add_f32_dpp %3, %3, %3 row_ror:1 row_mask:0xf bank_mask:0xf"
        : "+v"(a), "+v"(b), "+v"(c), "+v"(d));
}
__device__ __forceinline__ f32x4 ld_bf4(const bf16* p) { const v2u w = *(const v2u*)p; return (f32x4){bflo(w.x), bfhi(w.x), bflo(w.y), bfhi(w.y)}; }
__device__ __forceinline__ void ph_att_cache(const Args& a, const Ids& id, int layer) {
    const int j = layer >> 1, lane = id.lane;
    bf16 *KAS = (bf16*)(a.ws + id.z + A_KAS), *VAS = (bf16*)(a.ws + id.z + A_VAS), *KBS = (bf16*)(a.ws + id.z + A_KBS), *VBS = (bf16*)(a.ws + id.z + A_VBS);
    for (int r = id.gw; r < 4 * PAST; r += id.ngw) {
        const int b = r >> 9, pos = r & (PAST - 1);
        const size_t src = (size_t)((b * 2 + j) * PAST + pos), dst = (size_t)(b * SKV + pos);
#pragma unroll
        for (int q = 0; q < 2; ++q) { const int e = lane + 64 * q; KAS[dst * 128 + e] = (bf16)f2bf(a.in[3 + id.z][src * 128 + e]); VAS[dst * 128 + e] = (bf16)f2bf(a.in[4 + id.z][src * 128 + e]); }
#pragma unroll
        for (int q = 0; q < 8; ++q) { const int e = lane + 64 * q; KBS[dst * 512 + e] = (bf16)f2bf(a.in[5 + id.z][src * 512 + e]); VBS[dst * 512 + e] = (bf16)f2bf(a.in[6 + id.z][src * 512 + e]); }
    }
}

typedef short bf16x8_t __attribute__((ext_vector_type(8)));
typedef float f32x16 __attribute__((ext_vector_type(16)));
typedef short v4i16_t __attribute__((ext_vector_type(4)));
constexpr float AT_THR = 8.0f;
constexpr int AT_KP = 144, AT_KBUF = 64 * AT_KP, AT_VOFF = 2 * AT_KBUF, AT_VBUFMAX = 64 * 288, AT_WSF = AT_VOFF + 2 * AT_VBUFMAX;
static_assert(AT_WSF + 8 * 128 <= RING_BYTES, "attention LDS");
template <int NDT>
__device__ __forceinline__ void attn_unit(const bf16* Qrow0, int ldq, const bf16* Kb, int ldk, const bf16* Vb, int ldv, int S, bf16* Obf, bf16* Od, int ldo, LAS unsigned char* lds, const Ids& id) {
    constexpr int VP = (NDT == 2) ? 144 : 288, NVL = NDT / 2;
    const int lane = id.lane, w = id.wave, r32 = lane & 31, hi = lane >> 5, tid = id.tid;
    bf16x8_t qf[4];
    { const bf16* qrow = Qrow0 + (size_t)(32 * w + r32) * ldq;
#pragma unroll
      for (int s = 0; s < 4; ++s) qf[s] = *(const bf16x8_t*)(qrow + 16 * s + 8 * hi); }
    f32x16 o[NDT];
#pragma unroll
    for (int dt = 0; dt < NDT; ++dt)
#pragma unroll
        for (int r = 0; r < 16; ++r) o[dt][r] = 0.f;
    float m_run = 0.f, l_run = 0.f;
    const int NT = S >> 6;
    LAS float* wsf = (LAS float*)(lds + AT_WSF + w * 128);
    const int krow = tid >> 3, kch = tid & 7;
    v4u kreg, vreg[NVL];
#define AT_GLOAD(t) do { kreg = *(const v4u*)(Kb + (size_t)((t) * 64 + krow) * ldk + 8 * kch); \
        if (NDT == 2) vreg[0] = *(const v4u*)(Vb + (size_t)((t) * 64 + krow) * ldv + 8 * kch); \
        else { _Pragma("unroll") for (int i_ = 0; i_ < NVL; ++i_) { const int ix_ = tid + 512 * i_; vreg[i_] = *(const v4u*)(Vb + (size_t)((t) * 64 + (ix_ >> 4)) * ldv + 8 * (ix_ & 15)); } } } while (0)
#define AT_LSTORE(b) do { *(LAS v4u*)(lds + (b) * AT_KBUF + krow * AT_KP + 16 * kch) = kreg; \
        if (NDT == 2) *(LAS v4u*)(lds + AT_VOFF + (b) * AT_VBUFMAX + krow * VP + 16 * kch) = vreg[0]; \
        else { _Pragma("unroll") for (int i_ = 0; i_ < NVL; ++i_) { const int ix_ = tid + 512 * i_; *(LAS v4u*)(lds + AT_VOFF + (b) * AT_VBUFMAX + (ix_ >> 4) * VP + 16 * (ix_ & 15)) = vreg[i_]; } } } while (0)
    AT_GLOAD(0); AT_LSTORE(0);
    __syncthreads();
    const int vbase = (4 * hi + ((lane & 15) >> 2)) * VP + 32 * ((lane >> 4) & 1) + 8 * (lane & 3);
#pragma unroll 1
    for (int t = 0; t < NT; ++t) {
        const int b = t & 1;
        if (t + 1 < NT) AT_GLOAD(t + 1);
        const LAS unsigned char* Kt = lds + b * AT_KBUF + r32 * AT_KP + 16 * hi;
        const LAS unsigned char* Vt = lds + AT_VOFF + b * AT_VBUFMAX + vbase;
        f32x16 p0, p1;
        { const float nm = -m_run;
#pragma unroll
          for (int r = 0; r < 16; ++r) { p0[r] = nm; p1[r] = nm; } }
#pragma unroll
        for (int s = 0; s < 4; ++s) { const bf16x8_t k0 = *(const LAS bf16x8_t*)(Kt + 32 * s), k1 = *(const LAS bf16x8_t*)(Kt + 32 * AT_KP + 32 * s);
            p0 = __builtin_amdgcn_mfma_f32_32x32x16_bf16(k0, qf[s], p0, 0, 0, 0); p1 = __builtin_amdgcn_mfma_f32_32x32x16_bf16(k1, qf[s], p1, 0, 0, 0); }
        float mx = __builtin_fmaxf(p0[0], p1[0]);
#pragma unroll
        for (int r = 1; r < 16; ++r) mx = __builtin_fmaxf(__builtin_fmaxf(mx, p0[r]), p1[r]);
        mx = fmaxf(mx, __shfl_xor(mx, 32));
        if (t == 0 || __any(mx > AT_THR)) {
            const float dl = (t == 0) ? mx : fmaxf(mx, 0.f), al = __builtin_amdgcn_exp2f(-dl); m_run += dl; l_run *= al;
#pragma unroll
            for (int r = 0; r < 16; ++r) { p0[r] -= dl; p1[r] -= dl; }
            if (hi == 0) wsf[r32] = al;
            LDS_WAIT(); asm volatile("" ::: "memory");
            { f32x4 a4[4];
#pragma unroll
              for (int g4 = 0; g4 < 4; ++g4) a4[g4] = *(const LAS f32x4*)(wsf + 8 * g4 + 4 * hi);
#pragma unroll
              for (int dt = 0; dt < NDT; ++dt)
#pragma unroll
                  for (int r = 0; r < 16; ++r) o[dt][r] *= a4[r >> 2][r & 3]; }
            LDS_WAIT(); asm volatile("" ::: "memory");
        }
        float rs = 0.f;
#pragma unroll
        for (int r = 0; r < 16; ++r) { p0[r] = __builtin_amdgcn_exp2f(p0[r]); p1[r] = __builtin_amdgcn_exp2f(p1[r]); rs += p0[r] + p1[r]; }
        l_run += rs;
        bf16x8_t pf[4];
#pragma unroll
        for (int ks = 0; ks < 4; ++ks) { v4u pw;
#pragma unroll
            for (int dd = 0; dd < 4; ++dd) { const int r = 8 * (ks & 1) + 2 * dd; pw[dd] = (ks < 2) ? pk2(p0[r], p0[r + 1]) : pk2(p1[r], p1[r + 1]); }
            pf[ks] = __builtin_bit_cast(bf16x8_t, pw); }
#pragma unroll
        for (int ks = 0; ks < 4; ++ks)
#pragma unroll
            for (int dt = 0; dt < NDT; ++dt) {
                const v4i16_t lo = __builtin_amdgcn_ds_read_tr16_b64_v4i16((LAS v4i16_t*)(Vt + (16 * ks) * VP + 64 * dt));
                const v4i16_t hh = __builtin_amdgcn_ds_read_tr16_b64_v4i16((LAS v4i16_t*)(Vt + (16 * ks + 8) * VP + 64 * dt));
                const bf16x8_t vf = (bf16x8_t){lo[0], lo[1], lo[2], lo[3], hh[0], hh[1], hh[2], hh[3]};
                o[dt] = __builtin_amdgcn_mfma_f32_32x32x16_bf16(pf[ks], vf, o[dt], 0, 0, 0); }
        if (t + 1 < NT) AT_LSTORE(b ^ 1);
        __syncthreads();
    }
#undef AT_GLOAD
#undef AT_LSTORE
    const float lt = l_run + __shfl_xor(l_run, 32);
    int lane_e = lane; asm volatile("" : "+v"(lane_e));
    const int r32e = lane_e & 31, hie = lane_e >> 5;
    if (hi == 0) wsf[r32] = 1.0f / lt;
    LDS_WAIT(); asm volatile("" ::: "memory");
    f32x4 a4[4];
#pragma unroll
    for (int g4 = 0; g4 < 4; ++g4) a4[g4] = *(const LAS f32x4*)(wsf + 8 * g4 + 4 * hi);
    LDS_WAIT(); asm volatile("" ::: "memory");
#pragma unroll
    for (int dt = 0; dt < NDT; ++dt)
#pragma unroll
        for (int r = 0; r < 16; ++r) { const float val = o[dt][r] * a4[r >> 2][r & 3]; const int off = (32 * w + (r & 3) + 8 * (r >> 2) + 4 * hie) * ldo + 32 * dt + r32e;
            (NDT == 2 ? Obf : Od)[off] = (bf16)f2bf(val); }
}
__device__ __forceinline__ void ph_attn(const Args& a, const Ids& id, LAS unsigned char* lds, int G, int vcu) {
    const bf16 *QA = (const bf16*)(a.ws + id.z + A_QA), *QB = (const bf16*)(a.ws + id.z + A_QB), *KAP = (const bf16*)(a.ws + id.z + A_KAP), *VAP = (const bf16*)(a.ws + id.z + A_VAP), *KBP = (const bf16*)(a.ws + id.z + A_KBP), *VBP = (const bf16*)(a.ws + id.z + A_VBP);
    const bf16 *KAS = (const bf16*)(a.ws + id.z + A_KAS), *VAS = (const bf16*)(a.ws + id.z + A_VAS), *KBS = (const bf16*)(a.ws + id.z + A_KBS), *VBS = (const bf16*)(a.ws + id.z + A_VBS);
    bf16* H = (bf16*)(a.ws + id.z + A_H); bf16* DT = (bf16*)(a.ws + id.z + A_DT);
    for (int s = vcu; s < 256; s += G) {
        const int h8 = s & 7;
#pragma unroll 1
        for (int pass = 0; pass < 2; ++pass) {
            size_t m0, kvrow; int S;
            if (pass == 0) { const int b = s >> 6, qb = (s >> 3) & 7; m0 = (size_t)NPR + b * TS + qb * 256; kvrow = (size_t)b * SKV; S = SKV; }
            else { const int b = s >> 3; m0 = (size_t)b * TP; kvrow = m0; S = TP; }
            const bf16* Ka = (pass == 0 ? KAS : KAP) + kvrow * 128 + (h8 >> 2) * 64; const bf16* Va = (pass == 0 ? VAS : VAP) + kvrow * 128 + (h8 >> 2) * 64;
            const bf16* Kd = (pass == 0 ? KBS : KBP) + kvrow * 512 + h8 * 64; const bf16* Vd = (pass == 0 ? VBS : VBP) + kvrow * 512 + (h8 >> 1) * 128;
            attn_unit<2>(QA + m0 * 512 + h8 * 64, 512, Ka, 128, Va, 128, S, H + m0 * D + h8 * 64, nullptr, D, lds, id);
            attn_unit<4>(QB + m0 * 512 + h8 * 64, 512, Kd, 512, Vd, 512, S, nullptr, DT + m0 * D + h8 * 128, D, lds, id);
        }
    }
}
__device__ __forceinline__ void ph_att_comb(const Args& a, const Ids& id, int layer) {
    const int j = layer >> 1, lane = id.lane; const float lam_init = (layer == 0) ? 0.2f : 0.4707130183435842f;
    const float* lf = a.in[15 + id.z] + j * 256; const float* sg = a.in[16 + id.z] + j * 128;
    const float s01 = wave_sum(lf[lane] * lf[64 + lane]), s23 = wave_sum(lf[128 + lane] * lf[192 + lane]);
    const float lam = expf(s01) - expf(s23) + lam_init;
    const bf16* DT = (const bf16*)(a.ws + id.z + A_DT); bf16* H = (bf16*)(a.ws + id.z + A_H);
    const f32x4 gg = *(const f32x4*)(sg + 4 * (lane & 31)) * (1.0f - lam_init);
    for (int m = id.gw; m < NTOK; m += id.ngw) {
        f32x4 v[4];
#pragma unroll
        for (int hd = 0; hd < 4; ++hd) v[hd] = ld_bf4(DT + (size_t)m * D + 256 * hd + 4 * lane);
        float ss[4];
#pragma unroll
        for (int hd = 0; hd < 4; ++hd) { f32x4 o; o[0] = __shfl_xor(v[hd][0], 32); o[1] = __shfl_xor(v[hd][1], 32); o[2] = __shfl_xor(v[hd][2], 32); o[3] = __shfl_xor(v[hd][3], 32);
            v[hd] = v[hd] - o * lam;
            ss[hd] = (lane < 32) ? (v[hd][0] * v[hd][0] + v[hd][1] * v[hd][1]) + (v[hd][2] * v[hd][2] + v[hd][3] * v[hd][3]) : 0.f; }
        row16_sum4(ss[0], ss[1], ss[2], ss[3]);
#pragma unroll
        for (int hd = 0; hd < 4; ++hd) { const float tot = ss[hd] + __shfl_xor(ss[hd], 16); const float ri = 1.0f / sqrtf(tot * (1.0f / 128.0f) + 1e-6f); const f32x4 o = v[hd] * ri * gg;
            if (lane < 32) *(v2u*)(H + (size_t)m * D + 512 + hd * 128 + 4 * lane) = (v2u){pk2(o[0], o[1]), pk2(o[2], o[3])}; }
    }
}

__device__ __forceinline__ void lora2_phase(LAS unsigned char* lds, const bf16* A, const bf16* Bt, const pg8::EpiLora2& E, int G, int bx, const Ids& id) {
    const int wid = id.wave, lane = id.lane, tid = id.tid, wr = wid >> 2, wc = wid & 3, fr = lane & 15, fq = lane >> 4;
    constexpr int PT = 144;
    LAS unsigned char* As = lds; LAS unsigned char* Bs = lds + 256 * PT;
    const int colr = 32 * wc + 8 * (fr >> 2) + (fr & 3);
#pragma unroll 1
    for (int u = bx; u < 256; u += G) {
        const int pm = u >> 2, pn = 16 + (u & 3); const int kofs = 256, nch = 2;
        f32x4 acc[2][2][4][2];
#pragma unroll
        for (int ai = 0; ai < 2; ++ai)
#pragma unroll
            for (int bj = 0; bj < 2; ++bj)
#pragma unroll
                for (int m = 0; m < 4; ++m) { acc[ai][bj][m][0] = (f32x4){0.f, 0.f, 0.f, 0.f}; acc[ai][bj][m][1] = (f32x4){0.f, 0.f, 0.f, 0.f}; }
#pragma unroll 1
        for (int ch = 0; ch < nch; ++ch) {
            const bf16* Ag = A + (size_t)(pm * 256) * 384 + kofs + 64 * ch; const bf16* Bg = Bt + (size_t)(pn * 256) * 384 + kofs + 64 * ch;
#pragma unroll
            for (int i = 0; i < 4; ++i) { const int idx = tid + 512 * i, r = idx >> 3, c8 = idx & 7;
                *(LAS v4u*)(As + r * PT + 16 * c8) = *(const v4u*)(Ag + (size_t)r * 384 + 8 * c8); *(LAS v4u*)(Bs + r * PT + 16 * c8) = *(const v4u*)(Bg + (size_t)r * 384 + 8 * c8); }
            __syncthreads();
#pragma unroll
            for (int ks = 0; ks < 2; ++ks) {
                bf16x8_t bo[2][4], ao[2][2];
#pragma unroll
                for (int ai = 0; ai < 2; ++ai)
#pragma unroll
                    for (int m = 0; m < 4; ++m) bo[ai][m] = *(const LAS bf16x8_t*)(As + (128 * ai + 64 * wr + 16 * m + fr) * PT + 64 * ks + 16 * fq);
#pragma unroll
                for (int bj = 0; bj < 2; ++bj)
#pragma unroll
                    for (int n = 0; n < 2; ++n) ao[bj][n] = *(const LAS bf16x8_t*)(Bs + (128 * bj + colr + 4 * n) * PT + 64 * ks + 16 * fq);
#pragma unroll
                for (int ai = 0; ai < 2; ++ai)
#pragma unroll
                    for (int bj = 0; bj < 2; ++bj)
#pragma unroll
                        for (int m = 0; m < 4; ++m)
#pragma unroll
                            for (int n = 0; n < 2; ++n) acc[ai][bj][m][n] = __builtin_amdgcn_mfma_f32_16x16x32_bf16(ao[bj][n], bo[ai][m], acc[ai][bj][m][n], 0, 0, 0);
            }
            __syncthreads();
        }
        E(acc, pg8::Unit{pm, pn}, wr, wc, fr, fq);
    }
}
__device__ __forceinline__ void ph_rw_prep(const Args& a, const Ids& id, int layer) {
    const int j = layer >> 1, lane = id.lane, h = lane >> 2, qd = lane & 3;
    const bf16* RKV = (const bf16*)(a.ws + id.z + A_RKV) + 1024 + h * 64 + 16 * qd; float* INV = (float*)(a.ws + id.z + WS_INV);
    const f32x4* kc = (const f32x4*)(a.in[28 + id.z] + (size_t)(j * 3 + 0) * D + h * 64 + 16 * qd);
    const f32x4 c0 = kc[0], c1 = kc[1], c2 = kc[2], c3 = kc[3];
    int m = id.gw; v4u wa, wb; if (m < NTOK) { wa = *(const v4u*)(RKV + (size_t)m * 3072); wb = *(const v4u*)(RKV + (size_t)m * 3072 + 8); }
    for (; m < NTOK; m += id.ngw) {
        const v4u w0 = wa, w1 = wb;
        if (m + id.ngw < NTOK) { wa = *(const v4u*)(RKV + (size_t)(m + id.ngw) * 3072); wb = *(const v4u*)(RKV + (size_t)(m + id.ngw) * 3072 + 8); }
        const f32x4 t0 = (f32x4){bflo(w0.x), bfhi(w0.x), bflo(w0.y), bfhi(w0.y)} * c0, t1 = (f32x4){bflo(w0.z), bfhi(w0.z), bflo(w0.w), bfhi(w0.w)} * c1,
                    t2 = (f32x4){bflo(w1.x), bfhi(w1.x), bflo(w1.y), bfhi(w1.y)} * c2, t3 = (f32x4){bflo(w1.z), bfhi(w1.z), bflo(w1.w), bfhi(w1.w)} * c3;
        const f32x4 q4 = t0 * t0 + t1 * t1 + t2 * t2 + t3 * t3;
        float s = (q4[0] + q4[1]) + (q4[2] + q4[3]);
        asm("s_nop 1\n\tv_add_f32_dpp %0, %0, %0 quad_perm:[1,0,3,2] row_mask:0xf bank_mask:0xf\n\ts_nop 1\n\tv_add_f32_dpp %0, %0, %0 quad_perm:[2,3,0,1] row_mask:0xf bank_mask:0xf\n\ts_nop 1" : "+v"(s));
        if (qd == 0) INV[m * 16 + h] = 1.0f / sqrtf(s + 1e-12f);
    }
}

constexpr int SC_TC = 16;
constexpr int CK_AH = 0, CK_RH = 2560, CK_VT = 5120, CK_KCT = 7680, CK_BCT = 10240, CK_TM = 12288, CK_LAK = 12800, CK_MRB = 13312, CK_MRK = 13824, CK_GC = 14336, CK_SLOT = 16384;
constexpr int CK_TMP = 4 * CK_SLOT, CK_TMPW = 4608;
constexpr int SC_YOFF = (CK_TMP + 2 * CK_TMPW) / 4;
constexpr int CK_BSL = (SC_YOFF + 2 * SC_TC * 64) * 4;
static_assert(CK_BSL + 1024 <= RING_BYTES, "scan LDS");
constexpr size_t A_BS = AR + 208 * MiB;
constexpr int CK_AEW = CK_BSL + 1024;
constexpr int CK_L1F = CK_AEW + 2 * 4608;
static_assert(CK_L1F + 2 * 4096 <= RING_BYTES, "scan LDS");
constexpr int SC_NC = TS / SC_TC;
struct ScDesc { int mbase, T, h, dir, b; };
__device__ __forceinline__ void sc_desc(ScDesc& d, int slot, int c) {
    if (slot < 128) { d.b = slot >> 5; d.h = (slot >> 1) & 15; d.dir = slot & 1; d.T = TS; d.mbase = NPR + d.b * TS; }
    else { const int cp = (slot - 128) * 8 + (c >> 4); d.b = cp >> 5; d.h = (cp >> 1) & 15; d.dir = cp & 1; d.T = TP; d.mbase = d.b * TP; }
}
__device__ __forceinline__ int sc_cbase(int slot, int c) { return (slot < 128 ? c : (c & 15)) * SC_TC; }
__device__ __forceinline__ int sc_tok(const ScDesc& d, int s) { return d.mbase + (d.dir ? d.T - 1 - s : s); }
typedef float f32x2 __attribute__((ext_vector_type(2)));
typedef short bf16x4_t __attribute__((ext_vector_type(4)));
#define MF32(a_, b_, c_) __builtin_amdgcn_mfma_f32_16x16x32_bf16(a_, b_, c_, 0, 0, 0)
__device__ __forceinline__ f32x4 mf16_pad(const bf16x4_t a, const bf16x4_t b, const f32x4 c) {
    const bf16x8_t a8 = (bf16x8_t){a[0], a[1], a[2], a[3], 0, 0, 0, 0}, b8 = (bf16x8_t){b[0], b[1], b[2], b[3], 0, 0, 0, 0};
    return __builtin_amdgcn_mfma_f32_16x16x32_bf16(a8, b8, c, 0, 0, 0);
}
#define MF16(a_, b_, c_) mf16_pad(a_, b_, c_)
__device__ __forceinline__ v2u pk4u(const f32x4 v) { return (v2u){pk2(v[0], v[1]), pk2(v[2], v[3])}; }
__device__ __forceinline__ bf16x4_t pk4(const f32x4 v) { return __builtin_bit_cast(bf16x4_t, pk4u(v)); }
__device__ __forceinline__ f32x2 exp2v(const f32x2 x) { return (f32x2){__builtin_amdgcn_exp2f(x[0]), __builtin_amdgcn_exp2f(x[1])}; }
template <int CTRL> __device__ __forceinline__ float dpp_f(float v) { return __builtin_bit_cast(float, __builtin_amdgcn_update_dpp(0, __builtin_bit_cast(int, v), CTRL, 0xf, 0xf, true)); }
__device__ __forceinline__ float bperm_f(int srclane, float v) { return __builtin_bit_cast(float, __builtin_amdgcn_ds_bpermute(srclane << 2, __builtin_bit_cast(int, v))); }
struct CkKv { f32x2 kkc, kac, rkc; };
struct CkRaw { unsigned r[2], k[2]; float iv[2]; unsigned v[2]; bf16x8_t lf[4]; };
__device__ __forceinline__ void ck_load(CkRaw& R, const Args& a, const Ids& id, int slot, int c, int hq) {
    const int lane = id.lane, kp = 8 * hq + (lane & 7), tq = lane >> 3; ScDesc d; sc_desc(d, slot, c);
    const int s0 = sc_cbase(slot, c) + 2 * tq; const int m0 = sc_tok(d, s0); const int ms = d.dir ? -1 : 1;
    const unsigned char* bR = a.ws + id.z + A_RKV; const unsigned char* bI = a.ws + id.z + WS_INV;
    const unsigned oR = (unsigned)m0 * 6144u + (unsigned)(d.h * 128 + 4 * kp), oI = (unsigned)m0 * 64u + (unsigned)(d.h * 4);
    const unsigned sR = (unsigned)(ms * 6144), sI = (unsigned)(ms * 64);
#pragma unroll
    for (int it = 0; it < 2; ++it) {
        R.r[it] = *(const unsigned*)(bR + (oR + it * sR)); R.k[it] = *(const unsigned*)(bR + (oR + it * sR + 2048u)); R.v[it] = *(const unsigned*)(bR + (oR + it * sR + 4096u));
        R.iv[it] = *(const float*)(bI + (oI + it * sI)); }
    if (hq == 3) { const int c2 = c + 2 < SC_NC ? c + 2 : SC_NC - 1; ScDesc d2; sc_desc(d2, slot, c2);
        const bf16* L1 = (const bf16*)(a.ws + id.z + A_L1) + (size_t)sc_tok(d2, sc_cbase(slot, c2) + (lane & 15)) * 384 + 8 * (lane >> 4) + 64 * d2.dir;
        R.lf[0] = *(const bf16x8_t*)(L1 + 128); R.lf[1] = *(const bf16x8_t*)(L1 + 160); R.lf[2] = *(const bf16x8_t*)L1; R.lf[3] = *(const bf16x8_t*)(L1 + 32); }
}
__device__ __forceinline__ void ck_derive(const CkRaw& Rin, const Args& a, const Ids& id, LAS unsigned char* sb, LAS unsigned char* tb, LAS unsigned char* bsl, const LAS unsigned char* aew, LAS unsigned char* l1f, CkKv& kv, int layer, int slot, int c, int hq, bool tail = false) {
    if (tail) asm volatile("s_waitcnt vmcnt(0)" ::: "memory");
    else if (hq == 3) asm volatile("s_waitcnt vmcnt(12)" ::: "memory"); else asm volatile("s_waitcnt vmcnt(8)" ::: "memory");
    CkRaw R = Rin;
#pragma unroll
    for (int it = 0; it < 2; ++it) asm volatile("" : "+v"(R.r[it]), "+v"(R.k[it]), "+v"(R.iv[it]), "+v"(R.v[it]));
    if (hq == 3) { asm volatile("" : "+v"(R.lf[0]), "+v"(R.lf[1]), "+v"(R.lf[2]), "+v"(R.lf[3]));
#pragma unroll
        for (int f = 0; f < 4; ++f) *(LAS bf16x8_t*)(l1f + f * 1024 + id.lane * 16) = R.lf[f]; }
    const int lane = id.lane, kp = 8 * hq + (lane & 7), tq = lane >> 3, j = layer >> 1; ScDesc d; sc_desc(d, slot, c);
    if (slot < 128 ? c == 0 : (c & 15) == 0) {
        const float* kvp = a.in[28 + id.z] + (size_t)(j * 3) * D + d.h * 64 + 2 * kp;
        kv.kkc = *(const f32x2*)kvp; kv.kac = *(const f32x2*)(kvp + D); kv.rkc = *(const f32x2*)(kvp + 2 * D);
        asm volatile("s_waitcnt vmcnt(0)" : "+v"(kv.kkc), "+v"(kv.kac), "+v"(kv.rkc) :: "memory"); }
    const f32x2 kkc = kv.kkc, kac = kv.kac;
    const unsigned ra0 = *(const LAS unsigned*)(aew + (2 * tq) * 144 + 4 * kp), ra1 = *(const LAS unsigned*)(aew + (2 * tq + 1) * 144 + 4 * kp);
    const unsigned re0 = *(const LAS unsigned*)(aew + 2304 + (2 * tq) * 144 + 4 * kp), re1 = *(const LAS unsigned*)(aew + 2304 + (2 * tq + 1) * 144 + 4 * kp);
    const f32x2 e0 = (f32x2){bflo(re0), bfhi(re0)}, e1 = (f32x2){bflo(re1), bfhi(re1)}, tot = e0 + e1;
    const int tl = ((lane & 7) << 3) | (lane >> 3), ts = lane & 7;
    const f32x2 yt = (f32x2){bperm_f(tl, tot[0]), bperm_f(tl, tot[1])};
    const float m1 = ts >= 1 ? 1.f : 0.f, m2 = ts >= 2 ? 1.f : 0.f, m4 = ts >= 4 ? 1.f : 0.f;
    const f32x2 p1 = yt + (f32x2){dpp_f<0x111>(yt[0]), dpp_f<0x111>(yt[1])} * m1;
    const f32x2 p2 = p1 + (f32x2){dpp_f<0x112>(p1[0]), dpp_f<0x112>(p1[1])} * m2;
    const f32x2 p3 = p2 + (f32x2){dpp_f<0x114>(p2[0]), dpp_f<0x114>(p2[1])} * m4;
    f32x2 ct = yt + (f32x2){dpp_f<0xB1>(yt[0]), dpp_f<0xB1>(yt[1])};
    ct = ct + (f32x2){dpp_f<0x4E>(ct[0]), dpp_f<0x4E>(ct[1])};
    ct = ct + (f32x2){dpp_f<0x141>(ct[0]), dpp_f<0x141>(ct[1])};
    const f32x2 s3 = (f32x2){bperm_f(tl, p3[0]), bperm_f(tl, p3[1])}, cumC = (f32x2){bperm_f(tl, ct[0]), bperm_f(tl, ct[1])};
    const f32x2 carry = s3 - tot;
    const f32x2 gC = exp2v(-cumC);
    f32x2 gprev = exp2v(-carry), cum = carry;
    f32x2 kcp = (f32x2){0.f, 0.f}, bcp = (f32x2){0.f, 0.f};
    const f32x2 rkc = kv.rkc; float bon0 = 0.f, bon1 = 0.f;
#pragma unroll
    for (int it = 0; it < 2; ++it) {
        cum = cum + (it == 0 ? e0 : e1); const f32x2 g = exp2v(-cum), ig = exp2v(cum);
        const f32x2 k2 = (f32x2){bflo(R.k[it]), bfhi(R.k[it])}, a2 = (f32x2){bflo(it == 0 ? ra0 : ra1), bfhi(it == 0 ? ra0 : ra1)}, r2 = (f32x2){bflo(R.r[it]), bfhi(R.r[it])};
        const f32x2 kdv = k2 * ((a2 - 1.0f) * kac + 1.0f);
        const f32x2 kk = k2 * kkc * R.iv[it], Ah = kk * gprev, Bh = kk * a2 * ig, Kh = kdv * ig, Rh = r2 * g, Kc = Kh * gC, Bc = Bh * gC;
        { const f32x2 bp = r2 * kdv * rkc; if (it == 0) bon0 = bp[0] + bp[1]; else bon1 = bp[0] + bp[1]; }
        gprev = g;
        const int ro = (2 * tq + it) * 144 + 4 * kp;
        *(LAS unsigned*)(sb + CK_AH + ro) = pk2(Ah[0], Ah[1]); *(LAS unsigned*)(sb + CK_RH + ro) = pk2(Rh[0], Rh[1]);
        *(LAS unsigned*)(tb + ro) = pk2(Bh[0], Bh[1]); *(LAS unsigned*)(tb + 2304 + ro) = pk2(Kh[0], Kh[1]);
        if (it == 1) { *(LAS unsigned*)(sb + CK_KCT + (2 * kp) * 32 + 4 * tq) = pk2(kcp[0], Kc[0]); *(LAS unsigned*)(sb + CK_KCT + (2 * kp + 1) * 32 + 4 * tq) = pk2(kcp[1], Kc[1]);
                       *(LAS unsigned*)(sb + CK_BCT + (2 * kp) * 32 + 4 * tq) = pk2(bcp[0], Bc[0]); *(LAS unsigned*)(sb + CK_BCT + (2 * kp + 1) * 32 + 4 * tq) = pk2(bcp[1], Bc[1]); }
        else { kcp = Kc; bcp = Bc; }
    }
    if (tq == 0) *(LAS f32x2*)(sb + CK_GC + 8 * kp) = gC;
    asm volatile("s_nop 1\n\t"
        "v_add_f32_dpp %0, %0, %0 quad_perm:[1,0,3,2] row_mask:0xf bank_mask:0xf\n\tv_add_f32_dpp %1, %1, %1 quad_perm:[1,0,3,2] row_mask:0xf bank_mask:0xf\n\ts_nop 1\n\t"
        "v_add_f32_dpp %0, %0, %0 quad_perm:[2,3,0,1] row_mask:0xf bank_mask:0xf\n\tv_add_f32_dpp %1, %1, %1 quad_perm:[2,3,0,1] row_mask:0xf bank_mask:0xf\n\ts_nop 1\n\t"
        "v_add_f32_dpp %0, %0, %0 row_half_mirror row_mask:0xf bank_mask:0xf\n\tv_add_f32_dpp %1, %1, %1 row_half_mirror row_mask:0xf bank_mask:0xf\n\ts_nop 1" : "+v"(bon0), "+v"(bon1));
    if ((lane & 7) == 0) *(LAS f32x2*)(bsl + (hq * 16 + 2 * tq) * 4) = (f32x2){bon0, bon1};
    *(LAS unsigned*)(sb + CK_VT + (2 * kp) * 32 + 4 * tq) = (R.v[0] & 0xffffu) | (R.v[1] << 16);
    *(LAS unsigned*)(sb + CK_VT + (2 * kp + 1) * 32 + 4 * tq) = (R.v[0] >> 16) | (R.v[1] & 0xffff0000u);
}
struct CkAew { bf16x8_t la0, la1, le0, le1, wa0, wa1, we0, we1; f32x4 ba, be; };
__device__ __forceinline__ void ck_aew_load(CkAew& F, const Args& a, const Ids& id, int layer, int slot, int c, int w) {
    const int lane = id.lane, ln = lane & 15, q = lane >> 4, j = layer >> 1; ScDesc d; sc_desc(d, slot, c);
    const int tok = sc_tok(d, sc_cbase(slot, c) + ln);
    const int ka = 128 + 64 * d.dir, ke = 64 * d.dir;
    const bf16* L1 = (const bf16*)(a.ws + id.z + A_L1) + (size_t)tok * 384 + 8 * q;
    const bf16* W2 = (const bf16*)(a.ws + id.z + W_BT2) + (size_t)(d.h * 64 + 16 * w + ln) * 384 + 8 * q;
    const bf16* Wa = W2 + (size_t)(d.dir * 1024) * 384 + ka; const bf16* We = W2 + (size_t)((2 + d.dir) * 1024) * 384 + ke;
    F.la0 = *(const bf16x8_t*)(L1 + ka); F.la1 = *(const bf16x8_t*)(L1 + ka + 32); F.le0 = *(const bf16x8_t*)(L1 + ke); F.le1 = *(const bf16x8_t*)(L1 + ke + 32);
    F.wa0 = *(const bf16x8_t*)Wa; F.wa1 = *(const bf16x8_t*)(Wa + 32); F.we0 = *(const bf16x8_t*)We; F.we1 = *(const bf16x8_t*)(We + 32);
    const size_t bo = (size_t)j * 2 * D + d.dir * 1024 + d.h * 64 + 16 * w + 4 * q;
    F.ba = *(const f32x4*)(a.in[23 + id.z] + bo); F.be = *(const f32x4*)(a.in[20 + id.z] + bo);
}
__device__ __forceinline__ void ck_aew_loadW(CkAew& F, const Args& a, const Ids& id, int layer, int slot, int c, int w) {
    const int lane = id.lane, ln = lane & 15, q = lane >> 4, j = layer >> 1; ScDesc d; sc_desc(d, slot, c);
    const int ka = 128 + 64 * d.dir, ke = 64 * d.dir;
    const bf16* W2 = (const bf16*)(a.ws + id.z + W_BT2) + (size_t)(d.h * 64 + 16 * w + ln) * 384 + 8 * q;
    const bf16* Wa = W2 + (size_t)(d.dir * 1024) * 384 + ka; const bf16* We = W2 + (size_t)((2 + d.dir) * 1024) * 384 + ke;
    F.wa0 = *(const bf16x8_t*)Wa; F.wa1 = *(const bf16x8_t*)(Wa + 32); F.we0 = *(const bf16x8_t*)We; F.we1 = *(const bf16x8_t*)(We + 32);
    const size_t bo = (size_t)j * 2 * D + d.dir * 1024 + d.h * 64 + 16 * w + 4 * q;
    F.ba = *(const f32x4*)(a.in[23 + id.z] + bo); F.be = *(const f32x4*)(a.in[20 + id.z] + bo);
}
__device__ __forceinline__ void ck_aew_finish(CkAew& F, const Ids& id, LAS unsigned char* dst, int w, const LAS unsigned char* l1f = nullptr) {
    if (l1f) { F.la0 = *(const LAS bf16x8_t*)(l1f + id.lane * 16); F.la1 = *(const LAS bf16x8_t*)(l1f + 1024 + id.lane * 16); F.le0 = *(const LAS bf16x8_t*)(l1f + 2048 + id.lane * 16); F.le1 = *(const LAS bf16x8_t*)(l1f + 3072 + id.lane * 16); }
    asm volatile("s_waitcnt vmcnt(0)" : "+v"(F.la0), "+v"(F.la1), "+v"(F.le0), "+v"(F.le1), "+v"(F.wa0), "+v"(F.wa1), "+v"(F.we0), "+v"(F.we1), "+v"(F.ba), "+v"(F.be) :: "memory");
    const int ln = id.lane & 15, q = id.lane >> 4;
    const f32x4 zero = (f32x4){0.f, 0.f, 0.f, 0.f};
    f32x4 da = MF32(F.wa0, F.la0, zero); da = MF32(F.wa1, F.la1, da);
    f32x4 de = MF32(F.we0, F.le0, zero); de = MF32(F.we1, F.le1, de);
#pragma unroll
    for (int jj = 0; jj < 4; ++jj) {
        da[jj] = __builtin_amdgcn_rcpf(1.0f + __builtin_amdgcn_exp2f(-1.4426950408889634f * (da[jj] + F.ba[jj])));
        de[jj] = 0.8750387749719753f * __builtin_amdgcn_rcpf(1.0f + __builtin_amdgcn_exp2f(-1.4426950408889634f * (de[jj] + F.be[jj]))); }
    *(LAS v2u*)(dst + ln * 144 + 2 * (16 * w + 4 * q)) = pk4u(da); *(LAS v2u*)(dst + 2304 + ln * 144 + 2 * (16 * w + 4 * q)) = pk4u(de);
}
__device__ __forceinline__ void ck_products(const Ids& id, LAS unsigned char* sb, const LAS unsigned char* tb, int hq) {
    const int ln = id.lane & 15, q = id.lane >> 4;
    const f32x4 zero = (f32x4){0.f, 0.f, 0.f, 0.f};
    if (hq == 0) {
        f32x4 P0 = zero, P1 = zero;
#pragma unroll
        for (int ks = 0; ks < 2; ++ks) { const int fo = ln * 144 + 64 * ks + 16 * q;
            const bf16x8_t ah = *(const LAS bf16x8_t*)(sb + CK_AH + fo), bh = *(const LAS bf16x8_t*)(tb + fo);
            P0 = MF32(ah, bh, P0);
            P1 = MF32(bh, ah, P1); }
        f32x4 b1, a1, z0;
#pragma unroll
        for (int jj = 0; jj < 4; ++jj) { const int row = 4 * q + jj;
            b1[jj] = (ln < row) ? -P0[jj] : 0.f;
            a1[jj] = (row < ln) ? -P1[jj] : 0.f;
            z0[jj] = a1[jj] + ((row == ln) ? 1.f : 0.f); }
        const bf16x4_t a1b = pk4(a1), b1b = pk4(b1);
        const f32x4 b2 = MF16(a1b, b1b, zero), a2 = MF16(b1b, a1b, zero);
        const bf16x4_t b2b = pk4(b2), a2b = pk4(a2);
        const f32x4 z1 = MF16(b2b, pk4(z0), z0);
        const f32x4 b4 = MF16(a2b, b2b, zero), a4 = MF16(b2b, a2b, zero);
        const bf16x4_t b4b = pk4(b4), a4b = pk4(a4);
        const f32x4 z2 = MF16(b4b, pk4(z1), z1);
        const f32x4 b8 = MF16(a4b, b4b, zero);
        const f32x4 z3 = MF16(pk4(b8), pk4(z2), z2);
        *(LAS v2u*)(sb + CK_TM + ln * 32 + 8 * q) = pk4u(z3);
    } else {
        const LAS unsigned char* pa = tb + (hq == 2 ? 0 : 2304); const LAS unsigned char* pb = sb + (hq == 1 ? CK_AH : CK_RH);
        f32x4 P = zero;
#pragma unroll
        for (int ks = 0; ks < 2; ++ks) { const int fo = ln * 144 + 64 * ks + 16 * q; P = MF32(*(const LAS bf16x8_t*)(pa + fo), *(const LAS bf16x8_t*)(pb + fo), P); }
        f32x4 m;
#pragma unroll
        for (int jj = 0; jj < 4; ++jj) { const int row = 4 * q + jj; m[jj] = ((hq == 1) ? (row < ln) : (row <= ln)) ? P[jj] : 0.f; }
        *(LAS v2u*)(sb + (hq == 1 ? CK_LAK : (hq == 2 ? CK_MRB : CK_MRK)) + ln * 32 + 8 * q) = pk4u(m);
    }
}
__device__ __forceinline__ void sc_flush(const Args& a, const Ids& id, const LAS float* L, int hq, int slot, int c) {
    bf16* Y = (bf16*)(a.ws + id.z + A_Y);
    ScDesc d; sc_desc(d, slot, c); const int cb = sc_cbase(slot, c);
#pragma unroll
    for (int qq = 0; qq < 2; ++qq) { const int idx = hq * 64 + id.lane + 256 * qq, s = idx >> 5, rp = idx & 31;
        const f32x2 yv = *(const LAS f32x2*)(L + SC_YOFF + (c & 1) * SC_TC * 64 + s * 64 + 2 * rp);
        *(unsigned*)(Y + ((size_t)d.dir * NTOK + sc_tok(d, cb + s)) * D + d.h * 64 + 2 * rp) = pk2(yv[0], yv[1]); }
    if (hq == 0 && id.lane < 16) { const LAS float* bl = L + CK_BSL / 4 + (c & 3) * 64 + id.lane;
        ((float*)(a.ws + id.z + A_BS))[((size_t)d.dir * NTOK + sc_tok(d, cb + id.lane)) * 16 + d.h] = (bl[0] + bl[16]) + (bl[32] + bl[48]); }
}
__device__ __forceinline__ void ph_rw_scan(const Args& a, const Ids& id, LAS unsigned char* lds, int layer, int G, int vcu) {
    const int j = layer >> 1, lane = id.lane, w = id.wave;
    LAS float* L = (LAS float*)lds;
    constexpr int NC = TS / SC_TC;
    for (int slot = vcu; slot < 256; slot += G) {
        if (w >= 4) {
            const int hq = w - 4; CkRaw R0, R1; CkKv kv;
            __builtin_amdgcn_s_setprio(2);
            LAS unsigned char* tg = lds + CK_TMP;
            ck_load(R0, a, id, slot, 0, hq); ck_load(R1, a, id, slot, 1, hq);
            __syncthreads();
            ck_derive(R0, a, id, lds, tg, lds + CK_BSL, lds + CK_AEW, lds + CK_L1F, kv, layer, slot, 0, hq);
            ck_load(R0, a, id, slot, 2, hq);
            ck_derive(R1, a, id, lds + CK_SLOT, tg + CK_TMPW, lds + CK_BSL + 256, lds + CK_AEW + 4608, lds + CK_L1F + 4096, kv, layer, slot, 1, hq);
            ck_load(R1, a, id, slot, 3, hq);
            __syncthreads();
            ck_products(id, lds, tg, hq);
            __syncthreads();
#pragma unroll 1
            for (int n = 0; n < NC; n += 2) {
                ck_products(id, lds + ((n + 1) & 3) * CK_SLOT, tg + CK_TMPW, hq);
                if (n + 2 < NC) ck_derive(R0, a, id, lds + ((n + 2) & 3) * CK_SLOT, tg, lds + CK_BSL + ((n + 2) & 3) * 256, lds + CK_AEW, lds + CK_L1F, kv, layer, slot, n + 2, hq, n + 3 >= NC);
                if (n > 0) sc_flush(a, id, L, hq, slot, n - 1);
                if (n + 4 < NC) ck_load(R0, a, id, slot, n + 4, hq);
                __syncthreads();
                if (n + 2 < NC) ck_products(id, lds + ((n + 2) & 3) * CK_SLOT, tg, hq);
                if (n + 3 < NC) ck_derive(R1, a, id, lds + ((n + 3) & 3) * CK_SLOT, tg + CK_TMPW, lds + CK_BSL + ((n + 3) & 3) * 256, lds + CK_AEW + 4608, lds + CK_L1F + 4096, kv, layer, slot, n + 3, hq, n + 4 >= NC);
                sc_flush(a, id, L, hq, slot, n);
                if (n + 5 < NC) ck_load(R1, a, id, slot, n + 5, hq);
                __syncthreads();
            }
            sc_flush(a, id, L, hq, slot, NC - 1);
            __builtin_amdgcn_s_setprio(0);
        } else {
            const int ln = lane & 15, q = lane >> 4, i0l = 16 * w; const bool prompt = slot >= 128;
            const f32x4 zero = (f32x4){0.f, 0.f, 0.f, 0.f};
            f32x4 S0 = zero, S1 = zero, S2 = zero, S3 = zero;
            if (!prompt) { ScDesc d; sc_desc(d, slot, 0);
                const float* sp = a.in[7 + id.z] + ((((size_t)(d.b * 2 + j) * 2 + d.dir) * 16 + d.h) * 64 + i0l + ln) * 64 + 4 * q;
                S0 = *(const f32x4*)sp; S1 = *(const f32x4*)(sp + 16); S2 = *(const f32x4*)(sp + 32); S3 = *(const f32x4*)(sp + 48); }
            CkAew F;
            ck_aew_load(F, a, id, layer, slot, 0, w); ck_aew_finish(F, id, lds + CK_AEW, w);
            ck_aew_load(F, a, id, layer, slot, 1, w); ck_aew_finish(F, id, lds + CK_AEW + 4608, w);
            __syncthreads();
            __syncthreads();
            ck_aew_load(F, a, id, layer, slot, 2, w); ck_aew_finish(F, id, lds + CK_AEW, w);
            __syncthreads();
#pragma unroll 1
            for (int c = 0; c < NC; ++c) {
                if (prompt && (c & 15) == 0) { S0 = zero; S1 = zero; S2 = zero; S3 = zero; }
                if (c + 3 < NC && prompt && ((c + 3) & 15) == 0) ck_aew_loadW(F, a, id, layer, slot, c + 3, w);
                const LAS unsigned char* sb = lds + (c & 3) * CK_SLOT;
                const bf16x8_t sf0 = __builtin_bit_cast(bf16x8_t, (v4u){pk2(S0[0], S0[1]), pk2(S0[2], S0[3]), pk2(S1[0], S1[1]), pk2(S1[2], S1[3])});
                const bf16x8_t sf1 = __builtin_bit_cast(bf16x8_t, (v4u){pk2(S2[0], S2[1]), pk2(S2[2], S2[3]), pk2(S3[0], S3[1]), pk2(S3[2], S3[3])});
                const int po = ln * 144 + 8 * q;
                const v2u ah0 = *(const LAS v2u*)(sb + CK_AH + po), ah1 = *(const LAS v2u*)(sb + CK_AH + po + 32), ah2 = *(const LAS v2u*)(sb + CK_AH + po + 64), ah3 = *(const LAS v2u*)(sb + CK_AH + po + 96);
                const v2u rh0 = *(const LAS v2u*)(sb + CK_RH + po), rh1 = *(const LAS v2u*)(sb + CK_RH + po + 32), rh2 = *(const LAS v2u*)(sb + CK_RH + po + 64), rh3 = *(const LAS v2u*)(sb + CK_RH + po + 96);
                const int so = ln * 32 + 8 * q;
                const bf16x4_t vt = *(const LAS bf16x4_t*)(sb + CK_VT + i0l * 32 + so), lak = *(const LAS bf16x4_t*)(sb + CK_LAK + so), mrk = *(const LAS bf16x4_t*)(sb + CK_MRK + so),
                               mrb = *(const LAS bf16x4_t*)(sb + CK_MRB + so), tm = *(const LAS bf16x4_t*)(sb + CK_TM + so);
                f32x4 u0 = MF16(lak, vt, zero), y = MF16(mrk, vt, zero);
                u0 = MF32(__builtin_bit_cast(bf16x8_t, (v4u){ah0.x, ah0.y, ah1.x, ah1.y}), sf0, u0); u0 = MF32(__builtin_bit_cast(bf16x8_t, (v4u){ah2.x, ah2.y, ah3.x, ah3.y}), sf1, u0);
                y = MF32(__builtin_bit_cast(bf16x8_t, (v4u){rh0.x, rh0.y, rh1.x, rh1.y}), sf0, y); y = MF32(__builtin_bit_cast(bf16x8_t, (v4u){rh2.x, rh2.y, rh3.x, rh3.y}), sf1, y);
                const f32x4 gc0 = *(const LAS f32x4*)(sb + CK_GC + 16 * q), gc1 = *(const LAS f32x4*)(sb + CK_GC + 64 + 16 * q), gc2 = *(const LAS f32x4*)(sb + CK_GC + 128 + 16 * q), gc3 = *(const LAS f32x4*)(sb + CK_GC + 192 + 16 * q);
                S0 = MF16(*(const LAS bf16x4_t*)(sb + CK_KCT + so), vt, S0 * gc0); S1 = MF16(*(const LAS bf16x4_t*)(sb + CK_KCT + 512 + so), vt, S1 * gc1);
                S2 = MF16(*(const LAS bf16x4_t*)(sb + CK_KCT + 1024 + so), vt, S2 * gc2); S3 = MF16(*(const LAS bf16x4_t*)(sb + CK_KCT + 1536 + so), vt, S3 * gc3);
                const f32x4 u = MF16(tm, pk4(u0), zero);
                const bf16x4_t nub = pk4(-u);
                y = MF16(mrb, nub, y);
                S0 = MF16(*(const LAS bf16x4_t*)(sb + CK_BCT + so), nub, S0); S1 = MF16(*(const LAS bf16x4_t*)(sb + CK_BCT + 512 + so), nub, S1);
                S2 = MF16(*(const LAS bf16x4_t*)(sb + CK_BCT + 1024 + so), nub, S2); S3 = MF16(*(const LAS bf16x4_t*)(sb + CK_BCT + 1536 + so), nub, S3);
                LAS float* yb = L + SC_YOFF + (c & 1) * SC_TC * 64 + i0l + ln;
#pragma unroll
                for (int jj = 0; jj < 4; ++jj) yb[(4 * q + jj) * 64] = y[jj];
                if (prompt && (c & 15) == 15) { ScDesc d; sc_desc(d, slot, c);
                    float* dp = a.out + id.z + O_ST + ((((size_t)(d.b * 2 + j) * 2 + d.dir) * 16 + d.h) * 64 + i0l + ln) * 64 + 4 * q;
                    *(f32x4*)dp = S0; *(f32x4*)(dp + 16) = S1; *(f32x4*)(dp + 32) = S2; *(f32x4*)(dp + 48) = S3; }
                if (c + 3 < NC) ck_aew_finish(F, id, lds + CK_AEW + ((c + 3) & 1) * 4608, w, lds + CK_L1F + ((c + 3) & 1) * 4096);
                __syncthreads();
            }
        }
        __syncthreads();
    }
}
__device__ __forceinline__ void ph_rw_post(const Args& a, const Ids& id, int layer) {
    const int j = layer >> 1, lane = id.lane;
    const bf16* RKV = (const bf16*)(a.ws + id.z + A_RKV); const bf16* Y = (const bf16*)(a.ws + id.z + A_Y);
    const float* BS = (const float*)(a.ws + id.z + A_BS); bf16* H = (bf16*)(a.ws + id.z + A_H);
    const float* lnx = a.in[29 + id.z] + (size_t)j * 2 * D;
    f32x4 l0[4], l1[4];
#pragma unroll
    for (int q = 0; q < 4; ++q) { const int c = 4 * lane + 256 * q; l0[q] = *(const f32x4*)(lnx + c); l1[q] = *(const f32x4*)(lnx + D + c); }
    for (int m = id.gw; m < NTOK; m += id.ngw) {
        f32x4 y[4], v[4], g[4]; float s[4], qv[4], bs[4];
#pragma unroll
        for (int q = 0; q < 4; ++q) { const int c = 4 * lane + 256 * q; y[q] = ld_bf4(Y + (size_t)m * D + c) + ld_bf4(Y + ((size_t)NTOK + m) * D + c);
            v[q] = ld_bf4(RKV + (size_t)m * 3072 + 2048 + c); g[q] = ld_bf4(H + (size_t)m * D + c);
            bs[q] = BS[(size_t)m * 16 + (lane >> 4) + 4 * q] + BS[((size_t)NTOK + m) * 16 + (lane >> 4) + 4 * q]; }
#pragma unroll
        for (int q = 0; q < 4; ++q) s[q] = (y[q][0] + y[q][1]) + (y[q][2] + y[q][3]);
        row16_sum4(s[0], s[1], s[2], s[3]);
#pragma unroll
        for (int q = 0; q < 4; ++q) { const float mean = s[q] * (1.0f / 64.0f); y[q] = y[q] - mean; qv[q] = (y[q][0] * y[q][0] + y[q][1] * y[q][1]) + (y[q][2] * y[q][2] + y[q][3] * y[q][3]); }
        row16_sum4(qv[0], qv[1], qv[2], qv[3]);
#pragma unroll
        for (int q = 0; q < 4; ++q) { const float ri = 1.0f / sqrtf(qv[q] * (1.0f / 64.0f) + 64e-5f); const f32x4 o = ((y[q] * ri) * l0[q] + l1[q] + v[q] * bs[q]) * g[q];
            *(v2u*)(H + (size_t)m * D + 4 * lane + 256 * q) = (v2u){pk2(o[0], o[1]), pk2(o[2], o[3])}; }
    }
}

enum Kind { K_PRO = 0, K_NORM0 = 1, K_QKV = 2, K_APOST = 3, K_ATTN = 4, K_ACOMB = 5, K_MIXOUT = 6, K_RNORM = 7, K_MLP1 = 8, K_MLP2 = 9, K_REND = 10,
            K_RMIX = 11, K_RKV = 12, K_RPREP = 13, K_RSCAN = 14, K_RPOST = 15, K_RENDMIX = 16 };
constexpr int NPH = 36;
#ifndef PROBE_MASK
#define PROBE_MASK 0
#endif
#ifndef PROBE_REPS
#define PROBE_REPS 1
#endif
template <int KIND, int LAYER>
__device__ __forceinline__ void run_phase(const Args& a, LAS unsigned char* lds, int G, int bx, int vcu, int wave_s, int rep) {
    Ids id; { int lv; asm volatile("v_mbcnt_lo_u32_b32 %0, -1, 0\n\tv_mbcnt_hi_u32_b32 %0, -1, %0" : "=v"(lv)); int zz; asm volatile("s_mov_b32 %0, 0" : "=s"(zz)); id.lane = lv; id.z = zz; }
    id.wave = wave_s; id.tid = wave_s * 64 + id.lane; id.gw = vcu * NWAVES + id.wave; id.ngw = G * NWAVES;
    constexpr int layer = LAYER;
    if constexpr (KIND == K_PRO) ph_prologue(a, id, lds);
    else if constexpr (KIND == K_NORM0) ph_norm0(a, id);
    else if constexpr (KIND == K_QKV) {
        constexpr int j = layer >> 1;
        pg8::Gemm g{(const bf16*)(a.ws + id.z + A_H), (const bf16*)(a.ws + id.z + W_WINT), NTOK, NQKV, D}; pg8::StaticOrder S; S.init(NTOK, NQKV, G, bx);
        const float* RC = (const float*)(a.ws + id.z + WS_ROPE);
        pg8::EpiQkv<QkvMap> E{a.ws + id.z, a.out + id.z, a.in[14 + id.z] + j * 128, RC, RC + 2048 * 64, j};
        pg8::gemm_phase<pg8::EpiQkv<QkvMap>, pg8::StaticOrder, true, true>(lds + RING_OFF, g, S, E, id.wave);
        { Ids id2 = id; int lv; asm volatile("v_mbcnt_lo_u32_b32 %0, -1, 0\n\tv_mbcnt_hi_u32_b32 %0, -1, %0" : "=v"(lv)); int zz; asm volatile("s_mov_b32 %0, 0" : "=s"(zz));
          id2.lane = lv; id2.z = zz; id2.tid = id.wave * 64 + lv;
          if (G == 256) { if (bx >= 64) { id2.gw = (bx - 64) * NWAVES + id.wave; id2.ngw = 192 * NWAVES; ph_att_cache(a, id2, layer); conv_weights(a, id2, lds, layer, 2); } }
          else { ph_att_cache(a, id2, layer); conv_weights(a, id2, lds, layer, 2); } }
    }
    else if constexpr (KIND == K_MIXOUT) {
        pg8::Gemm g{(const bf16*)(a.ws + id.z + A_H), (const bf16*)(a.ws + id.z + ((layer & 1) ? W_WOT : W_WOUTT)), NTOK, D, D}; pg8::StaticOrder S; S.init(NTOK, D, G, bx);
        pg8::EpiBf16<0> E{(bf16*)(a.ws + id.z + A_M), D, 1 << 20, nullptr, 0};
        pg8::gemm_phase<pg8::EpiBf16<0>, pg8::StaticOrder, true, true>(lds + RING_OFF, g, S, E, id.wave);
    }
    else if constexpr (KIND == K_MLP2) {
        pg8::Gemm g{(const bf16*)(a.ws + id.z + A_HID), (const bf16*)(a.ws + id.z + W_W2T), NTOK, D, FF}; pg8::StaticOrder S; S.init(NTOK, D, G, bx);
        pg8::EpiBf16<0> E{(bf16*)(a.ws + id.z + A_F), D, 1 << 20, nullptr, 0};
        pg8::gemm_phase<pg8::EpiBf16<0>, pg8::StaticOrder, true, true>(lds + RING_OFF, g, S, E, id.wave);
    }
    else if constexpr (KIND == K_MLP1) {
        pg8::Gemm g{(const bf16*)(a.ws + id.z + A_H), (const bf16*)(a.ws + id.z + W_W1T), NTOK, FF, D}; pg8::StaticOrder S; S.init(NTOK, FF, G, bx);
        pg8::EpiBf16<2> E{(bf16*)(a.ws + id.z + A_HID), FF, 1 << 20, nullptr, 0};
        pg8::gemm_phase<pg8::EpiBf16<2>, pg8::StaticOrder, true, true>(lds + RING_OFF, g, S, E, id.wave);
    }
    else if constexpr (KIND == K_RKV) {
        {
            pg8::Gemm g{(const bf16*)(a.ws + id.z + A_A2), (const bf16*)(a.ws + id.z + W_BTL), NTOK, 512, KRKV}; pg8::StaticOrder S; S.init(NTOK, 512, G, bx);
            pg8::EpiL1 E{(bf16*)(a.ws + id.z + A_L1)};
            pg8::gemm_phase<pg8::EpiL1, pg8::StaticOrder, true, true>(lds + RING_OFF, g, S, E, id.wave); }
        {
            pg8::Gemm g{(const bf16*)(a.ws + id.z + A_XS), (const bf16*)(a.ws + id.z + W_BTR), 3 * NTOK, 3072, D}; pg8::RkvOrder S{bx};
            pg8::EpiRkv3 E{(bf16*)(a.ws + id.z + A_RKV)};
            pg8::gemm_phase<pg8::EpiRkv3, pg8::RkvOrder, true, true>(lds + RING_OFF, g, S, E, id.wave); }
    }
    else if constexpr (KIND == K_RPREP) {
        constexpr int j = layer >> 1;
        static_assert(A_A1 - A_A0 == 32 * MiB && A_EW0 - A_A0 == 64 * MiB && A_EW1 - A_A0 == 96 * MiB, "EpiLora2 output stride");
        pg8::EpiLora2 E{(bf16*)(a.ws + id.z + A_A0), (size_t)16 * MiB, (bf16*)(a.ws + id.z + A_G), a.in[23 + id.z] + (size_t)j * 2 * D, a.in[20 + id.z] + (size_t)j * 2 * D};
        lora2_phase(lds + RING_OFF, (const bf16*)(a.ws + id.z + A_L1), (const bf16*)(a.ws + id.z + W_BT2), E, G, bx, id);
        { Ids id2 = id; int lv; asm volatile("v_mbcnt_lo_u32_b32 %0, -1, 0\n\tv_mbcnt_hi_u32_b32 %0, -1, %0" : "=v"(lv)); int zz; asm volatile("s_mov_b32 %0, 0" : "=s"(zz));
          id2.lane = lv; id2.z = zz; id2.tid = id.wave * 64 + lv; ph_rw_prep(a, id2, layer); }
    }
    else if constexpr (KIND == K_ATTN) ph_attn(a, id, lds, G, vcu);
    else if constexpr (KIND == K_ACOMB) ph_att_comb(a, id, layer);
    else if constexpr (KIND == K_RNORM) ph_resid_norm(a, id, layer, rep + 1 < (((PROBE_MASK >> K_RNORM) & 1) ? PROBE_REPS : 1));
    else if constexpr (KIND == K_REND) ph_resid_end(a, id, lds, layer, rep + 1 < (((PROBE_MASK >> K_REND) & 1) ? PROBE_REPS : 1));
    else if constexpr (KIND == K_RMIX) ph_rw_mix(a, id, layer);
    else if constexpr (KIND == K_RENDMIX) ph_rend_mix(a, id, lds, layer);
    else if constexpr (KIND == K_RSCAN) { if (rep > 0) { ph_rw_prep(a, id, layer); __syncthreads(); cg::this_grid().sync(); } ph_rw_scan(a, id, lds, layer, G, vcu); }
    else if constexpr (KIND == K_RPOST) ph_rw_post(a, id, layer);
}

__global__ void __launch_bounds__(NWAVES * 64, 2) mega_fwd(Args a) {
    extern __shared__ __attribute__((aligned(16))) unsigned char lds_raw[];
    LAS unsigned char* lds = (LAS unsigned char*)lds_raw;
    const int G = gridDim.x, bx = blockIdx.x; const int vcu = (G % 8 == 0) ? (bx % 8) * (G / 8) + bx / 8 : bx;
    volatile LAS unsigned* MISC = (volatile LAS unsigned*)(lds + MISC_OFF);
    for (int u = threadIdx.x; u < (LDS_BYTES - LDSCTL_OFF) / 4; u += NWAVES * 64) ((LAS unsigned*)(lds + LDSCTL_OFF))[u] = 0u;
    __syncthreads();
#if MK_N_LAUNCHES == 1 && !MK_CG_BARRIER
    XcdBarrier bar = xcd_barrier_post((unsigned*)(a.ws + WS_CTL) + CW_BAR, MISC + 8, threadIdx.x == 0);
#endif
    (void)MISC;
    const int lo = a.ph_lo, hi = a.ph_hi;
    const int wave_s = __builtin_amdgcn_readfirstlane(threadIdx.x >> 6);
#if MK_N_LAUNCHES == 1
#if MK_CG_BARRIER
#define GRID_BAR(ph) cg::this_grid().sync()
#else
#define GRID_BAR(ph) do { if ((ph) == 0) cg::this_grid().sync(); else { int l_; asm volatile("v_mbcnt_lo_u32_b32 %0, -1, 0\n\tv_mbcnt_hi_u32_b32 %0, -1, %0" : "=v"(l_)); xcd_barrier(bar, wave_s == 0 && l_ == 0); } } while (0)
#endif
#else
#define GRID_BAR(ph) do { } while (0)
#endif
#define PHASE(ph, KIND, LAYER) do { if (lo <= (ph) && (ph) < hi) { constexpr int nrep_ = ((PROBE_MASK >> (KIND)) & 1) ? PROBE_REPS : 1; \
        _Pragma("unroll 1") for (int rep_ = 0; rep_ < nrep_; ++rep_) { run_phase<KIND, LAYER>(a, lds, G, bx, vcu, wave_s, rep_); if (rep_ + 1 < nrep_) { __syncthreads(); cg::this_grid().sync(); } } \
        if ((ph) + 1 < hi) GRID_BAR(ph); } } while (0)
#define ATTN_LAYER(p0, L) PHASE((p0) + 0, K_QKV, L); PHASE((p0) + 1, K_ATTN, L); PHASE((p0) + 2, K_ACOMB, L); PHASE((p0) + 3, K_MIXOUT, L); \
        PHASE((p0) + 4, K_RNORM, L); PHASE((p0) + 5, K_MLP1, L); PHASE((p0) + 6, K_MLP2, L); PHASE((p0) + 7, K_RENDMIX, L)
#define RWKV_LAYER(p0, L) PHASE((p0) + 0, K_RKV, L); PHASE((p0) + 1, K_RPREP, L); PHASE((p0) + 2, K_RSCAN, L); PHASE((p0) + 3, K_RPOST, L); PHASE((p0) + 4, K_MIXOUT, L); \
        PHASE((p0) + 5, K_RNORM, L); PHASE((p0) + 6, K_MLP1, L); PHASE((p0) + 7, K_MLP2, L); PHASE((p0) + 8, K_REND, L)
    PHASE(0, K_PRO, 0); PHASE(1, K_NORM0, 0);
    ATTN_LAYER(2, 0); RWKV_LAYER(10, 1); ATTN_LAYER(19, 2); RWKV_LAYER(27, 3);
#undef PHASE
#undef ATTN_LAYER
#undef RWKV_LAYER
#undef GRID_BAR
}

extern "C" void kernel_launch(void* const* d_in, const int* in_sizes, int n_in, void* d_out, int out_size, void* d_ws, size_t ws_size, hipStream_t stream) {
    static int grid = 0;
    if (grid == 0) {
        if (n_in != 32 || (size_t)out_size != OUT_TOTAL || ws_size < WS_END) { fprintf(stderr, "kernel_launch: unexpected problem (n_in %d, out %d, ws %zu; need ws >= %zu); nothing launched\n", n_in, out_size, ws_size, (size_t)WS_END); grid = -1; return; }
        int dev = 0, cus = 0, per_cu = 0;
        if (hipGetDevice(&dev) != hipSuccess || hipDeviceGetAttribute(&cus, hipDeviceAttributeMultiprocessorCount, dev) != hipSuccess) { grid = -1; return; }
        if (hipFuncSetAttribute((const void*)mega_fwd, hipFuncAttributeMaxDynamicSharedMemorySize, LDS_BYTES) != hipSuccess) { fprintf(stderr, "kernel_launch: hipFuncSetAttribute failed\n"); grid = -1; return; }
        if (hipOccupancyMaxActiveBlocksPerMultiprocessor(&per_cu, (const void*)mega_fwd, NWAVES * 64, LDS_BYTES) != hipSuccess || per_cu < 1) { fprintf(stderr, "kernel_launch: occupancy query failed (%d)\n", per_cu); (void)hipGetLastError(); per_cu = 1; }
        grid = cus * (per_cu < 1 ? 1 : 1);
        fprintf(stderr, "kernel_launch: %d CUs, occupancy %d/CU, grid %d\n", cus, per_cu, grid);
    }
    if (grid < 0) return;
    (void)in_sizes;
    if (hipMemsetAsync((char*)d_ws + WS_CTL, 0, CTL_ZERO_BYTES, stream) != hipSuccess) { fprintf(stderr, "kernel_launch: memset failed\n"); return; }
    Args a{};
    for (int i = 0; i < 32; ++i) a.in[i] = (const float*)d_in[i];
    a.out = (float*)d_out; a.ws = (unsigned char*)d_ws;
#if MK_N_LAUNCHES == 1
    a.ph_lo = 0; a.ph_hi = NPH;
    void* args[] = {&a};
    hipError_t e = hipLaunchCooperativeKernel((const void*)mega_fwd, dim3(grid), dim3(NWAVES * 64), args, LDS_BYTES, stream);
    if (e != hipSuccess) fprintf(stderr, "kernel_launch: cooperative launch failed: %s (grid %d)\n", hipGetErrorString(e), grid);
#else
    for (int ph = 0; ph < NPH; ++ph) {
        a.ph_lo = ph; a.ph_hi = ph + 1;
        hipLaunchKernelGGL(mega_fwd, dim3(grid), dim3(NWAVES * 64), LDS_BYTES, stream, a);
    }
#endif
}
```

```cpp
#include <hip/hip_runtime.h>
#include <hip/hip_cooperative_groups.h>
#include <cstdio>
#include <cstdint>
namespace cg = cooperative_groups;
namespace pg8 {
#define PG8_LAS __attribute__((address_space(3)))
typedef unsigned short bf16_t;
typedef short bf16x8 __attribute__((ext_vector_type(8)));
typedef float f32x4 __attribute__((ext_vector_type(4)));
typedef unsigned u32x4 __attribute__((ext_vector_type(4)));
constexpr int BM = 256, BK = 64, HALF = 128, HTB = HALF * BK * 2  , STAGE_BYTES = 8 * HTB, NXCD = 8, WGM = 8;

__host__ __device__ __forceinline__ int lds_byte(int r, int c) { const int st = (r >> 4) * 2 + (c >> 5), rr = r & 15, cc = c & 31, ob = rr * 64 + cc * 2; return st * 1024 + (ob ^ (((ob >> 9) & 1) << 5)); }
__host__ __device__ __forceinline__ void stage_rc(int b, int& R, int& C) { const int st = b / 1024, sb = b % 1024, swz = sb ^ (((sb >> 9) & 1) << 5); R = (st >> 1) * 16 + swz / 64; C = (st & 1) * 32 + (swz % 64) / 2; }
__host__ __device__ __forceinline__ int perm32(int rho) { const int n = rho >> 4, i = rho & 15; return 8 * (i >> 2) + 4 * n + (i & 3); }

struct Unit { int pm, pn; };
struct Gemm { const bf16_t* A; const bf16_t* Bt; int M, N, K; };

struct StaticOrder {
    int nM, nN, nwg, G, c;
    __host__ __device__ void init(int M, int N, int G_, int c_) { nM = M / BM; nN = N / BM; nwg = nM * nN; G = G_; c = c_; }
    __host__ __device__ bool next(int i, Unit& u) const {
        const long L = (long)i * G + c; if (L >= nwg) return false;
        int wgid = (int)L; { const int q = nwg / NXCD, r = nwg % NXCD, xcd = wgid % NXCD, off = wgid / NXCD; wgid = (xcd < r ? xcd * (q + 1) : r * (q + 1) + (xcd - r) * q) + off; }
        const int nig = WGM * nN, gid = wgid / nig, fm = gid * WGM, gsz = (nM - fm) < WGM ? (nM - fm) : WGM;
        u.pm = fm + ((wgid % nig) % gsz); u.pn = (wgid % nig) / gsz; return true;
    }
    __device__ __forceinline__ void a_ready(const Unit&) const {}
    __device__ __forceinline__ void done(const Unit&) const {}
};


__device__ __forceinline__ unsigned cvt_pk_bf16(float lo, float hi) { unsigned r; asm volatile("v_cvt_pk_bf16_f32 %0, %1, %2" : "=v"(r) : "v"(lo), "v"(hi)); return r; }

template <int ACT> struct EpiBf16 {
    static constexpr bool PERM = true, AFTER_DRAIN = false;
    bf16_t* O0; int ld0; int nt0; bf16_t* O1; int ld1;
    __device__ __forceinline__ void operator()(const f32x4 (&acc)[2][2][4][2], const Unit& u, int wr, int wc, int fr, int fq) const {
        const int row0 = u.pm * BM + wr * 64 + fr;
        bf16_t* base; int ldc, colt;
        if (u.pn < nt0) { base = O0; ldc = ld0; colt = u.pn * BM; } else { base = O1; ldc = ld1; colt = (u.pn - nt0) * BM; }
        const int col0 = colt + wc * 32 + 8 * fq;
#pragma unroll
        for (int ai = 0; ai < 2; ++ai)
#pragma unroll
            for (int m = 0; m < 4; ++m) { bf16_t* rowp = base + (size_t)(row0 + ai * HALF + m * 16) * ldc + col0;
#pragma unroll
                for (int bj = 0; bj < 2; ++bj) { f32x4 v0 = acc[ai][bj][m][0], v1 = acc[ai][bj][m][1];
                    if (ACT == 2) {
#pragma unroll
                        for (int e = 0; e < 4; ++e) { float a = v0[e] > 0.f ? v0[e] : 0.f; v0[e] = a * a; float b = v1[e] > 0.f ? v1[e] : 0.f; v1[e] = b * b; } }
                    u32x4 w; w.x = cvt_pk_bf16(v0[0], v0[1]); w.y = cvt_pk_bf16(v0[2], v0[3]); w.z = cvt_pk_bf16(v1[0], v1[1]); w.w = cvt_pk_bf16(v1[2], v1[3]);
                    *(u32x4*)(rowp + bj * HALF) = w; } }
    }
    __device__ __forceinline__ void fused(f32x4 (&)[2][2][4][2], const Unit&, int, int, int, int, PG8_LAS unsigned char*, int, int) const {}
};


__device__ __forceinline__ float sig_f(float x) { return 1.0f / (1.0f + __expf(-x)); }
struct RkvOrder {
    int c;
    __device__ __forceinline__ bool next(int i, Unit& u) const {
        int L; if (c < 128) { if (i >= 2) return false; L = c * 2 + i; } else { if (i >= 4) return false; L = 256 + (c - 128) * 4 + i; }
        const int which = L >> 8, r = L & 255; u.pm = which * 64 + (r >> 2); u.pn = which * 4 + (r & 3); return true; }
    __device__ __forceinline__ void a_ready(const Unit&) const {}
    __device__ __forceinline__ void done(const Unit&) const {}
};
struct EpiRkv3 {
    static constexpr bool PERM = true, AFTER_DRAIN = false;
    bf16_t* RKV;
    __device__ __forceinline__ void operator()(const f32x4 (&acc)[2][2][4][2], const Unit& u, int wr, int wc, int fr, int fq) const {
        const int row0 = (u.pm & 63) * BM + wr * 64 + fr, col0 = u.pn * BM + wc * 32 + 8 * fq;
#pragma unroll
        for (int ai = 0; ai < 2; ++ai)
#pragma unroll
            for (int m = 0; m < 4; ++m) { bf16_t* rowp = RKV + (size_t)(row0 + ai * HALF + m * 16) * 3072 + col0;
#pragma unroll
                for (int bj = 0; bj < 2; ++bj) { const f32x4 v0 = acc[ai][bj][m][0], v1 = acc[ai][bj][m][1];
                    u32x4 w; w.x = cvt_pk_bf16(v0[0], v0[1]); w.y = cvt_pk_bf16(v0[2], v0[3]); w.z = cvt_pk_bf16(v1[0], v1[1]); w.w = cvt_pk_bf16(v1[2], v1[3]);
                    *(u32x4*)(rowp + bj * HALF) = w; } }
    }
};
struct EpiL1 {
    static constexpr bool PERM = true, AFTER_DRAIN = false;
    bf16_t* L1;
    __device__ __forceinline__ void operator()(const f32x4 (&acc)[2][2][4][2], const Unit& u, int wr, int wc, int fr, int fq) const {
        const int row0 = u.pm * BM + wr * 64 + fr, colt = u.pn * BM, col0 = colt + wc * 32 + 8 * fq;
#pragma unroll
        for (int ai = 0; ai < 2; ++ai)
#pragma unroll
            for (int m = 0; m < 4; ++m) { bf16_t* rowp = L1 + (size_t)(row0 + ai * HALF + m * 16) * 384 + col0;
#pragma unroll
                for (int bj = 0; bj < 2; ++bj) { f32x4 v0 = acc[ai][bj][m][0], v1 = acc[ai][bj][m][1];
                    const int cb = colt + bj * HALF;
                    if (cb >= 384) continue;
                    if (cb == 0) {
#pragma unroll
                        for (int e = 0; e < 4; ++e) { v0[e] = 1.0f - 2.0f / (1.0f + __expf(2.0f * v0[e])); v1[e] = 1.0f - 2.0f / (1.0f + __expf(2.0f * v1[e])); } }
                    else if (cb == 256) {
#pragma unroll
                        for (int e = 0; e < 4; ++e) { v0[e] = sig_f(v0[e]); v1[e] = sig_f(v1[e]); } }
                    u32x4 w; w.x = cvt_pk_bf16(v0[0], v0[1]); w.y = cvt_pk_bf16(v0[2], v0[3]); w.z = cvt_pk_bf16(v1[0], v1[1]); w.w = cvt_pk_bf16(v1[2], v1[3]);
                    *(u32x4*)(rowp + bj * HALF) = w; } }
    }
};
struct EpiLora2 {
    static constexpr bool PERM = true, AFTER_DRAIN = false;
    bf16_t* o4; size_t ostride; bf16_t* og; const float* a0; const float* w0;
    __device__ __forceinline__ void operator()(const f32x4 (&acc)[2][2][4][2], const Unit& u, int wr, int wc, int fr, int fq) const {
        const int row0 = u.pm * BM + wr * 64 + fr; const int blk = u.pn >> 2, colt = (u.pn & 3) * BM;
        bf16_t* base = (blk < 4) ? o4 + (size_t)blk * ostride : og;
        const float* bs = ((blk < 2) ? a0 : w0) + (blk & 1) * 1024;
        const int col0 = colt + wc * 32 + 8 * fq;
        const float sc = (blk >= 2) ? 0.8750387749719753f : 1.0f;
#pragma unroll
        for (int bj = 0; bj < 2; ++bj) {
            f32x4 b0 = (f32x4){0.f, 0.f, 0.f, 0.f}, b1 = b0;
            if (blk < 4) { b0 = *(const f32x4*)(bs + col0 + bj * HALF); b1 = *(const f32x4*)(bs + col0 + bj * HALF + 4); }
#pragma unroll
            for (int ai = 0; ai < 2; ++ai)
#pragma unroll
                for (int m = 0; m < 4; ++m) { bf16_t* rowp = base + (size_t)(row0 + ai * HALF + m * 16) * 1024 + col0;
                    f32x4 v0 = acc[ai][bj][m][0] + b0, v1 = acc[ai][bj][m][1] + b1;
                    if (blk < 4) {
#pragma unroll
                        for (int e = 0; e < 4; ++e) { v0[e] = sc * sig_f(v0[e]); v1[e] = sc * sig_f(v1[e]); } }
                    u32x4 w; w.x = cvt_pk_bf16(v0[0], v0[1]); w.y = cvt_pk_bf16(v0[2], v0[3]); w.z = cvt_pk_bf16(v1[0], v1[1]); w.w = cvt_pk_bf16(v1[2], v1[3]);
                    *(u32x4*)(rowp + bj * HALF) = w; } }
    }
};


template <class MP> struct EpiQkv {
    static constexpr bool PERM = true, AFTER_DRAIN = false;
    unsigned char* ws; float* out; const float* gain; const float* RC; const float* RS; int j;
    static constexpr size_t oQA = MP::oQA, oQB = MP::oQB, oKAP = MP::oKAP, oVAP = MP::oVAP, oKBP = MP::oKBP, oVBP = MP::oVBP, oKAS = MP::oKAS, oVAS = MP::oVAS, oKBS = MP::oKBS, oVBS = MP::oVBS;
    static constexpr size_t oKG = MP::oKG, oVG = MP::oVG, oKD = MP::oKD, oVD = MP::oVD;
    __device__ __forceinline__ void operator()(const f32x4 (&acc)[2][2][4][2], const Unit& u, int wr, int wc, int fr, int fq) const {
        const int ch = 4 * u.pn + wc; const bool smp = u.pm >= 32;
        const bool isq = (ch < 8) || (ch >= 12 && ch < 20), isk = (ch == 8 || ch == 9) || (ch >= 20 && ch < 28);
        const int dl = 8 * fq;
        const bool hi2 = (fq & 2) != 0;
        f32x4 g[2][2];
#pragma unroll
        for (int bj = 0; bj < 2; ++bj)
#pragma unroll
            for (int n = 0; n < 2; ++n) g[bj][n] = (ch < 10) ? *(const f32x4*)(gain + (ch < 8 ? 0 : 64) + bj * 32 + dl + 4 * n) : (f32x4){1.f, 1.f, 1.f, 1.f};
        constexpr float QS = 0.18033688011112042f;
#pragma unroll
        for (int ai = 0; ai < 2; ++ai)
#pragma unroll
            for (int m = 0; m < 4; ++m) {
                const int mrow = u.pm * BM + ai * HALF + wr * 64 + m * 16 + fr;
                const int b = smp ? ((mrow - 8192) >> 11) : (mrow >> 8), t = smp ? ((mrow - 8192) & 2047) : (mrow & 255);
                f32x4 v[2][2];
#pragma unroll
                for (int bj = 0; bj < 2; ++bj)
#pragma unroll
                    for (int n = 0; n < 2; ++n) v[bj][n] = acc[ai][bj][m][n];
                if (ch < 10) { float ss = 0.f;
#pragma unroll
                    for (int bj = 0; bj < 2; ++bj)
#pragma unroll
                        for (int n = 0; n < 2; ++n) ss += (v[bj][n][0] * v[bj][n][0] + v[bj][n][1] * v[bj][n][1]) + (v[bj][n][2] * v[bj][n][2] + v[bj][n][3] * v[bj][n][3]);
                    ss += __shfl_xor(ss, 16); ss += __shfl_xor(ss, 32);
                    const float ri = 1.0f / sqrtf(ss * (1.0f / 64.0f) + 1e-6f);
#pragma unroll
                    for (int bj = 0; bj < 2; ++bj)
#pragma unroll
                        for (int n = 0; n < 2; ++n) v[bj][n] = v[bj][n] * ri * g[bj][n]; }
                f32x4 vr[2][2];
#pragma unroll
                for (int bj = 0; bj < 2; ++bj)
#pragma unroll
                    for (int n = 0; n < 2; ++n) { vr[bj][n] = v[bj][n];
                        if (smp && (isq || isk)) { f32x4 p; p[0] = __shfl_xor(v[bj][n][0], 32); p[1] = __shfl_xor(v[bj][n][1], 32); p[2] = __shfl_xor(v[bj][n][2], 32); p[3] = __shfl_xor(v[bj][n][3], 32);
                            const f32x4 cs = *(const f32x4*)(RC + t * 64 + bj * 32 + dl + 4 * n), sn = *(const f32x4*)(RS + t * 64 + bj * 32 + dl + 4 * n);
                            const f32x4 rot = hi2 ? p : -p; vr[bj][n] = v[bj][n] * cs + rot * sn; } }
#define EQ_PK8(x0, x1) ((u32x4){cvt_pk_bf16((x0)[0], (x0)[1]), cvt_pk_bf16((x0)[2], (x0)[3]), cvt_pk_bf16((x1)[0], (x1)[1]), cvt_pk_bf16((x1)[2], (x1)[3])})
                const size_t srow = (size_t)(b * 2560 + 512 + t), prow = (size_t)((b * 2 + j) * 256 + t);
#pragma unroll
                for (int bj = 0; bj < 2; ++bj) {
                    const int f0 = bj * 32 + dl;
                    if (isq) { const f32x4 s0 = vr[bj][0] * QS, s1 = vr[bj][1] * QS; const size_t o = (ch < 8) ? oQA + ((size_t)mrow * 512 + ch * 64 + f0) * 2 : oQB + ((size_t)mrow * 512 + (ch - 12) * 64 + f0) * 2;
                        *(u32x4*)(ws + o) = EQ_PK8(s0, s1); }
                    else {
                        const bool gq = ch < 12, kk = isk;
                        const int e = gq ? ((ch & 1) * 64 + f0) : ((ch - (kk ? 20 : 28)) * 64 + f0); const int wdt = gq ? 128 : 512;
                        if (!smp) { const size_t of = (gq ? (kk ? oKG : oVG) : (kk ? oKD : oVD)) + prow * wdt + e; *(f32x4*)(out + of) = v[bj][0]; *(f32x4*)(out + of + 4) = v[bj][1];
                            const size_t o = (gq ? (kk ? oKAP : oVAP) : (kk ? oKBP : oVBP)) + ((size_t)mrow * wdt + e) * 2; *(u32x4*)(ws + o) = EQ_PK8(v[bj][0], v[bj][1]); }
                        else { const size_t o = (gq ? (kk ? oKAS : oVAS) : (kk ? oKBS : oVBS)) + (srow * wdt + e) * 2; *(u32x4*)(ws + o) = EQ_PK8(vr[bj][0], vr[bj][1]); } }
                }
#undef EQ_PK8
            }
    }
};

template <class Epi, class Sched, bool ALIGN_EPI = false, bool SP2 = false>
__device__ __forceinline__ void gemm_phase(PG8_LAS unsigned char* lds, const Gemm g, const Sched& S, const Epi& E, const int wave_index) {
    int lane_o; asm volatile("v_mbcnt_lo_u32_b32 %0, -1, 0\n\tv_mbcnt_hi_u32_b32 %0, -1, %0" : "=v"(lane_o));
    const int wid = wave_index, lane = lane_o, tid = wid * 64 + lane, wr = wid >> 2, wc = wid & 3, fr = lane & 15, fq = lane >> 4;
    const int K = g.K, nt = K / BK;
    unsigned voffA[2], voffB[2];
#pragma unroll
    for (int i = 0; i < 2; ++i) { int R, C; stage_rc(tid * 16 + i * 8192, R, C); const int Rb = Epi::PERM ? ((R & ~31) + perm32(R & 31)) : R;
        voffA[i] = (unsigned)(R * K + C) * 2u; voffB[i] = (unsigned)(Rb * K + C) * 2u; }
    const size_t kstep = (size_t)(BK * 2);
    const size_t hstep = (size_t)HALF * K * 2;
    const size_t tstep = 2 * hstep;
    const unsigned ldsw = (unsigned)wid * 1024u;
    const int aoff = lds_byte(wr * 64 + fr, fq * 8), boff = lds_byte(wc * 32 + fr, fq * 8);
#define PG8_SA(b, h) (((b) * 2 + (h)) * HTB)
#define PG8_SB(b, h) ((4 + (b) * 2 + (h)) * HTB)
#define PG8_STAGE(bufoff, gbase, voff) do { _Pragma("unroll") for (int _i = 0; _i < 2; ++_i) \
        __builtin_amdgcn_global_load_lds((const unsigned*)((const char*)(gbase) + (voff)[_i]), (PG8_LAS unsigned*)(lds + (bufoff) + ldsw + _i * 8192), 16, 0, 0); } while (0)
#define PG8_LDA(dst, b, h) do { _Pragma("unroll") for (int m = 0; m < 4; ++m) _Pragma("unroll") for (int k = 0; k < 2; ++k) dst[m][k] = *(const PG8_LAS bf16x8*)(lds + PG8_SA(b, h) + aoff + m * 2048 + k * 1024); } while (0)
#define PG8_LDB(dst, b, h) do { _Pragma("unroll") for (int n = 0; n < 2; ++n) _Pragma("unroll") for (int k = 0; k < 2; ++k) dst[n][k] = *(const PG8_LAS bf16x8*)(lds + PG8_SB(b, h) + boff + n * 2048 + k * 1024); } while (0)
#define PG8_MMA(ai, bj, At, Bt) do { __builtin_amdgcn_s_setprio(1); _Pragma("unroll") for (int m = 0; m < 4; ++m) _Pragma("unroll") for (int n = 0; n < 2; ++n) _Pragma("unroll") for (int k = 0; k < 2; ++k) \
        acc[ai][bj][m][n] = __builtin_amdgcn_mfma_f32_16x16x32_bf16(Bt[n][k], At[m][k], acc[ai][bj][m][n], 0, 0, 0); __builtin_amdgcn_s_setprio(0); } while (0)
#define PG8_WAIT_V(n) asm volatile("s_waitcnt vmcnt(" #n ")" ::: "memory")
#define PG8_WAIT_L(n) asm volatile("s_waitcnt lgkmcnt(" #n ")" ::: "memory")
#define PG8_BAR __builtin_amdgcn_s_barrier()
#define PG8_SCHED __builtin_amdgcn_sched_barrier(0)
    Unit cur, nxt; int ui = 0;
    if (!S.next(0, cur)) return;
    f32x4 acc[2][2][4][2];
#pragma unroll
    for (int a = 0; a < 2; ++a)
#pragma unroll
        for (int b = 0; b < 2; ++b)
#pragma unroll
            for (int m = 0; m < 4; ++m)
#pragma unroll
                for (int n = 0; n < 2; ++n) acc[a][b][m][n] = (f32x4){0.f, 0.f, 0.f, 0.f};
    bf16x8 At[4][2], B0[2][2], B1[2][2];
    const char* cA = (const char*)g.A + (size_t)cur.pm * tstep; const char* cB = (const char*)g.Bt + (size_t)cur.pn * tstep;
    S.a_ready(cur);
    if constexpr (SP2) {
        PG8_STAGE(PG8_SB(0, 0), cB, voffB); PG8_STAGE(PG8_SB(0, 1), cB + hstep, voffB); PG8_STAGE(PG8_SA(0, 0), cA, voffA); PG8_STAGE(PG8_SA(0, 1), cA + hstep, voffA);
        if (wr == 1) PG8_BAR;
        PG8_WAIT_V(2); PG8_BAR;
        PG8_STAGE(PG8_SB(1, 0), cB + kstep, voffB); PG8_STAGE(PG8_SA(1, 0), cA + kstep, voffA); PG8_STAGE(PG8_SB(1, 1), cB + hstep + kstep, voffB);
        PG8_WAIT_V(6); PG8_BAR;
    } else {
        PG8_STAGE(PG8_SB(0, 0), cB, voffB); PG8_STAGE(PG8_SA(0, 0), cA, voffA); PG8_STAGE(PG8_SB(0, 1), cB + hstep, voffB); PG8_STAGE(PG8_SA(0, 1), cA + hstep, voffA);
        if (wr == 1) PG8_BAR;
        PG8_WAIT_V(4); PG8_BAR;
        PG8_STAGE(PG8_SB(1, 0), cB + kstep, voffB); PG8_STAGE(PG8_SA(1, 0), cA + kstep, voffA); PG8_STAGE(PG8_SB(1, 1), cB + hstep + kstep, voffB);
        PG8_WAIT_V(6); PG8_BAR;
    }
    for (;;) {
        const bool has_next = S.next(ui + 1, nxt);
        const char* nA = has_next ? (const char*)g.A + (size_t)nxt.pm * tstep : cA; const char* nB = has_next ? (const char*)g.Bt + (size_t)nxt.pn * tstep : cB;
#pragma unroll 1
        for (int t = 0; t < nt; t += 2) {
            const bool last = (t == nt - 2);
            const char* a1 = cA + (size_t)(t + 1) * kstep;
            const char* a2 = last ? nA : cA + (size_t)(t + 2) * kstep; const char* b2 = last ? nB : cB + (size_t)(t + 2) * kstep;
            const char* a3 = a2 + kstep; const char* b3 = b2 + kstep;
            if (last && has_next) S.a_ready(nxt);
            if constexpr (SP2) {
            PG8_LDB(B0, 0, 0); PG8_LDB(B1, 0, 1); PG8_SCHED; PG8_LDA(At, 0, 0); PG8_STAGE(PG8_SA(1, 1), a1 + hstep, voffA);
            PG8_WAIT_V(8); PG8_WAIT_L(0); PG8_BAR; PG8_MMA(0, 0, At, B0); PG8_MMA(0, 1, At, B1); PG8_BAR; PG8_SCHED;
            PG8_LDA(At, 0, 1); PG8_STAGE(PG8_SB(0, 0), b2, voffB); PG8_STAGE(PG8_SB(0, 1), b2 + hstep, voffB); PG8_STAGE(PG8_SA(0, 0), a2, voffA);
            PG8_WAIT_V(8); PG8_WAIT_L(0); PG8_BAR; PG8_MMA(1, 0, At, B0); PG8_MMA(1, 1, At, B1); PG8_BAR; PG8_SCHED;
            PG8_LDB(B0, 1, 0); PG8_LDB(B1, 1, 1); PG8_SCHED; PG8_LDA(At, 1, 0); PG8_STAGE(PG8_SA(0, 1), a2 + hstep, voffA);
            PG8_WAIT_V(8); PG8_WAIT_L(0); PG8_BAR; PG8_MMA(0, 0, At, B0); PG8_MMA(0, 1, At, B1); PG8_BAR; PG8_SCHED;
            PG8_LDA(At, 1, 1); PG8_STAGE(PG8_SB(1, 0), b3, voffB); PG8_STAGE(PG8_SB(1, 1), b3 + hstep, voffB); PG8_STAGE(PG8_SA(1, 0), a3, voffA);
            PG8_WAIT_V(8); PG8_WAIT_L(0); PG8_BAR; PG8_MMA(1, 0, At, B0); PG8_MMA(1, 1, At, B1); PG8_BAR; PG8_SCHED;
            } else {
            PG8_LDB(B0, 0, 0); PG8_SCHED; PG8_LDA(At, 0, 0); PG8_STAGE(PG8_SA(1, 1), a1 + hstep, voffA);
            PG8_WAIT_L(8); PG8_BAR; PG8_WAIT_L(0); PG8_MMA(0, 0, At, B0); PG8_BAR; PG8_SCHED;
            PG8_LDB(B1, 0, 1); PG8_STAGE(PG8_SB(0, 0), b2, voffB);
            PG8_BAR; PG8_WAIT_L(0); PG8_MMA(0, 1, At, B1); PG8_BAR;
            PG8_LDA(At, 0, 1); PG8_STAGE(PG8_SA(0, 0), a2, voffA);
            PG8_BAR; PG8_WAIT_L(0); PG8_MMA(1, 0, At, B0); PG8_BAR; PG8_SCHED;
            PG8_STAGE(PG8_SB(0, 1), b2 + hstep, voffB);
            PG8_WAIT_V(6); PG8_BAR; PG8_MMA(1, 1, At, B1); PG8_BAR;
            PG8_LDB(B0, 1, 0); PG8_SCHED; PG8_LDA(At, 1, 0); PG8_STAGE(PG8_SA(0, 1), a2 + hstep, voffA);
            PG8_WAIT_L(8); PG8_BAR; PG8_WAIT_L(0); PG8_MMA(0, 0, At, B0); PG8_BAR; PG8_SCHED;
            PG8_LDB(B1, 1, 1); PG8_STAGE(PG8_SB(1, 0), b3, voffB);
            PG8_BAR; PG8_WAIT_L(0); PG8_MMA(0, 1, At, B1); PG8_BAR;
            PG8_LDA(At, 1, 1); PG8_STAGE(PG8_SA(1, 0), a3, voffA);
            PG8_BAR; PG8_WAIT_L(0); PG8_MMA(1, 0, At, B0); PG8_BAR; PG8_SCHED;
            PG8_STAGE(PG8_SB(1, 1), b3 + hstep, voffB);
            PG8_WAIT_V(6); PG8_BAR; PG8_MMA(1, 1, At, B1); PG8_BAR;
            }
        }
        if constexpr (ALIGN_EPI) { if (wr == 0) PG8_BAR; }
        if constexpr (!Epi::AFTER_DRAIN) { E(acc, cur, wr, wc, fr, fq); S.done(cur); }
        if (!has_next) break;
#pragma unroll
        for (int a = 0; a < 2; ++a)
#pragma unroll
            for (int b = 0; b < 2; ++b)
#pragma unroll
                for (int m = 0; m < 4; ++m)
#pragma unroll
                    for (int n = 0; n < 2; ++n) acc[a][b][m][n] = (f32x4){0.f, 0.f, 0.f, 0.f};
        cur = nxt; cA = nA; cB = nB; ++ui;
        if constexpr (ALIGN_EPI) { if (wr == 1) PG8_BAR; }
    }
    PG8_WAIT_V(0);
    if constexpr (!ALIGN_EPI) { if (wr == 0) PG8_BAR; }
    PG8_BAR;
    if constexpr (Epi::AFTER_DRAIN) { E.fused(acc, cur, wr, wc, fr, fq, lds, wid, lane); S.done(cur); }
#undef PG8_SA
#undef PG8_SB
#undef PG8_STAGE
#undef PG8_LDA
#undef PG8_LDB
#undef PG8_MMA
#undef PG8_WAIT_V
#undef PG8_WAIT_L
#undef PG8_BAR
#undef PG8_SCHED
}
}

#define GAS __attribute__((address_space(1)))
#define LAS __attribute__((address_space(3)))
typedef unsigned short bf16;
typedef unsigned v4u __attribute__((ext_vector_type(4)));
typedef unsigned v2u __attribute__((ext_vector_type(2)));
typedef float f32x4 __attribute__((ext_vector_type(4)));
#define LDS_WAIT() asm volatile("s_waitcnt lgkmcnt(0)" ::: "memory")

#ifndef MK_N_LAUNCHES
#define MK_N_LAUNCHES 1
#endif
#ifndef MK_CG_BARRIER
#define MK_CG_BARRIER 0
#endif

constexpr int D = 1024, NTOK = 16384, NPR = 8192, TP = 256, TS = 2048, PAST = 512, SKV = 2560, FF = 4096, DEPTH = 4;
constexpr int NQKV = 2304, NRKV = 3584, KRKV = 2048;
constexpr int NWAVES = 8;
constexpr size_t O_X = 0, O_KG = 16777216, O_VG = 18874368, O_KD = 20971520, O_VD = 29360128, O_ST = 37748736, OUT_TOTAL = 46137344;
constexpr size_t MiB = 1u << 20;
constexpr size_t WS_CTL = 0, CTL_ZERO_BYTES = 1 * MiB;
constexpr size_t WS_MOD = 65536;
constexpr size_t WS_ROPE = 1 * MiB;
constexpr size_t WS_INV = 2 * MiB;
constexpr size_t WS_W = 4 * MiB;
constexpr size_t W_W1T = WS_W, W_W2T = WS_W + 8 * MiB, W_MIX = WS_W + 16 * MiB;
constexpr size_t W_WINT = W_MIX, W_WOUTT = W_MIX + 6 * MiB;
constexpr size_t W_BTR = W_MIX, W_BTL = W_MIX + 6 * MiB, W_WOT = W_MIX + 14 * MiB, W_BT2 = W_MIX + 16 * MiB;
constexpr size_t AR = 40 * MiB;
constexpr size_t A_H = AR;
constexpr size_t A_QKVRAW = AR + 32 * MiB;
constexpr size_t A_DT = AR + 32 * MiB;
constexpr size_t A_M = AR + 96 * MiB;
constexpr size_t A_QA = AR + 176 * MiB, A_QB = AR + 192 * MiB, A_KAP = AR + 208 * MiB, A_VAP = AR + 210 * MiB, A_KBP = AR + 212 * MiB, A_VBP = AR + 220 * MiB;
constexpr size_t A_KAS = AR + 228 * MiB, A_VAS = AR + 231 * MiB, A_KBS = AR + 234 * MiB, A_VBS = AR + 244 * MiB;
constexpr size_t A_HID = AR + 32 * MiB;
constexpr size_t A_F = AR + 160 * MiB;
constexpr size_t A_A2 = AR + 32 * MiB;
constexpr size_t A_XS = AR + 208 * MiB;
constexpr size_t A_Y = AR + 32 * MiB;
constexpr size_t A_RKV = AR + 96 * MiB;
constexpr size_t A_L1 = AR + 192 * MiB;
constexpr size_t A_G = A_H;
constexpr size_t A_A0 = AR + 208 * MiB, A_A1 = AR + 240 * MiB, A_EW0 = AR + 272 * MiB, A_EW1 = AR + 304 * MiB;
constexpr size_t WS_END = AR + 336 * MiB;
struct QkvMap { static constexpr size_t oQA = A_QA, oQB = A_QB, oKAP = A_KAP, oVAP = A_VAP, oKBP = A_KBP, oVBP = A_VBP, oKAS = A_KAS, oVAS = A_VAS, oKBS = A_KBS, oVBS = A_VBS, oKG = O_KG, oVG = O_VG, oKD = O_KD, oVD = O_VD; };
constexpr int CW_BAR = 4096;

constexpr int RING_OFF = 0, RING_BYTES = 131072;
constexpr int LDSCTL_OFF = RING_BYTES, MISC_OFF = LDSCTL_OFF + 320;
constexpr int LDS_BYTES = 147456;

typedef float f32x2_t __attribute__((ext_vector_type(2))); typedef __bf16 bf16x2_t __attribute__((ext_vector_type(2)));
__device__ __forceinline__ unsigned pk2(float lo, float hi) { const f32x2_t v = {lo, hi}; return __builtin_bit_cast(unsigned, __builtin_convertvector(v, bf16x2_t)); }
__device__ __forceinline__ unsigned f2bf(float f) { return pk2(f, 0.f) & 0xffffu; }
__device__ __forceinline__ float bf2f(unsigned short h) { return __builtin_bit_cast(float, (unsigned)h << 16); }
__device__ __forceinline__ float bflo(unsigned w) { return __builtin_bit_cast(float, w << 16); }
__device__ __forceinline__ float bfhi(unsigned w) { return __builtin_bit_cast(float, w & 0xffff0000u); }
__device__ __forceinline__ float sigmoidf_(float x) { return 1.0f / (1.0f + __expf(-x)); }
__device__ __forceinline__ float rdl(float x, int l) { return __builtin_bit_cast(float, __builtin_amdgcn_readlane(__builtin_bit_cast(int, x), l)); }
__device__ __forceinline__ float wave_sum(float v) {
    asm("s_nop 1\n\tv_add_f32_dpp %0, %0, %0 row_ror:8 row_mask:0xf bank_mask:0xf\n\ts_nop 1\n\tv_add_f32_dpp %0, %0, %0 row_ror:4 row_mask:0xf bank_mask:0xf\n\ts_nop 1\n\t"
        "v_add_f32_dpp %0, %0, %0 row_ror:2 row_mask:0xf bank_mask:0xf\n\ts_nop 1\n\tv_add_f32_dpp %0, %0, %0 row_ror:1 row_mask:0xf bank_mask:0xf\n\ts_nop 1" : "+v"(v));
    return (rdl(v, 0) + rdl(v, 16)) + (rdl(v, 32) + rdl(v, 48));
}

#define XB_TMO      128
#define XB_XCNT(j)  (256  + 64 * (j))
#define XB_XSUB(j)  (1280 + 64 * (j))
#define XB_XGEN(j)  (2304 + 64 * (j))
#define XB_TOP      3328
#define XB_TOPGEN   3392
#define XCD_BAR_WORDS 3456
#define XB_SPIN_CAP (1u << 18)

__device__ __forceinline__ unsigned xb_ld(unsigned* p)              { return __hip_atomic_load(p, __ATOMIC_RELAXED, __HIP_MEMORY_SCOPE_AGENT); }
__device__ __forceinline__ unsigned xb_add(unsigned* p, unsigned v) { return __hip_atomic_fetch_add(p, v, __ATOMIC_RELAXED, __HIP_MEMORY_SCOPE_AGENT); }
__device__ __forceinline__ unsigned xb_xcc_id() { return (unsigned)__builtin_amdgcn_s_getreg((3 << 11) | 20) & 0xFu; }
#define XB_SPIN(cond, bar) do { unsigned _sp = 0; while (cond) { __builtin_amdgcn_s_sleep(1); \
    if ((++_sp & 255u) == 0u) { if (xb_ld(&(bar)[XB_TMO])) break; if (_sp > XB_SPIN_CAP) { atomicAdd(&(bar)[XB_TMO], 1u); break; } } } } while (0)

struct XcdBarrier {
    unsigned* bar; unsigned x;
    volatile LAS unsigned* st;
};

__device__ __forceinline__ XcdBarrier xcd_barrier_post(unsigned* bar, volatile LAS unsigned* st, bool leader) {
    XcdBarrier b; b.bar = bar; b.x = xb_xcc_id(); b.st = st;
    if (leader) (void)xb_add(&bar[XB_XCNT(b.x)], 1u);
    return b;
}
__device__ __forceinline__ void xcd_barrier_complete(unsigned* bar, unsigned x, unsigned& nloc, unsigned& nx) {
    const unsigned G = gridDim.x * gridDim.y * gridDim.z;
    unsigned sum, cnt, mine, sp = 0u;
    for (;;) {
        sum = 0u; cnt = 0u; mine = 0u;
#pragma unroll
        for (unsigned j = 0; j < 16; ++j) { const unsigned c = xb_ld(&bar[XB_XCNT(j)]); sum += c; cnt += (c > 0u) ? 1u : 0u; mine = (j == x) ? c : mine; }
        if (sum == G) break;
        __builtin_amdgcn_s_sleep(1);
        if ((++sp & 255u) == 0u) { if (xb_ld(&bar[XB_TMO])) break; if (sp > XB_SPIN_CAP) { atomicAdd(&bar[XB_TMO], 1u); break; } }
    }
    nloc = mine > 0u ? mine : 1u; nx = cnt > 0u ? cnt : 1u;
}

__device__ __forceinline__ void xcd_barrier(const XcdBarrier& b, bool leader) {
    asm volatile("s_waitcnt vmcnt(0)" ::: "memory");
    __syncthreads();
    if (leader) {
        unsigned* bar = b.bar;
        __builtin_amdgcn_s_waitcnt(0);
        unsigned nloc = b.st[0], nx = b.st[1];
        if (nloc == 0u) { xcd_barrier_complete(bar, b.x, nloc, nx); b.st[0] = nloc; b.st[1] = nx; }
        const unsigned old = xb_add(&bar[XB_XSUB(b.x)], 1u);
        const unsigned gen = old / nloc;
        if (old + 1u == (gen + 1u) * nloc) {
            __builtin_amdgcn_fence(__ATOMIC_RELEASE, "agent");
            asm volatile("s_waitcnt vmcnt(0)" ::: "memory");
            const unsigned og = xb_add(&bar[XB_TOP], 1u);
            const unsigned tg = og / nx;
            if (og + 1u == (tg + 1u) * nx) xb_add(&bar[XB_TOPGEN], 1u);
            else XB_SPIN(xb_ld(&bar[XB_TOPGEN]) == tg, bar);
            __builtin_amdgcn_fence(__ATOMIC_ACQUIRE, "agent");
            xb_add(&bar[XB_XGEN(b.x)], 1u);
            asm volatile("s_waitcnt vmcnt(0)" ::: "memory");
        } else {
            XB_SPIN(xb_ld(&bar[XB_XGEN(b.x)]) == gen, bar);
            __builtin_amdgcn_fence(__ATOMIC_ACQUIRE, "agent");
            asm volatile("s_waitcnt vmcnt(0)" ::: "memory");
        }
    }
    __syncthreads();
}

struct Args { const float* in[32]; float* out; unsigned char* ws; int ph_lo, ph_hi; };
struct Ids { int tid, lane, wave, gw, ngw, z; };

__device__ __forceinline__ int cond_of(int m) { return m < NPR ? 4 : ((m - NPR) >> 11); }
__device__ __forceinline__ const float* mod_ptr_(const Args& a, const Ids& id, int cond, int layer) { return (const float*)(a.ws + id.z + WS_MOD) + (size_t)(cond * 4 + layer) * 6144; }

__device__ __forceinline__ void tr_item(const float* W, int ldw, int col0, const float* scale, bf16* WT, int ldt, int drow0, int dcol0, LAS float* scr, int kb, int nb, int lane, int dnb = -1) {
    const int k0 = 64 * kb, n0 = 32 * nb, dn0 = 32 * (dnb < 0 ? nb : dnb);
#pragma unroll 8
    for (int i = 0; i < 32; ++i) { const int kk = 2 * i + (lane >> 5); float v = W[(size_t)(k0 + kk) * ldw + col0 + n0 + (lane & 31)]; if (scale) v *= scale[k0 + kk]; scr[kk * 33 + (lane & 31)] = v; }
    LDS_WAIT(); asm volatile("" ::: "memory");
    const int c = lane & 7;
#pragma unroll
    for (int j = 0; j < 4; ++j) { const int n = (lane >> 3) + 8 * j; const LAS float* s = scr + (8 * c) * 33 + n;
        v4u o; o.x = pk2(s[0 * 33], s[1 * 33]); o.y = pk2(s[2 * 33], s[3 * 33]); o.z = pk2(s[4 * 33], s[5 * 33]); o.w = pk2(s[6 * 33], s[7 * 33]);
        *(v4u*)(WT + (size_t)(drow0 + dn0 + n) * ldt + dcol0 + k0 + 8 * c) = o; }
    LDS_WAIT(); asm volatile("" ::: "memory");
}
__device__ __forceinline__ bool tr_matrix(int& r, const float* W, int K, int N, bf16* WT, LAS float* scr, int lane) {
    const int nblk = N / 32, items = (K / 64) * nblk;
    if (r < items) { tr_item(W, N, 0, nullptr, WT, K, 0, 0, scr, r / nblk, r % nblk, lane); return true; }
    r -= items; return false;
}
__device__ __forceinline__ bool tr_rwproj(int& r, const float* W, int ncols, const float* mu, bf16* BT1, int drow0, LAS float* scr, int lane) {
    const int nblk = ncols / 32, items = 16 * nblk * 2;
    if (r < items) { const int half = r / (16 * nblk), q = r % (16 * nblk); tr_item(W, ncols, 0, half ? mu : nullptr, BT1, KRKV, drow0, half * 1024, scr, q / nblk, q % nblk, lane); return true; }
    r -= items; return false;
}
__device__ __forceinline__ void conv_weights(const Args& a, const Ids& id, LAS unsigned char* lds, int layer, int parts = 3) {
    LAS float* scr = (LAS float*)(lds + id.wave * 16384);
    const int j = layer >> 1;
    bf16* W1T = (bf16*)(a.ws + id.z + W_W1T); bf16* W2T = (bf16*)(a.ws + id.z + W_W2T);
    const float* mw1 = a.in[30 + id.z] + (size_t)layer * D * FF; const float* mw2 = a.in[31 + id.z] + (size_t)layer * D * FF;
    if ((layer & 1) == 0) {
        bf16* WINT = (bf16*)(a.ws + id.z + W_WINT); bf16* WOUTT = (bf16*)(a.ws + id.z + W_WOUTT);
        const float* win = a.in[12 + id.z] + (size_t)j * D * NQKV; const float* wout = a.in[13 + id.z] + (size_t)j * D * D;
        const int lo = (parts & 2) ? 0 : 4096, hi = (parts & 1) ? 2048 + 2048 + 1152 + 512 : 4096;
        for (int it = lo + id.gw; it < hi; it += id.ngw) {
            int r = it;
            if (tr_matrix(r, mw1, D, FF, W1T, scr, id.lane)) continue;
            if (tr_matrix(r, mw2, FF, D, W2T, scr, id.lane)) continue;
            if (r < 1152) {
                const int kb = r / 72, nb = r % 72; tr_item(win, NQKV, 0, nullptr, WINT, D, 0, 0, scr, kb, nb, id.lane, (nb & ~7) + 4 * (nb & 1) + ((nb >> 1) & 3)); continue; }
            r -= 1152;
            tr_matrix(r, wout, D, D, WOUTT, scr, id.lane);
        }
    } else {
        bf16* BTR = (bf16*)(a.ws + id.z + W_BTR); bf16* BT1 = (bf16*)(a.ws + id.z + W_BTL); bf16* WOT = (bf16*)(a.ws + id.z + W_WOT);
        const float* mu = a.in[17 + id.z] + (size_t)j * 6 * D;
        const float* wrkv = a.in[18 + id.z] + (size_t)j * 3 * D * D;
        const float* w1 = a.in[21 + id.z] + (size_t)j * 2 * D * 64; const float* a1 = a.in[24 + id.z] + (size_t)j * 2 * D * 64; const float* g1 = a.in[26 + id.z] + (size_t)j * D * 128;
        const float* wo = a.in[19 + id.z] + (size_t)j * D * D;
        bf16* BT2 = (bf16*)(a.ws + id.z + W_BT2); const float* w2 = a.in[22 + id.z] + (size_t)j * 2 * 64 * D; const float* a2 = a.in[25 + id.z] + (size_t)j * 2 * 64 * D; const float* g2 = a.in[27 + id.z] + (size_t)j * 128 * D;
        const int total = 2048 + 2048 + 1536 + 256 + 128 + 512 + 128 + 4 * 32 + 64 + 5120;
        for (int it = id.gw; it < total; it += id.ngw) {
            int r = it;
            if (tr_matrix(r, mw1, D, FF, W1T, scr, id.lane)) continue;
            if (tr_matrix(r, mw2, FF, D, W2T, scr, id.lane)) continue;
            if (tr_matrix(r, wrkv, D, D, BTR, scr, id.lane)) continue;
            if (tr_matrix(r, wrkv + (size_t)D * D, D, D, BTR + (size_t)D * D, scr, id.lane)) continue;
            if (tr_matrix(r, wrkv + (size_t)2 * D * D, D, D, BTR + (size_t)2 * D * D, scr, id.lane)) continue;
            if (tr_rwproj(r, w1, 64, mu + 1 * D, BT1, 0, scr, id.lane)) continue;
            if (tr_rwproj(r, w1 + (size_t)D * 64, 64, mu + 1 * D, BT1, 64, scr, id.lane)) continue;
            if (tr_rwproj(r, a1, 64, mu + 4 * D, BT1, 128, scr, id.lane)) continue;
            if (tr_rwproj(r, a1 + (size_t)D * 64, 64, mu + 4 * D, BT1, 192, scr, id.lane)) continue;
            if (tr_rwproj(r, g1, 128, mu + 5 * D, BT1, 256, scr, id.lane)) continue;
            if (tr_matrix(r, wo, D, D, WOT, scr, id.lane)) continue;
            if (r < 128) {
                v4u z = (v4u){0u, 0u, 0u, 0u}; v4u* p = (v4u*)(BT1 + (size_t)(384 + r) * KRKV);
#pragma unroll
                for (int q = 0; q < 4; ++q) p[id.lane + 64 * q] = z;
                continue; }
            r -= 128;
            if (r < 128) { const int i = r >> 5, q = r & 31; const float* W = (i < 2 ? a2 : w2) + (size_t)(i & 1) * 64 * D; tr_item(W, D, 0, nullptr, BT2, 384, 1024 * i, 64 * (i ^ 2), scr, 0, q, id.lane); continue; }
            r -= 128;
            if (r < 64) { tr_item(g2, D, 0, nullptr, BT2, 384, 4096, 256, scr, r >> 5, r & 31, id.lane); continue; }
            r -= 64;
            { const int blk = r >> 10; const int c0 = (blk < 4) ? 8 * (blk ^ 2) : 32, c1 = (blk < 4) ? 8 * (blk ^ 2) + 8 : 48;
              if (id.lane < 48 && (id.lane < c0 || id.lane >= c1)) *(v4u*)(BT2 + (size_t)r * 384 + 8 * id.lane) = (v4u){0u, 0u, 0u, 0u}; }
        }
    }
}

struct RowV { f32x4 v[4]; };
__device__ __forceinline__ void ld_row(RowV& r, const float* p, int lane) {
#pragma unroll
    for (int j = 0; j < 4; ++j) r.v[j] = ((const f32x4*)p)[lane + 64 * j];
}
__device__ __forceinline__ void ld_row_bf16(RowV& r, const bf16* p, int lane) {
#pragma unroll
    for (int j = 0; j < 4; ++j) { const v2u w = ((const v2u*)p)[lane + 64 * j]; r.v[j] = (f32x4){bflo(w.x), bfhi(w.x), bflo(w.y), bfhi(w.y)}; }
}
__device__ __forceinline__ void st_row(const RowV& r, float* p, int lane) {
#pragma unroll
    for (int j = 0; j < 4; ++j) ((f32x4*)p)[lane + 64 * j] = r.v[j];
}
__device__ __forceinline__ void st_row_bf16(const RowV& r, bf16* p, int lane) {
#pragma unroll
    for (int j = 0; j < 4; ++j) { v2u w; w.x = pk2(r.v[j][0], r.v[j][1]); w.y = pk2(r.v[j][2], r.v[j][3]); ((v2u*)p)[lane + 64 * j] = w; }
}
__device__ __forceinline__ float row_rinv(const RowV& r) {
    float s = 0.f;
#pragma unroll
    for (int j = 0; j < 4; ++j) s += (r.v[j][0] * r.v[j][0] + r.v[j][1] * r.v[j][1]) + (r.v[j][2] * r.v[j][2] + r.v[j][3] * r.v[j][3]);
    s = wave_sum(s);
    return 1.0f / sqrtf(s * (1.0f / 1024.0f) + 1e-6f);
}
__device__ __forceinline__ void norm_mod(RowV& h, const RowV& x, const float* g, const float* sc, const float* sh, int lane) {
    const float ri = row_rinv(x);
#pragma unroll
    for (int j = 0; j < 4; ++j) { const f32x4 gv = ((const f32x4*)g)[lane + 64 * j], scv = ((const f32x4*)sc)[lane + 64 * j], shv = ((const f32x4*)sh)[lane + 64 * j];
        h.v[j] = (x.v[j] * ri) * gv * (scv + 1.0f) + shv; }
}
__device__ __forceinline__ void resid_add(RowV& x, const RowV& m, const float* g, const float* gt, int lane) {
    const float ri = row_rinv(m);
#pragma unroll
    for (int j = 0; j < 4; ++j) { const f32x4 gv = ((const f32x4*)g)[lane + 64 * j], gtv = ((const f32x4*)gt)[lane + 64 * j];
        x.v[j] = x.v[j] + gtv * ((m.v[j] * ri) * gv); }
}

__device__ __forceinline__ float rope_inv(int jj) {
    const float t[16] = {1.0f, 0.5623413324356079f, 0.3162277638912201f, 0.17782793939113617f, 0.10000000149011612f, 0.05623412877321243f, 0.03162277862429619f, 0.017782794311642647f,
                         0.009999999776482582f, 0.005623413249850273f, 0.003162277862429619f, 0.0017782794311642647f, 0.0010000000474974513f, 0.000562341301701963f, 0.0003162277862429619f, 0.00017782794020604342f};
    float r = t[0];
#pragma unroll
    for (int i = 1; i < 16; ++i) r = (jj == i) ? t[i] : r;
    return r;
}
__device__ __forceinline__ void ph_prologue(const Args& a, const Ids& id, LAS unsigned char* lds) {
    float* MOD = (float*)(a.ws + id.z + WS_MOD);
    { LAS float* red = (LAS float*)lds;
      for (int it = blockIdx.x; it < 4 * 96; it += gridDim.x) {
        const int i = it / 96, n = (it % 96) * 64 + id.lane;
        float acc[5];
#pragma unroll
        for (int c = 0; c < 5; ++c) acc[c] = 0.f;
        const float* W = a.in[9 + id.z] + (size_t)i * 1024 * 6144 + n;
#pragma unroll 1
        for (int k0 = 128 * id.wave; k0 < 128 * id.wave + 128; k0 += 64) {
            float sv[5];
#pragma unroll
            for (int c = 0; c < 5; ++c) { const float x = (c < 4) ? a.in[2 + id.z][c * 1024 + k0 + id.lane] : a.in[8 + id.z][k0 + id.lane]; sv[c] = x / (1.0f + __expf(-x)); }
#pragma unroll 16
            for (int kk = 0; kk < 64; ++kk) { const float w = W[(size_t)(k0 + kk) * 6144];
#pragma unroll
                for (int c = 0; c < 5; ++c) acc[c] += w * __shfl(sv[c], kk); }
        }
#pragma unroll
        for (int c = 0; c < 5; ++c) red[(id.wave * 5 + c) * 64 + id.lane] = acc[c];
        __syncthreads();
        if (id.wave < 5) { float s = a.in[10 + id.z][i * 6144 + n];
#pragma unroll
            for (int w8 = 0; w8 < 8; ++w8) s += red[(w8 * 5 + id.wave) * 64 + id.lane];
            MOD[(size_t)(id.wave * 4 + i) * 6144 + n] = s; }
        __syncthreads();
      } }
    { float* RC = (float*)(a.ws + id.z + WS_ROPE); float* RS = RC + 2048 * 64;
      for (int e = id.gw * 64 + id.lane; e < 2048 * 64; e += id.ngw * 64) { const int t = e >> 6, d = e & 63; const int pos = (d < 32) ? (t >> 6) : (t & 63);
          const float ang = (float)pos * rope_inv(d & 15); RC[e] = __cosf(ang); RS[e] = __sinf(ang); } }
    conv_weights(a, id, lds, 0, 1);
}

struct RawBf { v2u v[4]; };
__device__ __forceinline__ void ld_raw_bf(RawBf& r, const bf16* p, int lane) {
#pragma unroll
    for (int j = 0; j < 4; ++j) r.v[j] = ((const v2u*)p)[lane + 64 * j];
}
__device__ __forceinline__ void cvt_raw_bf(RowV& o, const RawBf& r) {
#pragma unroll
    for (int j = 0; j < 4; ++j) o.v[j] = (f32x4){bflo(r.v[j].x), bfhi(r.v[j].x), bflo(r.v[j].y), bfhi(r.v[j].y)};
}
__device__ __forceinline__ const float* x_row_ptr(const Args& a, const Ids& id, int layer, int m) {
    return (layer == 0) ? ((m < NPR) ? a.in[0 + id.z] + (size_t)m * D : a.in[1 + id.z] + (size_t)(m - NPR) * D) : a.out + id.z + O_X + (size_t)m * D;
}
__device__ __forceinline__ void ph_norm0(const Args& a, const Ids& id) {
    bf16* H = (bf16*)(a.ws + id.z + A_H); const float* g0 = a.in[11 + id.z] + (size_t)(0 * 4 + 0) * D;
    int m = id.gw; RowV xn; if (m < NTOK) ld_row(xn, x_row_ptr(a, id, 0, m), id.lane);
    for (; m < NTOK; m += id.ngw) { RowV x = xn, h; if (m + id.ngw < NTOK) ld_row(xn, x_row_ptr(a, id, 0, m + id.ngw), id.lane);
        const float* md = mod_ptr_(a, id, cond_of(m), 0);
        norm_mod(h, x, g0, md + 1024, md + 0, id.lane); st_row_bf16(h, H + (size_t)m * D, id.lane); }
}
__device__ __forceinline__ void ph_resid_norm(const Args& a, const Ids& id, int layer, bool dummy = false) {
    bf16* H = (bf16*)(a.ws + id.z + (dummy ? AR + 224 * MiB : A_H)); float* xout = dummy ? (float*)(a.ws + id.z + A_F) : a.out + id.z + O_X; const bf16* M = (const bf16*)(a.ws + id.z + A_M); const float* g1 = a.in[11 + id.z] + (size_t)(layer * 4 + 1) * D; const float* g2 = a.in[11 + id.z] + (size_t)(layer * 4 + 2) * D;
    int m = id.gw; RowV xn; RawBf xbn, mn;
    if (m < NTOK) { if (layer == 0) ld_row(xn, x_row_ptr(a, id, 0, m), id.lane); else ld_raw_bf(xbn, (const bf16*)(a.out + id.z + O_X + (size_t)m * D) + ((layer & 1) ? 1024 : 0), id.lane); ld_raw_bf(mn, M + (size_t)m * D, id.lane); }
    for (; m < NTOK; m += id.ngw) { RowV x, mm, h; if (layer == 0) x = xn; else cvt_raw_bf(x, xbn); cvt_raw_bf(mm, mn);
        if (m + id.ngw < NTOK) { if (layer == 0) ld_row(xn, x_row_ptr(a, id, 0, m + id.ngw), id.lane); else ld_raw_bf(xbn, (const bf16*)(a.out + id.z + O_X + (size_t)(m + id.ngw) * D) + ((layer & 1) ? 1024 : 0), id.lane);
                                 ld_raw_bf(mn, M + (size_t)(m + id.ngw) * D, id.lane); }
        const float* md = mod_ptr_(a, id, cond_of(m), layer);
        resid_add(x, mm, g1, md + 2048, id.lane); st_row_bf16(x, (bf16*)(xout + (size_t)m * D), id.lane);
        norm_mod(h, x, g2, md + 4096, md + 3072, id.lane); st_row_bf16(h, H + (size_t)m * D, id.lane); }
}
__device__ __forceinline__ void ph_resid_end(const Args& a, const Ids& id, LAS unsigned char* lds, int layer, bool dummy = false) {
    bf16* H = (bf16*)(a.ws + id.z + (dummy ? AR + 96 * MiB : A_H)); float* xout = dummy ? (float*)(a.ws + id.z + AR + 32 * MiB) : a.out + id.z + O_X; const bf16* F = (const bf16*)(a.ws + id.z + A_F); const float* g3 = a.in[11 + id.z] + (size_t)(layer * 4 + 3) * D;
    const bool next_attn = (layer + 1 < DEPTH) && (((layer + 1) & 1) == 0);
    const float* g0n = a.in[11 + id.z] + (size_t)((layer + 1) * 4 + 0) * D;
    int m = id.gw; RawBf xbn, fn; if (m < NTOK) { ld_raw_bf(xbn, (const bf16*)(a.out + id.z + O_X + (size_t)m * D), id.lane); ld_raw_bf(fn, F + (size_t)m * D, id.lane); }
    for (; m < NTOK; m += id.ngw) { RowV x, ff; cvt_raw_bf(x, xbn); cvt_raw_bf(ff, fn);
        if (m + id.ngw < NTOK) { ld_raw_bf(xbn, (const bf16*)(a.out + id.z + O_X + (size_t)(m + id.ngw) * D), id.lane); ld_raw_bf(fn, F + (size_t)(m + id.ngw) * D, id.lane); }
        const float* md = mod_ptr_(a, id, cond_of(m), layer);
        resid_add(x, ff, g3, md + 5120, id.lane);
        if (layer + 1 == DEPTH) st_row(x, xout + (size_t)m * D, id.lane); else st_row_bf16(x, (bf16*)(xout + (size_t)m * D), id.lane);
        if (next_attn) { RowV h; const float* mdn = mod_ptr_(a, id, cond_of(m), layer + 1); norm_mod(h, x, g0n, mdn + 1024, mdn + 0, id.lane); st_row_bf16(h, H + (size_t)m * D, id.lane); } }
    if (layer + 1 < DEPTH) conv_weights(a, id, lds, layer + 1, next_attn ? 1 : 3);
}
__device__ __forceinline__ void ph_rw_mix(const Args& a, const Ids& id, int layer) {
    bf16* A2 = (bf16*)(a.ws + id.z + A_A2); bf16* XS = (bf16*)(a.ws + id.z + A_XS); const float* g0 = a.in[11 + id.z] + (size_t)(layer * 4 + 0) * D; const float* mu6 = a.in[17 + id.z] + (size_t)(layer >> 1) * 6 * D;
    for (int g8 = id.gw; g8 < NTOK / 8; g8 += id.ngw) {
        const int m0 = g8 * 8; const int t0 = (m0 < NPR) ? (m0 & (TP - 1)) : ((m0 - NPR) & (TS - 1)); const int T = (m0 < NPR) ? TP : TS;
        const float* md = mod_ptr_(a, id, cond_of(m0), layer); const float* xp = a.out + id.z + O_X + (size_t)m0 * D;
        RowV hp, hc, hn, xr;
#pragma unroll
        for (int q = 0; q < 4; ++q) hp.v[q] = (f32x4){0.f, 0.f, 0.f, 0.f};
        if (t0 > 0) { ld_row_bf16(xr, (const bf16*)(xp - D), id.lane); norm_mod(hp, xr, g0, md + 1024, md + 0, id.lane); }
        ld_row_bf16(xr, (const bf16*)xp, id.lane); norm_mod(hc, xr, g0, md + 1024, md + 0, id.lane);
        RawBf nx; if (t0 + 1 < T) ld_raw_bf(nx, (const bf16*)(xp + D), id.lane);
#pragma unroll 1
        for (int i = 0; i < 8; ++i) {
#pragma unroll
            for (int q = 0; q < 4; ++q) hn.v[q] = (f32x4){0.f, 0.f, 0.f, 0.f};
            const RawBf cu = nx; if (i + 2 <= 8 && t0 + i + 2 < T) ld_raw_bf(nx, (const bf16*)(xp + (size_t)(i + 2) * D), id.lane);
            if (t0 + i + 1 < T) { cvt_raw_bf(xr, cu); norm_mod(hn, xr, g0, md + 1024, md + 0, id.lane); }
            RowV xx;
#pragma unroll
            for (int q = 0; q < 4; ++q) xx.v[q] = (hp.v[q] + hn.v[q]) * 0.5f - hc.v[q];
            st_row_bf16(hc, A2 + (size_t)(m0 + i) * KRKV, id.lane); st_row_bf16(xx, A2 + (size_t)(m0 + i) * KRKV + D, id.lane);
#pragma unroll
            for (int p = 0; p < 3; ++p) { const float* mu = mu6 + (size_t)(p == 0 ? 0 : p + 1) * D; RowV xm;
#pragma unroll
                for (int q = 0; q < 4; ++q) xm.v[q] = hc.v[q] + xx.v[q] * ((const f32x4*)mu)[id.lane + 64 * q];
                st_row_bf16(xm, XS + ((size_t)p * NTOK + m0 + i) * D, id.lane); }
            hp = hc; hc = hn;
        }
    }
}

__device__ __forceinline__ void ph_rend_mix(const Args& a, const Ids& id, LAS unsigned char* lds, int layer) {
    const int nl = layer + 1;
    bf16* A2 = (bf16*)(a.ws + id.z + A_A2); bf16* XS = (bf16*)(a.ws + id.z + A_XS); const bf16* F = (const bf16*)(a.ws + id.z + A_F);
    const float* g3 = a.in[11 + id.z] + (size_t)(layer * 4 + 3) * D; const float* g0 = a.in[11 + id.z] + (size_t)(nl * 4 + 0) * D; const float* mu6 = a.in[17 + id.z] + (size_t)(nl >> 1) * 6 * D;
    for (int g8 = id.gw; g8 < NTOK / 8; g8 += id.ngw) {
        const int m0 = g8 * 8; const int t0 = (m0 < NPR) ? (m0 & (TP - 1)) : ((m0 - NPR) & (TS - 1)); const int T = (m0 < NPR) ? TP : TS;
        const float* mdp = mod_ptr_(a, id, cond_of(m0), layer); const float* md = mod_ptr_(a, id, cond_of(m0), nl);
        float* xp = a.out + id.z + O_X + (size_t)m0 * D; const bf16* fp = F + (size_t)m0 * D;
        RowV hp, hc, hn, xr, fr; RawBf nx, nf;
#pragma unroll
        for (int q = 0; q < 4; ++q) hp.v[q] = (f32x4){0.f, 0.f, 0.f, 0.f};
        if (t0 > 0) { ld_row_bf16(xr, (const bf16*)(xp - D), id.lane); ld_row_bf16(fr, fp - D, id.lane); resid_add(xr, fr, g3, mdp + 5120, id.lane); norm_mod(hp, xr, g0, md + 1024, md + 0, id.lane); }
        ld_row_bf16(xr, (const bf16*)xp, id.lane); ld_row_bf16(fr, fp, id.lane); resid_add(xr, fr, g3, mdp + 5120, id.lane); st_row_bf16(xr, (bf16*)xp + 1024, id.lane);
        norm_mod(hc, xr, g0, md + 1024, md + 0, id.lane);
        if (t0 + 1 < T) { ld_raw_bf(nx, (const bf16*)(xp + D), id.lane); ld_raw_bf(nf, fp + D, id.lane); }
#pragma unroll 1
        for (int i = 0; i < 8; ++i) {
#pragma unroll
            for (int q = 0; q < 4; ++q) hn.v[q] = (f32x4){0.f, 0.f, 0.f, 0.f};
            const RawBf cu = nx, cf = nf; if (i + 2 <= 8 && t0 + i + 2 < T) { ld_raw_bf(nx, (const bf16*)(xp + (size_t)(i + 2) * D), id.lane); ld_raw_bf(nf, fp + (size_t)(i + 2) * D, id.lane); }
            if (t0 + i + 1 < T) { cvt_raw_bf(xr, cu); cvt_raw_bf(fr, cf); resid_add(xr, fr, g3, mdp + 5120, id.lane);
                if (i + 1 < 8) st_row_bf16(xr, (bf16*)(xp + (size_t)(i + 1) * D) + 1024, id.lane);
                norm_mod(hn, xr, g0, md + 1024, md + 0, id.lane); }
            RowV xx;
#pragma unroll
            for (int q = 0; q < 4; ++q) xx.v[q] = (hp.v[q] + hn.v[q]) * 0.5f - hc.v[q];
            st_row_bf16(hc, A2 + (size_t)(m0 + i) * KRKV, id.lane); st_row_bf16(xx, A2 + (size_t)(m0 + i) * KRKV + D, id.lane);
#pragma unroll
            for (int p = 0; p < 3; ++p) { const float* mu = mu6 + (size_t)(p == 0 ? 0 : p + 1) * D; RowV xm;
#pragma unroll
                for (int q = 0; q < 4; ++q) xm.v[q] = hc.v[q] + xx.v[q] * ((const f32x4*)mu)[id.lane + 64 * q];
                st_row_bf16(xm, XS + ((size_t)p * NTOK + m0 + i) * D, id.lane); }
            hp = hc; hc = hn;
        }
    }
    conv_weights(a, id, lds, nl, 3);
}

__device__ __forceinline__ void row16_sum4(float& a, float& b, float& c, float& d) {
    asm("s_nop 1\n\t"
        "v_add_f32_dpp %0, %0, %0 row_ror:8 row_mask:0xf bank_mask:0xf\n\tv_add_f32_dpp %1, %1, %1 row_ror:8 row_mask:0xf bank_mask:0xf\n\tv_add_f32_dpp %2, %2, %2 row_ror:8 row_mask:0xf bank_mask:0xf\n\tv_add_f32_dpp %3, %3, %3 row_ror:8 row_mask:0xf bank_mask:0xf\n\t"
        "v_add_f32_dpp %0, %0, %0 row_ror:4 row_mask:0xf bank_mask:0xf\n\tv_add_f32_dpp %1, %1, %1 row_ror:4 row_mask:0xf bank_mask:0xf\n\tv_add_f32_dpp %2, %2, %2 row_ror:4 row_mask:0xf bank_mask:0xf\n\tv_add_f32_dpp %3, %3, %3 row_ror:4 row_mask:0xf bank_mask:0xf\n\t"
        "v_add_f32_dpp %0, %0, %0 row_ror:2 row_mask:0xf bank_mask:0xf\n\tv_add_f32_dpp %1, %1, %1 row_ror:2 row_mask:0xf bank_mask:0xf\n\tv_add_f32_dpp %2, %2, %2 row_ror:2 row_mask:0xf bank_mask:0xf\n\tv_add_f32_dpp %3, %3, %3 row_ror:2 row_mask:0xf bank_mask:0xf\n\t"
        "v_add_f32_dpp %0, %0, %0 row_ror:1 row_mask:0xf bank_mask:0xf\n\tv_add_f32_dpp %1, %1, %1 row_ror:1 row_mask:0xf bank_mask:0xf\n\tv_add_f32_dpp %2, %2, %2 row_ror:1 row_mask:0xf bank_mask:0xf\n\tv_add_f32_dpp %3, %3, %3 row_ror:1 row_mask:0xf bank_mask:0xf"
        : "+v"(a), "+v"(b), "+v"(c), "+v"(d));
}
__device__ __forceinline__ f32x4 ld_bf4(const bf16* p) { const v2u w = *(const v2u*)p; return (f32x4){bflo(w.x), bfhi(w.x), bflo(w.y), bfhi(w.y)}; }
__device__ __forceinline__ void ph_att_cache(const Args& a, const Ids& id, int layer) {
    const int j = layer >> 1, lane = id.lane;
    bf16 *KAS = (bf16*)(a.ws + id.z + A_KAS), *VAS = (bf16*)(a.ws + id.z + A_VAS), *KBS = (bf16*)(a.ws + id.z + A_KBS), *VBS = (bf16*)(a.ws + id.z + A_VBS);
    for (int r = id.gw; r < 4 * PAST; r += id.ngw) {
        const int b = r >> 9, pos = r & (PAST - 1);
        const size_t src = (size_t)((b * 2 + j) * PAST + pos), dst = (size_t)(b * SKV + pos);
#pragma unroll
        for (int q = 0; q < 2; ++q) { const int e = lane + 64 * q; KAS[dst * 128 + e] = (bf16)f2bf(a.in[3 + id.z][src * 128 + e]); VAS[dst * 128 + e] = (bf16)f2bf(a.in[4 + id.z][src * 128 + e]); }
#pragma unroll
        for (int q = 0; q < 8; ++q) { const int e = lane + 64 * q; KBS[dst * 512 + e] = (bf16)f2bf(a.in[5 + id.z][src * 512 + e]); VBS[dst * 512 + e] = (bf16)f2bf(a.in[6 + id.z][src * 512 + e]); }
    }
}

typedef short bf16x8_t __attribute__((ext_vector_type(8)));
typedef float f32x16 __attribute__((ext_vector_type(16)));
typedef short v4i16_t __attribute__((ext_vector_type(4)));
constexpr float AT_THR = 8.0f;
constexpr int AT_KP = 144, AT_KBUF = 64 * AT_KP, AT_VOFF = 2 * AT_KBUF, AT_VBUFMAX = 64 * 288, AT_WSF = AT_VOFF + 2 * AT_VBUFMAX;
static_assert(AT_WSF + 8 * 128 <= RING_BYTES, "attention LDS");
template <int NDT>
__device__ __forceinline__ void attn_unit(const bf16* Qrow0, int ldq, const bf16* Kb, int ldk, const bf16* Vb, int ldv, int S, bf16* Obf, bf16* Od, int ldo, LAS unsigned char* lds, const Ids& id) {
    constexpr int VP = (NDT == 2) ? 144 : 288, NVL = NDT / 2;
    const int lane = id.lane, w = id.wave, r32 = lane & 31, hi = lane >> 5, tid = id.tid;
    bf16x8_t qf[4];
    { const bf16* qrow = Qrow0 + (size_t)(32 * w + r32) * ldq;
#pragma unroll
      for (int s = 0; s < 4; ++s) qf[s] = *(const bf16x8_t*)(qrow + 16 * s + 8 * hi); }
    f32x16 o[NDT];
#pragma unroll
    for (int dt = 0; dt < NDT; ++dt)
#pragma unroll
        for (int r = 0; r < 16; ++r) o[dt][r] = 0.f;
    float m_run = 0.f, l_run = 0.f;
    const int NT = S >> 6;
    LAS float* wsf = (LAS float*)(lds + AT_WSF + w * 128);
    const int krow = tid >> 3, kch = tid & 7;
    v4u kreg, vreg[NVL];
#define AT_GLOAD(t) do { kreg = *(const v4u*)(Kb + (size_t)((t) * 64 + krow) * ldk + 8 * kch); \
        if (NDT == 2) vreg[0] = *(const v4u*)(Vb + (size_t)((t) * 64 + krow) * ldv + 8 * kch); \
        else { _Pragma("unroll") for (int i_ = 0; i_ < NVL; ++i_) { const int ix_ = tid + 512 * i_; vreg[i_] = *(const v4u*)(Vb + (size_t)((t) * 64 + (ix_ >> 4)) * ldv + 8 * (ix_ & 15)); } } } while (0)
#define AT_LSTORE(b) do { *(LAS v4u*)(lds + (b) * AT_KBUF + krow * AT_KP + 16 * kch) = kreg; \
        if (NDT == 2) *(LAS v4u*)(lds + AT_VOFF + (b) * AT_VBUFMAX + krow * VP + 16 * kch) = vreg[0]; \
        else { _Pragma("unroll") for (int i_ = 0; i_ < NVL; ++i_) { const int ix_ = tid + 512 * i_; *(LAS v4u*)(lds + AT_VOFF + (b) * AT_VBUFMAX + (ix_ >> 4) * VP + 16 * (ix_ & 15)) = vreg[i_]; } } } while (0)
    AT_GLOAD(0); AT_LSTORE(0);
    __syncthreads();
    const int vbase = (4 * hi + ((lane & 15) >> 2)) * VP + 32 * ((lane >> 4) & 1) + 8 * (lane & 3);
#pragma unroll 1
    for (int t = 0; t < NT; ++t) {
        const int b = t & 1;
        if (t + 1 < NT) AT_GLOAD(t + 1);
        const LAS unsigned char* Kt = lds + b * AT_KBUF + r32 * AT_KP + 16 * hi;
        const LAS unsigned char* Vt = lds + AT_VOFF + b * AT_VBUFMAX + vbase;
        f32x16 p0, p1;
        { const float nm = -m_run;
#pragma unroll
          for (int r = 0; r < 16; ++r) { p0[r] = nm; p1[r] = nm; } }
#pragma unroll
        for (int s = 0; s < 4; ++s) { const bf16x8_t k0 = *(const LAS bf16x8_t*)(Kt + 32 * s), k1 = *(const LAS bf16x8_t*)(Kt + 32 * AT_KP + 32 * s);
            p0 = __builtin_amdgcn_mfma_f32_32x32x16_bf16(k0, qf[s], p0, 0, 0, 0); p1 = __builtin_amdgcn_mfma_f32_32x32x16_bf16(k1, qf[s], p1, 0, 0, 0); }
        float mx = __builtin_fmaxf(p0[0], p1[0]);
#pragma unroll
        for (int r = 1; r < 16; ++r) mx = __builtin_fmaxf(__builtin_fmaxf(mx, p0[r]), p1[r]);
        mx = fmaxf(mx, __shfl_xor(mx, 32));
        if (t == 0 || __any(mx > AT_THR)) {
            const float dl = (t == 0) ? mx : fmaxf(mx, 0.f), al = __builtin_amdgcn_exp2f(-dl); m_run += dl; l_run *= al;
#pragma unroll
            for (int r = 0; r < 16; ++r) { p0[r] -= dl; p1[r] -= dl; }
            if (hi == 0) wsf[r32] = al;
            LDS_WAIT(); asm volatile("" ::: "memory");
            { f32x4 a4[4];
#pragma unroll
              for (int g4 = 0; g4 < 4; ++g4) a4[g4] = *(const LAS f32x4*)(wsf + 8 * g4 + 4 * hi);
#pragma unroll
              for (int dt = 0; dt < NDT; ++dt)
#pragma unroll
                  for (int r = 0; r < 16; ++r) o[dt][r] *= a4[r >> 2][r & 3]; }
            LDS_WAIT(); asm volatile("" ::: "memory");
        }
        float rs = 0.f;
#pragma unroll
        for (int r = 0; r < 16; ++r) { p0[r] = __builtin_amdgcn_exp2f(p0[r]); p1[r] = __builtin_amdgcn_exp2f(p1[r]); rs += p0[r] + p1[r]; }
        l_run += rs;
        bf16x8_t pf[4];
#pragma unroll
        for (int ks = 0; ks < 4; ++ks) { v4u pw;
#pragma unroll
            for (int dd = 0; dd < 4; ++dd) { const int r = 8 * (ks & 1) + 2 * dd; pw[dd] = (ks < 2) ? pk2(p0[r], p0[r + 1]) : pk2(p1[r], p1[r + 1]); }
            pf[ks] = __builtin_bit_cast(bf16x8_t, pw); }
#pragma unroll
        for (int ks = 0; ks < 4; ++ks)
#pragma unroll
            for (int dt = 0; dt < NDT; ++dt) {
                const v4i16_t lo = __builtin_amdgcn_ds_read_tr16_b64_v4i16((LAS v4i16_t*)(Vt + (16 * ks) * VP + 64 * dt));
                const v4i16_t hh = __builtin_amdgcn_ds_read_tr16_b64_v4i16((LAS v4i16_t*)(Vt + (16 * ks + 8) * VP + 64 * dt));
                const bf16x8_t vf = (bf16x8_t){lo[0], lo[1], lo[2], lo[3], hh[0], hh[1], hh[2], hh[3]};
                o[dt] = __builtin_amdgcn_mfma_f32_32x32x16_bf16(pf[ks], vf, o[dt], 0, 0, 0); }
        if (t + 1 < NT) AT_LSTORE(b ^ 1);
        __syncthreads();
    }
#undef AT_GLOAD
#undef AT_LSTORE
    const float lt = l_run + __shfl_xor(l_run, 32);
    int lane_e = lane; asm volatile("" : "+v"(lane_e));
    const int r32e = lane_e & 31, hie = lane_e >> 5;
    if (hi == 0) wsf[r32] = 1.0f / lt;
    LDS_WAIT(); asm volatile("" ::: "memory");
    f32x4 a4[4];
#pragma unroll
    for (int g4 = 0; g4 < 4; ++g4) a4[g4] = *(const LAS f32x4*)(wsf + 8 * g4 + 4 * hi);
    LDS_WAIT(); asm volatile("" ::: "memory");
#pragma unroll
    for (int dt = 0; dt < NDT; ++dt)
#pragma unroll
        for (int r = 0; r < 16; ++r) { const float val = o[dt][r] * a4[r >> 2][r & 3]; const int off = (32 * w + (r & 3) + 8 * (r >> 2) + 4 * hie) * ldo + 32 * dt + r32e;
            (NDT == 2 ? Obf : Od)[off] = (bf16)f2bf(val); }
}
__device__ __forceinline__ void ph_attn(const Args& a, const Ids& id, LAS unsigned char* lds, int G, int vcu) {
    const bf16 *QA = (const bf16*)(a.ws + id.z + A_QA), *QB = (const bf16*)(a.ws + id.z + A_QB), *KAP = (const bf16*)(a.ws + id.z + A_KAP), *VAP = (const bf16*)(a.ws + id.z + A_VAP), *KBP = (const bf16*)(a.ws + id.z + A_KBP), *VBP = (const bf16*)(a.ws + id.z + A_VBP);
    const bf16 *KAS = (const bf16*)(a.ws + id.z + A_KAS), *VAS = (const bf16*)(a.ws + id.z + A_VAS), *KBS = (const bf16*)(a.ws + id.z + A_KBS), *VBS = (const bf16*)(a.ws + id.z + A_VBS);
    bf16* H = (bf16*)(a.ws + id.z + A_H); bf16* DT = (bf16*)(a.ws + id.z + A_DT);
    for (int s = vcu; s < 256; s += G) {
        const int h8 = s & 7;
#pragma unroll 1
        for (int pass = 0; pass < 2; ++pass) {
            size_t m0, kvrow; int S;
            if (pass == 0) { const int b = s >> 6, qb = (s >> 3) & 7; m0 = (size_t)NPR + b * TS + qb * 256; kvrow = (size_t)b * SKV; S = SKV; }
            else { const int b = s >> 3; m0 = (size_t)b * TP; kvrow = m0; S = TP; }
            const bf16* Ka = (pass == 0 ? KAS : KAP) + kvrow * 128 + (h8 >> 2) * 64; const bf16* Va = (pass == 0 ? VAS : VAP) + kvrow * 128 + (h8 >> 2) * 64;
            const bf16* Kd = (pass == 0 ? KBS : KBP) + kvrow * 512 + h8 * 64; const bf16* Vd = (pass == 0 ? VBS : VBP) + kvrow * 512 + (h8 >> 1) * 128;
            attn_unit<2>(QA + m0 * 512 + h8 * 64, 512, Ka, 128, Va, 128, S, H + m0 * D + h8 * 64, nullptr, D, lds, id);
            attn_unit<4>(QB + m0 * 512 + h8 * 64, 512, Kd, 512, Vd, 512, S, nullptr, DT + m0 * D + h8 * 128, D, lds, id);
        }
    }
}
__device__ __forceinline__ void ph_att_comb(const Args& a, const Ids& id, int layer) {
    const int j = layer >> 1, lane = id.lane; const float lam_init = (layer == 0) ? 0.2f : 0.4707130183435842f;
    const float* lf = a.in[15 + id.z] + j * 256; const float* sg = a.in[16 + id.z] + j * 128;
    const float s01 = wave_sum(lf[lane] * lf[64 + lane]), s23 = wave_sum(lf[128 + lane] * lf[192 + lane]);
    const float lam = expf(s01) - expf(s23) + lam_init;
    const bf16* DT = (const bf16*)(a.ws + id.z + A_DT); bf16* H = (bf16*)(a.ws + id.z + A_H);
    const f32x4 gg = *(const f32x4*)(sg + 4 * (lane & 31)) * (1.0f - lam_init);
    for (int m = id.gw; m < NTOK; m += id.ngw) {
        f32x4 v[4];
#pragma unroll
        for (int hd = 0; hd < 4; ++hd) v[hd] = ld_bf4(DT + (size_t)m * D + 256 * hd + 4 * lane);
        float ss[4];
#pragma unroll
        for (int hd = 0; hd < 4; ++hd) { f32x4 o; o[0] = __shfl_xor(v[hd][0], 32); o[1] = __shfl_xor(v[hd][1], 32); o[2] = __shfl_xor(v[hd][2], 32); o[3] = __shfl_xor(v[hd][3], 32);
            v[hd] = v[hd] - o * lam;
            ss[hd] = (lane < 32) ? (v[hd][0] * v[hd][0] + v[hd][1] * v[hd][1]) + (v[hd][2] * v[hd][2] + v[hd][3] * v[hd][3]) : 0.f; }
        row16_sum4(ss[0], ss[1], ss[2], ss[3]);
#pragma unroll
        for (int hd = 0; hd < 4; ++hd) { const float tot = ss[hd] + __shfl_xor(ss[hd], 16); const float ri = 1.0f / sqrtf(tot * (1.0f / 128.0f) + 1e-6f); const f32x4 o = v[hd] * ri * gg;
            if (lane < 32) *(v2u*)(H + (size_t)m * D + 512 + hd * 128 + 4 * lane) = (v2u){pk2(o[0], o[1]), pk2(o[2], o[3])}; }
    }
}

__device__ __forceinline__ void lora2_phase(LAS unsigned char* lds, const bf16* A, const bf16* Bt, const pg8::EpiLora2& E, int G, int bx, const Ids& id) {
    const int wid = id.wave, lane = id.lane, tid = id.tid, wr = wid >> 2, wc = wid & 3, fr = lane & 15, fq = lane >> 4;
    constexpr int PT = 144;
    LAS unsigned char* As = lds; LAS unsigned char* Bs = lds + 256 * PT;
    const int colr = 32 * wc + 8 * (fr >> 2) + (fr & 3);
#pragma unroll 1
    for (int u = bx; u < 256; u += G) {
        const int pm = u >> 2, pn = 16 + (u & 3); const int kofs = 256, nch = 2;
        f32x4 acc[2][2][4][2];
#pragma unroll
        for (int ai = 0; ai < 2; ++ai)
#pragma unroll
            for (int bj = 0; bj < 2; ++bj)
#pragma unroll
                for (int m = 0; m < 4; ++m) { acc[ai][bj][m][0] = (f32x4){0.f, 0.f, 0.f, 0.f}; acc[ai][bj][m][1] = (f32x4){0.f, 0.f, 0.f, 0.f}; }
#pragma unroll 1
        for (int ch = 0; ch < nch; ++ch) {
            const bf16* Ag = A + (size_t)(pm * 256) * 384 + kofs + 64 * ch; const bf16* Bg = Bt + (size_t)(pn * 256) * 384 + kofs + 64 * ch;
#pragma unroll
            for (int i = 0; i < 4; ++i) { const int idx = tid + 512 * i, r = idx >> 3, c8 = idx & 7;
                *(LAS v4u*)(As + r * PT + 16 * c8) = *(const v4u*)(Ag + (size_t)r * 384 + 8 * c8); *(LAS v4u*)(Bs + r * PT + 16 * c8) = *(const v4u*)(Bg + (size_t)r * 384 + 8 * c8); }
            __syncthreads();
#pragma unroll
            for (int ks = 0; ks < 2; ++ks) {
                bf16x8_t bo[2][4], ao[2][2];
#pragma unroll
                for (int ai = 0; ai < 2; ++ai)
#pragma unroll
                    for (int m = 0; m < 4; ++m) bo[ai][m] = *(const LAS bf16x8_t*)(As + (128 * ai + 64 * wr + 16 * m + fr) * PT + 64 * ks + 16 * fq);
#pragma unroll
                for (int bj = 0; bj < 2; ++bj)
#pragma unroll
                    for (int n = 0; n < 2; ++n) ao[bj][n] = *(const LAS bf16x8_t*)(Bs + (128 * bj + colr + 4 * n) * PT + 64 * ks + 16 * fq);
#pragma unroll
                for (int ai = 0; ai < 2; ++ai)
#pragma unroll
                    for (int bj = 0; bj < 2; ++bj)
#pragma unroll
                        for (int m = 0; m < 4; ++m)
#pragma unroll
                            for (int n = 0; n < 2; ++n) acc[ai][bj][m][n] = __builtin_amdgcn_mfma_f32_16x16x32_bf16(ao[bj][n], bo[ai][m], acc[ai][bj][m][n], 0, 0, 0);
            }
            __syncthreads();
        }
        E(acc, pg8::Unit{pm, pn}, wr, wc, fr, fq);
    }
}
__device__ __forceinline__ void ph_rw_prep(const Args& a, const Ids& id, int layer) {
    const int j = layer >> 1, lane = id.lane, h = lane >> 2, qd = lane & 3;
    const bf16* RKV = (const bf16*)(a.ws + id.z + A_RKV) + 1024 + h * 64 + 16 * qd; float* INV = (float*)(a.ws + id.z + WS_INV);
    const f32x4* kc = (const f32x4*)(a.in[28 + id.z] + (size_t)(j * 3 + 0) * D + h * 64 + 16 * qd);
    const f32x4 c0 = kc[0], c1 = kc[1], c2 = kc[2], c3 = kc[3];
    int m = id.gw; v4u wa, wb; if (m < NTOK) { wa = *(const v4u*)(RKV + (size_t)m * 3072); wb = *(const v4u*)(RKV + (size_t)m * 3072 + 8); }
    for (; m < NTOK; m += id.ngw) {
        const v4u w0 = wa, w1 = wb;
        if (m + id.ngw < NTOK) { wa = *(const v4u*)(RKV + (size_t)(m + id.ngw) * 3072); wb = *(const v4u*)(RKV + (size_t)(m + id.ngw) * 3072 + 8); }
        const f32x4 t0 = (f32x4){bflo(w0.x), bfhi(w0.x), bflo(w0.y), bfhi(w0.y)} * c0, t1 = (f32x4){bflo(w0.z), bfhi(w0.z), bflo(w0.w), bfhi(w0.w)} * c1,
                    t2 = (f32x4){bflo(w1.x), bfhi(w1.x), bflo(w1.y), bfhi(w1.y)} * c2, t3 = (f32x4){bflo(w1.z), bfhi(w1.z), bflo(w1.w), bfhi(w1.w)} * c3;
        const f32x4 q4 = t0 * t0 + t1 * t1 + t2 * t2 + t3 * t3;
        float s = (q4[0] + q4[1]) + (q4[2] + q4[3]);
        asm("s_nop 1\n\tv_add_f32_dpp %0, %0, %0 quad_perm:[1,0,3,2] row_mask:0xf bank_mask:0xf\n\ts_nop 1\n\tv_add_f32_dpp %0, %0, %0 quad_perm:[2,3,0,1] row_mask:0xf bank_mask:0xf\n\ts_nop 1" : "+v"(s));
        if (qd == 0) INV[m * 16 + h] = 1.0f / sqrtf(s + 1e-12f);
    }
}

constexpr int SC_TC = 16;
constexpr int CK_AH = 0, CK_RH = 2560, CK_VT = 5120, CK_KCT = 7680, CK_BCT = 10240, CK_TM = 12288, CK_LAK = 12800, CK_MRB = 13312, CK_MRK = 13824, CK_GC = 14336, CK_SLOT = 16384;
constexpr int CK_TMP = 4 * CK_SLOT, CK_TMPW = 4608;
constexpr int SC_YOFF = (CK_TMP + 2 * CK_TMPW) / 4;
constexpr int CK_BSL = (SC_YOFF + 2 * SC_TC * 64) * 4;
static_assert(CK_BSL + 1024 <= RING_BYTES, "scan LDS");
constexpr size_t A_BS = AR + 208 * MiB;
constexpr int CK_AEW = CK_BSL + 1024;
constexpr int CK_L1F = CK_AEW + 2 * 6912;
static_assert(CK_L1F + 2 * 4096 <= RING_BYTES, "scan LDS");
constexpr int SC_NC = TS / SC_TC;
struct ScDesc { int mbase, T, h, dir, b; };
__device__ __forceinline__ void sc_desc(ScDesc& d, int slot, int c) {
    if (slot < 128) { d.b = slot >> 5; d.h = (slot >> 1) & 15; d.dir = slot & 1; d.T = TS; d.mbase = NPR + d.b * TS; }
    else { const int cp = (slot - 128) * 8 + (c >> 4); d.b = cp >> 5; d.h = (cp >> 1) & 15; d.dir = cp & 1; d.T = TP; d.mbase = d.b * TP; }
}
__device__ __forceinline__ int sc_cbase(int slot, int c) { return (slot < 128 ? c : (c & 15)) * SC_TC; }
__device__ __forceinline__ int sc_tok(const ScDesc& d, int s) { return d.mbase + (d.dir ? d.T - 1 - s : s); }
typedef float f32x2 __attribute__((ext_vector_type(2)));
typedef short bf16x4_t __attribute__((ext_vector_type(4)));
#define MF32(a_, b_, c_) __builtin_amdgcn_mfma_f32_16x16x32_bf16(a_, b_, c_, 0, 0, 0)
__device__ __forceinline__ f32x4 mf16_pad(const bf16x4_t a, const bf16x4_t b, const f32x4 c) {
    const bf16x8_t a8 = (bf16x8_t){a[0], a[1], a[2], a[3], 0, 0, 0, 0}, b8 = (bf16x8_t){b[0], b[1], b[2], b[3], 0, 0, 0, 0};
    return __builtin_amdgcn_mfma_f32_16x16x32_bf16(a8, b8, c, 0, 0, 0);
}
#define MF16(a_, b_, c_) mf16_pad(a_, b_, c_)
__device__ __forceinline__ v2u pk4u(const f32x4 v) { return (v2u){pk2(v[0], v[1]), pk2(v[2], v[3])}; }
__device__ __forceinline__ bf16x4_t pk4(const f32x4 v) { return __builtin_bit_cast(bf16x4_t, pk4u(v)); }
__device__ __forceinline__ f32x2 exp2v(const f32x2 x) { return (f32x2){__builtin_amdgcn_exp2f(x[0]), __builtin_amdgcn_exp2f(x[1])}; }
template <int CTRL> __device__ __forceinline__ float dpp_f(float v) { return __builtin_bit_cast(float, __builtin_amdgcn_update_dpp(0, __builtin_bit_cast(int, v), CTRL, 0xf, 0xf, true)); }
__device__ __forceinline__ float bperm_f(int srclane, float v) { return __builtin_bit_cast(float, __builtin_amdgcn_ds_bpermute(srclane << 2, __builtin_bit_cast(int, v))); }
struct CkKv { f32x2 kkc, kac, rkc; };
struct CkRaw { unsigned r[2], k[2]; float iv[2]; unsigned v[2]; bf16x8_t lf[4]; };
__device__ __forceinline__ void ck_load(CkRaw& R, const Args& a, const Ids& id, int slot, int c, int hq) {
    const int lane = id.lane, kp = 8 * hq + (lane & 7), tq = lane >> 3; ScDesc d; sc_desc(d, slot, c);
    const int s0 = sc_cbase(slot, c) + 2 * tq; const int m0 = sc_tok(d, s0); const int ms = d.dir ? -1 : 1;
    const unsigned char* bR = a.ws + id.z + A_RKV; const unsigned char* bI = a.ws + id.z + WS_INV;
    const unsigned oR = (unsigned)m0 * 6144u + (unsigned)(d.h * 128 + 4 * kp), oI = (unsigned)m0 * 64u + (unsigned)(d.h * 4);
    const unsigned sR = (unsigned)(ms * 6144), sI = (unsigned)(ms * 64);
#pragma unroll
    for (int it = 0; it < 2; ++it) {
        R.r[it] = *(const unsigned*)(bR + (oR + it * sR)); R.k[it] = *(const unsigned*)(bR + (oR + it * sR + 2048u)); R.v[it] = *(const unsigned*)(bR + (oR + it * sR + 4096u));
        R.iv[it] = *(const float*)(bI + (oI + it * sI)); }
    if (hq == 3) { const int c2 = c + 2 < SC_NC ? c + 2 : SC_NC - 1; ScDesc d2; sc_desc(d2, slot, c2);
        const bf16* L1 = (const bf16*)(a.ws + id.z + A_L1) + (size_t)sc_tok(d2, sc_cbase(slot, c2) + (lane & 15)) * 384 + 8 * (lane >> 4) + 64 * d2.dir;
        R.lf[0] = *(const bf16x8_t*)(L1 + 128); R.lf[1] = *(const bf16x8_t*)(L1 + 160); R.lf[2] = *(const bf16x8_t*)L1; R.lf[3] = *(const bf16x8_t*)(L1 + 32); }
}
__device__ __forceinline__ void ck_derive(const CkRaw& Rin, const Args& a, const Ids& id, LAS unsigned char* sb, LAS unsigned char* tb, LAS unsigned char* bsl, const LAS unsigned char* aew, LAS unsigned char* l1f, CkKv& kv, int layer, int slot, int c, int hq, bool tail = false) {
    if (tail) asm volatile("s_waitcnt vmcnt(0)" ::: "memory");
    else if (hq == 3) asm volatile("s_waitcnt vmcnt(12)" ::: "memory"); else asm volatile("s_waitcnt vmcnt(8)" ::: "memory");
    CkRaw R = Rin;
#pragma unroll
    for (int it = 0; it < 2; ++it) asm volatile("" : "+v"(R.r[it]), "+v"(R.k[it]), "+v"(R.iv[it]), "+v"(R.v[it]));
    if (hq == 3) { asm volatile("" : "+v"(R.lf[0]), "+v"(R.lf[1]), "+v"(R.lf[2]), "+v"(R.lf[3]));
#pragma unroll
        for (int f = 0; f < 4; ++f) *(LAS bf16x8_t*)(l1f + f * 1024 + id.lane * 16) = R.lf[f]; }
    const int lane = id.lane, kp = 8 * hq + (lane & 7), tq = lane >> 3, j = layer >> 1; ScDesc d; sc_desc(d, slot, c);
    if (slot < 128 ? c == 0 : (c & 15) == 0) {
        const float* kvp = a.in[28 + id.z] + (size_t)(j * 3) * D + d.h * 64 + 2 * kp;
        kv.kkc = *(const f32x2*)kvp; kv.kac = *(const f32x2*)(kvp + D); kv.rkc = *(const f32x2*)(kvp + 2 * D);
        asm volatile("s_waitcnt vmcnt(0)" : "+v"(kv.kkc), "+v"(kv.kac), "+v"(kv.rkc) :: "memory"); }
    const f32x2 kkc = kv.kkc, kac = kv.kac;
    const unsigned ra0 = *(const LAS unsigned*)(aew + (2 * tq) * 144 + 4 * kp), ra1 = *(const LAS unsigned*)(aew + (2 * tq + 1) * 144 + 4 * kp);
    const LAS unsigned char* cb = aew + 2304 + 8 * kp;
    const f32x2 c0 = *(const LAS f32x2*)(cb + (2 * tq) * 288), c1 = *(const LAS f32x2*)(cb + (2 * tq + 1) * 288), cumC = *(const LAS f32x2*)(cb + 15 * 288);
    const f32x2 cA = *(const LAS f32x2*)(cb + (tq > 0 ? 2 * tq - 1 : 0) * 288);
    const f32x2 carry = tq > 0 ? cA : (f32x2){0.f, 0.f};
    const f32x2 gC = exp2v(-cumC);
    f32x2 gprev = exp2v(-carry);
    f32x2 kcp = (f32x2){0.f, 0.f}, bcp = (f32x2){0.f, 0.f};
    const f32x2 rkc = kv.rkc; float bon0 = 0.f, bon1 = 0.f;
#pragma unroll
    for (int it = 0; it < 2; ++it) {
        const f32x2 cum = it == 0 ? c0 : c1; const f32x2 g = exp2v(-cum), ig = exp2v(cum);
        const f32x2 k2 = (f32x2){bflo(R.k[it]), bfhi(R.k[it])}, a2 = (f32x2){bflo(it == 0 ? ra0 : ra1), bfhi(it == 0 ? ra0 : ra1)}, r2 = (f32x2){bflo(R.r[it]), bfhi(R.r[it])};
        const f32x2 kdv = k2 * ((a2 - 1.0f) * kac + 1.0f);
        const f32x2 kk = k2 * kkc * R.iv[it], Ah = kk * gprev, Bh = kk * a2 * ig, Kh = kdv * ig, Rh = r2 * g, Kc = Kh * gC, Bc = Bh * gC;
        { const f32x2 bp = r2 * kdv * rkc; if (it == 0) bon0 = bp[0] + bp[1]; else bon1 = bp[0] + bp[1]; }
        gprev = g;
        const int ro = (2 * tq + it) * 144 + 4 * kp;
        *(LAS unsigned*)(sb + CK_AH + ro) = pk2(Ah[0], Ah[1]); *(LAS unsigned*)(sb + CK_RH + ro) = pk2(Rh[0], Rh[1]);
        *(LAS unsigned*)(tb + ro) = pk2(Bh[0], Bh[1]); *(LAS unsigned*)(tb + 2304 + ro) = pk2(Kh[0], Kh[1]);
        if (it == 1) { *(LAS unsigned*)(sb + CK_KCT + (2 * kp) * 32 + 4 * tq) = pk2(kcp[0], Kc[0]); *(LAS unsigned*)(sb + CK_KCT + (2 * kp + 1) * 32 + 4 * tq) = pk2(kcp[1], Kc[1]);
                       *(LAS unsigned*)(sb + CK_BCT + (2 * kp) * 32 + 4 * tq) = pk2(bcp[0], Bc[0]); *(LAS unsigned*)(sb + CK_BCT + (2 * kp + 1) * 32 + 4 * tq) = pk2(bcp[1], Bc[1]); }
        else { kcp = Kc; bcp = Bc; }
    }
    if (tq == 0) *(LAS f32x2*)(sb + CK_GC + 8 * kp) = gC;
    asm volatile("s_nop 1\n\t"
        "v_add_f32_dpp %0, %0, %0 quad_perm:[1,0,3,2] row_mask:0xf bank_mask:0xf\n\tv_add_f32_dpp %1, %1, %1 quad_perm:[1,0,3,2] row_mask:0xf bank_mask:0xf\n\ts_nop 1\n\t"
        "v_add_f32_dpp %0, %0, %0 quad_perm:[2,3,0,1] row_mask:0xf bank_mask:0xf\n\tv_add_f32_dpp %1, %1, %1 quad_perm:[2,3,0,1] row_mask:0xf bank_mask:0xf\n\ts_nop 1\n\t"
        "v_add_f32_dpp %0, %0, %0 row_half_mirror row_mask:0xf bank_mask:0xf\n\tv_add_f32_dpp %1, %1, %1 row_half_mirror row_mask:0xf bank_mask:0xf\n\ts_nop 1" : "+v"(bon0), "+v"(bon1));
    if ((lane & 7) == 0) *(LAS f32x2*)(bsl + (hq * 16 + 2 * tq) * 4) = (f32x2){bon0, bon1};
    *(LAS unsigned*)(sb + CK_VT + (2 * kp) * 32 + 4 * tq) = (R.v[0] & 0xffffu) | (R.v[1] << 16);
    *(LAS unsigned*)(sb + CK_VT + (2 * kp + 1) * 32 + 4 * tq) = (R.v[0] >> 16) | (R.v[1] & 0xffff0000u);
}
struct CkAew { bf16x8_t la0, la1, le0, le1, wa0, wa1, we0, we1; f32x4 ba, be; };
__device__ __forceinline__ void ck_aew_load(CkAew& F, const Args& a, const Ids& id, int layer, int slot, int c, int w) {
    const int lane = id.lane, ln = lane & 15, q = lane >> 4, j = layer >> 1; ScDesc d; sc_desc(d, slot, c);
    const int tok = sc_tok(d, sc_cbase(slot, c) + ln);
    const int ka = 128 + 64 * d.dir, ke = 64 * d.dir;
    const bf16* L1 = (const bf16*)(a.ws + id.z + A_L1) + (size_t)tok * 384 + 8 * q;
    const bf16* W2 = (const bf16*)(a.ws + id.z + W_BT2) + (size_t)(d.h * 64 + 16 * w + ln) * 384 + 8 * q;
    const bf16* Wa = W2 + (size_t)(d.dir * 1024) * 384 + ka; const bf16* We = W2 + (size_t)((2 + d.dir) * 1024) * 384 + ke;
    F.la0 = *(const bf16x8_t*)(L1 + ka); F.la1 = *(const bf16x8_t*)(L1 + ka + 32); F.le0 = *(const bf16x8_t*)(L1 + ke); F.le1 = *(const bf16x8_t*)(L1 + ke + 32);
    F.wa0 = *(const bf16x8_t*)Wa; F.wa1 = *(const bf16x8_t*)(Wa + 32); F.we0 = *(const bf16x8_t*)We; F.we1 = *(const bf16x8_t*)(We + 32);
    const size_t bo = (size_t)j * 2 * D + d.dir * 1024 + d.h * 64 + 16 * w + 4 * q;
    F.ba = *(const f32x4*)(a.in[23 + id.z] + bo); F.be = *(const f32x4*)(a.in[20 + id.z] + bo);
}
__device__ __forceinline__ void ck_aew_loadW(CkAew& F, const Args& a, const Ids& id, int layer, int slot, int c, int w) {
    const int lane = id.lane, ln = lane & 15, q = lane >> 4, j = layer >> 1; ScDesc d; sc_desc(d, slot, c);
    const int ka = 128 + 64 * d.dir, ke = 64 * d.dir;
    const bf16* W2 = (const bf16*)(a.ws + id.z + W_BT2) + (size_t)(d.h * 64 + 16 * w + ln) * 384 + 8 * q;
    const bf16* Wa = W2 + (size_t)(d.dir * 1024) * 384 + ka; const bf16* We = W2 + (size_t)((2 + d.dir) * 1024) * 384 + ke;
    F.wa0 = *(const bf16x8_t*)Wa; F.wa1 = *(const bf16x8_t*)(Wa + 32); F.we0 = *(const bf16x8_t*)We; F.we1 = *(const bf16x8_t*)(We + 32);
    const size_t bo = (size_t)j * 2 * D + d.dir * 1024 + d.h * 64 + 16 * w + 4 * q;
    F.ba = *(const f32x4*)(a.in[23 + id.z] + bo); F.be = *(const f32x4*)(a.in[20 + id.z] + bo);
}
__device__ __forceinline__ void ck_aew_finish(CkAew& F, const Ids& id, LAS unsigned char* dst, int w, const LAS unsigned char* l1f = nullptr) {
    if (l1f) { F.la0 = *(const LAS bf16x8_t*)(l1f + id.lane * 16); F.la1 = *(const LAS bf16x8_t*)(l1f + 1024 + id.lane * 16); F.le0 = *(const LAS bf16x8_t*)(l1f + 2048 + id.lane * 16); F.le1 = *(const LAS bf16x8_t*)(l1f + 3072 + id.lane * 16); }
    asm volatile("s_waitcnt vmcnt(0)" : "+v"(F.la0), "+v"(F.la1), "+v"(F.le0), "+v"(F.le1), "+v"(F.wa0), "+v"(F.wa1), "+v"(F.we0), "+v"(F.we1), "+v"(F.ba), "+v"(F.be) :: "memory");
    const int ln = id.lane & 15, q = id.lane >> 4;
    const f32x4 zero = (f32x4){0.f, 0.f, 0.f, 0.f};
    f32x4 da = MF32(F.wa0, F.la0, zero); da = MF32(F.wa1, F.la1, da);
    f32x4 de = MF32(F.we0, F.le0, zero); de = MF32(F.we1, F.le1, de);
#pragma unroll
    for (int jj = 0; jj < 4; ++jj) {
        da[jj] = __builtin_amdgcn_rcpf(1.0f + __builtin_amdgcn_exp2f(-1.4426950408889634f * (da[jj] + F.ba[jj])));
        de[jj] = 0.8750387749719753f * __builtin_amdgcn_rcpf(1.0f + __builtin_amdgcn_exp2f(-1.4426950408889634f * (de[jj] + F.be[jj]))); }
    *(LAS v2u*)(dst + ln * 144 + 2 * (16 * w + 4 * q)) = pk4u(da);
    const v2u pe = pk4u(de);
    f32x4 cs = (f32x4){bflo(pe[0]), bfhi(pe[0]), bflo(pe[1]), bfhi(pe[1])};
#pragma unroll
    for (int jj = 0; jj < 4; ++jj) {
        cs[jj] += dpp_f<0x111>(cs[jj]); cs[jj] += dpp_f<0x112>(cs[jj]); cs[jj] += dpp_f<0x114>(cs[jj]); cs[jj] += dpp_f<0x118>(cs[jj]); }
    *(LAS f32x4*)(dst + 2304 + ln * 288 + 4 * (16 * w + 4 * q)) = cs;
}
__device__ __forceinline__ void ck_products(const Ids& id, LAS unsigned char* sb, const LAS unsigned char* tb, int hq) {
    const int ln = id.lane & 15, q = id.lane >> 4;
    const f32x4 zero = (f32x4){0.f, 0.f, 0.f, 0.f};
    if (hq == 0) {
        f32x4 P0 = zero, P1 = zero;
#pragma unroll
        for (int ks = 0; ks < 2; ++ks) { const int fo = ln * 144 + 64 * ks + 16 * q;
            const bf16x8_t ah = *(const LAS bf16x8_t*)(sb + CK_AH + fo), bh = *(const LAS bf16x8_t*)(tb + fo);
            P0 = MF32(ah, bh, P0);
            P1 = MF32(bh, ah, P1); }
        f32x4 b1, a1, z0;
#pragma unroll
        for (int jj = 0; jj < 4; ++jj) { const int row = 4 * q + jj;
            b1[jj] = (ln < row) ? -P0[jj] : 0.f;
            a1[jj] = (row < ln) ? -P1[jj] : 0.f;
            z0[jj] = a1[jj] + ((row == ln) ? 1.f : 0.f); }
        const bf16x4_t a1b = pk4(a1), b1b = pk4(b1);
        const f32x4 b2 = MF16(a1b, b1b, zero), a2 = MF16(b1b, a1b, zero);
        const bf16x4_t b2b = pk4(b2), a2b = pk4(a2);
        const f32x4 z1 = MF16(b2b, pk4(z0), z0);
        const f32x4 b4 = MF16(a2b, b2b, zero), a4 = MF16(b2b, a2b, zero);
        const bf16x4_t b4b = pk4(b4), a4b = pk4(a4);
        const f32x4 z2 = MF16(b4b, pk4(z1), z1);
        const f32x4 b8 = MF16(a4b, b4b, zero);
        const f32x4 z3 = MF16(pk4(b8), pk4(z2), z2);
        *(LAS v2u*)(sb + CK_TM + ln * 32 + 8 * q) = pk4u(z3);
    } else {
        const LAS unsigned char* pa = tb + (hq == 2 ? 0 : 2304); const LAS unsigned char* pb = sb + (hq == 1 ? CK_AH : CK_RH);
        f32x4 P = zero;
#pragma unroll
        for (int ks = 0; ks < 2; ++ks) { const int fo = ln * 144 + 64 * ks + 16 * q; P = MF32(*(const LAS bf16x8_t*)(pa + fo), *(const LAS bf16x8_t*)(pb + fo), P); }
        f32x4 m;
#pragma unroll
        for (int jj = 0; jj < 4; ++jj) { const int row = 4 * q + jj; m[jj] = ((hq == 1) ? (row < ln) : (row <= ln)) ? P[jj] : 0.f; }
        *(LAS v2u*)(sb + (hq == 1 ? CK_LAK : (hq == 2 ? CK_MRB : CK_MRK)) + ln * 32 + 8 * q) = pk4u(m);
    }
}
__device__ __forceinline__ void sc_flush(const Args& a, const Ids& id, const LAS float* L, int hq, int slot, int c) {
    bf16* Y = (bf16*)(a.ws + id.z + A_Y);
    ScDesc d; sc_desc(d, slot, c); const int cb = sc_cbase(slot, c);
#pragma unroll
    for (int qq = 0; qq < 2; ++qq) { const int idx = hq * 64 + id.lane + 256 * qq, s = idx >> 5, rp = idx & 31;
        const f32x2 yv = *(const LAS f32x2*)(L + SC_YOFF + (c & 1) * SC_TC * 64 + s * 64 + 2 * rp);
        *(unsigned*)(Y + ((size_t)d.dir * NTOK + sc_tok(d, cb + s)) * D + d.h * 64 + 2 * rp) = pk2(yv[0], yv[1]); }
    if (hq == 0 && id.lane < 16) { const LAS float* bl = L + CK_BSL / 4 + (c & 3) * 64 + id.lane;
        ((float*)(a.ws + id.z + A_BS))[((size_t)d.dir * NTOK + sc_tok(d, cb + id.lane)) * 16 + d.h] = (bl[0] + bl[16]) + (bl[32] + bl[48]); }
}
__device__ __forceinline__ void ph_rw_scan(const Args& a, const Ids& id, LAS unsigned char* lds, int layer, int G, int vcu) {
    const int j = layer >> 1, lane = id.lane, w = id.wave;
    LAS float* L = (LAS float*)lds;
    constexpr int NC = TS / SC_TC;
    for (int slot = vcu; slot < 256; slot += G) {
        if (w >= 4) {
            const int hq = w - 4; CkRaw R0, R1; CkKv kv;
            __builtin_amdgcn_s_setprio(2);
            LAS unsigned char* tg = lds + CK_TMP;
            ck_load(R0, a, id, slot, 0, hq); ck_load(R1, a, id, slot, 1, hq);
            __syncthreads();
            ck_derive(R0, a, id, lds, tg, lds + CK_BSL, lds + CK_AEW, lds + CK_L1F, kv, layer, slot, 0, hq);
            ck_load(R0, a, id, slot, 2, hq);
            ck_derive(R1, a, id, lds + CK_SLOT, tg + CK_TMPW, lds + CK_BSL + 256, lds + CK_AEW + 6912, lds + CK_L1F + 4096, kv, layer, slot, 1, hq);
            ck_load(R1, a, id, slot, 3, hq);
            __syncthreads();
            ck_products(id, lds, tg, hq);
            __syncthreads();
#pragma unroll 1
            for (int n = 0; n < NC; n += 2) {
                ck_products(id, lds + ((n + 1) & 3) * CK_SLOT, tg + CK_TMPW, hq);
                if (n + 2 < NC) ck_derive(R0, a, id, lds + ((n + 2) & 3) * CK_SLOT, tg, lds + CK_BSL + ((n + 2) & 3) * 256, lds + CK_AEW, lds + CK_L1F, kv, layer, slot, n + 2, hq, n + 3 >= NC);
                if (n > 0) sc_flush(a, id, L, hq, slot, n - 1);
                if (n + 4 < NC) ck_load(R0, a, id, slot, n + 4, hq);
                __syncthreads();
                if (n + 2 < NC) ck_products(id, lds + ((n + 2) & 3) * CK_SLOT, tg, hq);
                if (n + 3 < NC) ck_derive(R1, a, id, lds + ((n + 3) & 3) * CK_SLOT, tg + CK_TMPW, lds + CK_BSL + ((n + 3) & 3) * 256, lds + CK_AEW + 6912, lds + CK_L1F + 4096, kv, layer, slot, n + 3, hq, n + 4 >= NC);
                sc_flush(a, id, L, hq, slot, n);
                if (n + 5 < NC) ck_load(R1, a, id, slot, n + 5, hq);
                __syncthreads();
            }
            sc_flush(a, id, L, hq, slot, NC - 1);
            __builtin_amdgcn_s_setprio(0);
        } else {
            const int ln = lane & 15, q = lane >> 4, i0l = 16 * w; const bool prompt = slot >= 128;
            const f32x4 zero = (f32x4){0.f, 0.f, 0.f, 0.f};
            f32x4 S0 = zero, S1 = zero, S2 = zero, S3 = zero;
            if (!prompt) { ScDesc d; sc_desc(d, slot, 0);
                const float* sp = a.in[7 + id.z] + ((((size_t)(d.b * 2 + j) * 2 + d.dir) * 16 + d.h) * 64 + i0l + ln) * 64 + 4 * q;
                S0 = *(const f32x4*)sp; S1 = *(const f32x4*)(sp + 16); S2 = *(const f32x4*)(sp + 32); S3 = *(const f32x4*)(sp + 48); }
            CkAew F;
            ck_aew_load(F, a, id, layer, slot, 0, w); ck_aew_finish(F, id, lds + CK_AEW, w);
            ck_aew_load(F, a, id, layer, slot, 1, w); ck_aew_finish(F, id, lds + CK_AEW + 6912, w);
            __syncthreads();
            __syncthreads();
            ck_aew_load(F, a, id, layer, slot, 2, w); ck_aew_finish(F, id, lds + CK_AEW, w);
            __syncthreads();
#pragma unroll 1
            for (int c = 0; c < NC; ++c) {
                if (prompt && (c & 15) == 0) { S0 = zero; S1 = zero; S2 = zero; S3 = zero; }
                if (c + 3 < NC && prompt && ((c + 3) & 15) == 0) ck_aew_loadW(F, a, id, layer, slot, c + 3, w);
                const LAS unsigned char* sb = lds + (c & 3) * CK_SLOT;
                const bf16x8_t sf0 = __builtin_bit_cast(bf16x8_t, (v4u){pk2(S0[0], S0[1]), pk2(S0[2], S0[3]), pk2(S1[0], S1[1]), pk2(S1[2], S1[3])});
                const bf16x8_t sf1 = __builtin_bit_cast(bf16x8_t, (v4u){pk2(S2[0], S2[1]), pk2(S2[2], S2[3]), pk2(S3[0], S3[1]), pk2(S3[2], S3[3])});
                const int po = ln * 144 + 8 * q;
                const v2u ah0 = *(const LAS v2u*)(sb + CK_AH + po), ah1 = *(const LAS v2u*)(sb + CK_AH + po + 32), ah2 = *(const LAS v2u*)(sb + CK_AH + po + 64), ah3 = *(const LAS v2u*)(sb + CK_AH + po + 96);
                const v2u rh0 = *(const LAS v2u*)(sb + CK_RH + po), rh1 = *(const LAS v2u*)(sb + CK_RH + po + 32), rh2 = *(const LAS v2u*)(sb + CK_RH + po + 64), rh3 = *(const LAS v2u*)(sb + CK_RH + po + 96);
                const int so = ln * 32 + 8 * q;
                const bf16x4_t vt = *(const LAS bf16x4_t*)(sb + CK_VT + i0l * 32 + so), lak = *(const LAS bf16x4_t*)(sb + CK_LAK + so), mrk = *(const LAS bf16x4_t*)(sb + CK_MRK + so),
                               mrb = *(const LAS bf16x4_t*)(sb + CK_MRB + so), tm = *(const LAS bf16x4_t*)(sb + CK_TM + so);
                f32x4 u0 = MF16(lak, vt, zero), y = MF16(mrk, vt, zero);
                u0 = MF32(__builtin_bit_cast(bf16x8_t, (v4u){ah0.x, ah0.y, ah1.x, ah1.y}), sf0, u0); u0 = MF32(__builtin_bit_cast(bf16x8_t, (v4u){ah2.x, ah2.y, ah3.x, ah3.y}), sf1, u0);
                y = MF32(__builtin_bit_cast(bf16x8_t, (v4u){rh0.x, rh0.y, rh1.x, rh1.y}), sf0, y); y = MF32(__builtin_bit_cast(bf16x8_t, (v4u){rh2.x, rh2.y, rh3.x, rh3.y}), sf1, y);
                const f32x4 gc0 = *(const LAS f32x4*)(sb + CK_GC + 16 * q), gc1 = *(const LAS f32x4*)(sb + CK_GC + 64 + 16 * q), gc2 = *(const LAS f32x4*)(sb + CK_GC + 128 + 16 * q), gc3 = *(const LAS f32x4*)(sb + CK_GC + 192 + 16 * q);
                S0 = MF16(*(const LAS bf16x4_t*)(sb + CK_KCT + so), vt, S0 * gc0); S1 = MF16(*(const LAS bf16x4_t*)(sb + CK_KCT + 512 + so), vt, S1 * gc1);
                S2 = MF16(*(const LAS bf16x4_t*)(sb + CK_KCT + 1024 + so), vt, S2 * gc2); S3 = MF16(*(const LAS bf16x4_t*)(sb + CK_KCT + 1536 + so), vt, S3 * gc3);
                const f32x4 u = MF16(tm, pk4(u0), zero);
                const bf16x4_t nub = pk4(-u);
                y = MF16(mrb, nub, y);
                S0 = MF16(*(const LAS bf16x4_t*)(sb + CK_BCT + so), nub, S0); S1 = MF16(*(const LAS bf16x4_t*)(sb + CK_BCT + 512 + so), nub, S1);
                S2 = MF16(*(const LAS bf16x4_t*)(sb + CK_BCT + 1024 + so), nub, S2); S3 = MF16(*(const LAS bf16x4_t*)(sb + CK_BCT + 1536 + so), nub, S3);
                LAS float* yb = L + SC_YOFF + (c & 1) * SC_TC * 64 + i0l + ln;
#pragma unroll
                for (int jj = 0; jj < 4; ++jj) yb[(4 * q + jj) * 64] = y[jj];
                if (prompt && (c & 15) == 15) { ScDesc d; sc_desc(d, slot, c);
                    float* dp = a.out + id.z + O_ST + ((((size_t)(d.b * 2 + j) * 2 + d.dir) * 16 + d.h) * 64 + i0l + ln) * 64 + 4 * q;
                    *(f32x4*)dp = S0; *(f32x4*)(dp + 16) = S1; *(f32x4*)(dp + 32) = S2; *(f32x4*)(dp + 48) = S3; }
                if (c + 3 < NC) ck_aew_finish(F, id, lds + CK_AEW + ((c + 3) & 1) * 6912, w, lds + CK_L1F + ((c + 3) & 1) * 4096);
                __syncthreads();
            }
        }
        __syncthreads();
    }
}
__device__ __forceinline__ void ph_rw_post(const Args& a, const Ids& id, int layer) {
    const int j = layer >> 1, lane = id.lane;
    const bf16* RKV = (const bf16*)(a.ws + id.z + A_RKV); const bf16* Y = (const bf16*)(a.ws + id.z + A_Y);
    const float* BS = (const float*)(a.ws + id.z + A_BS); bf16* H = (bf16*)(a.ws + id.z + A_H);
    const float* lnx = a.in[29 + id.z] + (size_t)j * 2 * D;
    f32x4 l0[4], l1[4];
#pragma unroll
    for (int q = 0; q < 4; ++q) { const int c = 4 * lane + 256 * q; l0[q] = *(const f32x4*)(lnx + c); l1[q] = *(const f32x4*)(lnx + D + c); }
    for (int m = id.gw; m < NTOK; m += id.ngw) {
        f32x4 y[4], v[4], g[4]; float s[4], qv[4], bs[4];
#pragma unroll
        for (int q = 0; q < 4; ++q) { const int c = 4 * lane + 256 * q; y[q] = ld_bf4(Y + (size_t)m * D + c) + ld_bf4(Y + ((size_t)NTOK + m) * D + c);
            v[q] = ld_bf4(RKV + (size_t)m * 3072 + 2048 + c); g[q] = ld_bf4(H + (size_t)m * D + c);
            bs[q] = BS[(size_t)m * 16 + (lane >> 4) + 4 * q] + BS[((size_t)NTOK + m) * 16 + (lane >> 4) + 4 * q]; }
#pragma unroll
        for (int q = 0; q < 4; ++q) s[q] = (y[q][0] + y[q][1]) + (y[q][2] + y[q][3]);
        row16_sum4(s[0], s[1], s[2], s[3]);
#pragma unroll
        for (int q = 0; q < 4; ++q) { const float mean = s[q] * (1.0f / 64.0f); y[q] = y[q] - mean; qv[q] = (y[q][0] * y[q][0] + y[q][1] * y[q][1]) + (y[q][2] * y[q][2] + y[q][3] * y[q][3]); }
        row16_sum4(qv[0], qv[1], qv[2], qv[3]);
#pragma unroll
        for (int q = 0; q < 4; ++q) { const float ri = 1.0f / sqrtf(qv[q] * (1.0f / 64.0f) + 64e-5f); const f32x4 o = ((y[q] * ri) * l0[q] + l1[q] + v[q] * bs[q]) * g[q];
            *(v2u*)(H + (size_t)m * D + 4 * lane + 256 * q) = (v2u){pk2(o[0], o[1]), pk2(o[2], o[3])}; }
    }
}

enum Kind { K_PRO = 0, K_NORM0 = 1, K_QKV = 2, K_APOST = 3, K_ATTN = 4, K_ACOMB = 5, K_MIXOUT = 6, K_RNORM = 7, K_MLP1 = 8, K_MLP2 = 9, K_REND = 10,
            K_RMIX = 11, K_RKV = 12, K_RPREP = 13, K_RSCAN = 14, K_RPOST = 15, K_RENDMIX = 16 };
constexpr int NPH = 36;
#ifndef PROBE_MASK
#define PROBE_MASK 0
#endif
#ifndef PROBE_REPS
#define PROBE_REPS 1
#endif
template <int KIND, int LAYER>
__device__ __forceinline__ void run_phase(const Args& a, LAS unsigned char* lds, int G, int bx, int vcu, int wave_s, int rep) {
    Ids id; { int lv; asm volatile("v_mbcnt_lo_u32_b32 %0, -1, 0\n\tv_mbcnt_hi_u32_b32 %0, -1, %0" : "=v"(lv)); int zz; asm volatile("s_mov_b32 %0, 0" : "=s"(zz)); id.lane = lv; id.z = zz; }
    id.wave = wave_s; id.tid = wave_s * 64 + id.lane; id.gw = vcu * NWAVES + id.wave; id.ngw = G * NWAVES;
    constexpr int layer = LAYER;
    if constexpr (KIND == K_PRO) ph_prologue(a, id, lds);
    else if constexpr (KIND == K_NORM0) ph_norm0(a, id);
    else if constexpr (KIND == K_QKV) {
        constexpr int j = layer >> 1;
        pg8::Gemm g{(const bf16*)(a.ws + id.z + A_H), (const bf16*)(a.ws + id.z + W_WINT), NTOK, NQKV, D}; pg8::StaticOrder S; S.init(NTOK, NQKV, G, bx);
        const float* RC = (const float*)(a.ws + id.z + WS_ROPE);
        pg8::EpiQkv<QkvMap> E{a.ws + id.z, a.out + id.z, a.in[14 + id.z] + j * 128, RC, RC + 2048 * 64, j};
        pg8::gemm_phase<pg8::EpiQkv<QkvMap>, pg8::StaticOrder, true, true>(lds + RING_OFF, g, S, E, id.wave);
        { Ids id2 = id; int lv; asm volatile("v_mbcnt_lo_u32_b32 %0, -1, 0\n\tv_mbcnt_hi_u32_b32 %0, -1, %0" : "=v"(lv)); int zz; asm volatile("s_mov_b32 %0, 0" : "=s"(zz));
          id2.lane = lv; id2.z = zz; id2.tid = id.wave * 64 + lv;
          if (G == 256) { if (bx >= 64) { id2.gw = (bx - 64) * NWAVES + id.wave; id2.ngw = 192 * NWAVES; ph_att_cache(a, id2, layer); conv_weights(a, id2, lds, layer, 2); } }
          else { ph_att_cache(a, id2, layer); conv_weights(a, id2, lds, layer, 2); } }
    }
    else if constexpr (KIND == K_MIXOUT) {
        pg8::Gemm g{(const bf16*)(a.ws + id.z + A_H), (const bf16*)(a.ws + id.z + ((layer & 1) ? W_WOT : W_WOUTT)), NTOK, D, D}; pg8::StaticOrder S; S.init(NTOK, D, G, bx);
        pg8::EpiBf16<0> E{(bf16*)(a.ws + id.z + A_M), D, 1 << 20, nullptr, 0};
        pg8::gemm_phase<pg8::EpiBf16<0>, pg8::StaticOrder, true, true>(lds + RING_OFF, g, S, E, id.wave);
    }
    else if constexpr (KIND == K_MLP2) {
        pg8::Gemm g{(const bf16*)(a.ws + id.z + A_HID), (const bf16*)(a.ws + id.z + W_W2T), NTOK, D, FF}; pg8::StaticOrder S; S.init(NTOK, D, G, bx);
        pg8::EpiBf16<0> E{(bf16*)(a.ws + id.z + A_F), D, 1 << 20, nullptr, 0};
        pg8::gemm_phase<pg8::EpiBf16<0>, pg8::StaticOrder, true, true>(lds + RING_OFF, g, S, E, id.wave);
    }
    else if constexpr (KIND == K_MLP1) {
        pg8::Gemm g{(const bf16*)(a.ws + id.z + A_H), (const bf16*)(a.ws + id.z + W_W1T), NTOK, FF, D}; pg8::StaticOrder S; S.init(NTOK, FF, G, bx);
        pg8::EpiBf16<2> E{(bf16*)(a.ws + id.z + A_HID), FF, 1 << 20, nullptr, 0};
        pg8::gemm_phase<pg8::EpiBf16<2>, pg8::StaticOrder, true, true>(lds + RING_OFF, g, S, E, id.wave);
    }
    else if constexpr (KIND == K_RKV) {
        {
            pg8::Gemm g{(const bf16*)(a.ws + id.z + A_A2), (const bf16*)(a.ws + id.z + W_BTL), NTOK, 512, KRKV}; pg8::StaticOrder S; S.init(NTOK, 512, G, bx);
            pg8::EpiL1 E{(bf16*)(a.ws + id.z + A_L1)};
            pg8::gemm_phase<pg8::EpiL1, pg8::StaticOrder, true, true>(lds + RING_OFF, g, S, E, id.wave); }
        {
            pg8::Gemm g{(const bf16*)(a.ws + id.z + A_XS), (const bf16*)(a.ws + id.z + W_BTR), 3 * NTOK, 3072, D}; pg8::RkvOrder S{bx};
            pg8::EpiRkv3 E{(bf16*)(a.ws + id.z + A_RKV)};
            pg8::gemm_phase<pg8::EpiRkv3, pg8::RkvOrder, true, true>(lds + RING_OFF, g, S, E, id.wave); }
    }
    else if constexpr (KIND == K_RPREP) {
        constexpr int j = layer >> 1;
        static_assert(A_A1 - A_A0 == 32 * MiB && A_EW0 - A_A0 == 64 * MiB && A_EW1 - A_A0 == 96 * MiB, "EpiLora2 output stride");
        pg8::EpiLora2 E{(bf16*)(a.ws + id.z + A_A0), (size_t)16 * MiB, (bf16*)(a.ws + id.z + A_G), a.in[23 + id.z] + (size_t)j * 2 * D, a.in[20 + id.z] + (size_t)j * 2 * D};
        lora2_phase(lds + RING_OFF, (const bf16*)(a.ws + id.z + A_L1), (const bf16*)(a.ws + id.z + W_BT2), E, G, bx, id);
        { Ids id2 = id; int lv; asm volatile("v_mbcnt_lo_u32_b32 %0, -1, 0\n\tv_mbcnt_hi_u32_b32 %0, -1, %0" : "=v"(lv)); int zz; asm volatile("s_mov_b32 %0, 0" : "=s"(zz));
          id2.lane = lv; id2.z = zz; id2.tid = id.wave * 64 + lv; ph_rw_prep(a, id2, layer); }
    }
    else if constexpr (KIND == K_ATTN) ph_attn(a, id, lds, G, vcu);
    else if constexpr (KIND == K_ACOMB) ph_att_comb(a, id, layer);
    else if constexpr (KIND == K_RNORM) ph_resid_norm(a, id, layer, rep + 1 < (((PROBE_MASK >> K_RNORM) & 1) ? PROBE_REPS : 1));
    else if constexpr (KIND == K_REND) ph_resid_end(a, id, lds, layer, rep + 1 < (((PROBE_MASK >> K_REND) & 1) ? PROBE_REPS : 1));
    else if constexpr (KIND == K_RMIX) ph_rw_mix(a, id, layer);
    else if constexpr (KIND == K_RENDMIX) ph_rend_mix(a, id, lds, layer);
    else if constexpr (KIND == K_RSCAN) { if (rep > 0) { ph_rw_prep(a, id, layer); __syncthreads(); cg::this_grid().sync(); } ph_rw_scan(a, id, lds, layer, G, vcu); }
    else if constexpr (KIND == K_RPOST) ph_rw_post(a, id, layer);
}

__global__ void __launch_bounds__(NWAVES * 64, 2) mega_fwd(Args a) {
    extern __shared__ __attribute__((aligned(16))) unsigned char lds_raw[];
    LAS unsigned char* lds = (LAS unsigned char*)lds_raw;
    const int G = gridDim.x, bx = blockIdx.x; const int vcu = (G % 8 == 0) ? (bx % 8) * (G / 8) + bx / 8 : bx;
    volatile LAS unsigned* MISC = (volatile LAS unsigned*)(lds + MISC_OFF);
    for (int u = threadIdx.x; u < (LDS_BYTES - LDSCTL_OFF) / 4; u += NWAVES * 64) ((LAS unsigned*)(lds + LDSCTL_OFF))[u] = 0u;
    __syncthreads();
#if MK_N_LAUNCHES == 1 && !MK_CG_BARRIER
    XcdBarrier bar = xcd_barrier_post((unsigned*)(a.ws + WS_CTL) + CW_BAR, MISC + 8, threadIdx.x == 0);
#endif
    (void)MISC;
    const int lo = a.ph_lo, hi = a.ph_hi;
    const int wave_s = __builtin_amdgcn_readfirstlane(threadIdx.x >> 6);
#if MK_N_LAUNCHES == 1
#if MK_CG_BARRIER
#define GRID_BAR(ph) cg::this_grid().sync()
#else
#define GRID_BAR(ph) do { if ((ph) == 0) cg::this_grid().sync(); else { int l_; asm volatile("v_mbcnt_lo_u32_b32 %0, -1, 0\n\tv_mbcnt_hi_u32_b32 %0, -1, %0" : "=v"(l_)); xcd_barrier(bar, wave_s == 0 && l_ == 0); } } while (0)
#endif
#else
#define GRID_BAR(ph) do { } while (0)
#endif
#define PHASE(ph, KIND, LAYER) do { if (lo <= (ph) && (ph) < hi) { constexpr int nrep_ = ((PROBE_MASK >> (KIND)) & 1) ? PROBE_REPS : 1; \
        _Pragma("unroll 1") for (int rep_ = 0; rep_ < nrep_; ++rep_) { run_phase<KIND, LAYER>(a, lds, G, bx, vcu, wave_s, rep_); if (rep_ + 1 < nrep_) { __syncthreads(); cg::this_grid().sync(); } } \
        if ((ph) + 1 < hi) GRID_BAR(ph); } } while (0)
#define ATTN_LAYER(p0, L) PHASE((p0) + 0, K_QKV, L); PHASE((p0) + 1, K_ATTN, L); PHASE((p0) + 2, K_ACOMB, L); PHASE((p0) + 3, K_MIXOUT, L); \
        PHASE((p0) + 4, K_RNORM, L); PHASE((p0) + 5, K_MLP1, L); PHASE((p0) + 6, K_MLP2, L); PHASE((p0) + 7, K_RENDMIX, L)
#define RWKV_LAYER(p0, L) PHASE((p0) + 0, K_RKV, L); PHASE((p0) + 1, K_RPREP, L); PHASE((p0) + 2, K_RSCAN, L); PHASE((p0) + 3, K_RPOST, L); PHASE((p0) + 4, K_MIXOUT, L); \
        PHASE((p0) + 5, K_RNORM, L); PHASE((p0) + 6, K_MLP1, L); PHASE((p0) + 7, K_MLP2, L); PHASE((p0) + 8, K_REND, L)
    PHASE(0, K_PRO, 0); PHASE(1, K_NORM0, 0);
    ATTN_LAYER(2, 0); RWKV_LAYER(10, 1); ATTN_LAYER(19, 2); RWKV_LAYER(27, 3);
#undef PHASE
#undef ATTN_LAYER
#undef RWKV_LAYER
#undef GRID_BAR
}

extern "C" void kernel_launch(void* const* d_in, const int* in_sizes, int n_in, void* d_out, int out_size, void* d_ws, size_t ws_size, hipStream_t stream) {
    static int grid = 0;
    if (grid == 0) {
        if (n_in != 32 || (size_t)out_size != OUT_TOTAL || ws_size < WS_END) { fprintf(stderr, "kernel_launch: unexpected problem (n_in %d, out %d, ws %zu; need ws >= %zu); nothing launched\n", n_in, out_size, ws_size, (size_t)WS_END); grid = -1; return; }
        int dev = 0, cus = 0, per_cu = 0;
        if (hipGetDevice(&dev) != hipSuccess || hipDeviceGetAttribute(&cus, hipDeviceAttributeMultiprocessorCount, dev) != hipSuccess) { grid = -1; return; }
        if (hipFuncSetAttribute((const void*)mega_fwd, hipFuncAttributeMaxDynamicSharedMemorySize, LDS_BYTES) != hipSuccess) { fprintf(stderr, "kernel_launch: hipFuncSetAttribute failed\n"); grid = -1; return; }
        if (hipOccupancyMaxActiveBlocksPerMultiprocessor(&per_cu, (const void*)mega_fwd, NWAVES * 64, LDS_BYTES) != hipSuccess || per_cu < 1) { fprintf(stderr, "kernel_launch: occupancy query failed (%d)\n", per_cu); (void)hipGetLastError(); per_cu = 1; }
        grid = cus * (per_cu < 1 ? 1 : 1);
        fprintf(stderr, "kernel_launch: %d CUs, occupancy %d/CU, grid %d\n", cus, per_cu, grid);
    }
    if (grid < 0) return;
    (void)in_sizes;
    if (hipMemsetAsync((char*)d_ws + WS_CTL, 0, CTL_ZERO_BYTES, stream) != hipSuccess) { fprintf(stderr, "kernel_launch: memset failed\n"); return; }
    Args a{};
    for (int i = 0; i < 32; ++i) a.in[i] = (const float*)d_in[i];
    a.out = (float*)d_out; a.ws = (unsigned char*)d_ws;
#if MK_N_LAUNCHES == 1
    a.ph_lo = 0; a.ph_hi = NPH;
    void* args[] = {&a};
    hipError_t e = hipLaunchCooperativeKernel((const void*)mega_fwd, dim3(grid), dim3(NWAVES * 64), args, LDS_BYTES, stream);
    if (e != hipSuccess) fprintf(stderr, "kernel_launch: cooperative launch failed: %s (grid %d)\n", hipGetErrorString(e), grid);
#else
    for (int ph = 0; ph < NPH; ++ph) {
        a.ph_lo = ph; a.ph_hi = ph + 1;
        hipLaunchKernelGGL(mega_fwd, dim3(grid), dim3(NWAVES * 64), LDS_BYTES, stream, a);
    }
#endif
}
```

```cpp
#include <hip/hip_runtime.h>
#include <hip/hip_cooperative_groups.h>
#include <cstdio>
#include <cstdint>
namespace cg = cooperative_groups;
namespace pg8 {
#define PG8_LAS __attribute__((address_space(3)))
typedef unsigned short bf16_t;
typedef short bf16x8 __attribute__((ext_vector_type(8)));
typedef float f32x4 __attribute__((ext_vector_type(4)));
typedef unsigned u32x4 __attribute__((ext_vector_type(4)));
constexpr int BM = 256, BK = 64, HALF = 128, HTB = HALF * BK * 2  , STAGE_BYTES = 8 * HTB, NXCD = 8, WGM = 8;

__host__ __device__ __forceinline__ int lds_byte(int r, int c) { const int st = (r >> 4) * 2 + (c >> 5), rr = r & 15, cc = c & 31, ob = rr * 64 + cc * 2; return st * 1024 + (ob ^ (((ob >> 9) & 1) << 5)); }
__host__ __device__ __forceinline__ void stage_rc(int b, int& R, int& C) { const int st = b / 1024, sb = b % 1024, swz = sb ^ (((sb >> 9) & 1) << 5); R = (st >> 1) * 16 + swz / 64; C = (st & 1) * 32 + (swz % 64) / 2; }
__host__ __device__ __forceinline__ int perm32(int rho) { const int n = rho >> 4, i = rho & 15; return 8 * (i >> 2) + 4 * n + (i & 3); }

struct Unit { int pm, pn; };
struct Gemm { const bf16_t* A; const bf16_t* Bt; int M, N, K; };

struct StaticOrder {
    int nM, nN, nwg, G, c;
    __host__ __device__ void init(int M, int N, int G_, int c_) { nM = M / BM; nN = N / BM; nwg = nM * nN; G = G_; c = c_; }
    __host__ __device__ bool next(int i, Unit& u) const {
        const long L = (long)i * G + c; if (L >= nwg) return false;
        int wgid = (int)L; { const int q = nwg / NXCD, r = nwg % NXCD, xcd = wgid % NXCD, off = wgid / NXCD; wgid = (xcd < r ? xcd * (q + 1) : r * (q + 1) + (xcd - r) * q) + off; }
        const int nig = WGM * nN, gid = wgid / nig, fm = gid * WGM, gsz = (nM - fm) < WGM ? (nM - fm) : WGM;
        u.pm = fm + ((wgid % nig) % gsz); u.pn = (wgid % nig) / gsz; return true;
    }
    __device__ __forceinline__ void a_ready(const Unit&) const {}
    __device__ __forceinline__ void done(const Unit&) const {}
};


__device__ __forceinline__ unsigned cvt_pk_bf16(float lo, float hi) { unsigned r; asm volatile("v_cvt_pk_bf16_f32 %0, %1, %2" : "=v"(r) : "v"(lo), "v"(hi)); return r; }

template <int ACT> struct EpiBf16 {
    static constexpr bool PERM = true, AFTER_DRAIN = false;
    bf16_t* O0; int ld0; int nt0; bf16_t* O1; int ld1;
    __device__ __forceinline__ void operator()(const f32x4 (&acc)[2][2][4][2], const Unit& u, int wr, int wc, int fr, int fq) const {
        const int row0 = u.pm * BM + wr * 64 + fr;
        bf16_t* base; int ldc, colt;
        if (u.pn < nt0) { base = O0; ldc = ld0; colt = u.pn * BM; } else { base = O1; ldc = ld1; colt = (u.pn - nt0) * BM; }
        const int col0 = colt + wc * 32 + 8 * fq;
#pragma unroll
        for (int ai = 0; ai < 2; ++ai)
#pragma unroll
            for (int m = 0; m < 4; ++m) { bf16_t* rowp = base + (size_t)(row0 + ai * HALF + m * 16) * ldc + col0;
#pragma unroll
                for (int bj = 0; bj < 2; ++bj) { f32x4 v0 = acc[ai][bj][m][0], v1 = acc[ai][bj][m][1];
                    if (ACT == 2) {
#pragma unroll
                        for (int e = 0; e < 4; ++e) { float a = v0[e] > 0.f ? v0[e] : 0.f; v0[e] = a * a; float b = v1[e] > 0.f ? v1[e] : 0.f; v1[e] = b * b; } }
                    u32x4 w; w.x = cvt_pk_bf16(v0[0], v0[1]); w.y = cvt_pk_bf16(v0[2], v0[3]); w.z = cvt_pk_bf16(v1[0], v1[1]); w.w = cvt_pk_bf16(v1[2], v1[3]);
                    *(u32x4*)(rowp + bj * HALF) = w; } }
    }
    __device__ __forceinline__ void fused(f32x4 (&)[2][2][4][2], const Unit&, int, int, int, int, PG8_LAS unsigned char*, int, int) const {}
};


__device__ __forceinline__ float sig_f(float x) { return 1.0f / (1.0f + __expf(-x)); }
struct RkvOrder {
    int c;
    __device__ __forceinline__ bool next(int i, Unit& u) const {
        int L; if (c < 128) { if (i >= 2) return false; L = c * 2 + i; } else { if (i >= 4) return false; L = 256 + (c - 128) * 4 + i; }
        const int which = L >> 8, r = L & 255; u.pm = which * 64 + (r >> 2); u.pn = which * 4 + (r & 3); return true; }
    __device__ __forceinline__ void a_ready(const Unit&) const {}
    __device__ __forceinline__ void done(const Unit&) const {}
};
struct EpiRkv3 {
    static constexpr bool PERM = true, AFTER_DRAIN = false;
    bf16_t* RKV;
    __device__ __forceinline__ void operator()(const f32x4 (&acc)[2][2][4][2], const Unit& u, int wr, int wc, int fr, int fq) const {
        const int row0 = (u.pm & 63) * BM + wr * 64 + fr, col0 = u.pn * BM + wc * 32 + 8 * fq;
#pragma unroll
        for (int ai = 0; ai < 2; ++ai)
#pragma unroll
            for (int m = 0; m < 4; ++m) { bf16_t* rowp = RKV + (size_t)(row0 + ai * HALF + m * 16) * 3072 + col0;
#pragma unroll
                for (int bj = 0; bj < 2; ++bj) { const f32x4 v0 = acc[ai][bj][m][0], v1 = acc[ai][bj][m][1];
                    u32x4 w; w.x = cvt_pk_bf16(v0[0], v0[1]); w.y = cvt_pk_bf16(v0[2], v0[3]); w.z = cvt_pk_bf16(v1[0], v1[1]); w.w = cvt_pk_bf16(v1[2], v1[3]);
                    *(u32x4*)(rowp + bj * HALF) = w; } }
    }
};
struct EpiL1 {
    static constexpr bool PERM = true, AFTER_DRAIN = false;
    bf16_t* L1;
    __device__ __forceinline__ void operator()(const f32x4 (&acc)[2][2][4][2], const Unit& u, int wr, int wc, int fr, int fq) const {
        const int row0 = u.pm * BM + wr * 64 + fr, colt = u.pn * BM, col0 = colt + wc * 32 + 8 * fq;
#pragma unroll
        for (int ai = 0; ai < 2; ++ai)
#pragma unroll
            for (int m = 0; m < 4; ++m) { bf16_t* rowp = L1 + (size_t)(row0 + ai * HALF + m * 16) * 384 + col0;
#pragma unroll
                for (int bj = 0; bj < 2; ++bj) { f32x4 v0 = acc[ai][bj][m][0], v1 = acc[ai][bj][m][1];
                    const int cb = colt + bj * HALF;
                    if (cb >= 384) continue;
                    if (cb == 0) {
#pragma unroll
                        for (int e = 0; e < 4; ++e) { v0[e] = 1.0f - 2.0f / (1.0f + __expf(2.0f * v0[e])); v1[e] = 1.0f - 2.0f / (1.0f + __expf(2.0f * v1[e])); } }
                    else if (cb == 256) {
#pragma unroll
                        for (int e = 0; e < 4; ++e) { v0[e] = sig_f(v0[e]); v1[e] = sig_f(v1[e]); } }
                    u32x4 w; w.x = cvt_pk_bf16(v0[0], v0[1]); w.y = cvt_pk_bf16(v0[2], v0[3]); w.z = cvt_pk_bf16(v1[0], v1[1]); w.w = cvt_pk_bf16(v1[2], v1[3]);
                    *(u32x4*)(rowp + bj * HALF) = w; } }
    }
};
struct EpiLora2 {
    static constexpr bool PERM = true, AFTER_DRAIN = false;
    bf16_t* o4; size_t ostride; bf16_t* og; const float* a0; const float* w0;
    __device__ __forceinline__ void operator()(const f32x4 (&acc)[2][2][4][2], const Unit& u, int wr, int wc, int fr, int fq) const {
        const int row0 = u.pm * BM + wr * 64 + fr; const int blk = u.pn >> 2, colt = (u.pn & 3) * BM;
        bf16_t* base = (blk < 4) ? o4 + (size_t)blk * ostride : og;
        const float* bs = ((blk < 2) ? a0 : w0) + (blk & 1) * 1024;
        const int col0 = colt + wc * 32 + 8 * fq;
        const float sc = (blk >= 2) ? 0.8750387749719753f : 1.0f;
#pragma unroll
        for (int bj = 0; bj < 2; ++bj) {
            f32x4 b0 = (f32x4){0.f, 0.f, 0.f, 0.f}, b1 = b0;
            if (blk < 4) { b0 = *(const f32x4*)(bs + col0 + bj * HALF); b1 = *(const f32x4*)(bs + col0 + bj * HALF + 4); }
#pragma unroll
            for (int ai = 0; ai < 2; ++ai)
#pragma unroll
                for (int m = 0; m < 4; ++m) { bf16_t* rowp = base + (size_t)(row0 + ai * HALF + m * 16) * 1024 + col0;
                    f32x4 v0 = acc[ai][bj][m][0] + b0, v1 = acc[ai][bj][m][1] + b1;
                    if (blk < 4) {
#pragma unroll
                        for (int e = 0; e < 4; ++e) { v0[e] = sc * sig_f(v0[e]); v1[e] = sc * sig_f(v1[e]); } }
                    u32x4 w; w.x = cvt_pk_bf16(v0[0], v0[1]); w.y = cvt_pk_bf16(v0[2], v0[3]); w.z = cvt_pk_bf16(v1[0], v1[1]); w.w = cvt_pk_bf16(v1[2], v1[3]);
                    *(u32x4*)(rowp + bj * HALF) = w; } }
    }
};


template <class MP> struct EpiQkv {
    static constexpr bool PERM = true, AFTER_DRAIN = false;
    unsigned char* ws; float* out; const float* gain; const float* RC; const float* RS; int j;
    static constexpr size_t oQA = MP::oQA, oQB = MP::oQB, oKAP = MP::oKAP, oVAP = MP::oVAP, oKBP = MP::oKBP, oVBP = MP::oVBP, oKAS = MP::oKAS, oVAS = MP::oVAS, oKBS = MP::oKBS, oVBS = MP::oVBS;
    static constexpr size_t oKG = MP::oKG, oVG = MP::oVG, oKD = MP::oKD, oVD = MP::oVD;
    __device__ __forceinline__ void operator()(const f32x4 (&acc)[2][2][4][2], const Unit& u, int wr, int wc, int fr, int fq) const {
        const int ch = 4 * u.pn + wc; const bool smp = u.pm >= 32;
        const bool isq = (ch < 8) || (ch >= 12 && ch < 20), isk = (ch == 8 || ch == 9) || (ch >= 20 && ch < 28);
        const int dl = 8 * fq;
        const bool hi2 = (fq & 2) != 0;
        f32x4 g[2][2];
#pragma unroll
        for (int bj = 0; bj < 2; ++bj)
#pragma unroll
            for (int n = 0; n < 2; ++n) g[bj][n] = (ch < 10) ? *(const f32x4*)(gain + (ch < 8 ? 0 : 64) + bj * 32 + dl + 4 * n) : (f32x4){1.f, 1.f, 1.f, 1.f};
        constexpr float QS = 0.18033688011112042f;
#pragma unroll
        for (int ai = 0; ai < 2; ++ai)
#pragma unroll
            for (int m = 0; m < 4; ++m) {
                const int mrow = u.pm * BM + ai * HALF + wr * 64 + m * 16 + fr;
                const int b = smp ? ((mrow - 8192) >> 11) : (mrow >> 8), t = smp ? ((mrow - 8192) & 2047) : (mrow & 255);
                f32x4 v[2][2];
#pragma unroll
                for (int bj = 0; bj < 2; ++bj)
#pragma unroll
                    for (int n = 0; n < 2; ++n) v[bj][n] = acc[ai][bj][m][n];
                if (ch < 10) { float ss = 0.f;
#pragma unroll
                    for (int bj = 0; bj < 2; ++bj)
#pragma unroll
                        for (int n = 0; n < 2; ++n) ss += (v[bj][n][0] * v[bj][n][0] + v[bj][n][1] * v[bj][n][1]) + (v[bj][n][2] * v[bj][n][2] + v[bj][n][3] * v[bj][n][3]);
                    ss += __shfl_xor(ss, 16); ss += __shfl_xor(ss, 32);
                    const float ri = 1.0f / sqrtf(ss * (1.0f / 64.0f) + 1e-6f);
#pragma unroll
                    for (int bj = 0; bj < 2; ++bj)
#pragma unroll
                        for (int n = 0; n < 2; ++n) v[bj][n] = v[bj][n] * ri * g[bj][n]; }
                f32x4 vr[2][2];
#pragma unroll
                for (int bj = 0; bj < 2; ++bj)
#pragma unroll
                    for (int n = 0; n < 2; ++n) { vr[bj][n] = v[bj][n];
                        if (smp && (isq || isk)) { f32x4 p; p[0] = __shfl_xor(v[bj][n][0], 32); p[1] = __shfl_xor(v[bj][n][1], 32); p[2] = __shfl_xor(v[bj][n][2], 32); p[3] = __shfl_xor(v[bj][n][3], 32);
                            const f32x4 cs = *(const f32x4*)(RC + t * 64 + bj * 32 + dl + 4 * n), sn = *(const f32x4*)(RS + t * 64 + bj * 32 + dl + 4 * n);
                            const f32x4 rot = hi2 ? p : -p; vr[bj][n] = v[bj][n] * cs + rot * sn; } }
#define EQ_PK8(x0, x1) ((u32x4){cvt_pk_bf16((x0)[0], (x0)[1]), cvt_pk_bf16((x0)[2], (x0)[3]), cvt_pk_bf16((x1)[0], (x1)[1]), cvt_pk_bf16((x1)[2], (x1)[3])})
                const size_t srow = (size_t)(b * 2560 + 512 + t), prow = (size_t)((b * 2 + j) * 256 + t);
#pragma unroll
                for (int bj = 0; bj < 2; ++bj) {
                    const int f0 = bj * 32 + dl;
                    if (isq) { const f32x4 s0 = vr[bj][0] * QS, s1 = vr[bj][1] * QS; const size_t o = (ch < 8) ? oQA + ((size_t)mrow * 512 + ch * 64 + f0) * 2 : oQB + ((size_t)mrow * 512 + (ch - 12) * 64 + f0) * 2;
                        *(u32x4*)(ws + o) = EQ_PK8(s0, s1); }
                    else {
                        const bool gq = ch < 12, kk = isk;
                        const int e = gq ? ((ch & 1) * 64 + f0) : ((ch - (kk ? 20 : 28)) * 64 + f0); const int wdt = gq ? 128 : 512;
                        if (!smp) { const size_t of = (gq ? (kk ? oKG : oVG) : (kk ? oKD : oVD)) + prow * wdt + e; *(f32x4*)(out + of) = v[bj][0]; *(f32x4*)(out + of + 4) = v[bj][1];
                            const size_t o = (gq ? (kk ? oKAP : oVAP) : (kk ? oKBP : oVBP)) + ((size_t)mrow * wdt + e) * 2; *(u32x4*)(ws + o) = EQ_PK8(v[bj][0], v[bj][1]); }
                        else { const size_t o = (gq ? (kk ? oKAS : oVAS) : (kk ? oKBS : oVBS)) + (srow * wdt + e) * 2; *(u32x4*)(ws + o) = EQ_PK8(vr[bj][0], vr[bj][1]); } }
                }
#undef EQ_PK8
            }
    }
};

template <class Epi, class Sched, bool ALIGN_EPI = false, bool SP2 = false>
__device__ __forceinline__ void gemm_phase(PG8_LAS unsigned char* lds, const Gemm g, const Sched& S, const Epi& E, const int wave_index) {
    int lane_o; asm volatile("v_mbcnt_lo_u32_b32 %0, -1, 0\n\tv_mbcnt_hi_u32_b32 %0, -1, %0" : "=v"(lane_o));
    const int wid = wave_index, lane = lane_o, tid = wid * 64 + lane, wr = wid >> 2, wc = wid & 3, fr = lane & 15, fq = lane >> 4;
    const int K = g.K, nt = K / BK;
    unsigned voffA[2], voffB[2];
#pragma unroll
    for (int i = 0; i < 2; ++i) { int R, C; stage_rc(tid * 16 + i * 8192, R, C); const int Rb = Epi::PERM ? ((R & ~31) + perm32(R & 31)) : R;
        voffA[i] = (unsigned)(R * K + C) * 2u; voffB[i] = (unsigned)(Rb * K + C) * 2u; }
    const size_t kstep = (size_t)(BK * 2);
    const size_t hstep = (size_t)HALF * K * 2;
    const size_t tstep = 2 * hstep;
    const unsigned ldsw = (unsigned)wid * 1024u;
    const int aoff = lds_byte(wr * 64 + fr, fq * 8), boff = lds_byte(wc * 32 + fr, fq * 8);
#define PG8_SA(b, h) (((b) * 2 + (h)) * HTB)
#define PG8_SB(b, h) ((4 + (b) * 2 + (h)) * HTB)
#define PG8_STAGE(bufoff, gbase, voff) do { _Pragma("unroll") for (int _i = 0; _i < 2; ++_i) \
        __builtin_amdgcn_global_load_lds((const unsigned*)((const char*)(gbase) + (voff)[_i]), (PG8_LAS unsigned*)(lds + (bufoff) + ldsw + _i * 8192), 16, 0, 0); } while (0)
#define PG8_LDA(dst, b, h) do { _Pragma("unroll") for (int m = 0; m < 4; ++m) _Pragma("unroll") for (int k = 0; k < 2; ++k) dst[m][k] = *(const PG8_LAS bf16x8*)(lds + PG8_SA(b, h) + aoff + m * 2048 + k * 1024); } while (0)
#define PG8_LDB(dst, b, h) do { _Pragma("unroll") for (int n = 0; n < 2; ++n) _Pragma("unroll") for (int k = 0; k < 2; ++k) dst[n][k] = *(const PG8_LAS bf16x8*)(lds + PG8_SB(b, h) + boff + n * 2048 + k * 1024); } while (0)
#define PG8_MMA(ai, bj, At, Bt) do { __builtin_amdgcn_s_setprio(1); _Pragma("unroll") for (int m = 0; m < 4; ++m) _Pragma("unroll") for (int n = 0; n < 2; ++n) _Pragma("unroll") for (int k = 0; k < 2; ++k) \
        acc[ai][bj][m][n] = __builtin_amdgcn_mfma_f32_16x16x32_bf16(Bt[n][k], At[m][k], acc[ai][bj][m][n], 0, 0, 0); __builtin_amdgcn_s_setprio(0); } while (0)
#define PG8_WAIT_V(n) asm volatile("s_waitcnt vmcnt(" #n ")" ::: "memory")
#define PG8_WAIT_L(n) asm volatile("s_waitcnt lgkmcnt(" #n ")" ::: "memory")
#define PG8_BAR __builtin_amdgcn_s_barrier()
#define PG8_SCHED __builtin_amdgcn_sched_barrier(0)
    Unit cur, nxt; int ui = 0;
    if (!S.next(0, cur)) return;
    f32x4 acc[2][2][4][2];
#pragma unroll
    for (int a = 0; a < 2; ++a)
#pragma unroll
        for (int b = 0; b < 2; ++b)
#pragma unroll
            for (int m = 0; m < 4; ++m)
#pragma unroll
                for (int n = 0; n < 2; ++n) acc[a][b][m][n] = (f32x4){0.f, 0.f, 0.f, 0.f};
    bf16x8 At[4][2], B0[2][2], B1[2][2];
    const char* cA = (const char*)g.A + (size_t)cur.pm * tstep; const char* cB = (const char*)g.Bt + (size_t)cur.pn * tstep;
    S.a_ready(cur);
    if constexpr (SP2) {
        PG8_STAGE(PG8_SB(0, 0), cB, voffB); PG8_STAGE(PG8_SB(0, 1), cB + hstep, voffB); PG8_STAGE(PG8_SA(0, 0), cA, voffA); PG8_STAGE(PG8_SA(0, 1), cA + hstep, voffA);
        if (wr == 1) PG8_BAR;
        PG8_WAIT_V(2); PG8_BAR;
        PG8_STAGE(PG8_SB(1, 0), cB + kstep, voffB); PG8_STAGE(PG8_SA(1, 0), cA + kstep, voffA); PG8_STAGE(PG8_SB(1, 1), cB + hstep + kstep, voffB);
        PG8_WAIT_V(6); PG8_BAR;
    } else {
        PG8_STAGE(PG8_SB(0, 0), cB, voffB); PG8_STAGE(PG8_SA(0, 0), cA, voffA); PG8_STAGE(PG8_SB(0, 1), cB + hstep, voffB); PG8_STAGE(PG8_SA(0, 1), cA + hstep, voffA);
        if (wr == 1) PG8_BAR;
        PG8_WAIT_V(4); PG8_BAR;
        PG8_STAGE(PG8_SB(1, 0), cB + kstep, voffB); PG8_STAGE(PG8_SA(1, 0), cA + kstep, voffA); PG8_STAGE(PG8_SB(1, 1), cB + hstep + kstep, voffB);
        PG8_WAIT_V(6); PG8_BAR;
    }
    for (;;) {
        const bool has_next = S.next(ui + 1, nxt);
        const char* nA = has_next ? (const char*)g.A + (size_t)nxt.pm * tstep : cA; const char* nB = has_next ? (const char*)g.Bt + (size_t)nxt.pn * tstep : cB;
#pragma unroll 1
        for (int t = 0; t < nt; t += 2) {
            const bool last = (t == nt - 2);
            const char* a1 = cA + (size_t)(t + 1) * kstep;
            const char* a2 = last ? nA : cA + (size_t)(t + 2) * kstep; const char* b2 = last ? nB : cB + (size_t)(t + 2) * kstep;
            const char* a3 = a2 + kstep; const char* b3 = b2 + kstep;
            if (last && has_next) S.a_ready(nxt);
            if constexpr (SP2) {
            PG8_LDB(B0, 0, 0); PG8_LDB(B1, 0, 1); PG8_SCHED; PG8_LDA(At, 0, 0); PG8_STAGE(PG8_SA(1, 1), a1 + hstep, voffA);
            PG8_WAIT_V(8); PG8_WAIT_L(0); PG8_BAR; PG8_MMA(0, 0, At, B0); PG8_MMA(0, 1, At, B1); PG8_BAR; PG8_SCHED;
            PG8_LDA(At, 0, 1); PG8_STAGE(PG8_SB(0, 0), b2, voffB); PG8_STAGE(PG8_SB(0, 1), b2 + hstep, voffB); PG8_STAGE(PG8_SA(0, 0), a2, voffA);
            PG8_WAIT_V(8); PG8_WAIT_L(0); PG8_BAR; PG8_MMA(1, 0, At, B0); PG8_MMA(1, 1, At, B1); PG8_BAR; PG8_SCHED;
            PG8_LDB(B0, 1, 0); PG8_LDB(B1, 1, 1); PG8_SCHED; PG8_LDA(At, 1, 0); PG8_STAGE(PG8_SA(0, 1), a2 + hstep, voffA);
            PG8_WAIT_V(8); PG8_WAIT_L(0); PG8_BAR; PG8_MMA(0, 0, At, B0); PG8_MMA(0, 1, At, B1); PG8_BAR; PG8_SCHED;
            PG8_LDA(At, 1, 1); PG8_STAGE(PG8_SB(1, 0), b3, voffB); PG8_STAGE(PG8_SB(1, 1), b3 + hstep, voffB); PG8_STAGE(PG8_SA(1, 0), a3, voffA);
            PG8_WAIT_V(8); PG8_WAIT_L(0); PG8_BAR; PG8_MMA(1, 0, At, B0); PG8_MMA(1, 1, At, B1); PG8_BAR; PG8_SCHED;
            } else {
            PG8_LDB(B0, 0, 0); PG8_SCHED; PG8_LDA(At, 0, 0); PG8_STAGE(PG8_SA(1, 1), a1 + hstep, voffA);
            PG8_WAIT_L(8); PG8_BAR; PG8_WAIT_L(0); PG8_MMA(0, 0, At, B0); PG8_BAR; PG8_SCHED;
            PG8_LDB(B1, 0, 1); PG8_STAGE(PG8_SB(0, 0), b2, voffB);
            PG8_BAR; PG8_WAIT_L(0); PG8_MMA(0, 1, At, B1); PG8_BAR;
            PG8_LDA(At, 0, 1); PG8_STAGE(PG8_SA(0, 0), a2, voffA);
            PG8_BAR; PG8_WAIT_L(0); PG8_MMA(1, 0, At, B0); PG8_BAR; PG8_SCHED;
            PG8_STAGE(PG8_SB(0, 1), b2 + hstep, voffB);
            PG8_WAIT_V(6); PG8_BAR; PG8_MMA(1, 1, At, B1); PG8_BAR;
            PG8_LDB(B0, 1, 0); PG8_SCHED; PG8_LDA(At, 1, 0); PG8_STAGE(PG8_SA(0, 1), a2 + hstep, voffA);
            PG8_WAIT_L(8); PG8_BAR; PG8_WAIT_L(0); PG8_MMA(0, 0, At, B0); PG8_BAR; PG8_SCHED;
            PG8_LDB(B1, 1, 1); PG8_STAGE(PG8_SB(1, 0), b3, voffB);
            PG8_BAR; PG8_WAIT_L(0); PG8_MMA(0, 1, At, B1); PG8_BAR;
            PG8_LDA(At, 1, 1); PG8_STAGE(PG8_SA(1, 0), a3, voffA);
            PG8_BAR; PG8_WAIT_L(0); PG8_MMA(1, 0, At, B0); PG8_BAR; PG8_SCHED;
            PG8_STAGE(PG8_SB(1, 1), b3 + hstep, voffB);
            PG8_WAIT_V(6); PG8_BAR; PG8_MMA(1, 1, At, B1); PG8_BAR;
            }
        }
        if constexpr (ALIGN_EPI) { if (wr == 0) PG8_BAR; }
        if constexpr (!Epi::AFTER_DRAIN) { E(acc, cur, wr, wc, fr, fq); S.done(cur); }
        if (!has_next) break;
#pragma unroll
        for (int a = 0; a < 2; ++a)
#pragma unroll
            for (int b = 0; b < 2; ++b)
#pragma unroll
                for (int m = 0; m < 4; ++m)
#pragma unroll
                    for (int n = 0; n < 2; ++n) acc[a][b][m][n] = (f32x4){0.f, 0.f, 0.f, 0.f};
        cur = nxt; cA = nA; cB = nB; ++ui;
        if constexpr (ALIGN_EPI) { if (wr == 1) PG8_BAR; }
    }
    PG8_WAIT_V(0);
    if constexpr (!ALIGN_EPI) { if (wr == 0) PG8_BAR; }
    PG8_BAR;
    if constexpr (Epi::AFTER_DRAIN) { E.fused(acc, cur, wr, wc, fr, fq, lds, wid, lane); S.done(cur); }
#undef PG8_SA
#undef PG8_SB
#undef PG8_STAGE
#undef PG8_LDA
#undef PG8_LDB
#undef PG8_MMA
#undef PG8_WAIT_V
#undef PG8_WAIT_L
#undef PG8_BAR
#undef PG8_SCHED
}
}

#define GAS __attribute__((address_space(1)))
#define LAS __attribute__((address_space(3)))
typedef unsigned short bf16;
typedef unsigned v4u __attribute__((ext_vector_type(4)));
typedef unsigned v2u __attribute__((ext_vector_type(2)));
typedef float f32x4 __attribute__((ext_vector_type(4)));
#define LDS_WAIT() asm volatile("s_waitcnt lgkmcnt(0)" ::: "memory")

#ifndef MK_N_LAUNCHES
#define MK_N_LAUNCHES 1
#endif
#ifndef MK_CG_BARRIER
#define MK_CG_BARRIER 0
#endif

constexpr int D = 1024, NTOK = 16384, NPR = 8192, TP = 256, TS = 2048, PAST = 512, SKV = 2560, FF = 4096, DEPTH = 4;
constexpr int NQKV = 2304, NRKV = 3584, KRKV = 2048;
constexpr int NWAVES = 8;
constexpr size_t O_X = 0, O_KG = 16777216, O_VG = 18874368, O_KD = 20971520, O_VD = 29360128, O_ST = 37748736, OUT_TOTAL = 46137344;
constexpr size_t MiB = 1u << 20;
constexpr size_t WS_CTL = 0, CTL_ZERO_BYTES = 1 * MiB;
constexpr size_t WS_MOD = 65536;
constexpr size_t WS_ROPE = 1 * MiB;
constexpr size_t WS_INV = 2 * MiB;
constexpr size_t WS_W = 4 * MiB;
constexpr size_t W_W1T = WS_W, W_W2T = WS_W + 8 * MiB, W_MIX = WS_W + 16 * MiB;
constexpr size_t W_WINT = W_MIX, W_WOUTT = W_MIX + 6 * MiB;
constexpr size_t W_BTR = W_MIX, W_BTL = W_MIX + 6 * MiB, W_WOT = W_MIX + 14 * MiB, W_BT2 = W_MIX + 16 * MiB;
constexpr size_t AR = 40 * MiB;
constexpr size_t A_H = AR;
constexpr size_t A_QKVRAW = AR + 32 * MiB;
constexpr size_t A_DT = AR + 32 * MiB;
constexpr size_t A_M = AR + 96 * MiB;
constexpr size_t A_QA = AR + 176 * MiB, A_QB = AR + 192 * MiB, A_KAP = AR + 208 * MiB, A_VAP = AR + 210 * MiB, A_KBP = AR + 212 * MiB, A_VBP = AR + 220 * MiB;
constexpr size_t A_KAS = AR + 228 * MiB, A_VAS = AR + 231 * MiB, A_KBS = AR + 234 * MiB, A_VBS = AR + 244 * MiB;
constexpr size_t A_HID = AR + 32 * MiB;
constexpr size_t A_F = AR + 160 * MiB;
constexpr size_t A_A2 = AR + 32 * MiB;
constexpr size_t A_XS = AR + 208 * MiB;
constexpr size_t A_Y = AR + 32 * MiB;
constexpr size_t A_RKV = AR + 96 * MiB;
constexpr size_t A_L1 = AR + 192 * MiB;
constexpr size_t A_G = A_H;
constexpr size_t A_A0 = AR + 208 * MiB, A_A1 = AR + 240 * MiB, A_EW0 = AR + 272 * MiB, A_EW1 = AR + 304 * MiB;
constexpr size_t WS_END = AR + 336 * MiB;
struct QkvMap { static constexpr size_t oQA = A_QA, oQB = A_QB, oKAP = A_KAP, oVAP = A_VAP, oKBP = A_KBP, oVBP = A_VBP, oKAS = A_KAS, oVAS = A_VAS, oKBS = A_KBS, oVBS = A_VBS, oKG = O_KG, oVG = O_VG, oKD = O_KD, oVD = O_VD; };
constexpr int CW_BAR = 4096;

constexpr int RING_OFF = 0, RING_BYTES = 131072;
constexpr int LDSCTL_OFF = RING_BYTES, MISC_OFF = LDSCTL_OFF + 320;
constexpr int LDS_BYTES = 147456;

typedef float f32x2_t __attribute__((ext_vector_type(2))); typedef __bf16 bf16x2_t __attribute__((ext_vector_type(2)));
__device__ __forceinline__ unsigned pk2(float lo, float hi) { const f32x2_t v = {lo, hi}; return __builtin_bit_cast(unsigned, __builtin_convertvector(v, bf16x2_t)); }
__device__ __forceinline__ unsigned f2bf(float f) { return pk2(f, 0.f) & 0xffffu; }
__device__ __forceinline__ float bf2f(unsigned short h) { return __builtin_bit_cast(float, (unsigned)h << 16); }
__device__ __forceinline__ float bflo(unsigned w) { return __builtin_bit_cast(float, w << 16); }
__device__ __forceinline__ float bfhi(unsigned w) { return __builtin_bit_cast(float, w & 0xffff0000u); }
__device__ __forceinline__ float sigmoidf_(float x) { return 1.0f / (1.0f + __expf(-x)); }
__device__ __forceinline__ float rdl(float x, int l) { return __builtin_bit_cast(float, __builtin_amdgcn_readlane(__builtin_bit_cast(int, x), l)); }
__device__ __forceinline__ float wave_sum(float v) {
    asm("s_nop 1\n\tv_add_f32_dpp %0, %0, %0 row_ror:8 row_mask:0xf bank_mask:0xf\n\ts_nop 1\n\tv_add_f32_dpp %0, %0, %0 row_ror:4 row_mask:0xf bank_mask:0xf\n\ts_nop 1\n\t"
        "v_add_f32_dpp %0, %0, %0 row_ror:2 row_mask:0xf bank_mask:0xf\n\ts_nop 1\n\tv_add_f32_dpp %0, %0, %0 row_ror:1 row_mask:0xf bank_mask:0xf\n\ts_nop 1" : "+v"(v));
    return (rdl(v, 0) + rdl(v, 16)) + (rdl(v, 32) + rdl(v, 48));
}

#define XB_TMO      128
#define XB_XCNT(j)  (256  + 64 * (j))
#define XB_XSUB(j)  (1280 + 64 * (j))
#define XB_XGEN(j)  (2304 + 64 * (j))
#define XB_TOP      3328
#define XB_TOPGEN   3392
#define XCD_BAR_WORDS 3456
#define XB_SPIN_CAP (1u << 18)

__device__ __forceinline__ unsigned xb_ld(unsigned* p)              { return __hip_atomic_load(p, __ATOMIC_RELAXED, __HIP_MEMORY_SCOPE_AGENT); }
__device__ __forceinline__ unsigned xb_add(unsigned* p, unsigned v) { return __hip_atomic_fetch_add(p, v, __ATOMIC_RELAXED, __HIP_MEMORY_SCOPE_AGENT); }
__device__ __forceinline__ unsigned xb_xcc_id() { return (unsigned)__builtin_amdgcn_s_getreg((3 << 11) | 20) & 0xFu; }
#define XB_SPIN(cond, bar) do { unsigned _sp = 0; while (cond) { __builtin_amdgcn_s_sleep(1); \
    if ((++_sp & 255u) == 0u) { if (xb_ld(&(bar)[XB_TMO])) break; if (_sp > XB_SPIN_CAP) { atomicAdd(&(bar)[XB_TMO], 1u); break; } } } } while (0)

struct XcdBarrier {
    unsigned* bar; unsigned x;
    volatile LAS unsigned* st;
};

__device__ __forceinline__ XcdBarrier xcd_barrier_post(unsigned* bar, volatile LAS unsigned* st, bool leader) {
    XcdBarrier b; b.bar = bar; b.x = xb_xcc_id(); b.st = st;
    if (leader) (void)xb_add(&bar[XB_XCNT(b.x)], 1u);
    return b;
}
__device__ __forceinline__ void xcd_barrier_complete(unsigned* bar, unsigned x, unsigned& nloc, unsigned& nx) {
    const unsigned G = gridDim.x * gridDim.y * gridDim.z;
    unsigned sum, cnt, mine, sp = 0u;
    for (;;) {
        sum = 0u; cnt = 0u; mine = 0u;
#pragma unroll
        for (unsigned j = 0; j < 16; ++j) { const unsigned c = xb_ld(&bar[XB_XCNT(j)]); sum += c; cnt += (c > 0u) ? 1u : 0u; mine = (j == x) ? c : mine; }
        if (sum == G) break;
        __builtin_amdgcn_s_sleep(1);
        if ((++sp & 255u) == 0u) { if (xb_ld(&bar[XB_TMO])) break; if (sp > XB_SPIN_CAP) { atomicAdd(&bar[XB_TMO], 1u); break; } }
    }
    nloc = mine > 0u ? mine : 1u; nx = cnt > 0u ? cnt : 1u;
}

__device__ __forceinline__ void xcd_barrier(const XcdBarrier& b, bool leader) {
    asm volatile("s_waitcnt vmcnt(0)" ::: "memory");
    __syncthreads();
    if (leader) {
        unsigned* bar = b.bar;
        __builtin_amdgcn_s_waitcnt(0);
        unsigned nloc = b.st[0], nx = b.st[1];
        if (nloc == 0u) { xcd_barrier_complete(bar, b.x, nloc, nx); b.st[0] = nloc; b.st[1] = nx; }
        const unsigned old = xb_add(&bar[XB_XSUB(b.x)], 1u);
        const unsigned gen = old / nloc;
        if (old + 1u == (gen + 1u) * nloc) {
            __builtin_amdgcn_fence(__ATOMIC_RELEASE, "agent");
            asm volatile("s_waitcnt vmcnt(0)" ::: "memory");
            const unsigned og = xb_add(&bar[XB_TOP], 1u);
            const unsigned tg = og / nx;
            if (og + 1u == (tg + 1u) * nx) xb_add(&bar[XB_TOPGEN], 1u);
            else XB_SPIN(xb_ld(&bar[XB_TOPGEN]) == tg, bar);
            __builtin_amdgcn_fence(__ATOMIC_ACQUIRE, "agent");
            xb_add(&bar[XB_XGEN(b.x)], 1u);
            asm volatile("s_waitcnt vmcnt(0)" ::: "memory");
        } else {
            XB_SPIN(xb_ld(&bar[XB_XGEN(b.x)]) == gen, bar);
            __builtin_amdgcn_fence(__ATOMIC_ACQUIRE, "agent");
            asm volatile("s_waitcnt vmcnt(0)" ::: "memory");
        }
    }
    __syncthreads();
}

struct Args { const float* in[32]; float* out; unsigned char* ws; int ph_lo, ph_hi; };
struct Ids { int tid, lane, wave, gw, ngw, z; };

__device__ __forceinline__ int cond_of(int m) { return m < NPR ? 4 : ((m - NPR) >> 11); }
__device__ __forceinline__ const float* mod_ptr_(const Args& a, const Ids& id, int cond, int layer) { return (const float*)(a.ws + id.z + WS_MOD) + (size_t)(cond * 4 + layer) * 6144; }

__device__ __forceinline__ void tr_item(const float* W, int ldw, int col0, const float* scale, bf16* WT, int ldt, int drow0, int dcol0, LAS float* scr, int kb, int nb, int lane, int dnb = -1) {
    const int k0 = 64 * kb, n0 = 32 * nb, dn0 = 32 * (dnb < 0 ? nb : dnb);
#pragma unroll 8
    for (int i = 0; i < 32; ++i) { const int kk = 2 * i + (lane >> 5); float v = W[(size_t)(k0 + kk) * ldw + col0 + n0 + (lane & 31)]; if (scale) v *= scale[k0 + kk]; scr[kk * 33 + (lane & 31)] = v; }
    LDS_WAIT(); asm volatile("" ::: "memory");
    const int c = lane & 7;
#pragma unroll
    for (int j = 0; j < 4; ++j) { const int n = (lane >> 3) + 8 * j; const LAS float* s = scr + (8 * c) * 33 + n;
        v4u o; o.x = pk2(s[0 * 33], s[1 * 33]); o.y = pk2(s[2 * 33], s[3 * 33]); o.z = pk2(s[4 * 33], s[5 * 33]); o.w = pk2(s[6 * 33], s[7 * 33]);
        *(v4u*)(WT + (size_t)(drow0 + dn0 + n) * ldt + dcol0 + k0 + 8 * c) = o; }
    LDS_WAIT(); asm volatile("" ::: "memory");
}
__device__ __forceinline__ bool tr_matrix(int& r, const float* W, int K, int N, bf16* WT, LAS float* scr, int lane) {
    const int nblk = N / 32, items = (K / 64) * nblk;
    if (r < items) { tr_item(W, N, 0, nullptr, WT, K, 0, 0, scr, r / nblk, r % nblk, lane); return true; }
    r -= items; return false;
}
__device__ __forceinline__ bool tr_rwproj(int& r, const float* W, int ncols, const float* mu, bf16* BT1, int drow0, LAS float* scr, int lane) {
    const int nblk = ncols / 32, items = 16 * nblk * 2;
    if (r < items) { const int half = r / (16 * nblk), q = r % (16 * nblk); tr_item(W, ncols, 0, half ? mu : nullptr, BT1, KRKV, drow0, half * 1024, scr, q / nblk, q % nblk, lane); return true; }
    r -= items; return false;
}
__device__ __forceinline__ void conv_weights(const Args& a, const Ids& id, LAS unsigned char* lds, int layer, int parts = 3) {
    LAS float* scr = (LAS float*)(lds + id.wave * 16384);
    const int j = layer >> 1;
    bf16* W1T = (bf16*)(a.ws + id.z + W_W1T); bf16* W2T = (bf16*)(a.ws + id.z + W_W2T);
    const float* mw1 = a.in[30 + id.z] + (size_t)layer * D * FF; const float* mw2 = a.in[31 + id.z] + (size_t)layer * D * FF;
    if ((layer & 1) == 0) {
        bf16* WINT = (bf16*)(a.ws + id.z + W_WINT); bf16* WOUTT = (bf16*)(a.ws + id.z + W_WOUTT);
        const float* win = a.in[12 + id.z] + (size_t)j * D * NQKV; const float* wout = a.in[13 + id.z] + (size_t)j * D * D;
        const int lo = (parts & 2) ? 0 : 4096, hi = (parts & 1) ? 2048 + 2048 + 1152 + 512 : 4096;
        for (int it = lo + id.gw; it < hi; it += id.ngw) {
            int r = it;
            if (tr_matrix(r, mw1, D, FF, W1T, scr, id.lane)) continue;
            if (tr_matrix(r, mw2, FF, D, W2T, scr, id.lane)) continue;
            if (r < 1152) {
                const int kb = r / 72, nb = r % 72; tr_item(win, NQKV, 0, nullptr, WINT, D, 0, 0, scr, kb, nb, id.lane, (nb & ~7) + 4 * (nb & 1) + ((nb >> 1) & 3)); continue; }
            r -= 1152;
            tr_matrix(r, wout, D, D, WOUTT, scr, id.lane);
        }
    } else {
        bf16* BTR = (bf16*)(a.ws + id.z + W_BTR); bf16* BT1 = (bf16*)(a.ws + id.z + W_BTL); bf16* WOT = (bf16*)(a.ws + id.z + W_WOT);
        const float* mu = a.in[17 + id.z] + (size_t)j * 6 * D;
        const float* wrkv = a.in[18 + id.z] + (size_t)j * 3 * D * D;
        const float* w1 = a.in[21 + id.z] + (size_t)j * 2 * D * 64; const float* a1 = a.in[24 + id.z] + (size_t)j * 2 * D * 64; const float* g1 = a.in[26 + id.z] + (size_t)j * D * 128;
        const float* wo = a.in[19 + id.z] + (size_t)j * D * D;
        bf16* BT2 = (bf16*)(a.ws + id.z + W_BT2); const float* w2 = a.in[22 + id.z] + (size_t)j * 2 * 64 * D; const float* a2 = a.in[25 + id.z] + (size_t)j * 2 * 64 * D; const float* g2 = a.in[27 + id.z] + (size_t)j * 128 * D;
        const int total = 2048 + 2048 + 1536 + 256 + 128 + 512 + 128 + 4 * 32 + 64 + 5120;
        for (int it = id.gw; it < total; it += id.ngw) {
            int r = it;
            if (tr_matrix(r, mw1, D, FF, W1T, scr, id.lane)) continue;
            if (tr_matrix(r, mw2, FF, D, W2T, scr, id.lane)) continue;
            if (tr_matrix(r, wrkv, D, D, BTR, scr, id.lane)) continue;
            if (tr_matrix(r, wrkv + (size_t)D * D, D, D, BTR + (size_t)D * D, scr, id.lane)) continue;
            if (tr_matrix(r, wrkv + (size_t)2 * D * D, D, D, BTR + (size_t)2 * D * D, scr, id.lane)) continue;
            if (tr_rwproj(r, w1, 64, mu + 1 * D, BT1, 0, scr, id.lane)) continue;
            if (tr_rwproj(r, w1 + (size_t)D * 64, 64, mu + 1 * D, BT1, 64, scr, id.lane)) continue;
            if (tr_rwproj(r, a1, 64, mu + 4 * D, BT1, 128, scr, id.lane)) continue;
            if (tr_rwproj(r, a1 + (size_t)D * 64, 64, mu + 4 * D, BT1, 192, scr, id.lane)) continue;
            if (tr_rwproj(r, g1, 128, mu + 5 * D, BT1, 256, scr, id.lane)) continue;
            if (tr_matrix(r, wo, D, D, WOT, scr, id.lane)) continue;
            if (r < 128) {
                v4u z = (v4u){0u, 0u, 0u, 0u}; v4u* p = (v4u*)(BT1 + (size_t)(384 + r) * KRKV);
#pragma unroll
                for (int q = 0; q < 4; ++q) p[id.lane + 64 * q] = z;
                continue; }
            r -= 128;
            if (r < 128) { const int i = r >> 5, q = r & 31; const float* W = (i < 2 ? a2 : w2) + (size_t)(i & 1) * 64 * D; tr_item(W, D, 0, nullptr, BT2, 384, 1024 * i, 64 * (i ^ 2), scr, 0, q, id.lane); continue; }
            r -= 128;
            if (r < 64) { tr_item(g2, D, 0, nullptr, BT2, 384, 4096, 256, scr, r >> 5, r & 31, id.lane); continue; }
            r -= 64;
            { const int blk = r >> 10; const int c0 = (blk < 4) ? 8 * (blk ^ 2) : 32, c1 = (blk < 4) ? 8 * (blk ^ 2) + 8 : 48;
              if (id.lane < 48 && (id.lane < c0 || id.lane >= c1)) *(v4u*)(BT2 + (size_t)r * 384 + 8 * id.lane) = (v4u){0u, 0u, 0u, 0u}; }
        }
    }
}

struct RowV { f32x4 v[4]; };
__device__ __forceinline__ void ld_row(RowV& r, const float* p, int lane) {
#pragma unroll
    for (int j = 0; j < 4; ++j) r.v[j] = ((const f32x4*)p)[lane + 64 * j];
}
__device__ __forceinline__ void ld_row_bf16(RowV& r, const bf16* p, int lane) {
#pragma unroll
    for (int j = 0; j < 4; ++j) { const v2u w = ((const v2u*)p)[lane + 64 * j]; r.v[j] = (f32x4){bflo(w.x), bfhi(w.x), bflo(w.y), bfhi(w.y)}; }
}
__device__ __forceinline__ void st_row(const RowV& r, float* p, int lane) {
#pragma unroll
    for (int j = 0; j < 4; ++j) ((f32x4*)p)[lane + 64 * j] = r.v[j];
}
__device__ __forceinline__ void st_row_bf16(const RowV& r, bf16* p, int lane) {
#pragma unroll
    for (int j = 0; j < 4; ++j) { v2u w; w.x = pk2(r.v[j][0], r.v[j][1]); w.y = pk2(r.v[j][2], r.v[j][3]); ((v2u*)p)[lane + 64 * j] = w; }
}
__device__ __forceinline__ float row_rinv(const RowV& r) {
    float s = 0.f;
#pragma unroll
    for (int j = 0; j < 4; ++j) s += (r.v[j][0] * r.v[j][0] + r.v[j][1] * r.v[j][1]) + (r.v[j][2] * r.v[j][2] + r.v[j][3] * r.v[j][3]);
    s = wave_sum(s);
    return 1.0f / sqrtf(s * (1.0f / 1024.0f) + 1e-6f);
}
__device__ __forceinline__ void norm_mod(RowV& h, const RowV& x, const float* g, const float* sc, const float* sh, int lane) {
    const float ri = row_rinv(x);
#pragma unroll
    for (int j = 0; j < 4; ++j) { const f32x4 gv = ((const f32x4*)g)[lane + 64 * j], scv = ((const f32x4*)sc)[lane + 64 * j], shv = ((const f32x4*)sh)[lane + 64 * j];
        h.v[j] = (x.v[j] * ri) * gv * (scv + 1.0f) + shv; }
}
__device__ __forceinline__ void resid_add(RowV& x, const RowV& m, const float* g, const float* gt, int lane) {
    const float ri = row_rinv(m);
#pragma unroll
    for (int j = 0; j < 4; ++j) { const f32x4 gv = ((const f32x4*)g)[lane + 64 * j], gtv = ((const f32x4*)gt)[lane + 64 * j];
        x.v[j] = x.v[j] + gtv * ((m.v[j] * ri) * gv); }
}

__device__ __forceinline__ float rope_inv(int jj) {
    const float t[16] = {1.0f, 0.5623413324356079f, 0.3162277638912201f, 0.17782793939113617f, 0.10000000149011612f, 0.05623412877321243f, 0.03162277862429619f, 0.017782794311642647f,
                         0.009999999776482582f, 0.005623413249850273f, 0.003162277862429619f, 0.0017782794311642647f, 0.0010000000474974513f, 0.000562341301701963f, 0.0003162277862429619f, 0.00017782794020604342f};
    float r = t[0];
#pragma unroll
    for (int i = 1; i < 16; ++i) r = (jj == i) ? t[i] : r;
    return r;
}
__device__ __forceinline__ void ph_prologue(const Args& a, const Ids& id, LAS unsigned char* lds) {
    float* MOD = (float*)(a.ws + id.z + WS_MOD);
    { LAS float* red = (LAS float*)lds;
      for (int it = blockIdx.x; it < 4 * 96; it += gridDim.x) {
        const int i = it / 96, n = (it % 96) * 64 + id.lane;
        float acc[5];
#pragma unroll
        for (int c = 0; c < 5; ++c) acc[c] = 0.f;
        const float* W = a.in[9 + id.z] + (size_t)i * 1024 * 6144 + n;
#pragma unroll 1
        for (int k0 = 128 * id.wave; k0 < 128 * id.wave + 128; k0 += 64) {
            float sv[5];
#pragma unroll
            for (int c = 0; c < 5; ++c) { const float x = (c < 4) ? a.in[2 + id.z][c * 1024 + k0 + id.lane] : a.in[8 + id.z][k0 + id.lane]; sv[c] = x / (1.0f + __expf(-x)); }
#pragma unroll 16
            for (int kk = 0; kk < 64; ++kk) { const float w = W[(size_t)(k0 + kk) * 6144];
#pragma unroll
                for (int c = 0; c < 5; ++c) acc[c] += w * __shfl(sv[c], kk); }
        }
#pragma unroll
        for (int c = 0; c < 5; ++c) red[(id.wave * 5 + c) * 64 + id.lane] = acc[c];
        __syncthreads();
        if (id.wave < 5) { float s = a.in[10 + id.z][i * 6144 + n];
#pragma unroll
            for (int w8 = 0; w8 < 8; ++w8) s += red[(w8 * 5 + id.wave) * 64 + id.lane];
            MOD[(size_t)(id.wave * 4 + i) * 6144 + n] = s; }
        __syncthreads();
      } }
    { float* RC = (float*)(a.ws + id.z + WS_ROPE); float* RS = RC + 2048 * 64;
      for (int e = id.gw * 64 + id.lane; e < 2048 * 64; e += id.ngw * 64) { const int t = e >> 6, d = e & 63; const int pos = (d < 32) ? (t >> 6) : (t & 63);
          const float ang = (float)pos * rope_inv(d & 15); RC[e] = __cosf(ang); RS[e] = __sinf(ang); } }
    conv_weights(a, id, lds, 0, 1);
}

struct RawBf { v2u v[4]; };
__device__ __forceinline__ void ld_raw_bf(RawBf& r, const bf16* p, int lane) {
#pragma unroll
    for (int j = 0; j < 4; ++j) r.v[j] = ((const v2u*)p)[lane + 64 * j];
}
__device__ __forceinline__ void cvt_raw_bf(RowV& o, const RawBf& r) {
#pragma unroll
    for (int j = 0; j < 4; ++j) o.v[j] = (f32x4){bflo(r.v[j].x), bfhi(r.v[j].x), bflo(r.v[j].y), bfhi(r.v[j].y)};
}
__device__ __forceinline__ const float* x_row_ptr(const Args& a, const Ids& id, int layer, int m) {
    return (layer == 0) ? ((m < NPR) ? a.in[0 + id.z] + (size_t)m * D : a.in[1 + id.z] + (size_t)(m - NPR) * D) : a.out + id.z + O_X + (size_t)m * D;
}
__device__ __forceinline__ void ph_norm0(const Args& a, const Ids& id) {
    bf16* H = (bf16*)(a.ws + id.z + A_H); const float* g0 = a.in[11 + id.z] + (size_t)(0 * 4 + 0) * D;
    int m = id.gw; RowV xn; if (m < NTOK) ld_row(xn, x_row_ptr(a, id, 0, m), id.lane);
    for (; m < NTOK; m += id.ngw) { RowV x = xn, h; if (m + id.ngw < NTOK) ld_row(xn, x_row_ptr(a, id, 0, m + id.ngw), id.lane);
        const float* md = mod_ptr_(a, id, cond_of(m), 0);
        norm_mod(h, x, g0, md + 1024, md + 0, id.lane); st_row_bf16(h, H + (size_t)m * D, id.lane); }
}
__device__ __forceinline__ void ph_resid_norm(const Args& a, const Ids& id, int layer, bool dummy = false) {
    bf16* H = (bf16*)(a.ws + id.z + (dummy ? AR + 224 * MiB : A_H)); float* xout = dummy ? (float*)(a.ws + id.z + A_F) : a.out + id.z + O_X; const bf16* M = (const bf16*)(a.ws + id.z + A_M); const float* g1 = a.in[11 + id.z] + (size_t)(layer * 4 + 1) * D; const float* g2 = a.in[11 + id.z] + (size_t)(layer * 4 + 2) * D;
    int m = id.gw; RowV xn; RawBf xbn, mn;
    if (m < NTOK) { if (layer == 0) ld_row(xn, x_row_ptr(a, id, 0, m), id.lane); else ld_raw_bf(xbn, (const bf16*)(a.out + id.z + O_X + (size_t)m * D) + ((layer & 1) ? 1024 : 0), id.lane); ld_raw_bf(mn, M + (size_t)m * D, id.lane); }
    for (; m < NTOK; m += id.ngw) { RowV x, mm, h; if (layer == 0) x = xn; else cvt_raw_bf(x, xbn); cvt_raw_bf(mm, mn);
        if (m + id.ngw < NTOK) { if (layer == 0) ld_row(xn, x_row_ptr(a, id, 0, m + id.ngw), id.lane); else ld_raw_bf(xbn, (const bf16*)(a.out + id.z + O_X + (size_t)(m + id.ngw) * D) + ((layer & 1) ? 1024 : 0), id.lane);
                                 ld_raw_bf(mn, M + (size_t)(m + id.ngw) * D, id.lane); }
        const float* md = mod_ptr_(a, id, cond_of(m), layer);
        resid_add(x, mm, g1, md + 2048, id.lane); st_row_bf16(x, (bf16*)(xout + (size_t)m * D), id.lane);
        norm_mod(h, x, g2, md + 4096, md + 3072, id.lane); st_row_bf16(h, H + (size_t)m * D, id.lane); }
}
__device__ __forceinline__ void ph_resid_end(const Args& a, const Ids& id, LAS unsigned char* lds, int layer, bool dummy = false) {
    bf16* H = (bf16*)(a.ws + id.z + (dummy ? AR + 96 * MiB : A_H)); float* xout = dummy ? (float*)(a.ws + id.z + AR + 32 * MiB) : a.out + id.z + O_X; const bf16* F = (const bf16*)(a.ws + id.z + A_F); const float* g3 = a.in[11 + id.z] + (size_t)(layer * 4 + 3) * D;
    const bool next_attn = (layer + 1 < DEPTH) && (((layer + 1) & 1) == 0);
    const float* g0n = a.in[11 + id.z] + (size_t)((layer + 1) * 4 + 0) * D;
    int m = id.gw; RawBf xbn, fn; if (m < NTOK) { ld_raw_bf(xbn, (const bf16*)(a.out + id.z + O_X + (size_t)m * D), id.lane); ld_raw_bf(fn, F + (size_t)m * D, id.lane); }
    for (; m < NTOK; m += id.ngw) { RowV x, ff; cvt_raw_bf(x, xbn); cvt_raw_bf(ff, fn);
        if (m + id.ngw < NTOK) { ld_raw_bf(xbn, (const bf16*)(a.out + id.z + O_X + (size_t)(m + id.ngw) * D), id.lane); ld_raw_bf(fn, F + (size_t)(m + id.ngw) * D, id.lane); }
        const float* md = mod_ptr_(a, id, cond_of(m), layer);
        resid_add(x, ff, g3, md + 5120, id.lane);
        if (layer + 1 == DEPTH) st_row(x, xout + (size_t)m * D, id.lane); else st_row_bf16(x, (bf16*)(xout + (size_t)m * D), id.lane);
        if (next_attn) { RowV h; const float* mdn = mod_ptr_(a, id, cond_of(m), layer + 1); norm_mod(h, x, g0n, mdn + 1024, mdn + 0, id.lane); st_row_bf16(h, H + (size_t)m * D, id.lane); } }
    if (layer + 1 < DEPTH) conv_weights(a, id, lds, layer + 1, next_attn ? 1 : 3);
}
__device__ __forceinline__ void ph_rw_mix(const Args& a, const Ids& id, int layer) {
    bf16* A2 = (bf16*)(a.ws + id.z + A_A2); bf16* XS = (bf16*)(a.ws + id.z + A_XS); const float* g0 = a.in[11 + id.z] + (size_t)(layer * 4 + 0) * D; const float* mu6 = a.in[17 + id.z] + (size_t)(layer >> 1) * 6 * D;
    for (int g8 = id.gw; g8 < NTOK / 8; g8 += id.ngw) {
        const int m0 = g8 * 8; const int t0 = (m0 < NPR) ? (m0 & (TP - 1)) : ((m0 - NPR) & (TS - 1)); const int T = (m0 < NPR) ? TP : TS;
        const float* md = mod_ptr_(a, id, cond_of(m0), layer); const float* xp = a.out + id.z + O_X + (size_t)m0 * D;
        RowV hp, hc, hn, xr;
#pragma unroll
        for (int q = 0; q < 4; ++q) hp.v[q] = (f32x4){0.f, 0.f, 0.f, 0.f};
        if (t0 > 0) { ld_row_bf16(xr, (const bf16*)(xp - D), id.lane); norm_mod(hp, xr, g0, md + 1024, md + 0, id.lane); }
        ld_row_bf16(xr, (const bf16*)xp, id.lane); norm_mod(hc, xr, g0, md + 1024, md + 0, id.lane);
        RawBf nx; if (t0 + 1 < T) ld_raw_bf(nx, (const bf16*)(xp + D), id.lane);
#pragma unroll 1
        for (int i = 0; i < 8; ++i) {
#pragma unroll
            for (int q = 0; q < 4; ++q) hn.v[q] = (f32x4){0.f, 0.f, 0.f, 0.f};
            const RawBf cu = nx; if (i + 2 <= 8 && t0 + i + 2 < T) ld_raw_bf(nx, (const bf16*)(xp + (size_t)(i + 2) * D), id.lane);
            if (t0 + i + 1 < T) { cvt_raw_bf(xr, cu); norm_mod(hn, xr, g0, md + 1024, md + 0, id.lane); }
            RowV xx;
#pragma unroll
            for (int q = 0; q < 4; ++q) xx.v[q] = (hp.v[q] + hn.v[q]) * 0.5f - hc.v[q];
            st_row_bf16(hc, A2 + (size_t)(m0 + i) * KRKV, id.lane); st_row_bf16(xx, A2 + (size_t)(m0 + i) * KRKV + D, id.lane);
#pragma unroll
            for (int p = 0; p < 3; ++p) { const float* mu = mu6 + (size_t)(p == 0 ? 0 : p + 1) * D; RowV xm;
#pragma unroll
                for (int q = 0; q < 4; ++q) xm.v[q] = hc.v[q] + xx.v[q] * ((const f32x4*)mu)[id.lane + 64 * q];
                st_row_bf16(xm, XS + ((size_t)p * NTOK + m0 + i) * D, id.lane); }
            hp = hc; hc = hn;
        }
    }
}

__device__ __forceinline__ void ph_rend_mix(const Args& a, const Ids& id, LAS unsigned char* lds, int layer) {
    const int nl = layer + 1;
    bf16* A2 = (bf16*)(a.ws + id.z + A_A2); bf16* XS = (bf16*)(a.ws + id.z + A_XS); const bf16* F = (const bf16*)(a.ws + id.z + A_F);
    const float* g3 = a.in[11 + id.z] + (size_t)(layer * 4 + 3) * D; const float* g0 = a.in[11 + id.z] + (size_t)(nl * 4 + 0) * D; const float* mu6 = a.in[17 + id.z] + (size_t)(nl >> 1) * 6 * D;
    for (int g8 = id.gw; g8 < NTOK / 8; g8 += id.ngw) {
        const int m0 = g8 * 8; const int t0 = (m0 < NPR) ? (m0 & (TP - 1)) : ((m0 - NPR) & (TS - 1)); const int T = (m0 < NPR) ? TP : TS;
        const float* mdp = mod_ptr_(a, id, cond_of(m0), layer); const float* md = mod_ptr_(a, id, cond_of(m0), nl);
        float* xp = a.out + id.z + O_X + (size_t)m0 * D; const bf16* fp = F + (size_t)m0 * D;
        RowV hp, hc, hn, xr, fr; RawBf nx, nf;
#pragma unroll
        for (int q = 0; q < 4; ++q) hp.v[q] = (f32x4){0.f, 0.f, 0.f, 0.f};
        if (t0 > 0) { ld_row_bf16(xr, (const bf16*)(xp - D), id.lane); ld_row_bf16(fr, fp - D, id.lane); resid_add(xr, fr, g3, mdp + 5120, id.lane); norm_mod(hp, xr, g0, md + 1024, md + 0, id.lane); }
        ld_row_bf16(xr, (const bf16*)xp, id.lane); ld_row_bf16(fr, fp, id.lane); resid_add(xr, fr, g3, mdp + 5120, id.lane); st_row_bf16(xr, (bf16*)xp + 1024, id.lane);
        norm_mod(hc, xr, g0, md + 1024, md + 0, id.lane);
        if (t0 + 1 < T) { ld_raw_bf(nx, (const bf16*)(xp + D), id.lane); ld_raw_bf(nf, fp + D, id.lane); }
#pragma unroll 1
        for (int i = 0; i < 8; ++i) {
#pragma unroll
            for (int q = 0; q < 4; ++q) hn.v[q] = (f32x4){0.f, 0.f, 0.f, 0.f};
            const RawBf cu = nx, cf = nf; if (i + 2 <= 8 && t0 + i + 2 < T) { ld_raw_bf(nx, (const bf16*)(xp + (size_t)(i + 2) * D), id.lane); ld_raw_bf(nf, fp + (size_t)(i + 2) * D, id.lane); }
            if (t0 + i + 1 < T) { cvt_raw_bf(xr, cu); cvt_raw_bf(fr, cf); resid_add(xr, fr, g3, mdp + 5120, id.lane);
                if (i + 1 < 8) st_row_bf16(xr, (bf16*)(xp + (size_t)(i + 1) * D) + 1024, id.lane);
                norm_mod(hn, xr, g0, md + 1024, md + 0, id.lane); }
            RowV xx;
#pragma unroll
            for (int q = 0; q < 4; ++q) xx.v[q] = (hp.v[q] + hn.v[q]) * 0.5f - hc.v[q];
            st_row_bf16(hc, A2 + (size_t)(m0 + i) * KRKV, id.lane); st_row_bf16(xx, A2 + (size_t)(m0 + i) * KRKV + D, id.lane);
#pragma unroll
            for (int p = 0; p < 3; ++p) { const float* mu = mu6 + (size_t)(p == 0 ? 0 : p + 1) * D; RowV xm;
#pragma unroll
                for (int q = 0; q < 4; ++q) xm.v[q] = hc.v[q] + xx.v[q] * ((const f32x4*)mu)[id.lane + 64 * q];
                st_row_bf16(xm, XS + ((size_t)p * NTOK + m0 + i) * D, id.lane); }
            hp = hc; hc = hn;
        }
    }
    conv_weights(a, id, lds, nl, 3);
}

__device__ __forceinline__ void row16_sum4(float& a, float& b, float& c, float& d) {
    asm("s_nop 1\n\t"
        "v_add_f32_dpp %0, %0, %0 row_ror:8 row_mask:0xf bank_mask:0xf\n\tv_add_f32_dpp %1, %1, %1 row_ror:8 row_mask:0xf bank_mask:0xf\n\tv_add_f32_dpp %2, %2, %2 row_ror:8 row_mask:0xf bank_mask:0xf\n\tv_add_f32_dpp %3, %3, %3 row_ror:8 row_mask:0xf bank_mask:0xf\n\t"
        "v_add_f32_dpp %0, %0, %0 row_ror:4 row_mask:0xf bank_mask:0xf\n\tv_add_f32_dpp %1, %1, %1 row_ror:4 row_mask:0xf bank_mask:0xf\n\tv_add_f32_dpp %2, %2, %2 row_ror:4 row_mask:0xf bank_mask:0xf\n\tv_add_f32_dpp %3, %3, %3 row_ror:4 row_mask:0xf bank_mask:0xf\n\t"
        "v_add_f32_dpp %0, %0, %0 row_ror:2 row_mask:0xf bank_mask:0xf\n\tv_add_f32_dpp %1, %1, %1 row_ror:2 row_mask:0xf bank_mask:0xf\n\tv_add_f32_dpp %2, %2, %2 row_ror:2 row_mask:0xf bank_mask:0xf\n\tv_add_f32_dpp %3, %3, %3 row_ror:2 row_mask:0xf bank_mask:0xf\n\t"
        "v_add_f32_dpp %0, %0, %0 row_ror:1 row_mask:0xf bank_mask:0xf\n\tv_add_f32_dpp %1, %1, %1 row_ror:1 row_mask:0xf bank_mask:0xf\n\tv_add_f32_dpp %2, %2, %2 row_ror:1 row_mask:0xf bank_mask:0xf\n\tv_add_f32_dpp %3, %3, %3 row_ror:1 row_mask:0xf bank_mask:0xf"
        : "+v"(a), "+v"(b), "+v"(c), "+v"(d));
}
__device__ __forceinline__ f32x4 ld_bf4(const bf16* p) { const v2u w = *(const v2u*)p; return (f32x4){bflo(w.x), bfhi(w.x), bflo(w.y), bfhi(w.y)}; }
__device__ __forceinline__ void ph_att_cache(const Args& a, const Ids& id, int layer) {
    const int j = layer >> 1, lane = id.lane;
    bf16 *KAS = (bf16*)(a.ws + id.z + A_KAS), *VAS = (bf16*)(a.ws + id.z + A_VAS), *KBS = (bf16*)(a.ws + id.z + A_KBS), *VBS = (bf16*)(a.ws + id.z + A_VBS);
    for (int r = id.gw; r < 4 * PAST; r += id.ngw) {
        const int b = r >> 9, pos = r & (PAST - 1);
        const size_t src = (size_t)((b * 2 + j) * PAST + pos), dst = (size_t)(b * SKV + pos);
#pragma unroll
        for (int q = 0; q < 2; ++q) { const int e = lane + 64 * q; KAS[dst * 128 + e] = (bf16)f2bf(a.in[3 + id.z][src * 128 + e]); VAS[dst * 128 + e] = (bf16)f2bf(a.in[4 + id.z][src * 128 + e]); }
#pragma unroll
        for (int q = 0; q < 8; ++q) { const int e = lane + 64 * q; KBS[dst * 512 + e] = (bf16)f2bf(a.in[5 + id.z][src * 512 + e]); VBS[dst * 512 + e] = (bf16)f2bf(a.in[6 + id.z][src * 512 + e]); }
    }
}

typedef short bf16x8_t __attribute__((ext_vector_type(8)));
typedef float f32x16 __attribute__((ext_vector_type(16)));
typedef short v4i16_t __attribute__((ext_vector_type(4)));
constexpr float AT_THR = 8.0f;
constexpr int AT_KP = 144, AT_KBUF = 64 * AT_KP, AT_VOFF = 2 * AT_KBUF, AT_VBUFMAX = 64 * 288, AT_WSF = AT_VOFF + 2 * AT_VBUFMAX;
static_assert(AT_WSF + 8 * 128 <= RING_BYTES, "attention LDS");
template <int NDT>
__device__ __forceinline__ void attn_unit(const bf16* Qrow0, int ldq, const bf16* Kb, int ldk, const bf16* Vb, int ldv, int S, bf16* Obf, bf16* Od, int ldo, LAS unsigned char* lds, const Ids& id) {
    constexpr int VP = (NDT == 2) ? 144 : 288, NVL = NDT / 2;
    const int lane = id.lane, w = id.wave, r32 = lane & 31, hi = lane >> 5, tid = id.tid;
    bf16x8_t qf[4];
    { const bf16* qrow = Qrow0 + (size_t)(32 * w + r32) * ldq;
#pragma unroll
      for (int s = 0; s < 4; ++s) qf[s] = *(const bf16x8_t*)(qrow + 16 * s + 8 * hi); }
    f32x16 o[NDT];
#pragma unroll
    for (int dt = 0; dt < NDT; ++dt)
#pragma unroll
        for (int r = 0; r < 16; ++r) o[dt][r] = 0.f;
    float m_run = 0.f, l_run = 0.f;
    const int NT = S >> 6;
    LAS float* wsf = (LAS float*)(lds + AT_WSF + w * 128);
    const int krow = tid >> 3, kch = tid & 7;
    v4u kreg, vreg[NVL];
#define AT_GLOAD(t) do { kreg = *(const v4u*)(Kb + (size_t)((t) * 64 + krow) * ldk + 8 * kch); \
        if (NDT == 2) vreg[0] = *(const v4u*)(Vb + (size_t)((t) * 64 + krow) * ldv + 8 * kch); \
        else { _Pragma("unroll") for (int i_ = 0; i_ < NVL; ++i_) { const int ix_ = tid + 512 * i_; vreg[i_] = *(const v4u*)(Vb + (size_t)((t) * 64 + (ix_ >> 4)) * ldv + 8 * (ix_ & 15)); } } } while (0)
#define AT_LSTORE(b) do { *(LAS v4u*)(lds + (b) * AT_KBUF + krow * AT_KP + 16 * kch) = kreg; \
        if (NDT == 2) *(LAS v4u*)(lds + AT_VOFF + (b) * AT_VBUFMAX + krow * VP + 16 * kch) = vreg[0]; \
        else { _Pragma("unroll") for (int i_ = 0; i_ < NVL; ++i_) { const int ix_ = tid + 512 * i_; *(LAS v4u*)(lds + AT_VOFF + (b) * AT_VBUFMAX + (ix_ >> 4) * VP + 16 * (ix_ & 15)) = vreg[i_]; } } } while (0)
    AT_GLOAD(0); AT_LSTORE(0);
    __syncthreads();
    const int vbase = (4 * hi + ((lane & 15) >> 2)) * VP + 32 * ((lane >> 4) & 1) + 8 * (lane & 3);
#pragma unroll 1
    for (int t = 0; t < NT; ++t) {
        const int b = t & 1;
        if (t + 1 < NT) AT_GLOAD(t + 1);
        const LAS unsigned char* Kt = lds + b * AT_KBUF + r32 * AT_KP + 16 * hi;
        const LAS unsigned char* Vt = lds + AT_VOFF + b * AT_VBUFMAX + vbase;
        f32x16 p0, p1;
        { const float nm = -m_run;
#pragma unroll
          for (int r = 0; r < 16; ++r) { p0[r] = nm; p1[r] = nm; } }
#pragma unroll
        for (int s = 0; s < 4; ++s) { const bf16x8_t k0 = *(const LAS bf16x8_t*)(Kt + 32 * s), k1 = *(const LAS bf16x8_t*)(Kt + 32 * AT_KP + 32 * s);
            p0 = __builtin_amdgcn_mfma_f32_32x32x16_bf16(k0, qf[s], p0, 0, 0, 0); p1 = __builtin_amdgcn_mfma_f32_32x32x16_bf16(k1, qf[s], p1, 0, 0, 0); }
        float mx = __builtin_fmaxf(p0[0], p1[0]);
#pragma unroll
        for (int r = 1; r < 16; ++r) mx = __builtin_fmaxf(__builtin_fmaxf(mx, p0[r]), p1[r]);
        mx = fmaxf(mx, __shfl_xor(mx, 32));
        if (t == 0 || __any(mx > AT_THR)) {
            const float dl = (t == 0) ? mx : fmaxf(mx, 0.f), al = __builtin_amdgcn_exp2f(-dl); m_run += dl; l_run *= al;
#pragma unroll
            for (int r = 0; r < 16; ++r) { p0[r] -= dl; p1[r] -= dl; }
            if (hi == 0) wsf[r32] = al;
            LDS_WAIT(); asm volatile("" ::: "memory");
            { f32x4 a4[4];
#pragma unroll
              for (int g4 = 0; g4 < 4; ++g4) a4[g4] = *(const LAS f32x4*)(wsf + 8 * g4 + 4 * hi);
#pragma unroll
              for (int dt = 0; dt < NDT; ++dt)
#pragma unroll
                  for (int r = 0; r < 16; ++r) o[dt][r] *= a4[r >> 2][r & 3]; }
            LDS_WAIT(); asm volatile("" ::: "memory");
        }
        float rs = 0.f;
#pragma unroll
        for (int r = 0; r < 16; ++r) { p0[r] = __builtin_amdgcn_exp2f(p0[r]); p1[r] = __builtin_amdgcn_exp2f(p1[r]); rs += p0[r] + p1[r]; }
        l_run += rs;
        bf16x8_t pf[4];
#pragma unroll
        for (int ks = 0; ks < 4; ++ks) { v4u pw;
#pragma unroll
            for (int dd = 0; dd < 4; ++dd) { const int r = 8 * (ks & 1) + 2 * dd; pw[dd] = (ks < 2) ? pk2(p0[r], p0[r + 1]) : pk2(p1[r], p1[r + 1]); }
            pf[ks] = __builtin_bit_cast(bf16x8_t, pw); }
#pragma unroll
        for (int ks = 0; ks < 4; ++ks)
#pragma unroll
            for (int dt = 0; dt < NDT; ++dt) {
                const v4i16_t lo = __builtin_amdgcn_ds_read_tr16_b64_v4i16((LAS v4i16_t*)(Vt + (16 * ks) * VP + 64 * dt));
                const v4i16_t hh = __builtin_amdgcn_ds_read_tr16_b64_v4i16((LAS v4i16_t*)(Vt + (16 * ks + 8) * VP + 64 * dt));
                const bf16x8_t vf = (bf16x8_t){lo[0], lo[1], lo[2], lo[3], hh[0], hh[1], hh[2], hh[3]};
                o[dt] = __builtin_amdgcn_mfma_f32_32x32x16_bf16(pf[ks], vf, o[dt], 0, 0, 0); }
        if (t + 1 < NT) AT_LSTORE(b ^ 1);
        __syncthreads();
    }
#undef AT_GLOAD
#undef AT_LSTORE
    const float lt = l_run + __shfl_xor(l_run, 32);
    int lane_e = lane; asm volatile("" : "+v"(lane_e));
    const int r32e = lane_e & 31, hie = lane_e >> 5;
    if (hi == 0) wsf[r32] = 1.0f / lt;
    LDS_WAIT(); asm volatile("" ::: "memory");
    f32x4 a4[4];
#pragma unroll
    for (int g4 = 0; g4 < 4; ++g4) a4[g4] = *(const LAS f32x4*)(wsf + 8 * g4 + 4 * hi);
    LDS_WAIT(); asm volatile("" ::: "memory");
#pragma unroll
    for (int dt = 0; dt < NDT; ++dt)
#pragma unroll
        for (int r = 0; r < 16; ++r) { const float val = o[dt][r] * a4[r >> 2][r & 3]; const int off = (32 * w + (r & 3) + 8 * (r >> 2) + 4 * hie) * ldo + 32 * dt + r32e;
            (NDT == 2 ? Obf : Od)[off] = (bf16)f2bf(val); }
}
__device__ __forceinline__ void ph_attn(const Args& a, const Ids& id, LAS unsigned char* lds, int G, int vcu) {
    const bf16 *QA = (const bf16*)(a.ws + id.z + A_QA), *QB = (const bf16*)(a.ws + id.z + A_QB), *KAP = (const bf16*)(a.ws + id.z + A_KAP), *VAP = (const bf16*)(a.ws + id.z + A_VAP), *KBP = (const bf16*)(a.ws + id.z + A_KBP), *VBP = (const bf16*)(a.ws + id.z + A_VBP);
    const bf16 *KAS = (const bf16*)(a.ws + id.z + A_KAS), *VAS = (const bf16*)(a.ws + id.z + A_VAS), *KBS = (const bf16*)(a.ws + id.z + A_KBS), *VBS = (const bf16*)(a.ws + id.z + A_VBS);
    bf16* H = (bf16*)(a.ws + id.z + A_H); bf16* DT = (bf16*)(a.ws + id.z + A_DT);
    for (int s = vcu; s < 256; s += G) {
        const int h8 = s & 7;
#pragma unroll 1
        for (int pass = 0; pass < 2; ++pass) {
            size_t m0, kvrow; int S;
            if (pass == 0) { const int b = s >> 6, qb = (s >> 3) & 7; m0 = (size_t)NPR + b * TS + qb * 256; kvrow = (size_t)b * SKV; S = SKV; }
            else { const int b = s >> 3; m0 = (size_t)b * TP; kvrow = m0; S = TP; }
            const bf16* Ka = (pass == 0 ? KAS : KAP) + kvrow * 128 + (h8 >> 2) * 64; const bf16* Va = (pass == 0 ? VAS : VAP) + kvrow * 128 + (h8 >> 2) * 64;
            const bf16* Kd = (pass == 0 ? KBS : KBP) + kvrow * 512 + h8 * 64; const bf16* Vd = (pass == 0 ? VBS : VBP) + kvrow * 512 + (h8 >> 1) * 128;
            attn_unit<2>(QA + m0 * 512 + h8 * 64, 512, Ka, 128, Va, 128, S, H + m0 * D + h8 * 64, nullptr, D, lds, id);
            attn_unit<4>(QB + m0 * 512 + h8 * 64, 512, Kd, 512, Vd, 512, S, nullptr, DT + m0 * D + h8 * 128, D, lds, id);
        }
    }
}
__device__ __forceinline__ void ph_att_comb(const Args& a, const Ids& id, int layer) {
    const int j = layer >> 1, lane = id.lane; const float lam_init = (layer == 0) ? 0.2f : 0.4707130183435842f;
    const float* lf = a.in[15 + id.z] + j * 256; const float* sg = a.in[16 + id.z] + j * 128;
    const float s01 = wave_sum(lf[lane] * lf[64 + lane]), s23 = wave_sum(lf[128 + lane] * lf[192 + lane]);
    const float lam = expf(s01) - expf(s23) + lam_init;
    const bf16* DT = (const bf16*)(a.ws + id.z + A_DT); bf16* H = (bf16*)(a.ws + id.z + A_H);
    const f32x4 gg = *(const f32x4*)(sg + 4 * (lane & 31)) * (1.0f - lam_init);
    for (int m = id.gw; m < NTOK; m += id.ngw) {
        f32x4 v[4];
#pragma unroll
        for (int hd = 0; hd < 4; ++hd) v[hd] = ld_bf4(DT + (size_t)m * D + 256 * hd + 4 * lane);
        float ss[4];
#pragma unroll
        for (int hd = 0; hd < 4; ++hd) { f32x4 o; o[0] = __shfl_xor(v[hd][0], 32); o[1] = __shfl_xor(v[hd][1], 32); o[2] = __shfl_xor(v[hd][2], 32); o[3] = __shfl_xor(v[hd][3], 32);
            v[hd] = v[hd] - o * lam;
            ss[hd] = (lane < 32) ? (v[hd][0] * v[hd][0] + v[hd][1] * v[hd][1]) + (v[hd][2] * v[hd][2] + v[hd][3] * v[hd][3]) : 0.f; }
        row16_sum4(ss[0], ss[1], ss[2], ss[3]);
#pragma unroll
        for (int hd = 0; hd < 4; ++hd) { const float tot = ss[hd] + __shfl_xor(ss[hd], 16); const float ri = 1.0f / sqrtf(tot * (1.0f / 128.0f) + 1e-6f); const f32x4 o = v[hd] * ri * gg;
            if (lane < 32) *(v2u*)(H + (size_t)m * D + 512 + hd * 128 + 4 * lane) = (v2u){pk2(o[0], o[1]), pk2(o[2], o[3])}; }
    }
}

__device__ __forceinline__ void lora2_phase(LAS unsigned char* lds, const bf16* A, const bf16* Bt, const pg8::EpiLora2& E, int G, int bx, const Ids& id) {
    const int wid = id.wave, lane = id.lane, tid = id.tid, wr = wid >> 2, wc = wid & 3, fr = lane & 15, fq = lane >> 4;
    constexpr int PT = 144;
    LAS unsigned char* As = lds; LAS unsigned char* Bs = lds + 256 * PT;
    const int colr = 32 * wc + 8 * (fr >> 2) + (fr & 3);
#pragma unroll 1
    for (int u = bx; u < 256; u += G) {
        const int pm = u >> 2, pn = 16 + (u & 3); const int kofs = 256, nch = 2;
        f32x4 acc[2][2][4][2];
#pragma unroll
        for (int ai = 0; ai < 2; ++ai)
#pragma unroll
            for (int bj = 0; bj < 2; ++bj)
#pragma unroll
                for (int m = 0; m < 4; ++m) { acc[ai][bj][m][0] = (f32x4){0.f, 0.f, 0.f, 0.f}; acc[ai][bj][m][1] = (f32x4){0.f, 0.f, 0.f, 0.f}; }
#pragma unroll 1
        for (int ch = 0; ch < nch; ++ch) {
            const bf16* Ag = A + (size_t)(pm * 256) * 384 + kofs + 64 * ch; const bf16* Bg = Bt + (size_t)(pn * 256) * 384 + kofs + 64 * ch;
#pragma unroll
            for (int i = 0; i < 4; ++i) { const int idx = tid + 512 * i, r = idx >> 3, c8 = idx & 7;
                *(LAS v4u*)(As + r * PT + 16 * c8) = *(const v4u*)(Ag + (size_t)r * 384 + 8 * c8); *(LAS v4u*)(Bs + r * PT + 16 * c8) = *(const v4u*)(Bg + (size_t)r * 384 + 8 * c8); }
            __syncthreads();
#pragma unroll
            for (int ks = 0; ks < 2; ++ks) {
                bf16x8_t bo[2][4], ao[2][2];
#pragma unroll
                for (int ai = 0; ai < 2; ++ai)
#pragma unroll
                    for (int m = 0; m < 4; ++m) bo[ai][m] = *(const LAS bf16x8_t*)(As + (128 * ai + 64 * wr + 16 * m + fr) * PT + 64 * ks + 16 * fq);
#pragma unroll
                for (int bj = 0; bj < 2; ++bj)
#pragma unroll
                    for (int n = 0; n < 2; ++n) ao[bj][n] = *(const LAS bf16x8_t*)(Bs + (128 * bj + colr + 4 * n) * PT + 64 * ks + 16 * fq);
#pragma unroll
                for (int ai = 0; ai < 2; ++ai)
#pragma unroll
                    for (int bj = 0; bj < 2; ++bj)
#pragma unroll
                        for (int m = 0; m < 4; ++m)
#pragma unroll
                            for (int n = 0; n < 2; ++n) acc[ai][bj][m][n] = __builtin_amdgcn_mfma_f32_16x16x32_bf16(ao[bj][n], bo[ai][m], acc[ai][bj][m][n], 0, 0, 0);
            }
            __syncthreads();
        }
        E(acc, pg8::Unit{pm, pn}, wr, wc, fr, fq);
    }
}
__device__ __forceinline__ void ph_rw_prep(const Args& a, const Ids& id, int layer) {
    const int j = layer >> 1, lane = id.lane, h = lane >> 2, qd = lane & 3;
    const bf16* RKV = (const bf16*)(a.ws + id.z + A_RKV) + 1024 + h * 64 + 16 * qd; float* INV = (float*)(a.ws + id.z + WS_INV);
    const f32x4* kc = (const f32x4*)(a.in[28 + id.z] + (size_t)(j * 3 + 0) * D + h * 64 + 16 * qd);
    const f32x4 c0 = kc[0], c1 = kc[1], c2 = kc[2], c3 = kc[3];
    int m = id.gw; v4u wa, wb; if (m < NTOK) { wa = *(const v4u*)(RKV + (size_t)m * 3072); wb = *(const v4u*)(RKV + (size_t)m * 3072 + 8); }
    for (; m < NTOK; m += id.ngw) {
        const v4u w0 = wa, w1 = wb;
        if (m + id.ngw < NTOK) { wa = *(const v4u*)(RKV + (size_t)(m + id.ngw) * 3072); wb = *(const v4u*)(RKV + (size_t)(m + id.ngw) * 3072 + 8); }
        const f32x4 t0 = (f32x4){bflo(w0.x), bfhi(w0.x), bflo(w0.y), bfhi(w0.y)} * c0, t1 = (f32x4){bflo(w0.z), bfhi(w0.z), bflo(w0.w), bfhi(w0.w)} * c1,
                    t2 = (f32x4){bflo(w1.x), bfhi(w1.x), bflo(w1.y), bfhi(w1.y)} * c2, t3 = (f32x4){bflo(w1.z), bfhi(w1.z), bflo(w1.w), bfhi(w1.w)} * c3;
        const f32x4 q4 = t0 * t0 + t1 * t1 + t2 * t2 + t3 * t3;
        float s = (q4[0] + q4[1]) + (q4[2] + q4[3]);
        asm("s_nop 1\n\tv_add_f32_dpp %0, %0, %0 quad_perm:[1,0,3,2] row_mask:0xf bank_mask:0xf\n\ts_nop 1\n\tv_add_f32_dpp %0, %0, %0 quad_perm:[2,3,0,1] row_mask:0xf bank_mask:0xf\n\ts_nop 1" : "+v"(s));
        if (qd == 0) INV[m * 16 + h] = 1.0f / sqrtf(s + 1e-12f);
    }
}

constexpr int SC_TC = 16;
constexpr int CK_AH = 0, CK_RH = 2560, CK_VT = 5120, CK_KCT = 7680, CK_BCT = 10240, CK_TM = 12288, CK_LAK = 12800, CK_MRB = 13312, CK_MRK = 13824, CK_GC = 14336, CK_SLOT = 16384;
constexpr int CK_TMP = 4 * CK_SLOT, CK_TMPW = 4608;
constexpr int SC_YOFF = (CK_TMP + 2 * CK_TMPW) / 4;
constexpr int CK_BSL = (SC_YOFF + 2 * SC_TC * 64) * 4;
static_assert(CK_BSL + 1024 <= RING_BYTES, "scan LDS");
constexpr size_t A_BS = AR + 208 * MiB;
constexpr int CK_AEW = CK_BSL + 1024;
constexpr int CK_L1F = CK_AEW + 2 * 6912;
static_assert(CK_L1F + 2 * 4096 <= RING_BYTES, "scan LDS");
constexpr int SC_NC = TS / SC_TC;
struct ScDesc { int mbase, T, h, dir, b; };
__device__ __forceinline__ void sc_desc(ScDesc& d, int slot, int c) {
    if (slot < 128) { d.b = slot >> 5; d.h = (slot >> 1) & 15; d.dir = slot & 1; d.T = TS; d.mbase = NPR + d.b * TS; }
    else { const int cp = (slot - 128) * 8 + (c >> 4); d.b = cp >> 5; d.h = (cp >> 1) & 15; d.dir = cp & 1; d.T = TP; d.mbase = d.b * TP; }
}
__device__ __forceinline__ int sc_cbase(int slot, int c) { return (slot < 128 ? c : (c & 15)) * SC_TC; }
__device__ __forceinline__ int sc_tok(const ScDesc& d, int s) { return d.mbase + (d.dir ? d.T - 1 - s : s); }
typedef float f32x2 __attribute__((ext_vector_type(2)));
typedef short bf16x4_t __attribute__((ext_vector_type(4)));
#define MF32(a_, b_, c_) __builtin_amdgcn_mfma_f32_16x16x32_bf16(a_, b_, c_, 0, 0, 0)
__device__ __forceinline__ f32x4 mf16_pad(const bf16x4_t a, const bf16x4_t b, const f32x4 c) {
    const bf16x8_t a8 = (bf16x8_t){a[0], a[1], a[2], a[3], 0, 0, 0, 0}, b8 = (bf16x8_t){b[0], b[1], b[2], b[3], 0, 0, 0, 0};
    return __builtin_amdgcn_mfma_f32_16x16x32_bf16(a8, b8, c, 0, 0, 0);
}
#define MF16(a_, b_, c_) mf16_pad(a_, b_, c_)
__device__ __forceinline__ v2u pk4u(const f32x4 v) { return (v2u){pk2(v[0], v[1]), pk2(v[2], v[3])}; }
__device__ __forceinline__ bf16x4_t pk4(const f32x4 v) { return __builtin_bit_cast(bf16x4_t, pk4u(v)); }
__device__ __forceinline__ f32x2 exp2v(const f32x2 x) { return (f32x2){__builtin_amdgcn_exp2f(x[0]), __builtin_amdgcn_exp2f(x[1])}; }
template <int CTRL> __device__ __forceinline__ float dpp_f(float v) { return __builtin_bit_cast(float, __builtin_amdgcn_update_dpp(0, __builtin_bit_cast(int, v), CTRL, 0xf, 0xf, true)); }
__device__ __forceinline__ float bperm_f(int srclane, float v) { return __builtin_bit_cast(float, __builtin_amdgcn_ds_bpermute(srclane << 2, __builtin_bit_cast(int, v))); }
struct CkKv { f32x2 kkc, kac, rkc; };
struct CkRaw { unsigned r[2], k[2]; float iv[2]; unsigned v[2]; bf16x8_t lf; };
__device__ __forceinline__ void ck_load(CkRaw& R, const Args& a, const Ids& id, int slot, int c, int hq) {
    const int lane = id.lane, kp = 8 * hq + (lane & 7), tq = lane >> 3; ScDesc d; sc_desc(d, slot, c);
    const int s0 = sc_cbase(slot, c) + 2 * tq; const int m0 = sc_tok(d, s0); const int ms = d.dir ? -1 : 1;
    const unsigned char* bR = a.ws + id.z + A_RKV; const unsigned char* bI = a.ws + id.z + WS_INV;
    const unsigned oR = (unsigned)m0 * 6144u + (unsigned)(d.h * 128 + 4 * kp), oI = (unsigned)m0 * 64u + (unsigned)(d.h * 4);
    const unsigned sR = (unsigned)(ms * 6144), sI = (unsigned)(ms * 64);
#pragma unroll
    for (int it = 0; it < 2; ++it) {
        R.r[it] = *(const unsigned*)(bR + (oR + it * sR)); R.k[it] = *(const unsigned*)(bR + (oR + it * sR + 2048u)); R.v[it] = *(const unsigned*)(bR + (oR + it * sR + 4096u));
        R.iv[it] = *(const float*)(bI + (oI + it * sI)); }
    { const int c2 = c + 2 < SC_NC ? c + 2 : SC_NC - 1; ScDesc d2; sc_desc(d2, slot, c2);
        const bf16* L1 = (const bf16*)(a.ws + id.z + A_L1) + (size_t)sc_tok(d2, sc_cbase(slot, c2) + (lane & 15)) * 384 + 8 * (lane >> 4) + 64 * d2.dir;
        R.lf = *(const bf16x8_t*)(L1 + (hq < 2 ? 128 + 32 * hq : 32 * (hq - 2))); }
}
__device__ __forceinline__ void ck_derive(const CkRaw& Rin, const Args& a, const Ids& id, LAS unsigned char* sb, LAS unsigned char* tb, LAS unsigned char* bsl, const LAS unsigned char* aew, LAS unsigned char* l1f, CkKv& kv, int layer, int slot, int c, int hq) {
    asm volatile("s_waitcnt vmcnt(9)" ::: "memory");
    CkRaw R = Rin;
#pragma unroll
    for (int it = 0; it < 2; ++it) asm volatile("" : "+v"(R.r[it]), "+v"(R.k[it]), "+v"(R.iv[it]), "+v"(R.v[it]));
    asm volatile("" : "+v"(R.lf));
    *(LAS bf16x8_t*)(l1f + hq * 1024 + id.lane * 16) = R.lf;
    const int lane = id.lane, kp = 8 * hq + (lane & 7), tq = lane >> 3, j = layer >> 1; ScDesc d; sc_desc(d, slot, c);
    if (slot < 128 ? c == 0 : (c & 15) == 0) {
        const float* kvp = a.in[28 + id.z] + (size_t)(j * 3) * D + d.h * 64 + 2 * kp;
        kv.kkc = *(const f32x2*)kvp; kv.kac = *(const f32x2*)(kvp + D); kv.rkc = *(const f32x2*)(kvp + 2 * D);
        asm volatile("s_waitcnt vmcnt(0)" : "+v"(kv.kkc), "+v"(kv.kac), "+v"(kv.rkc) :: "memory"); }
    const f32x2 kkc = kv.kkc, kac = kv.kac;
    const unsigned ra0 = *(const LAS unsigned*)(aew + (2 * tq) * 144 + 4 * kp), ra1 = *(const LAS unsigned*)(aew + (2 * tq + 1) * 144 + 4 * kp);
    const LAS unsigned char* cb = aew + 2304 + 8 * kp;
    const f32x2 c0 = *(const LAS f32x2*)(cb + (2 * tq) * 288), c1 = *(const LAS f32x2*)(cb + (2 * tq + 1) * 288), cumC = *(const LAS f32x2*)(cb + 15 * 288);
    const f32x2 cA = *(const LAS f32x2*)(cb + (tq > 0 ? 2 * tq - 1 : 0) * 288);
    const f32x2 carry = tq > 0 ? cA : (f32x2){0.f, 0.f};
    const f32x2 gC = exp2v(-cumC);
    f32x2 gprev = exp2v(-carry);
    f32x2 kcp = (f32x2){0.f, 0.f}, bcp = (f32x2){0.f, 0.f};
    const f32x2 rkc = kv.rkc; float bon0 = 0.f, bon1 = 0.f;
#pragma unroll
    for (int it = 0; it < 2; ++it) {
        const f32x2 cum = it == 0 ? c0 : c1; const f32x2 g = exp2v(-cum), ig = exp2v(cum);
        const f32x2 k2 = (f32x2){bflo(R.k[it]), bfhi(R.k[it])}, a2 = (f32x2){bflo(it == 0 ? ra0 : ra1), bfhi(it == 0 ? ra0 : ra1)}, r2 = (f32x2){bflo(R.r[it]), bfhi(R.r[it])};
        const f32x2 kdv = k2 * ((a2 - 1.0f) * kac + 1.0f);
        const f32x2 kk = k2 * kkc * R.iv[it], Ah = kk * gprev, Bh = kk * a2 * ig, Kh = kdv * ig, Rh = r2 * g, Kc = Kh * gC, Bc = Bh * gC;
        { const f32x2 bp = r2 * kdv * rkc; if (it == 0) bon0 = bp[0] + bp[1]; else bon1 = bp[0] + bp[1]; }
        gprev = g;
        const int ro = (2 * tq + it) * 144 + 4 * kp;
        *(LAS unsigned*)(sb + CK_AH + ro) = pk2(Ah[0], Ah[1]); *(LAS unsigned*)(sb + CK_RH + ro) = pk2(Rh[0], Rh[1]);
        *(LAS unsigned*)(tb + ro) = pk2(Bh[0], Bh[1]); *(LAS unsigned*)(tb + 2304 + ro) = pk2(Kh[0], Kh[1]);
        if (it == 1) { *(LAS unsigned*)(sb + CK_KCT + (2 * kp) * 32 + 4 * tq) = pk2(kcp[0], Kc[0]); *(LAS unsigned*)(sb + CK_KCT + (2 * kp + 1) * 32 + 4 * tq) = pk2(kcp[1], Kc[1]);
                       *(LAS unsigned*)(sb + CK_BCT + (2 * kp) * 32 + 4 * tq) = pk2(bcp[0], Bc[0]); *(LAS unsigned*)(sb + CK_BCT + (2 * kp + 1) * 32 + 4 * tq) = pk2(bcp[1], Bc[1]); }
        else { kcp = Kc; bcp = Bc; }
    }
    if (tq == 0) *(LAS f32x2*)(sb + CK_GC + 8 * kp) = gC;
    asm volatile("s_nop 1\n\t"
        "v_add_f32_dpp %0, %0, %0 quad_perm:[1,0,3,2] row_mask:0xf bank_mask:0xf\n\tv_add_f32_dpp %1, %1, %1 quad_perm:[1,0,3,2] row_mask:0xf bank_mask:0xf\n\ts_nop 1\n\t"
        "v_add_f32_dpp %0, %0, %0 quad_perm:[2,3,0,1] row_mask:0xf bank_mask:0xf\n\tv_add_f32_dpp %1, %1, %1 quad_perm:[2,3,0,1] row_mask:0xf bank_mask:0xf\n\ts_nop 1\n\t"
        "v_add_f32_dpp %0, %0, %0 row_half_mirror row_mask:0xf bank_mask:0xf\n\tv_add_f32_dpp %1, %1, %1 row_half_mirror row_mask:0xf bank_mask:0xf\n\ts_nop 1" : "+v"(bon0), "+v"(bon1));
    if ((lane & 7) == 0) *(LAS f32x2*)(bsl + (hq * 16 + 2 * tq) * 4) = (f32x2){bon0, bon1};
    *(LAS unsigned*)(sb + CK_VT + (2 * kp) * 32 + 4 * tq) = (R.v[0] & 0xffffu) | (R.v[1] << 16);
    *(LAS unsigned*)(sb + CK_VT + (2 * kp + 1) * 32 + 4 * tq) = (R.v[0] >> 16) | (R.v[1] & 0xffff0000u);
}
struct CkAew { bf16x8_t la0, la1, le0, le1, wa0, wa1, we0, we1; f32x4 ba, be; };
__device__ __forceinline__ void ck_aew_load(CkAew& F, const Args& a, const Ids& id, int layer, int slot, int c, int w) {
    const int lane = id.lane, ln = lane & 15, q = lane >> 4, j = layer >> 1; ScDesc d; sc_desc(d, slot, c);
    const int tok = sc_tok(d, sc_cbase(slot, c) + ln);
    const int ka = 128 + 64 * d.dir, ke = 64 * d.dir;
    const bf16* L1 = (const bf16*)(a.ws + id.z + A_L1) + (size_t)tok * 384 + 8 * q;
    const bf16* W2 = (const bf16*)(a.ws + id.z + W_BT2) + (size_t)(d.h * 64 + 16 * w + ln) * 384 + 8 * q;
    const bf16* Wa = W2 + (size_t)(d.dir * 1024) * 384 + ka; const bf16* We = W2 + (size_t)((2 + d.dir) * 1024) * 384 + ke;
    F.la0 = *(const bf16x8_t*)(L1 + ka); F.la1 = *(const bf16x8_t*)(L1 + ka + 32); F.le0 = *(const bf16x8_t*)(L1 + ke); F.le1 = *(const bf16x8_t*)(L1 + ke + 32);
    F.wa0 = *(const bf16x8_t*)Wa; F.wa1 = *(const bf16x8_t*)(Wa + 32); F.we0 = *(const bf16x8_t*)We; F.we1 = *(const bf16x8_t*)(We + 32);
    const size_t bo = (size_t)j * 2 * D + d.dir * 1024 + d.h * 64 + 16 * w + 4 * q;
    F.ba = *(const f32x4*)(a.in[23 + id.z] + bo); F.be = *(const f32x4*)(a.in[20 + id.z] + bo);
}
__device__ __forceinline__ void ck_aew_loadW(CkAew& F, const Args& a, const Ids& id, int layer, int slot, int c, int w) {
    const int lane = id.lane, ln = lane & 15, q = lane >> 4, j = layer >> 1; ScDesc d; sc_desc(d, slot, c);
    const int ka = 128 + 64 * d.dir, ke = 64 * d.dir;
    const bf16* W2 = (const bf16*)(a.ws + id.z + W_BT2) + (size_t)(d.h * 64 + 16 * w + ln) * 384 + 8 * q;
    const bf16* Wa = W2 + (size_t)(d.dir * 1024) * 384 + ka; const bf16* We = W2 + (size_t)((2 + d.dir) * 1024) * 384 + ke;
    F.wa0 = *(const bf16x8_t*)Wa; F.wa1 = *(const bf16x8_t*)(Wa + 32); F.we0 = *(const bf16x8_t*)We; F.we1 = *(const bf16x8_t*)(We + 32);
    const size_t bo = (size_t)j * 2 * D + d.dir * 1024 + d.h * 64 + 16 * w + 4 * q;
    F.ba = *(const f32x4*)(a.in[23 + id.z] + bo); F.be = *(const f32x4*)(a.in[20 + id.z] + bo);
}
__device__ __forceinline__ void ck_aew_finish(CkAew& F, const Ids& id, LAS unsigned char* dst, int w, const LAS unsigned char* l1f = nullptr) {
    if (l1f) { F.la0 = *(const LAS bf16x8_t*)(l1f + id.lane * 16); F.la1 = *(const LAS bf16x8_t*)(l1f + 1024 + id.lane * 16); F.le0 = *(const LAS bf16x8_t*)(l1f + 2048 + id.lane * 16); F.le1 = *(const LAS bf16x8_t*)(l1f + 3072 + id.lane * 16); }
    asm volatile("s_waitcnt vmcnt(0)" : "+v"(F.la0), "+v"(F.la1), "+v"(F.le0), "+v"(F.le1), "+v"(F.wa0), "+v"(F.wa1), "+v"(F.we0), "+v"(F.we1), "+v"(F.ba), "+v"(F.be) :: "memory");
    const int ln = id.lane & 15, q = id.lane >> 4;
    const f32x4 zero = (f32x4){0.f, 0.f, 0.f, 0.f};
    f32x4 da = MF32(F.wa0, F.la0, zero); da = MF32(F.wa1, F.la1, da);
    f32x4 de = MF32(F.we0, F.le0, zero); de = MF32(F.we1, F.le1, de);
#pragma unroll
    for (int jj = 0; jj < 4; ++jj) {
        da[jj] = __builtin_amdgcn_rcpf(1.0f + __builtin_amdgcn_exp2f(-1.4426950408889634f * (da[jj] + F.ba[jj])));
        de[jj] = 0.8750387749719753f * __builtin_amdgcn_rcpf(1.0f + __builtin_amdgcn_exp2f(-1.4426950408889634f * (de[jj] + F.be[jj]))); }
    *(LAS v2u*)(dst + ln * 144 + 2 * (16 * w + 4 * q)) = pk4u(da);
    const v2u pe = pk4u(de);
    f32x4 cs = (f32x4){bflo(pe[0]), bfhi(pe[0]), bflo(pe[1]), bfhi(pe[1])};
#pragma unroll
    for (int jj = 0; jj < 4; ++jj) {
        cs[jj] += dpp_f<0x111>(cs[jj]); cs[jj] += dpp_f<0x112>(cs[jj]); cs[jj] += dpp_f<0x114>(cs[jj]); cs[jj] += dpp_f<0x118>(cs[jj]); }
    *(LAS f32x4*)(dst + 2304 + ln * 288 + 4 * (16 * w + 4 * q)) = cs;
}
__device__ __forceinline__ void ck_products(const Ids& id, LAS unsigned char* sb, const LAS unsigned char* tb, int hq) {
    const int ln = id.lane & 15, q = id.lane >> 4;
    const f32x4 zero = (f32x4){0.f, 0.f, 0.f, 0.f};
    if (hq == 0) {
        f32x4 P0 = zero, P1 = zero;
#pragma unroll
        for (int ks = 0; ks < 2; ++ks) { const int fo = ln * 144 + 64 * ks + 16 * q;
            const bf16x8_t ah = *(const LAS bf16x8_t*)(sb + CK_AH + fo), bh = *(const LAS bf16x8_t*)(tb + fo);
            P0 = MF32(ah, bh, P0);
            P1 = MF32(bh, ah, P1); }
        f32x4 b1, a1, z0;
#pragma unroll
        for (int jj = 0; jj < 4; ++jj) { const int row = 4 * q + jj;
            b1[jj] = (ln < row) ? -P0[jj] : 0.f;
            a1[jj] = (row < ln) ? -P1[jj] : 0.f;
            z0[jj] = a1[jj] + ((row == ln) ? 1.f : 0.f); }
        const bf16x4_t a1b = pk4(a1), b1b = pk4(b1);
        const f32x4 b2 = MF16(a1b, b1b, zero), a2 = MF16(b1b, a1b, zero);
        const bf16x4_t b2b = pk4(b2), a2b = pk4(a2);
        const f32x4 z1 = MF16(b2b, pk4(z0), z0);
        const f32x4 b4 = MF16(a2b, b2b, zero), a4 = MF16(b2b, a2b, zero);
        const bf16x4_t b4b = pk4(b4), a4b = pk4(a4);
        const f32x4 z2 = MF16(b4b, pk4(z1), z1);
        const f32x4 b8 = MF16(a4b, b4b, zero);
        const f32x4 z3 = MF16(pk4(b8), pk4(z2), z2);
        *(LAS v2u*)(sb + CK_TM + ln * 32 + 8 * q) = pk4u(z3);
    } else {
        const LAS unsigned char* pa = tb + (hq == 2 ? 0 : 2304); const LAS unsigned char* pb = sb + (hq == 1 ? CK_AH : CK_RH);
        f32x4 P = zero;
#pragma unroll
        for (int ks = 0; ks < 2; ++ks) { const int fo = ln * 144 + 64 * ks + 16 * q; P = MF32(*(const LAS bf16x8_t*)(pa + fo), *(const LAS bf16x8_t*)(pb + fo), P); }
        f32x4 m;
#pragma unroll
        for (int jj = 0; jj < 4; ++jj) { const int row = 4 * q + jj; m[jj] = ((hq == 1) ? (row < ln) : (row <= ln)) ? P[jj] : 0.f; }
        *(LAS v2u*)(sb + (hq == 1 ? CK_LAK : (hq == 2 ? CK_MRB : CK_MRK)) + ln * 32 + 8 * q) = pk4u(m);
    }
}
__device__ __forceinline__ void sc_flush(const Args& a, const Ids& id, const LAS float* L, int hq, int slot, int c) {
    bf16* Y = (bf16*)(a.ws + id.z + A_Y);
    ScDesc d; sc_desc(d, slot, c); const int cb = sc_cbase(slot, c);
#pragma unroll
    for (int qq = 0; qq < 2; ++qq) { const int idx = hq * 64 + id.lane + 256 * qq, s = idx >> 5, rp = idx & 31;
        const f32x2 yv = *(const LAS f32x2*)(L + SC_YOFF + (c & 1) * SC_TC * 64 + s * 64 + 2 * rp);
        *(unsigned*)(Y + ((size_t)d.dir * NTOK + sc_tok(d, cb + s)) * D + d.h * 64 + 2 * rp) = pk2(yv[0], yv[1]); }
    if (hq == 0 && id.lane < 16) { const LAS float* bl = L + CK_BSL / 4 + (c & 3) * 64 + id.lane;
        ((float*)(a.ws + id.z + A_BS))[((size_t)d.dir * NTOK + sc_tok(d, cb + id.lane)) * 16 + d.h] = (bl[0] + bl[16]) + (bl[32] + bl[48]); }
}
__device__ __forceinline__ void ph_rw_scan(const Args& a, const Ids& id, LAS unsigned char* lds, int layer, int G, int vcu) {
    const int j = layer >> 1, lane = id.lane, w = id.wave;
    LAS float* L = (LAS float*)lds;
    constexpr int NC = TS / SC_TC;
    for (int slot = vcu; slot < 256; slot += G) {
        if (w >= 4) {
            const int hq = w - 4; CkRaw R0, R1; CkKv kv;
            __builtin_amdgcn_s_setprio(2);
            LAS unsigned char* tg = lds + CK_TMP;
            ck_load(R0, a, id, slot, 0, hq); ck_load(R1, a, id, slot, 1, hq);
            __syncthreads();
            ck_derive(R0, a, id, lds, tg, lds + CK_BSL, lds + CK_AEW, lds + CK_L1F, kv, layer, slot, 0, hq);
            ck_load(R0, a, id, slot, 2, hq);
            ck_derive(R1, a, id, lds + CK_SLOT, tg + CK_TMPW, lds + CK_BSL + 256, lds + CK_AEW + 6912, lds + CK_L1F + 4096, kv, layer, slot, 1, hq);
            ck_load(R1, a, id, slot, 3, hq);
            __syncthreads();
            ck_products(id, lds, tg, hq);
            __syncthreads();
#pragma unroll 1
            for (int n = 0; n < NC; n += 2) {
                ck_products(id, lds + ((n + 1) & 3) * CK_SLOT, tg + CK_TMPW, hq);
                if (n + 2 < NC) ck_derive(R0, a, id, lds + ((n + 2) & 3) * CK_SLOT, tg, lds + CK_BSL + ((n + 2) & 3) * 256, lds + CK_AEW, lds + CK_L1F, kv, layer, slot, n + 2, hq);
                if (n > 0) sc_flush(a, id, L, hq, slot, n - 1);
                ck_load(R0, a, id, slot, n + 4 < NC ? n + 4 : NC - 2, hq);
                __syncthreads();
                if (n + 2 < NC) ck_products(id, lds + ((n + 2) & 3) * CK_SLOT, tg, hq);
                if (n + 3 < NC) ck_derive(R1, a, id, lds + ((n + 3) & 3) * CK_SLOT, tg + CK_TMPW, lds + CK_BSL + ((n + 3) & 3) * 256, lds + CK_AEW + 6912, lds + CK_L1F + 4096, kv, layer, slot, n + 3, hq);
                sc_flush(a, id, L, hq, slot, n);
                ck_load(R1, a, id, slot, n + 5 < NC ? n + 5 : NC - 1, hq);
                __syncthreads();
            }
            sc_flush(a, id, L, hq, slot, NC - 1);
            __builtin_amdgcn_s_setprio(0);
        } else {
            const int ln = lane & 15, q = lane >> 4, i0l = 16 * w; const bool prompt = slot >= 128;
            const f32x4 zero = (f32x4){0.f, 0.f, 0.f, 0.f};
            f32x4 S0 = zero, S1 = zero, S2 = zero, S3 = zero;
            if (!prompt) { ScDesc d; sc_desc(d, slot, 0);
                const float* sp = a.in[7 + id.z] + ((((size_t)(d.b * 2 + j) * 2 + d.dir) * 16 + d.h) * 64 + i0l + ln) * 64 + 4 * q;
                S0 = *(const f32x4*)sp; S1 = *(const f32x4*)(sp + 16); S2 = *(const f32x4*)(sp + 32); S3 = *(const f32x4*)(sp + 48); }
            CkAew F;
            ck_aew_load(F, a, id, layer, slot, 0, w); ck_aew_finish(F, id, lds + CK_AEW, w);
            ck_aew_load(F, a, id, layer, slot, 1, w); ck_aew_finish(F, id, lds + CK_AEW + 6912, w);
            __syncthreads();
            __syncthreads();
            ck_aew_load(F, a, id, layer, slot, 2, w); ck_aew_finish(F, id, lds + CK_AEW, w);
            __syncthreads();
#pragma unroll 1
            for (int c = 0; c < NC; ++c) {
                if (prompt && (c & 15) == 0) { S0 = zero; S1 = zero; S2 = zero; S3 = zero; }
                if (c + 3 < NC && prompt && ((c + 3) & 15) == 0) ck_aew_loadW(F, a, id, layer, slot, c + 3, w);
                const LAS unsigned char* sb = lds + (c & 3) * CK_SLOT;
                const bf16x8_t sf0 = __builtin_bit_cast(bf16x8_t, (v4u){pk2(S0[0], S0[1]), pk2(S0[2], S0[3]), pk2(S1[0], S1[1]), pk2(S1[2], S1[3])});
                const bf16x8_t sf1 = __builtin_bit_cast(bf16x8_t, (v4u){pk2(S2[0], S2[1]), pk2(S2[2], S2[3]), pk2(S3[0], S3[1]), pk2(S3[2], S3[3])});
                const int po = ln * 144 + 8 * q;
                const v2u ah0 = *(const LAS v2u*)(sb + CK_AH + po), ah1 = *(const LAS v2u*)(sb + CK_AH + po + 32), ah2 = *(const LAS v2u*)(sb + CK_AH + po + 64), ah3 = *(const LAS v2u*)(sb + CK_AH + po + 96);
                const v2u rh0 = *(const LAS v2u*)(sb + CK_RH + po), rh1 = *(const LAS v2u*)(sb + CK_RH + po + 32), rh2 = *(const LAS v2u*)(sb + CK_RH + po + 64), rh3 = *(const LAS v2u*)(sb + CK_RH + po + 96);
                const int so = ln * 32 + 8 * q;
                const bf16x4_t vt = *(const LAS bf16x4_t*)(sb + CK_VT + i0l * 32 + so), lak = *(const LAS bf16x4_t*)(sb + CK_LAK + so), mrk = *(const LAS bf16x4_t*)(sb + CK_MRK + so),
                               mrb = *(const LAS bf16x4_t*)(sb + CK_MRB + so), tm = *(const LAS bf16x4_t*)(sb + CK_TM + so);
                f32x4 u0 = MF16(lak, vt, zero), y = MF16(mrk, vt, zero);
                u0 = MF32(__builtin_bit_cast(bf16x8_t, (v4u){ah0.x, ah0.y, ah1.x, ah1.y}), sf0, u0); u0 = MF32(__builtin_bit_cast(bf16x8_t, (v4u){ah2.x, ah2.y, ah3.x, ah3.y}), sf1, u0);
                y = MF32(__builtin_bit_cast(bf16x8_t, (v4u){rh0.x, rh0.y, rh1.x, rh1.y}), sf0, y); y = MF32(__builtin_bit_cast(bf16x8_t, (v4u){rh2.x, rh2.y, rh3.x, rh3.y}), sf1, y);
                const f32x4 gc0 = *(const LAS f32x4*)(sb + CK_GC + 16 * q), gc1 = *(const LAS f32x4*)(sb + CK_GC + 64 + 16 * q), gc2 = *(const LAS f32x4*)(sb + CK_GC + 128 + 16 * q), gc3 = *(const LAS f32x4*)(sb + CK_GC + 192 + 16 * q);
                S0 = MF16(*(const LAS bf16x4_t*)(sb + CK_KCT + so), vt, S0 * gc0); S1 = MF16(*(const LAS bf16x4_t*)(sb + CK_KCT + 512 + so), vt, S1 * gc1);
                S2 = MF16(*(const LAS bf16x4_t*)(sb + CK_KCT + 1024 + so), vt, S2 * gc2); S3 = MF16(*(const LAS bf16x4_t*)(sb + CK_KCT + 1536 + so), vt, S3 * gc3);
                const f32x4 u = MF16(tm, pk4(u0), zero);
                const bf16x4_t nub = pk4(-u);
                y = MF16(mrb, nub, y);
                S0 = MF16(*(const LAS bf16x4_t*)(sb + CK_BCT + so), nub, S0); S1 = MF16(*(const LAS bf16x4_t*)(sb + CK_BCT + 512 + so), nub, S1);
                S2 = MF16(*(const LAS bf16x4_t*)(sb + CK_BCT + 1024 + so), nub, S2); S3 = MF16(*(const LAS bf16x4_t*)(sb + CK_BCT + 1536 + so), nub, S3);
                LAS float* yb = L + SC_YOFF + (c & 1) * SC_TC * 64 + i0l + ln;
#pragma unroll
                for (int jj = 0; jj < 4; ++jj) yb[(4 * q + jj) * 64] = y[jj];
                if (prompt && (c & 15) == 15) { ScDesc d; sc_desc(d, slot, c);
                    float* dp = a.out + id.z + O_ST + ((((size_t)(d.b * 2 + j) * 2 + d.dir) * 16 + d.h) * 64 + i0l + ln) * 64 + 4 * q;
                    *(f32x4*)dp = S0; *(f32x4*)(dp + 16) = S1; *(f32x4*)(dp + 32) = S2; *(f32x4*)(dp + 48) = S3; }
                if (c + 3 < NC) ck_aew_finish(F, id, lds + CK_AEW + ((c + 3) & 1) * 6912, w, lds + CK_L1F + ((c + 3) & 1) * 4096);
                __syncthreads();
            }
        }
        __syncthreads();
    }
}
__device__ __forceinline__ void ph_rw_post(const Args& a, const Ids& id, int layer) {
    const int j = layer >> 1, lane = id.lane;
    const bf16* RKV = (const bf16*)(a.ws + id.z + A_RKV); const bf16* Y = (const bf16*)(a.ws + id.z + A_Y);
    const float* BS = (const float*)(a.ws + id.z + A_BS); bf16* H = (bf16*)(a.ws + id.z + A_H);
    const float* lnx = a.in[29 + id.z] + (size_t)j * 2 * D;
    f32x4 l0[4], l1[4];
#pragma unroll
    for (int q = 0; q < 4; ++q) { const int c = 4 * lane + 256 * q; l0[q] = *(const f32x4*)(lnx + c); l1[q] = *(const f32x4*)(lnx + D + c); }
    for (int m = id.gw; m < NTOK; m += id.ngw) {
        f32x4 y[4], v[4], g[4]; float s[4], qv[4], bs[4];
#pragma unroll
        for (int q = 0; q < 4; ++q) { const int c = 4 * lane + 256 * q; y[q] = ld_bf4(Y + (size_t)m * D + c) + ld_bf4(Y + ((size_t)NTOK + m) * D + c);
            v[q] = ld_bf4(RKV + (size_t)m * 3072 + 2048 + c); g[q] = ld_bf4(H + (size_t)m * D + c);
            bs[q] = BS[(size_t)m * 16 + (lane >> 4) + 4 * q] + BS[((size_t)NTOK + m) * 16 + (lane >> 4) + 4 * q]; }
#pragma unroll
        for (int q = 0; q < 4; ++q) s[q] = (y[q][0] + y[q][1]) + (y[q][2] + y[q][3]);
        row16_sum4(s[0], s[1], s[2], s[3]);
#pragma unroll
        for (int q = 0; q < 4; ++q) { const float mean = s[q] * (1.0f / 64.0f); y[q] = y[q] - mean; qv[q] = (y[q][0] * y[q][0] + y[q][1] * y[q][1]) + (y[q][2] * y[q][2] + y[q][3] * y[q][3]); }
        row16_sum4(qv[0], qv[1], qv[2], qv[3]);
#pragma unroll
        for (int q = 0; q < 4; ++q) { const float ri = 1.0f / sqrtf(qv[q] * (1.0f / 64.0f) + 64e-5f); const f32x4 o = ((y[q] * ri) * l0[q] + l1[q] + v[q] * bs[q]) * g[q];
            *(v2u*)(H + (size_t)m * D + 4 * lane + 256 * q) = (v2u){pk2(o[0], o[1]), pk2(o[2], o[3])}; }
    }
}

enum Kind { K_PRO = 0, K_NORM0 = 1, K_QKV = 2, K_APOST = 3, K_ATTN = 4, K_ACOMB = 5, K_MIXOUT = 6, K_RNORM = 7, K_MLP1 = 8, K_MLP2 = 9, K_REND = 10,
            K_RMIX = 11, K_RKV = 12, K_RPREP = 13, K_RSCAN = 14, K_RPOST = 15, K_RENDMIX = 16 };
constexpr int NPH = 36;
#ifndef PROBE_MASK
#define PROBE_MASK 0
#endif
#ifndef PROBE_REPS
#define PROBE_REPS 1
#endif
template <int KIND, int LAYER>
__device__ __forceinline__ void run_phase(const Args& a, LAS unsigned char* lds, int G, int bx, int vcu, int wave_s, int rep) {
    Ids id; { int lv; asm volatile("v_mbcnt_lo_u32_b32 %0, -1, 0\n\tv_mbcnt_hi_u32_b32 %0, -1, %0" : "=v"(lv)); int zz; asm volatile("s_mov_b32 %0, 0" : "=s"(zz)); id.lane = lv; id.z = zz; }
    id.wave = wave_s; id.tid = wave_s * 64 + id.lane; id.gw = vcu * NWAVES + id.wave; id.ngw = G * NWAVES;
    constexpr int layer = LAYER;
    if constexpr (KIND == K_PRO) ph_prologue(a, id, lds);
    else if constexpr (KIND == K_NORM0) ph_norm0(a, id);
    else if constexpr (KIND == K_QKV) {
        constexpr int j = layer >> 1;
        pg8::Gemm g{(const bf16*)(a.ws + id.z + A_H), (const bf16*)(a.ws + id.z + W_WINT), NTOK, NQKV, D}; pg8::StaticOrder S; S.init(NTOK, NQKV, G, bx);
        const float* RC = (const float*)(a.ws + id.z + WS_ROPE);
        pg8::EpiQkv<QkvMap> E{a.ws + id.z, a.out + id.z, a.in[14 + id.z] + j * 128, RC, RC + 2048 * 64, j};
        pg8::gemm_phase<pg8::EpiQkv<QkvMap>, pg8::StaticOrder, true, true>(lds + RING_OFF, g, S, E, id.wave);
        { Ids id2 = id; int lv; asm volatile("v_mbcnt_lo_u32_b32 %0, -1, 0\n\tv_mbcnt_hi_u32_b32 %0, -1, %0" : "=v"(lv)); int zz; asm volatile("s_mov_b32 %0, 0" : "=s"(zz));
          id2.lane = lv; id2.z = zz; id2.tid = id.wave * 64 + lv;
          if (G == 256) { if (bx >= 64) { id2.gw = (bx - 64) * NWAVES + id.wave; id2.ngw = 192 * NWAVES; ph_att_cache(a, id2, layer); conv_weights(a, id2, lds, layer, 2); } }
          else { ph_att_cache(a, id2, layer); conv_weights(a, id2, lds, layer, 2); } }
    }
    else if constexpr (KIND == K_MIXOUT) {
        pg8::Gemm g{(const bf16*)(a.ws + id.z + A_H), (const bf16*)(a.ws + id.z + ((layer & 1) ? W_WOT : W_WOUTT)), NTOK, D, D}; pg8::StaticOrder S; S.init(NTOK, D, G, bx);
        pg8::EpiBf16<0> E{(bf16*)(a.ws + id.z + A_M), D, 1 << 20, nullptr, 0};
        pg8::gemm_phase<pg8::EpiBf16<0>, pg8::StaticOrder, true, true>(lds + RING_OFF, g, S, E, id.wave);
    }
    else if constexpr (KIND == K_MLP2) {
        pg8::Gemm g{(const bf16*)(a.ws + id.z + A_HID), (const bf16*)(a.ws + id.z + W_W2T), NTOK, D, FF}; pg8::StaticOrder S; S.init(NTOK, D, G, bx);
        pg8::EpiBf16<0> E{(bf16*)(a.ws + id.z + A_F), D, 1 << 20, nullptr, 0};
        pg8::gemm_phase<pg8::EpiBf16<0>, pg8::StaticOrder, true, true>(lds + RING_OFF, g, S, E, id.wave);
    }
    else if constexpr (KIND == K_MLP1) {
        pg8::Gemm g{(const bf16*)(a.ws + id.z + A_H), (const bf16*)(a.ws + id.z + W_W1T), NTOK, FF, D}; pg8::StaticOrder S; S.init(NTOK, FF, G, bx);
        pg8::EpiBf16<2> E{(bf16*)(a.ws + id.z + A_HID), FF, 1 << 20, nullptr, 0};
        pg8::gemm_phase<pg8::EpiBf16<2>, pg8::StaticOrder, true, true>(lds + RING_OFF, g, S, E, id.wave);
    }
    else if constexpr (KIND == K_RKV) {
        {
            pg8::Gemm g{(const bf16*)(a.ws + id.z + A_A2), (const bf16*)(a.ws + id.z + W_BTL), NTOK, 512, KRKV}; pg8::StaticOrder S; S.init(NTOK, 512, G, bx);
            pg8::EpiL1 E{(bf16*)(a.ws + id.z + A_L1)};
            pg8::gemm_phase<pg8::EpiL1, pg8::StaticOrder, true, true>(lds + RING_OFF, g, S, E, id.wave); }
        {
            pg8::Gemm g{(const bf16*)(a.ws + id.z + A_XS), (const bf16*)(a.ws + id.z + W_BTR), 3 * NTOK, 3072, D}; pg8::RkvOrder S{bx};
            pg8::EpiRkv3 E{(bf16*)(a.ws + id.z + A_RKV)};
            pg8::gemm_phase<pg8::EpiRkv3, pg8::RkvOrder, true, true>(lds + RING_OFF, g, S, E, id.wave); }
    }
    else if constexpr (KIND == K_RPREP) {
        constexpr int j = layer >> 1;
        static_assert(A_A1 - A_A0 == 32 * MiB && A_EW0 - A_A0 == 64 * MiB && A_EW1 - A_A0 == 96 * MiB, "EpiLora2 output stride");
        pg8::EpiLora2 E{(bf16*)(a.ws + id.z + A_A0), (size_t)16 * MiB, (bf16*)(a.ws + id.z + A_G), a.in[23 + id.z] + (size_t)j * 2 * D, a.in[20 + id.z] + (size_t)j * 2 * D};
        lora2_phase(lds + RING_OFF, (const bf16*)(a.ws + id.z + A_L1), (const bf16*)(a.ws + id.z + W_BT2), E, G, bx, id);
        { Ids id2 = id; int lv; asm volatile("v_mbcnt_lo_u32_b32 %0, -1, 0\n\tv_mbcnt_hi_u32_b32 %0, -1, %0" : "=v"(lv)); int zz; asm volatile("s_mov_b32 %0, 0" : "=s"(zz));
          id2.lane = lv; id2.z = zz; id2.tid = id.wave * 64 + lv; ph_rw_prep(a, id2, layer); }
    }
    else if constexpr (KIND == K_ATTN) ph_attn(a, id, lds, G, vcu);
    else if constexpr (KIND == K_ACOMB) ph_att_comb(a, id, layer);
    else if constexpr (KIND == K_RNORM) ph_resid_norm(a, id, layer, rep + 1 < (((PROBE_MASK >> K_RNORM) & 1) ? PROBE_REPS : 1));
    else if constexpr (KIND == K_REND) ph_resid_end(a, id, lds, layer, rep + 1 < (((PROBE_MASK >> K_REND) & 1) ? PROBE_REPS : 1));
    else if constexpr (KIND == K_RMIX) ph_rw_mix(a, id, layer);
    else if constexpr (KIND == K_RENDMIX) ph_rend_mix(a, id, lds, layer);
    else if constexpr (KIND == K_RSCAN) { if (rep > 0) { ph_rw_prep(a, id, layer); __syncthreads(); cg::this_grid().sync(); } ph_rw_scan(a, id, lds, layer, G, vcu); }
    else if constexpr (KIND == K_RPOST) ph_rw_post(a, id, layer);
}

__global__ void __launch_bounds__(NWAVES * 64, 2) mega_fwd(Args a) {
    extern __shared__ __attribute__((aligned(16))) unsigned char lds_raw[];
    LAS unsigned char* lds = (LAS unsigned char*)lds_raw;
    const int G = gridDim.x, bx = blockIdx.x; const int vcu = (G % 8 == 0) ? (bx % 8) * (G / 8) + bx / 8 : bx;
    volatile LAS unsigned* MISC = (volatile LAS unsigned*)(lds + MISC_OFF);
    for (int u = threadIdx.x; u < (LDS_BYTES - LDSCTL_OFF) / 4; u += NWAVES * 64) ((LAS unsigned*)(lds + LDSCTL_OFF))[u] = 0u;
    __syncthreads();
#if MK_N_LAUNCHES == 1 && !MK_CG_BARRIER
    XcdBarrier bar = xcd_barrier_post((unsigned*)(a.ws + WS_CTL) + CW_BAR, MISC + 8, threadIdx.x == 0);
#endif
    (void)MISC;
    const int lo = a.ph_lo, hi = a.ph_hi;
    const int wave_s = __builtin_amdgcn_readfirstlane(threadIdx.x >> 6);
#if MK_N_LAUNCHES == 1
#if MK_CG_BARRIER
#define GRID_BAR(ph) cg::this_grid().sync()
#else
#define GRID_BAR(ph) do { if ((ph) == 0) cg::this_grid().sync(); else { int l_; asm volatile("v_mbcnt_lo_u32_b32 %0, -1, 0\n\tv_mbcnt_hi_u32_b32 %0, -1, %0" : "=v"(l_)); xcd_barrier(bar, wave_s == 0 && l_ == 0); } } while (0)
#endif
#else
#define GRID_BAR(ph) do { } while (0)
#endif
#define PHASE(ph, KIND, LAYER) do { if (lo <= (ph) && (ph) < hi) { constexpr int nrep_ = ((PROBE_MASK >> (KIND)) & 1) ? PROBE_REPS : 1; \
        _Pragma("unroll 1") for (int rep_ = 0; rep_ < nrep_; ++rep_) { run_phase<KIND, LAYER>(a, lds, G, bx, vcu, wave_s, rep_); if (rep_ + 1 < nrep_) { __syncthreads(); cg::this_grid().sync(); } } \
        if ((ph) + 1 < hi) GRID_BAR(ph); } } while (0)
#define ATTN_LAYER(p0, L) PHASE((p0) + 0, K_QKV, L); PHASE((p0) + 1, K_ATTN, L); PHASE((p0) + 2, K_ACOMB, L); PHASE((p0) + 3, K_MIXOUT, L); \
        PHASE((p0) + 4, K_RNORM, L); PHASE((p0) + 5, K_MLP1, L); PHASE((p0) + 6, K_MLP2, L); PHASE((p0) + 7, K_RENDMIX, L)
#define RWKV_LAYER(p0, L) PHASE((p0) + 0, K_RKV, L); PHASE((p0) + 1, K_RPREP, L); PHASE((p0) + 2, K_RSCAN, L); PHASE((p0) + 3, K_RPOST, L); PHASE((p0) + 4, K_MIXOUT, L); \
        PHASE((p0) + 5, K_RNORM, L); PHASE((p0) + 6, K_MLP1, L); PHASE((p0) + 7, K_MLP2, L); PHASE((p0) + 8, K_REND, L)
    PHASE(0, K_PRO, 0); PHASE(1, K_NORM0, 0);
    ATTN_LAYER(2, 0); RWKV_LAYER(10, 1); ATTN_LAYER(19, 2); RWKV_LAYER(27, 3);
#undef PHASE
#undef ATTN_LAYER
#undef RWKV_LAYER
#undef GRID_BAR
}

extern "C" void kernel_launch(void* const* d_in, const int* in_sizes, int n_in, void* d_out, int out_size, void* d_ws, size_t ws_size, hipStream_t stream) {
    static int grid = 0;
    if (grid == 0) {
        if (n_in != 32 || (size_t)out_size != OUT_TOTAL || ws_size < WS_END) { fprintf(stderr, "kernel_launch: unexpected problem (n_in %d, out %d, ws %zu; need ws >= %zu); nothing launched\n", n_in, out_size, ws_size, (size_t)WS_END); grid = -1; return; }
        int dev = 0, cus = 0, per_cu = 0;
        if (hipGetDevice(&dev) != hipSuccess || hipDeviceGetAttribute(&cus, hipDeviceAttributeMultiprocessorCount, dev) != hipSuccess) { grid = -1; return; }
        if (hipFuncSetAttribute((const void*)mega_fwd, hipFuncAttributeMaxDynamicSharedMemorySize, LDS_BYTES) != hipSuccess) { fprintf(stderr, "kernel_launch: hipFuncSetAttribute failed\n"); grid = -1; return; }
        if (hipOccupancyMaxActiveBlocksPerMultiprocessor(&per_cu, (const void*)mega_fwd, NWAVES * 64, LDS_BYTES) != hipSuccess || per_cu < 1) { fprintf(stderr, "kernel_launch: occupancy query failed (%d)\n", per_cu); (void)hipGetLastError(); per_cu = 1; }
        grid = cus * (per_cu < 1 ? 1 : 1);
        fprintf(stderr, "kernel_launch: %d CUs, occupancy %d/CU, grid %d\n", cus, per_cu, grid);
    }
    if (grid < 0) return;
    (void)in_sizes;
    if (hipMemsetAsync((char*)d_ws + WS_CTL, 0, CTL_ZERO_BYTES, stream) != hipSuccess) { fprintf(stderr, "kernel_launch: memset failed\n"); return; }
    Args a{};
    for (int i = 0; i < 32; ++i) a.in[i] = (const float*)d_in[i];
    a.out = (float*)d_out; a.ws = (unsigned char*)d_ws;
#if MK_N_LAUNCHES == 1
    a.ph_lo = 0; a.ph_hi = NPH;
    void* args[] = {&a};
    hipError_t e = hipLaunchCooperativeKernel((const void*)mega_fwd, dim3(grid), dim3(NWAVES * 64), args, LDS_BYTES, stream);
    if (e != hipSuccess) fprintf(stderr, "kernel_launch: cooperative launch failed: %s (grid %d)\n", hipGetErrorString(e), grid);
#else
    for (int ph = 0; ph < NPH; ++ph) {
        a.ph_lo = ph; a.ph_hi = ph + 1;
        hipLaunchKernelGGL(mega_fwd, dim3(grid), dim3(NWAVES * 64), LDS_BYTES, stream, a);
    }
#endif
}
```
